# Optimizing an MI355X kernel written in HIP

```python
import jax, jax.numpy as jnp
from jax import lax
import numpy as np


D_MODEL = 1024
BATCH = 8
SEQ = 4096
DEPTH = 2

GRID_W = 64
CTX_LEN = 256
W_A = 256
H_A = 4
DH_A = 64
HGRN_CHUNK = 16
W_B = 384
H_B = 4
DH_B = 96
MLSTM_CHUNK = 64
W_C = 384
H_C = 6
DH_C = 64
WIN_ROWS = 8
WIN_COLS = 16
W_MIX = W_A + W_B + W_C
ROPE_BASE = 10000.0
EPS = 1e-6
SPLITS = (('a_q', W_A), ('a_ff', W_A), ('a_fb', W_A), ('a_i', W_A), ('a_z', W_A),
          ('b_q', W_B), ('b_k', W_B), ('b_v', W_B), ('b_o', W_B), ('b_z', W_B), ('b_g', 4 * H_B),
          ('c_q', W_C), ('c_k', W_C), ('c_v', W_C), ('c_z', W_C))
P_IN = 5 * W_A + 5 * W_B + 4 * H_B + 4 * W_C

kernel_name = 'hybrid_hgrn2_mlstm_natten_block'


def rms(x, g):
    x32 = x.astype(jnp.float32)
    return x32 * lax.rsqrt(jnp.mean(x32 * x32, axis=-1, keepdims=True) + EPS) * g.astype(jnp.float32)


def heads(a, h):
    return a.reshape(*a.shape[:-1], h, a.shape[-1] // h)


def head_rms(o, g):
    o = o * lax.rsqrt(jnp.mean(o * o, axis=-1, keepdims=True) + EPS)
    return o.reshape(*o.shape[:-2], -1) * g.astype(jnp.float32)


def split_proj(p):
    out = {}
    off = 0
    for name, w in SPLITS:
        out[name] = p[..., off:off + w]
        off += w
    return out


def rope_2d(x):
    T, d = x.shape[1], x.shape[-1]
    t = jnp.arange(T)
    half = d // 2

    def rot(xp, pos):
        dp = xp.shape[-1]
        inv = ROPE_BASE ** (-jnp.arange(0, dp, 2, dtype=jnp.float32) / dp)
        ang = pos.astype(jnp.float32)[:, None] * inv[None, :]
        cos = jnp.cos(ang)[None, :, None, :]
        sin = jnp.sin(ang)[None, :, None, :]
        x1, x2 = xp[..., :dp // 2], xp[..., dp // 2:]
        return jnp.concatenate([x1 * cos - x2 * sin, x2 * cos + x1 * sin], axis=-1)

    return jnp.concatenate([rot(x[..., :half], t // GRID_W), rot(x[..., half:], t % GRID_W)], axis=-1)


def gla_chunked(q, k, v, logf, s0):
    B, T, H, dk = q.shape
    dv = v.shape[-1]
    L = HGRN_CHUNK
    N = T // L
    q = q.reshape(B, N, L, H, dk)
    k = k.reshape(B, N, L, H, dk)
    logf = logf.reshape(B, N, L, H, dk)
    v = v.reshape(B, N, L, H, dv)
    b = jnp.cumsum(logf, axis=2)
    mask = np.tril(np.ones((L, L), dtype=bool))[None, None, :, :, None, None]
    decay = jnp.exp(jnp.where(mask, b[:, :, :, None] - b[:, :, None, :], -jnp.inf))
    A = jnp.einsum('bnthk,bnshk,bntshk->bntsh', q, k, decay)
    o_intra = jnp.einsum('bntsh,bnshv->bnthv', A, v)
    bL = b[:, :, -1]
    U = jnp.einsum('bnshk,bnshv->bnhkv', k * jnp.exp(bL[:, :, None] - b), v)

    def step(S, inp):
        a, u = inp
        return a[..., None] * S + u, S

    s_fin, s_prev = lax.scan(step, s0, (jnp.moveaxis(jnp.exp(bL), 1, 0), jnp.moveaxis(U, 1, 0)))
    s_prev = jnp.moveaxis(s_prev, 0, 1)
    o_inter = jnp.einsum('bnthk,bnhkv->bnthv', q * jnp.exp(b), s_prev)
    return (o_intra + o_inter).reshape(B, T, H, dv), s_fin


def mlstm_chunked(q, k, v, ig, lf, state0):
    B, T, H, dk = q.shape
    dv = v.shape[-1]
    L = MLSTM_CHUNK
    N = T // L
    q = q.reshape(B, N, L, H, dk)
    k = k.reshape(B, N, L, H, dk)
    v = v.reshape(B, N, L, H, dv)
    ig = ig.reshape(B, N, L, H)
    lf = lf.reshape(B, N, L, H)
    b = jnp.cumsum(lf, axis=2)
    bL = b[:, :, -1]
    w = bL[:, :, None] + ig - b
    m_loc = jnp.max(w, axis=2)
    ew = jnp.exp(w - m_loc[:, :, None])
    C_loc = jnp.einsum('bnsh,bnshk,bnshv->bnhkv', ew, k, v)
    n_loc = jnp.einsum('bnsh,bnshk->bnhk', ew, k)

    def step(carry, inp):
        C, n, m = carry
        bl, ml, Cl, nl = inp
        m_new = jnp.maximum(bl + m, ml)
        a = jnp.exp(bl + m - m_new)
        e = jnp.exp(ml - m_new)
        C_new = a[..., None, None] * C + e[..., None, None] * Cl
        n_new = a[..., None] * n + e[..., None] * nl
        return (C_new, n_new, m_new), (C, n, m)

    xs = tuple(jnp.moveaxis(a, 1, 0) for a in (bL, m_loc, C_loc, n_loc))
    final, (C_prev, n_prev, m_prev) = lax.scan(step, state0, xs)
    C_prev = jnp.moveaxis(C_prev, 0, 1)
    n_prev = jnp.moveaxis(n_prev, 0, 1)
    m_prev = jnp.moveaxis(m_prev, 0, 1)
    mask = np.tril(np.ones((L, L), dtype=bool))[None, None, :, :, None]
    D = jnp.where(mask, b[:, :, :, None] - b[:, :, None, :] + ig[:, :, None], -jnp.inf)
    inter = b + m_prev[:, :, None]
    m_t = jnp.maximum(jnp.max(D, axis=3), inter)
    S = jnp.einsum('bnthk,bnshk->bntsh', q, k) * jnp.exp(D - m_t[:, :, :, None])
    e_in = jnp.exp(inter - m_t)
    num = jnp.einsum('bntsh,bnshv->bnthv', S, v) + e_in[..., None] * jnp.einsum('bnthk,bnhkv->bnthv', q, C_prev)
    den = jnp.sum(S, axis=3) + e_in * jnp.einsum('bnthk,bnhk->bnth', q, n_prev)
    h = num / jnp.maximum(jnp.abs(den), jnp.exp(-m_t))[..., None]
    return h.reshape(B, T, H, dv), final


def hgrn2_mixer(px, pc, lb, gn, need_ctx):
    lb = lb.reshape(2, H_A, DH_A)

    def direction(p, d, s0, reverse):
        q = heads(jax.nn.silu(p['a_q']), H_A) * (DH_A ** -0.5)
        v = heads(p['a_i'], H_A)
        fl = heads(p[('a_ff', 'a_fb')[d]], H_A)
        lbd = lb[d]
        logf = jnp.logaddexp(jnp.log(lbd), jnp.log1p(-lbd) + jax.nn.log_sigmoid(fl))
        k = (1.0 - lbd) * jax.nn.sigmoid(-fl)
        if reverse:
            q, k, v, logf = (jnp.flip(a, axis=1) for a in (q, k, v, logf))
        o, s = gla_chunked(q, k, v, logf, s0)
        if reverse:
            o = jnp.flip(o, axis=1)
        return o, s

    B = px['a_q'].shape[0]
    s0 = jnp.zeros((B, H_A, DH_A, DH_A), jnp.float32)
    oc_f, sc_f = direction(pc, 0, s0, False)
    oc_b, sc_b = direction(pc, 1, s0, True)
    ol_f, _ = direction(px, 0, sc_f, False)
    ol_b, _ = direction(px, 1, sc_b, True)
    y = head_rms(ol_f + ol_b, gn) * jax.nn.silu(px['a_z'])
    yc = head_rms(oc_f + oc_b, gn) * jax.nn.silu(pc['a_z']) if need_ctx else None
    return y, yc


def mlstm_mixer(px, pc, gate_b, gn, need_ctx):
    def prep(p, rotary):
        q = heads(p['b_q'], H_B) * (DH_B ** -0.5)
        k = heads(p['b_k'], H_B)
        v = heads(p['b_v'], H_B)
        if rotary:
            q, k = rope_2d(q), rope_2d(k)
        g = p['b_g'].reshape(*p['b_g'].shape[:-1], 4, H_B) + gate_b.astype(jnp.float32)
        return q, k, v, g

    def direction(q, k, v, g, d, state0, reverse):
        ig = g[..., d, :]
        lf = jax.nn.log_sigmoid(g[..., 2 + d, :])
        if reverse:
            q, k, v, ig, lf = (jnp.flip(a, axis=1) for a in (q, k, v, ig, lf))
        h, st = mlstm_chunked(q, k, v, ig, lf, state0)
        if reverse:
            h = jnp.flip(h, axis=1)
        return h, st

    B = px['b_q'].shape[0]
    state0 = (jnp.zeros((B, H_B, DH_B, DH_B), jnp.float32), jnp.zeros((B, H_B, DH_B), jnp.float32),
              jnp.zeros((B, H_B), jnp.float32))
    qc, kc, vc, gc = prep(pc, False)
    ql, kl, vl, gl = prep(px, True)
    hc_f, st_f = direction(qc, kc, vc, gc, 0, state0, False)
    hc_b, st_b = direction(qc, kc, vc, gc, 1, state0, True)
    hl_f, _ = direction(ql, kl, vl, gl, 0, st_f, False)
    hl_b, _ = direction(ql, kl, vl, gl, 1, st_b, True)
    y = jax.nn.sigmoid(px['b_o']) * head_rms(hl_f + hl_b, gn) * jax.nn.silu(px['b_z'])
    yc = (jax.nn.sigmoid(pc['b_o']) * head_rms(hc_f + hc_b, gn) * jax.nn.silu(pc['b_z'])) if need_ctx else None
    return y, yc


def na_mixer(px, pc, rpb, need_ctx):
    scale = DH_C ** -0.5
    q = heads(px['c_q'], H_C) * scale
    k = heads(px['c_k'], H_C)
    v = heads(px['c_v'], H_C)
    qc = heads(pc['c_q'], H_C) * scale
    kc = heads(pc['c_k'], H_C)
    vc = heads(pc['c_v'], H_C)
    B, T = q.shape[0], q.shape[1]
    rows = T // GRID_W
    win_r = min(WIN_ROWS, rows)
    qg = q.reshape(B, rows, GRID_W, H_C, DH_C)
    kg = k.reshape(B, rows, GRID_W, H_C, DH_C)
    vg = v.reshape(B, rows, GRID_W, H_C, DH_C)
    col = np.arange(GRID_W)
    cs = np.clip(col - WIN_COLS // 2, 0, GRID_W - WIN_COLS)
    band = (col[None, :] >= cs[:, None]) & (col[None, :] < cs[:, None] + WIN_COLS)
    dc_idx = np.clip(col[None, :] - col[:, None] + WIN_COLS - 1, 0, 2 * WIN_COLS - 2)
    rpb_c = rpb.astype(jnp.float32)[:, :, dc_idx]
    band_b = band[:, None, :]

    def row_fn(r):
        rs = jnp.clip(r - win_r // 2, 0, rows - win_r)
        q_r = lax.dynamic_index_in_dim(qg, r, axis=1, keepdims=False)
        k_b = lax.dynamic_slice_in_dim(kg, rs, win_r, axis=1)
        v_b = lax.dynamic_slice_in_dim(vg, rs, win_r, axis=1)
        dr = rs - r + jnp.arange(win_r) + WIN_ROWS - 1
        bias = jnp.transpose(jnp.take(rpb_c, dr, axis=1), (0, 2, 1, 3))
        s_w = jnp.einsum('bchd,bjkhd->bhcjk', q_r, k_b) + bias[None]
        s_w = jnp.where(band_b, s_w, -jnp.inf)
        s_c = jnp.einsum('bchd,bnhd->bhcn', q_r, kc)
        logits = jnp.concatenate([s_w.reshape(B, H_C, GRID_W, win_r * GRID_W), s_c], axis=-1).astype(jnp.float32)
        p = jax.nn.softmax(logits, axis=-1)
        p_w = p[..., :win_r * GRID_W].reshape(B, H_C, GRID_W, win_r, GRID_W)
        p_c = p[..., win_r * GRID_W:]
        return jnp.einsum('bhcjk,bjkhd->bchd', p_w, v_b) + jnp.einsum('bhcn,bnhd->bchd', p_c, vc)

    o = lax.map(row_fn, jnp.arange(rows))
    o = jnp.moveaxis(o, 0, 1).reshape(B, T, W_C)
    y = o * jax.nn.silu(px['c_z'])
    yc = None
    if need_ctx:
        s = jnp.einsum('bnhd,bmhd->bhnm', qc, kc).astype(jnp.float32)
        oc = jnp.einsum('bhnm,bmhd->bnhd', jax.nn.softmax(s, axis=-1), vc)
        yc = oc.reshape(B, oc.shape[1], W_C) * jax.nn.silu(pc['c_z'])
    return y, yc


def setup_inputs(seed: int = 0) -> dict:
    key = jax.random.key(seed)
    ks = jax.random.split(key, 16)
    nrm = jax.random.normal
    f32 = jnp.float32
    gate_b = jnp.concatenate([0.1 * nrm(ks[12], (DEPTH, 2, H_B), f32),
                              3.0 + 0.5 * nrm(ks[13], (DEPTH, 2, H_B), f32)], axis=1)
    return {
        'x': nrm(ks[0], (BATCH, SEQ, D_MODEL), f32),
        'c': nrm(ks[1], (BATCH, D_MODEL), f32),
        'ctx': nrm(ks[2], (BATCH, CTX_LEN, D_MODEL), f32),
        'c_ctx': nrm(ks[3], (D_MODEL,), f32),
        'w_mod': 0.5 * D_MODEL ** -0.5 * nrm(ks[4], (DEPTH, D_MODEL, 3 * D_MODEL), f32),
        'b_mod': 0.02 * nrm(ks[5], (DEPTH, 3 * D_MODEL), f32),
        'g_pre': 1.0 + 0.02 * nrm(ks[6], (DEPTH, D_MODEL), f32),
        'g_post': 1.0 + 0.02 * nrm(ks[7], (DEPTH, D_MODEL), f32),
        'w_in': D_MODEL ** -0.5 * nrm(ks[8], (DEPTH, D_MODEL, P_IN), f32),
        'w_out': W_MIX ** -0.5 * nrm(ks[9], (DEPTH, W_MIX, D_MODEL), f32),
        'hgrn_lb': 0.5 * nrm(ks[10], (DEPTH, 2, W_A), f32),
        'hgrn_gn': 1.0 + 0.02 * nrm(ks[11], (DEPTH, W_A), f32),
        'mlstm_gate_b': gate_b,
        'mlstm_gn': 1.0 + 0.02 * nrm(ks[14], (DEPTH, W_B), f32),
        'na_rpb': 0.02 * nrm(ks[15], (DEPTH, H_C, 2 * WIN_ROWS - 1, 2 * WIN_COLS - 1), f32),
    }


def reference(x, c, ctx, c_ctx, w_mod, b_mod, g_pre, g_post, w_in, w_out, hgrn_lb, hgrn_gn, mlstm_gate_b, mlstm_gn, na_rpb):
    lb_cum = jnp.cumsum(jax.nn.softmax(hgrn_lb.astype(jnp.float32), axis=0), axis=0)
    lb_all = lb_cum - lb_cum[0]
    for l in range(DEPTH):
        need_ctx = l < DEPTH - 1
        mod = jax.nn.silu(c.astype(jnp.float32)) @ w_mod[l] + b_mod[l]
        mod_c = jax.nn.silu(c_ctx.astype(jnp.float32)) @ w_mod[l] + b_mod[l]
        sh, sc, gt = jnp.split(mod, 3, axis=-1)
        shc, scc, gtc = jnp.split(mod_c, 3, axis=-1)
        hx = rms(x, g_pre[l]) * (1.0 + sc[:, None]) + sh[:, None]
        hc = rms(ctx, g_pre[l]) * (1.0 + scc) + shc
        px = split_proj(hx @ w_in[l])
        pc = split_proj(hc @ w_in[l])
        ya, yac = hgrn2_mixer(px, pc, lb_all[l], hgrn_gn[l], need_ctx)
        yb, ybc = mlstm_mixer(px, pc, mlstm_gate_b[l], mlstm_gn[l], need_ctx)
        yc, ycc = na_mixer(px, pc, na_rpb[l], need_ctx)
        ux = jnp.concatenate([ya, yb, yc], axis=-1) @ w_out[l]
        x = x + (gt[:, None] * rms(ux, g_post[l])).astype(x.dtype)
        if need_ctx:
            uc = jnp.concatenate([yac, ybc, ycc], axis=-1) @ w_out[l]
            ctx = ctx + (gtc * rms(uc, g_post[l])).astype(ctx.dtype)
    return x
```

```cpp
#include <hip/hip_runtime.h>
#include <stdint.h>
#include <cstdio>

namespace cfg {
constexpr int D = 1024, NB = 8, S = 4096, CTX = 256;
constexpr int MX = NB * S, MC = NB * CTX, M = MX + MC;
constexpr int PIN = 4752, NPAD = 4864, PLD = 4736;
constexpr int A_Q = 0, A_FF = 256, A_FB = 512, A_I = 768, A_Z = 1024, B_Q = 1280, B_K = 1664, B_V = 2048, B_O = 2432, B_Z = 2816,
              C_Q = 3200, C_K = 3584, C_V = 3968, C_Z = 4352;
constexpr float EPS = 1e-6f;
constexpr size_t WS_WT_IN = 0;
constexpr size_t WS_WT_OUT = WS_WT_IN + 2ull * NPAD * 1024 * 2;
constexpr size_t WS_MOD = WS_WT_OUT + 2ull * 1024 * 1024 * 2;
constexpr size_t WS_GATES = WS_MOD + 2ull * 9 * 3072 * 4;
constexpr size_t WS_CTX1 = WS_GATES + (size_t)M * 16 * 4;
constexpr size_t WS_HXY = WS_CTX1 + (size_t)MC * 1024 * 4;
constexpr size_t WS_P = WS_HXY + (size_t)M * 1024 * 2;
constexpr size_t WS_OH = WS_P + (size_t)M * PLD * 2;
constexpr size_t WS_OM = WS_OH + (size_t)M * 256 * 4;
constexpr size_t WS_END = WS_OM + (size_t)M * 384 * 4;
static_assert(WS_END <= 536870912ull, "workspace");
static_assert(WS_MOD % 256 == 0 && WS_GATES % 256 == 0 && WS_CTX1 % 256 == 0 && WS_HXY % 256 == 0 && WS_P % 256 == 0 && WS_OH % 256 == 0 && WS_OM % 256 == 0, "align");
}
using namespace cfg;

typedef unsigned short bf16;
typedef short bf16x8 __attribute__((ext_vector_type(8)));
typedef float f32x4 __attribute__((ext_vector_type(4)));

__device__ __forceinline__ float bf2f(bf16 v) { return __uint_as_float(((unsigned)v) << 16); }
__device__ __forceinline__ bf16 f2bf(float f) { unsigned u = __float_as_uint(f); u += 0x7fffu + ((u >> 16) & 1u); return (bf16)(u >> 16); }
__device__ __forceinline__ float silu_f(float v) { return v / (1.f + __expf(-v)); }
__device__ __forceinline__ float sigmoid_f(float v) { return 1.f / (1.f + __expf(-v)); }
__device__ __forceinline__ float logsigmoid_f(float v) { return fminf(v, 0.f) - log1pf(__expf(-fabsf(v))); }
__device__ __forceinline__ float wave_sum(float v) {
#pragma unroll
    for (int o = 1; o < 64; o <<= 1) v += __shfl_xor(v, o);
    return v;
}

__global__ void k_convert_w(const float* __restrict__ w_in, const float* __restrict__ w_out, bf16* __restrict__ wt_in, bf16* __restrict__ wt_out) {
    const size_t total_in = 2ull * NPAD * 1024, total_out = 2ull * 1024 * 1024;
    for (size_t i = (size_t)blockIdx.x * blockDim.x + threadIdx.x; i < total_in + total_out; i += (size_t)gridDim.x * blockDim.x) {
        if (i < total_in) {
            const int k = (int)(i % 1024); const int n = (int)((i / 1024) % NPAD); const int l = (int)(i / (1024ull * NPAD));
            const int no = n < 3200 ? n : (n < 4736 ? n + 16 : (n < 4752 ? 3200 + n - 4736 : -1));
            const float v = no >= 0 ? w_in[((size_t)l * 1024 + k) * PIN + no] : 0.f;
            wt_in[i] = f2bf(v);
        } else {
            const size_t j = i - total_in; const int k = (int)(j % 1024); const int n = (int)((j / 1024) % 1024); const int l = (int)(j / (1024ull * 1024));
            wt_out[j] = f2bf(w_out[((size_t)l * 1024 + k) * 1024 + n]);
        }
    }
}

__global__ void k_mod(const float* __restrict__ c, const float* __restrict__ c_ctx, const float* __restrict__ w_mod, const float* __restrict__ b_mod, float* __restrict__ mod) {
    const int idx = blockIdx.x * blockDim.x + threadIdx.x;
    if (idx >= 2 * 9 * 3072) return;
    const int j = idx % 3072, r = (idx / 3072) % 9, l = idx / (9 * 3072);
    const float* cv = r < 8 ? c + r * 1024 : c_ctx;
    float acc = 0.f;
    for (int k = 0; k < 1024; ++k) { const float v = cv[k]; acc += silu_f(v) * w_mod[((size_t)l * 1024 + k) * 3072 + j]; }
    mod[idx] = acc + b_mod[l * 3072 + j];
}

__global__ void __launch_bounds__(256) k_prenorm(const float* __restrict__ xsrc, const float* __restrict__ csrc, const float* __restrict__ mod_l, const float* __restrict__ g_pre_l, bf16* __restrict__ hx) {
    const int m = (blockIdx.x * blockDim.x + threadIdx.x) >> 6, lane = threadIdx.x & 63;
    if (m >= M) return;
    const float* src; int r;
    if (m < MX) { src = xsrc + (size_t)m * 1024; r = m / S; } else { src = csrc + (size_t)(m - MX) * 1024; r = 8; }
    float4 v[4]; float ss = 0.f;
#pragma unroll
    for (int j = 0; j < 4; ++j) { v[j] = ((const float4*)src)[lane + 64 * j]; ss += v[j].x * v[j].x + v[j].y * v[j].y + v[j].z * v[j].z + v[j].w * v[j].w; }
    ss = wave_sum(ss);
    const float rinv = 1.f / sqrtf(ss * (1.f / 1024.f) + EPS);
    const float* sh = mod_l + r * 3072; const float* sc = sh + 1024;
#pragma unroll
    for (int j = 0; j < 4; ++j) {
        const int d = 4 * (lane + 64 * j);
        const float4 g = *(const float4*)(g_pre_l + d), s1 = *(const float4*)(sc + d), s0 = *(const float4*)(sh + d);
        const float o0 = v[j].x * rinv * g.x * (1.f + s1.x) + s0.x, o1 = v[j].y * rinv * g.y * (1.f + s1.y) + s0.y;
        const float o2 = v[j].z * rinv * g.z * (1.f + s1.z) + s0.z, o3 = v[j].w * rinv * g.w * (1.f + s1.w) + s0.w;
        ushort4 w; w.x = f2bf(o0); w.y = f2bf(o1); w.z = f2bf(o2); w.w = f2bf(o3);
        *(ushort4*)(hx + (size_t)m * 1024 + d) = w;
    }
}

template <int MODE>
__global__ void __launch_bounds__(256) k_gemm_simple(const bf16* __restrict__ A, const bf16* __restrict__ Bt, int K, bf16* __restrict__ P, float* __restrict__ gates, const float* __restrict__ gate_b_l, float* __restrict__ UX) {
    const int wave = threadIdx.x >> 6, lane = threadIdx.x & 63, r16 = lane & 15, quad = lane >> 4;
    const int m0 = blockIdx.y * 64 + wave * 16, n0 = blockIdx.x * 64;
    f32x4 acc[4];
#pragma unroll
    for (int j = 0; j < 4; ++j) acc[j] = (f32x4){0.f, 0.f, 0.f, 0.f};
    const bf16* ap = A + (size_t)(m0 + r16) * K + quad * 8;
    const bf16* bp = Bt + (size_t)(n0 + r16) * K + quad * 8;
    for (int k0 = 0; k0 < K; k0 += 32) {
        const bf16x8 a = *(const bf16x8*)(ap + k0);
#pragma unroll
        for (int j = 0; j < 4; ++j) { const bf16x8 b = *(const bf16x8*)(bp + (size_t)j * 16 * K + k0); acc[j] = __builtin_amdgcn_mfma_f32_16x16x32_bf16(a, b, acc[j], 0, 0, 0); }
    }
#pragma unroll
    for (int j = 0; j < 4; ++j)
#pragma unroll
        for (int i = 0; i < 4; ++i) {
            const int row = m0 + quad * 4 + i, col = n0 + j * 16 + r16; const float v = acc[j][i];
            if (MODE == 0) {
                if (col < PLD) P[(size_t)row * PLD + col] = f2bf(v);
                else if (col < PIN) { const int g = col - PLD; float val = v + gate_b_l[g]; if (g >= 8) val = logsigmoid_f(val); gates[(size_t)row * 16 + g] = val; }
            } else UX[(size_t)row * 1024 + col] = v;
        }
}

__device__ __forceinline__ int seq_row(int b, int step, int dir) {
    if (step < CTX) { const int n = dir ? CTX - 1 - step : step; return MX + b * CTX + n; }
    int t = step - CTX; if (dir) t = S - 1 - t; return b * S + t;
}
__global__ void __launch_bounds__(64) k_hgrn_naive(const bf16* __restrict__ P, const float* __restrict__ hgrn_lb, int l, int dir, float* __restrict__ oh) {
    const int b = blockIdx.x >> 2, h = blockIdx.x & 3, j = threadIdx.x;
    __shared__ float sq[64], sf[64], sk[64];
    float St[64];
#pragma unroll
    for (int i = 0; i < 64; ++i) St[i] = 0.f;
    float lbv = 0.f;
    if (l == 1) { const float v0 = hgrn_lb[(0 * 2 + dir) * 256 + h * 64 + j], v1 = hgrn_lb[(1 * 2 + dir) * 256 + h * 64 + j]; lbv = 1.f / (1.f + expf(v0 - v1)); }
    const int fcol = (dir ? A_FB : A_FF) + h * 64 + j;
    int m = seq_row(b, 0, dir);
    bf16 rq = P[(size_t)m * PLD + A_Q + h * 64 + j], rf = P[(size_t)m * PLD + fcol], rv = P[(size_t)m * PLD + A_I + h * 64 + j];
    for (int step = 0; step < CTX + S; ++step) {
        const int mcur = m; const float qa = bf2f(rq), fl = bf2f(rf), v = bf2f(rv);
        if (step + 1 < CTX + S) { m = seq_row(b, step + 1, dir); rq = P[(size_t)m * PLD + A_Q + h * 64 + j]; rf = P[(size_t)m * PLD + fcol]; rv = P[(size_t)m * PLD + A_I + h * 64 + j]; }
        const float q = silu_f(qa) * 0.125f, sg = sigmoid_f(fl), f = lbv + (1.f - lbv) * sg, kk = (1.f - lbv) * (1.f - sg);
        __syncthreads(); sq[j] = q; sf[j] = f; sk[j] = kk; __syncthreads();
        float o = 0.f;
#pragma unroll
        for (int i = 0; i < 64; ++i) { St[i] = sf[i] * St[i] + sk[i] * v; o += sq[i] * St[i]; }
        float* dst = oh + (size_t)mcur * 256 + h * 64 + j;
        if (dir == 0) *dst = o; else *dst += o;
    }
}
__global__ void __launch_bounds__(256) k_hgrn_combine(const float* __restrict__ oh, const bf16* __restrict__ P, const float* __restrict__ gn_l, bf16* __restrict__ Y) {
    const int m = blockIdx.x, c = threadIdx.x;
    const float o = oh[(size_t)m * 256 + c];
    const float ss = wave_sum(o * o);
    const float r = 1.f / sqrtf(ss * (1.f / 64.f) + EPS);
    const float z = bf2f(P[(size_t)m * PLD + A_Z + c]);
    Y[(size_t)m * 1024 + c] = f2bf(o * r * gn_l[c] * silu_f(z));
}

__global__ void __launch_bounds__(128) k_mlstm_naive(const bf16* __restrict__ P, const float* __restrict__ gates, int dir, float* __restrict__ om) {
    const int b = blockIdx.x >> 2, h = blockIdx.x & 3, j = threadIdx.x;
    __shared__ float sq[96], sk[96], sden;
    float Cc[96];
#pragma unroll
    for (int i = 0; i < 96; ++i) Cc[i] = 0.f;
    float mm = 0.f;
    const int part = j >= 48 ? 1 : 0, ii = j - 48 * part, fidx = ii < 24 ? ii : ii - 24, partner = ii < 24 ? j + 24 : j - 24;
    const float inv = expf(-(float)(2 * fidx) * (1.f / 48.f) * 9.210340371976184f);
    for (int step = 0; step < CTX + S; ++step) {
        const int m = seq_row(b, step, dir);
        const bf16* pr = P + (size_t)m * PLD;
        float q = 0.f, k = 0.f, v = 0.f;
        if (j < 96) {
            q = bf2f(pr[B_Q + h * 96 + j]); k = bf2f(pr[B_K + h * 96 + j]); v = bf2f(pr[B_V + h * 96 + j]);
            if (m < MX) {
                const int t = m % S; const float pos = (float)(part ? (t % 64) : (t / 64)); const float ang = pos * inv; const float cs = cosf(ang), sn = sinf(ang);
                const float q2 = bf2f(pr[B_Q + h * 96 + partner]), k2 = bf2f(pr[B_K + h * 96 + partner]);
                if (ii < 24) { q = q * cs - q2 * sn; k = k * cs - k2 * sn; } else { q = q * cs + q2 * sn; k = k * cs + k2 * sn; }
            }
            q *= 0.10206207261596575f;
        } else if (j == 96) v = 1.f;
        const float ig = gates[(size_t)m * 16 + dir * 4 + h], lf = gates[(size_t)m * 16 + 8 + dir * 4 + h];
        const float mnew = fmaxf(lf + mm, ig), a = expf(lf + mm - mnew), e = expf(ig - mnew); mm = mnew;
        __syncthreads(); if (j < 96) { sq[j] = q; sk[j] = k; } __syncthreads();
        float num = 0.f; const float ev = e * v;
#pragma unroll
        for (int i = 0; i < 96; ++i) { Cc[i] = a * Cc[i] + ev * sk[i]; num += sq[i] * Cc[i]; }
        if (j == 96) sden = num;
        __syncthreads();
        if (j < 96) {
            const float den = sden; const float hh = num / fmaxf(fabsf(den), expf(-mnew));
            float* dst = om + (size_t)m * 384 + h * 96 + j;
            if (dir == 0) *dst = hh; else *dst += hh;
        }
    }
}
__global__ void __launch_bounds__(256) k_mlstm_combine(const float* __restrict__ om, const bf16* __restrict__ P, const float* __restrict__ gn_l, bf16* __restrict__ Y) {
    const int m = blockIdx.x, h = threadIdx.x >> 6, lane = threadIdx.x & 63;
    const float e0 = om[(size_t)m * 384 + h * 96 + lane], e1 = lane < 32 ? om[(size_t)m * 384 + h * 96 + 64 + lane] : 0.f;
    const float ss = wave_sum(e0 * e0 + e1 * e1);
    const float r = 1.f / sqrtf(ss * (1.f / 96.f) + EPS);
    const bf16* pr = P + (size_t)m * PLD;
    { const int c = h * 96 + lane; Y[(size_t)m * 1024 + 256 + c] = f2bf(sigmoid_f(bf2f(pr[B_O + c])) * (e0 * r * gn_l[c]) * silu_f(bf2f(pr[B_Z + c]))); }
    if (lane < 32) { const int c = h * 96 + 64 + lane; Y[(size_t)m * 1024 + 256 + c] = f2bf(sigmoid_f(bf2f(pr[B_O + c])) * (e1 * r * gn_l[c]) * silu_f(bf2f(pr[B_Z + c]))); }
}

__device__ __forceinline__ void load_row64(const bf16* p, float* dst) {
#pragma unroll
    for (int c = 0; c < 8; ++c) { const uint4 w = *(const uint4*)(p + 8 * c); const unsigned u[4] = {w.x, w.y, w.z, w.w};
#pragma unroll
        for (int e = 0; e < 4; ++e) { dst[8 * c + 2 * e] = __uint_as_float(u[e] << 16); dst[8 * c + 2 * e + 1] = __uint_as_float(u[e] & 0xffff0000u); } }
}
__global__ void __launch_bounds__(256) k_na_naive(const bf16* __restrict__ P, const float* __restrict__ rpb_l, bf16* __restrict__ Y) {
    const int idx = blockIdx.x * blockDim.x + threadIdx.x;
    if (idx >= MX * 6) return;
    const int h = idx / MX, m = idx % MX, b = m / S, t = m % S, r = t / 64, c = t % 64;
    const int rs = min(max(r - 4, 0), 56), cs = min(max(c - 8, 0), 48);
    float q[64], acc[64], kv[64];
    load_row64(P + (size_t)m * PLD + C_Q + h * 64, q);
#pragma unroll
    for (int d = 0; d < 64; ++d) { q[d] *= 0.125f; acc[d] = 0.f; }
    float mx = -INFINITY, lsum = 0.f;
    for (int key = 0; key < 128 + CTX; ++key) {
        int km; float bias = 0.f;
        if (key < 128) { const int jr = key >> 4, kc = cs + (key & 15); km = b * S + (rs + jr) * 64 + kc; bias = rpb_l[(h * 15 + (rs + jr - r + 7)) * 31 + (kc - c + 15)]; }
        else km = MX + b * CTX + (key - 128);
        load_row64(P + (size_t)km * PLD + C_K + h * 64, kv);
        float s = 0.f;
#pragma unroll
        for (int d = 0; d < 64; ++d) s += q[d] * kv[d];
        s += bias;
        const float mnew = fmaxf(mx, s), scale = __expf(mx - mnew), pe = __expf(s - mnew); mx = mnew;
        lsum = lsum * scale + pe;
        load_row64(P + (size_t)km * PLD + C_V + h * 64, kv);
#pragma unroll
        for (int d = 0; d < 64; ++d) acc[d] = acc[d] * scale + pe * kv[d];
    }
    const float rl = 1.f / lsum;
    const bf16* zr = P + (size_t)m * PLD + C_Z + h * 64;
#pragma unroll
    for (int d = 0; d < 64; ++d) Y[(size_t)m * 1024 + 640 + h * 64 + d] = f2bf(acc[d] * rl * silu_f(bf2f(zr[d])));
}
__global__ void __launch_bounds__(256) k_na_ctx_naive(const bf16* __restrict__ P, bf16* __restrict__ Y) {
    const int idx = blockIdx.x * blockDim.x + threadIdx.x;
    if (idx >= MC * 6) return;
    const int h = idx / MC, mc = idx % MC, b = mc / CTX, m = MX + mc;
    float q[64], acc[64], kv[64];
    load_row64(P + (size_t)m * PLD + C_Q + h * 64, q);
#pragma unroll
    for (int d = 0; d < 64; ++d) { q[d] *= 0.125f; acc[d] = 0.f; }
    float mx = -INFINITY, lsum = 0.f;
    for (int key = 0; key < CTX; ++key) {
        const int km = MX + b * CTX + key;
        load_row64(P + (size_t)km * PLD + C_K + h * 64, kv);
        float s = 0.f;
#pragma unroll
        for (int d = 0; d < 64; ++d) s += q[d] * kv[d];
        const float mnew = fmaxf(mx, s), scale = __expf(mx - mnew), pe = __expf(s - mnew); mx = mnew;
        lsum = lsum * scale + pe;
        load_row64(P + (size_t)km * PLD + C_V + h * 64, kv);
#pragma unroll
        for (int d = 0; d < 64; ++d) acc[d] = acc[d] * scale + pe * kv[d];
    }
    const float rl = 1.f / lsum;
    const bf16* zr = P + (size_t)m * PLD + C_Z + h * 64;
#pragma unroll
    for (int d = 0; d < 64; ++d) Y[(size_t)m * 1024 + 640 + h * 64 + d] = f2bf(acc[d] * rl * silu_f(bf2f(zr[d])));
}

__global__ void __launch_bounds__(256) k_postnorm(const float* __restrict__ UX, const float* xsrc, const float* csrc, const float* __restrict__ mod_l, const float* __restrict__ g_post_l, float* xdst, float* cdst) {
    const int m = (blockIdx.x * blockDim.x + threadIdx.x) >> 6, lane = threadIdx.x & 63;
    if (m >= M) return;
    const float* src; float* dst; int r;
    if (m < MX) { src = xsrc + (size_t)m * 1024; dst = xdst + (size_t)m * 1024; r = m / S; }
    else { if (!cdst) return; src = csrc + (size_t)(m - MX) * 1024; dst = cdst + (size_t)(m - MX) * 1024; r = 8; }
    const float* ur = UX + (size_t)m * 1024;
    float4 u[4]; float ss = 0.f;
#pragma unroll
    for (int j = 0; j < 4; ++j) { u[j] = ((const float4*)ur)[lane + 64 * j]; ss += u[j].x * u[j].x + u[j].y * u[j].y + u[j].z * u[j].z + u[j].w * u[j].w; }
    ss = wave_sum(ss);
    const float rinv = 1.f / sqrtf(ss * (1.f / 1024.f) + EPS);
    const float* gt = mod_l + r * 3072 + 2048;
#pragma unroll
    for (int j = 0; j < 4; ++j) {
        const int d = 4 * (lane + 64 * j);
        const float4 g = *(const float4*)(g_post_l + d), t = *(const float4*)(gt + d), xv = *(const float4*)(src + d);
        float4 o; o.x = xv.x + t.x * (u[j].x * rinv * g.x); o.y = xv.y + t.y * (u[j].y * rinv * g.y); o.z = xv.z + t.z * (u[j].z * rinv * g.z); o.w = xv.w + t.w * (u[j].w * rinv * g.w);
        *(float4*)(dst + d) = o;
    }
}

extern "C" void kernel_launch(void* const* d_in, const int* in_sizes, int n_in, void* d_out, int out_size, void* d_ws, size_t ws_size, hipStream_t stream) {
    if (n_in != 15 || ws_size < WS_END) { fprintf(stderr, "kernel_launch: unexpected n_in %d / ws_size %zu (need %zu)\n", n_in, ws_size, (size_t)WS_END); return; }
    const float* x = (const float*)d_in[0]; const float* c = (const float*)d_in[1]; const float* ctx = (const float*)d_in[2]; const float* c_ctx = (const float*)d_in[3];
    const float* w_mod = (const float*)d_in[4]; const float* b_mod = (const float*)d_in[5]; const float* g_pre = (const float*)d_in[6]; const float* g_post = (const float*)d_in[7];
    const float* w_in = (const float*)d_in[8]; const float* w_out = (const float*)d_in[9]; const float* hgrn_lb = (const float*)d_in[10]; const float* hgrn_gn = (const float*)d_in[11];
    const float* gate_b = (const float*)d_in[12]; const float* mlstm_gn = (const float*)d_in[13]; const float* na_rpb = (const float*)d_in[14];
    float* out = (float*)d_out; unsigned char* ws = (unsigned char*)d_ws;
    bf16* wt_in = (bf16*)(ws + WS_WT_IN); bf16* wt_out = (bf16*)(ws + WS_WT_OUT); float* mod = (float*)(ws + WS_MOD); float* gates = (float*)(ws + WS_GATES);
    float* ctx1 = (float*)(ws + WS_CTX1); bf16* hxy = (bf16*)(ws + WS_HXY); bf16* P = (bf16*)(ws + WS_P); float* UX = (float*)(ws + WS_P); float* oh = (float*)(ws + WS_OH); float* om = (float*)(ws + WS_OM);

    hipLaunchKernelGGL(k_convert_w, dim3(2048), dim3(256), 0, stream, w_in, w_out, wt_in, wt_out);
    hipLaunchKernelGGL(k_mod, dim3((2 * 9 * 3072 + 255) / 256), dim3(256), 0, stream, c, c_ctx, w_mod, b_mod, mod);
    for (int l = 0; l < 2; ++l) {
        const float* xs = l == 0 ? x : out; const float* cs = l == 0 ? ctx : ctx1;
        const float* mod_l = mod + (size_t)l * 9 * 3072;
        hipLaunchKernelGGL(k_prenorm, dim3(M / 4), dim3(256), 0, stream, xs, cs, mod_l, g_pre + l * 1024, hxy);
        hipLaunchKernelGGL(k_gemm_simple<0>, dim3(NPAD / 64, M / 64), dim3(256), 0, stream, hxy, wt_in + (size_t)l * NPAD * 1024, 1024, P, gates, gate_b + l * 16, (float*)nullptr);
        hipLaunchKernelGGL(k_hgrn_naive, dim3(32), dim3(64), 0, stream, P, hgrn_lb, l, 0, oh);
        hipLaunchKernelGGL(k_hgrn_naive, dim3(32), dim3(64), 0, stream, P, hgrn_lb, l, 1, oh);
        hipLaunchKernelGGL(k_mlstm_naive, dim3(32), dim3(128), 0, stream, P, gates, 0, om);
        hipLaunchKernelGGL(k_mlstm_naive, dim3(32), dim3(128), 0, stream, P, gates, 1, om);
        hipLaunchKernelGGL(k_hgrn_combine, dim3(M), dim3(256), 0, stream, oh, P, hgrn_gn + l * 256, hxy);
        hipLaunchKernelGGL(k_mlstm_combine, dim3(M), dim3(256), 0, stream, om, P, mlstm_gn + l * 384, hxy);
        hipLaunchKernelGGL(k_na_naive, dim3(MX * 6 / 256), dim3(256), 0, stream, P, na_rpb + (size_t)l * 6 * 15 * 31, hxy);
        if (l == 0) hipLaunchKernelGGL(k_na_ctx_naive, dim3(MC * 6 / 256), dim3(256), 0, stream, P, hxy);
        hipLaunchKernelGGL(k_gemm_simple<1>, dim3(1024 / 64, M / 64), dim3(256), 0, stream, hxy, wt_out + (size_t)l * 1024 * 1024, 1024, (bf16*)nullptr, (float*)nullptr, (const float*)nullptr, UX);
        hipLaunchKernelGGL(k_postnorm, dim3(M / 4), dim3(256), 0, stream, UX, xs, cs, mod_l, g_post + l * 1024, out, l == 0 ? ctx1 : (float*)nullptr);
    }
}
```

```cpp
#include <hip/hip_runtime.h>
#include <stdint.h>
#include <cstdio>

namespace cfg {
constexpr int D = 1024, NB = 8, S = 4096, CTX = 256;
constexpr int MX = NB * S, MC = NB * CTX, M = MX + MC;
constexpr int PIN = 4752, NPAD = 4864, PLD = 4736;
constexpr int A_Q = 0, A_FF = 256, A_FB = 512, A_I = 768, A_Z = 1024, B_Q = 1280, B_K = 1664, B_V = 2048, B_O = 2432, B_Z = 2816,
              C_Q = 3200, C_K = 3584, C_V = 3968, C_Z = 4352;
constexpr float EPS = 1e-6f;
constexpr size_t WS_CTL = 0, CTL_BYTES = 65536;
constexpr size_t WS_WT_IN = WS_CTL + CTL_BYTES;
constexpr size_t WS_WT_OUT = WS_WT_IN + 2ull * NPAD * 1024 * 2;
constexpr size_t WS_MOD = WS_WT_OUT + 2ull * 1024 * 1024 * 2;
constexpr size_t WS_GATES = WS_MOD + 2ull * 9 * 3072 * 4;
constexpr size_t WS_CTX1 = WS_GATES + (size_t)M * 16 * 4;
constexpr size_t WS_HXY = WS_CTX1 + (size_t)MC * 1024 * 4;
constexpr size_t WS_P = WS_HXY + (size_t)M * 1024 * 2;
constexpr size_t WS_OH = WS_P + (size_t)M * PLD * 2;
constexpr size_t WS_OM = WS_OH + (size_t)M * 256 * 4;
constexpr size_t WS_END = WS_OM + (size_t)M * 384 * 4;
static_assert(WS_END <= 536870912ull, "workspace");
static_assert(WS_WT_IN % 256 == 0 && WS_MOD % 256 == 0 && WS_GATES % 256 == 0 && WS_CTX1 % 256 == 0 && WS_HXY % 256 == 0 && WS_P % 256 == 0 && WS_OH % 256 == 0 && WS_OM % 256 == 0, "align");
}
using namespace cfg;

namespace pg8 {
#define PG8_LAS __attribute__((address_space(3)))
typedef unsigned short bf16_t;
typedef short bf16x8 __attribute__((ext_vector_type(8)));
typedef float f32x4 __attribute__((ext_vector_type(4)));
typedef unsigned u32x4 __attribute__((ext_vector_type(4)));
constexpr int BM = 256, BK = 64, HALF = 128, HTB = HALF * BK * 2  , STAGE_BYTES = 8 * HTB, NXCD = 8, WGM = 8;

__host__ __device__ __forceinline__ int lds_byte(int r, int c) { const int st = (r >> 4) * 2 + (c >> 5), rr = r & 15, cc = c & 31, ob = rr * 64 + cc * 2; return st * 1024 + (ob ^ (((ob >> 9) & 1) << 5)); }
__host__ __device__ __forceinline__ void stage_rc(int b, int& R, int& C) { const int st = b / 1024, sb = b % 1024, swz = sb ^ (((sb >> 9) & 1) << 5); R = (st >> 1) * 16 + swz / 64; C = (st & 1) * 32 + (swz % 64) / 2; }
__host__ __device__ __forceinline__ int perm32(int rho) { const int n = rho >> 4, i = rho & 15; return 8 * (i >> 2) + 4 * n + (i & 3); }

struct Unit { int pm, pn; };
struct Gemm { const bf16_t* A; const bf16_t* Bt; int M, N, K; };

struct StaticOrder {
    int nM, nN, nwg, G, c;
    __host__ __device__ void init(int M, int N, int G_, int c_) { nM = M / BM; nN = N / BM; nwg = nM * nN; G = G_; c = c_; }
    __host__ __device__ bool next(int i, Unit& u) const {
        const long L = (long)i * G + c; if (L >= nwg) return false;
        int wgid = (int)L; { const int q = nwg / NXCD, r = nwg % NXCD, xcd = wgid % NXCD, off = wgid / NXCD; wgid = (xcd < r ? xcd * (q + 1) : r * (q + 1) + (xcd - r) * q) + off; }
        const int nig = WGM * nN, gid = wgid / nig, fm = gid * WGM, gsz = (nM - fm) < WGM ? (nM - fm) : WGM;
        u.pm = fm + ((wgid % nig) % gsz); u.pn = (wgid % nig) / gsz; return true;
    }
    __device__ __forceinline__ void a_ready(const Unit&) const {}
    __device__ __forceinline__ void done(const Unit&) const {}
};

__device__ __forceinline__ unsigned cvt_pk_bf16(float lo, float hi) { unsigned r; asm volatile("v_cvt_pk_bf16_f32 %0, %1, %2" : "=v"(r) : "v"(lo), "v"(hi)); return r; }
__device__ __forceinline__ float logsigmoid_e(float v) { return fminf(v, 0.f) - log1pf(__expf(-fabsf(v))); }

struct EpiIn {
    static constexpr bool PERM = true, AFTER_DRAIN = false;
    bf16_t* P; float* gates; const float* gate_b;
    __device__ __forceinline__ void operator()(const f32x4 (&acc)[2][2][4][2], const Unit& u, int wr, int wc, int fr, int fq) const {
        const int row0 = u.pm * BM + wr * 64 + fr, col0 = u.pn * BM + wc * 32 + 8 * fq;
#pragma unroll
        for (int bj = 0; bj < 2; ++bj) {
            const int col = col0 + bj * HALF;
            if (col < cfg::PLD) {
#pragma unroll
                for (int ai = 0; ai < 2; ++ai)
#pragma unroll
                    for (int m = 0; m < 4; ++m) { const f32x4 v0 = acc[ai][bj][m][0], v1 = acc[ai][bj][m][1];
                        u32x4 w; w.x = cvt_pk_bf16(v0[0], v0[1]); w.y = cvt_pk_bf16(v0[2], v0[3]); w.z = cvt_pk_bf16(v1[0], v1[1]); w.w = cvt_pk_bf16(v1[2], v1[3]);
                        *(u32x4*)(P + (size_t)(row0 + ai * HALF + m * 16) * cfg::PLD + col) = w; }
            } else if (col < cfg::PIN) {
                const int g0 = col - cfg::PLD;
                const f32x4 b0 = *(const f32x4*)(gate_b + g0), b1 = *(const f32x4*)(gate_b + g0 + 4);
#pragma unroll
                for (int ai = 0; ai < 2; ++ai)
#pragma unroll
                    for (int m = 0; m < 4; ++m) { f32x4 v0 = acc[ai][bj][m][0] + b0, v1 = acc[ai][bj][m][1] + b1;
                        if (g0 >= 8) {
#pragma unroll
                            for (int e = 0; e < 4; ++e) { v0[e] = logsigmoid_e(v0[e]); v1[e] = logsigmoid_e(v1[e]); } }
                        float* gp = gates + (size_t)(row0 + ai * HALF + m * 16) * 16 + g0;
                        *(f32x4*)gp = v0; *(f32x4*)(gp + 4) = v1; }
            }
        }
    }
};
struct EpiOut {
    static constexpr bool PERM = false, AFTER_DRAIN = false;
    float* C;
    __device__ __forceinline__ void operator()(const f32x4 (&acc)[2][2][4][2], const Unit& u, int wr, int wc, int fr, int fq) const {
        const int row0 = u.pm * BM + wr * 64 + fr, col0 = u.pn * BM + wc * 32 + 4 * fq;
#pragma unroll
        for (int ai = 0; ai < 2; ++ai)
#pragma unroll
            for (int m = 0; m < 4; ++m) { float* rowp = C + (size_t)(row0 + ai * HALF + m * 16) * 1024 + col0;
#pragma unroll
                for (int bj = 0; bj < 2; ++bj)
#pragma unroll
                    for (int n = 0; n < 2; ++n) *(f32x4*)(rowp + bj * HALF + n * 16) = acc[ai][bj][m][n]; }
    }
};

template <class Epi, class Sched, bool ALIGN_EPI = false, bool SP2 = false>
__device__ __forceinline__ void gemm_phase(PG8_LAS unsigned char* lds, const Gemm g, const Sched& S, const Epi& E) {
    const int tid = threadIdx.x, wid = __builtin_amdgcn_readfirstlane(tid >> 6), lane = tid & 63, wr = wid >> 2, wc = wid & 3, fr = lane & 15, fq = lane >> 4;
    const int K = g.K, nt = K / BK;
    unsigned voffA[2], voffB[2];
#pragma unroll
    for (int i = 0; i < 2; ++i) { int R, C; stage_rc(tid * 16 + i * 8192, R, C); const int Rb = Epi::PERM ? ((R & ~31) + perm32(R & 31)) : R;
        voffA[i] = (unsigned)(R * K + C) * 2u; voffB[i] = (unsigned)(Rb * K + C) * 2u; }
    const size_t kstep = (size_t)(BK * 2);
    const size_t hstep = (size_t)HALF * K * 2;
    const size_t tstep = 2 * hstep;
    const unsigned ldsw = (unsigned)wid * 1024u;
    const int aoff = lds_byte(wr * 64 + fr, fq * 8), boff = lds_byte(wc * 32 + fr, fq * 8);
#define PG8_SA(b, h) (((b) * 2 + (h)) * HTB)
#define PG8_SB(b, h) ((4 + (b) * 2 + (h)) * HTB)
#define PG8_STAGE(bufoff, gbase, voff) do { _Pragma("unroll") for (int _i = 0; _i < 2; ++_i) \
        __builtin_amdgcn_global_load_lds((const unsigned*)((const char*)(gbase) + (voff)[_i]), (PG8_LAS unsigned*)(lds + (bufoff) + ldsw + _i * 8192), 16, 0, 0); } while (0)
#define PG8_LDA(dst, b, h) do { _Pragma("unroll") for (int m = 0; m < 4; ++m) _Pragma("unroll") for (int k = 0; k < 2; ++k) dst[m][k] = *(const PG8_LAS bf16x8*)(lds + PG8_SA(b, h) + aoff + m * 2048 + k * 1024); } while (0)
#define PG8_LDB(dst, b, h) do { _Pragma("unroll") for (int n = 0; n < 2; ++n) _Pragma("unroll") for (int k = 0; k < 2; ++k) dst[n][k] = *(const PG8_LAS bf16x8*)(lds + PG8_SB(b, h) + boff + n * 2048 + k * 1024); } while (0)
#define PG8_MMA(ai, bj, At, Bt) do { __builtin_amdgcn_s_setprio(1); _Pragma("unroll") for (int m = 0; m < 4; ++m) _Pragma("unroll") for (int n = 0; n < 2; ++n) _Pragma("unroll") for (int k = 0; k < 2; ++k) \
        acc[ai][bj][m][n] = __builtin_amdgcn_mfma_f32_16x16x32_bf16(Bt[n][k], At[m][k], acc[ai][bj][m][n], 0, 0, 0); __builtin_amdgcn_s_setprio(0); } while (0)
#define PG8_WAIT_V(n) asm volatile("s_waitcnt vmcnt(" #n ")" ::: "memory")
#define PG8_WAIT_L(n) asm volatile("s_waitcnt lgkmcnt(" #n ")" ::: "memory")
#define PG8_BAR __builtin_amdgcn_s_barrier()
#define PG8_SCHED __builtin_amdgcn_sched_barrier(0)
    Unit cur, nxt; int ui = 0;
    if (!S.next(0, cur)) return;
    f32x4 acc[2][2][4][2];
#pragma unroll
    for (int a = 0; a < 2; ++a)
#pragma unroll
        for (int b = 0; b < 2; ++b)
#pragma unroll
            for (int m = 0; m < 4; ++m)
#pragma unroll
                for (int n = 0; n < 2; ++n) acc[a][b][m][n] = (f32x4){0.f, 0.f, 0.f, 0.f};
    bf16x8 At[4][2], B0[2][2], B1[2][2];
    const char* cA = (const char*)g.A + (size_t)cur.pm * tstep; const char* cB = (const char*)g.Bt + (size_t)cur.pn * tstep;
    S.a_ready(cur);
    if constexpr (SP2) {
        PG8_STAGE(PG8_SB(0, 0), cB, voffB); PG8_STAGE(PG8_SB(0, 1), cB + hstep, voffB); PG8_STAGE(PG8_SA(0, 0), cA, voffA); PG8_STAGE(PG8_SA(0, 1), cA + hstep, voffA);
        if (wr == 1) PG8_BAR;
        PG8_WAIT_V(2); PG8_BAR;
        PG8_STAGE(PG8_SB(1, 0), cB + kstep, voffB); PG8_STAGE(PG8_SA(1, 0), cA + kstep, voffA); PG8_STAGE(PG8_SB(1, 1), cB + hstep + kstep, voffB);
        PG8_WAIT_V(6); PG8_BAR;
    } else {
        PG8_STAGE(PG8_SB(0, 0), cB, voffB); PG8_STAGE(PG8_SA(0, 0), cA, voffA); PG8_STAGE(PG8_SB(0, 1), cB + hstep, voffB); PG8_STAGE(PG8_SA(0, 1), cA + hstep, voffA);
        if (wr == 1) PG8_BAR;
        PG8_WAIT_V(4); PG8_BAR;
        PG8_STAGE(PG8_SB(1, 0), cB + kstep, voffB); PG8_STAGE(PG8_SA(1, 0), cA + kstep, voffA); PG8_STAGE(PG8_SB(1, 1), cB + hstep + kstep, voffB);
        PG8_WAIT_V(6); PG8_BAR;
    }
    for (;;) {
        const bool has_next = S.next(ui + 1, nxt);
        const char* nA = has_next ? (const char*)g.A + (size_t)nxt.pm * tstep : cA; const char* nB = has_next ? (const char*)g.Bt + (size_t)nxt.pn * tstep : cB;
        for (int t = 0; t < nt; t += 2) {
            const bool last = (t == nt - 2);
            const char* a1 = cA + (size_t)(t + 1) * kstep;
            const char* a2 = last ? nA : cA + (size_t)(t + 2) * kstep; const char* b2 = last ? nB : cB + (size_t)(t + 2) * kstep;
            const char* a3 = a2 + kstep; const char* b3 = b2 + kstep;
            if (last && has_next) S.a_ready(nxt);
            if constexpr (SP2) {
            PG8_LDB(B0, 0, 0); PG8_LDB(B1, 0, 1); PG8_SCHED; PG8_LDA(At, 0, 0); PG8_STAGE(PG8_SA(1, 1), a1 + hstep, voffA);
            PG8_WAIT_V(8); PG8_WAIT_L(0); PG8_BAR; PG8_MMA(0, 0, At, B0); PG8_MMA(0, 1, At, B1); PG8_BAR; PG8_SCHED;
            PG8_LDA(At, 0, 1); PG8_STAGE(PG8_SB(0, 0), b2, voffB); PG8_STAGE(PG8_SB(0, 1), b2 + hstep, voffB); PG8_STAGE(PG8_SA(0, 0), a2, voffA);
            PG8_WAIT_V(8); PG8_WAIT_L(0); PG8_BAR; PG8_MMA(1, 0, At, B0); PG8_MMA(1, 1, At, B1); PG8_BAR; PG8_SCHED;
            PG8_LDB(B0, 1, 0); PG8_LDB(B1, 1, 1); PG8_SCHED; PG8_LDA(At, 1, 0); PG8_STAGE(PG8_SA(0, 1), a2 + hstep, voffA);
            PG8_WAIT_V(8); PG8_WAIT_L(0); PG8_BAR; PG8_MMA(0, 0, At, B0); PG8_MMA(0, 1, At, B1); PG8_BAR; PG8_SCHED;
            PG8_LDA(At, 1, 1); PG8_STAGE(PG8_SB(1, 0), b3, voffB); PG8_STAGE(PG8_SB(1, 1), b3 + hstep, voffB); PG8_STAGE(PG8_SA(1, 0), a3, voffA);
            PG8_WAIT_V(8); PG8_WAIT_L(0); PG8_BAR; PG8_MMA(1, 0, At, B0); PG8_MMA(1, 1, At, B1); PG8_BAR; PG8_SCHED;
            } else {
            PG8_LDB(B0, 0, 0); PG8_SCHED; PG8_LDA(At, 0, 0); PG8_STAGE(PG8_SA(1, 1), a1 + hstep, voffA);
            PG8_WAIT_L(8); PG8_BAR; PG8_WAIT_L(0); PG8_MMA(0, 0, At, B0); PG8_BAR; PG8_SCHED;
            PG8_LDB(B1, 0, 1); PG8_STAGE(PG8_SB(0, 0), b2, voffB);
            PG8_BAR; PG8_WAIT_L(0); PG8_MMA(0, 1, At, B1); PG8_BAR;
            PG8_LDA(At, 0, 1); PG8_STAGE(PG8_SA(0, 0), a2, voffA);
            PG8_BAR; PG8_WAIT_L(0); PG8_MMA(1, 0, At, B0); PG8_BAR; PG8_SCHED;
            PG8_STAGE(PG8_SB(0, 1), b2 + hstep, voffB);
            PG8_WAIT_V(6); PG8_BAR; PG8_MMA(1, 1, At, B1); PG8_BAR;
            PG8_LDB(B0, 1, 0); PG8_SCHED; PG8_LDA(At, 1, 0); PG8_STAGE(PG8_SA(0, 1), a2 + hstep, voffA);
            PG8_WAIT_L(8); PG8_BAR; PG8_WAIT_L(0); PG8_MMA(0, 0, At, B0); PG8_BAR; PG8_SCHED;
            PG8_LDB(B1, 1, 1); PG8_STAGE(PG8_SB(1, 0), b3, voffB);
            PG8_BAR; PG8_WAIT_L(0); PG8_MMA(0, 1, At, B1); PG8_BAR;
            PG8_LDA(At, 1, 1); PG8_STAGE(PG8_SA(1, 0), a3, voffA);
            PG8_BAR; PG8_WAIT_L(0); PG8_MMA(1, 0, At, B0); PG8_BAR; PG8_SCHED;
            PG8_STAGE(PG8_SB(1, 1), b3 + hstep, voffB);
            PG8_WAIT_V(6); PG8_BAR; PG8_MMA(1, 1, At, B1); PG8_BAR;
            }
        }
        if constexpr (ALIGN_EPI) { if (wr == 0) PG8_BAR; }
        if constexpr (!Epi::AFTER_DRAIN) { E(acc, cur, wr, wc, fr, fq); S.done(cur); }
        if (!has_next) break;
#pragma unroll
        for (int a = 0; a < 2; ++a)
#pragma unroll
            for (int b = 0; b < 2; ++b)
#pragma unroll
                for (int m = 0; m < 4; ++m)
#pragma unroll
                    for (int n = 0; n < 2; ++n) acc[a][b][m][n] = (f32x4){0.f, 0.f, 0.f, 0.f};
        cur = nxt; cA = nA; cB = nB; ++ui;
        if constexpr (ALIGN_EPI) { if (wr == 1) PG8_BAR; }
    }
    PG8_WAIT_V(0);
    if constexpr (!ALIGN_EPI) { if (wr == 0) PG8_BAR; }
    PG8_BAR;
    if constexpr (Epi::AFTER_DRAIN) { E.fused(acc, cur, wr, wc, fr, fq, lds, wid, lane); S.done(cur); }
#undef PG8_SA
#undef PG8_SB
#undef PG8_STAGE
#undef PG8_LDA
#undef PG8_LDB
#undef PG8_MMA
#undef PG8_WAIT_V
#undef PG8_WAIT_L
#undef PG8_BAR
#undef PG8_SCHED
}
}
constexpr int RING_OFF = 0, RING_BYTES = 131072;
constexpr int LDSCTL_OFF = RING_BYTES, MISC_OFF = LDSCTL_OFF + 320;
constexpr int LDS_BYTES = 147456;
constexpr int CW_BAR = 4096;

#define GAS __attribute__((address_space(1)))
#define LAS __attribute__((address_space(3)))
typedef unsigned short bf16;
typedef unsigned v4u __attribute__((ext_vector_type(4)));
typedef float f32x4 __attribute__((ext_vector_type(4)));
typedef short bf16x8 __attribute__((ext_vector_type(8)));
typedef GAS unsigned gu32;
#define RLX_AGENT __ATOMIC_RELAXED, __HIP_MEMORY_SCOPE_AGENT
#define LDS_WAIT() asm volatile("s_waitcnt lgkmcnt(0)" ::: "memory")
#define VM_WAIT() asm volatile("s_waitcnt vmcnt(0)" ::: "memory")
__device__ __forceinline__ unsigned f2bfu(float f) { unsigned u = __builtin_bit_cast(unsigned, f); return (u + 0x7fffu + ((u >> 16) & 1u)) >> 16; }
__device__ __forceinline__ bf16 f2bf(float f) { return (bf16)f2bfu(f); }
__device__ __forceinline__ unsigned pk2(float lo, float hi) { return f2bfu(lo) | (f2bfu(hi) << 16); }
__device__ __forceinline__ float bf2f(bf16 v) { return __uint_as_float(((unsigned)v) << 16); }
__device__ __forceinline__ float silu_f(float v) { return v / (1.f + __expf(-v)); }
__device__ __forceinline__ float sigmoid_f(float v) { return 1.f / (1.f + __expf(-v)); }
__device__ __forceinline__ float wave_sum(float v) {
#pragma unroll
    for (int o = 1; o < 64; o <<= 1) v += __shfl_xor(v, o);
    return v;
}
__device__ __forceinline__ float rdlane(float v, int i) { return __int_as_float(__builtin_amdgcn_readlane(__float_as_int(v), i)); }

#define XB_TMO      128
#define XB_XCNT(j)  (256  + 64 * (j))
#define XB_XSUB(j)  (1280 + 64 * (j))
#define XB_XGEN(j)  (2304 + 64 * (j))
#define XB_TOP      3328
#define XB_TOPGEN   3392
#define XCD_BAR_WORDS 3456
#define XB_SPIN_CAP (1u << 18)

__device__ __forceinline__ unsigned xb_ld(unsigned* p)              { return __hip_atomic_load(p, __ATOMIC_RELAXED, __HIP_MEMORY_SCOPE_AGENT); }
__device__ __forceinline__ unsigned xb_add(unsigned* p, unsigned v) { return __hip_atomic_fetch_add(p, v, __ATOMIC_RELAXED, __HIP_MEMORY_SCOPE_AGENT); }
__device__ __forceinline__ unsigned xb_xcc_id() { return (unsigned)__builtin_amdgcn_s_getreg((3 << 11) | 20) & 0xFu; }
#define XB_SPIN(cond, bar) do { unsigned _sp = 0; while (cond) { __builtin_amdgcn_s_sleep(1); \
    if ((++_sp & 255u) == 0u) { if (xb_ld(&(bar)[XB_TMO])) break; if (_sp > XB_SPIN_CAP) { atomicAdd(&(bar)[XB_TMO], 1u); break; } } } } while (0)

struct XcdBarrier {
    unsigned* bar; unsigned x;
    volatile LAS unsigned* st;
};

__device__ __forceinline__ XcdBarrier xcd_barrier_post(unsigned* bar, volatile LAS unsigned* st) {
    XcdBarrier b; b.bar = bar; b.x = xb_xcc_id(); b.st = st;
    if (threadIdx.x == 0) (void)xb_add(&bar[XB_XCNT(b.x)], 1u);
    return b;
}
__device__ __forceinline__ void xcd_barrier_complete(unsigned* bar, unsigned x, unsigned& nloc, unsigned& nx) {
    const unsigned G = gridDim.x * gridDim.y * gridDim.z;
    unsigned sum, cnt, mine, sp = 0u;
    for (;;) {
        sum = 0u; cnt = 0u; mine = 0u;
#pragma unroll
        for (unsigned j = 0; j < 16; ++j) { const unsigned c = xb_ld(&bar[XB_XCNT(j)]); sum += c; cnt += (c > 0u) ? 1u : 0u; mine = (j == x) ? c : mine; }
        if (sum == G) break;
        __builtin_amdgcn_s_sleep(1);
        if ((++sp & 255u) == 0u) { if (xb_ld(&bar[XB_TMO])) break; if (sp > XB_SPIN_CAP) { atomicAdd(&bar[XB_TMO], 1u); break; } }
    }
    nloc = mine > 0u ? mine : 1u; nx = cnt > 0u ? cnt : 1u;
}

__device__ __forceinline__ void xcd_barrier(const XcdBarrier& b) {
    asm volatile("s_waitcnt vmcnt(0)" ::: "memory");
    __syncthreads();
    if (threadIdx.x == 0) {
        unsigned* bar = b.bar;
        __builtin_amdgcn_s_waitcnt(0);
        unsigned nloc = b.st[0], nx = b.st[1];
        if (nloc == 0u) { xcd_barrier_complete(bar, b.x, nloc, nx); b.st[0] = nloc; b.st[1] = nx; }
        const unsigned old = xb_add(&bar[XB_XSUB(b.x)], 1u);
        const unsigned gen = old / nloc;
        if (old + 1u == (gen + 1u) * nloc) {
            __builtin_amdgcn_fence(__ATOMIC_RELEASE, "agent");
            asm volatile("s_waitcnt vmcnt(0)" ::: "memory");
            const unsigned og = xb_add(&bar[XB_TOP], 1u);
            const unsigned tg = og / nx;
            if (og + 1u == (tg + 1u) * nx) xb_add(&bar[XB_TOPGEN], 1u);
            else XB_SPIN(xb_ld(&bar[XB_TOPGEN]) == tg, bar);
            __builtin_amdgcn_fence(__ATOMIC_ACQUIRE, "agent");
            xb_add(&bar[XB_XGEN(b.x)], 1u);
            asm volatile("s_waitcnt vmcnt(0)" ::: "memory");
        } else {
            XB_SPIN(xb_ld(&bar[XB_XGEN(b.x)]) == gen, bar);
            __builtin_amdgcn_fence(__ATOMIC_ACQUIRE, "agent");
            asm volatile("s_waitcnt vmcnt(0)" ::: "memory");
        }
    }
    __syncthreads();
}

struct Ctx {
    LAS unsigned char* lds; int tid, lane, wave, vcu, G, gw, NGW;
    const float *x, *c, *ctx, *c_ctx, *w_mod, *b_mod, *g_pre, *g_post, *w_in, *w_out, *hgrn_lb, *hgrn_gn, *gate_b, *mlstm_gn, *na_rpb;
    float* out; bf16 *wt_in, *wt_out, *hxy, *P; float *mod, *gates, *ctx1, *UX, *oh, *om;
};

__device__ __forceinline__ void transpose_item(const float* W, int N, int Nnew, bool remap, bf16* WT, LAS float* scr, int item, int lane) {
    const int nblk = Nnew / 32, kb = item / nblk, nb = item % nblk, k0 = 64 * kb, n0 = 32 * nb;
    const int nn = n0 + (lane & 31);
    int no = nn; if (remap) no = nn < 3200 ? nn : (nn < 4736 ? nn + 16 : (nn < 4752 ? 3200 + nn - 4736 : -1));
#pragma unroll 8
    for (int i = 0; i < 32; ++i) { const int kk = 2 * i + (lane >> 5); scr[kk * 33 + (lane & 31)] = no >= 0 ? W[(size_t)(k0 + kk) * N + no] : 0.f; }
    LDS_WAIT(); asm volatile("" ::: "memory");
    const int c = lane & 7;
#pragma unroll
    for (int j = 0; j < 4; ++j) { const int n = (lane >> 3) + 8 * j; const LAS float* s = scr + (8 * c) * 33 + n;
        v4u o; o.x = pk2(s[0 * 33], s[1 * 33]); o.y = pk2(s[2 * 33], s[3 * 33]); o.z = pk2(s[4 * 33], s[5 * 33]); o.w = pk2(s[6 * 33], s[7 * 33]);
        *(GAS v4u*)(WT + (size_t)(n0 + n) * 1024 + k0 + 8 * c) = o; }
    LDS_WAIT(); asm volatile("" ::: "memory");
}
__device__ __forceinline__ void phase_p0(const Ctx& F) {
    if (F.vcu < 96) {
        LAS float* tab = (LAS float*)(F.lds);
        LAS float* part = (LAS float*)(F.lds + 36864);
        for (int i = F.tid; i < 9 * 1024; i += 512) { const int r = i >> 10, k = i & 1023; const float v = r < 8 ? F.c[r * 1024 + k] : F.c_ctx[k]; tab[i] = silu_f(v); }
        __syncthreads();
        for (int it = F.vcu; it < 96; it += F.G) {
            const int l = it / 48, jb = it % 48, col = jb * 64 + F.lane;
            float acc[9];
#pragma unroll
            for (int r = 0; r < 9; ++r) acc[r] = 0.f;
            const float* wp = F.w_mod + ((size_t)l * 1024 + F.wave * 128) * 3072 + col;
#pragma unroll 4
            for (int k = 0; k < 128; ++k) { const float wv = wp[(size_t)k * 3072];
#pragma unroll
                for (int r = 0; r < 9; ++r) acc[r] += tab[r * 1024 + F.wave * 128 + k] * wv; }
#pragma unroll
            for (int r = 0; r < 9; ++r) part[(F.wave * 9 + r) * 64 + F.lane] = acc[r];
            __syncthreads();
            for (int i = F.tid; i < 9 * 64; i += 512) { const int r = i >> 6, j = i & 63; float s = 0.f;
#pragma unroll
                for (int w = 0; w < 8; ++w) s += part[(w * 9 + r) * 64 + j];
                F.mod[((size_t)l * 9 + r) * 3072 + jb * 64 + j] = s + F.b_mod[l * 3072 + jb * 64 + j]; }
            __syncthreads();
        }
    }
    __syncthreads();
    LAS float* scr = (LAS float*)(F.lds + F.wave * 16384);
    constexpr int I_IN = 16 * (NPAD / 32), I_OUT = 16 * 32;
    for (int it = F.gw; it < 2 * I_IN + 2 * I_OUT; it += F.NGW) {
        int r = it;
        if (r < 2 * I_IN) { const int l = r / I_IN; transpose_item(F.w_in + (size_t)l * 1024 * PIN, PIN, NPAD, true, F.wt_in + (size_t)l * NPAD * 1024, scr, r % I_IN, F.lane); continue; }
        r -= 2 * I_IN; { const int l = r / I_OUT; transpose_item(F.w_out + (size_t)l * 1024 * 1024, 1024, 1024, false, F.wt_out + (size_t)l * 1024 * 1024, scr, r % I_OUT, F.lane); }
    }
}

__device__ __forceinline__ void prenorm_row(const float4 (&v)[4], float ss, const float* mod_r, const float* g_pre_l, bf16* dst, int lane) {
    const float rinv = 1.f / sqrtf(ss * (1.f / 1024.f) + EPS);
    const float* sh = mod_r; const float* sc = mod_r + 1024;
#pragma unroll
    for (int j = 0; j < 4; ++j) {
        const int d = 4 * (lane + 64 * j);
        const float4 g = *(const float4*)(g_pre_l + d), s1 = *(const float4*)(sc + d), s0 = *(const float4*)(sh + d);
        const float o0 = v[j].x * rinv * g.x * (1.f + s1.x) + s0.x, o1 = v[j].y * rinv * g.y * (1.f + s1.y) + s0.y;
        const float o2 = v[j].z * rinv * g.z * (1.f + s1.z) + s0.z, o3 = v[j].w * rinv * g.w * (1.f + s1.w) + s0.w;
        uint2 w; w.x = pk2(o0, o1); w.y = pk2(o2, o3);
        *(uint2*)(dst + d) = w;
    }
}
__device__ __forceinline__ void phase_prenorm0(const Ctx& F) {
    for (int m = F.gw; m < M; m += F.NGW) {
        const float* src; int r;
        if (m < MX) { src = F.x + (size_t)m * 1024; r = m / S; } else { src = F.ctx + (size_t)(m - MX) * 1024; r = 8; }
        float4 v[4]; float ss = 0.f;
#pragma unroll
        for (int j = 0; j < 4; ++j) { v[j] = ((const float4*)src)[F.lane + 64 * j]; ss += v[j].x * v[j].x + v[j].y * v[j].y + v[j].z * v[j].z + v[j].w * v[j].w; }
        ss = wave_sum(ss);
        prenorm_row(v, ss, F.mod + (size_t)r * 3072, F.g_pre, F.hxy + (size_t)m * 1024, F.lane);
    }
}
__device__ __forceinline__ void phase_post(const Ctx& F, int l) {
    const int Ml = l == 0 ? M : MX;
    const float* mod_l = F.mod + (size_t)l * 9 * 3072; const float* g_post_l = F.g_post + l * 1024;
    for (int m = F.gw; m < Ml; m += F.NGW) {
        const float* src; float* dst; int r;
        if (m < MX) { src = (l == 0 ? F.x : F.out) + (size_t)m * 1024; dst = F.out + (size_t)m * 1024; r = m / S; }
        else { src = F.ctx + (size_t)(m - MX) * 1024; dst = F.ctx1 + (size_t)(m - MX) * 1024; r = 8; }
        const float* ur = F.UX + (size_t)m * 1024;
        float4 u[4]; float ss = 0.f;
#pragma unroll
        for (int j = 0; j < 4; ++j) { u[j] = ((const float4*)ur)[F.lane + 64 * j]; ss += u[j].x * u[j].x + u[j].y * u[j].y + u[j].z * u[j].z + u[j].w * u[j].w; }
        ss = wave_sum(ss);
        const float rinv = 1.f / sqrtf(ss * (1.f / 1024.f) + EPS);
        const float* gt = mod_l + r * 3072 + 2048;
        float ss2 = 0.f;
#pragma unroll
        for (int j = 0; j < 4; ++j) {
            const int d = 4 * (F.lane + 64 * j);
            const float4 g = *(const float4*)(g_post_l + d), t = *(const float4*)(gt + d), xv = *(const float4*)(src + d);
            float4 o; o.x = xv.x + t.x * (u[j].x * rinv * g.x); o.y = xv.y + t.y * (u[j].y * rinv * g.y); o.z = xv.z + t.z * (u[j].z * rinv * g.z); o.w = xv.w + t.w * (u[j].w * rinv * g.w);
            *(float4*)(dst + d) = o; u[j] = o; ss2 += o.x * o.x + o.y * o.y + o.z * o.z + o.w * o.w;
        }
        if (l == 0) { ss2 = wave_sum(ss2); prenorm_row(u, ss2, F.mod + (size_t)(9 + r) * 3072, F.g_pre + 1024, F.hxy + (size_t)m * 1024, F.lane); }
    }
}

__device__ __forceinline__ int seq_row(int b, int step, int dir) {
    if (step < CTX) { const int n = dir ? CTX - 1 - step : step; return MX + b * CTX + n; }
    int t = step - CTX; if (dir) t = S - 1 - t; return b * S + t;
}
__device__ __forceinline__ void hgrn_naive_item(const Ctx& F, int l, int b, int h) {
    const int j = F.lane; const bf16* P = F.P;
    for (int dir = 0; dir < 2; ++dir) {
        float St[64];
#pragma unroll
        for (int i = 0; i < 64; ++i) St[i] = 0.f;
        float lbv = 0.f;
        if (l == 1) { const float v0 = F.hgrn_lb[(0 * 2 + dir) * 256 + h * 64 + j], v1 = F.hgrn_lb[(1 * 2 + dir) * 256 + h * 64 + j]; lbv = 1.f / (1.f + expf(v0 - v1)); }
        const int fcol = (dir ? A_FB : A_FF) + h * 64 + j;
        int m = seq_row(b, 0, dir);
        bf16 rq = P[(size_t)m * PLD + A_Q + h * 64 + j], rf = P[(size_t)m * PLD + fcol], rv = P[(size_t)m * PLD + A_I + h * 64 + j];
        for (int step = 0; step < CTX + S; ++step) {
            const int mcur = m; const float qa = bf2f(rq), fl = bf2f(rf), v = bf2f(rv);
            if (step + 1 < CTX + S) { m = seq_row(b, step + 1, dir); rq = P[(size_t)m * PLD + A_Q + h * 64 + j]; rf = P[(size_t)m * PLD + fcol]; rv = P[(size_t)m * PLD + A_I + h * 64 + j]; }
            const float q = silu_f(qa) * 0.125f, sg = sigmoid_f(fl), f = lbv + (1.f - lbv) * sg, kk = (1.f - lbv) * (1.f - sg);
            float o = 0.f;
#pragma unroll
            for (int i = 0; i < 64; ++i) { St[i] = rdlane(f, i) * St[i] + rdlane(kk, i) * v; o += rdlane(q, i) * St[i]; }
            float* dst = F.oh + (size_t)mcur * 256 + h * 64 + j;
            if (dir == 0) *dst = o; else *dst += o;
        }
    }
}
__device__ __forceinline__ void rope_consts(int i, int& part, int& lo, int& partner, float& inv) {
    part = i >= 48 ? 1 : 0; const int ii = i - 48 * part; lo = ii < 24 ? 1 : 0; const int fidx = lo ? ii : ii - 24; partner = lo ? i + 24 : i - 24;
    inv = expf(-(float)(2 * fidx) * (1.f / 48.f) * 9.210340371976184f);
}
__device__ __forceinline__ void load_qk_rope(const bf16* pr, int h, int i, int m, int part, int lo, int partner, float inv, float& q, float& k) {
    q = bf2f(pr[B_Q + h * 96 + i]); k = bf2f(pr[B_K + h * 96 + i]);
    if (m < MX) {
        const int t = m % S; const float pos = (float)(part ? (t % 64) : (t / 64)); const float ang = pos * inv; const float cs = cosf(ang), sn = sinf(ang);
        const float q2 = bf2f(pr[B_Q + h * 96 + partner]), k2 = bf2f(pr[B_K + h * 96 + partner]);
        if (lo) { q = q * cs - q2 * sn; k = k * cs - k2 * sn; } else { q = q * cs + q2 * sn; k = k * cs + k2 * sn; }
    }
    q *= 0.10206207261596575f;
}
__device__ __forceinline__ void mlstm_naive_item(const Ctx& F, int b, int h, int half) {
    const int lane = F.lane; const bool active = lane < (half ? 32 : 64); const int col = half * 64 + lane;
    int partA, loA, pnA, partB, loB, pnB; float invA, invB;
    rope_consts(lane, partA, loA, pnA, invA); rope_consts(lane < 32 ? 64 + lane : 64, partB, loB, pnB, invB);
    for (int dir = 0; dir < 2; ++dir) {
        float Cc[96];
#pragma unroll
        for (int i = 0; i < 96; ++i) Cc[i] = 0.f;
        float na = 0.f, nb = 0.f, mm = 0.f;
        for (int step = 0; step < CTX + S; ++step) {
            const int m = seq_row(b, step, dir);
            const bf16* pr = F.P + (size_t)m * PLD;
            float qa, ka, qb = 0.f, kb = 0.f;
            load_qk_rope(pr, h, lane, m, partA, loA, pnA, invA, qa, ka);
            if (lane < 32) load_qk_rope(pr, h, 64 + lane, m, partB, loB, pnB, invB, qb, kb);
            const float v = active ? bf2f(pr[B_V + h * 96 + col]) : 0.f;
            const float ig = F.gates[(size_t)m * 16 + dir * 4 + h], lf = F.gates[(size_t)m * 16 + 8 + dir * 4 + h];
            const float mnew = fmaxf(lf + mm, ig), a = expf(lf + mm - mnew), e = expf(ig - mnew); mm = mnew;
            const float ev = e * v; float num = 0.f;
#pragma unroll
            for (int i = 0; i < 64; ++i) { Cc[i] = a * Cc[i] + ev * rdlane(ka, i); num += rdlane(qa, i) * Cc[i]; }
#pragma unroll
            for (int i = 0; i < 32; ++i) { Cc[64 + i] = a * Cc[64 + i] + ev * rdlane(kb, i); num += rdlane(qb, i) * Cc[64 + i]; }
            na = a * na + e * ka; nb = a * nb + e * kb;
            const float den = wave_sum(qa * na + qb * nb);
            const float hh = num / fmaxf(fabsf(den), expf(-mnew));
            if (active) { float* dst = F.om + (size_t)m * 384 + h * 96 + col; if (dir == 0) *dst = hh; else *dst += hh; }
        }
    }
}
__device__ __forceinline__ void load_row64(const bf16* p, float* dst) {
#pragma unroll
    for (int c = 0; c < 8; ++c) { const uint4 w = *(const uint4*)(p + 8 * c); const unsigned u[4] = {w.x, w.y, w.z, w.w};
#pragma unroll
        for (int e = 0; e < 4; ++e) { dst[8 * c + 2 * e] = __uint_as_float(u[e] << 16); dst[8 * c + 2 * e + 1] = __uint_as_float(u[e] & 0xffff0000u); } }
}
__device__ __forceinline__ void na_naive_item(const Ctx& F, int l, int idx) {
    const bf16* P = F.P;
    int h, m, b, nk, r = 0, c = 0, rs = 0, cs = 0; const bool lat = idx < MX * 6;
    if (lat) { h = idx / MX; m = idx % MX; b = m / S; const int t = m % S; r = t / 64; c = t % 64; rs = min(max(r - 4, 0), 56); cs = min(max(c - 8, 0), 48); nk = 128 + CTX; }
    else { const int i2 = idx - MX * 6; h = i2 / MC; const int mc = i2 % MC; b = mc / CTX; m = MX + mc; nk = CTX; }
    const float* rpb_l = F.na_rpb + (size_t)l * 6 * 15 * 31;
    float q[64], acc[64], kv[64];
    load_row64(P + (size_t)m * PLD + C_Q + h * 64, q);
#pragma unroll
    for (int d = 0; d < 64; ++d) { q[d] *= 0.125f; acc[d] = 0.f; }
    float mx = -INFINITY, lsum = 0.f;
    for (int key = 0; key < nk; ++key) {
        int km; float bias = 0.f;
        if (lat && key < 128) { const int jr = key >> 4, kc = cs + (key & 15); km = b * S + (rs + jr) * 64 + kc; bias = rpb_l[(h * 15 + (rs + jr - r + 7)) * 31 + (kc - c + 15)]; }
        else km = MX + b * CTX + (lat ? key - 128 : key);
        load_row64(P + (size_t)km * PLD + C_K + h * 64, kv);
        float s = 0.f;
#pragma unroll
        for (int d = 0; d < 64; ++d) s += q[d] * kv[d];
        s += bias;
        const float mnew = fmaxf(mx, s), scale = __expf(mx - mnew), pe = __expf(s - mnew); mx = mnew;
        lsum = lsum * scale + pe;
        load_row64(P + (size_t)km * PLD + C_V + h * 64, kv);
#pragma unroll
        for (int d = 0; d < 64; ++d) acc[d] = acc[d] * scale + pe * kv[d];
    }
    const float rl = 1.f / lsum;
    const bf16* zr = P + (size_t)m * PLD + C_Z + h * 64;
#pragma unroll
    for (int d = 0; d < 64; ++d) F.hxy[(size_t)m * 1024 + 640 + h * 64 + d] = f2bf(acc[d] * rl * silu_f(bf2f(zr[d])));
}
__device__ __forceinline__ void phase_mix_naive(const Ctx& F, int l) {
    if (F.gw < 32) hgrn_naive_item(F, l, F.gw >> 2, F.gw & 3);
    else if (F.gw < 96) { const int it = F.gw - 32; mlstm_naive_item(F, it >> 3, (it >> 1) & 3, it & 1); }
    const int nitems = MX * 6 + (l == 0 ? MC * 6 : 0);
    for (int idx = (F.G * 512 - 1) - (F.vcu * 512 + F.tid); idx < nitems; idx += F.G * 512) na_naive_item(F, l, idx);
}
__device__ __forceinline__ void phase_combine_naive(const Ctx& F, int l) {
    const int Ml = l == 0 ? M : MX; const int lane = F.lane;
    const float* gnh = F.hgrn_gn + l * 256; const float* gnm = F.mlstm_gn + l * 384;
    for (int m = F.gw; m < Ml; m += F.NGW) {
        const bf16* pr = F.P + (size_t)m * PLD; bf16* yr = F.hxy + (size_t)m * 1024;
#pragma unroll
        for (int h = 0; h < 4; ++h) {
            const int c = h * 64 + lane; const float o = F.oh[(size_t)m * 256 + c];
            const float r = 1.f / sqrtf(wave_sum(o * o) * (1.f / 64.f) + EPS);
            yr[c] = f2bf(o * r * gnh[c] * silu_f(bf2f(pr[A_Z + c])));
        }
#pragma unroll
        for (int h = 0; h < 4; ++h) {
            const float e0 = F.om[(size_t)m * 384 + h * 96 + lane], e1 = lane < 32 ? F.om[(size_t)m * 384 + h * 96 + 64 + lane] : 0.f;
            const float r = 1.f / sqrtf(wave_sum(e0 * e0 + e1 * e1) * (1.f / 96.f) + EPS);
            { const int c = h * 96 + lane; yr[256 + c] = f2bf(sigmoid_f(bf2f(pr[B_O + c])) * (e0 * r * gnm[c]) * silu_f(bf2f(pr[B_Z + c]))); }
            if (lane < 32) { const int c = h * 96 + 64 + lane; yr[256 + c] = f2bf(sigmoid_f(bf2f(pr[B_O + c])) * (e1 * r * gnm[c]) * silu_f(bf2f(pr[B_Z + c]))); }
        }
    }
}

constexpr int NPH = 12;
struct Args { const float* in[15]; float* out; unsigned char* ws; int ph_lo, ph_hi; };
__global__ void __launch_bounds__(512, 2) mega_fwd(Args args) {
    extern __shared__ __attribute__((aligned(16))) unsigned char lds[];
    Ctx F;
    F.lds = (LAS unsigned char*)lds;
    F.tid = threadIdx.x; F.lane = F.tid & 63; F.wave = __builtin_amdgcn_readfirstlane(F.tid >> 6);
    F.G = gridDim.x; { const int bx = blockIdx.x; F.vcu = (F.G % 8 == 0) ? (bx % 8) * (F.G / 8) + bx / 8 : bx; }
    F.gw = F.vcu * 8 + F.wave; F.NGW = F.G * 8;
    unsigned char* ws = args.ws;
    F.x = args.in[0]; F.c = args.in[1]; F.ctx = args.in[2]; F.c_ctx = args.in[3]; F.w_mod = args.in[4]; F.b_mod = args.in[5]; F.g_pre = args.in[6]; F.g_post = args.in[7];
    F.w_in = args.in[8]; F.w_out = args.in[9]; F.hgrn_lb = args.in[10]; F.hgrn_gn = args.in[11]; F.gate_b = args.in[12]; F.mlstm_gn = args.in[13]; F.na_rpb = args.in[14];
    F.out = args.out;
    F.wt_in = (bf16*)(ws + WS_WT_IN); F.wt_out = (bf16*)(ws + WS_WT_OUT); F.mod = (float*)(ws + WS_MOD); F.gates = (float*)(ws + WS_GATES); F.ctx1 = (float*)(ws + WS_CTX1);
    F.hxy = (bf16*)(ws + WS_HXY); F.P = (bf16*)(ws + WS_P); F.UX = (float*)(ws + WS_P); F.oh = (float*)(ws + WS_OH); F.om = (float*)(ws + WS_OM);
    for (int u = F.tid; u < (LDS_BYTES - LDSCTL_OFF) / 4; u += 512) ((LAS unsigned*)(F.lds + LDSCTL_OFF))[u] = 0u;
    __syncthreads();
    XcdBarrier bar = xcd_barrier_post((unsigned*)(ws + WS_CTL) + CW_BAR, (volatile LAS unsigned*)(F.lds + MISC_OFF) + 8);

    const int lo = args.ph_lo, hi = args.ph_hi;
#define IN(k) (lo <= (k) && (k) < hi)
#define SEAM(k) do { if ((k) + 1 < hi) xcd_barrier(bar); } while (0)
    if (IN(0)) { phase_p0(F); SEAM(0); }
    if (IN(1)) { phase_prenorm0(F); SEAM(1); }
#define LAYER(l) \
    if (IN(2 + 5 * (l))) { \
        pg8::Gemm g{F.hxy, F.wt_in + (size_t)(l) * NPAD * 1024, M, NPAD, 1024}; pg8::StaticOrder SO; SO.init(M, NPAD, F.G, (int)blockIdx.x); \
        pg8::EpiIn E{F.P, F.gates, F.gate_b + (l) * 16}; \
        pg8::gemm_phase<pg8::EpiIn, pg8::StaticOrder, true, true>(F.lds + RING_OFF, g, SO, E); SEAM(2 + 5 * (l)); } \
    if (IN(3 + 5 * (l))) { phase_mix_naive(F, (l)); SEAM(3 + 5 * (l)); } \
    if (IN(4 + 5 * (l))) { phase_combine_naive(F, (l)); SEAM(4 + 5 * (l)); } \
    if (IN(5 + 5 * (l))) { \
        constexpr int Ml = (l) == 0 ? M : MX; \
        pg8::Gemm g{F.hxy, F.wt_out + (size_t)(l) * 1024 * 1024, Ml, 1024, 1024}; pg8::StaticOrder SO; SO.init(Ml, 1024, F.G, (int)blockIdx.x); \
        pg8::EpiOut E{F.UX}; \
        pg8::gemm_phase<pg8::EpiOut, pg8::StaticOrder, true, true>(F.lds + RING_OFF, g, SO, E); SEAM(5 + 5 * (l)); } \
    if (IN(6 + 5 * (l))) { phase_post(F, (l)); SEAM(6 + 5 * (l)); }
    LAYER(0)
    LAYER(1)
#undef LAYER
#undef IN
#undef SEAM
}

extern "C" void kernel_launch(void* const* d_in, const int* in_sizes, int n_in, void* d_out, int out_size, void* d_ws, size_t ws_size, hipStream_t stream) {
    static int grid = 0;
    if (grid == 0) {
        if (n_in != 15 || ws_size < WS_END) { fprintf(stderr, "kernel_launch: unexpected n_in %d / ws_size %zu (need %zu); nothing launched\n", n_in, ws_size, (size_t)WS_END); grid = -1; return; }
        int dev = 0, cus = 0, per_cu = 0;
        if (hipGetDevice(&dev) != hipSuccess || hipDeviceGetAttribute(&cus, hipDeviceAttributeMultiprocessorCount, dev) != hipSuccess) { grid = -1; return; }
        if (hipFuncSetAttribute((const void*)mega_fwd, hipFuncAttributeMaxDynamicSharedMemorySize, LDS_BYTES) != hipSuccess) { fprintf(stderr, "kernel_launch: hipFuncSetAttribute failed\n"); grid = -1; return; }
        if (hipOccupancyMaxActiveBlocksPerMultiprocessor(&per_cu, (const void*)mega_fwd, 512, LDS_BYTES) != hipSuccess || per_cu < 1) { fprintf(stderr, "kernel_launch: occupancy query says %d blocks/CU\n", per_cu); (void)hipGetLastError(); grid = -1; return; }
        grid = cus;
    }
    if (grid < 0) return;
    (void)hipMemsetAsync((char*)d_ws + WS_CTL, 0, CTL_BYTES, stream);
    Args a{};
    for (int i = 0; i < 15; ++i) a.in[i] = (const float*)d_in[i];
    a.out = (float*)d_out; a.ws = (unsigned char*)d_ws; a.ph_lo = 0; a.ph_hi = NPH;
    hipLaunchKernelGGL(mega_fwd, dim3(grid), dim3(512), LDS_BYTES, stream, a);
}
```

```cpp
#include <hip/hip_runtime.h>
#include <stdint.h>
#include <cstdio>

namespace cfg {
constexpr int D = 1024, NB = 8, S = 4096, CTX = 256;
constexpr int MX = NB * S, MC = NB * CTX, M = MX + MC;
constexpr int PIN = 4752, NPAD = 4864, PLD = 4736;
constexpr int A_Q = 0, A_FF = 256, A_FB = 512, A_I = 768, A_Z = 1024, B_Q = 1280, B_K = 1664, B_V = 2048, B_O = 2432, B_Z = 2816,
              C_Q = 3200, C_K = 3584, C_V = 3968, C_Z = 4352;
constexpr float EPS = 1e-6f;
constexpr size_t WS_CTL = 0, CTL_BYTES = 65536;
constexpr size_t WS_WT_IN = WS_CTL + CTL_BYTES;
constexpr size_t WS_WT_OUT = WS_WT_IN + 2ull * NPAD * 1024 * 2;
constexpr size_t WS_MOD = WS_WT_OUT + 2ull * 1024 * 1024 * 2;
constexpr size_t WS_GATES = WS_MOD + 2ull * 9 * 3072 * 4;
constexpr size_t WS_CTX1 = WS_GATES + (size_t)M * 16 * 4;
constexpr size_t WS_HXY = WS_CTX1 + (size_t)MC * 1024 * 4;
constexpr size_t WS_P = WS_HXY + (size_t)M * 1024 * 2;
constexpr size_t WS_OH = WS_P + (size_t)M * PLD * 2;
constexpr size_t WS_OM = WS_OH + (size_t)M * 256 * 4;
constexpr size_t WS_STM = WS_OM + (size_t)M * 384 * 2;
constexpr size_t WS_ROPE = WS_STM + 32ull * 2 * 8 * (96 * 112 + 16) * 4;
constexpr size_t WS_STH = WS_ROPE + 64 * 24 * 8;
constexpr size_t WS_END = WS_STH + 32ull * 2 * 8 * (64 * 64 + 64) * 4;
static_assert(WS_END <= 536870912ull, "workspace");
static_assert(WS_WT_IN % 256 == 0 && WS_MOD % 256 == 0 && WS_GATES % 256 == 0 && WS_CTX1 % 256 == 0 && WS_HXY % 256 == 0 && WS_P % 256 == 0 && WS_OH % 256 == 0 && WS_OM % 256 == 0 && WS_STM % 256 == 0 && WS_ROPE % 256 == 0 && WS_STH % 256 == 0, "align");
}
using namespace cfg;

namespace pg8 {
#define PG8_LAS __attribute__((address_space(3)))
typedef unsigned short bf16_t;
typedef short bf16x8 __attribute__((ext_vector_type(8)));
typedef float f32x4 __attribute__((ext_vector_type(4)));
typedef unsigned u32x4 __attribute__((ext_vector_type(4)));
constexpr int BM = 256, BK = 64, HALF = 128, HTB = HALF * BK * 2  , STAGE_BYTES = 8 * HTB, NXCD = 8, WGM = 8;

__host__ __device__ __forceinline__ int lds_byte(int r, int c) { const int st = (r >> 4) * 2 + (c >> 5), rr = r & 15, cc = c & 31, ob = rr * 64 + cc * 2; return st * 1024 + (ob ^ (((ob >> 9) & 1) << 5)); }
__host__ __device__ __forceinline__ void stage_rc(int b, int& R, int& C) { const int st = b / 1024, sb = b % 1024, swz = sb ^ (((sb >> 9) & 1) << 5); R = (st >> 1) * 16 + swz / 64; C = (st & 1) * 32 + (swz % 64) / 2; }
__host__ __device__ __forceinline__ int perm32(int rho) { const int n = rho >> 4, i = rho & 15; return 8 * (i >> 2) + 4 * n + (i & 3); }

struct Unit { int pm, pn; };
struct Gemm { const bf16_t* A; const bf16_t* Bt; int M, N, K; };

struct StaticOrder {
    int nM, nN, nwg, G, c;
    __host__ __device__ void init(int M, int N, int G_, int c_) { nM = M / BM; nN = N / BM; nwg = nM * nN; G = G_; c = c_; }
    __host__ __device__ bool next(int i, Unit& u) const {
        const long L = (long)i * G + c; if (L >= nwg) return false;
        int wgid = (int)L; { const int q = nwg / NXCD, r = nwg % NXCD, xcd = wgid % NXCD, off = wgid / NXCD; wgid = (xcd < r ? xcd * (q + 1) : r * (q + 1) + (xcd - r) * q) + off; }
        const int nig = WGM * nN, gid = wgid / nig, fm = gid * WGM, gsz = (nM - fm) < WGM ? (nM - fm) : WGM;
        u.pm = fm + ((wgid % nig) % gsz); u.pn = (wgid % nig) / gsz; return true;
    }
    __device__ __forceinline__ void a_ready(const Unit&) const {}
    __device__ __forceinline__ void done(const Unit&) const {}
};

__device__ __forceinline__ unsigned cvt_pk_bf16(float lo, float hi) { unsigned r; asm volatile("v_cvt_pk_bf16_f32 %0, %1, %2" : "=v"(r) : "v"(lo), "v"(hi)); return r; }
__device__ __forceinline__ float logsigmoid_e(float v) { return fminf(v, 0.f) - log1pf(__expf(-fabsf(v))); }

struct EpiIn {
    static constexpr bool PERM = true, AFTER_DRAIN = false;
    bf16_t* P; float* gates; const float* gate_b;
    __device__ __forceinline__ void operator()(const f32x4 (&acc)[2][2][4][2], const Unit& u, int wr, int wc, int fr, int fq) const {
        const int row0 = u.pm * BM + wr * 64 + fr, col0 = u.pn * BM + wc * 32 + 8 * fq;
#pragma unroll
        for (int bj = 0; bj < 2; ++bj) {
            const int col = col0 + bj * HALF;
            if (col < cfg::PLD) {
#pragma unroll
                for (int ai = 0; ai < 2; ++ai)
#pragma unroll
                    for (int m = 0; m < 4; ++m) { const f32x4 v0 = acc[ai][bj][m][0], v1 = acc[ai][bj][m][1];
                        u32x4 w; w.x = cvt_pk_bf16(v0[0], v0[1]); w.y = cvt_pk_bf16(v0[2], v0[3]); w.z = cvt_pk_bf16(v1[0], v1[1]); w.w = cvt_pk_bf16(v1[2], v1[3]);
                        *(u32x4*)(P + (size_t)(row0 + ai * HALF + m * 16) * cfg::PLD + col) = w; }
            } else if (col < cfg::PIN) {
                const int g0 = col - cfg::PLD;
                const f32x4 b0 = *(const f32x4*)(gate_b + g0), b1 = *(const f32x4*)(gate_b + g0 + 4);
#pragma unroll
                for (int ai = 0; ai < 2; ++ai)
#pragma unroll
                    for (int m = 0; m < 4; ++m) { f32x4 v0 = acc[ai][bj][m][0] + b0, v1 = acc[ai][bj][m][1] + b1;
                        if (g0 >= 8) {
#pragma unroll
                            for (int e = 0; e < 4; ++e) { v0[e] = logsigmoid_e(v0[e]); v1[e] = logsigmoid_e(v1[e]); } }
                        float* gp = gates + (size_t)(row0 + ai * HALF + m * 16) * 16 + g0;
                        *(f32x4*)gp = v0; *(f32x4*)(gp + 4) = v1; }
            }
        }
    }
};
struct EpiOut {
    static constexpr bool PERM = false, AFTER_DRAIN = false;
    float* C;
    __device__ __forceinline__ void operator()(const f32x4 (&acc)[2][2][4][2], const Unit& u, int wr, int wc, int fr, int fq) const {
        const int row0 = u.pm * BM + wr * 64 + fr, col0 = u.pn * BM + wc * 32 + 4 * fq;
#pragma unroll
        for (int ai = 0; ai < 2; ++ai)
#pragma unroll
            for (int m = 0; m < 4; ++m) { float* rowp = C + (size_t)(row0 + ai * HALF + m * 16) * 1024 + col0;
#pragma unroll
                for (int bj = 0; bj < 2; ++bj)
#pragma unroll
                    for (int n = 0; n < 2; ++n) *(f32x4*)(rowp + bj * HALF + n * 16) = acc[ai][bj][m][n]; }
    }
};

template <class Epi, class Sched, bool ALIGN_EPI = false, bool SP2 = false>
__device__ __forceinline__ void gemm_phase(PG8_LAS unsigned char* lds, const Gemm g, const Sched& S, const Epi& E) {
    const int tid = threadIdx.x, wid = __builtin_amdgcn_readfirstlane(tid >> 6), lane = tid & 63, wr = wid >> 2, wc = wid & 3, fr = lane & 15, fq = lane >> 4;
    const int K = g.K, nt = K / BK;
    unsigned voffA[2], voffB[2];
#pragma unroll
    for (int i = 0; i < 2; ++i) { int R, C; stage_rc(tid * 16 + i * 8192, R, C); const int Rb = Epi::PERM ? ((R & ~31) + perm32(R & 31)) : R;
        voffA[i] = (unsigned)(R * K + C) * 2u; voffB[i] = (unsigned)(Rb * K + C) * 2u; }
    const size_t kstep = (size_t)(BK * 2);
    const size_t hstep = (size_t)HALF * K * 2;
    const size_t tstep = 2 * hstep;
    const unsigned ldsw = (unsigned)wid * 1024u;
    const int aoff = lds_byte(wr * 64 + fr, fq * 8), boff = lds_byte(wc * 32 + fr, fq * 8);
#define PG8_SA(b, h) (((b) * 2 + (h)) * HTB)
#define PG8_SB(b, h) ((4 + (b) * 2 + (h)) * HTB)
#define PG8_STAGE(bufoff, gbase, voff) do { _Pragma("unroll") for (int _i = 0; _i < 2; ++_i) \
        __builtin_amdgcn_global_load_lds((const unsigned*)((const char*)(gbase) + (voff)[_i]), (PG8_LAS unsigned*)(lds + (bufoff) + ldsw + _i * 8192), 16, 0, 0); } while (0)
#define PG8_LDA(dst, b, h) do { _Pragma("unroll") for (int m = 0; m < 4; ++m) _Pragma("unroll") for (int k = 0; k < 2; ++k) dst[m][k] = *(const PG8_LAS bf16x8*)(lds + PG8_SA(b, h) + aoff + m * 2048 + k * 1024); } while (0)
#define PG8_LDB(dst, b, h) do { _Pragma("unroll") for (int n = 0; n < 2; ++n) _Pragma("unroll") for (int k = 0; k < 2; ++k) dst[n][k] = *(const PG8_LAS bf16x8*)(lds + PG8_SB(b, h) + boff + n * 2048 + k * 1024); } while (0)
#define PG8_MMA(ai, bj, At, Bt) do { __builtin_amdgcn_s_setprio(1); _Pragma("unroll") for (int m = 0; m < 4; ++m) _Pragma("unroll") for (int n = 0; n < 2; ++n) _Pragma("unroll") for (int k = 0; k < 2; ++k) \
        acc[ai][bj][m][n] = __builtin_amdgcn_mfma_f32_16x16x32_bf16(Bt[n][k], At[m][k], acc[ai][bj][m][n], 0, 0, 0); __builtin_amdgcn_s_setprio(0); } while (0)
#define PG8_WAIT_V(n) asm volatile("s_waitcnt vmcnt(" #n ")" ::: "memory")
#define PG8_WAIT_L(n) asm volatile("s_waitcnt lgkmcnt(" #n ")" ::: "memory")
#define PG8_BAR __builtin_amdgcn_s_barrier()
#define PG8_SCHED __builtin_amdgcn_sched_barrier(0)
    Unit cur, nxt; int ui = 0;
    if (!S.next(0, cur)) return;
    f32x4 acc[2][2][4][2];
#pragma unroll
    for (int a = 0; a < 2; ++a)
#pragma unroll
        for (int b = 0; b < 2; ++b)
#pragma unroll
            for (int m = 0; m < 4; ++m)
#pragma unroll
                for (int n = 0; n < 2; ++n) acc[a][b][m][n] = (f32x4){0.f, 0.f, 0.f, 0.f};
    bf16x8 At[4][2], B0[2][2], B1[2][2];
    const char* cA = (const char*)g.A + (size_t)cur.pm * tstep; const char* cB = (const char*)g.Bt + (size_t)cur.pn * tstep;
    S.a_ready(cur);
    if constexpr (SP2) {
        PG8_STAGE(PG8_SB(0, 0), cB, voffB); PG8_STAGE(PG8_SB(0, 1), cB + hstep, voffB); PG8_STAGE(PG8_SA(0, 0), cA, voffA); PG8_STAGE(PG8_SA(0, 1), cA + hstep, voffA);
        if (wr == 1) PG8_BAR;
        PG8_WAIT_V(2); PG8_BAR;
        PG8_STAGE(PG8_SB(1, 0), cB + kstep, voffB); PG8_STAGE(PG8_SA(1, 0), cA + kstep, voffA); PG8_STAGE(PG8_SB(1, 1), cB + hstep + kstep, voffB);
        PG8_WAIT_V(6); PG8_BAR;
    } else {
        PG8_STAGE(PG8_SB(0, 0), cB, voffB); PG8_STAGE(PG8_SA(0, 0), cA, voffA); PG8_STAGE(PG8_SB(0, 1), cB + hstep, voffB); PG8_STAGE(PG8_SA(0, 1), cA + hstep, voffA);
        if (wr == 1) PG8_BAR;
        PG8_WAIT_V(4); PG8_BAR;
        PG8_STAGE(PG8_SB(1, 0), cB + kstep, voffB); PG8_STAGE(PG8_SA(1, 0), cA + kstep, voffA); PG8_STAGE(PG8_SB(1, 1), cB + hstep + kstep, voffB);
        PG8_WAIT_V(6); PG8_BAR;
    }
    for (;;) {
        const bool has_next = S.next(ui + 1, nxt);
        const char* nA = has_next ? (const char*)g.A + (size_t)nxt.pm * tstep : cA; const char* nB = has_next ? (const char*)g.Bt + (size_t)nxt.pn * tstep : cB;
        for (int t = 0; t < nt; t += 2) {
            const bool last = (t == nt - 2);
            const char* a1 = cA + (size_t)(t + 1) * kstep;
            const char* a2 = last ? nA : cA + (size_t)(t + 2) * kstep; const char* b2 = last ? nB : cB + (size_t)(t + 2) * kstep;
            const char* a3 = a2 + kstep; const char* b3 = b2 + kstep;
            if (last && has_next) S.a_ready(nxt);
            if constexpr (SP2) {
            PG8_LDB(B0, 0, 0); PG8_LDB(B1, 0, 1); PG8_SCHED; PG8_LDA(At, 0, 0); PG8_STAGE(PG8_SA(1, 1), a1 + hstep, voffA);
            PG8_WAIT_V(8); PG8_WAIT_L(0); PG8_BAR; PG8_MMA(0, 0, At, B0); PG8_MMA(0, 1, At, B1); PG8_BAR; PG8_SCHED;
            PG8_LDA(At, 0, 1); PG8_STAGE(PG8_SB(0, 0), b2, voffB); PG8_STAGE(PG8_SB(0, 1), b2 + hstep, voffB); PG8_STAGE(PG8_SA(0, 0), a2, voffA);
            PG8_WAIT_V(8); PG8_WAIT_L(0); PG8_BAR; PG8_MMA(1, 0, At, B0); PG8_MMA(1, 1, At, B1); PG8_BAR; PG8_SCHED;
            PG8_LDB(B0, 1, 0); PG8_LDB(B1, 1, 1); PG8_SCHED; PG8_LDA(At, 1, 0); PG8_STAGE(PG8_SA(0, 1), a2 + hstep, voffA);
            PG8_WAIT_V(8); PG8_WAIT_L(0); PG8_BAR; PG8_MMA(0, 0, At, B0); PG8_MMA(0, 1, At, B1); PG8_BAR; PG8_SCHED;
            PG8_LDA(At, 1, 1); PG8_STAGE(PG8_SB(1, 0), b3, voffB); PG8_STAGE(PG8_SB(1, 1), b3 + hstep, voffB); PG8_STAGE(PG8_SA(1, 0), a3, voffA);
            PG8_WAIT_V(8); PG8_WAIT_L(0); PG8_BAR; PG8_MMA(1, 0, At, B0); PG8_MMA(1, 1, At, B1); PG8_BAR; PG8_SCHED;
            } else {
            PG8_LDB(B0, 0, 0); PG8_SCHED; PG8_LDA(At, 0, 0); PG8_STAGE(PG8_SA(1, 1), a1 + hstep, voffA);
            PG8_WAIT_L(8); PG8_BAR; PG8_WAIT_L(0); PG8_MMA(0, 0, At, B0); PG8_BAR; PG8_SCHED;
            PG8_LDB(B1, 0, 1); PG8_STAGE(PG8_SB(0, 0), b2, voffB);
            PG8_BAR; PG8_WAIT_L(0); PG8_MMA(0, 1, At, B1); PG8_BAR;
            PG8_LDA(At, 0, 1); PG8_STAGE(PG8_SA(0, 0), a2, voffA);
            PG8_BAR; PG8_WAIT_L(0); PG8_MMA(1, 0, At, B0); PG8_BAR; PG8_SCHED;
            PG8_STAGE(PG8_SB(0, 1), b2 + hstep, voffB);
            PG8_WAIT_V(6); PG8_BAR; PG8_MMA(1, 1, At, B1); PG8_BAR;
            PG8_LDB(B0, 1, 0); PG8_SCHED; PG8_LDA(At, 1, 0); PG8_STAGE(PG8_SA(0, 1), a2 + hstep, voffA);
            PG8_WAIT_L(8); PG8_BAR; PG8_WAIT_L(0); PG8_MMA(0, 0, At, B0); PG8_BAR; PG8_SCHED;
            PG8_LDB(B1, 1, 1); PG8_STAGE(PG8_SB(1, 0), b3, voffB);
            PG8_BAR; PG8_WAIT_L(0); PG8_MMA(0, 1, At, B1); PG8_BAR;
            PG8_LDA(At, 1, 1); PG8_STAGE(PG8_SA(1, 0), a3, voffA);
            PG8_BAR; PG8_WAIT_L(0); PG8_MMA(1, 0, At, B0); PG8_BAR; PG8_SCHED;
            PG8_STAGE(PG8_SB(1, 1), b3 + hstep, voffB);
            PG8_WAIT_V(6); PG8_BAR; PG8_MMA(1, 1, At, B1); PG8_BAR;
            }
        }
        if constexpr (ALIGN_EPI) { if (wr == 0) PG8_BAR; }
        if constexpr (!Epi::AFTER_DRAIN) { E(acc, cur, wr, wc, fr, fq); S.done(cur); }
        if (!has_next) break;
#pragma unroll
        for (int a = 0; a < 2; ++a)
#pragma unroll
            for (int b = 0; b < 2; ++b)
#pragma unroll
                for (int m = 0; m < 4; ++m)
#pragma unroll
                    for (int n = 0; n < 2; ++n) acc[a][b][m][n] = (f32x4){0.f, 0.f, 0.f, 0.f};
        cur = nxt; cA = nA; cB = nB; ++ui;
        if constexpr (ALIGN_EPI) { if (wr == 1) PG8_BAR; }
    }
    PG8_WAIT_V(0);
    if constexpr (!ALIGN_EPI) { if (wr == 0) PG8_BAR; }
    PG8_BAR;
    if constexpr (Epi::AFTER_DRAIN) { E.fused(acc, cur, wr, wc, fr, fq, lds, wid, lane); S.done(cur); }
#undef PG8_SA
#undef PG8_SB
#undef PG8_STAGE
#undef PG8_LDA
#undef PG8_LDB
#undef PG8_MMA
#undef PG8_WAIT_V
#undef PG8_WAIT_L
#undef PG8_BAR
#undef PG8_SCHED
}
}
constexpr int RING_OFF = 0, RING_BYTES = 131072;
constexpr int LDSCTL_OFF = RING_BYTES, MISC_OFF = LDSCTL_OFF + 320;
constexpr int LDS_BYTES = 147456;
constexpr int CW_BAR = 4096;

#define GAS __attribute__((address_space(1)))
#define LAS __attribute__((address_space(3)))
typedef unsigned short bf16;
typedef unsigned v4u __attribute__((ext_vector_type(4)));
typedef float f32x4 __attribute__((ext_vector_type(4)));
typedef short bf16x8 __attribute__((ext_vector_type(8)));
typedef GAS unsigned gu32;
#define RLX_AGENT __ATOMIC_RELAXED, __HIP_MEMORY_SCOPE_AGENT
#define LDS_WAIT() asm volatile("s_waitcnt lgkmcnt(0)" ::: "memory")
#define VM_WAIT() asm volatile("s_waitcnt vmcnt(0)" ::: "memory")
__device__ __forceinline__ unsigned f2bfu(float f) { unsigned u = __builtin_bit_cast(unsigned, f); return (u + 0x7fffu + ((u >> 16) & 1u)) >> 16; }
__device__ __forceinline__ bf16 f2bf(float f) { return (bf16)f2bfu(f); }
__device__ __forceinline__ unsigned pk2(float lo, float hi) { return f2bfu(lo) | (f2bfu(hi) << 16); }
__device__ __forceinline__ float bf2f(bf16 v) { return __uint_as_float(((unsigned)v) << 16); }
__device__ __forceinline__ float silu_f(float v) { return v / (1.f + __expf(-v)); }
__device__ __forceinline__ float sigmoid_f(float v) { return 1.f / (1.f + __expf(-v)); }
__device__ __forceinline__ float wave_sum(float v) {
#pragma unroll
    for (int o = 1; o < 64; o <<= 1) v += __shfl_xor(v, o);
    return v;
}
__device__ __forceinline__ float rdlane(float v, int i) { return __int_as_float(__builtin_amdgcn_readlane(__float_as_int(v), i)); }

#define XB_TMO      128
#define XB_XCNT(j)  (256  + 64 * (j))
#define XB_XSUB(j)  (1280 + 64 * (j))
#define XB_XGEN(j)  (2304 + 64 * (j))
#define XB_TOP      3328
#define XB_TOPGEN   3392
#define XCD_BAR_WORDS 3456
#define XB_SPIN_CAP (1u << 18)

__device__ __forceinline__ unsigned xb_ld(unsigned* p)              { return __hip_atomic_load(p, __ATOMIC_RELAXED, __HIP_MEMORY_SCOPE_AGENT); }
__device__ __forceinline__ unsigned xb_add(unsigned* p, unsigned v) { return __hip_atomic_fetch_add(p, v, __ATOMIC_RELAXED, __HIP_MEMORY_SCOPE_AGENT); }
__device__ __forceinline__ unsigned xb_xcc_id() { return (unsigned)__builtin_amdgcn_s_getreg((3 << 11) | 20) & 0xFu; }
#define XB_SPIN(cond, bar) do { unsigned _sp = 0; while (cond) { __builtin_amdgcn_s_sleep(1); \
    if ((++_sp & 255u) == 0u) { if (xb_ld(&(bar)[XB_TMO])) break; if (_sp > XB_SPIN_CAP) { atomicAdd(&(bar)[XB_TMO], 1u); break; } } } } while (0)

struct XcdBarrier {
    unsigned* bar; unsigned x;
    volatile LAS unsigned* st;
};

__device__ __forceinline__ XcdBarrier xcd_barrier_post(unsigned* bar, volatile LAS unsigned* st) {
    XcdBarrier b; b.bar = bar; b.x = xb_xcc_id(); b.st = st;
    if (threadIdx.x == 0) (void)xb_add(&bar[XB_XCNT(b.x)], 1u);
    return b;
}
__device__ __forceinline__ void xcd_barrier_complete(unsigned* bar, unsigned x, unsigned& nloc, unsigned& nx) {
    const unsigned G = gridDim.x * gridDim.y * gridDim.z;
    unsigned sum, cnt, mine, sp = 0u;
    for (;;) {
        sum = 0u; cnt = 0u; mine = 0u;
#pragma unroll
        for (unsigned j = 0; j < 16; ++j) { const unsigned c = xb_ld(&bar[XB_XCNT(j)]); sum += c; cnt += (c > 0u) ? 1u : 0u; mine = (j == x) ? c : mine; }
        if (sum == G) break;
        __builtin_amdgcn_s_sleep(1);
        if ((++sp & 255u) == 0u) { if (xb_ld(&bar[XB_TMO])) break; if (sp > XB_SPIN_CAP) { atomicAdd(&bar[XB_TMO], 1u); break; } }
    }
    nloc = mine > 0u ? mine : 1u; nx = cnt > 0u ? cnt : 1u;
}

__device__ __forceinline__ void xcd_barrier(const XcdBarrier& b) {
    asm volatile("s_waitcnt vmcnt(0)" ::: "memory");
    __syncthreads();
    if (threadIdx.x == 0) {
        unsigned* bar = b.bar;
        __builtin_amdgcn_s_waitcnt(0);
        unsigned nloc = b.st[0], nx = b.st[1];
        if (nloc == 0u) { xcd_barrier_complete(bar, b.x, nloc, nx); b.st[0] = nloc; b.st[1] = nx; }
        const unsigned old = xb_add(&bar[XB_XSUB(b.x)], 1u);
        const unsigned gen = old / nloc;
        if (old + 1u == (gen + 1u) * nloc) {
            __builtin_amdgcn_fence(__ATOMIC_RELEASE, "agent");
            asm volatile("s_waitcnt vmcnt(0)" ::: "memory");
            const unsigned og = xb_add(&bar[XB_TOP], 1u);
            const unsigned tg = og / nx;
            if (og + 1u == (tg + 1u) * nx) xb_add(&bar[XB_TOPGEN], 1u);
            else XB_SPIN(xb_ld(&bar[XB_TOPGEN]) == tg, bar);
            __builtin_amdgcn_fence(__ATOMIC_ACQUIRE, "agent");
            xb_add(&bar[XB_XGEN(b.x)], 1u);
            asm volatile("s_waitcnt vmcnt(0)" ::: "memory");
        } else {
            XB_SPIN(xb_ld(&bar[XB_XGEN(b.x)]) == gen, bar);
            __builtin_amdgcn_fence(__ATOMIC_ACQUIRE, "agent");
            asm volatile("s_waitcnt vmcnt(0)" ::: "memory");
        }
    }
    __syncthreads();
}

struct Ctx {
    LAS unsigned char* lds; int tid, lane, wave, vcu, G, gw, NGW;
    const float *x, *c, *ctx, *c_ctx, *w_mod, *b_mod, *g_pre, *g_post, *w_in, *w_out, *hgrn_lb, *hgrn_gn, *gate_b, *mlstm_gn, *na_rpb;
    float* out; bf16 *wt_in, *wt_out, *hxy, *P; float *mod, *gates, *ctx1, *UX, *stm, *sth, *rope; bf16 *otm, *oth;
};

__device__ __forceinline__ void transpose_item(const float* W, int N, int Nnew, bool remap, bf16* WT, LAS float* scr, int item, int lane) {
    const int nblk = Nnew / 32, kb = item / nblk, nb = item % nblk, k0 = 64 * kb, n0 = 32 * nb;
    const int nn = n0 + (lane & 31);
    int no = nn; if (remap) no = nn < 3200 ? nn : (nn < 4736 ? nn + 16 : (nn < 4752 ? 3200 + nn - 4736 : -1));
#pragma unroll 8
    for (int i = 0; i < 32; ++i) { const int kk = 2 * i + (lane >> 5); scr[kk * 33 + (lane & 31)] = no >= 0 ? W[(size_t)(k0 + kk) * N + no] : 0.f; }
    LDS_WAIT(); asm volatile("" ::: "memory");
    const int c = lane & 7;
#pragma unroll
    for (int j = 0; j < 4; ++j) { const int n = (lane >> 3) + 8 * j; const LAS float* s = scr + (8 * c) * 33 + n;
        v4u o; o.x = pk2(s[0 * 33], s[1 * 33]); o.y = pk2(s[2 * 33], s[3 * 33]); o.z = pk2(s[4 * 33], s[5 * 33]); o.w = pk2(s[6 * 33], s[7 * 33]);
        *(GAS v4u*)(WT + (size_t)(n0 + n) * 1024 + k0 + 8 * c) = o; }
    LDS_WAIT(); asm volatile("" ::: "memory");
}
__device__ __forceinline__ void phase_p0(const Ctx& F) {
    if (F.vcu < 96) {
        LAS float* tab = (LAS float*)(F.lds);
        LAS float* part = (LAS float*)(F.lds + 36864);
        for (int i = F.tid; i < 9 * 1024; i += 512) { const int r = i >> 10, k = i & 1023; const float v = r < 8 ? F.c[r * 1024 + k] : F.c_ctx[k]; tab[i] = silu_f(v); }
        __syncthreads();
        for (int it = F.vcu; it < 96; it += F.G) {
            const int l = it / 48, jb = it % 48, col = jb * 64 + F.lane;
            float acc[9];
#pragma unroll
            for (int r = 0; r < 9; ++r) acc[r] = 0.f;
            const float* wp = F.w_mod + ((size_t)l * 1024 + F.wave * 128) * 3072 + col;
#pragma unroll 4
            for (int k = 0; k < 128; ++k) { const float wv = wp[(size_t)k * 3072];
#pragma unroll
                for (int r = 0; r < 9; ++r) acc[r] += tab[r * 1024 + F.wave * 128 + k] * wv; }
#pragma unroll
            for (int r = 0; r < 9; ++r) part[(F.wave * 9 + r) * 64 + F.lane] = acc[r];
            __syncthreads();
            for (int i = F.tid; i < 9 * 64; i += 512) { const int r = i >> 6, j = i & 63; float s = 0.f;
#pragma unroll
                for (int w = 0; w < 8; ++w) s += part[(w * 9 + r) * 64 + j];
                F.mod[((size_t)l * 9 + r) * 3072 + jb * 64 + j] = s + F.b_mod[l * 3072 + jb * 64 + j]; }
            __syncthreads();
        }
    }
    if (F.vcu == 96 % F.G) for (int i = F.tid; i < 64 * 24; i += 512) { const int pos = i / 24, f = i % 24; const float ang = (float)pos * expf(-(float)(2 * f) * (1.f / 48.f) * 9.210340371976184f); F.rope[2 * i] = cosf(ang); F.rope[2 * i + 1] = sinf(ang); }
    __syncthreads();
    LAS float* scr = (LAS float*)(F.lds + F.wave * 16384);
    constexpr int I_IN = 16 * (NPAD / 32), I_OUT = 16 * 32;
    for (int it = F.gw; it < 2 * I_IN + 2 * I_OUT; it += F.NGW) {
        int r = it;
        if (r < 2 * I_IN) { const int l = r / I_IN; transpose_item(F.w_in + (size_t)l * 1024 * PIN, PIN, NPAD, true, F.wt_in + (size_t)l * NPAD * 1024, scr, r % I_IN, F.lane); continue; }
        r -= 2 * I_IN; { const int l = r / I_OUT; transpose_item(F.w_out + (size_t)l * 1024 * 1024, 1024, 1024, false, F.wt_out + (size_t)l * 1024 * 1024, scr, r % I_OUT, F.lane); }
    }
}

__device__ __forceinline__ void prenorm_row(const float4 (&v)[4], float ss, const float* mod_r, const float* g_pre_l, bf16* dst, int lane) {
    const float rinv = 1.f / sqrtf(ss * (1.f / 1024.f) + EPS);
    const float* sh = mod_r; const float* sc = mod_r + 1024;
#pragma unroll
    for (int j = 0; j < 4; ++j) {
        const int d = 4 * (lane + 64 * j);
        const float4 g = *(const float4*)(g_pre_l + d), s1 = *(const float4*)(sc + d), s0 = *(const float4*)(sh + d);
        const float o0 = v[j].x * rinv * g.x * (1.f + s1.x) + s0.x, o1 = v[j].y * rinv * g.y * (1.f + s1.y) + s0.y;
        const float o2 = v[j].z * rinv * g.z * (1.f + s1.z) + s0.z, o3 = v[j].w * rinv * g.w * (1.f + s1.w) + s0.w;
        uint2 w; w.x = pk2(o0, o1); w.y = pk2(o2, o3);
        *(uint2*)(dst + d) = w;
    }
}
__device__ __forceinline__ void phase_prenorm0(const Ctx& F) {
    for (int m = F.gw; m < M; m += F.NGW) {
        const float* src; int r;
        if (m < MX) { src = F.x + (size_t)m * 1024; r = m / S; } else { src = F.ctx + (size_t)(m - MX) * 1024; r = 8; }
        float4 v[4]; float ss = 0.f;
#pragma unroll
        for (int j = 0; j < 4; ++j) { v[j] = ((const float4*)src)[F.lane + 64 * j]; ss += v[j].x * v[j].x + v[j].y * v[j].y + v[j].z * v[j].z + v[j].w * v[j].w; }
        ss = wave_sum(ss);
        prenorm_row(v, ss, F.mod + (size_t)r * 3072, F.g_pre, F.hxy + (size_t)m * 1024, F.lane);
    }
}
__device__ __forceinline__ void phase_post(const Ctx& F, int l) {
    const int Ml = l == 0 ? M : MX;
    const float* mod_l = F.mod + (size_t)l * 9 * 3072; const float* g_post_l = F.g_post + l * 1024;
    for (int m = F.gw; m < Ml; m += F.NGW) {
        const float* src; float* dst; int r;
        if (m < MX) { src = (l == 0 ? F.x : F.out) + (size_t)m * 1024; dst = F.out + (size_t)m * 1024; r = m / S; }
        else { src = F.ctx + (size_t)(m - MX) * 1024; dst = F.ctx1 + (size_t)(m - MX) * 1024; r = 8; }
        const float* ur = F.UX + (size_t)m * 1024;
        float4 u[4]; float ss = 0.f;
#pragma unroll
        for (int j = 0; j < 4; ++j) { u[j] = ((const float4*)ur)[F.lane + 64 * j]; ss += u[j].x * u[j].x + u[j].y * u[j].y + u[j].z * u[j].z + u[j].w * u[j].w; }
        ss = wave_sum(ss);
        const float rinv = 1.f / sqrtf(ss * (1.f / 1024.f) + EPS);
        const float* gt = mod_l + r * 3072 + 2048;
        float ss2 = 0.f;
#pragma unroll
        for (int j = 0; j < 4; ++j) {
            const int d = 4 * (F.lane + 64 * j);
            const float4 g = *(const float4*)(g_post_l + d), t = *(const float4*)(gt + d), xv = *(const float4*)(src + d);
            float4 o; o.x = xv.x + t.x * (u[j].x * rinv * g.x); o.y = xv.y + t.y * (u[j].y * rinv * g.y); o.z = xv.z + t.z * (u[j].z * rinv * g.z); o.w = xv.w + t.w * (u[j].w * rinv * g.w);
            *(float4*)(dst + d) = o; u[j] = o; ss2 += o.x * o.x + o.y * o.y + o.z * o.z + o.w * o.w;
        }
        if (l == 0) { ss2 = wave_sum(ss2); prenorm_row(u, ss2, F.mod + (size_t)(9 + r) * 3072, F.g_pre + 1024, F.hxy + (size_t)m * 1024, F.lane); }
    }
}

__device__ __forceinline__ int seq_row(int b, int step, int dir) {
    if (step < CTX) { const int n = dir ? CTX - 1 - step : step; return MX + b * CTX + n; }
    int t = step - CTX; if (dir) t = S - 1 - t; return b * S + t;
}
__device__ __forceinline__ void load_row64(const bf16* p, float* dst) {
#pragma unroll
    for (int c = 0; c < 8; ++c) { const uint4 w = *(const uint4*)(p + 8 * c); const unsigned u[4] = {w.x, w.y, w.z, w.w};
#pragma unroll
        for (int e = 0; e < 4; ++e) { dst[8 * c + 2 * e] = __uint_as_float(u[e] << 16); dst[8 * c + 2 * e + 1] = __uint_as_float(u[e] & 0xffff0000u); } }
}
__device__ __forceinline__ void na_naive_item(const Ctx& F, int l, int idx) {
    const bf16* P = F.P;
    int h, m, b, nk, r = 0, c = 0, rs = 0, cs = 0; const bool lat = idx < MX * 6;
    if (lat) { h = idx / MX; m = idx % MX; b = m / S; const int t = m % S; r = t / 64; c = t % 64; rs = min(max(r - 4, 0), 56); cs = min(max(c - 8, 0), 48); nk = 128 + CTX; }
    else { const int i2 = idx - MX * 6; h = i2 / MC; const int mc = i2 % MC; b = mc / CTX; m = MX + mc; nk = CTX; }
    const float* rpb_l = F.na_rpb + (size_t)l * 6 * 15 * 31;
    float q[64], acc[64], kv[64];
    load_row64(P + (size_t)m * PLD + C_Q + h * 64, q);
#pragma unroll
    for (int d = 0; d < 64; ++d) { q[d] *= 0.125f; acc[d] = 0.f; }
    float mx = -INFINITY, lsum = 0.f;
    for (int key = 0; key < nk; ++key) {
        int km; float bias = 0.f;
        if (lat && key < 128) { const int jr = key >> 4, kc = cs + (key & 15); km = b * S + (rs + jr) * 64 + kc; bias = rpb_l[(h * 15 + (rs + jr - r + 7)) * 31 + (kc - c + 15)]; }
        else km = MX + b * CTX + (lat ? key - 128 : key);
        load_row64(P + (size_t)km * PLD + C_K + h * 64, kv);
        float s = 0.f;
#pragma unroll
        for (int d = 0; d < 64; ++d) s += q[d] * kv[d];
        s += bias;
        const float mnew = fmaxf(mx, s), scale = __expf(mx - mnew), pe = __expf(s - mnew); mx = mnew;
        lsum = lsum * scale + pe;
        load_row64(P + (size_t)km * PLD + C_V + h * 64, kv);
#pragma unroll
        for (int d = 0; d < 64; ++d) acc[d] = acc[d] * scale + pe * kv[d];
    }
    const float rl = 1.f / lsum;
    const bf16* zr = P + (size_t)m * PLD + C_Z + h * 64;
#pragma unroll
    for (int d = 0; d < 64; ++d) F.hxy[(size_t)m * 1024 + 640 + h * 64 + d] = f2bf(acc[d] * rl * silu_f(bf2f(zr[d])));
}

typedef short s16x4 __attribute__((ext_vector_type(4)));
typedef short v4i16_t __attribute__((ext_vector_type(4)));
__device__ __forceinline__ s16x4 tr_read(const LAS bf16* p) { return __builtin_bit_cast(s16x4, __builtin_amdgcn_ds_read_tr16_b64_v4i16((LAS v4i16_t*)p)); }
__device__ __forceinline__ bf16x8 tr_frag(const LAS bf16* T, int stride, int rowA, int rowB, int col0, int lane) {
    const int q = (lane >> 2) & 3, p = lane & 3;
    const s16x4 lo = tr_read(T + (rowA + q) * stride + col0 + 4 * p), hi = tr_read(T + (rowB + q) * stride + col0 + 4 * p);
    return (bf16x8){lo[0], lo[1], lo[2], lo[3], hi[0], hi[1], hi[2], hi[3]};
}
__device__ __forceinline__ bf16x8 rm_frag(const LAS bf16* T, int stride, int row, int k0) { return *(const LAS bf16x8*)(T + row * stride + k0); }
__device__ __forceinline__ f32x4 mfma16(bf16x8 a, bf16x8 b, f32x4 c) { return __builtin_amdgcn_mfma_f32_16x16x32_bf16(a, b, c, 0, 0, 0); }
typedef unsigned v2u __attribute__((ext_vector_type(2)));
typedef float f32x2 __attribute__((ext_vector_type(2)));
__device__ __forceinline__ void unpack8(const v4u w, float* f) {
    f[0] = __uint_as_float(w.x << 16); f[1] = __uint_as_float(w.x & 0xffff0000u); f[2] = __uint_as_float(w.y << 16); f[3] = __uint_as_float(w.y & 0xffff0000u);
    f[4] = __uint_as_float(w.z << 16); f[5] = __uint_as_float(w.z & 0xffff0000u); f[6] = __uint_as_float(w.w << 16); f[7] = __uint_as_float(w.w & 0xffff0000u);
}
__device__ __forceinline__ v4u pack8(const float* f) { v4u w; w.x = pk2(f[0], f[1]); w.y = pk2(f[2], f[3]); w.z = pk2(f[4], f[5]); w.w = pk2(f[6], f[7]); return w; }

namespace ml {
constexpr int QSTR = 104, VSTR = 120;
constexpr int OFF_QS = 0, OFF_KS = OFF_QS + 64 * QSTR * 2, OFF_VS = OFF_KS + 64 * QSTR * 2, OFF_CT = OFF_VS + 64 * VSTR * 2;
constexpr int OFF_HT = OFF_CT + 2 * 112 * QSTR * 2, OFF_DEN = OFF_HT + 64 * 100 * 4, OFF_ROPE = OFF_DEN + 256, OFF_END = OFF_ROPE + 64 * 24 * 8;
static_assert(OFF_END <= RING_BYTES, "mlstm LDS");
constexpr int ST_FLOATS = 96 * 112 + 16;
}
struct MlJob { int b, h, isctx, t0, nchunk; };

__device__ __forceinline__ void mlstm_dir(const Ctx& F, int l, const MlJob jb, int dir, int fold_r, int emit_slot, int mode, bf16* otmp, float* ST) {
    using namespace ml;
    int tid_ = F.tid; asm volatile("" : "+v"(tid_));
    const int tid = tid_, lane = tid & 63, w = __builtin_amdgcn_readfirstlane(tid >> 6), g = lane >> 4, c = lane & 15;
    LAS bf16* QS = (LAS bf16*)(F.lds + OFF_QS); LAS bf16* KS = (LAS bf16*)(F.lds + OFF_KS); LAS bf16* VS = (LAS bf16*)(F.lds + OFF_VS);
    LAS bf16* CT0 = (LAS bf16*)(F.lds + OFF_CT); LAS float* HT = (LAS float*)(F.lds + OFF_HT); LAS float* DEN = (LAS float*)(F.lds + OFF_DEN);
    const LAS f32x2* ROPE = (const LAS f32x2*)(F.lds + OFF_ROPE);
    const int rowbase = jb.isctx ? MX + jb.b * CTX : jb.b * S;
    const int h = jb.h; const bf16* P = F.P;
    float* STd = ST + (size_t)(((jb.b * 4 + h) * 2 + dir) * 8) * ST_FLOATS;
    f32x4 Cst[7];
#pragma unroll
    for (int et = 0; et < 7; ++et) Cst[et] = (f32x4){0.f, 0.f, 0.f, 0.f};
    if (w < 6 && fold_r >= 0) {
#pragma unroll
        for (int et = 0; et < 7; ++et)
#pragma unroll
            for (int r = 0; r < 4; ++r) Cst[et][r] = STd[(16 * w + 4 * g + r) * 112 + 16 * et + c];
        for (int k = 1; k <= fold_r; ++k) {
            const float* sl = STd + (size_t)k * ST_FLOATS; const float dec = __expf(sl[96 * 112]);
#pragma unroll
            for (int et = 0; et < 7; ++et)
#pragma unroll
                for (int r = 0; r < 4; ++r) Cst[et][r] = dec * Cst[et][r] + sl[(16 * w + 4 * g + r) * 112 + 16 * et + c];
        }
    }
    float Btot = 0.f;
    for (int i = tid; i < 64 * 16; i += 512) { const int s = i >> 4, e = 96 + (i & 15); VS[s * VSTR + e] = (e == 96) ? (bf16)0x3F80 : (bf16)0; }
    if (w < 6) {
#pragma unroll
        for (int et = 0; et < 7; ++et) { v2u v; v.x = pk2(Cst[et][0], Cst[et][1]); v.y = pk2(Cst[et][2], Cst[et][3]); *(LAS v2u*)(CT0 + (16 * et + c) * QSTR + 16 * w + 4 * g) = v; }
    }
    const bool hasqk = tid < 384; const int qk_tok = tid / 6, qk_pi = tid % 6, qk_part = qk_pi / 3, qk_pp = qk_pi % 3, qk_d0 = 48 * qk_part + 8 * qk_pp;
    const int v1_tok = tid / 12, v1_pc = tid % 12; const bool hasv2 = tid < 256; const int v2_tok = (512 + tid) / 12, v2_pc = (512 + tid) % 12;
    v4u rq0, rq1, rk0, rk1, rv1, rv2; float rig = 0.f, rlf = 0.f;
    rq0 = rq1 = rk0 = rk1 = rv1 = rv2 = (v4u){0u, 0u, 0u, 0u};
    auto tok_of = [&](int ci, int i) -> int { return dir == 0 ? jb.t0 + 64 * ci + i : jb.t0 + 64 * (jb.nchunk - 1 - ci) + (63 - i); };
    auto issue_loads = [&](int ci) {
        if (hasqk) { const bf16* pr = P + (size_t)(rowbase + tok_of(ci, qk_tok)) * PLD + h * 96 + qk_d0;
            if (mode != 0) { rq0 = *(const v4u*)(pr + B_Q); rq1 = *(const v4u*)(pr + B_Q + 24); }
            rk0 = *(const v4u*)(pr + B_K); rk1 = *(const v4u*)(pr + B_K + 24); }
        rv1 = *(const v4u*)(P + (size_t)(rowbase + tok_of(ci, v1_tok)) * PLD + B_V + h * 96 + 8 * v1_pc);
        if (hasv2) rv2 = *(const v4u*)(P + (size_t)(rowbase + tok_of(ci, v2_tok)) * PLD + B_V + h * 96 + 8 * v2_pc);
        const float* gp = F.gates + (size_t)(rowbase + tok_of(ci, lane)) * 16 + dir * 4 + h; rig = gp[0]; rlf = gp[8];
    };
    issue_loads(0);
    __syncthreads();
    for (int ci = 0; ci < jb.nchunk; ++ci) {
        LAS bf16* CTc = CT0 + (ci & 1) * 112 * QSTR; LAS bf16* CTn = CT0 + ((ci + 1) & 1) * 112 * QSTR;
        float bcs = rlf;
#pragma unroll
        for (int o = 1; o < 64; o <<= 1) { const float t = __shfl_up(bcs, o); if (lane >= o) bcs += t; }
        const float qsc = __expf(bcs) * 0.10206207261596575f, ksc = __expf(rig - bcs);
        const float bL = __shfl(bcs, 63), ebL = __expf(bL);
        if (hasqk) {
            const float ks_t = __shfl(ksc, qk_tok), qs_t = __shfl(qsc, qk_tok);
            float cs[8], sn[8];
            if (!jb.isctx) { const int t = tok_of(ci, qk_tok); const int pos = qk_part ? (t & 63) : (t >> 6);
#pragma unroll
                for (int e = 0; e < 8; ++e) { const f32x2 v = ROPE[pos * 24 + 8 * qk_pp + e]; cs[e] = v[0]; sn[e] = v[1]; } }
            else {
#pragma unroll
                for (int e = 0; e < 8; ++e) { cs[e] = 1.f; sn[e] = 0.f; } }
            float a[8], b2[8], o0[8], o1[8];
            unpack8(rk0, a); unpack8(rk1, b2);
#pragma unroll
            for (int e = 0; e < 8; ++e) { o0[e] = (a[e] * cs[e] - b2[e] * sn[e]) * ks_t; o1[e] = (b2[e] * cs[e] + a[e] * sn[e]) * ks_t; }
            *(LAS v4u*)(KS + qk_tok * QSTR + qk_d0) = pack8(o0); *(LAS v4u*)(KS + qk_tok * QSTR + qk_d0 + 24) = pack8(o1);
            if (mode != 0) {
                unpack8(rq0, a); unpack8(rq1, b2);
#pragma unroll
                for (int e = 0; e < 8; ++e) { o0[e] = (a[e] * cs[e] - b2[e] * sn[e]) * qs_t; o1[e] = (b2[e] * cs[e] + a[e] * sn[e]) * qs_t; }
                *(LAS v4u*)(QS + qk_tok * QSTR + qk_d0) = pack8(o0); *(LAS v4u*)(QS + qk_tok * QSTR + qk_d0 + 24) = pack8(o1);
            }
        } else { (void)__shfl(ksc, 0); (void)__shfl(qsc, 0); }
        *(LAS v4u*)(VS + v1_tok * VSTR + 8 * v1_pc) = rv1;
        if (hasv2) *(LAS v4u*)(VS + v2_tok * VSTR + 8 * v2_pc) = rv2;
        if (ci + 1 < jb.nchunk) issue_loads(ci + 1);
        __syncthreads();
        if (mode != 0) {
            const int tt = w & 3, jh = w >> 2;
            bf16x8 qf[3];
#pragma unroll
            for (int ks = 0; ks < 3; ++ks) qf[ks] = rm_frag(QS, QSTR, 16 * tt + c, 32 * ks + 8 * g);
            f32x4 st[4];
#pragma unroll
            for (int ss = 0; ss < 4; ++ss) { st[ss] = (f32x4){0.f, 0.f, 0.f, 0.f};
                if (ss <= tt) {
#pragma unroll
                    for (int ks = 0; ks < 3; ++ks) st[ss] = mfma16(rm_frag(KS, QSTR, 16 * ss + c, 32 * ks + 8 * g), qf[ks], st[ss]);
                    if (ss == tt) {
#pragma unroll
                        for (int r = 0; r < 4; ++r) if (4 * g + r > c) st[ss][r] = 0.f; }
                } }
            bf16x8 pf[2];
#pragma unroll
            for (int kk = 0; kk < 2; ++kk) { const unsigned u0 = pk2(st[2 * kk][0], st[2 * kk][1]), u1 = pk2(st[2 * kk][2], st[2 * kk][3]), u2 = pk2(st[2 * kk + 1][0], st[2 * kk + 1][1]), u3 = pk2(st[2 * kk + 1][2], st[2 * kk + 1][3]);
                pf[kk] = __builtin_bit_cast(bf16x8, (v4u){u0, u1, u2, u3}); }
#pragma unroll
            for (int ei = 0; ei < 4; ++ei) { const int et = 4 * jh + ei;
                if (et < 7) {
                    f32x4 acc = (f32x4){0.f, 0.f, 0.f, 0.f};
#pragma unroll
                    for (int kk = 0; kk < 2; ++kk) if (2 * kk <= tt) acc = mfma16(tr_frag(VS, VSTR, 32 * kk + 4 * g, 32 * kk + 16 + 4 * g, 16 * et, lane), pf[kk], acc);
#pragma unroll
                    for (int ks = 0; ks < 3; ++ks) acc = mfma16(rm_frag(CTc, QSTR, 16 * et + c, 32 * ks + 8 * g), qf[ks], acc);
                    if (et < 6) *(LAS f32x4*)(HT + (16 * tt + c) * 100 + 16 * et + 4 * g) = acc;
                    else if (g == 0) DEN[16 * tt + c] = acc[0];
                } }
        }
        if (w < 6) {
#pragma unroll
            for (int kk = 0; kk < 2; ++kk) { const bf16x8 af = tr_frag(KS, QSTR, 32 * kk + 8 * g, 32 * kk + 8 * g + 4, 16 * w, lane);
#pragma unroll
                for (int et = 0; et < 7; ++et) Cst[et] = mfma16(af, tr_frag(VS, VSTR, 32 * kk + 8 * g, 32 * kk + 8 * g + 4, 16 * et, lane), Cst[et]); }
#pragma unroll
            for (int et = 0; et < 7; ++et) { Cst[et] = Cst[et] * ebL;
                if (mode != 0) { v2u v; v.x = pk2(Cst[et][0], Cst[et][1]); v.y = pk2(Cst[et][2], Cst[et][3]); *(LAS v2u*)(CTn + (16 * et + c) * QSTR + 16 * w + 4 * g) = v; } }
        }
        Btot += bL;
        __syncthreads();
        if (mode != 0) {
            const int i = tid >> 3, sub = tid & 7, e0 = 12 * sub; const int m = rowbase + tok_of(ci, i);
            float hv[12]; const float rden = 1.f / fmaxf(fabsf(DEN[i]), 1.f);
#pragma unroll
            for (int q4 = 0; q4 < 3; ++q4) { const f32x4 v = *(const LAS f32x4*)(HT + i * 100 + e0 + 4 * q4); hv[4 * q4] = v[0] * rden; hv[4 * q4 + 1] = v[1] * rden; hv[4 * q4 + 2] = v[2] * rden; hv[4 * q4 + 3] = v[3] * rden; }
            bf16* tp = otmp + (size_t)m * 384 + h * 96 + e0;
            if (mode == 1) {
#pragma unroll
                for (int q4 = 0; q4 < 3; ++q4) { uint2 v; v.x = pk2(hv[4 * q4], hv[4 * q4 + 1]); v.y = pk2(hv[4 * q4 + 2], hv[4 * q4 + 3]); *(uint2*)(tp + 4 * q4) = v; }
            } else {
                float ss = 0.f;
#pragma unroll
                for (int q4 = 0; q4 < 3; ++q4) { const uint2 v = *(const uint2*)(tp + 4 * q4);
                    hv[4 * q4] += __uint_as_float(v.x << 16); hv[4 * q4 + 1] += __uint_as_float(v.x & 0xffff0000u); hv[4 * q4 + 2] += __uint_as_float(v.y << 16); hv[4 * q4 + 3] += __uint_as_float(v.y & 0xffff0000u); }
#pragma unroll
                for (int e = 0; e < 12; ++e) ss += hv[e] * hv[e];
                ss += __shfl_xor(ss, 1); ss += __shfl_xor(ss, 2); ss += __shfl_xor(ss, 4);
                const float rinv = 1.f / sqrtf(ss * (1.f / 96.f) + EPS);
                const bf16* pr = P + (size_t)m * PLD + h * 96 + e0; const float* gn = F.mlstm_gn + l * 384 + h * 96 + e0;
                bf16* yp = F.hxy + (size_t)m * 1024 + 256 + h * 96 + e0;
#pragma unroll
                for (int q4 = 0; q4 < 3; ++q4) { const uint2 ov = *(const uint2*)(pr + B_O + 4 * q4), zv = *(const uint2*)(pr + B_Z + 4 * q4);
                    const float og[4] = {__uint_as_float(ov.x << 16), __uint_as_float(ov.x & 0xffff0000u), __uint_as_float(ov.y << 16), __uint_as_float(ov.y & 0xffff0000u)};
                    const float zg[4] = {__uint_as_float(zv.x << 16), __uint_as_float(zv.x & 0xffff0000u), __uint_as_float(zv.y << 16), __uint_as_float(zv.y & 0xffff0000u)};
                    float o[4];
#pragma unroll
                    for (int e = 0; e < 4; ++e) o[e] = sigmoid_f(og[e]) * (hv[4 * q4 + e] * rinv * gn[4 * q4 + e]) * silu_f(zg[e]);
                    uint2 v; v.x = pk2(o[0], o[1]); v.y = pk2(o[2], o[3]); *(uint2*)(yp + 4 * q4) = v; }
            }
        }
    }
    if (emit_slot >= 0 && w < 6) {
        float* sl = STd + (size_t)emit_slot * ST_FLOATS;
#pragma unroll
        for (int et = 0; et < 7; ++et)
#pragma unroll
            for (int r = 0; r < 4; ++r) sl[(16 * w + 4 * g + r) * 112 + 16 * et + c] = Cst[et][r];
        if (w == 0 && lane == 0) sl[96 * 112] = Btot;
    }
    __syncthreads();
}
__device__ __forceinline__ void mlstm_load_rope(const Ctx& F, const float* rope_tab) {
    LAS f32x2* ROPE = (LAS f32x2*)(F.lds + ml::OFF_ROPE);
    for (int i = F.tid; i < 64 * 24; i += 512) ROPE[i] = ((const f32x2*)rope_tab)[i];
}
__device__ __forceinline__ void mlstm_itemA(const Ctx& F, int l, int bh, int it, bf16* otmp, float* ST) {
    const int b = bh >> 2, h = bh & 3;
    if (it == 0) {
        const MlJob jb{b, h, 1, 0, 4};
        mlstm_dir(F, l, jb, 0, -1, 0, l == 0 ? 1 : 0, otmp, ST);
        mlstm_dir(F, l, jb, 1, -1, 0, l == 0 ? 2 : 0, otmp, ST);
    } else {
        const int dir = (it - 1) / 7, k = (it - 1) % 7, seg = dir == 0 ? k : 7 - k;
        const MlJob jb{b, h, 0, 512 * seg, 8};
        mlstm_dir(F, l, jb, dir, -1, 1 + k, 0, otmp, ST);
    }
}
__device__ __forceinline__ void mlstm_itemC(const Ctx& F, int l, int bh, int seg, bf16* otmp, float* ST) {
    const MlJob jb{bh >> 2, bh & 3, 0, 512 * seg, 8};
    mlstm_dir(F, l, jb, 0, seg, -1, 1, otmp, ST);
    mlstm_dir(F, l, jb, 1, 7 - seg, -1, 2, otmp, ST);
}

namespace hg {
constexpr int STR = 72;
constexpr int IMG = 64 * STR * 2;
constexpr int OFF_KO = 0, OFF_KH = IMG, OFF_VS = 2 * IMG, OFF_QJ = 3 * IMG, OFF_ST = 7 * IMG, OFF_HT = 9 * IMG, OFF_TOT = OFF_HT + 64 * 68 * 4, OFF_BL = OFF_TOT + 8 * 64 * 4, OFF_END = OFF_BL + 512;
static_assert(OFF_END <= RING_BYTES, "hgrn LDS");
constexpr int ST_FLOATS = 64 * 64 + 64;
}
__device__ __forceinline__ void hgrn_dir(const Ctx& F, int l, const MlJob jb, int dir, int fold_r, int emit_slot, int mode, bf16* otmp, float* ST) {
    using namespace hg;
    int tid_ = F.tid; asm volatile("" : "+v"(tid_));
    const int tid = tid_, lane = tid & 63, w = __builtin_amdgcn_readfirstlane(tid >> 6), g = lane >> 4, c = lane & 15;
    LAS bf16* KO = (LAS bf16*)(F.lds + OFF_KO); LAS bf16* KH = (LAS bf16*)(F.lds + OFF_KH); LAS bf16* VS = (LAS bf16*)(F.lds + OFF_VS); LAS bf16* QJ = (LAS bf16*)(F.lds + OFF_QJ);
    LAS bf16* ST0 = (LAS bf16*)(F.lds + OFF_ST); LAS float* HT = (LAS float*)(F.lds + OFF_HT); LAS float* TOT = (LAS float*)(F.lds + OFF_TOT); LAS float* BL = (LAS float*)(F.lds + OFF_BL);
    const int rowbase = jb.isctx ? MX + jb.b * CTX : jb.b * S;
    const int h = jb.h; const bf16* P = F.P;
    float* STd = ST + (size_t)(((jb.b * 4 + h) * 2 + dir) * 8) * ST_FLOATS;
    const int dt = w >> 1, et0 = 2 * (w & 1);
    f32x4 Sst[2]; float Btot[4];
#pragma unroll
    for (int i = 0; i < 2; ++i) Sst[i] = (f32x4){0.f, 0.f, 0.f, 0.f};
#pragma unroll
    for (int r = 0; r < 4; ++r) Btot[r] = 0.f;
    if (fold_r >= 0) {
#pragma unroll
        for (int i = 0; i < 2; ++i)
#pragma unroll
            for (int r = 0; r < 4; ++r) Sst[i][r] = STd[(16 * dt + 4 * g + r) * 64 + 16 * (et0 + i) + c];
        for (int k = 1; k <= fold_r; ++k) {
            const float* sl = STd + (size_t)k * ST_FLOATS;
#pragma unroll
            for (int r = 0; r < 4; ++r) { const float dec = __expf(sl[64 * 64 + 16 * dt + 4 * g + r]);
#pragma unroll
                for (int i = 0; i < 2; ++i) Sst[i][r] = dec * Sst[i][r] + sl[(16 * dt + 4 * g + r) * 64 + 16 * (et0 + i) + c]; }
        }
    }
    if (mode != 0) {
#pragma unroll
        for (int i = 0; i < 2; ++i) { v2u v; v.x = pk2(Sst[i][0], Sst[i][1]); v.y = pk2(Sst[i][2], Sst[i][3]); *(LAS v2u*)(ST0 + (16 * (et0 + i) + c) * STR + 16 * dt + 4 * g) = v; }
    }
    const int ps = tid >> 3, oct = tid & 7, d0 = 8 * oct;
    float lbv[8];
#pragma unroll
    for (int e = 0; e < 8; ++e) { lbv[e] = 0.f;
        if (l == 1) { const float v0 = F.hgrn_lb[(0 * 2 + dir) * 256 + h * 64 + d0 + e], v1 = F.hgrn_lb[(1 * 2 + dir) * 256 + h * 64 + d0 + e]; lbv[e] = 1.f / (1.f + expf(v0 - v1)); } }
    const int fcol = dir ? A_FB : A_FF;
    auto tok_of = [&](int ci, int i) -> int { return dir == 0 ? jb.t0 + 64 * ci + i : jb.t0 + 64 * (jb.nchunk - 1 - ci) + (63 - i); };
    v4u rq, rf, rv; rq = rf = rv = (v4u){0u, 0u, 0u, 0u};
    auto issue_loads = [&](int ci) {
        const bf16* pr = P + (size_t)(rowbase + tok_of(ci, ps)) * PLD + h * 64 + d0;
        if (mode != 0) rq = *(const v4u*)(pr + A_Q);
        rf = *(const v4u*)(pr + fcol); rv = *(const v4u*)(pr + A_I);
    };
    issue_loads(0);
    __syncthreads();
    for (int ci = 0; ci < jb.nchunk; ++ci) {
        LAS bf16* STc = ST0 + (ci & 1) * 64 * STR; LAS bf16* STn = ST0 + ((ci + 1) & 1) * 64 * STR;
        float qv[8], kk[8], bb[8], fl[8];
        unpack8(rf, fl);
#pragma unroll
        for (int e = 0; e < 8; ++e) { const float sg = sigmoid_f(fl[e]); const float f = lbv[e] + (1.f - lbv[e]) * sg; bb[e] = __logf(f); kk[e] = (1.f - lbv[e]) * (1.f - sg); }
        if (mode != 0) { unpack8(rq, qv);
#pragma unroll
            for (int e = 0; e < 8; ++e) qv[e] = silu_f(qv[e]) * 0.125f; }
        const v4u vraw = rv;
        if (ci + 1 < jb.nchunk) issue_loads(ci + 1);
#pragma unroll
        for (int o = 8; o < 64; o <<= 1) {
#pragma unroll
            for (int e = 0; e < 8; ++e) { const float t = __shfl_up(bb[e], o); if (lane >= o) bb[e] += t; } }
        if (lane >= 56) { *(LAS f32x4*)(TOT + w * 64 + d0) = (f32x4){bb[0], bb[1], bb[2], bb[3]}; *(LAS f32x4*)(TOT + w * 64 + d0 + 4) = (f32x4){bb[4], bb[5], bb[6], bb[7]}; }
        __syncthreads();
        {
            float run[8], pre[8], ref1[8], ref2[8], ref3[8];
#pragma unroll
            for (int e = 0; e < 8; ++e) { run[e] = 0.f; pre[e] = 0.f; ref1[e] = ref2[e] = ref3[e] = 0.f; }
#pragma unroll
            for (int ww = 0; ww < 8; ++ww) {
                if (ww == w) {
#pragma unroll
                    for (int e = 0; e < 8; ++e) pre[e] = run[e]; }
                if (ww == 2) {
#pragma unroll
                    for (int e = 0; e < 8; ++e) ref1[e] = run[e]; }
                if (ww == 4) {
#pragma unroll
                    for (int e = 0; e < 8; ++e) ref2[e] = run[e]; }
                if (ww == 6) {
#pragma unroll
                    for (int e = 0; e < 8; ++e) ref3[e] = run[e]; }
                const f32x4 t0 = *(const LAS f32x4*)(TOT + ww * 64 + d0), t1 = *(const LAS f32x4*)(TOT + ww * 64 + d0 + 4);
                run[0] += t0[0]; run[1] += t0[1]; run[2] += t0[2]; run[3] += t0[3]; run[4] += t1[0]; run[5] += t1[1]; run[6] += t1[2]; run[7] += t1[3];
            }
            const int sub = ps >> 4;
            float o8[8];
#pragma unroll
            for (int e = 0; e < 8; ++e) bb[e] += pre[e];
#pragma unroll
            for (int e = 0; e < 8; ++e) { const float rown = sub == 0 ? 0.f : (sub == 1 ? ref1[e] : (sub == 2 ? ref2[e] : ref3[e])); o8[e] = kk[e] * __expf(rown - bb[e]); }
            if (mode != 0) *(LAS v4u*)(KO + ps * STR + d0) = pack8(o8);
#pragma unroll
            for (int e = 0; e < 8; ++e) o8[e] = kk[e] * __expf(run[e] - bb[e]);
            *(LAS v4u*)(KH + ps * STR + d0) = pack8(o8);
            *(LAS v4u*)(VS + ps * STR + d0) = vraw;
            if (mode != 0) {
#pragma unroll
                for (int e = 0; e < 8; ++e) o8[e] = qv[e] * __expf(bb[e]);
                *(LAS v4u*)(QJ + ps * STR + d0) = pack8(o8);
                if (sub >= 1) {
#pragma unroll
                    for (int e = 0; e < 8; ++e) o8[e] = qv[e] * __expf(bb[e] - ref1[e]);
                    *(LAS v4u*)(QJ + (64 + ps) * STR + d0) = pack8(o8); }
                if (sub >= 2) {
#pragma unroll
                    for (int e = 0; e < 8; ++e) o8[e] = qv[e] * __expf(bb[e] - ref2[e]);
                    *(LAS v4u*)(QJ + (128 + ps) * STR + d0) = pack8(o8); }
                if (sub >= 3) {
#pragma unroll
                    for (int e = 0; e < 8; ++e) o8[e] = qv[e] * __expf(bb[e] - ref3[e]);
                    *(LAS v4u*)(QJ + (192 + ps) * STR + d0) = pack8(o8); }
            }
            if (ps == 0) { *(LAS f32x4*)(BL + d0) = (f32x4){run[0], run[1], run[2], run[3]}; *(LAS f32x4*)(BL + d0 + 4) = (f32x4){run[4], run[5], run[6], run[7]}; }
        }
        __syncthreads();
        if (mode != 0) {
            const int tt = w & 3, eh = w >> 2;
            f32x4 at[4];
#pragma unroll
            for (int j = 0; j < 4; ++j) { at[j] = (f32x4){0.f, 0.f, 0.f, 0.f};
                if (j <= tt) {
#pragma unroll
                    for (int ks = 0; ks < 2; ++ks) at[j] = mfma16(rm_frag(KO, STR, 16 * j + c, 32 * ks + 8 * g), rm_frag(QJ + j * 64 * STR, STR, 16 * tt + c, 32 * ks + 8 * g), at[j]);
                    if (j == tt) {
#pragma unroll
                        for (int r = 0; r < 4; ++r) if (4 * g + r > c) at[j][r] = 0.f; }
                } }
            bf16x8 pf[2];
#pragma unroll
            for (int k2 = 0; k2 < 2; ++k2) { const unsigned u0 = pk2(at[2 * k2][0], at[2 * k2][1]), u1 = pk2(at[2 * k2][2], at[2 * k2][3]), u2 = pk2(at[2 * k2 + 1][0], at[2 * k2 + 1][1]), u3 = pk2(at[2 * k2 + 1][2], at[2 * k2 + 1][3]);
                pf[k2] = __builtin_bit_cast(bf16x8, (v4u){u0, u1, u2, u3}); }
            bf16x8 qf[2];
#pragma unroll
            for (int ks = 0; ks < 2; ++ks) qf[ks] = rm_frag(QJ, STR, 16 * tt + c, 32 * ks + 8 * g);
#pragma unroll
            for (int ei = 0; ei < 2; ++ei) { const int et = 2 * eh + ei;
                f32x4 acc = (f32x4){0.f, 0.f, 0.f, 0.f};
#pragma unroll
                for (int k2 = 0; k2 < 2; ++k2) if (2 * k2 <= tt) acc = mfma16(tr_frag(VS, STR, 32 * k2 + 4 * g, 32 * k2 + 16 + 4 * g, 16 * et, lane), pf[k2], acc);
#pragma unroll
                for (int ks = 0; ks < 2; ++ks) acc = mfma16(rm_frag(STc, STR, 16 * et + c, 32 * ks + 8 * g), qf[ks], acc);
                *(LAS f32x4*)(HT + (16 * tt + c) * 68 + 16 * et + 4 * g) = acc; }
        }
        {
            const f32x4 blv = *(const LAS f32x4*)(BL + 16 * dt + 4 * g);
#pragma unroll
            for (int r = 0; r < 4; ++r) { const float dec = __expf(blv[r]); Sst[0][r] *= dec; Sst[1][r] *= dec; Btot[r] += blv[r]; }
#pragma unroll
            for (int k2 = 0; k2 < 2; ++k2) { const bf16x8 af = tr_frag(KH, STR, 32 * k2 + 8 * g, 32 * k2 + 8 * g + 4, 16 * dt, lane);
#pragma unroll
                for (int i = 0; i < 2; ++i) Sst[i] = mfma16(af, tr_frag(VS, STR, 32 * k2 + 8 * g, 32 * k2 + 8 * g + 4, 16 * (et0 + i), lane), Sst[i]); }
            if (mode != 0) {
#pragma unroll
                for (int i = 0; i < 2; ++i) { v2u v; v.x = pk2(Sst[i][0], Sst[i][1]); v.y = pk2(Sst[i][2], Sst[i][3]); *(LAS v2u*)(STn + (16 * (et0 + i) + c) * STR + 16 * dt + 4 * g) = v; } }
        }
        __syncthreads();
        if (mode != 0) {
            const int i = tid >> 3, sub8 = tid & 7, e0 = 8 * sub8; const int m = rowbase + tok_of(ci, i);
            float hv[8];
            { const f32x4 a0 = *(const LAS f32x4*)(HT + i * 68 + e0), a1 = *(const LAS f32x4*)(HT + i * 68 + e0 + 4); hv[0] = a0[0]; hv[1] = a0[1]; hv[2] = a0[2]; hv[3] = a0[3]; hv[4] = a1[0]; hv[5] = a1[1]; hv[6] = a1[2]; hv[7] = a1[3]; }
            bf16* tp = otmp + (size_t)m * 256 + h * 64 + e0;
            if (mode == 1) *(v4u*)tp = pack8(hv);
            else {
                float tv[8]; unpack8(*(const v4u*)tp, tv);
                float ss = 0.f;
#pragma unroll
                for (int e = 0; e < 8; ++e) { hv[e] += tv[e]; ss += hv[e] * hv[e]; }
                ss += __shfl_xor(ss, 1); ss += __shfl_xor(ss, 2); ss += __shfl_xor(ss, 4);
                const float rinv = 1.f / sqrtf(ss * (1.f / 64.f) + EPS);
                float zv[8]; unpack8(*(const v4u*)(P + (size_t)m * PLD + A_Z + h * 64 + e0), zv);
                const float* gn = F.hgrn_gn + l * 256 + h * 64 + e0;
#pragma unroll
                for (int e = 0; e < 8; ++e) hv[e] = hv[e] * rinv * gn[e] * silu_f(zv[e]);
                *(v4u*)(F.hxy + (size_t)m * 1024 + h * 64 + e0) = pack8(hv);
            }
        }
    }
    if (emit_slot >= 0) {
        float* sl = STd + (size_t)emit_slot * ST_FLOATS;
#pragma unroll
        for (int i = 0; i < 2; ++i)
#pragma unroll
            for (int r = 0; r < 4; ++r) sl[(16 * dt + 4 * g + r) * 64 + 16 * (et0 + i) + c] = Sst[i][r];
        if ((w & 1) == 0 && c == 0) {
#pragma unroll
            for (int r = 0; r < 4; ++r) sl[64 * 64 + 16 * dt + 4 * g + r] = Btot[r]; }
    }
    __syncthreads();
}
__device__ __forceinline__ void hgrn_itemA(const Ctx& F, int l, int bh, int it, bf16* otmp, float* ST) {
    const int b = bh >> 2, h = bh & 3;
    if (it == 0) {
        const MlJob jb{b, h, 1, 0, 4};
        hgrn_dir(F, l, jb, 0, -1, 0, l == 0 ? 1 : 0, otmp, ST);
        hgrn_dir(F, l, jb, 1, -1, 0, l == 0 ? 2 : 0, otmp, ST);
    } else {
        const int dir = (it - 1) / 7, k = (it - 1) % 7, seg = dir == 0 ? k : 7 - k;
        const MlJob jb{b, h, 0, 512 * seg, 8};
        hgrn_dir(F, l, jb, dir, -1, 1 + k, 0, otmp, ST);
    }
}
__device__ __forceinline__ void hgrn_itemC(const Ctx& F, int l, int bh, int seg, bf16* otmp, float* ST) {
    const MlJob jb{bh >> 2, bh & 3, 0, 512 * seg, 8};
    hgrn_dir(F, l, jb, 0, seg, -1, 1, otmp, ST);
    hgrn_dir(F, l, jb, 1, 7 - seg, -1, 2, otmp, ST);
}

__device__ __forceinline__ void phase_mixA(const Ctx& F, int l) {
    mlstm_load_rope(F, F.rope);
    for (int it = F.vcu; it < 2 * 32 * 15; it += F.G) {
        if (it < 32 * 15) mlstm_itemA(F, l, it / 15, it % 15, F.otm, F.stm);
        else { const int i2 = it - 32 * 15; hgrn_itemA(F, l, i2 / 15, i2 % 15, F.oth, F.sth); }
    }
    const int nitems = MX * 6 + (l == 0 ? MC * 6 : 0);
    for (int idx = (F.G * 512 - 1) - (F.vcu * 512 + F.tid); idx < nitems; idx += F.G * 512) na_naive_item(F, l, idx);
}
__device__ __forceinline__ void phase_mixC(const Ctx& F, int l) {
    mlstm_load_rope(F, F.rope);
    for (int it = F.vcu; it < 512; it += F.G) {
        if (it < 256) mlstm_itemC(F, l, it >> 3, it & 7, F.otm, F.stm);
        else hgrn_itemC(F, l, (it - 256) >> 3, it & 7, F.oth, F.sth);
    }
}

constexpr int NPH = 12;
struct Args { const float* in[15]; float* out; unsigned char* ws; int ph_lo, ph_hi; };
__global__ void __launch_bounds__(512, 2) mega_fwd(Args args) {
    extern __shared__ __attribute__((aligned(16))) unsigned char lds[];
    Ctx F;
    F.lds = (LAS unsigned char*)lds;
    F.tid = threadIdx.x; F.lane = F.tid & 63; F.wave = __builtin_amdgcn_readfirstlane(F.tid >> 6);
    F.G = gridDim.x; { const int bx = blockIdx.x; F.vcu = (F.G % 8 == 0) ? (bx % 8) * (F.G / 8) + bx / 8 : bx; }
    F.gw = F.vcu * 8 + F.wave; F.NGW = F.G * 8;
    unsigned char* ws = args.ws;
    F.x = args.in[0]; F.c = args.in[1]; F.ctx = args.in[2]; F.c_ctx = args.in[3]; F.w_mod = args.in[4]; F.b_mod = args.in[5]; F.g_pre = args.in[6]; F.g_post = args.in[7];
    F.w_in = args.in[8]; F.w_out = args.in[9]; F.hgrn_lb = args.in[10]; F.hgrn_gn = args.in[11]; F.gate_b = args.in[12]; F.mlstm_gn = args.in[13]; F.na_rpb = args.in[14];
    F.out = args.out;
    F.wt_in = (bf16*)(ws + WS_WT_IN); F.wt_out = (bf16*)(ws + WS_WT_OUT); F.mod = (float*)(ws + WS_MOD); F.gates = (float*)(ws + WS_GATES); F.ctx1 = (float*)(ws + WS_CTX1);
    F.hxy = (bf16*)(ws + WS_HXY); F.P = (bf16*)(ws + WS_P); F.UX = (float*)(ws + WS_P); F.oth = (bf16*)(ws + WS_OH); F.sth = (float*)(ws + WS_STH); F.otm = (bf16*)(ws + WS_OM); F.stm = (float*)(ws + WS_STM); F.rope = (float*)(ws + WS_ROPE);
    for (int u = F.tid; u < (LDS_BYTES - LDSCTL_OFF) / 4; u += 512) ((LAS unsigned*)(F.lds + LDSCTL_OFF))[u] = 0u;
    __syncthreads();
    XcdBarrier bar = xcd_barrier_post((unsigned*)(ws + WS_CTL) + CW_BAR, (volatile LAS unsigned*)(F.lds + MISC_OFF) + 8);

    const int lo = args.ph_lo, hi = args.ph_hi;
#define IN(k) (lo <= (k) && (k) < hi)
#define SEAM(k) do { if ((k) + 1 < hi) xcd_barrier(bar); } while (0)
    if (IN(0)) { phase_p0(F); SEAM(0); }
    if (IN(1)) { phase_prenorm0(F); SEAM(1); }
#define LAYER(l) \
    if (IN(2 + 5 * (l))) { \
        pg8::Gemm g{F.hxy, F.wt_in + (size_t)(l) * NPAD * 1024, M, NPAD, 1024}; pg8::StaticOrder SO; SO.init(M, NPAD, F.G, (int)blockIdx.x); \
        pg8::EpiIn E{F.P, F.gates, F.gate_b + (l) * 16}; \
        pg8::gemm_phase<pg8::EpiIn, pg8::StaticOrder, true, true>(F.lds + RING_OFF, g, SO, E); SEAM(2 + 5 * (l)); } \
    if (IN(3 + 5 * (l))) { phase_mixA(F, (l)); SEAM(3 + 5 * (l)); } \
    if (IN(4 + 5 * (l))) { phase_mixC(F, (l)); SEAM(4 + 5 * (l)); } \
    if (IN(5 + 5 * (l))) { \
        constexpr int Ml = (l) == 0 ? M : MX; \
        pg8::Gemm g{F.hxy, F.wt_out + (size_t)(l) * 1024 * 1024, Ml, 1024, 1024}; pg8::StaticOrder SO; SO.init(Ml, 1024, F.G, (int)blockIdx.x); \
        pg8::EpiOut E{F.UX}; \
        pg8::gemm_phase<pg8::EpiOut, pg8::StaticOrder, true, true>(F.lds + RING_OFF, g, SO, E); SEAM(5 + 5 * (l)); } \
    if (IN(6 + 5 * (l))) { phase_post(F, (l)); SEAM(6 + 5 * (l)); }
    LAYER(0)
    LAYER(1)
#undef LAYER
#undef IN
#undef SEAM
}

extern "C" void kernel_launch(void* const* d_in, const int* in_sizes, int n_in, void* d_out, int out_size, void* d_ws, size_t ws_size, hipStream_t stream) {
    static int grid = 0;
    if (grid == 0) {
        if (n_in != 15 || ws_size < WS_END) { fprintf(stderr, "kernel_launch: unexpected n_in %d / ws_size %zu (need %zu); nothing launched\n", n_in, ws_size, (size_t)WS_END); grid = -1; return; }
        int dev = 0, cus = 0, per_cu = 0;
        if (hipGetDevice(&dev) != hipSuccess || hipDeviceGetAttribute(&cus, hipDeviceAttributeMultiprocessorCount, dev) != hipSuccess) { grid = -1; return; }
        if (hipFuncSetAttribute((const void*)mega_fwd, hipFuncAttributeMaxDynamicSharedMemorySize, LDS_BYTES) != hipSuccess) { fprintf(stderr, "kernel_launch: hipFuncSetAttribute failed\n"); grid = -1; return; }
        if (hipOccupancyMaxActiveBlocksPerMultiprocessor(&per_cu, (const void*)mega_fwd, 512, LDS_BYTES) != hipSuccess || per_cu < 1) { fprintf(stderr, "kernel_launch: occupancy query says %d blocks/CU\n", per_cu); (void)hipGetLastError(); grid = -1; return; }
        grid = cus;
    }
    if (grid < 0) return;
    (void)hipMemsetAsync((char*)d_ws + WS_CTL, 0, CTL_BYTES, stream);
    Args a{};
    for (int i = 0; i < 15; ++i) a.in[i] = (const float*)d_in[i];
    a.out = (float*)d_out; a.ws = (unsigned char*)d_ws; a.ph_lo = 0; a.ph_hi = NPH;
    hipLaunchKernelGGL(mega_fwd, dim3(grid), dim3(512), LDS_BYTES, stream, a);
}
```

```cpp
#include <hip/hip_runtime.h>
#include <stdint.h>
#include <cstdio>

namespace cfg {
constexpr int D = 1024, NB = 8, S = 4096, CTX = 256;
constexpr int MX = NB * S, MC = NB * CTX, M = MX + MC;
constexpr int PIN = 4752, NPAD = 4864, PLD = 4736;
constexpr int A_Q = 0, A_FF = 256, A_FB = 512, A_I = 768, A_Z = 1024, B_Q = 1280, B_K = 1664, B_V = 2048, B_O = 2432, B_Z = 2816,
              C_Q = 3200, C_K = 3584, C_V = 3968, C_Z = 4352;
constexpr float EPS = 1e-6f;
constexpr size_t WS_CTL = 0, CTL_BYTES = 65536;
constexpr size_t WS_WT_IN = WS_CTL + CTL_BYTES;
constexpr size_t WS_WT_OUT = WS_WT_IN + 2ull * NPAD * 1024 * 2;
constexpr size_t WS_MOD = WS_WT_OUT + 2ull * 1024 * 1024 * 2;
constexpr size_t WS_GATES = WS_MOD + 2ull * 9 * 3072 * 4;
constexpr size_t WS_CTX1 = WS_GATES + (size_t)M * 16 * 4;
constexpr size_t WS_HXY = WS_CTX1 + (size_t)MC * 1024 * 4;
constexpr size_t WS_P = WS_HXY + (size_t)M * 1024 * 2;
constexpr size_t WS_OH = WS_P + (size_t)M * PLD * 2;
constexpr size_t WS_OM = WS_OH + (size_t)M * 256 * 4;
constexpr size_t WS_STM = WS_OM + (size_t)M * 384 * 2;
constexpr size_t WS_ROPE = WS_STM + 32ull * 2 * 8 * (96 * 112 + 16) * 4;
constexpr size_t WS_STH = WS_ROPE + 64 * 24 * 8;
constexpr size_t WS_END = WS_STH + 32ull * 2 * 8 * (64 * 64 + 64) * 4;
static_assert(WS_END <= 536870912ull, "workspace");
static_assert(WS_WT_IN % 256 == 0 && WS_MOD % 256 == 0 && WS_GATES % 256 == 0 && WS_CTX1 % 256 == 0 && WS_HXY % 256 == 0 && WS_P % 256 == 0 && WS_OH % 256 == 0 && WS_OM % 256 == 0 && WS_STM % 256 == 0 && WS_ROPE % 256 == 0 && WS_STH % 256 == 0, "align");
}
using namespace cfg;

namespace pg8 {
#define PG8_LAS __attribute__((address_space(3)))
typedef unsigned short bf16_t;
typedef short bf16x8 __attribute__((ext_vector_type(8)));
typedef float f32x4 __attribute__((ext_vector_type(4)));
typedef unsigned u32x4 __attribute__((ext_vector_type(4)));
constexpr int BM = 256, BK = 64, HALF = 128, HTB = HALF * BK * 2  , STAGE_BYTES = 8 * HTB, NXCD = 8, WGM = 8;

__host__ __device__ __forceinline__ int lds_byte(int r, int c) { const int st = (r >> 4) * 2 + (c >> 5), rr = r & 15, cc = c & 31, ob = rr * 64 + cc * 2; return st * 1024 + (ob ^ (((ob >> 9) & 1) << 5)); }
__host__ __device__ __forceinline__ void stage_rc(int b, int& R, int& C) { const int st = b / 1024, sb = b % 1024, swz = sb ^ (((sb >> 9) & 1) << 5); R = (st >> 1) * 16 + swz / 64; C = (st & 1) * 32 + (swz % 64) / 2; }
__host__ __device__ __forceinline__ int perm32(int rho) { const int n = rho >> 4, i = rho & 15; return 8 * (i >> 2) + 4 * n + (i & 3); }

struct Unit { int pm, pn; };
struct Gemm { const bf16_t* A; const bf16_t* Bt; int M, N, K; };

struct StaticOrder {
    int nM, nN, nwg, G, c;
    __host__ __device__ void init(int M, int N, int G_, int c_) { nM = M / BM; nN = N / BM; nwg = nM * nN; G = G_; c = c_; }
    __host__ __device__ bool next(int i, Unit& u) const {
        const long L = (long)i * G + c; if (L >= nwg) return false;
        int wgid = (int)L; { const int q = nwg / NXCD, r = nwg % NXCD, xcd = wgid % NXCD, off = wgid / NXCD; wgid = (xcd < r ? xcd * (q + 1) : r * (q + 1) + (xcd - r) * q) + off; }
        const int nig = WGM * nN, gid = wgid / nig, fm = gid * WGM, gsz = (nM - fm) < WGM ? (nM - fm) : WGM;
        u.pm = fm + ((wgid % nig) % gsz); u.pn = (wgid % nig) / gsz; return true;
    }
    __device__ __forceinline__ void a_ready(const Unit&) const {}
    __device__ __forceinline__ void done(const Unit&) const {}
};

__device__ __forceinline__ unsigned cvt_pk_bf16(float lo, float hi) { unsigned r; asm volatile("v_cvt_pk_bf16_f32 %0, %1, %2" : "=v"(r) : "v"(lo), "v"(hi)); return r; }
__device__ __forceinline__ float logsigmoid_e(float v) { return fminf(v, 0.f) - log1pf(__expf(-fabsf(v))); }

struct EpiIn {
    static constexpr bool PERM = true, AFTER_DRAIN = false;
    bf16_t* P; float* gates; const float* gate_b;
    __device__ __forceinline__ void operator()(const f32x4 (&acc)[2][2][4][2], const Unit& u, int wr, int wc, int fr, int fq) const {
        const int row0 = u.pm * BM + wr * 64 + fr, col0 = u.pn * BM + wc * 32 + 8 * fq;
#pragma unroll
        for (int bj = 0; bj < 2; ++bj) {
            const int col = col0 + bj * HALF;
            if (col < cfg::PLD) {
#pragma unroll
                for (int ai = 0; ai < 2; ++ai)
#pragma unroll
                    for (int m = 0; m < 4; ++m) { const f32x4 v0 = acc[ai][bj][m][0], v1 = acc[ai][bj][m][1];
                        u32x4 w; w.x = cvt_pk_bf16(v0[0], v0[1]); w.y = cvt_pk_bf16(v0[2], v0[3]); w.z = cvt_pk_bf16(v1[0], v1[1]); w.w = cvt_pk_bf16(v1[2], v1[3]);
                        *(u32x4*)(P + (size_t)(row0 + ai * HALF + m * 16) * cfg::PLD + col) = w; }
            } else if (col < cfg::PIN) {
                const int g0 = col - cfg::PLD;
                const f32x4 b0 = *(const f32x4*)(gate_b + g0), b1 = *(const f32x4*)(gate_b + g0 + 4);
#pragma unroll
                for (int ai = 0; ai < 2; ++ai)
#pragma unroll
                    for (int m = 0; m < 4; ++m) { f32x4 v0 = acc[ai][bj][m][0] + b0, v1 = acc[ai][bj][m][1] + b1;
                        if (g0 >= 8) {
#pragma unroll
                            for (int e = 0; e < 4; ++e) { v0[e] = logsigmoid_e(v0[e]); v1[e] = logsigmoid_e(v1[e]); } }
                        float* gp = gates + (size_t)(row0 + ai * HALF + m * 16) * 16 + g0;
                        *(f32x4*)gp = v0; *(f32x4*)(gp + 4) = v1; }
            }
        }
    }
};
struct EpiOut {
    static constexpr bool PERM = false, AFTER_DRAIN = false;
    float* C;
    __device__ __forceinline__ void operator()(const f32x4 (&acc)[2][2][4][2], const Unit& u, int wr, int wc, int fr, int fq) const {
        const int row0 = u.pm * BM + wr * 64 + fr, col0 = u.pn * BM + wc * 32 + 4 * fq;
#pragma unroll
        for (int ai = 0; ai < 2; ++ai)
#pragma unroll
            for (int m = 0; m < 4; ++m) { float* rowp = C + (size_t)(row0 + ai * HALF + m * 16) * 1024 + col0;
#pragma unroll
                for (int bj = 0; bj < 2; ++bj)
#pragma unroll
                    for (int n = 0; n < 2; ++n) *(f32x4*)(rowp + bj * HALF + n * 16) = acc[ai][bj][m][n]; }
    }
};

template <class Epi, class Sched, bool ALIGN_EPI = false, bool SP2 = false>
__device__ __forceinline__ void gemm_phase(PG8_LAS unsigned char* lds, const Gemm g, const Sched& S, const Epi& E) {
    const int tid = threadIdx.x, wid = __builtin_amdgcn_readfirstlane(tid >> 6), lane = tid & 63, wr = wid >> 2, wc = wid & 3, fr = lane & 15, fq = lane >> 4;
    const int K = g.K, nt = K / BK;
    unsigned voffA[2], voffB[2];
#pragma unroll
    for (int i = 0; i < 2; ++i) { int R, C; stage_rc(tid * 16 + i * 8192, R, C); const int Rb = Epi::PERM ? ((R & ~31) + perm32(R & 31)) : R;
        voffA[i] = (unsigned)(R * K + C) * 2u; voffB[i] = (unsigned)(Rb * K + C) * 2u; }
    const size_t kstep = (size_t)(BK * 2);
    const size_t hstep = (size_t)HALF * K * 2;
    const size_t tstep = 2 * hstep;
    const unsigned ldsw = (unsigned)wid * 1024u;
    const int aoff = lds_byte(wr * 64 + fr, fq * 8), boff = lds_byte(wc * 32 + fr, fq * 8);
#define PG8_SA(b, h) (((b) * 2 + (h)) * HTB)
#define PG8_SB(b, h) ((4 + (b) * 2 + (h)) * HTB)
#define PG8_STAGE(bufoff, gbase, voff) do { _Pragma("unroll") for (int _i = 0; _i < 2; ++_i) \
        __builtin_amdgcn_global_load_lds((const unsigned*)((const char*)(gbase) + (voff)[_i]), (PG8_LAS unsigned*)(lds + (bufoff) + ldsw + _i * 8192), 16, 0, 0); } while (0)
#define PG8_LDA(dst, b, h) do { _Pragma("unroll") for (int m = 0; m < 4; ++m) _Pragma("unroll") for (int k = 0; k < 2; ++k) dst[m][k] = *(const PG8_LAS bf16x8*)(lds + PG8_SA(b, h) + aoff + m * 2048 + k * 1024); } while (0)
#define PG8_LDB(dst, b, h) do { _Pragma("unroll") for (int n = 0; n < 2; ++n) _Pragma("unroll") for (int k = 0; k < 2; ++k) dst[n][k] = *(const PG8_LAS bf16x8*)(lds + PG8_SB(b, h) + boff + n * 2048 + k * 1024); } while (0)
#define PG8_MMA(ai, bj, At, Bt) do { __builtin_amdgcn_s_setprio(1); _Pragma("unroll") for (int m = 0; m < 4; ++m) _Pragma("unroll") for (int n = 0; n < 2; ++n) _Pragma("unroll") for (int k = 0; k < 2; ++k) \
        acc[ai][bj][m][n] = __builtin_amdgcn_mfma_f32_16x16x32_bf16(Bt[n][k], At[m][k], acc[ai][bj][m][n], 0, 0, 0); __builtin_amdgcn_s_setprio(0); } while (0)
#define PG8_WAIT_V(n) asm volatile("s_waitcnt vmcnt(" #n ")" ::: "memory")
#define PG8_WAIT_L(n) asm volatile("s_waitcnt lgkmcnt(" #n ")" ::: "memory")
#define PG8_BAR __builtin_amdgcn_s_barrier()
#define PG8_SCHED __builtin_amdgcn_sched_barrier(0)
    Unit cur, nxt; int ui = 0;
    if (!S.next(0, cur)) return;
    f32x4 acc[2][2][4][2];
#pragma unroll
    for (int a = 0; a < 2; ++a)
#pragma unroll
        for (int b = 0; b < 2; ++b)
#pragma unroll
            for (int m = 0; m < 4; ++m)
#pragma unroll
                for (int n = 0; n < 2; ++n) acc[a][b][m][n] = (f32x4){0.f, 0.f, 0.f, 0.f};
    bf16x8 At[4][2], B0[2][2], B1[2][2];
    const char* cA = (const char*)g.A + (size_t)cur.pm * tstep; const char* cB = (const char*)g.Bt + (size_t)cur.pn * tstep;
    S.a_ready(cur);
    if constexpr (SP2) {
        PG8_STAGE(PG8_SB(0, 0), cB, voffB); PG8_STAGE(PG8_SB(0, 1), cB + hstep, voffB); PG8_STAGE(PG8_SA(0, 0), cA, voffA); PG8_STAGE(PG8_SA(0, 1), cA + hstep, voffA);
        if (wr == 1) PG8_BAR;
        PG8_WAIT_V(2); PG8_BAR;
        PG8_STAGE(PG8_SB(1, 0), cB + kstep, voffB); PG8_STAGE(PG8_SA(1, 0), cA + kstep, voffA); PG8_STAGE(PG8_SB(1, 1), cB + hstep + kstep, voffB);
        PG8_WAIT_V(6); PG8_BAR;
    } else {
        PG8_STAGE(PG8_SB(0, 0), cB, voffB); PG8_STAGE(PG8_SA(0, 0), cA, voffA); PG8_STAGE(PG8_SB(0, 1), cB + hstep, voffB); PG8_STAGE(PG8_SA(0, 1), cA + hstep, voffA);
        if (wr == 1) PG8_BAR;
        PG8_WAIT_V(4); PG8_BAR;
        PG8_STAGE(PG8_SB(1, 0), cB + kstep, voffB); PG8_STAGE(PG8_SA(1, 0), cA + kstep, voffA); PG8_STAGE(PG8_SB(1, 1), cB + hstep + kstep, voffB);
        PG8_WAIT_V(6); PG8_BAR;
    }
    for (;;) {
        const bool has_next = S.next(ui + 1, nxt);
        const char* nA = has_next ? (const char*)g.A + (size_t)nxt.pm * tstep : cA; const char* nB = has_next ? (const char*)g.Bt + (size_t)nxt.pn * tstep : cB;
        for (int t = 0; t < nt; t += 2) {
            const bool last = (t == nt - 2);
            const char* a1 = cA + (size_t)(t + 1) * kstep;
            const char* a2 = last ? nA : cA + (size_t)(t + 2) * kstep; const char* b2 = last ? nB : cB + (size_t)(t + 2) * kstep;
            const char* a3 = a2 + kstep; const char* b3 = b2 + kstep;
            if (last && has_next) S.a_ready(nxt);
            if constexpr (SP2) {
            PG8_LDB(B0, 0, 0); PG8_LDB(B1, 0, 1); PG8_SCHED; PG8_LDA(At, 0, 0); PG8_STAGE(PG8_SA(1, 1), a1 + hstep, voffA);
            PG8_WAIT_V(8); PG8_WAIT_L(0); PG8_BAR; PG8_MMA(0, 0, At, B0); PG8_MMA(0, 1, At, B1); PG8_BAR; PG8_SCHED;
            PG8_LDA(At, 0, 1); PG8_STAGE(PG8_SB(0, 0), b2, voffB); PG8_STAGE(PG8_SB(0, 1), b2 + hstep, voffB); PG8_STAGE(PG8_SA(0, 0), a2, voffA);
            PG8_WAIT_V(8); PG8_WAIT_L(0); PG8_BAR; PG8_MMA(1, 0, At, B0); PG8_MMA(1, 1, At, B1); PG8_BAR; PG8_SCHED;
            PG8_LDB(B0, 1, 0); PG8_LDB(B1, 1, 1); PG8_SCHED; PG8_LDA(At, 1, 0); PG8_STAGE(PG8_SA(0, 1), a2 + hstep, voffA);
            PG8_WAIT_V(8); PG8_WAIT_L(0); PG8_BAR; PG8_MMA(0, 0, At, B0); PG8_MMA(0, 1, At, B1); PG8_BAR; PG8_SCHED;
            PG8_LDA(At, 1, 1); PG8_STAGE(PG8_SB(1, 0), b3, voffB); PG8_STAGE(PG8_SB(1, 1), b3 + hstep, voffB); PG8_STAGE(PG8_SA(1, 0), a3, voffA);
            PG8_WAIT_V(8); PG8_WAIT_L(0); PG8_BAR; PG8_MMA(1, 0, At, B0); PG8_MMA(1, 1, At, B1); PG8_BAR; PG8_SCHED;
            } else {
            PG8_LDB(B0, 0, 0); PG8_SCHED; PG8_LDA(At, 0, 0); PG8_STAGE(PG8_SA(1, 1), a1 + hstep, voffA);
            PG8_WAIT_L(8); PG8_BAR; PG8_WAIT_L(0); PG8_MMA(0, 0, At, B0); PG8_BAR; PG8_SCHED;
            PG8_LDB(B1, 0, 1); PG8_STAGE(PG8_SB(0, 0), b2, voffB);
            PG8_BAR; PG8_WAIT_L(0); PG8_MMA(0, 1, At, B1); PG8_BAR;
            PG8_LDA(At, 0, 1); PG8_STAGE(PG8_SA(0, 0), a2, voffA);
            PG8_BAR; PG8_WAIT_L(0); PG8_MMA(1, 0, At, B0); PG8_BAR; PG8_SCHED;
            PG8_STAGE(PG8_SB(0, 1), b2 + hstep, voffB);
            PG8_WAIT_V(6); PG8_BAR; PG8_MMA(1, 1, At, B1); PG8_BAR;
            PG8_LDB(B0, 1, 0); PG8_SCHED; PG8_LDA(At, 1, 0); PG8_STAGE(PG8_SA(0, 1), a2 + hstep, voffA);
            PG8_WAIT_L(8); PG8_BAR; PG8_WAIT_L(0); PG8_MMA(0, 0, At, B0); PG8_BAR; PG8_SCHED;
            PG8_LDB(B1, 1, 1); PG8_STAGE(PG8_SB(1, 0), b3, voffB);
            PG8_BAR; PG8_WAIT_L(0); PG8_MMA(0, 1, At, B1); PG8_BAR;
            PG8_LDA(At, 1, 1); PG8_STAGE(PG8_SA(1, 0), a3, voffA);
            PG8_BAR; PG8_WAIT_L(0); PG8_MMA(1, 0, At, B0); PG8_BAR; PG8_SCHED;
            PG8_STAGE(PG8_SB(1, 1), b3 + hstep, voffB);
            PG8_WAIT_V(6); PG8_BAR; PG8_MMA(1, 1, At, B1); PG8_BAR;
            }
        }
        if constexpr (ALIGN_EPI) { if (wr == 0) PG8_BAR; }
        if constexpr (!Epi::AFTER_DRAIN) { E(acc, cur, wr, wc, fr, fq); S.done(cur); }
        if (!has_next) break;
#pragma unroll
        for (int a = 0; a < 2; ++a)
#pragma unroll
            for (int b = 0; b < 2; ++b)
#pragma unroll
                for (int m = 0; m < 4; ++m)
#pragma unroll
                    for (int n = 0; n < 2; ++n) acc[a][b][m][n] = (f32x4){0.f, 0.f, 0.f, 0.f};
        cur = nxt; cA = nA; cB = nB; ++ui;
        if constexpr (ALIGN_EPI) { if (wr == 1) PG8_BAR; }
    }
    PG8_WAIT_V(0);
    if constexpr (!ALIGN_EPI) { if (wr == 0) PG8_BAR; }
    PG8_BAR;
    if constexpr (Epi::AFTER_DRAIN) { E.fused(acc, cur, wr, wc, fr, fq, lds, wid, lane); S.done(cur); }
#undef PG8_SA
#undef PG8_SB
#undef PG8_STAGE
#undef PG8_LDA
#undef PG8_LDB
#undef PG8_MMA
#undef PG8_WAIT_V
#undef PG8_WAIT_L
#undef PG8_BAR
#undef PG8_SCHED
}
}
constexpr int RING_OFF = 0, RING_BYTES = 131072;
constexpr int LDSCTL_OFF = RING_BYTES, MISC_OFF = LDSCTL_OFF + 320;
constexpr int LDS_BYTES = 147456;
constexpr int CW_BAR = 4096;

#define GAS __attribute__((address_space(1)))
#define LAS __attribute__((address_space(3)))
typedef unsigned short bf16;
typedef unsigned v4u __attribute__((ext_vector_type(4)));
typedef float f32x4 __attribute__((ext_vector_type(4)));
typedef short bf16x8 __attribute__((ext_vector_type(8)));
typedef GAS unsigned gu32;
#define RLX_AGENT __ATOMIC_RELAXED, __HIP_MEMORY_SCOPE_AGENT
#define LDS_WAIT() asm volatile("s_waitcnt lgkmcnt(0)" ::: "memory")
#define VM_WAIT() asm volatile("s_waitcnt vmcnt(0)" ::: "memory")
__device__ __forceinline__ unsigned f2bfu(float f) { unsigned u = __builtin_bit_cast(unsigned, f); return (u + 0x7fffu + ((u >> 16) & 1u)) >> 16; }
__device__ __forceinline__ bf16 f2bf(float f) { return (bf16)f2bfu(f); }
__device__ __forceinline__ unsigned pk2(float lo, float hi) { return f2bfu(lo) | (f2bfu(hi) << 16); }
__device__ __forceinline__ float bf2f(bf16 v) { return __uint_as_float(((unsigned)v) << 16); }
__device__ __forceinline__ float silu_f(float v) { return v / (1.f + __expf(-v)); }
__device__ __forceinline__ float sigmoid_f(float v) { return 1.f / (1.f + __expf(-v)); }
__device__ __forceinline__ float wave_sum(float v) {
#pragma unroll
    for (int o = 1; o < 64; o <<= 1) v += __shfl_xor(v, o);
    return v;
}
__device__ __forceinline__ float rdlane(float v, int i) { return __int_as_float(__builtin_amdgcn_readlane(__float_as_int(v), i)); }

#define XB_TMO      128
#define XB_XCNT(j)  (256  + 64 * (j))
#define XB_XSUB(j)  (1280 + 64 * (j))
#define XB_XGEN(j)  (2304 + 64 * (j))
#define XB_TOP      3328
#define XB_TOPGEN   3392
#define XCD_BAR_WORDS 3456
#define XB_SPIN_CAP (1u << 18)

__device__ __forceinline__ unsigned xb_ld(unsigned* p)              { return __hip_atomic_load(p, __ATOMIC_RELAXED, __HIP_MEMORY_SCOPE_AGENT); }
__device__ __forceinline__ unsigned xb_add(unsigned* p, unsigned v) { return __hip_atomic_fetch_add(p, v, __ATOMIC_RELAXED, __HIP_MEMORY_SCOPE_AGENT); }
__device__ __forceinline__ unsigned xb_xcc_id() { return (unsigned)__builtin_amdgcn_s_getreg((3 << 11) | 20) & 0xFu; }
#define XB_SPIN(cond, bar) do { unsigned _sp = 0; while (cond) { __builtin_amdgcn_s_sleep(1); \
    if ((++_sp & 255u) == 0u) { if (xb_ld(&(bar)[XB_TMO])) break; if (_sp > XB_SPIN_CAP) { atomicAdd(&(bar)[XB_TMO], 1u); break; } } } } while (0)

struct XcdBarrier {
    unsigned* bar; unsigned x;
    volatile LAS unsigned* st;
};

__device__ __forceinline__ XcdBarrier xcd_barrier_post(unsigned* bar, volatile LAS unsigned* st) {
    XcdBarrier b; b.bar = bar; b.x = xb_xcc_id(); b.st = st;
    if (threadIdx.x == 0) (void)xb_add(&bar[XB_XCNT(b.x)], 1u);
    return b;
}
__device__ __forceinline__ void xcd_barrier_complete(unsigned* bar, unsigned x, unsigned& nloc, unsigned& nx) {
    const unsigned G = gridDim.x * gridDim.y * gridDim.z;
    unsigned sum, cnt, mine, sp = 0u;
    for (;;) {
        sum = 0u; cnt = 0u; mine = 0u;
#pragma unroll
        for (unsigned j = 0; j < 16; ++j) { const unsigned c = xb_ld(&bar[XB_XCNT(j)]); sum += c; cnt += (c > 0u) ? 1u : 0u; mine = (j == x) ? c : mine; }
        if (sum == G) break;
        __builtin_amdgcn_s_sleep(1);
        if ((++sp & 255u) == 0u) { if (xb_ld(&bar[XB_TMO])) break; if (sp > XB_SPIN_CAP) { atomicAdd(&bar[XB_TMO], 1u); break; } }
    }
    nloc = mine > 0u ? mine : 1u; nx = cnt > 0u ? cnt : 1u;
}

__device__ __forceinline__ void xcd_barrier(const XcdBarrier& b) {
    asm volatile("s_waitcnt vmcnt(0)" ::: "memory");
    __syncthreads();
    if (threadIdx.x == 0) {
        unsigned* bar = b.bar;
        __builtin_amdgcn_s_waitcnt(0);
        unsigned nloc = b.st[0], nx = b.st[1];
        if (nloc == 0u) { xcd_barrier_complete(bar, b.x, nloc, nx); b.st[0] = nloc; b.st[1] = nx; }
        const unsigned old = xb_add(&bar[XB_XSUB(b.x)], 1u);
        const unsigned gen = old / nloc;
        if (old + 1u == (gen + 1u) * nloc) {
            __builtin_amdgcn_fence(__ATOMIC_RELEASE, "agent");
            asm volatile("s_waitcnt vmcnt(0)" ::: "memory");
            const unsigned og = xb_add(&bar[XB_TOP], 1u);
            const unsigned tg = og / nx;
            if (og + 1u == (tg + 1u) * nx) xb_add(&bar[XB_TOPGEN], 1u);
            else XB_SPIN(xb_ld(&bar[XB_TOPGEN]) == tg, bar);
            __builtin_amdgcn_fence(__ATOMIC_ACQUIRE, "agent");
            xb_add(&bar[XB_XGEN(b.x)], 1u);
            asm volatile("s_waitcnt vmcnt(0)" ::: "memory");
        } else {
            XB_SPIN(xb_ld(&bar[XB_XGEN(b.x)]) == gen, bar);
            __builtin_amdgcn_fence(__ATOMIC_ACQUIRE, "agent");
            asm volatile("s_waitcnt vmcnt(0)" ::: "memory");
        }
    }
    __syncthreads();
}

struct Ctx {
    LAS unsigned char* lds; int tid, lane, wave, vcu, G, gw, NGW;
    const float *x, *c, *ctx, *c_ctx, *w_mod, *b_mod, *g_pre, *g_post, *w_in, *w_out, *hgrn_lb, *hgrn_gn, *gate_b, *mlstm_gn, *na_rpb;
    float* out; bf16 *wt_in, *wt_out, *hxy, *P; float *mod, *gates, *ctx1, *UX, *stm, *sth, *rope; bf16 *otm, *oth;
};

__device__ __forceinline__ void transpose_item(const float* W, int N, int Nnew, bool remap, bf16* WT, LAS float* scr, int item, int lane) {
    const int nblk = Nnew / 32, kb = item / nblk, nb = item % nblk, k0 = 64 * kb, n0 = 32 * nb;
    const int nn = n0 + (lane & 31);
    int no = nn; if (remap) no = nn < 3200 ? nn : (nn < 4736 ? nn + 16 : (nn < 4752 ? 3200 + nn - 4736 : -1));
#pragma unroll 8
    for (int i = 0; i < 32; ++i) { const int kk = 2 * i + (lane >> 5); scr[kk * 33 + (lane & 31)] = no >= 0 ? W[(size_t)(k0 + kk) * N + no] : 0.f; }
    LDS_WAIT(); asm volatile("" ::: "memory");
    const int c = lane & 7;
#pragma unroll
    for (int j = 0; j < 4; ++j) { const int n = (lane >> 3) + 8 * j; const LAS float* s = scr + (8 * c) * 33 + n;
        v4u o; o.x = pk2(s[0 * 33], s[1 * 33]); o.y = pk2(s[2 * 33], s[3 * 33]); o.z = pk2(s[4 * 33], s[5 * 33]); o.w = pk2(s[6 * 33], s[7 * 33]);
        *(GAS v4u*)(WT + (size_t)(n0 + n) * 1024 + k0 + 8 * c) = o; }
    LDS_WAIT(); asm volatile("" ::: "memory");
}
__device__ __forceinline__ void phase_p0(const Ctx& F) {
    if (F.vcu < 96) {
        LAS float* tab = (LAS float*)(F.lds);
        LAS float* part = (LAS float*)(F.lds + 36864);
        for (int i = F.tid; i < 9 * 1024; i += 512) { const int r = i >> 10, k = i & 1023; const float v = r < 8 ? F.c[r * 1024 + k] : F.c_ctx[k]; tab[i] = silu_f(v); }
        __syncthreads();
        for (int it = F.vcu; it < 96; it += F.G) {
            const int l = it / 48, jb = it % 48, col = jb * 64 + F.lane;
            float acc[9];
#pragma unroll
            for (int r = 0; r < 9; ++r) acc[r] = 0.f;
            const float* wp = F.w_mod + ((size_t)l * 1024 + F.wave * 128) * 3072 + col;
#pragma unroll 4
            for (int k = 0; k < 128; ++k) { const float wv = wp[(size_t)k * 3072];
#pragma unroll
                for (int r = 0; r < 9; ++r) acc[r] += tab[r * 1024 + F.wave * 128 + k] * wv; }
#pragma unroll
            for (int r = 0; r < 9; ++r) part[(F.wave * 9 + r) * 64 + F.lane] = acc[r];
            __syncthreads();
            for (int i = F.tid; i < 9 * 64; i += 512) { const int r = i >> 6, j = i & 63; float s = 0.f;
#pragma unroll
                for (int w = 0; w < 8; ++w) s += part[(w * 9 + r) * 64 + j];
                F.mod[((size_t)l * 9 + r) * 3072 + jb * 64 + j] = s + F.b_mod[l * 3072 + jb * 64 + j]; }
            __syncthreads();
        }
    }
    if (F.vcu == 96 % F.G) for (int i = F.tid; i < 64 * 24; i += 512) { const int pos = i / 24, f = i % 24; const float ang = (float)pos * expf(-(float)(2 * f) * (1.f / 48.f) * 9.210340371976184f); F.rope[2 * i] = cosf(ang); F.rope[2 * i + 1] = sinf(ang); }
    __syncthreads();
    LAS float* scr = (LAS float*)(F.lds + F.wave * 16384);
    constexpr int I_IN = 16 * (NPAD / 32), I_OUT = 16 * 32;
    for (int it = F.gw; it < 2 * I_IN + 2 * I_OUT; it += F.NGW) {
        int r = it;
        if (r < 2 * I_IN) { const int l = r / I_IN; transpose_item(F.w_in + (size_t)l * 1024 * PIN, PIN, NPAD, true, F.wt_in + (size_t)l * NPAD * 1024, scr, r % I_IN, F.lane); continue; }
        r -= 2 * I_IN; { const int l = r / I_OUT; transpose_item(F.w_out + (size_t)l * 1024 * 1024, 1024, 1024, false, F.wt_out + (size_t)l * 1024 * 1024, scr, r % I_OUT, F.lane); }
    }
}

__device__ __forceinline__ void prenorm_row(const float4 (&v)[4], float ss, const float* mod_r, const float* g_pre_l, bf16* dst, int lane) {
    const float rinv = 1.f / sqrtf(ss * (1.f / 1024.f) + EPS);
    const float* sh = mod_r; const float* sc = mod_r + 1024;
#pragma unroll
    for (int j = 0; j < 4; ++j) {
        const int d = 4 * (lane + 64 * j);
        const float4 g = *(const float4*)(g_pre_l + d), s1 = *(const float4*)(sc + d), s0 = *(const float4*)(sh + d);
        const float o0 = v[j].x * rinv * g.x * (1.f + s1.x) + s0.x, o1 = v[j].y * rinv * g.y * (1.f + s1.y) + s0.y;
        const float o2 = v[j].z * rinv * g.z * (1.f + s1.z) + s0.z, o3 = v[j].w * rinv * g.w * (1.f + s1.w) + s0.w;
        uint2 w; w.x = pk2(o0, o1); w.y = pk2(o2, o3);
        *(uint2*)(dst + d) = w;
    }
}
__device__ __forceinline__ void phase_prenorm0(const Ctx& F) {
    for (int m = F.gw; m < M; m += F.NGW) {
        const float* src; int r;
        if (m < MX) { src = F.x + (size_t)m * 1024; r = m / S; } else { src = F.ctx + (size_t)(m - MX) * 1024; r = 8; }
        float4 v[4]; float ss = 0.f;
#pragma unroll
        for (int j = 0; j < 4; ++j) { v[j] = ((const float4*)src)[F.lane + 64 * j]; ss += v[j].x * v[j].x + v[j].y * v[j].y + v[j].z * v[j].z + v[j].w * v[j].w; }
        ss = wave_sum(ss);
        prenorm_row(v, ss, F.mod + (size_t)r * 3072, F.g_pre, F.hxy + (size_t)m * 1024, F.lane);
    }
}
__device__ __forceinline__ void phase_post(const Ctx& F, int l) {
    const int Ml = l == 0 ? M : MX;
    const float* mod_l = F.mod + (size_t)l * 9 * 3072; const float* g_post_l = F.g_post + l * 1024;
    for (int m = F.gw; m < Ml; m += F.NGW) {
        const float* src; float* dst; int r;
        if (m < MX) { src = (l == 0 ? F.x : F.out) + (size_t)m * 1024; dst = F.out + (size_t)m * 1024; r = m / S; }
        else { src = F.ctx + (size_t)(m - MX) * 1024; dst = F.ctx1 + (size_t)(m - MX) * 1024; r = 8; }
        const float* ur = F.UX + (size_t)m * 1024;
        float4 u[4]; float ss = 0.f;
#pragma unroll
        for (int j = 0; j < 4; ++j) { u[j] = ((const float4*)ur)[F.lane + 64 * j]; ss += u[j].x * u[j].x + u[j].y * u[j].y + u[j].z * u[j].z + u[j].w * u[j].w; }
        ss = wave_sum(ss);
        const float rinv = 1.f / sqrtf(ss * (1.f / 1024.f) + EPS);
        const float* gt = mod_l + r * 3072 + 2048;
        float ss2 = 0.f;
#pragma unroll
        for (int j = 0; j < 4; ++j) {
            const int d = 4 * (F.lane + 64 * j);
            const float4 g = *(const float4*)(g_post_l + d), t = *(const float4*)(gt + d), xv = *(const float4*)(src + d);
            float4 o; o.x = xv.x + t.x * (u[j].x * rinv * g.x); o.y = xv.y + t.y * (u[j].y * rinv * g.y); o.z = xv.z + t.z * (u[j].z * rinv * g.z); o.w = xv.w + t.w * (u[j].w * rinv * g.w);
            *(float4*)(dst + d) = o; u[j] = o; ss2 += o.x * o.x + o.y * o.y + o.z * o.z + o.w * o.w;
        }
        if (l == 0) { ss2 = wave_sum(ss2); prenorm_row(u, ss2, F.mod + (size_t)(9 + r) * 3072, F.g_pre + 1024, F.hxy + (size_t)m * 1024, F.lane); }
    }
}

__device__ __forceinline__ int seq_row(int b, int step, int dir) {
    if (step < CTX) { const int n = dir ? CTX - 1 - step : step; return MX + b * CTX + n; }
    int t = step - CTX; if (dir) t = S - 1 - t; return b * S + t;
}

typedef short s16x4 __attribute__((ext_vector_type(4)));
typedef short v4i16_t __attribute__((ext_vector_type(4)));
__device__ __forceinline__ s16x4 tr_read(const LAS bf16* p) { return __builtin_bit_cast(s16x4, __builtin_amdgcn_ds_read_tr16_b64_v4i16((LAS v4i16_t*)p)); }
__device__ __forceinline__ bf16x8 tr_frag(const LAS bf16* T, int stride, int rowA, int rowB, int col0, int lane) {
    const int q = (lane >> 2) & 3, p = lane & 3;
    const s16x4 lo = tr_read(T + (rowA + q) * stride + col0 + 4 * p), hi = tr_read(T + (rowB + q) * stride + col0 + 4 * p);
    return (bf16x8){lo[0], lo[1], lo[2], lo[3], hi[0], hi[1], hi[2], hi[3]};
}
__device__ __forceinline__ bf16x8 rm_frag(const LAS bf16* T, int stride, int row, int k0) { return *(const LAS bf16x8*)(T + row * stride + k0); }
__device__ __forceinline__ f32x4 mfma16(bf16x8 a, bf16x8 b, f32x4 c) { return __builtin_amdgcn_mfma_f32_16x16x32_bf16(a, b, c, 0, 0, 0); }
typedef unsigned v2u __attribute__((ext_vector_type(2)));
typedef float f32x2 __attribute__((ext_vector_type(2)));
__device__ __forceinline__ void unpack8(const v4u w, float* f) {
    f[0] = __uint_as_float(w.x << 16); f[1] = __uint_as_float(w.x & 0xffff0000u); f[2] = __uint_as_float(w.y << 16); f[3] = __uint_as_float(w.y & 0xffff0000u);
    f[4] = __uint_as_float(w.z << 16); f[5] = __uint_as_float(w.z & 0xffff0000u); f[6] = __uint_as_float(w.w << 16); f[7] = __uint_as_float(w.w & 0xffff0000u);
}
__device__ __forceinline__ v4u pack8(const float* f) { v4u w; w.x = pk2(f[0], f[1]); w.y = pk2(f[2], f[3]); w.z = pk2(f[4], f[5]); w.w = pk2(f[6], f[7]); return w; }

namespace ml {
constexpr int QSTR = 104, VSTR = 120;
constexpr int OFF_QS = 0, OFF_KS = OFF_QS + 64 * QSTR * 2, OFF_VS = OFF_KS + 64 * QSTR * 2, OFF_CT = OFF_VS + 64 * VSTR * 2;
constexpr int OFF_HT = OFF_CT + 2 * 112 * QSTR * 2, OFF_DEN = OFF_HT + 64 * 100 * 4, OFF_ROPE = OFF_DEN + 256, OFF_END = OFF_ROPE + 64 * 24 * 8;
static_assert(OFF_END <= RING_BYTES, "mlstm LDS");
constexpr int ST_FLOATS = 96 * 112 + 16;
}
struct MlJob { int b, h, isctx, t0, nchunk; };

__device__ __forceinline__ void mlstm_dir(const Ctx& F, int l, const MlJob jb, int dir, int fold_r, int emit_slot, int mode, bf16* otmp, float* ST) {
    using namespace ml;
    int tid_ = F.tid; asm volatile("" : "+v"(tid_));
    const int tid = tid_, lane = tid & 63, w = __builtin_amdgcn_readfirstlane(tid >> 6), g = lane >> 4, c = lane & 15;
    LAS bf16* QS = (LAS bf16*)(F.lds + OFF_QS); LAS bf16* KS = (LAS bf16*)(F.lds + OFF_KS); LAS bf16* VS = (LAS bf16*)(F.lds + OFF_VS);
    LAS bf16* CT0 = (LAS bf16*)(F.lds + OFF_CT); LAS float* HT = (LAS float*)(F.lds + OFF_HT); LAS float* DEN = (LAS float*)(F.lds + OFF_DEN);
    const LAS f32x2* ROPE = (const LAS f32x2*)(F.lds + OFF_ROPE);
    const int rowbase = jb.isctx ? MX + jb.b * CTX : jb.b * S;
    const int h = jb.h; const bf16* P = F.P;
    float* STd = ST + (size_t)(((jb.b * 4 + h) * 2 + dir) * 8) * ST_FLOATS;
    f32x4 Cst[7];
#pragma unroll
    for (int et = 0; et < 7; ++et) Cst[et] = (f32x4){0.f, 0.f, 0.f, 0.f};
    if (w < 6 && fold_r >= 0) {
#pragma unroll
        for (int et = 0; et < 7; ++et)
#pragma unroll
            for (int r = 0; r < 4; ++r) Cst[et][r] = STd[(16 * w + 4 * g + r) * 112 + 16 * et + c];
        for (int k = 1; k <= fold_r; ++k) {
            const float* sl = STd + (size_t)k * ST_FLOATS; const float dec = __expf(sl[96 * 112]);
#pragma unroll
            for (int et = 0; et < 7; ++et)
#pragma unroll
                for (int r = 0; r < 4; ++r) Cst[et][r] = dec * Cst[et][r] + sl[(16 * w + 4 * g + r) * 112 + 16 * et + c];
        }
    }
    float Btot = 0.f;
    for (int i = tid; i < 64 * 16; i += 512) { const int s = i >> 4, e = 96 + (i & 15); VS[s * VSTR + e] = (e == 96) ? (bf16)0x3F80 : (bf16)0; }
    if (w < 6) {
#pragma unroll
        for (int et = 0; et < 7; ++et) { v2u v; v.x = pk2(Cst[et][0], Cst[et][1]); v.y = pk2(Cst[et][2], Cst[et][3]); *(LAS v2u*)(CT0 + (16 * et + c) * QSTR + 16 * w + 4 * g) = v; }
    }
    const bool hasqk = tid < 384; const int qk_tok = tid / 6, qk_pi = tid % 6, qk_part = qk_pi / 3, qk_pp = qk_pi % 3, qk_d0 = 48 * qk_part + 8 * qk_pp;
    const int v1_tok = tid / 12, v1_pc = tid % 12; const bool hasv2 = tid < 256; const int v2_tok = (512 + tid) / 12, v2_pc = (512 + tid) % 12;
    v4u rq0, rq1, rk0, rk1, rv1, rv2; float rig = 0.f, rlf = 0.f;
    rq0 = rq1 = rk0 = rk1 = rv1 = rv2 = (v4u){0u, 0u, 0u, 0u};
    auto tok_of = [&](int ci, int i) -> int { return dir == 0 ? jb.t0 + 64 * ci + i : jb.t0 + 64 * (jb.nchunk - 1 - ci) + (63 - i); };
    auto issue_loads = [&](int ci) {
        if (hasqk) { const bf16* pr = P + (size_t)(rowbase + tok_of(ci, qk_tok)) * PLD + h * 96 + qk_d0;
            if (mode != 0) { rq0 = *(const v4u*)(pr + B_Q); rq1 = *(const v4u*)(pr + B_Q + 24); }
            rk0 = *(const v4u*)(pr + B_K); rk1 = *(const v4u*)(pr + B_K + 24); }
        rv1 = *(const v4u*)(P + (size_t)(rowbase + tok_of(ci, v1_tok)) * PLD + B_V + h * 96 + 8 * v1_pc);
        if (hasv2) rv2 = *(const v4u*)(P + (size_t)(rowbase + tok_of(ci, v2_tok)) * PLD + B_V + h * 96 + 8 * v2_pc);
        const float* gp = F.gates + (size_t)(rowbase + tok_of(ci, lane)) * 16 + dir * 4 + h; rig = gp[0]; rlf = gp[8];
    };
    issue_loads(0);
    __syncthreads();
    for (int ci = 0; ci < jb.nchunk; ++ci) {
        LAS bf16* CTc = CT0 + (ci & 1) * 112 * QSTR; LAS bf16* CTn = CT0 + ((ci + 1) & 1) * 112 * QSTR;
        float bcs = rlf;
#pragma unroll
        for (int o = 1; o < 64; o <<= 1) { const float t = __shfl_up(bcs, o); if (lane >= o) bcs += t; }
        const float qsc = __expf(bcs) * 0.10206207261596575f, ksc = __expf(rig - bcs);
        const float bL = __shfl(bcs, 63), ebL = __expf(bL);
        if (hasqk) {
            const float ks_t = __shfl(ksc, qk_tok), qs_t = __shfl(qsc, qk_tok);
            float cs[8], sn[8];
            if (!jb.isctx) { const int t = tok_of(ci, qk_tok); const int pos = qk_part ? (t & 63) : (t >> 6);
#pragma unroll
                for (int e = 0; e < 8; ++e) { const f32x2 v = ROPE[pos * 24 + 8 * qk_pp + e]; cs[e] = v[0]; sn[e] = v[1]; } }
            else {
#pragma unroll
                for (int e = 0; e < 8; ++e) { cs[e] = 1.f; sn[e] = 0.f; } }
            float a[8], b2[8], o0[8], o1[8];
            unpack8(rk0, a); unpack8(rk1, b2);
#pragma unroll
            for (int e = 0; e < 8; ++e) { o0[e] = (a[e] * cs[e] - b2[e] * sn[e]) * ks_t; o1[e] = (b2[e] * cs[e] + a[e] * sn[e]) * ks_t; }
            *(LAS v4u*)(KS + qk_tok * QSTR + qk_d0) = pack8(o0); *(LAS v4u*)(KS + qk_tok * QSTR + qk_d0 + 24) = pack8(o1);
            if (mode != 0) {
                unpack8(rq0, a); unpack8(rq1, b2);
#pragma unroll
                for (int e = 0; e < 8; ++e) { o0[e] = (a[e] * cs[e] - b2[e] * sn[e]) * qs_t; o1[e] = (b2[e] * cs[e] + a[e] * sn[e]) * qs_t; }
                *(LAS v4u*)(QS + qk_tok * QSTR + qk_d0) = pack8(o0); *(LAS v4u*)(QS + qk_tok * QSTR + qk_d0 + 24) = pack8(o1);
            }
        } else { (void)__shfl(ksc, 0); (void)__shfl(qsc, 0); }
        *(LAS v4u*)(VS + v1_tok * VSTR + 8 * v1_pc) = rv1;
        if (hasv2) *(LAS v4u*)(VS + v2_tok * VSTR + 8 * v2_pc) = rv2;
        if (ci + 1 < jb.nchunk) issue_loads(ci + 1);
        __syncthreads();
        if (mode != 0) {
            const int tt = w & 3, jh = w >> 2;
            bf16x8 qf[3];
#pragma unroll
            for (int ks = 0; ks < 3; ++ks) qf[ks] = rm_frag(QS, QSTR, 16 * tt + c, 32 * ks + 8 * g);
            f32x4 st[4];
#pragma unroll
            for (int ss = 0; ss < 4; ++ss) { st[ss] = (f32x4){0.f, 0.f, 0.f, 0.f};
                if (ss <= tt) {
#pragma unroll
                    for (int ks = 0; ks < 3; ++ks) st[ss] = mfma16(rm_frag(KS, QSTR, 16 * ss + c, 32 * ks + 8 * g), qf[ks], st[ss]);
                    if (ss == tt) {
#pragma unroll
                        for (int r = 0; r < 4; ++r) if (4 * g + r > c) st[ss][r] = 0.f; }
                } }
            bf16x8 pf[2];
#pragma unroll
            for (int kk = 0; kk < 2; ++kk) { const unsigned u0 = pk2(st[2 * kk][0], st[2 * kk][1]), u1 = pk2(st[2 * kk][2], st[2 * kk][3]), u2 = pk2(st[2 * kk + 1][0], st[2 * kk + 1][1]), u3 = pk2(st[2 * kk + 1][2], st[2 * kk + 1][3]);
                pf[kk] = __builtin_bit_cast(bf16x8, (v4u){u0, u1, u2, u3}); }
#pragma unroll
            for (int ei = 0; ei < 4; ++ei) { const int et = 4 * jh + ei;
                if (et < 7) {
                    f32x4 acc = (f32x4){0.f, 0.f, 0.f, 0.f};
#pragma unroll
                    for (int kk = 0; kk < 2; ++kk) if (2 * kk <= tt) acc = mfma16(tr_frag(VS, VSTR, 32 * kk + 4 * g, 32 * kk + 16 + 4 * g, 16 * et, lane), pf[kk], acc);
#pragma unroll
                    for (int ks = 0; ks < 3; ++ks) acc = mfma16(rm_frag(CTc, QSTR, 16 * et + c, 32 * ks + 8 * g), qf[ks], acc);
                    if (et < 6) *(LAS f32x4*)(HT + (16 * tt + c) * 100 + 16 * et + 4 * g) = acc;
                    else if (g == 0) DEN[16 * tt + c] = acc[0];
                } }
        }
        if (w < 6) {
#pragma unroll
            for (int kk = 0; kk < 2; ++kk) { const bf16x8 af = tr_frag(KS, QSTR, 32 * kk + 8 * g, 32 * kk + 8 * g + 4, 16 * w, lane);
#pragma unroll
                for (int et = 0; et < 7; ++et) Cst[et] = mfma16(af, tr_frag(VS, VSTR, 32 * kk + 8 * g, 32 * kk + 8 * g + 4, 16 * et, lane), Cst[et]); }
#pragma unroll
            for (int et = 0; et < 7; ++et) { Cst[et] = Cst[et] * ebL;
                if (mode != 0) { v2u v; v.x = pk2(Cst[et][0], Cst[et][1]); v.y = pk2(Cst[et][2], Cst[et][3]); *(LAS v2u*)(CTn + (16 * et + c) * QSTR + 16 * w + 4 * g) = v; } }
        }
        Btot += bL;
        __syncthreads();
        if (mode != 0) {
            const int i = tid >> 3, sub = tid & 7, e0 = 12 * sub; const int m = rowbase + tok_of(ci, i);
            float hv[12]; const float rden = 1.f / fmaxf(fabsf(DEN[i]), 1.f);
#pragma unroll
            for (int q4 = 0; q4 < 3; ++q4) { const f32x4 v = *(const LAS f32x4*)(HT + i * 100 + e0 + 4 * q4); hv[4 * q4] = v[0] * rden; hv[4 * q4 + 1] = v[1] * rden; hv[4 * q4 + 2] = v[2] * rden; hv[4 * q4 + 3] = v[3] * rden; }
            bf16* tp = otmp + (size_t)m * 384 + h * 96 + e0;
            if (mode == 1) {
#pragma unroll
                for (int q4 = 0; q4 < 3; ++q4) { uint2 v; v.x = pk2(hv[4 * q4], hv[4 * q4 + 1]); v.y = pk2(hv[4 * q4 + 2], hv[4 * q4 + 3]); *(uint2*)(tp + 4 * q4) = v; }
            } else {
                float ss = 0.f;
#pragma unroll
                for (int q4 = 0; q4 < 3; ++q4) { const uint2 v = *(const uint2*)(tp + 4 * q4);
                    hv[4 * q4] += __uint_as_float(v.x << 16); hv[4 * q4 + 1] += __uint_as_float(v.x & 0xffff0000u); hv[4 * q4 + 2] += __uint_as_float(v.y << 16); hv[4 * q4 + 3] += __uint_as_float(v.y & 0xffff0000u); }
#pragma unroll
                for (int e = 0; e < 12; ++e) ss += hv[e] * hv[e];
                ss += __shfl_xor(ss, 1); ss += __shfl_xor(ss, 2); ss += __shfl_xor(ss, 4);
                const float rinv = 1.f / sqrtf(ss * (1.f / 96.f) + EPS);
                const bf16* pr = P + (size_t)m * PLD + h * 96 + e0; const float* gn = F.mlstm_gn + l * 384 + h * 96 + e0;
                bf16* yp = F.hxy + (size_t)m * 1024 + 256 + h * 96 + e0;
#pragma unroll
                for (int q4 = 0; q4 < 3; ++q4) { const uint2 ov = *(const uint2*)(pr + B_O + 4 * q4), zv = *(const uint2*)(pr + B_Z + 4 * q4);
                    const float og[4] = {__uint_as_float(ov.x << 16), __uint_as_float(ov.x & 0xffff0000u), __uint_as_float(ov.y << 16), __uint_as_float(ov.y & 0xffff0000u)};
                    const float zg[4] = {__uint_as_float(zv.x << 16), __uint_as_float(zv.x & 0xffff0000u), __uint_as_float(zv.y << 16), __uint_as_float(zv.y & 0xffff0000u)};
                    float o[4];
#pragma unroll
                    for (int e = 0; e < 4; ++e) o[e] = sigmoid_f(og[e]) * (hv[4 * q4 + e] * rinv * gn[4 * q4 + e]) * silu_f(zg[e]);
                    uint2 v; v.x = pk2(o[0], o[1]); v.y = pk2(o[2], o[3]); *(uint2*)(yp + 4 * q4) = v; }
            }
        }
    }
    if (emit_slot >= 0 && w < 6) {
        float* sl = STd + (size_t)emit_slot * ST_FLOATS;
#pragma unroll
        for (int et = 0; et < 7; ++et)
#pragma unroll
            for (int r = 0; r < 4; ++r) sl[(16 * w + 4 * g + r) * 112 + 16 * et + c] = Cst[et][r];
        if (w == 0 && lane == 0) sl[96 * 112] = Btot;
    }
    __syncthreads();
}
__device__ __forceinline__ void mlstm_load_rope(const Ctx& F, const float* rope_tab) {
    LAS f32x2* ROPE = (LAS f32x2*)(F.lds + ml::OFF_ROPE);
    for (int i = F.tid; i < 64 * 24; i += 512) ROPE[i] = ((const f32x2*)rope_tab)[i];
}
__device__ __forceinline__ void mlstm_itemA(const Ctx& F, int l, int bh, int it, bf16* otmp, float* ST) {
    const int b = bh >> 2, h = bh & 3;
    if (it == 0) {
        const MlJob jb{b, h, 1, 0, 4};
        mlstm_dir(F, l, jb, 0, -1, 0, l == 0 ? 1 : 0, otmp, ST);
        mlstm_dir(F, l, jb, 1, -1, 0, l == 0 ? 2 : 0, otmp, ST);
    } else {
        const int dir = (it - 1) / 7, k = (it - 1) % 7, seg = dir == 0 ? k : 7 - k;
        const MlJob jb{b, h, 0, 512 * seg, 8};
        mlstm_dir(F, l, jb, dir, -1, 1 + k, 0, otmp, ST);
    }
}
__device__ __forceinline__ void mlstm_itemC(const Ctx& F, int l, int bh, int seg, bf16* otmp, float* ST) {
    const MlJob jb{bh >> 2, bh & 3, 0, 512 * seg, 8};
    mlstm_dir(F, l, jb, 0, seg, -1, 1, otmp, ST);
    mlstm_dir(F, l, jb, 1, 7 - seg, -1, 2, otmp, ST);
}

namespace hg {
constexpr int STR = 72;
constexpr int IMG = 64 * STR * 2;
constexpr int OFF_KO = 0, OFF_KH = IMG, OFF_VS = 2 * IMG, OFF_QJ = 3 * IMG, OFF_ST = 7 * IMG, OFF_HT = 9 * IMG, OFF_TOT = OFF_HT + 64 * 68 * 4, OFF_BL = OFF_TOT + 8 * 64 * 4, OFF_END = OFF_BL + 512;
static_assert(OFF_END <= RING_BYTES, "hgrn LDS");
constexpr int ST_FLOATS = 64 * 64 + 64;
}
__device__ __forceinline__ void hgrn_dir(const Ctx& F, int l, const MlJob jb, int dir, int fold_r, int emit_slot, int mode, bf16* otmp, float* ST) {
    using namespace hg;
    int tid_ = F.tid; asm volatile("" : "+v"(tid_));
    const int tid = tid_, lane = tid & 63, w = __builtin_amdgcn_readfirstlane(tid >> 6), g = lane >> 4, c = lane & 15;
    LAS bf16* KO = (LAS bf16*)(F.lds + OFF_KO); LAS bf16* KH = (LAS bf16*)(F.lds + OFF_KH); LAS bf16* VS = (LAS bf16*)(F.lds + OFF_VS); LAS bf16* QJ = (LAS bf16*)(F.lds + OFF_QJ);
    LAS bf16* ST0 = (LAS bf16*)(F.lds + OFF_ST); LAS float* HT = (LAS float*)(F.lds + OFF_HT); LAS float* TOT = (LAS float*)(F.lds + OFF_TOT); LAS float* BL = (LAS float*)(F.lds + OFF_BL);
    const int rowbase = jb.isctx ? MX + jb.b * CTX : jb.b * S;
    const int h = jb.h; const bf16* P = F.P;
    float* STd = ST + (size_t)(((jb.b * 4 + h) * 2 + dir) * 8) * ST_FLOATS;
    const int dt = w >> 1, et0 = 2 * (w & 1);
    f32x4 Sst[2]; float Btot[4];
#pragma unroll
    for (int i = 0; i < 2; ++i) Sst[i] = (f32x4){0.f, 0.f, 0.f, 0.f};
#pragma unroll
    for (int r = 0; r < 4; ++r) Btot[r] = 0.f;
    if (fold_r >= 0) {
#pragma unroll
        for (int i = 0; i < 2; ++i)
#pragma unroll
            for (int r = 0; r < 4; ++r) Sst[i][r] = STd[(16 * dt + 4 * g + r) * 64 + 16 * (et0 + i) + c];
        for (int k = 1; k <= fold_r; ++k) {
            const float* sl = STd + (size_t)k * ST_FLOATS;
#pragma unroll
            for (int r = 0; r < 4; ++r) { const float dec = __expf(sl[64 * 64 + 16 * dt + 4 * g + r]);
#pragma unroll
                for (int i = 0; i < 2; ++i) Sst[i][r] = dec * Sst[i][r] + sl[(16 * dt + 4 * g + r) * 64 + 16 * (et0 + i) + c]; }
        }
    }
    if (mode != 0) {
#pragma unroll
        for (int i = 0; i < 2; ++i) { v2u v; v.x = pk2(Sst[i][0], Sst[i][1]); v.y = pk2(Sst[i][2], Sst[i][3]); *(LAS v2u*)(ST0 + (16 * (et0 + i) + c) * STR + 16 * dt + 4 * g) = v; }
    }
    const int ps = tid >> 3, oct = tid & 7, d0 = 8 * oct;
    float lbv[8];
#pragma unroll
    for (int e = 0; e < 8; ++e) { lbv[e] = 0.f;
        if (l == 1) { const float v0 = F.hgrn_lb[(0 * 2 + dir) * 256 + h * 64 + d0 + e], v1 = F.hgrn_lb[(1 * 2 + dir) * 256 + h * 64 + d0 + e]; lbv[e] = 1.f / (1.f + expf(v0 - v1)); } }
    const int fcol = dir ? A_FB : A_FF;
    auto tok_of = [&](int ci, int i) -> int { return dir == 0 ? jb.t0 + 64 * ci + i : jb.t0 + 64 * (jb.nchunk - 1 - ci) + (63 - i); };
    v4u rq, rf, rv; rq = rf = rv = (v4u){0u, 0u, 0u, 0u};
    auto issue_loads = [&](int ci) {
        const bf16* pr = P + (size_t)(rowbase + tok_of(ci, ps)) * PLD + h * 64 + d0;
        if (mode != 0) rq = *(const v4u*)(pr + A_Q);
        rf = *(const v4u*)(pr + fcol); rv = *(const v4u*)(pr + A_I);
    };
    issue_loads(0);
    __syncthreads();
    for (int ci = 0; ci < jb.nchunk; ++ci) {
        LAS bf16* STc = ST0 + (ci & 1) * 64 * STR; LAS bf16* STn = ST0 + ((ci + 1) & 1) * 64 * STR;
        float qv[8], kk[8], bb[8], fl[8];
        unpack8(rf, fl);
#pragma unroll
        for (int e = 0; e < 8; ++e) { const float sg = sigmoid_f(fl[e]); const float f = lbv[e] + (1.f - lbv[e]) * sg; bb[e] = __logf(f); kk[e] = (1.f - lbv[e]) * (1.f - sg); }
        if (mode != 0) { unpack8(rq, qv);
#pragma unroll
            for (int e = 0; e < 8; ++e) qv[e] = silu_f(qv[e]) * 0.125f; }
        const v4u vraw = rv;
        if (ci + 1 < jb.nchunk) issue_loads(ci + 1);
#pragma unroll
        for (int o = 8; o < 64; o <<= 1) {
#pragma unroll
            for (int e = 0; e < 8; ++e) { const float t = __shfl_up(bb[e], o); if (lane >= o) bb[e] += t; } }
        if (lane >= 56) { *(LAS f32x4*)(TOT + w * 64 + d0) = (f32x4){bb[0], bb[1], bb[2], bb[3]}; *(LAS f32x4*)(TOT + w * 64 + d0 + 4) = (f32x4){bb[4], bb[5], bb[6], bb[7]}; }
        __syncthreads();
        {
            float run[8], pre[8], ref1[8], ref2[8], ref3[8];
#pragma unroll
            for (int e = 0; e < 8; ++e) { run[e] = 0.f; pre[e] = 0.f; ref1[e] = ref2[e] = ref3[e] = 0.f; }
#pragma unroll
            for (int ww = 0; ww < 8; ++ww) {
                if (ww == w) {
#pragma unroll
                    for (int e = 0; e < 8; ++e) pre[e] = run[e]; }
                if (ww == 2) {
#pragma unroll
                    for (int e = 0; e < 8; ++e) ref1[e] = run[e]; }
                if (ww == 4) {
#pragma unroll
                    for (int e = 0; e < 8; ++e) ref2[e] = run[e]; }
                if (ww == 6) {
#pragma unroll
                    for (int e = 0; e < 8; ++e) ref3[e] = run[e]; }
                const f32x4 t0 = *(const LAS f32x4*)(TOT + ww * 64 + d0), t1 = *(const LAS f32x4*)(TOT + ww * 64 + d0 + 4);
                run[0] += t0[0]; run[1] += t0[1]; run[2] += t0[2]; run[3] += t0[3]; run[4] += t1[0]; run[5] += t1[1]; run[6] += t1[2]; run[7] += t1[3];
            }
            const int sub = ps >> 4;
            float o8[8];
#pragma unroll
            for (int e = 0; e < 8; ++e) bb[e] += pre[e];
#pragma unroll
            for (int e = 0; e < 8; ++e) { const float rown = sub == 0 ? 0.f : (sub == 1 ? ref1[e] : (sub == 2 ? ref2[e] : ref3[e])); o8[e] = kk[e] * __expf(rown - bb[e]); }
            if (mode != 0) *(LAS v4u*)(KO + ps * STR + d0) = pack8(o8);
#pragma unroll
            for (int e = 0; e < 8; ++e) o8[e] = kk[e] * __expf(run[e] - bb[e]);
            *(LAS v4u*)(KH + ps * STR + d0) = pack8(o8);
            *(LAS v4u*)(VS + ps * STR + d0) = vraw;
            if (mode != 0) {
#pragma unroll
                for (int e = 0; e < 8; ++e) o8[e] = qv[e] * __expf(bb[e]);
                *(LAS v4u*)(QJ + ps * STR + d0) = pack8(o8);
                if (sub >= 1) {
#pragma unroll
                    for (int e = 0; e < 8; ++e) o8[e] = qv[e] * __expf(bb[e] - ref1[e]);
                    *(LAS v4u*)(QJ + (64 + ps) * STR + d0) = pack8(o8); }
                if (sub >= 2) {
#pragma unroll
                    for (int e = 0; e < 8; ++e) o8[e] = qv[e] * __expf(bb[e] - ref2[e]);
                    *(LAS v4u*)(QJ + (128 + ps) * STR + d0) = pack8(o8); }
                if (sub >= 3) {
#pragma unroll
                    for (int e = 0; e < 8; ++e) o8[e] = qv[e] * __expf(bb[e] - ref3[e]);
                    *(LAS v4u*)(QJ + (192 + ps) * STR + d0) = pack8(o8); }
            }
            if (ps == 0) { *(LAS f32x4*)(BL + d0) = (f32x4){run[0], run[1], run[2], run[3]}; *(LAS f32x4*)(BL + d0 + 4) = (f32x4){run[4], run[5], run[6], run[7]}; }
        }
        __syncthreads();
        if (mode != 0) {
            const int tt = w & 3, eh = w >> 2;
            f32x4 at[4];
#pragma unroll
            for (int j = 0; j < 4; ++j) { at[j] = (f32x4){0.f, 0.f, 0.f, 0.f};
                if (j <= tt) {
#pragma unroll
                    for (int ks = 0; ks < 2; ++ks) at[j] = mfma16(rm_frag(KO, STR, 16 * j + c, 32 * ks + 8 * g), rm_frag(QJ + j * 64 * STR, STR, 16 * tt + c, 32 * ks + 8 * g), at[j]);
                    if (j == tt) {
#pragma unroll
                        for (int r = 0; r < 4; ++r) if (4 * g + r > c) at[j][r] = 0.f; }
                } }
            bf16x8 pf[2];
#pragma unroll
            for (int k2 = 0; k2 < 2; ++k2) { const unsigned u0 = pk2(at[2 * k2][0], at[2 * k2][1]), u1 = pk2(at[2 * k2][2], at[2 * k2][3]), u2 = pk2(at[2 * k2 + 1][0], at[2 * k2 + 1][1]), u3 = pk2(at[2 * k2 + 1][2], at[2 * k2 + 1][3]);
                pf[k2] = __builtin_bit_cast(bf16x8, (v4u){u0, u1, u2, u3}); }
            bf16x8 qf[2];
#pragma unroll
            for (int ks = 0; ks < 2; ++ks) qf[ks] = rm_frag(QJ, STR, 16 * tt + c, 32 * ks + 8 * g);
#pragma unroll
            for (int ei = 0; ei < 2; ++ei) { const int et = 2 * eh + ei;
                f32x4 acc = (f32x4){0.f, 0.f, 0.f, 0.f};
#pragma unroll
                for (int k2 = 0; k2 < 2; ++k2) if (2 * k2 <= tt) acc = mfma16(tr_frag(VS, STR, 32 * k2 + 4 * g, 32 * k2 + 16 + 4 * g, 16 * et, lane), pf[k2], acc);
#pragma unroll
                for (int ks = 0; ks < 2; ++ks) acc = mfma16(rm_frag(STc, STR, 16 * et + c, 32 * ks + 8 * g), qf[ks], acc);
                *(LAS f32x4*)(HT + (16 * tt + c) * 68 + 16 * et + 4 * g) = acc; }
        }
        {
            const f32x4 blv = *(const LAS f32x4*)(BL + 16 * dt + 4 * g);
#pragma unroll
            for (int r = 0; r < 4; ++r) { const float dec = __expf(blv[r]); Sst[0][r] *= dec; Sst[1][r] *= dec; Btot[r] += blv[r]; }
#pragma unroll
            for (int k2 = 0; k2 < 2; ++k2) { const bf16x8 af = tr_frag(KH, STR, 32 * k2 + 8 * g, 32 * k2 + 8 * g + 4, 16 * dt, lane);
#pragma unroll
                for (int i = 0; i < 2; ++i) Sst[i] = mfma16(af, tr_frag(VS, STR, 32 * k2 + 8 * g, 32 * k2 + 8 * g + 4, 16 * (et0 + i), lane), Sst[i]); }
            if (mode != 0) {
#pragma unroll
                for (int i = 0; i < 2; ++i) { v2u v; v.x = pk2(Sst[i][0], Sst[i][1]); v.y = pk2(Sst[i][2], Sst[i][3]); *(LAS v2u*)(STn + (16 * (et0 + i) + c) * STR + 16 * dt + 4 * g) = v; } }
        }
        __syncthreads();
        if (mode != 0) {
            const int i = tid >> 3, sub8 = tid & 7, e0 = 8 * sub8; const int m = rowbase + tok_of(ci, i);
            float hv[8];
            { const f32x4 a0 = *(const LAS f32x4*)(HT + i * 68 + e0), a1 = *(const LAS f32x4*)(HT + i * 68 + e0 + 4); hv[0] = a0[0]; hv[1] = a0[1]; hv[2] = a0[2]; hv[3] = a0[3]; hv[4] = a1[0]; hv[5] = a1[1]; hv[6] = a1[2]; hv[7] = a1[3]; }
            bf16* tp = otmp + (size_t)m * 256 + h * 64 + e0;
            if (mode == 1) *(v4u*)tp = pack8(hv);
            else {
                float tv[8]; unpack8(*(const v4u*)tp, tv);
                float ss = 0.f;
#pragma unroll
                for (int e = 0; e < 8; ++e) { hv[e] += tv[e]; ss += hv[e] * hv[e]; }
                ss += __shfl_xor(ss, 1); ss += __shfl_xor(ss, 2); ss += __shfl_xor(ss, 4);
                const float rinv = 1.f / sqrtf(ss * (1.f / 64.f) + EPS);
                float zv[8]; unpack8(*(const v4u*)(P + (size_t)m * PLD + A_Z + h * 64 + e0), zv);
                const float* gn = F.hgrn_gn + l * 256 + h * 64 + e0;
#pragma unroll
                for (int e = 0; e < 8; ++e) hv[e] = hv[e] * rinv * gn[e] * silu_f(zv[e]);
                *(v4u*)(F.hxy + (size_t)m * 1024 + h * 64 + e0) = pack8(hv);
            }
        }
    }
    if (emit_slot >= 0) {
        float* sl = STd + (size_t)emit_slot * ST_FLOATS;
#pragma unroll
        for (int i = 0; i < 2; ++i)
#pragma unroll
            for (int r = 0; r < 4; ++r) sl[(16 * dt + 4 * g + r) * 64 + 16 * (et0 + i) + c] = Sst[i][r];
        if ((w & 1) == 0 && c == 0) {
#pragma unroll
            for (int r = 0; r < 4; ++r) sl[64 * 64 + 16 * dt + 4 * g + r] = Btot[r]; }
    }
    __syncthreads();
}
__device__ __forceinline__ void hgrn_itemA(const Ctx& F, int l, int bh, int it, bf16* otmp, float* ST) {
    const int b = bh >> 2, h = bh & 3;
    if (it == 0) {
        const MlJob jb{b, h, 1, 0, 4};
        hgrn_dir(F, l, jb, 0, -1, 0, l == 0 ? 1 : 0, otmp, ST);
        hgrn_dir(F, l, jb, 1, -1, 0, l == 0 ? 2 : 0, otmp, ST);
    } else {
        const int dir = (it - 1) / 7, k = (it - 1) % 7, seg = dir == 0 ? k : 7 - k;
        const MlJob jb{b, h, 0, 512 * seg, 8};
        hgrn_dir(F, l, jb, dir, -1, 1 + k, 0, otmp, ST);
    }
}
__device__ __forceinline__ void hgrn_itemC(const Ctx& F, int l, int bh, int seg, bf16* otmp, float* ST) {
    const MlJob jb{bh >> 2, bh & 3, 0, 512 * seg, 8};
    hgrn_dir(F, l, jb, 0, seg, -1, 1, otmp, ST);
    hgrn_dir(F, l, jb, 1, 7 - seg, -1, 2, otmp, ST);
}

namespace nat {
constexpr int STR = 72, IMG = 64 * STR * 2;
constexpr int OFF_K = 0, OFF_V = 2 * IMG, OFF_RPB = 4 * IMG, OFF_END = OFF_RPB + 2048;
static_assert(OFF_END <= RING_BYTES, "na LDS");
}
__device__ __forceinline__ void na_item(const Ctx& F, int l, int b, int h, int R0) {
    using namespace nat;
    int tid_ = F.tid; asm volatile("" : "+v"(tid_));
    const int tid = tid_, lane = tid & 63, w = __builtin_amdgcn_readfirstlane(tid >> 6), g = lane >> 4, c = lane & 15;
    LAS bf16* KT = (LAS bf16*)(F.lds + OFF_K); LAS bf16* VT = (LAS bf16*)(F.lds + OFF_V); LAS float* RPB = (LAS float*)(F.lds + OFF_RPB);
    const bf16* P = F.P; const bool lat = R0 >= 0;
    const int R = R0 + (w >> 1), ch = w & 1;
    const int rsR = min(max(R - 4, 0), 56);
    const int kr0 = lat ? min(max(R0 - 4, 0), 56) : 0;
    const int nwin = lat ? (min(max(R0 + 3 - 4, 0), 56) + 8 - kr0) : 0, nblk = nwin + 4;
    if (lat) for (int i = tid; i < 15 * 31; i += 512) RPB[i] = F.na_rpb[((size_t)l * 6 + h) * 465 + i];
    int mq[2]; bf16x8 qf[2][2]; int csq[2], qcol[2];
#pragma unroll
    for (int qt = 0; qt < 2; ++qt) {
        if (lat) { qcol[qt] = 32 * ch + 16 * qt + c; mq[qt] = b * S + R * 64 + qcol[qt]; } else { qcol[qt] = 0; mq[qt] = MX + b * CTX + 32 * w + 16 * qt + c; }
        csq[qt] = min(max(qcol[qt] - 8, 0), 48);
#pragma unroll
        for (int ks = 0; ks < 2; ++ks) { float f[8]; unpack8(*(const v4u*)(P + (size_t)mq[qt] * PLD + C_Q + h * 64 + 32 * ks + 8 * g), f);
#pragma unroll
            for (int e = 0; e < 8; ++e) f[e] *= 0.125f;
            qf[qt][ks] = __builtin_bit_cast(bf16x8, pack8(f)); }
    }
    f32x4 oacc[2][4]; float mrun[2], lrun[2];
#pragma unroll
    for (int qt = 0; qt < 2; ++qt) { mrun[qt] = -1e30f; lrun[qt] = 0.f;
#pragma unroll
        for (int dtl = 0; dtl < 4; ++dtl) oacc[qt][dtl] = (f32x4){0.f, 0.f, 0.f, 0.f}; }
    const int stok = tid >> 3, spc = tid & 7;
    auto blk_row = [&](int i) -> int { return i < nwin ? b * S + (kr0 + i) * 64 + stok : MX + b * CTX + 64 * (i - nwin) + stok; };
    v4u rk, rv;
    { const bf16* pr = P + (size_t)blk_row(0) * PLD + h * 64 + 8 * spc; rk = *(const v4u*)(pr + C_K); rv = *(const v4u*)(pr + C_V); }
    __syncthreads();
    *(LAS v4u*)(KT + stok * STR + 8 * spc) = rk; *(LAS v4u*)(VT + stok * STR + 8 * spc) = rv;
    if (nblk > 1) { const bf16* pr = P + (size_t)blk_row(1) * PLD + h * 64 + 8 * spc; rk = *(const v4u*)(pr + C_K); rv = *(const v4u*)(pr + C_V); }
    __syncthreads();
    for (int i = 0; i < nblk; ++i) {
        const LAS bf16* Kc = KT + (i & 1) * 64 * STR; const LAS bf16* Vc = VT + (i & 1) * 64 * STR;
        if (i + 1 < nblk) { LAS bf16* Kn = KT + ((i + 1) & 1) * 64 * STR; LAS bf16* Vn = VT + ((i + 1) & 1) * 64 * STR;
            *(LAS v4u*)(Kn + stok * STR + 8 * spc) = rk; *(LAS v4u*)(Vn + stok * STR + 8 * spc) = rv;
            if (i + 2 < nblk) { const bf16* pr = P + (size_t)blk_row(i + 2) * PLD + h * 64 + 8 * spc; rk = *(const v4u*)(pr + C_K); rv = *(const v4u*)(pr + C_V); } }
        const bool win = i < nwin; const int kr = kr0 + i;
        const bool active = !win || (kr >= rsR && kr < rsR + 8);
        if (active) {
#pragma unroll
            for (int qt = 0; qt < 2; ++qt) {
                f32x4 st[4];
#pragma unroll
                for (int kt = 0; kt < 4; ++kt) { st[kt] = (f32x4){0.f, 0.f, 0.f, 0.f};
#pragma unroll
                    for (int ks = 0; ks < 2; ++ks) st[kt] = mfma16(rm_frag(Kc, STR, 16 * kt + c, 32 * ks + 8 * g), qf[qt][ks], st[kt]); }
                if (win) { const int boff = (kr - R + 7) * 31 + 15 - qcol[qt];
#pragma unroll
                    for (int kt = 0; kt < 4; ++kt)
#pragma unroll
                        for (int r = 0; r < 4; ++r) { const int kc = 16 * kt + 4 * g + r; const bool ok = (unsigned)(kc - csq[qt]) < 16u; const float bias = RPB[ok ? boff + kc : 0]; st[kt][r] = ok ? st[kt][r] + bias : -1e30f; } }
                float bm = -1e30f;
#pragma unroll
                for (int kt = 0; kt < 4; ++kt)
#pragma unroll
                    for (int r = 0; r < 4; ++r) bm = fmaxf(bm, st[kt][r]);
                bm = fmaxf(bm, __shfl_xor(bm, 16)); bm = fmaxf(bm, __shfl_xor(bm, 32));
                const float mnew = fmaxf(mrun[qt], bm), alpha = __expf(mrun[qt] - mnew); mrun[qt] = mnew;
                float ps = 0.f;
#pragma unroll
                for (int kt = 0; kt < 4; ++kt)
#pragma unroll
                    for (int r = 0; r < 4; ++r) { const float p = __expf(st[kt][r] - mnew); st[kt][r] = p; ps += p; }
                lrun[qt] = lrun[qt] * alpha + ps;
                bf16x8 pf[2];
#pragma unroll
                for (int k2 = 0; k2 < 2; ++k2) { const unsigned u0 = pk2(st[2 * k2][0], st[2 * k2][1]), u1 = pk2(st[2 * k2][2], st[2 * k2][3]), u2 = pk2(st[2 * k2 + 1][0], st[2 * k2 + 1][1]), u3 = pk2(st[2 * k2 + 1][2], st[2 * k2 + 1][3]);
                    pf[k2] = __builtin_bit_cast(bf16x8, (v4u){u0, u1, u2, u3}); }
#pragma unroll
                for (int dtl = 0; dtl < 4; ++dtl) { f32x4 a = oacc[qt][dtl] * alpha;
#pragma unroll
                    for (int k2 = 0; k2 < 2; ++k2) a = mfma16(tr_frag(Vc, STR, 32 * k2 + 4 * g, 32 * k2 + 16 + 4 * g, 16 * dtl, lane), pf[k2], a);
                    oacc[qt][dtl] = a; }
            }
        }
        __syncthreads();
    }
#pragma unroll
    for (int qt = 0; qt < 2; ++qt) {
        float lt = lrun[qt]; lt += __shfl_xor(lt, 16); lt += __shfl_xor(lt, 32);
        const float rl = 1.f / lt;
        const bf16* zr = P + (size_t)mq[qt] * PLD + C_Z + h * 64; bf16* yr = F.hxy + (size_t)mq[qt] * 1024 + 640 + h * 64;
#pragma unroll
        for (int dtl = 0; dtl < 4; ++dtl) { const int d = 16 * dtl + 4 * g; const v2u zv = *(const v2u*)(zr + d);
            const float z0 = __uint_as_float(zv.x << 16), z1 = __uint_as_float(zv.x & 0xffff0000u), z2 = __uint_as_float(zv.y << 16), z3 = __uint_as_float(zv.y & 0xffff0000u);
            v2u o; o.x = pk2(oacc[qt][dtl][0] * rl * silu_f(z0), oacc[qt][dtl][1] * rl * silu_f(z1)); o.y = pk2(oacc[qt][dtl][2] * rl * silu_f(z2), oacc[qt][dtl][3] * rl * silu_f(z3));
            *(v2u*)(yr + d) = o; }
    }
}

__device__ __forceinline__ void phase_mixA(const Ctx& F, int l) {
    mlstm_load_rope(F, F.rope);
    for (int it = F.vcu; it < 2 * 32 * 15; it += F.G) {
        if (it < 32 * 15) mlstm_itemA(F, l, it / 15, it % 15, F.otm, F.stm);
        else { const int i2 = it - 32 * 15; hgrn_itemA(F, l, i2 / 15, i2 % 15, F.oth, F.sth); }
    }
    const int nna = 8 * 6 * 16 + (l == 0 ? 48 : 0);
    for (int it = F.G - 1 - F.vcu; it < nna; it += F.G) {
        if (it < 768) na_item(F, l, it / 96, (it / 16) % 6, 4 * (it % 16));
        else na_item(F, l, (it - 768) / 6, (it - 768) % 6, -1);
    }
}
__device__ __forceinline__ void phase_mixC(const Ctx& F, int l) {
    mlstm_load_rope(F, F.rope);
    for (int it = F.vcu; it < 512; it += F.G) {
        if (it < 256) mlstm_itemC(F, l, it >> 3, it & 7, F.otm, F.stm);
        else hgrn_itemC(F, l, (it - 256) >> 3, it & 7, F.oth, F.sth);
    }
}

constexpr int NPH = 12;
struct Args { const float* in[15]; float* out; unsigned char* ws; int ph_lo, ph_hi; };
__global__ void __launch_bounds__(512, 2) mega_fwd(Args args) {
    extern __shared__ __attribute__((aligned(16))) unsigned char lds[];
    Ctx F;
    F.lds = (LAS unsigned char*)lds;
    F.tid = threadIdx.x; F.lane = F.tid & 63; F.wave = __builtin_amdgcn_readfirstlane(F.tid >> 6);
    F.G = gridDim.x; { const int bx = blockIdx.x; F.vcu = (F.G % 8 == 0) ? (bx % 8) * (F.G / 8) + bx / 8 : bx; }
    F.gw = F.vcu * 8 + F.wave; F.NGW = F.G * 8;
    unsigned char* ws = args.ws;
    F.x = args.in[0]; F.c = args.in[1]; F.ctx = args.in[2]; F.c_ctx = args.in[3]; F.w_mod = args.in[4]; F.b_mod = args.in[5]; F.g_pre = args.in[6]; F.g_post = args.in[7];
    F.w_in = args.in[8]; F.w_out = args.in[9]; F.hgrn_lb = args.in[10]; F.hgrn_gn = args.in[11]; F.gate_b = args.in[12]; F.mlstm_gn = args.in[13]; F.na_rpb = args.in[14];
    F.out = args.out;
    F.wt_in = (bf16*)(ws + WS_WT_IN); F.wt_out = (bf16*)(ws + WS_WT_OUT); F.mod = (float*)(ws + WS_MOD); F.gates = (float*)(ws + WS_GATES); F.ctx1 = (float*)(ws + WS_CTX1);
    F.hxy = (bf16*)(ws + WS_HXY); F.P = (bf16*)(ws + WS_P); F.UX = (float*)(ws + WS_P); F.oth = (bf16*)(ws + WS_OH); F.sth = (float*)(ws + WS_STH); F.otm = (bf16*)(ws + WS_OM); F.stm = (float*)(ws + WS_STM); F.rope = (float*)(ws + WS_ROPE);
    for (int u = F.tid; u < (LDS_BYTES - LDSCTL_OFF) / 4; u += 512) ((LAS unsigned*)(F.lds + LDSCTL_OFF))[u] = 0u;
    __syncthreads();
    XcdBarrier bar = xcd_barrier_post((unsigned*)(ws + WS_CTL) + CW_BAR, (volatile LAS unsigned*)(F.lds + MISC_OFF) + 8);

    const int lo = args.ph_lo, hi = args.ph_hi;
#define IN(k) (lo <= (k) && (k) < hi)
#define SEAM(k) do { if ((k) + 1 < hi) xcd_barrier(bar); } while (0)
    if (IN(0)) { phase_p0(F); SEAM(0); }
    if (IN(1)) { phase_prenorm0(F); SEAM(1); }
#define LAYER(l) \
    if (IN(2 + 5 * (l))) { \
        pg8::Gemm g{F.hxy, F.wt_in + (size_t)(l) * NPAD * 1024, M, NPAD, 1024}; pg8::StaticOrder SO; SO.init(M, NPAD, F.G, (int)blockIdx.x); \
        pg8::EpiIn E{F.P, F.gates, F.gate_b + (l) * 16}; \
        pg8::gemm_phase<pg8::EpiIn, pg8::StaticOrder, true, true>(F.lds + RING_OFF, g, SO, E); SEAM(2 + 5 * (l)); } \
    if (IN(3 + 5 * (l))) { phase_mixA(F, (l)); SEAM(3 + 5 * (l)); } \
    if (IN(4 + 5 * (l))) { phase_mixC(F, (l)); SEAM(4 + 5 * (l)); } \
    if (IN(5 + 5 * (l))) { \
        constexpr int Ml = (l) == 0 ? M : MX; \
        pg8::Gemm g{F.hxy, F.wt_out + (size_t)(l) * 1024 * 1024, Ml, 1024, 1024}; pg8::StaticOrder SO; SO.init(Ml, 1024, F.G, (int)blockIdx.x); \
        pg8::EpiOut E{F.UX}; \
        pg8::gemm_phase<pg8::EpiOut, pg8::StaticOrder, true, true>(F.lds + RING_OFF, g, SO, E); SEAM(5 + 5 * (l)); } \
    if (IN(6 + 5 * (l))) { phase_post(F, (l)); SEAM(6 + 5 * (l)); }
    LAYER(0)
    LAYER(1)
#undef LAYER
#undef IN
#undef SEAM
}

extern "C" void kernel_launch(void* const* d_in, const int* in_sizes, int n_in, void* d_out, int out_size, void* d_ws, size_t ws_size, hipStream_t stream) {
    static int grid = 0;
    if (grid == 0) {
        if (n_in != 15 || ws_size < WS_END) { fprintf(stderr, "kernel_launch: unexpected n_in %d / ws_size %zu (need %zu); nothing launched\n", n_in, ws_size, (size_t)WS_END); grid = -1; return; }
        int dev = 0, cus = 0, per_cu = 0;
        if (hipGetDevice(&dev) != hipSuccess || hipDeviceGetAttribute(&cus, hipDeviceAttributeMultiprocessorCount, dev) != hipSuccess) { grid = -1; return; }
        if (hipFuncSetAttribute((const void*)mega_fwd, hipFuncAttributeMaxDynamicSharedMemorySize, LDS_BYTES) != hipSuccess) { fprintf(stderr, "kernel_launch: hipFuncSetAttribute failed\n"); grid = -1; return; }
        if (hipOccupancyMaxActiveBlocksPerMultiprocessor(&per_cu, (const void*)mega_fwd, 512, LDS_BYTES) != hipSuccess || per_cu < 1) { fprintf(stderr, "kernel_launch: occupancy query says %d blocks/CU\n", per_cu); (void)hipGetLastError(); grid = -1; return; }
        grid = cus;
    }
    if (grid < 0) return;
    (void)hipMemsetAsync((char*)d_ws + WS_CTL, 0, CTL_BYTES, stream);
    Args a{};
    for (int i = 0; i < 15; ++i) a.in[i] = (const float*)d_in[i];
    a.out = (float*)d_out; a.ws = (unsigned char*)d_ws; a.ph_lo = 0; a.ph_hi = NPH;
    hipLaunchKernelGGL(mega_fwd, dim3(grid), dim3(512), LDS_BYTES, stream, a);
}
```

```cpp
#include <hip/hip_runtime.h>
#include <stdint.h>
#include <cstdio>

namespace cfg {
constexpr int D = 1024, NB = 8, S = 4096, CTX = 256;
constexpr int MX = NB * S, MC = NB * CTX, M = MX + MC;
constexpr int PIN = 4752, NPAD = 4864, PLD = 4736;
constexpr int A_Q = 0, A_FF = 256, A_FB = 512, A_I = 768, A_Z = 1024, B_Q = 1280, B_K = 1664, B_V = 2048, B_O = 2432, B_Z = 2816,
              C_Q = 3200, C_K = 3584, C_V = 3968, C_Z = 4352;
constexpr float EPS = 1e-6f;
constexpr size_t WS_CTL = 0, CTL_BYTES = 65536;
constexpr size_t WS_WT_IN = WS_CTL + CTL_BYTES;
constexpr size_t WS_WT_OUT = WS_WT_IN + 2ull * NPAD * 1024 * 2;
constexpr size_t WS_MOD = WS_WT_OUT + 2ull * 1024 * 1024 * 2;
constexpr size_t WS_GATES = WS_MOD + 2ull * 9 * 3072 * 4;
constexpr size_t WS_CTX1 = WS_GATES + (size_t)M * 16 * 4;
constexpr size_t WS_HXY = WS_CTX1 + (size_t)MC * 1024 * 4;
constexpr size_t WS_P = WS_HXY + (size_t)M * 1024 * 2;
constexpr size_t WS_OH = WS_P + (size_t)M * PLD * 2;
constexpr size_t WS_OM = WS_OH + (size_t)M * 256 * 4;
constexpr size_t WS_STM = WS_OM + (size_t)M * 384 * 2;
constexpr size_t WS_ROPE = WS_STM + 32ull * 2 * 8 * (96 * 112 + 16) * 4;
constexpr size_t WS_STH = WS_ROPE + 64 * 24 * 8;
constexpr size_t WS_END = WS_STH + 32ull * 2 * 8 * (64 * 64 + 64) * 4;
static_assert(WS_END <= 536870912ull, "workspace");
static_assert(WS_WT_IN % 256 == 0 && WS_MOD % 256 == 0 && WS_GATES % 256 == 0 && WS_CTX1 % 256 == 0 && WS_HXY % 256 == 0 && WS_P % 256 == 0 && WS_OH % 256 == 0 && WS_OM % 256 == 0 && WS_STM % 256 == 0 && WS_ROPE % 256 == 0 && WS_STH % 256 == 0, "align");
}
using namespace cfg;

namespace pg8 {
#define PG8_LAS __attribute__((address_space(3)))
typedef unsigned short bf16_t;
typedef short bf16x8 __attribute__((ext_vector_type(8)));
typedef float f32x4 __attribute__((ext_vector_type(4)));
typedef unsigned u32x4 __attribute__((ext_vector_type(4)));
constexpr int BM = 256, BK = 64, HALF = 128, HTB = HALF * BK * 2  , STAGE_BYTES = 8 * HTB, NXCD = 8, WGM = 8;

__host__ __device__ __forceinline__ int lds_byte(int r, int c) { const int st = (r >> 4) * 2 + (c >> 5), rr = r & 15, cc = c & 31, ob = rr * 64 + cc * 2; return st * 1024 + (ob ^ (((ob >> 9) & 1) << 5)); }
__host__ __device__ __forceinline__ void stage_rc(int b, int& R, int& C) { const int st = b / 1024, sb = b % 1024, swz = sb ^ (((sb >> 9) & 1) << 5); R = (st >> 1) * 16 + swz / 64; C = (st & 1) * 32 + (swz % 64) / 2; }
__host__ __device__ __forceinline__ int perm32(int rho) { const int n = rho >> 4, i = rho & 15; return 8 * (i >> 2) + 4 * n + (i & 3); }

struct Unit { int pm, pn; };
struct Gemm { const bf16_t* A; const bf16_t* Bt; int M, N, K; };

struct StaticOrder {
    int nM, nN, nwg, G, c;
    __host__ __device__ void init(int M, int N, int G_, int c_) { nM = M / BM; nN = N / BM; nwg = nM * nN; G = G_; c = c_; }
    __host__ __device__ bool next(int i, Unit& u) const {
        const long L = (long)i * G + c; if (L >= nwg) return false;
        int wgid = (int)L; { const int q = nwg / NXCD, r = nwg % NXCD, xcd = wgid % NXCD, off = wgid / NXCD; wgid = (xcd < r ? xcd * (q + 1) : r * (q + 1) + (xcd - r) * q) + off; }
        const int nig = WGM * nN, gid = wgid / nig, fm = gid * WGM, gsz = (nM - fm) < WGM ? (nM - fm) : WGM;
        u.pm = fm + ((wgid % nig) % gsz); u.pn = (wgid % nig) / gsz; return true;
    }
    __device__ __forceinline__ void a_ready(const Unit&) const {}
    __device__ __forceinline__ void done(const Unit&) const {}
};

__device__ __forceinline__ unsigned cvt_pk_bf16(float lo, float hi) { unsigned r; asm volatile("v_cvt_pk_bf16_f32 %0, %1, %2" : "=v"(r) : "v"(lo), "v"(hi)); return r; }
__device__ __forceinline__ float logsigmoid_e(float v) { return fminf(v, 0.f) - log1pf(__expf(-fabsf(v))); }

struct EpiIn {
    static constexpr bool PERM = true, AFTER_DRAIN = false;
    bf16_t* P; float* gates; const float* gate_b;
    __device__ __forceinline__ void operator()(const f32x4 (&acc)[2][2][4][2], const Unit& u, int wr, int wc, int fr, int fq) const {
        const int row0 = u.pm * BM + wr * 64 + fr, col0 = u.pn * BM + wc * 32 + 8 * fq;
#pragma unroll
        for (int bj = 0; bj < 2; ++bj) {
            const int col = col0 + bj * HALF;
            if (col < cfg::PLD) {
                const int act = col < 256 ? 1 : col < 1024 ? 0 : col < 1280 ? 2 : col < 1664 ? 3 : col < 2432 ? 0 : col < 2816 ? 4 : col < 3200 ? 2 : col < 3584 ? 5 : col < 4352 ? 0 : 2;
#pragma unroll
                for (int ai = 0; ai < 2; ++ai)
#pragma unroll
                    for (int m = 0; m < 4; ++m) { f32x4 v0 = acc[ai][bj][m][0], v1 = acc[ai][bj][m][1];
                        if (act == 1 || act == 2 || act == 4) { const float sc = act == 1 ? 0.125f : 1.f;
#pragma unroll
                            for (int e = 0; e < 4; ++e) { const float s0 = __builtin_amdgcn_rcpf(1.f + __expf(-v0[e])), s1 = __builtin_amdgcn_rcpf(1.f + __expf(-v1[e])); v0[e] = act == 4 ? s0 : v0[e] * s0 * sc; v1[e] = act == 4 ? s1 : v1[e] * s1 * sc; } }
                        else if (act == 3) { v0 = v0 * 0.10206207261596575f; v1 = v1 * 0.10206207261596575f; }
                        else if (act == 5) { v0 = v0 * (0.125f * 1.4426950408889634f); v1 = v1 * (0.125f * 1.4426950408889634f); }
                        u32x4 w; w.x = cvt_pk_bf16(v0[0], v0[1]); w.y = cvt_pk_bf16(v0[2], v0[3]); w.z = cvt_pk_bf16(v1[0], v1[1]); w.w = cvt_pk_bf16(v1[2], v1[3]);
                        *(u32x4*)(P + (size_t)(row0 + ai * HALF + m * 16) * cfg::PLD + col) = w; }
            } else if (col < cfg::PIN) {
                const int g0 = col - cfg::PLD;
                const f32x4 b0 = *(const f32x4*)(gate_b + g0), b1 = *(const f32x4*)(gate_b + g0 + 4);
#pragma unroll
                for (int ai = 0; ai < 2; ++ai)
#pragma unroll
                    for (int m = 0; m < 4; ++m) { f32x4 v0 = acc[ai][bj][m][0] + b0, v1 = acc[ai][bj][m][1] + b1;
                        if (g0 >= 8) {
#pragma unroll
                            for (int e = 0; e < 4; ++e) { v0[e] = logsigmoid_e(v0[e]); v1[e] = logsigmoid_e(v1[e]); } }
                        float* gp = gates + (size_t)(row0 + ai * HALF + m * 16) * 16 + g0;
                        *(f32x4*)gp = v0; *(f32x4*)(gp + 4) = v1; }
            }
        }
    }
};
struct EpiOut {
    static constexpr bool PERM = true, AFTER_DRAIN = false;
    bf16_t* C;
    __device__ __forceinline__ void operator()(const f32x4 (&acc)[2][2][4][2], const Unit& u, int wr, int wc, int fr, int fq) const {
        const int row0 = u.pm * BM + wr * 64 + fr, col0 = u.pn * BM + wc * 32 + 8 * fq;
#pragma unroll
        for (int ai = 0; ai < 2; ++ai)
#pragma unroll
            for (int m = 0; m < 4; ++m) { bf16_t* rowp = C + (size_t)(row0 + ai * HALF + m * 16) * 1024 + col0;
#pragma unroll
                for (int bj = 0; bj < 2; ++bj) { const f32x4 v0 = acc[ai][bj][m][0], v1 = acc[ai][bj][m][1];
                    u32x4 w; w.x = cvt_pk_bf16(v0[0], v0[1]); w.y = cvt_pk_bf16(v0[2], v0[3]); w.z = cvt_pk_bf16(v1[0], v1[1]); w.w = cvt_pk_bf16(v1[2], v1[3]);
                    *(u32x4*)(rowp + bj * HALF) = w; } }
    }
};
struct SkipOrder {
    StaticOrder lat; int G, c;
    __device__ void init(int G_, int c_) { lat.init(cfg::MX, cfg::NPAD, G_, c_); G = G_; c = c_; }
    __device__ bool next(int i, Unit& u) const {
        const int L = i * G + c;
        if (L < lat.nwg) return lat.next(i, u);
        const int j = L - lat.nwg; if (j >= 88) return false;
        const int jj = j % 11; u.pm = 128 + j / 11;
        u.pn = jj < 3 ? 1 + jj : jj < 7 ? 3 + jj : jj < 10 ? 7 + jj : 18;
        return true;
    }
    __device__ __forceinline__ void a_ready(const Unit&) const {}
    __device__ __forceinline__ void done(const Unit&) const {}
};

template <class Epi, class Sched, bool ALIGN_EPI = false, bool SP2 = false>
__device__ __forceinline__ void gemm_phase(PG8_LAS unsigned char* lds, const Gemm g, const Sched& S, const Epi& E) {
    const int tid = threadIdx.x, wid = __builtin_amdgcn_readfirstlane(tid >> 6), lane = tid & 63, wr = wid >> 2, wc = wid & 3, fr = lane & 15, fq = lane >> 4;
    const int K = g.K, nt = K / BK;
    unsigned voffA[2], voffB[2];
#pragma unroll
    for (int i = 0; i < 2; ++i) { int R, C; stage_rc(tid * 16 + i * 8192, R, C); const int Rb = Epi::PERM ? ((R & ~31) + perm32(R & 31)) : R;
        voffA[i] = (unsigned)(R * K + C) * 2u; voffB[i] = (unsigned)(Rb * K + C) * 2u; }
    const size_t kstep = (size_t)(BK * 2);
    const size_t hstep = (size_t)HALF * K * 2;
    const size_t tstep = 2 * hstep;
    const unsigned ldsw = (unsigned)wid * 1024u;
    const int aoff = lds_byte(wr * 64 + fr, fq * 8), boff = lds_byte(wc * 32 + fr, fq * 8);
#define PG8_SA(b, h) (((b) * 2 + (h)) * HTB)
#define PG8_SB(b, h) ((4 + (b) * 2 + (h)) * HTB)
#define PG8_STAGE(bufoff, gbase, voff) do { _Pragma("unroll") for (int _i = 0; _i < 2; ++_i) \
        __builtin_amdgcn_global_load_lds((const unsigned*)((const char*)(gbase) + (voff)[_i]), (PG8_LAS unsigned*)(lds + (bufoff) + ldsw + _i * 8192), 16, 0, 0); } while (0)
#define PG8_LDA(dst, b, h) do { _Pragma("unroll") for (int m = 0; m < 4; ++m) _Pragma("unroll") for (int k = 0; k < 2; ++k) dst[m][k] = *(const PG8_LAS bf16x8*)(lds + PG8_SA(b, h) + aoff + m * 2048 + k * 1024); } while (0)
#define PG8_LDB(dst, b, h) do { _Pragma("unroll") for (int n = 0; n < 2; ++n) _Pragma("unroll") for (int k = 0; k < 2; ++k) dst[n][k] = *(const PG8_LAS bf16x8*)(lds + PG8_SB(b, h) + boff + n * 2048 + k * 1024); } while (0)
#define PG8_MMA(ai, bj, At, Bt) do { __builtin_amdgcn_s_setprio(1); _Pragma("unroll") for (int m = 0; m < 4; ++m) _Pragma("unroll") for (int n = 0; n < 2; ++n) _Pragma("unroll") for (int k = 0; k < 2; ++k) \
        acc[ai][bj][m][n] = __builtin_amdgcn_mfma_f32_16x16x32_bf16(Bt[n][k], At[m][k], acc[ai][bj][m][n], 0, 0, 0); __builtin_amdgcn_s_setprio(0); } while (0)
#define PG8_WAIT_V(n) asm volatile("s_waitcnt vmcnt(" #n ")" ::: "memory")
#define PG8_WAIT_L(n) asm volatile("s_waitcnt lgkmcnt(" #n ")" ::: "memory")
#define PG8_BAR __builtin_amdgcn_s_barrier()
#define PG8_SCHED __builtin_amdgcn_sched_barrier(0)
    Unit cur, nxt; int ui = 0;
    if (!S.next(0, cur)) return;
    f32x4 acc[2][2][4][2];
#pragma unroll
    for (int a = 0; a < 2; ++a)
#pragma unroll
        for (int b = 0; b < 2; ++b)
#pragma unroll
            for (int m = 0; m < 4; ++m)
#pragma unroll
                for (int n = 0; n < 2; ++n) acc[a][b][m][n] = (f32x4){0.f, 0.f, 0.f, 0.f};
    bf16x8 At[4][2], B0[2][2], B1[2][2];
    const char* cA = (const char*)g.A + (size_t)cur.pm * tstep; const char* cB = (const char*)g.Bt + (size_t)cur.pn * tstep;
    S.a_ready(cur);
    if constexpr (SP2) {
        PG8_STAGE(PG8_SB(0, 0), cB, voffB); PG8_STAGE(PG8_SB(0, 1), cB + hstep, voffB); PG8_STAGE(PG8_SA(0, 0), cA, voffA); PG8_STAGE(PG8_SA(0, 1), cA + hstep, voffA);
        if (wr == 1) PG8_BAR;
        PG8_WAIT_V(2); PG8_BAR;
        PG8_STAGE(PG8_SB(1, 0), cB + kstep, voffB); PG8_STAGE(PG8_SA(1, 0), cA + kstep, voffA); PG8_STAGE(PG8_SB(1, 1), cB + hstep + kstep, voffB);
        PG8_WAIT_V(6); PG8_BAR;
    } else {
        PG8_STAGE(PG8_SB(0, 0), cB, voffB); PG8_STAGE(PG8_SA(0, 0), cA, voffA); PG8_STAGE(PG8_SB(0, 1), cB + hstep, voffB); PG8_STAGE(PG8_SA(0, 1), cA + hstep, voffA);
        if (wr == 1) PG8_BAR;
        PG8_WAIT_V(4); PG8_BAR;
        PG8_STAGE(PG8_SB(1, 0), cB + kstep, voffB); PG8_STAGE(PG8_SA(1, 0), cA + kstep, voffA); PG8_STAGE(PG8_SB(1, 1), cB + hstep + kstep, voffB);
        PG8_WAIT_V(6); PG8_BAR;
    }
    for (;;) {
        const bool has_next = S.next(ui + 1, nxt);
        const char* nA = has_next ? (const char*)g.A + (size_t)nxt.pm * tstep : cA; const char* nB = has_next ? (const char*)g.Bt + (size_t)nxt.pn * tstep : cB;
        for (int t = 0; t < nt; t += 2) {
            const bool last = (t == nt - 2);
            const char* a1 = cA + (size_t)(t + 1) * kstep;
            const char* a2 = last ? nA : cA + (size_t)(t + 2) * kstep; const char* b2 = last ? nB : cB + (size_t)(t + 2) * kstep;
            const char* a3 = a2 + kstep; const char* b3 = b2 + kstep;
            if (last && has_next) S.a_ready(nxt);
            if constexpr (SP2) {
            PG8_LDB(B0, 0, 0); PG8_LDB(B1, 0, 1); PG8_SCHED; PG8_LDA(At, 0, 0); PG8_STAGE(PG8_SA(1, 1), a1 + hstep, voffA);
            PG8_WAIT_V(8); PG8_WAIT_L(0); PG8_BAR; PG8_MMA(0, 0, At, B0); PG8_MMA(0, 1, At, B1); PG8_BAR; PG8_SCHED;
            PG8_LDA(At, 0, 1); PG8_STAGE(PG8_SB(0, 0), b2, voffB); PG8_STAGE(PG8_SB(0, 1), b2 + hstep, voffB); PG8_STAGE(PG8_SA(0, 0), a2, voffA);
            PG8_WAIT_V(8); PG8_WAIT_L(0); PG8_BAR; PG8_MMA(1, 0, At, B0); PG8_MMA(1, 1, At, B1); PG8_BAR; PG8_SCHED;
            PG8_LDB(B0, 1, 0); PG8_LDB(B1, 1, 1); PG8_SCHED; PG8_LDA(At, 1, 0); PG8_STAGE(PG8_SA(0, 1), a2 + hstep, voffA);
            PG8_WAIT_V(8); PG8_WAIT_L(0); PG8_BAR; PG8_MMA(0, 0, At, B0); PG8_MMA(0, 1, At, B1); PG8_BAR; PG8_SCHED;
            PG8_LDA(At, 1, 1); PG8_STAGE(PG8_SB(1, 0), b3, voffB); PG8_STAGE(PG8_SB(1, 1), b3 + hstep, voffB); PG8_STAGE(PG8_SA(1, 0), a3, voffA);
            PG8_WAIT_V(8); PG8_WAIT_L(0); PG8_BAR; PG8_MMA(1, 0, At, B0); PG8_MMA(1, 1, At, B1); PG8_BAR; PG8_SCHED;
            } else {
            PG8_LDB(B0, 0, 0); PG8_SCHED; PG8_LDA(At, 0, 0); PG8_STAGE(PG8_SA(1, 1), a1 + hstep, voffA);
            PG8_WAIT_L(8); PG8_BAR; PG8_WAIT_L(0); PG8_MMA(0, 0, At, B0); PG8_BAR; PG8_SCHED;
            PG8_LDB(B1, 0, 1); PG8_STAGE(PG8_SB(0, 0), b2, voffB);
            PG8_BAR; PG8_WAIT_L(0); PG8_MMA(0, 1, At, B1); PG8_BAR;
            PG8_LDA(At, 0, 1); PG8_STAGE(PG8_SA(0, 0), a2, voffA);
            PG8_BAR; PG8_WAIT_L(0); PG8_MMA(1, 0, At, B0); PG8_BAR; PG8_SCHED;
            PG8_STAGE(PG8_SB(0, 1), b2 + hstep, voffB);
            PG8_WAIT_V(6); PG8_BAR; PG8_MMA(1, 1, At, B1); PG8_BAR;
            PG8_LDB(B0, 1, 0); PG8_SCHED; PG8_LDA(At, 1, 0); PG8_STAGE(PG8_SA(0, 1), a2 + hstep, voffA);
            PG8_WAIT_L(8); PG8_BAR; PG8_WAIT_L(0); PG8_MMA(0, 0, At, B0); PG8_BAR; PG8_SCHED;
            PG8_LDB(B1, 1, 1); PG8_STAGE(PG8_SB(1, 0), b3, voffB);
            PG8_BAR; PG8_WAIT_L(0); PG8_MMA(0, 1, At, B1); PG8_BAR;
            PG8_LDA(At, 1, 1); PG8_STAGE(PG8_SA(1, 0), a3, voffA);
            PG8_BAR; PG8_WAIT_L(0); PG8_MMA(1, 0, At, B0); PG8_BAR; PG8_SCHED;
            PG8_STAGE(PG8_SB(1, 1), b3 + hstep, voffB);
            PG8_WAIT_V(6); PG8_BAR; PG8_MMA(1, 1, At, B1); PG8_BAR;
            }
        }
        if constexpr (ALIGN_EPI) { if (wr == 0) PG8_BAR; }
        if constexpr (!Epi::AFTER_DRAIN) { E(acc, cur, wr, wc, fr, fq); S.done(cur); }
        if (!has_next) break;
#pragma unroll
        for (int a = 0; a < 2; ++a)
#pragma unroll
            for (int b = 0; b < 2; ++b)
#pragma unroll
                for (int m = 0; m < 4; ++m)
#pragma unroll
                    for (int n = 0; n < 2; ++n) acc[a][b][m][n] = (f32x4){0.f, 0.f, 0.f, 0.f};
        cur = nxt; cA = nA; cB = nB; ++ui;
        if constexpr (ALIGN_EPI) { if (wr == 1) PG8_BAR; }
    }
    PG8_WAIT_V(0);
    if constexpr (!ALIGN_EPI) { if (wr == 0) PG8_BAR; }
    PG8_BAR;
    if constexpr (Epi::AFTER_DRAIN) { E.fused(acc, cur, wr, wc, fr, fq, lds, wid, lane); S.done(cur); }
#undef PG8_SA
#undef PG8_SB
#undef PG8_STAGE
#undef PG8_LDA
#undef PG8_LDB
#undef PG8_MMA
#undef PG8_WAIT_V
#undef PG8_WAIT_L
#undef PG8_BAR
#undef PG8_SCHED
}
}
constexpr int RING_OFF = 0, RING_BYTES = 131072;
constexpr int LDSCTL_OFF = RING_BYTES, MISC_OFF = LDSCTL_OFF + 320;
constexpr int LDS_BYTES = 147456;
constexpr int CW_BAR = 4096;

#define GAS __attribute__((address_space(1)))
#define LAS __attribute__((address_space(3)))
typedef unsigned short bf16;
typedef unsigned v4u __attribute__((ext_vector_type(4)));
typedef float f32x4 __attribute__((ext_vector_type(4)));
typedef short bf16x8 __attribute__((ext_vector_type(8)));
typedef GAS unsigned gu32;
#define RLX_AGENT __ATOMIC_RELAXED, __HIP_MEMORY_SCOPE_AGENT
#define LDS_WAIT() asm volatile("s_waitcnt lgkmcnt(0)" ::: "memory")
#define VM_WAIT() asm volatile("s_waitcnt vmcnt(0)" ::: "memory")
__device__ __forceinline__ unsigned f2bfu(float f) { unsigned u = __builtin_bit_cast(unsigned, f); return (u + 0x7fffu + ((u >> 16) & 1u)) >> 16; }
__device__ __forceinline__ bf16 f2bf(float f) { return (bf16)f2bfu(f); }
typedef float f32x2_t __attribute__((ext_vector_type(2))); typedef __bf16 bf16x2_t __attribute__((ext_vector_type(2)));
__device__ __forceinline__ unsigned pk2(float lo, float hi) { f32x2_t v = {lo, hi}; bf16x2_t b = __builtin_convertvector(v, bf16x2_t); return __builtin_bit_cast(unsigned, b); }
__device__ __forceinline__ float xor16_max(float v) { auto r = __builtin_amdgcn_permlane16_swap(__float_as_uint(v), __float_as_uint(v), false, false); return fmaxf(__uint_as_float(r[0]), __uint_as_float(r[1])); }
__device__ __forceinline__ float xor32_max(float v) { auto r = __builtin_amdgcn_permlane32_swap(__float_as_uint(v), __float_as_uint(v), false, false); return fmaxf(__uint_as_float(r[0]), __uint_as_float(r[1])); }
__device__ __forceinline__ float xor16_sum(float v) { auto r = __builtin_amdgcn_permlane16_swap(__float_as_uint(v), __float_as_uint(v), false, false); return __uint_as_float(r[0]) + __uint_as_float(r[1]); }
__device__ __forceinline__ float xor32_sum(float v) { auto r = __builtin_amdgcn_permlane32_swap(__float_as_uint(v), __float_as_uint(v), false, false); return __uint_as_float(r[0]) + __uint_as_float(r[1]); }
__device__ __forceinline__ float bf2f(bf16 v) { return __uint_as_float(((unsigned)v) << 16); }
__device__ __forceinline__ float silu_f(float v) { return v / (1.f + __expf(-v)); }
__device__ __forceinline__ float sigmoid_f(float v) { return 1.f / (1.f + __expf(-v)); }
__device__ __forceinline__ float wave_sum(float v) {
#pragma unroll
    for (int o = 1; o < 64; o <<= 1) v += __shfl_xor(v, o);
    return v;
}
__device__ __forceinline__ float rdlane(float v, int i) { return __int_as_float(__builtin_amdgcn_readlane(__float_as_int(v), i)); }


#ifndef PROBE_T
#define PROBE_T 0
#endif
#define TS_LDS(F) ((volatile LAS unsigned long long*)((F).lds + LDSCTL_OFF + 128))
#define TS_START(F, id) do { if (PROBE_T == (id) && blockIdx.x == 0 && (F).tid == 0) TS_LDS(F)[1] = __builtin_amdgcn_s_memtime(); } while (0)
#define TS_STOP(F, id)  do { if (PROBE_T == (id) && blockIdx.x == 0 && (F).tid == 0) TS_LDS(F)[0] += __builtin_amdgcn_s_memtime() - TS_LDS(F)[1]; } while (0)
#define XB_TMO      128
#define XB_XCNT(j)  (256  + 64 * (j))
#define XB_XSUB(j)  (1280 + 64 * (j))
#define XB_XGEN(j)  (2304 + 64 * (j))
#define XB_TOP      3328
#define XB_TOPGEN   3392
#define XCD_BAR_WORDS 3456
#define XB_SPIN_CAP (1u << 18)

__device__ __forceinline__ unsigned xb_ld(unsigned* p)              { return __hip_atomic_load(p, __ATOMIC_RELAXED, __HIP_MEMORY_SCOPE_AGENT); }
__device__ __forceinline__ unsigned xb_add(unsigned* p, unsigned v) { return __hip_atomic_fetch_add(p, v, __ATOMIC_RELAXED, __HIP_MEMORY_SCOPE_AGENT); }
__device__ __forceinline__ unsigned xb_xcc_id() { return (unsigned)__builtin_amdgcn_s_getreg((3 << 11) | 20) & 0xFu; }
#define XB_SPIN(cond, bar) do { unsigned _sp = 0; while (cond) { __builtin_amdgcn_s_sleep(1); \
    if ((++_sp & 255u) == 0u) { if (xb_ld(&(bar)[XB_TMO])) break; if (_sp > XB_SPIN_CAP) { atomicAdd(&(bar)[XB_TMO], 1u); break; } } } } while (0)

struct XcdBarrier {
    unsigned* bar; unsigned x;
    volatile LAS unsigned* st;
};

__device__ __forceinline__ XcdBarrier xcd_barrier_post(unsigned* bar, volatile LAS unsigned* st) {
    XcdBarrier b; b.bar = bar; b.x = xb_xcc_id(); b.st = st;
    if (threadIdx.x == 0) (void)xb_add(&bar[XB_XCNT(b.x)], 1u);
    return b;
}
__device__ __forceinline__ void xcd_barrier_complete(unsigned* bar, unsigned x, unsigned& nloc, unsigned& nx) {
    const unsigned G = gridDim.x * gridDim.y * gridDim.z;
    unsigned sum, cnt, mine, sp = 0u;
    for (;;) {
        sum = 0u; cnt = 0u; mine = 0u;
#pragma unroll
        for (unsigned j = 0; j < 16; ++j) { const unsigned c = xb_ld(&bar[XB_XCNT(j)]); sum += c; cnt += (c > 0u) ? 1u : 0u; mine = (j == x) ? c : mine; }
        if (sum == G) break;
        __builtin_amdgcn_s_sleep(1);
        if ((++sp & 255u) == 0u) { if (xb_ld(&bar[XB_TMO])) break; if (sp > XB_SPIN_CAP) { atomicAdd(&bar[XB_TMO], 1u); break; } }
    }
    nloc = mine > 0u ? mine : 1u; nx = cnt > 0u ? cnt : 1u;
}

__device__ __forceinline__ void xcd_barrier(const XcdBarrier& b) {
    asm volatile("s_waitcnt vmcnt(0)" ::: "memory");
    __syncthreads();
    if (threadIdx.x == 0) {
        unsigned* bar = b.bar;
        __builtin_amdgcn_s_waitcnt(0);
        unsigned nloc = b.st[0], nx = b.st[1];
        if (nloc == 0u) { xcd_barrier_complete(bar, b.x, nloc, nx); b.st[0] = nloc; b.st[1] = nx; }
        const unsigned old = xb_add(&bar[XB_XSUB(b.x)], 1u);
        const unsigned gen = old / nloc;
        if (old + 1u == (gen + 1u) * nloc) {
            __builtin_amdgcn_fence(__ATOMIC_RELEASE, "agent");
            asm volatile("s_waitcnt vmcnt(0)" ::: "memory");
            const unsigned og = xb_add(&bar[XB_TOP], 1u);
            const unsigned tg = og / nx;
            if (og + 1u == (tg + 1u) * nx) xb_add(&bar[XB_TOPGEN], 1u);
            else XB_SPIN(xb_ld(&bar[XB_TOPGEN]) == tg, bar);
            __builtin_amdgcn_fence(__ATOMIC_ACQUIRE, "agent");
            xb_add(&bar[XB_XGEN(b.x)], 1u);
            asm volatile("s_waitcnt vmcnt(0)" ::: "memory");
        } else {
            XB_SPIN(xb_ld(&bar[XB_XGEN(b.x)]) == gen, bar);
            __builtin_amdgcn_fence(__ATOMIC_ACQUIRE, "agent");
            asm volatile("s_waitcnt vmcnt(0)" ::: "memory");
        }
    }
    __syncthreads();
}

struct Ctx {
    LAS unsigned char* lds; int tid, lane, wave, vcu, G, gw, NGW;
    const float *x, *c, *ctx, *c_ctx, *w_mod, *b_mod, *g_pre, *g_post, *w_in, *w_out, *hgrn_lb, *hgrn_gn, *gate_b, *mlstm_gn, *na_rpb;
    float* out; bf16 *wt_in, *wt_out, *hxy, *P; float *mod, *gates, *ctx1, *stm, *sth, *rope; bf16 *otm, *oth, *UX;
};

__device__ __forceinline__ void transpose_item(const float* W, int N, int Nnew, bool remap, bf16* WT, LAS float* scr, int item, int lane) {
    const int nblk = Nnew / 32, kb = item / nblk, nb = item % nblk, k0 = 64 * kb, n0 = 32 * nb;
    const int nn = n0 + (lane & 31);
    int no = nn; if (remap) no = nn < 3200 ? nn : (nn < 4736 ? nn + 16 : (nn < 4752 ? 3200 + nn - 4736 : -1));
#pragma unroll 8
    for (int i = 0; i < 32; ++i) { const int kk = 2 * i + (lane >> 5); scr[kk * 33 + (lane & 31)] = no >= 0 ? W[(size_t)(k0 + kk) * N + no] : 0.f; }
    LDS_WAIT(); asm volatile("" ::: "memory");
    const int c = lane & 7;
#pragma unroll
    for (int j = 0; j < 4; ++j) { const int n = (lane >> 3) + 8 * j; const LAS float* s = scr + (8 * c) * 33 + n;
        v4u o; o.x = pk2(s[0 * 33], s[1 * 33]); o.y = pk2(s[2 * 33], s[3 * 33]); o.z = pk2(s[4 * 33], s[5 * 33]); o.w = pk2(s[6 * 33], s[7 * 33]);
        *(GAS v4u*)(WT + (size_t)(n0 + n) * 1024 + k0 + 8 * c) = o; }
    LDS_WAIT(); asm volatile("" ::: "memory");
}
__device__ __forceinline__ void phase_p0(const Ctx& F) {
    if (F.vcu < 96) {
        LAS float* tab = (LAS float*)(F.lds);
        LAS float* part = (LAS float*)(F.lds + 36864);
        for (int i = F.tid; i < 9 * 1024; i += 512) { const int r = i >> 10, k = i & 1023; const float v = r < 8 ? F.c[r * 1024 + k] : F.c_ctx[k]; tab[i] = silu_f(v); }
        __syncthreads();
        for (int it = F.vcu; it < 96; it += F.G) {
            const int l = it / 48, jb = it % 48, col = jb * 64 + F.lane;
            float acc[9];
#pragma unroll
            for (int r = 0; r < 9; ++r) acc[r] = 0.f;
            const float* wp = F.w_mod + ((size_t)l * 1024 + F.wave * 128) * 3072 + col;
#pragma unroll 4
            for (int k = 0; k < 128; ++k) { const float wv = wp[(size_t)k * 3072];
#pragma unroll
                for (int r = 0; r < 9; ++r) acc[r] += tab[r * 1024 + F.wave * 128 + k] * wv; }
#pragma unroll
            for (int r = 0; r < 9; ++r) part[(F.wave * 9 + r) * 64 + F.lane] = acc[r];
            __syncthreads();
            for (int i = F.tid; i < 9 * 64; i += 512) { const int r = i >> 6, j = i & 63; float s = 0.f;
#pragma unroll
                for (int w = 0; w < 8; ++w) s += part[(w * 9 + r) * 64 + j];
                F.mod[((size_t)l * 9 + r) * 3072 + jb * 64 + j] = s + F.b_mod[l * 3072 + jb * 64 + j]; }
            __syncthreads();
        }
    }
    if (F.vcu == 96 % F.G) for (int i = F.tid; i < 64 * 24; i += 512) { const int pos = i / 24, f = i % 24; const float ang = (float)pos * expf(-(float)(2 * f) * (1.f / 48.f) * 9.210340371976184f); F.rope[2 * i] = cosf(ang); F.rope[2 * i + 1] = sinf(ang); }
    __syncthreads();
    LAS float* scr = (LAS float*)(F.lds + F.wave * 16384);
    constexpr int I_IN = 16 * (NPAD / 32), I_OUT = 16 * 32;
    for (int it = F.gw; it < 2 * I_IN + 2 * I_OUT; it += F.NGW) {
        int r = it;
        if (r < 2 * I_IN) { const int l = r / I_IN; transpose_item(F.w_in + (size_t)l * 1024 * PIN, PIN, NPAD, true, F.wt_in + (size_t)l * NPAD * 1024, scr, r % I_IN, F.lane); continue; }
        r -= 2 * I_IN; { const int l = r / I_OUT; transpose_item(F.w_out + (size_t)l * 1024 * 1024, 1024, 1024, false, F.wt_out + (size_t)l * 1024 * 1024, scr, r % I_OUT, F.lane); }
    }
}

__device__ __forceinline__ void prenorm_row(const float4 (&v)[4], float ss, const float* mod_r, const float* g_pre_l, bf16* dst, int lane) {
    const float rinv = 1.f / sqrtf(ss * (1.f / 1024.f) + EPS);
    const float* sh = mod_r; const float* sc = mod_r + 1024;
#pragma unroll
    for (int j = 0; j < 4; ++j) {
        const int d = 4 * (lane + 64 * j);
        const float4 g = *(const float4*)(g_pre_l + d), s1 = *(const float4*)(sc + d), s0 = *(const float4*)(sh + d);
        const float o0 = v[j].x * rinv * g.x * (1.f + s1.x) + s0.x, o1 = v[j].y * rinv * g.y * (1.f + s1.y) + s0.y;
        const float o2 = v[j].z * rinv * g.z * (1.f + s1.z) + s0.z, o3 = v[j].w * rinv * g.w * (1.f + s1.w) + s0.w;
        uint2 w; w.x = pk2(o0, o1); w.y = pk2(o2, o3);
        *(uint2*)(dst + d) = w;
    }
}
__device__ __forceinline__ void phase_prenorm0(const Ctx& F) {
    for (int m = F.gw; m < M; m += F.NGW) {
        const float* src; int r;
        if (m < MX) { src = F.x + (size_t)m * 1024; r = m / S; } else { src = F.ctx + (size_t)(m - MX) * 1024; r = 8; }
        float4 v[4]; float ss = 0.f;
#pragma unroll
        for (int j = 0; j < 4; ++j) { v[j] = ((const float4*)src)[F.lane + 64 * j]; ss += v[j].x * v[j].x + v[j].y * v[j].y + v[j].z * v[j].z + v[j].w * v[j].w; }
        ss = wave_sum(ss);
        prenorm_row(v, ss, F.mod + (size_t)r * 3072, F.g_pre, F.hxy + (size_t)m * 1024, F.lane);
    }
}
__device__ __forceinline__ void phase_post(const Ctx& F, int l) {
    const int Ml = l == 0 ? M : MX;
    const float* mod_l = F.mod + (size_t)l * 9 * 3072; const float* g_post_l = F.g_post + l * 1024;
    for (int m = F.gw; m < Ml; m += F.NGW) {
        const float* src; float* dst; int r;
        if (m < MX) { src = (l == 0 ? F.x : F.out) + (size_t)m * 1024; dst = F.out + (size_t)m * 1024; r = m / S; }
        else { src = F.ctx + (size_t)(m - MX) * 1024; dst = F.ctx1 + (size_t)(m - MX) * 1024; r = 8; }
        const bf16* ur = F.UX + (size_t)m * 1024;
        float4 u[4]; float ss = 0.f;
#pragma unroll
        for (int j = 0; j < 4; ++j) { const uint2 w = ((const uint2*)ur)[F.lane + 64 * j];
            u[j].x = __uint_as_float(w.x << 16); u[j].y = __uint_as_float(w.x & 0xffff0000u); u[j].z = __uint_as_float(w.y << 16); u[j].w = __uint_as_float(w.y & 0xffff0000u);
            ss += u[j].x * u[j].x + u[j].y * u[j].y + u[j].z * u[j].z + u[j].w * u[j].w; }
        ss = wave_sum(ss);
        const float rinv = 1.f / sqrtf(ss * (1.f / 1024.f) + EPS);
        const float* gt = mod_l + r * 3072 + 2048;
        float ss2 = 0.f;
#pragma unroll
        for (int j = 0; j < 4; ++j) {
            const int d = 4 * (F.lane + 64 * j);
            const float4 g = *(const float4*)(g_post_l + d), t = *(const float4*)(gt + d), xv = *(const float4*)(src + d);
            float4 o; o.x = xv.x + t.x * (u[j].x * rinv * g.x); o.y = xv.y + t.y * (u[j].y * rinv * g.y); o.z = xv.z + t.z * (u[j].z * rinv * g.z); o.w = xv.w + t.w * (u[j].w * rinv * g.w);
            *(float4*)(dst + d) = o; u[j] = o; ss2 += o.x * o.x + o.y * o.y + o.z * o.z + o.w * o.w;
        }
        if (l == 0) { ss2 = wave_sum(ss2); prenorm_row(u, ss2, F.mod + (size_t)(9 + r) * 3072, F.g_pre + 1024, F.hxy + (size_t)m * 1024, F.lane); }
    }
}

__device__ __forceinline__ int seq_row(int b, int step, int dir) {
    if (step < CTX) { const int n = dir ? CTX - 1 - step : step; return MX + b * CTX + n; }
    int t = step - CTX; if (dir) t = S - 1 - t; return b * S + t;
}
#ifndef DUP_SUB
#define DUP_SUB 0
#endif

typedef short s16x4 __attribute__((ext_vector_type(4)));
typedef short v4i16_t __attribute__((ext_vector_type(4)));
__device__ __forceinline__ s16x4 tr_read(const LAS bf16* p) { return __builtin_bit_cast(s16x4, __builtin_amdgcn_ds_read_tr16_b64_v4i16((LAS v4i16_t*)p)); }
__device__ __forceinline__ bf16x8 tr_frag(const LAS bf16* T, int stride, int rowA, int rowB, int col0, int lane) {
    const int q = (lane >> 2) & 3, p = lane & 3;
    const s16x4 lo = tr_read(T + (rowA + q) * stride + col0 + 4 * p), hi = tr_read(T + (rowB + q) * stride + col0 + 4 * p);
    return (bf16x8){lo[0], lo[1], lo[2], lo[3], hi[0], hi[1], hi[2], hi[3]};
}
__device__ __forceinline__ bf16x8 rm_frag(const LAS bf16* T, int stride, int row, int k0) { return *(const LAS bf16x8*)(T + row * stride + k0); }
__device__ __forceinline__ f32x4 mfma16(bf16x8 a, bf16x8 b, f32x4 c) { return __builtin_amdgcn_mfma_f32_16x16x32_bf16(a, b, c, 0, 0, 0); }
typedef unsigned v2u __attribute__((ext_vector_type(2)));
typedef float f32x2 __attribute__((ext_vector_type(2)));
__device__ __forceinline__ void unpack8(const v4u w, float* f) {
    f[0] = __uint_as_float(w.x << 16); f[1] = __uint_as_float(w.x & 0xffff0000u); f[2] = __uint_as_float(w.y << 16); f[3] = __uint_as_float(w.y & 0xffff0000u);
    f[4] = __uint_as_float(w.z << 16); f[5] = __uint_as_float(w.z & 0xffff0000u); f[6] = __uint_as_float(w.w << 16); f[7] = __uint_as_float(w.w & 0xffff0000u);
}
__device__ __forceinline__ v4u pack8(const float* f) { v4u w; w.x = pk2(f[0], f[1]); w.y = pk2(f[2], f[3]); w.z = pk2(f[4], f[5]); w.w = pk2(f[6], f[7]); return w; }

#ifndef PROBE_ML
#define PROBE_ML 0
#endif
__device__ __forceinline__ float wave_scan_incl(float x) {
    int v = __float_as_int(x);
#define DPP_ADD(ctrl, rmask) v = __float_as_int(__int_as_float(v) + __int_as_float(__builtin_amdgcn_update_dpp(0, v, ctrl, rmask, 0xF, false)))
    DPP_ADD(0x111, 0xF); DPP_ADD(0x112, 0xF); DPP_ADD(0x114, 0xF); DPP_ADD(0x118, 0xF); DPP_ADD(0x142, 0xA); DPP_ADD(0x143, 0xC);
#undef DPP_ADD
    return __int_as_float(v);
}
#define LDS_FENCE() asm volatile("" ::: "memory")
namespace ml {
constexpr int QSTR = 104, VSTR = 120;
constexpr int OFF_QS = 0, OFF_KS = OFF_QS + 64 * QSTR * 2, OFF_VS = OFF_KS + 64 * QSTR * 2, OFF_CT = OFF_VS + 64 * VSTR * 2;
constexpr int OFF_HT = OFF_CT + 2 * 112 * QSTR * 2, OFF_DEN = OFF_HT + 64 * 100 * 4, OFF_ROPE = OFF_DEN + 256, OFF_END = OFF_ROPE + 64 * 24 * 8;
static_assert(OFF_END <= RING_BYTES && 6 * 7 * 64 * 16 <= OFF_HT, "mlstm LDS");
constexpr int ST_FLOATS = 96 * 112 + 16;
}
struct MlJob { int b, h, isctx, t0, nchunk; };

__device__ __forceinline__ void mlstm_dir(const Ctx& F, int l, const MlJob jb, int dir, int fold_r, int emit_slot, int mode, bf16* otmp, float* ST) {
    using namespace ml;
    int tid_ = F.tid; asm volatile("" : "+v"(tid_));
    const int w = __builtin_amdgcn_readfirstlane(tid_ >> 6);
    const bool tsel = (mode != 0) && !jb.isctx && l == 0;
    if (tsel) TS_START(F, 10);
    LAS bf16* QS = (LAS bf16*)(F.lds + OFF_QS); LAS bf16* KS = (LAS bf16*)(F.lds + OFF_KS); LAS bf16* VS = (LAS bf16*)(F.lds + OFF_VS);
    LAS bf16* CT0 = (LAS bf16*)(F.lds + OFF_CT); LAS float* HT = (LAS float*)(F.lds + OFF_HT); LAS float* DEN = (LAS float*)(F.lds + OFF_DEN);
    const LAS f32x2* ROPE = (const LAS f32x2*)(F.lds + OFF_ROPE);
    const int rowbase = jb.isctx ? MX + jb.b * CTX : jb.b * S;
    const int h = jb.h; const bf16* P = F.P;
    float* STd = ST + (size_t)(((jb.b * 4 + h) * 2 + dir) * 8) * ST_FLOATS;
    f32x4 Cst[7];
#pragma unroll
    for (int et = 0; et < 7; ++et) Cst[et] = (f32x4){0.f, 0.f, 0.f, 0.f};
    if (fold_r >= 0) {
        LAS f32x4* FOLD = (LAS f32x4*)(F.lds + OFF_QS);
        float wk[8];
        { float bs[8]; bs[0] = 0.f;
#pragma unroll
          for (int k = 1; k < 8; ++k) bs[k] = STd[(size_t)k * ST_FLOATS + 96 * 112];
          float run = 1.f;
#pragma unroll
          for (int k = 7; k >= 0; --k) { wk[k] = (k <= fold_r) ? run : 0.f; run = (k >= 1 && k <= fold_r) ? run * __expf(bs[k]) : run; } }
#pragma unroll 2
        for (int p = tid_; p < 6 * 7 * 64; p += 512) {
            f32x4 v[8];
#pragma unroll
            for (int k = 0; k < 8; ++k) v[k] = *(const f32x4*)(STd + (size_t)k * ST_FLOATS + 4 * p);
            f32x4 acc = v[0] * wk[0];
#pragma unroll
            for (int k = 1; k < 8; ++k) acc += v[k] * wk[k];
            FOLD[p] = acc;
        }
        __syncthreads();
        if (w < 6) {
#pragma unroll
            for (int et = 0; et < 7; ++et) Cst[et] = FOLD[(w * 7 + et) * 64 + (tid_ & 63)];
        }
        __syncthreads();
    }
    asm volatile("" : "+v"(tid_));
    const int tid = tid_, lane = tid & 63, g = lane >> 4, c = lane & 15;
    float Btot = 0.f;
    for (int i = tid; i < 64 * 16; i += 512) { const int s = i >> 4, e = 96 + (i & 15); VS[s * VSTR + e] = (e == 96) ? (bf16)0x3F80 : (bf16)0; }
    if (w < 6) {
#pragma unroll
        for (int et = 0; et < 7; ++et) { v2u v; v.x = pk2(Cst[et][0], Cst[et][1]); v.y = pk2(Cst[et][2], Cst[et][3]); *(LAS v2u*)(CT0 + (16 * et + c) * QSTR + 16 * w + 4 * g) = v; }
    }
    const bool hasqk = tid < 384; const int qk_tok = tid / 6, qk_pi = tid % 6, qk_part = qk_pi / 3, qk_pp = qk_pi % 3, qk_d0 = 48 * qk_part + 8 * qk_pp;
    const int v1_tok = tid / 12, v1_pc = tid % 12; const bool hasv2 = tid < 256; const int v2_tok = (512 + tid) / 12, v2_pc = (512 + tid) % 12;
    struct LoadSet { v4u q0, q1, k0, k1, v1, v2; float ig, lf; };
    LoadSet LA, LB;
    v2u ft[3], fo[3], fz[3];
    const int fi_i = tid >> 3, fi_e0 = 12 * (tid & 7);
#pragma unroll
    for (int q4 = 0; q4 < 3; ++q4) { ft[q4] = (v2u){0u, 0u}; fo[q4] = (v2u){0u, 0u}; fz[q4] = (v2u){0u, 0u}; }
    LA.q0 = LA.q1 = LA.k0 = LA.k1 = LA.v1 = LA.v2 = (v4u){0u, 0u, 0u, 0u}; LA.ig = LA.lf = 0.f; LB = LA;
    auto tok_of = [&](int ci, int i) -> int { return dir == 0 ? jb.t0 + 64 * ci + i : jb.t0 + 64 * (jb.nchunk - 1 - ci) + (63 - i); };
    auto issue_loads = [&](LoadSet& L, int ci) {
        if (hasqk) { const bf16* pr = P + (size_t)(rowbase + tok_of(ci, qk_tok)) * PLD + h * 96 + qk_d0;
            if (mode != 0) { L.q0 = *(const v4u*)(pr + B_Q); L.q1 = *(const v4u*)(pr + B_Q + 24); }
            L.k0 = *(const v4u*)(pr + B_K); L.k1 = *(const v4u*)(pr + B_K + 24); }
        L.v1 = *(const v4u*)(P + (size_t)(rowbase + tok_of(ci, v1_tok)) * PLD + B_V + h * 96 + 8 * v1_pc);
        if (hasv2) L.v2 = *(const v4u*)(P + (size_t)(rowbase + tok_of(ci, v2_tok)) * PLD + B_V + h * 96 + 8 * v2_pc);
        const float* gp = F.gates + (size_t)(rowbase + tok_of(ci, lane)) * 16 + dir * 4 + h; L.ig = gp[0]; L.lf = gp[8];
    };
    auto issue_fin = [&](int ci) {
        const int m = rowbase + tok_of(ci, fi_i); const bf16* tp = otmp + (size_t)m * 384 + h * 96 + fi_e0; const bf16* pr = P + (size_t)m * PLD + h * 96 + fi_e0;
#pragma unroll
        for (int q4 = 0; q4 < 3; ++q4) { ft[q4] = *(const v2u*)(tp + 4 * q4); fo[q4] = *(const v2u*)(pr + B_O + 4 * q4); fz[q4] = *(const v2u*)(pr + B_Z + 4 * q4); }
    };
    auto finalize = [&](int ci) {
            const int i = tid >> 3, sub = tid & 7, e0 = 12 * sub; const int m = rowbase + tok_of(ci, i);
            float hv[12]; const float rden = 1.f / fmaxf(fabsf(DEN[i]), 1.f);
#pragma unroll
            for (int q4 = 0; q4 < 3; ++q4) { const f32x4 v = *(const LAS f32x4*)(HT + i * 100 + e0 + 4 * q4); hv[4 * q4] = v[0] * rden; hv[4 * q4 + 1] = v[1] * rden; hv[4 * q4 + 2] = v[2] * rden; hv[4 * q4 + 3] = v[3] * rden; }
            bf16* tp = otmp + (size_t)m * 384 + h * 96 + e0;
            if (mode == 1) {
#pragma unroll
                for (int q4 = 0; q4 < 3; ++q4) { v2u v; v.x = pk2(hv[4 * q4], hv[4 * q4 + 1]); v.y = pk2(hv[4 * q4 + 2], hv[4 * q4 + 3]); *(v2u*)(tp + 4 * q4) = v; }
            } else {
                float ss = 0.f;
#pragma unroll
                for (int q4 = 0; q4 < 3; ++q4) { const v2u v = ft[q4];
                    hv[4 * q4] += __uint_as_float(v.x << 16); hv[4 * q4 + 1] += __uint_as_float(v.x & 0xffff0000u); hv[4 * q4 + 2] += __uint_as_float(v.y << 16); hv[4 * q4 + 3] += __uint_as_float(v.y & 0xffff0000u); }
#pragma unroll
                for (int e = 0; e < 12; ++e) ss += hv[e] * hv[e];
                ss += __shfl_xor(ss, 1); ss += __shfl_xor(ss, 2); ss += __shfl_xor(ss, 4);
                const float rinv = 1.f / sqrtf(ss * (1.f / 96.f) + EPS);
                bf16* yp = F.hxy + (size_t)m * 1024 + 256 + h * 96 + e0; const float* gnv = F.mlstm_gn + l * 384 + h * 96 + e0;
#pragma unroll
                for (int q4 = 0; q4 < 3; ++q4) { const v2u ov = fo[q4], zv = fz[q4];
                    const float og[4] = {__uint_as_float(ov.x << 16), __uint_as_float(ov.x & 0xffff0000u), __uint_as_float(ov.y << 16), __uint_as_float(ov.y & 0xffff0000u)};
                    const float zg[4] = {__uint_as_float(zv.x << 16), __uint_as_float(zv.x & 0xffff0000u), __uint_as_float(zv.y << 16), __uint_as_float(zv.y & 0xffff0000u)};
                    float o[4];
#pragma unroll
                    for (int e = 0; e < 4; ++e) o[e] = og[e] * (hv[4 * q4 + e] * rinv * gnv[4 * q4 + e]) * zg[e];
                    v2u v; v.x = pk2(o[0], o[1]); v.y = pk2(o[2], o[3]); *(v2u*)(yp + 4 * q4) = v; }
            }
    };
    issue_loads(LA, 0); if (jb.nchunk > 1) issue_loads(LB, 1);
    __syncthreads();
    if (tsel) TS_STOP(F, 10);
    auto chunk_step = [&](LoadSet& L, int ci) {
        if (tsel) TS_START(F, 11);
        LAS bf16* CTc = CT0 + (ci & 1) * 112 * QSTR; LAS bf16* CTn = CT0 + ((ci + 1) & 1) * 112 * QSTR;
        const float bcs = wave_scan_incl(L.lf);
        const float qsc = __expf(bcs), ksc = __expf(L.ig - bcs);
        const float bL = rdlane(bcs, 63), ebL = __expf(bL);
        for (int rep_ = 0; rep_ < (PROBE_ML == 1 ? 2 : 1); ++rep_)
        if (hasqk) {
            const float ks_t = __shfl(ksc, qk_tok), qs_t = __shfl(qsc, qk_tok);
            float cs[8], sn[8];
            if (!jb.isctx) { const int t = tok_of(ci, qk_tok); const int pos = qk_part ? (t & 63) : (t >> 6);
#pragma unroll
                for (int e = 0; e < 8; ++e) { const f32x2 v = ROPE[pos * 24 + 8 * qk_pp + e]; cs[e] = v[0]; sn[e] = v[1]; } }
            else {
#pragma unroll
                for (int e = 0; e < 8; ++e) { cs[e] = 1.f; sn[e] = 0.f; } }
            float a[8], b2[8], o0[8], o1[8];
            unpack8(L.k0, a); unpack8(L.k1, b2);
#pragma unroll
            for (int e = 0; e < 8; ++e) { o0[e] = (a[e] * cs[e] - b2[e] * sn[e]) * ks_t; o1[e] = (b2[e] * cs[e] + a[e] * sn[e]) * ks_t; }
            *(LAS v4u*)(KS + qk_tok * QSTR + qk_d0) = pack8(o0); *(LAS v4u*)(KS + qk_tok * QSTR + qk_d0 + 24) = pack8(o1);
            if (mode != 0) {
                unpack8(L.q0, a); unpack8(L.q1, b2);
#pragma unroll
                for (int e = 0; e < 8; ++e) { o0[e] = (a[e] * cs[e] - b2[e] * sn[e]) * qs_t; o1[e] = (b2[e] * cs[e] + a[e] * sn[e]) * qs_t; }
                *(LAS v4u*)(QS + qk_tok * QSTR + qk_d0) = pack8(o0); *(LAS v4u*)(QS + qk_tok * QSTR + qk_d0 + 24) = pack8(o1);
            }
        } else { (void)__shfl(ksc, 0); (void)__shfl(qsc, 0); }
        *(LAS v4u*)(VS + v1_tok * VSTR + 8 * v1_pc) = L.v1;
        if (hasv2) *(LAS v4u*)(VS + v2_tok * VSTR + 8 * v2_pc) = L.v2;
        if (mode == 2 && ci > 0) { finalize(ci - 1); if (PROBE_ML == 4) finalize(ci - 1); }
        if (ci + 2 < jb.nchunk) issue_loads(L, ci + 2);
        if (tsel) { TS_STOP(F, 11); TS_START(F, 12); }
        __syncthreads();
        if (tsel) { TS_STOP(F, 12); TS_START(F, 13); }
        for (int rep_ = 0; rep_ < (PROBE_ML == 2 ? 2 : 1); ++rep_)
        if (mode != 0) {
            const int tt = w & 3, jh = w >> 2;
            bf16x8 qf[3], kf[4][3];
#pragma unroll
            for (int ks = 0; ks < 3; ++ks) qf[ks] = rm_frag(QS, QSTR, 16 * tt + c, 32 * ks + 8 * g);
#pragma unroll
            for (int ss = 0; ss < 4; ++ss) if (ss <= tt) {
#pragma unroll
                for (int ks = 0; ks < 3; ++ks) kf[ss][ks] = rm_frag(KS, QSTR, 16 * ss + c, 32 * ks + 8 * g); }
            LDS_FENCE();
            f32x4 st[4];
#pragma unroll
            for (int ss = 0; ss < 4; ++ss) { st[ss] = (f32x4){0.f, 0.f, 0.f, 0.f};
                if (ss <= tt) {
#pragma unroll
                    for (int ks = 0; ks < 3; ++ks) st[ss] = mfma16(kf[ss][ks], qf[ks], st[ss]);
                    if (ss == tt) {
#pragma unroll
                        for (int r = 0; r < 4; ++r) if (4 * g + r > c) st[ss][r] = 0.f; }
                } }
            bf16x8 pf[2];
#pragma unroll
            for (int kk = 0; kk < 2; ++kk) { const unsigned u0 = pk2(st[2 * kk][0], st[2 * kk][1]), u1 = pk2(st[2 * kk][2], st[2 * kk][3]), u2 = pk2(st[2 * kk + 1][0], st[2 * kk + 1][1]), u3 = pk2(st[2 * kk + 1][2], st[2 * kk + 1][3]);
                pf[kk] = __builtin_bit_cast(bf16x8, (v4u){u0, u1, u2, u3}); }
#pragma unroll
            for (int eb = 0; eb < 4; eb += 2) {
                bf16x8 vf[2][2], cf[2][3];
#pragma unroll
                for (int e2 = 0; e2 < 2; ++e2) { const int et = 4 * jh + eb + e2;
                    if (et < 7) {
#pragma unroll
                        for (int kk = 0; kk < 2; ++kk) if (2 * kk <= tt) vf[e2][kk] = tr_frag(VS, VSTR, 32 * kk + 4 * g, 32 * kk + 16 + 4 * g, 16 * et, lane);
#pragma unroll
                        for (int ks = 0; ks < 3; ++ks) cf[e2][ks] = rm_frag(CTc, QSTR, 16 * et + c, 32 * ks + 8 * g); } }
                LDS_FENCE();
#pragma unroll
                for (int e2 = 0; e2 < 2; ++e2) { const int et = 4 * jh + eb + e2;
                    if (et < 7) {
                        f32x4 acc = (f32x4){0.f, 0.f, 0.f, 0.f};
#pragma unroll
                        for (int kk = 0; kk < 2; ++kk) if (2 * kk <= tt) acc = mfma16(vf[e2][kk], pf[kk], acc);
#pragma unroll
                        for (int ks = 0; ks < 3; ++ks) acc = mfma16(cf[e2][ks], qf[ks], acc);
                        if (et < 6) *(LAS f32x4*)(HT + (16 * tt + c) * 100 + 16 * et + 4 * g) = acc;
                        else if (g == 0) DEN[16 * tt + c] = acc[0];
                    } }
            }
        }
        if (w < 6) {
#pragma unroll
            for (int kk = 0; kk < 2; ++kk) {
                bf16x8 vf[7]; const bf16x8 af = tr_frag(KS, QSTR, 32 * kk + 8 * g, 32 * kk + 8 * g + 4, 16 * w, lane);
#pragma unroll
                for (int et = 0; et < 7; ++et) vf[et] = tr_frag(VS, VSTR, 32 * kk + 8 * g, 32 * kk + 8 * g + 4, 16 * et, lane);
                LDS_FENCE();
#pragma unroll
                for (int et = 0; et < 7; ++et) Cst[et] = mfma16(af, vf[et], Cst[et]);
            }
#pragma unroll
            for (int et = 0; et < 7; ++et) { Cst[et] = Cst[et] * ebL;
                if (mode != 0) { v2u v; v.x = pk2(Cst[et][0], Cst[et][1]); v.y = pk2(Cst[et][2], Cst[et][3]); *(LAS v2u*)(CTn + (16 * et + c) * QSTR + 16 * w + 4 * g) = v; } }
        }
        Btot += bL;
        if (PROBE_ML == 3) { __syncthreads(); __syncthreads(); }
        if (tsel) { TS_STOP(F, 13); TS_START(F, 14); }
        __syncthreads();
        if (tsel) { TS_STOP(F, 14); TS_START(F, 15); }
        if (mode == 1) { finalize(ci); if (PROBE_ML == 4) finalize(ci); } else if (mode == 2) issue_fin(ci);
        if (tsel) TS_STOP(F, 15);
    };
    for (int ci = 0; ci < jb.nchunk; ci += 2) { chunk_step(LA, ci); chunk_step(LB, ci + 1); }
    if (mode == 2) finalize(jb.nchunk - 1);
    if (emit_slot >= 0 && w < 6) {
        float* sl = STd + (size_t)emit_slot * ST_FLOATS;
#pragma unroll
        for (int et = 0; et < 7; ++et) *(f32x4*)(sl + ((w * 7 + et) * 64 + lane) * 4) = Cst[et];
        if (w == 0 && lane == 0) sl[96 * 112] = Btot;
    }
    __syncthreads();
}
__device__ __forceinline__ void mlstm_load_rope(const Ctx& F, const float* rope_tab) {
    LAS f32x2* ROPE = (LAS f32x2*)(F.lds + ml::OFF_ROPE);
    for (int i = F.tid; i < 64 * 24; i += 512) ROPE[i] = ((const f32x2*)rope_tab)[i];
}
__device__ __forceinline__ void mlstm_itemA(const Ctx& F, int l, int bh, int it, bf16* otmp, float* ST) {
    const int b = bh >> 2, h = bh & 3;
    if (it == 0) {
        const MlJob jb{b, h, 1, 0, 4};
        mlstm_dir(F, l, jb, 0, -1, 0, l == 0 ? 1 : 0, otmp, ST);
        mlstm_dir(F, l, jb, 1, -1, 0, l == 0 ? 2 : 0, otmp, ST);
    } else {
        const int dir = (it - 1) / 7, k = (it - 1) % 7, seg = dir == 0 ? k : 7 - k;
        const MlJob jb{b, h, 0, 512 * seg, 8};
        mlstm_dir(F, l, jb, dir, -1, 1 + k, 0, otmp, ST);
    }
}
__device__ __forceinline__ void mlstm_itemC(const Ctx& F, int l, int bh, int seg, bf16* otmp, float* ST) {
    const MlJob jb{bh >> 2, bh & 3, 0, 512 * seg, 8};
    mlstm_dir(F, l, jb, 0, seg, -1, 1, otmp, ST);
    mlstm_dir(F, l, jb, 1, 7 - seg, -1, 2, otmp, ST);
}

namespace hg {
constexpr int STR = 72;
constexpr int IMG = 64 * STR * 2;
constexpr int OFF_KO = 0, OFF_KH = IMG, OFF_VS = 2 * IMG, OFF_QJ = 3 * IMG, OFF_ST = 7 * IMG, OFF_HT = 9 * IMG, OFF_TOT = OFF_HT + 64 * 68 * 4, OFF_BL = OFF_TOT + 8 * 64 * 4, OFF_END = OFF_BL + 512;
static_assert(OFF_END <= RING_BYTES, "hgrn LDS");
constexpr int ST_FLOATS = 64 * 64 + 64;
}
__device__ __forceinline__ void hgrn_dir(const Ctx& F, int l, const MlJob jb, int dir, int fold_r, int emit_slot, int mode, bf16* otmp, float* ST) {
    using namespace hg;
    int tid_ = F.tid; asm volatile("" : "+v"(tid_));
    const int tid = tid_, lane = tid & 63, w = __builtin_amdgcn_readfirstlane(tid >> 6), g = lane >> 4, c = lane & 15;
    LAS bf16* KO = (LAS bf16*)(F.lds + OFF_KO); LAS bf16* KH = (LAS bf16*)(F.lds + OFF_KH); LAS bf16* VS = (LAS bf16*)(F.lds + OFF_VS); LAS bf16* QJ = (LAS bf16*)(F.lds + OFF_QJ);
    LAS bf16* ST0 = (LAS bf16*)(F.lds + OFF_ST); LAS float* HT = (LAS float*)(F.lds + OFF_HT); LAS float* TOT = (LAS float*)(F.lds + OFF_TOT); LAS float* BL = (LAS float*)(F.lds + OFF_BL);
    const int rowbase = jb.isctx ? MX + jb.b * CTX : jb.b * S;
    const int h = jb.h; const bf16* P = F.P;
    float* STd = ST + (size_t)(((jb.b * 4 + h) * 2 + dir) * 8) * ST_FLOATS;
    const int dt = w >> 1, et0 = 2 * (w & 1);
    f32x4 Sst[2]; float Btot[4];
#pragma unroll
    for (int i = 0; i < 2; ++i) Sst[i] = (f32x4){0.f, 0.f, 0.f, 0.f};
#pragma unroll
    for (int r = 0; r < 4; ++r) Btot[r] = 0.f;
    if (fold_r >= 0) {
        f32x4 v[8][2], dk[8];
#pragma unroll
        for (int k = 0; k < 8; ++k) { const float* sl = STd + (size_t)k * ST_FLOATS; v[k][0] = *(const f32x4*)(sl + ((w * 2 + 0) * 64 + lane) * 4); v[k][1] = *(const f32x4*)(sl + ((w * 2 + 1) * 64 + lane) * 4);
            dk[k] = *(const f32x4*)(sl + 64 * 64 + 16 * dt + 4 * g); }
        f32x4 run = (f32x4){1.f, 1.f, 1.f, 1.f};
#pragma unroll
        for (int k = 7; k >= 0; --k) { const float on = (k <= fold_r) ? 1.f : 0.f; Sst[0] += v[k][0] * (run * on); Sst[1] += v[k][1] * (run * on);
            if (k >= 1) { const bool use = k <= fold_r; run[0] *= use ? __expf(dk[k][0]) : 1.f; run[1] *= use ? __expf(dk[k][1]) : 1.f; run[2] *= use ? __expf(dk[k][2]) : 1.f; run[3] *= use ? __expf(dk[k][3]) : 1.f; } }
    }
    if (mode != 0) {
#pragma unroll
        for (int i = 0; i < 2; ++i) { v2u v; v.x = pk2(Sst[i][0], Sst[i][1]); v.y = pk2(Sst[i][2], Sst[i][3]); *(LAS v2u*)(ST0 + (16 * (et0 + i) + c) * STR + 16 * dt + 4 * g) = v; }
    }
    const int ps = tid >> 3, oct = tid & 7, d0 = 8 * oct;
    float lbv[8];
#pragma unroll
    for (int e = 0; e < 8; ++e) { lbv[e] = 0.f;
        if (l == 1) { const float v0 = F.hgrn_lb[(0 * 2 + dir) * 256 + h * 64 + d0 + e], v1 = F.hgrn_lb[(1 * 2 + dir) * 256 + h * 64 + d0 + e]; lbv[e] = 1.f / (1.f + expf(v0 - v1)); } }
    const int fcol = dir ? A_FB : A_FF;
    auto tok_of = [&](int ci, int i) -> int { return dir == 0 ? jb.t0 + 64 * ci + i : jb.t0 + 64 * (jb.nchunk - 1 - ci) + (63 - i); };
    v4u rq, rf, rv; rq = rf = rv = (v4u){0u, 0u, 0u, 0u};
    v4u ft = (v4u){0u, 0u, 0u, 0u}, fz = (v4u){0u, 0u, 0u, 0u};
    const int fi_i = tid >> 3, fi_e0 = 8 * (tid & 7);
    float gnv[8];
#pragma unroll
    for (int e = 0; e < 8; ++e) gnv[e] = (mode == 2) ? F.hgrn_gn[l * 256 + h * 64 + fi_e0 + e] : 0.f;
    auto issue_loads = [&](int ci) {
        const bf16* pr = P + (size_t)(rowbase + tok_of(ci, ps)) * PLD + h * 64 + d0;
        if (mode != 0) rq = *(const v4u*)(pr + A_Q);
        rf = *(const v4u*)(pr + fcol); rv = *(const v4u*)(pr + A_I);
    };
    auto issue_fin = [&](int ci) { const int m = rowbase + tok_of(ci, fi_i); ft = *(const v4u*)(otmp + (size_t)m * 256 + h * 64 + fi_e0); fz = *(const v4u*)(P + (size_t)m * PLD + A_Z + h * 64 + fi_e0); };
    issue_loads(0);
    __syncthreads();
    for (int ci = 0; ci < jb.nchunk; ++ci) {
        LAS bf16* STc = ST0 + (ci & 1) * 64 * STR; LAS bf16* STn = ST0 + ((ci + 1) & 1) * 64 * STR;
        float qv[8], kk[8], bb[8], fl[8];
        unpack8(rf, fl);
#pragma unroll
        for (int e = 0; e < 8; ++e) { const float sg = sigmoid_f(fl[e]); const float f = lbv[e] + (1.f - lbv[e]) * sg; bb[e] = __logf(f); kk[e] = (1.f - lbv[e]) * (1.f - sg); }
        if (mode != 0) unpack8(rq, qv);
        const v4u vraw = rv;
        if (ci + 1 < jb.nchunk) issue_loads(ci + 1);
        if (mode == 2) issue_fin(ci);
#pragma unroll
        for (int o = 8; o < 64; o <<= 1) {
#pragma unroll
            for (int e = 0; e < 8; ++e) { const float t = __shfl_up(bb[e], o); if (lane >= o) bb[e] += t; } }
        if (lane >= 56) { *(LAS f32x4*)(TOT + w * 64 + d0) = (f32x4){bb[0], bb[1], bb[2], bb[3]}; *(LAS f32x4*)(TOT + w * 64 + d0 + 4) = (f32x4){bb[4], bb[5], bb[6], bb[7]}; }
        __syncthreads();
        {
            float run[8], pre[8], ref1[8], ref2[8], ref3[8];
#pragma unroll
            for (int e = 0; e < 8; ++e) { run[e] = 0.f; pre[e] = 0.f; ref1[e] = ref2[e] = ref3[e] = 0.f; }
#pragma unroll
            for (int ww = 0; ww < 8; ++ww) {
                if (ww == w) {
#pragma unroll
                    for (int e = 0; e < 8; ++e) pre[e] = run[e]; }
                if (ww == 2) {
#pragma unroll
                    for (int e = 0; e < 8; ++e) ref1[e] = run[e]; }
                if (ww == 4) {
#pragma unroll
                    for (int e = 0; e < 8; ++e) ref2[e] = run[e]; }
                if (ww == 6) {
#pragma unroll
                    for (int e = 0; e < 8; ++e) ref3[e] = run[e]; }
                const f32x4 t0 = *(const LAS f32x4*)(TOT + ww * 64 + d0), t1 = *(const LAS f32x4*)(TOT + ww * 64 + d0 + 4);
                run[0] += t0[0]; run[1] += t0[1]; run[2] += t0[2]; run[3] += t0[3]; run[4] += t1[0]; run[5] += t1[1]; run[6] += t1[2]; run[7] += t1[3];
            }
            const int sub = ps >> 4;
            float o8[8];
#pragma unroll
            for (int e = 0; e < 8; ++e) bb[e] += pre[e];
#pragma unroll
            for (int e = 0; e < 8; ++e) { const float rown = sub == 0 ? 0.f : (sub == 1 ? ref1[e] : (sub == 2 ? ref2[e] : ref3[e])); o8[e] = kk[e] * __expf(rown - bb[e]); }
            if (mode != 0) *(LAS v4u*)(KO + ps * STR + d0) = pack8(o8);
#pragma unroll
            for (int e = 0; e < 8; ++e) o8[e] = kk[e] * __expf(run[e] - bb[e]);
            *(LAS v4u*)(KH + ps * STR + d0) = pack8(o8);
            *(LAS v4u*)(VS + ps * STR + d0) = vraw;
            if (mode != 0) {
#pragma unroll
                for (int e = 0; e < 8; ++e) o8[e] = qv[e] * __expf(bb[e]);
                *(LAS v4u*)(QJ + ps * STR + d0) = pack8(o8);
                if (sub >= 1) {
#pragma unroll
                    for (int e = 0; e < 8; ++e) o8[e] = qv[e] * __expf(bb[e] - ref1[e]);
                    *(LAS v4u*)(QJ + (64 + ps) * STR + d0) = pack8(o8); }
                if (sub >= 2) {
#pragma unroll
                    for (int e = 0; e < 8; ++e) o8[e] = qv[e] * __expf(bb[e] - ref2[e]);
                    *(LAS v4u*)(QJ + (128 + ps) * STR + d0) = pack8(o8); }
                if (sub >= 3) {
#pragma unroll
                    for (int e = 0; e < 8; ++e) o8[e] = qv[e] * __expf(bb[e] - ref3[e]);
                    *(LAS v4u*)(QJ + (192 + ps) * STR + d0) = pack8(o8); }
            }
            if (ps == 0) { *(LAS f32x4*)(BL + d0) = (f32x4){run[0], run[1], run[2], run[3]}; *(LAS f32x4*)(BL + d0 + 4) = (f32x4){run[4], run[5], run[6], run[7]}; }
        }
        __syncthreads();
        if (mode != 0) {
            const int tt = w & 3, eh = w >> 2;
            f32x4 at[4];
#pragma unroll
            for (int j = 0; j < 4; ++j) { at[j] = (f32x4){0.f, 0.f, 0.f, 0.f};
                if (j <= tt) {
#pragma unroll
                    for (int ks = 0; ks < 2; ++ks) at[j] = mfma16(rm_frag(KO, STR, 16 * j + c, 32 * ks + 8 * g), rm_frag(QJ + j * 64 * STR, STR, 16 * tt + c, 32 * ks + 8 * g), at[j]);
                    if (j == tt) {
#pragma unroll
                        for (int r = 0; r < 4; ++r) if (4 * g + r > c) at[j][r] = 0.f; }
                } }
            bf16x8 pf[2];
#pragma unroll
            for (int k2 = 0; k2 < 2; ++k2) { const unsigned u0 = pk2(at[2 * k2][0], at[2 * k2][1]), u1 = pk2(at[2 * k2][2], at[2 * k2][3]), u2 = pk2(at[2 * k2 + 1][0], at[2 * k2 + 1][1]), u3 = pk2(at[2 * k2 + 1][2], at[2 * k2 + 1][3]);
                pf[k2] = __builtin_bit_cast(bf16x8, (v4u){u0, u1, u2, u3}); }
            bf16x8 qf[2];
#pragma unroll
            for (int ks = 0; ks < 2; ++ks) qf[ks] = rm_frag(QJ, STR, 16 * tt + c, 32 * ks + 8 * g);
#pragma unroll
            for (int ei = 0; ei < 2; ++ei) { const int et = 2 * eh + ei;
                f32x4 acc = (f32x4){0.f, 0.f, 0.f, 0.f};
#pragma unroll
                for (int k2 = 0; k2 < 2; ++k2) if (2 * k2 <= tt) acc = mfma16(tr_frag(VS, STR, 32 * k2 + 4 * g, 32 * k2 + 16 + 4 * g, 16 * et, lane), pf[k2], acc);
#pragma unroll
                for (int ks = 0; ks < 2; ++ks) acc = mfma16(rm_frag(STc, STR, 16 * et + c, 32 * ks + 8 * g), qf[ks], acc);
                *(LAS f32x4*)(HT + (16 * tt + c) * 68 + 16 * et + 4 * g) = acc; }
        }
        {
            const f32x4 blv = *(const LAS f32x4*)(BL + 16 * dt + 4 * g);
#pragma unroll
            for (int r = 0; r < 4; ++r) { const float dec = __expf(blv[r]); Sst[0][r] *= dec; Sst[1][r] *= dec; Btot[r] += blv[r]; }
#pragma unroll
            for (int k2 = 0; k2 < 2; ++k2) { const bf16x8 af = tr_frag(KH, STR, 32 * k2 + 8 * g, 32 * k2 + 8 * g + 4, 16 * dt, lane);
#pragma unroll
                for (int i = 0; i < 2; ++i) Sst[i] = mfma16(af, tr_frag(VS, STR, 32 * k2 + 8 * g, 32 * k2 + 8 * g + 4, 16 * (et0 + i), lane), Sst[i]); }
            if (mode != 0) {
#pragma unroll
                for (int i = 0; i < 2; ++i) { v2u v; v.x = pk2(Sst[i][0], Sst[i][1]); v.y = pk2(Sst[i][2], Sst[i][3]); *(LAS v2u*)(STn + (16 * (et0 + i) + c) * STR + 16 * dt + 4 * g) = v; } }
        }
        __syncthreads();
        if (mode != 0) {
            const int i = tid >> 3, sub8 = tid & 7, e0 = 8 * sub8; const int m = rowbase + tok_of(ci, i);
            float hv[8];
            { const f32x4 a0 = *(const LAS f32x4*)(HT + i * 68 + e0), a1 = *(const LAS f32x4*)(HT + i * 68 + e0 + 4); hv[0] = a0[0]; hv[1] = a0[1]; hv[2] = a0[2]; hv[3] = a0[3]; hv[4] = a1[0]; hv[5] = a1[1]; hv[6] = a1[2]; hv[7] = a1[3]; }
            bf16* tp = otmp + (size_t)m * 256 + h * 64 + e0;
            if (mode == 1) *(v4u*)tp = pack8(hv);
            else {
                float tv[8]; unpack8(ft, tv);
                float ss = 0.f;
#pragma unroll
                for (int e = 0; e < 8; ++e) { hv[e] += tv[e]; ss += hv[e] * hv[e]; }
                ss += __shfl_xor(ss, 1); ss += __shfl_xor(ss, 2); ss += __shfl_xor(ss, 4);
                const float rinv = 1.f / sqrtf(ss * (1.f / 64.f) + EPS);
                float zv[8]; unpack8(fz, zv);
#pragma unroll
                for (int e = 0; e < 8; ++e) hv[e] = hv[e] * rinv * gnv[e] * zv[e];
                *(v4u*)(F.hxy + (size_t)m * 1024 + h * 64 + e0) = pack8(hv);
            }
        }
    }
    if (emit_slot >= 0) {
        float* sl = STd + (size_t)emit_slot * ST_FLOATS;
        *(f32x4*)(sl + ((w * 2 + 0) * 64 + lane) * 4) = Sst[0]; *(f32x4*)(sl + ((w * 2 + 1) * 64 + lane) * 4) = Sst[1];
        if ((w & 1) == 0 && c == 0) *(f32x4*)(sl + 64 * 64 + 16 * dt + 4 * g) = (f32x4){Btot[0], Btot[1], Btot[2], Btot[3]};
    }
    __syncthreads();
}
__device__ __forceinline__ void hgrn_itemA(const Ctx& F, int l, int bh, int it, bf16* otmp, float* ST) {
    const int b = bh >> 2, h = bh & 3;
    if (it == 0) {
        const MlJob jb{b, h, 1, 0, 4};
        hgrn_dir(F, l, jb, 0, -1, 0, l == 0 ? 1 : 0, otmp, ST);
        hgrn_dir(F, l, jb, 1, -1, 0, l == 0 ? 2 : 0, otmp, ST);
    } else {
        const int dir = (it - 1) / 7, k = (it - 1) % 7, seg = dir == 0 ? k : 7 - k;
        const MlJob jb{b, h, 0, 512 * seg, 8};
        hgrn_dir(F, l, jb, dir, -1, 1 + k, 0, otmp, ST);
    }
}
__device__ __forceinline__ void hgrn_itemC(const Ctx& F, int l, int bh, int seg, bf16* otmp, float* ST) {
    const MlJob jb{bh >> 2, bh & 3, 0, 512 * seg, 8};
    hgrn_dir(F, l, jb, 0, seg, -1, 1, otmp, ST);
    hgrn_dir(F, l, jb, 1, 7 - seg, -1, 2, otmp, ST);
}

namespace nat {
constexpr int STR = 72, IMG = 64 * STR * 2;
constexpr int OFF_K = 0, OFF_V = 2 * IMG, OFF_RPB = 4 * IMG, OFF_END = OFF_RPB + 2048;
static_assert(OFF_END <= RING_BYTES, "na LDS");
}
__device__ __forceinline__ void na_item(const Ctx& F, int l, int b, int h, int R0) {
    using namespace nat;
    int tid_ = F.tid; asm volatile("" : "+v"(tid_));
    const int tid = tid_, lane = tid & 63, w = __builtin_amdgcn_readfirstlane(tid >> 6), g = lane >> 4, c = lane & 15;
    LAS bf16* KT = (LAS bf16*)(F.lds + OFF_K); LAS bf16* VT = (LAS bf16*)(F.lds + OFF_V); LAS float* RPB = (LAS float*)(F.lds + OFF_RPB);
    const bf16* P = F.P; const bool lat = R0 >= 0;
    const int R = R0 + (w >> 1), ch = w & 1;
    const int rsR = min(max(R - 4, 0), 56);
    const int kr0 = lat ? min(max(R0 - 4, 0), 56) : 0;
    const int nwin = lat ? (min(max(R0 + 3 - 4, 0), 56) + 8 - kr0) : 0, nblk = nwin + 4;
    if (lat) for (int i = tid; i < 15 * 31; i += 512) RPB[i] = F.na_rpb[((size_t)l * 6 + h) * 465 + i] * 1.4426950408889634f;
    int mq[2]; bf16x8 qf[2][2]; int csq[2], qcol[2];
#pragma unroll
    for (int qt = 0; qt < 2; ++qt) {
        if (lat) { qcol[qt] = 32 * ch + 16 * qt + c; mq[qt] = b * S + R * 64 + qcol[qt]; } else { qcol[qt] = 0; mq[qt] = MX + b * CTX + 32 * w + 16 * qt + c; }
        csq[qt] = min(max(qcol[qt] - 8, 0), 48);
#pragma unroll
        for (int ks = 0; ks < 2; ++ks) qf[qt][ks] = *(const bf16x8*)(P + (size_t)mq[qt] * PLD + C_Q + h * 64 + 32 * ks + 8 * g);
    }
    f32x4 oacc[2][4]; float mrun[2], lrun[2];
#pragma unroll
    for (int qt = 0; qt < 2; ++qt) { mrun[qt] = -1e30f; lrun[qt] = 0.f;
#pragma unroll
        for (int dtl = 0; dtl < 4; ++dtl) oacc[qt][dtl] = (f32x4){0.f, 0.f, 0.f, 0.f}; }
    const int stok = tid >> 3, spc = tid & 7;
    auto blk_row = [&](int i) -> int { return i < nwin ? b * S + (kr0 + i) * 64 + stok : MX + b * CTX + 64 * (i - nwin) + stok; };
    v4u rk, rv;
    { const bf16* pr = P + (size_t)blk_row(0) * PLD + h * 64 + 8 * spc; rk = *(const v4u*)(pr + C_K); rv = *(const v4u*)(pr + C_V); }
    __syncthreads();
    *(LAS v4u*)(KT + stok * STR + 8 * spc) = rk; *(LAS v4u*)(VT + stok * STR + 8 * spc) = rv;
    if (nblk > 1) { const bf16* pr = P + (size_t)blk_row(1) * PLD + h * 64 + 8 * spc; rk = *(const v4u*)(pr + C_K); rv = *(const v4u*)(pr + C_V); }
    __syncthreads();
    for (int i = 0; i < nblk; ++i) {
        const LAS bf16* Kc = KT + (i & 1) * 64 * STR; const LAS bf16* Vc = VT + (i & 1) * 64 * STR;
        if (i + 1 < nblk) { LAS bf16* Kn = KT + ((i + 1) & 1) * 64 * STR; LAS bf16* Vn = VT + ((i + 1) & 1) * 64 * STR;
            *(LAS v4u*)(Kn + stok * STR + 8 * spc) = rk; *(LAS v4u*)(Vn + stok * STR + 8 * spc) = rv;
            if (i + 2 < nblk) { const bf16* pr = P + (size_t)blk_row(i + 2) * PLD + h * 64 + 8 * spc; rk = *(const v4u*)(pr + C_K); rv = *(const v4u*)(pr + C_V); } }
        const bool win = i < nwin; const int kr = kr0 + i;
        const bool active = !win || (kr >= rsR && kr < rsR + 8);
        if (active) {
            f32x4 st[2][4];
#pragma unroll
            for (int kt = 0; kt < 4; ++kt) { st[0][kt] = (f32x4){0.f, 0.f, 0.f, 0.f}; st[1][kt] = (f32x4){0.f, 0.f, 0.f, 0.f};
#pragma unroll
                for (int ks = 0; ks < 2; ++ks) { const bf16x8 kf = rm_frag(Kc, STR, 16 * kt + c, 32 * ks + 8 * g); st[0][kt] = mfma16(kf, qf[0][ks], st[0][kt]); st[1][kt] = mfma16(kf, qf[1][ks], st[1][kt]); } }
            if (win) {
#pragma unroll
                for (int qt = 0; qt < 2; ++qt) { const int boff = (kr - R + 7) * 31 + 15 - qcol[qt];
#pragma unroll
                    for (int kt = 0; kt < 4; ++kt)
#pragma unroll
                        for (int r = 0; r < 4; ++r) { const int kc = 16 * kt + 4 * g + r; const float bias = RPB[min(max(boff + kc, 0), 464)]; const float v = st[qt][kt][r] + bias; st[qt][kt][r] = ((unsigned)(kc - csq[qt]) < 16u) ? v : -1e30f; } }
            }
            float alpha[2]; bf16x8 pf[2][2];
#pragma unroll
            for (int qt = 0; qt < 2; ++qt) {
                float bm = -1e30f;
#pragma unroll
                for (int kt = 0; kt < 4; ++kt)
#pragma unroll
                    for (int r = 0; r < 4; ++r) bm = fmaxf(bm, st[qt][kt][r]);
                bm = xor32_max(xor16_max(bm));
                const float mnew = fmaxf(mrun[qt], bm); alpha[qt] = __builtin_amdgcn_exp2f(mrun[qt] - mnew); mrun[qt] = mnew;
                float ps = 0.f;
#pragma unroll
                for (int kt = 0; kt < 4; ++kt)
#pragma unroll
                    for (int r = 0; r < 4; ++r) { const float p = __builtin_amdgcn_exp2f(st[qt][kt][r] - mnew); st[qt][kt][r] = p; ps += p; }
                lrun[qt] = lrun[qt] * alpha[qt] + ps;
#pragma unroll
                for (int k2 = 0; k2 < 2; ++k2) { const unsigned u0 = pk2(st[qt][2 * k2][0], st[qt][2 * k2][1]), u1 = pk2(st[qt][2 * k2][2], st[qt][2 * k2][3]), u2 = pk2(st[qt][2 * k2 + 1][0], st[qt][2 * k2 + 1][1]), u3 = pk2(st[qt][2 * k2 + 1][2], st[qt][2 * k2 + 1][3]);
                    pf[qt][k2] = __builtin_bit_cast(bf16x8, (v4u){u0, u1, u2, u3}); }
            }
#pragma unroll
            for (int dtl = 0; dtl < 4; ++dtl) { f32x4 a0 = oacc[0][dtl] * alpha[0], a1 = oacc[1][dtl] * alpha[1];
#pragma unroll
                for (int k2 = 0; k2 < 2; ++k2) { const bf16x8 vf = tr_frag(Vc, STR, 32 * k2 + 4 * g, 32 * k2 + 16 + 4 * g, 16 * dtl, lane); a0 = mfma16(vf, pf[0][k2], a0); a1 = mfma16(vf, pf[1][k2], a1); }
                oacc[0][dtl] = a0; oacc[1][dtl] = a1; }
        }
        __syncthreads();
    }
#pragma unroll
    for (int qt = 0; qt < 2; ++qt) {
        const float lt = xor32_sum(xor16_sum(lrun[qt]));
        const float rl = 1.f / lt;
        const bf16* zr = P + (size_t)mq[qt] * PLD + C_Z + h * 64; bf16* yr = F.hxy + (size_t)mq[qt] * 1024 + 640 + h * 64;
#pragma unroll
        for (int dtl = 0; dtl < 4; ++dtl) { const int d = 16 * dtl + 4 * g; const v2u zv = *(const v2u*)(zr + d);
            const float z0 = __uint_as_float(zv.x << 16), z1 = __uint_as_float(zv.x & 0xffff0000u), z2 = __uint_as_float(zv.y << 16), z3 = __uint_as_float(zv.y & 0xffff0000u);
            v2u o; o.x = pk2(oacc[qt][dtl][0] * rl * z0, oacc[qt][dtl][1] * rl * z1); o.y = pk2(oacc[qt][dtl][2] * rl * z2, oacc[qt][dtl][3] * rl * z3);
            *(v2u*)(yr + d) = o; }
    }
}

__device__ __forceinline__ void phase_mixA(const Ctx& F, int l) {
    mlstm_load_rope(F, F.rope);
    for (int rep = 0; rep < ((DUP_SUB == 1 && l == 0) ? 2 : 1); ++rep)
    if (l == 0) TS_START(F, 1);
    for (int it = F.vcu; it < 32 * 15; it += F.G) mlstm_itemA(F, l, it / 15, it % 15, F.otm, F.stm);
    if (l == 0) TS_STOP(F, 1);
    for (int rep = 0; rep < ((DUP_SUB == 2 && l == 0) ? 2 : 1); ++rep)
    if (l == 0) TS_START(F, 2);
    for (int i2 = F.G - 1 - F.vcu; i2 < 32 * 15; i2 += F.G) hgrn_itemA(F, l, i2 / 15, i2 % 15, F.oth, F.sth);
    if (l == 0) TS_STOP(F, 2);
    const int nna = 8 * 6 * 16 + (l == 0 ? 48 : 0);
    for (int rep = 0; rep < ((DUP_SUB == 3 && l == 0) ? 2 : 1); ++rep)
    for (int it = F.G - 1 - F.vcu; it < nna; it += F.G) {
        if (it < 768) na_item(F, l, it / 96, (it / 16) % 6, 4 * (it % 16));
        else na_item(F, l, (it - 768) / 6, (it - 768) % 6, -1);
    }
}
__device__ __forceinline__ void phase_mixC(const Ctx& F, int l) {
    mlstm_load_rope(F, F.rope);
    for (int rep = 0; rep < ((DUP_SUB == 4 && l == 0) ? 2 : 1); ++rep)
    if (l == 0) TS_START(F, 4);
    for (int it = F.vcu; it < 256; it += F.G) mlstm_itemC(F, l, it >> 3, it & 7, F.otm, F.stm);
    if (l == 0) TS_STOP(F, 4);
    for (int rep = 0; rep < ((DUP_SUB == 5 && l == 0) ? 2 : 1); ++rep)
    if (l == 0) TS_START(F, 5);
    for (int it = F.vcu; it < 256; it += F.G) hgrn_itemC(F, l, it >> 3, it & 7, F.oth, F.sth);
    if (l == 0) TS_STOP(F, 5);
}

constexpr int NPH = 12;
struct Args { const float* in[15]; float* out; unsigned char* ws; int ph_lo, ph_hi; };
__global__ void __launch_bounds__(512, 2) mega_fwd(Args args) {
    extern __shared__ __attribute__((aligned(16))) unsigned char lds[];
    Ctx F;
    F.lds = (LAS unsigned char*)lds;
    F.tid = threadIdx.x; F.lane = F.tid & 63; F.wave = __builtin_amdgcn_readfirstlane(F.tid >> 6);
    F.G = gridDim.x; { const int bx = blockIdx.x; F.vcu = (F.G % 8 == 0) ? (bx % 8) * (F.G / 8) + bx / 8 : bx; }
    F.gw = F.vcu * 8 + F.wave; F.NGW = F.G * 8;
    unsigned char* ws = args.ws;
    F.x = args.in[0]; F.c = args.in[1]; F.ctx = args.in[2]; F.c_ctx = args.in[3]; F.w_mod = args.in[4]; F.b_mod = args.in[5]; F.g_pre = args.in[6]; F.g_post = args.in[7];
    F.w_in = args.in[8]; F.w_out = args.in[9]; F.hgrn_lb = args.in[10]; F.hgrn_gn = args.in[11]; F.gate_b = args.in[12]; F.mlstm_gn = args.in[13]; F.na_rpb = args.in[14];
    F.out = args.out;
    F.wt_in = (bf16*)(ws + WS_WT_IN); F.wt_out = (bf16*)(ws + WS_WT_OUT); F.mod = (float*)(ws + WS_MOD); F.gates = (float*)(ws + WS_GATES); F.ctx1 = (float*)(ws + WS_CTX1);
    F.hxy = (bf16*)(ws + WS_HXY); F.P = (bf16*)(ws + WS_P); F.UX = (bf16*)(ws + WS_P); F.oth = (bf16*)(ws + WS_OH); F.sth = (float*)(ws + WS_STH); F.otm = (bf16*)(ws + WS_OM); F.stm = (float*)(ws + WS_STM); F.rope = (float*)(ws + WS_ROPE);
    for (int u = F.tid; u < (LDS_BYTES - LDSCTL_OFF) / 4; u += 512) ((LAS unsigned*)(F.lds + LDSCTL_OFF))[u] = 0u;
    __syncthreads();
    XcdBarrier bar = xcd_barrier_post((unsigned*)(ws + WS_CTL) + CW_BAR, (volatile LAS unsigned*)(F.lds + MISC_OFF) + 8);

    const int lo = args.ph_lo, hi = args.ph_hi;
#ifndef DUP_PHASE
#define DUP_PHASE -1
#endif
#define IN(k) (lo <= (k) && (k) < hi)
#define SEAM(k) do { if ((k) + 1 < hi) xcd_barrier(bar); } while (0)
#define PHASE(k, ...) if (IN(k)) { TS_START(F, 100 + (k)); __VA_ARGS__; if ((k) == DUP_PHASE) { xcd_barrier(bar); __VA_ARGS__; } SEAM(k); TS_STOP(F, 100 + (k)); }
    PHASE(0, phase_p0(F))
    PHASE(1, phase_prenorm0(F))
#define LAYER(l) \
    PHASE(2 + 5 * (l), { \
        pg8::Gemm g{F.hxy, F.wt_in + (size_t)(l) * NPAD * 1024, M, NPAD, 1024}; \
        pg8::EpiIn E{F.P, F.gates, F.gate_b + (l) * 16}; \
        if ((l) == 0) { pg8::StaticOrder SO; SO.init(M, NPAD, F.G, (int)blockIdx.x); pg8::gemm_phase<pg8::EpiIn, pg8::StaticOrder, true, true>(F.lds + RING_OFF, g, SO, E); } \
        else { pg8::SkipOrder SO; SO.init(F.G, (int)blockIdx.x); pg8::gemm_phase<pg8::EpiIn, pg8::SkipOrder, true, true>(F.lds + RING_OFF, g, SO, E); } }) \
    PHASE(3 + 5 * (l), phase_mixA(F, (l))) \
    PHASE(4 + 5 * (l), phase_mixC(F, (l))) \
    PHASE(5 + 5 * (l), { \
        constexpr int Ml = (l) == 0 ? M : MX; \
        pg8::Gemm g{F.hxy, F.wt_out + (size_t)(l) * 1024 * 1024, Ml, 1024, 1024}; pg8::StaticOrder SO; SO.init(Ml, 1024, F.G, (int)blockIdx.x); \
        pg8::EpiOut E{F.UX}; \
        pg8::gemm_phase<pg8::EpiOut, pg8::StaticOrder, true, true>(F.lds + RING_OFF, g, SO, E); }) \
    PHASE(6 + 5 * (l), phase_post(F, (l)))
    LAYER(0)
    LAYER(1)
#undef LAYER
#undef PHASE
#undef IN
#undef SEAM
    if (PROBE_T != 0 && blockIdx.x == 0 && F.tid == 0) { const unsigned long long t0 = __builtin_amdgcn_s_memtime(), dt = 8ull * TS_LDS(F)[0]; while (__builtin_amdgcn_s_memtime() - t0 < dt) __builtin_amdgcn_s_sleep(8); }
}

extern "C" void kernel_launch(void* const* d_in, const int* in_sizes, int n_in, void* d_out, int out_size, void* d_ws, size_t ws_size, hipStream_t stream) {
    static int grid = 0;
    if (grid == 0) {
        if (n_in != 15 || ws_size < WS_END) { fprintf(stderr, "kernel_launch: unexpected n_in %d / ws_size %zu (need %zu); nothing launched\n", n_in, ws_size, (size_t)WS_END); grid = -1; return; }
        int dev = 0, cus = 0, per_cu = 0;
        if (hipGetDevice(&dev) != hipSuccess || hipDeviceGetAttribute(&cus, hipDeviceAttributeMultiprocessorCount, dev) != hipSuccess) { grid = -1; return; }
        if (hipFuncSetAttribute((const void*)mega_fwd, hipFuncAttributeMaxDynamicSharedMemorySize, LDS_BYTES) != hipSuccess) { fprintf(stderr, "kernel_launch: hipFuncSetAttribute failed\n"); grid = -1; return; }
        if (hipOccupancyMaxActiveBlocksPerMultiprocessor(&per_cu, (const void*)mega_fwd, 512, LDS_BYTES) != hipSuccess || per_cu < 1) { fprintf(stderr, "kernel_launch: occupancy query says %d blocks/CU\n", per_cu); (void)hipGetLastError(); grid = -1; return; }
        grid = cus;
    }
    if (grid < 0) return;
    (void)hipMemsetAsync((char*)d_ws + WS_CTL, 0, CTL_BYTES, stream);
    Args a{};
    for (int i = 0; i < 15; ++i) a.in[i] = (const float*)d_in[i];
    a.out = (float*)d_out; a.ws = (unsigned char*)d_ws; a.ph_lo = 0; a.ph_hi = NPH;
    hipLaunchKernelGGL(mega_fwd, dim3(grid), dim3(512), LDS_BYTES, stream, a);
}
```

```cpp
#include <hip/hip_runtime.h>
#include <stdint.h>
#include <cstdio>

namespace cfg {
constexpr int D = 1024, NB = 8, S = 4096, CTX = 256;
constexpr int MX = NB * S, MC = NB * CTX, M = MX + MC;
constexpr int PIN = 4752, NPAD = 4864, PLD = 4736;
constexpr int A_Q = 0, A_FF = 256, A_FB = 512, A_I = 768, A_Z = 1024, B_Q = 1280, B_K = 1664, B_V = 2048, B_O = 2432, B_Z = 2816,
              C_Q = 3200, C_K = 3584, C_V = 3968, C_Z = 4352;
constexpr float EPS = 1e-6f;
constexpr size_t WS_CTL = 0, CTL_BYTES = 65536;
constexpr size_t WS_WT_IN = WS_CTL + CTL_BYTES;
constexpr size_t WS_WT_OUT = WS_WT_IN + 2ull * NPAD * 1024 * 2;
constexpr size_t WS_MOD = WS_WT_OUT + 2ull * 1024 * 1024 * 2;
constexpr size_t WS_GATES = WS_MOD + 2ull * 9 * 3072 * 4;
constexpr size_t WS_CTX1 = WS_GATES + (size_t)M * 16 * 4;
constexpr size_t WS_HXY = WS_CTX1 + (size_t)MC * 1024 * 4;
constexpr size_t WS_P = WS_HXY + (size_t)M * 1024 * 2;
constexpr size_t WS_OH = WS_P + (size_t)M * PLD * 2;
constexpr size_t WS_OM = WS_OH + (size_t)M * 256 * 4;
constexpr size_t WS_STM = WS_OM + (size_t)M * 384 * 2;
constexpr size_t WS_ROPE = WS_STM + 32ull * 2 * 8 * (96 * 112 + 16) * 4;
constexpr size_t WS_STH = WS_ROPE + 64 * 24 * 8;
constexpr size_t WS_END = WS_STH + 32ull * 2 * 8 * (64 * 64 + 64) * 4;
static_assert(WS_END <= 536870912ull, "workspace");
static_assert(WS_WT_IN % 256 == 0 && WS_MOD % 256 == 0 && WS_GATES % 256 == 0 && WS_CTX1 % 256 == 0 && WS_HXY % 256 == 0 && WS_P % 256 == 0 && WS_OH % 256 == 0 && WS_OM % 256 == 0 && WS_STM % 256 == 0 && WS_ROPE % 256 == 0 && WS_STH % 256 == 0, "align");
}
using namespace cfg;

namespace pg8 {
#define PG8_LAS __attribute__((address_space(3)))
typedef unsigned short bf16_t;
typedef short bf16x8 __attribute__((ext_vector_type(8)));
typedef float f32x4 __attribute__((ext_vector_type(4)));
typedef unsigned u32x4 __attribute__((ext_vector_type(4)));
constexpr int BM = 256, BK = 64, HALF = 128, HTB = HALF * BK * 2  , STAGE_BYTES = 8 * HTB, NXCD = 8, WGM = 8;

__host__ __device__ __forceinline__ int lds_byte(int r, int c) { const int st = (r >> 4) * 2 + (c >> 5), rr = r & 15, cc = c & 31, ob = rr * 64 + cc * 2; return st * 1024 + (ob ^ (((ob >> 9) & 1) << 5)); }
__host__ __device__ __forceinline__ void stage_rc(int b, int& R, int& C) { const int st = b / 1024, sb = b % 1024, swz = sb ^ (((sb >> 9) & 1) << 5); R = (st >> 1) * 16 + swz / 64; C = (st & 1) * 32 + (swz % 64) / 2; }
__host__ __device__ __forceinline__ int perm32(int rho) { const int n = rho >> 4, i = rho & 15; return 8 * (i >> 2) + 4 * n + (i & 3); }

struct Unit { int pm, pn; };
struct Gemm { const bf16_t* A; const bf16_t* Bt; int M, N, K; };

struct StaticOrder {
    int nM, nN, nwg, G, c;
    __host__ __device__ void init(int M, int N, int G_, int c_) { nM = M / BM; nN = N / BM; nwg = nM * nN; G = G_; c = c_; }
    __host__ __device__ bool next(int i, Unit& u) const {
        const long L = (long)i * G + c; if (L >= nwg) return false;
        int wgid = (int)L; { const int q = nwg / NXCD, r = nwg % NXCD, xcd = wgid % NXCD, off = wgid / NXCD; wgid = (xcd < r ? xcd * (q + 1) : r * (q + 1) + (xcd - r) * q) + off; }
        const int nig = WGM * nN, gid = wgid / nig, fm = gid * WGM, gsz = (nM - fm) < WGM ? (nM - fm) : WGM;
        u.pm = fm + ((wgid % nig) % gsz); u.pn = (wgid % nig) / gsz; return true;
    }
    __device__ __forceinline__ void a_ready(const Unit&) const {}
    __device__ __forceinline__ void done(const Unit&) const {}
};

__device__ __forceinline__ unsigned cvt_pk_bf16(float lo, float hi) { unsigned r; asm volatile("v_cvt_pk_bf16_f32 %0, %1, %2" : "=v"(r) : "v"(lo), "v"(hi)); return r; }
__device__ __forceinline__ float logsigmoid_e(float v) { return fminf(v, 0.f) - log1pf(__expf(-fabsf(v))); }

struct EpiIn {
    static constexpr bool PERM = true, AFTER_DRAIN = false;
    bf16_t* P; float* gates; const float* gate_b;
    __device__ __forceinline__ void operator()(const f32x4 (&acc)[2][2][4][2], const Unit& u, int wr, int wc, int fr, int fq) const {
        const int row0 = u.pm * BM + wr * 64 + fr, col0 = u.pn * BM + wc * 32 + 8 * fq;
#pragma unroll
        for (int bj = 0; bj < 2; ++bj) {
            const int col = col0 + bj * HALF;
            if (col < cfg::PLD) {
                const int act = col < 256 ? 1 : col < 1024 ? 0 : col < 1280 ? 2 : col < 1664 ? 3 : col < 2432 ? 0 : col < 2816 ? 4 : col < 3200 ? 2 : col < 3584 ? 5 : col < 4352 ? 0 : 2;
#pragma unroll
                for (int ai = 0; ai < 2; ++ai)
#pragma unroll
                    for (int m = 0; m < 4; ++m) { f32x4 v0 = acc[ai][bj][m][0], v1 = acc[ai][bj][m][1];
                        if (act == 1 || act == 2 || act == 4) { const float sc = act == 1 ? 0.125f : 1.f;
#pragma unroll
                            for (int e = 0; e < 4; ++e) { const float s0 = __builtin_amdgcn_rcpf(1.f + __expf(-v0[e])), s1 = __builtin_amdgcn_rcpf(1.f + __expf(-v1[e])); v0[e] = act == 4 ? s0 : v0[e] * s0 * sc; v1[e] = act == 4 ? s1 : v1[e] * s1 * sc; } }
                        else if (act == 3) { v0 = v0 * 0.10206207261596575f; v1 = v1 * 0.10206207261596575f; }
                        else if (act == 5) { v0 = v0 * (0.125f * 1.4426950408889634f); v1 = v1 * (0.125f * 1.4426950408889634f); }
                        u32x4 w; w.x = cvt_pk_bf16(v0[0], v0[1]); w.y = cvt_pk_bf16(v0[2], v0[3]); w.z = cvt_pk_bf16(v1[0], v1[1]); w.w = cvt_pk_bf16(v1[2], v1[3]);
                        *(u32x4*)(P + (size_t)(row0 + ai * HALF + m * 16) * cfg::PLD + col) = w; }
            } else if (col < cfg::PIN) {
                const int g0 = col - cfg::PLD;
                const f32x4 b0 = *(const f32x4*)(gate_b + g0), b1 = *(const f32x4*)(gate_b + g0 + 4);
#pragma unroll
                for (int ai = 0; ai < 2; ++ai)
#pragma unroll
                    for (int m = 0; m < 4; ++m) { f32x4 v0 = acc[ai][bj][m][0] + b0, v1 = acc[ai][bj][m][1] + b1;
                        if (g0 >= 8) {
#pragma unroll
                            for (int e = 0; e < 4; ++e) { v0[e] = logsigmoid_e(v0[e]); v1[e] = logsigmoid_e(v1[e]); } }
                        float* gp = gates + (size_t)(row0 + ai * HALF + m * 16) * 16 + g0;
                        *(f32x4*)gp = v0; *(f32x4*)(gp + 4) = v1; }
            }
        }
    }
};
struct EpiOut {
    static constexpr bool PERM = true, AFTER_DRAIN = false;
    bf16_t* C;
    __device__ __forceinline__ void operator()(const f32x4 (&acc)[2][2][4][2], const Unit& u, int wr, int wc, int fr, int fq) const {
        const int row0 = u.pm * BM + wr * 64 + fr, col0 = u.pn * BM + wc * 32 + 8 * fq;
#pragma unroll
        for (int ai = 0; ai < 2; ++ai)
#pragma unroll
            for (int m = 0; m < 4; ++m) { bf16_t* rowp = C + (size_t)(row0 + ai * HALF + m * 16) * 1024 + col0;
#pragma unroll
                for (int bj = 0; bj < 2; ++bj) { const f32x4 v0 = acc[ai][bj][m][0], v1 = acc[ai][bj][m][1];
                    u32x4 w; w.x = cvt_pk_bf16(v0[0], v0[1]); w.y = cvt_pk_bf16(v0[2], v0[3]); w.z = cvt_pk_bf16(v1[0], v1[1]); w.w = cvt_pk_bf16(v1[2], v1[3]);
                    *(u32x4*)(rowp + bj * HALF) = w; } }
    }
};
struct SkipOrder {
    StaticOrder lat; int G, c;
    __device__ void init(int G_, int c_) { lat.init(cfg::MX, cfg::NPAD, G_, c_); G = G_; c = c_; }
    __device__ bool next(int i, Unit& u) const {
        const int L = i * G + c;
        if (L < lat.nwg) return lat.next(i, u);
        const int j = L - lat.nwg; if (j >= 88) return false;
        const int jj = j % 11; u.pm = 128 + j / 11;
        u.pn = jj < 3 ? 1 + jj : jj < 7 ? 3 + jj : jj < 10 ? 7 + jj : 18;
        return true;
    }
    __device__ __forceinline__ void a_ready(const Unit&) const {}
    __device__ __forceinline__ void done(const Unit&) const {}
};

template <class Epi, class Sched, bool ALIGN_EPI = false, bool SP2 = false>
__device__ __forceinline__ void gemm_phase(PG8_LAS unsigned char* lds, const Gemm g, const Sched& S, const Epi& E) {
    const int tid = threadIdx.x, wid = __builtin_amdgcn_readfirstlane(tid >> 6), lane = tid & 63, wr = wid >> 2, wc = wid & 3, fr = lane & 15, fq = lane >> 4;
    const int K = g.K, nt = K / BK;
    unsigned voffA[2], voffB[2];
#pragma unroll
    for (int i = 0; i < 2; ++i) { int R, C; stage_rc(tid * 16 + i * 8192, R, C); const int Rb = Epi::PERM ? ((R & ~31) + perm32(R & 31)) : R;
        voffA[i] = (unsigned)(R * K + C) * 2u; voffB[i] = (unsigned)(Rb * K + C) * 2u; }
    const size_t kstep = (size_t)(BK * 2);
    const size_t hstep = (size_t)HALF * K * 2;
    const size_t tstep = 2 * hstep;
    const unsigned ldsw = (unsigned)wid * 1024u;
    const int aoff = lds_byte(wr * 64 + fr, fq * 8), boff = lds_byte(wc * 32 + fr, fq * 8);
#define PG8_SA(b, h) (((b) * 2 + (h)) * HTB)
#define PG8_SB(b, h) ((4 + (b) * 2 + (h)) * HTB)
#define PG8_STAGE(bufoff, gbase, voff) do { _Pragma("unroll") for (int _i = 0; _i < 2; ++_i) \
        __builtin_amdgcn_global_load_lds((const unsigned*)((const char*)(gbase) + (voff)[_i]), (PG8_LAS unsigned*)(lds + (bufoff) + ldsw + _i * 8192), 16, 0, 0); } while (0)
#define PG8_LDA(dst, b, h) do { _Pragma("unroll") for (int m = 0; m < 4; ++m) _Pragma("unroll") for (int k = 0; k < 2; ++k) dst[m][k] = *(const PG8_LAS bf16x8*)(lds + PG8_SA(b, h) + aoff + m * 2048 + k * 1024); } while (0)
#define PG8_LDB(dst, b, h) do { _Pragma("unroll") for (int n = 0; n < 2; ++n) _Pragma("unroll") for (int k = 0; k < 2; ++k) dst[n][k] = *(const PG8_LAS bf16x8*)(lds + PG8_SB(b, h) + boff + n * 2048 + k * 1024); } while (0)
#define PG8_MMA(ai, bj, At, Bt) do { __builtin_amdgcn_s_setprio(1); _Pragma("unroll") for (int m = 0; m < 4; ++m) _Pragma("unroll") for (int n = 0; n < 2; ++n) _Pragma("unroll") for (int k = 0; k < 2; ++k) \
        acc[ai][bj][m][n] = __builtin_amdgcn_mfma_f32_16x16x32_bf16(Bt[n][k], At[m][k], acc[ai][bj][m][n], 0, 0, 0); __builtin_amdgcn_s_setprio(0); } while (0)
#define PG8_WAIT_V(n) asm volatile("s_waitcnt vmcnt(" #n ")" ::: "memory")
#define PG8_WAIT_L(n) asm volatile("s_waitcnt lgkmcnt(" #n ")" ::: "memory")
#define PG8_BAR __builtin_amdgcn_s_barrier()
#define PG8_SCHED __builtin_amdgcn_sched_barrier(0)
    Unit cur, nxt; int ui = 0;
    if (!S.next(0, cur)) return;
    f32x4 acc[2][2][4][2];
#pragma unroll
    for (int a = 0; a < 2; ++a)
#pragma unroll
        for (int b = 0; b < 2; ++b)
#pragma unroll
            for (int m = 0; m < 4; ++m)
#pragma unroll
                for (int n = 0; n < 2; ++n) acc[a][b][m][n] = (f32x4){0.f, 0.f, 0.f, 0.f};
    bf16x8 At[4][2], B0[2][2], B1[2][2];
    const char* cA = (const char*)g.A + (size_t)cur.pm * tstep; const char* cB = (const char*)g.Bt + (size_t)cur.pn * tstep;
    S.a_ready(cur);
    if constexpr (SP2) {
        PG8_STAGE(PG8_SB(0, 0), cB, voffB); PG8_STAGE(PG8_SB(0, 1), cB + hstep, voffB); PG8_STAGE(PG8_SA(0, 0), cA, voffA); PG8_STAGE(PG8_SA(0, 1), cA + hstep, voffA);
        if (wr == 1) PG8_BAR;
        PG8_WAIT_V(2); PG8_BAR;
        PG8_STAGE(PG8_SB(1, 0), cB + kstep, voffB); PG8_STAGE(PG8_SA(1, 0), cA + kstep, voffA); PG8_STAGE(PG8_SB(1, 1), cB + hstep + kstep, voffB);
        PG8_WAIT_V(6); PG8_BAR;
    } else {
        PG8_STAGE(PG8_SB(0, 0), cB, voffB); PG8_STAGE(PG8_SA(0, 0), cA, voffA); PG8_STAGE(PG8_SB(0, 1), cB + hstep, voffB); PG8_STAGE(PG8_SA(0, 1), cA + hstep, voffA);
        if (wr == 1) PG8_BAR;
        PG8_WAIT_V(4); PG8_BAR;
        PG8_STAGE(PG8_SB(1, 0), cB + kstep, voffB); PG8_STAGE(PG8_SA(1, 0), cA + kstep, voffA); PG8_STAGE(PG8_SB(1, 1), cB + hstep + kstep, voffB);
        PG8_WAIT_V(6); PG8_BAR;
    }
    for (;;) {
        const bool has_next = S.next(ui + 1, nxt);
        const char* nA = has_next ? (const char*)g.A + (size_t)nxt.pm * tstep : cA; const char* nB = has_next ? (const char*)g.Bt + (size_t)nxt.pn * tstep : cB;
        for (int t = 0; t < nt; t += 2) {
            const bool last = (t == nt - 2);
            const char* a1 = cA + (size_t)(t + 1) * kstep;
            const char* a2 = last ? nA : cA + (size_t)(t + 2) * kstep; const char* b2 = last ? nB : cB + (size_t)(t + 2) * kstep;
            const char* a3 = a2 + kstep; const char* b3 = b2 + kstep;
            if (last && has_next) S.a_ready(nxt);
            if constexpr (SP2) {
            PG8_LDB(B0, 0, 0); PG8_LDB(B1, 0, 1); PG8_SCHED; PG8_LDA(At, 0, 0); PG8_STAGE(PG8_SA(1, 1), a1 + hstep, voffA);
            PG8_WAIT_V(8); PG8_WAIT_L(0); PG8_BAR; PG8_MMA(0, 0, At, B0); PG8_MMA(0, 1, At, B1); PG8_BAR; PG8_SCHED;
            PG8_LDA(At, 0, 1); PG8_STAGE(PG8_SB(0, 0), b2, voffB); PG8_STAGE(PG8_SB(0, 1), b2 + hstep, voffB); PG8_STAGE(PG8_SA(0, 0), a2, voffA);
            PG8_WAIT_V(8); PG8_WAIT_L(0); PG8_BAR; PG8_MMA(1, 0, At, B0); PG8_MMA(1, 1, At, B1); PG8_BAR; PG8_SCHED;
            PG8_LDB(B0, 1, 0); PG8_LDB(B1, 1, 1); PG8_SCHED; PG8_LDA(At, 1, 0); PG8_STAGE(PG8_SA(0, 1), a2 + hstep, voffA);
            PG8_WAIT_V(8); PG8_WAIT_L(0); PG8_BAR; PG8_MMA(0, 0, At, B0); PG8_MMA(0, 1, At, B1); PG8_BAR; PG8_SCHED;
            PG8_LDA(At, 1, 1); PG8_STAGE(PG8_SB(1, 0), b3, voffB); PG8_STAGE(PG8_SB(1, 1), b3 + hstep, voffB); PG8_STAGE(PG8_SA(1, 0), a3, voffA);
            PG8_WAIT_V(8); PG8_WAIT_L(0); PG8_BAR; PG8_MMA(1, 0, At, B0); PG8_MMA(1, 1, At, B1); PG8_BAR; PG8_SCHED;
            } else {
            PG8_LDB(B0, 0, 0); PG8_SCHED; PG8_LDA(At, 0, 0); PG8_STAGE(PG8_SA(1, 1), a1 + hstep, voffA);
            PG8_WAIT_L(8); PG8_BAR; PG8_WAIT_L(0); PG8_MMA(0, 0, At, B0); PG8_BAR; PG8_SCHED;
            PG8_LDB(B1, 0, 1); PG8_STAGE(PG8_SB(0, 0), b2, voffB);
            PG8_BAR; PG8_WAIT_L(0); PG8_MMA(0, 1, At, B1); PG8_BAR;
            PG8_LDA(At, 0, 1); PG8_STAGE(PG8_SA(0, 0), a2, voffA);
            PG8_BAR; PG8_WAIT_L(0); PG8_MMA(1, 0, At, B0); PG8_BAR; PG8_SCHED;
            PG8_STAGE(PG8_SB(0, 1), b2 + hstep, voffB);
            PG8_WAIT_V(6); PG8_BAR; PG8_MMA(1, 1, At, B1); PG8_BAR;
            PG8_LDB(B0, 1, 0); PG8_SCHED; PG8_LDA(At, 1, 0); PG8_STAGE(PG8_SA(0, 1), a2 + hstep, voffA);
            PG8_WAIT_L(8); PG8_BAR; PG8_WAIT_L(0); PG8_MMA(0, 0, At, B0); PG8_BAR; PG8_SCHED;
            PG8_LDB(B1, 1, 1); PG8_STAGE(PG8_SB(1, 0), b3, voffB);
            PG8_BAR; PG8_WAIT_L(0); PG8_MMA(0, 1, At, B1); PG8_BAR;
            PG8_LDA(At, 1, 1); PG8_STAGE(PG8_SA(1, 0), a3, voffA);
            PG8_BAR; PG8_WAIT_L(0); PG8_MMA(1, 0, At, B0); PG8_BAR; PG8_SCHED;
            PG8_STAGE(PG8_SB(1, 1), b3 + hstep, voffB);
            PG8_WAIT_V(6); PG8_BAR; PG8_MMA(1, 1, At, B1); PG8_BAR;
            }
        }
        if constexpr (ALIGN_EPI) { if (wr == 0) PG8_BAR; }
        if constexpr (!Epi::AFTER_DRAIN) { E(acc, cur, wr, wc, fr, fq); S.done(cur); }
        if (!has_next) break;
#pragma unroll
        for (int a = 0; a < 2; ++a)
#pragma unroll
            for (int b = 0; b < 2; ++b)
#pragma unroll
                for (int m = 0; m < 4; ++m)
#pragma unroll
                    for (int n = 0; n < 2; ++n) acc[a][b][m][n] = (f32x4){0.f, 0.f, 0.f, 0.f};
        cur = nxt; cA = nA; cB = nB; ++ui;
        if constexpr (ALIGN_EPI) { if (wr == 1) PG8_BAR; }
    }
    PG8_WAIT_V(0);
    if constexpr (!ALIGN_EPI) { if (wr == 0) PG8_BAR; }
    PG8_BAR;
    if constexpr (Epi::AFTER_DRAIN) { E.fused(acc, cur, wr, wc, fr, fq, lds, wid, lane); S.done(cur); }
#undef PG8_SA
#undef PG8_SB
#undef PG8_STAGE
#undef PG8_LDA
#undef PG8_LDB
#undef PG8_MMA
#undef PG8_WAIT_V
#undef PG8_WAIT_L
#undef PG8_BAR
#undef PG8_SCHED
}
}
constexpr int RING_OFF = 0, RING_BYTES = 131072;
constexpr int LDSCTL_OFF = RING_BYTES, MISC_OFF = LDSCTL_OFF + 320;
constexpr int LDS_BYTES = 147456;
constexpr int CW_BAR = 4096;

#define GAS __attribute__((address_space(1)))
#define LAS __attribute__((address_space(3)))
typedef unsigned short bf16;
typedef unsigned v4u __attribute__((ext_vector_type(4)));
typedef float f32x4 __attribute__((ext_vector_type(4)));
typedef short bf16x8 __attribute__((ext_vector_type(8)));
typedef GAS unsigned gu32;
#define RLX_AGENT __ATOMIC_RELAXED, __HIP_MEMORY_SCOPE_AGENT
#define LDS_WAIT() asm volatile("s_waitcnt lgkmcnt(0)" ::: "memory")
#define VM_WAIT() asm volatile("s_waitcnt vmcnt(0)" ::: "memory")
__device__ __forceinline__ unsigned f2bfu(float f) { unsigned u = __builtin_bit_cast(unsigned, f); return (u + 0x7fffu + ((u >> 16) & 1u)) >> 16; }
__device__ __forceinline__ bf16 f2bf(float f) { return (bf16)f2bfu(f); }
typedef float f32x2_t __attribute__((ext_vector_type(2))); typedef __bf16 bf16x2_t __attribute__((ext_vector_type(2)));
__device__ __forceinline__ unsigned pk2(float lo, float hi) { f32x2_t v = {lo, hi}; bf16x2_t b = __builtin_convertvector(v, bf16x2_t); return __builtin_bit_cast(unsigned, b); }
__device__ __forceinline__ float xor16_max(float v) { auto r = __builtin_amdgcn_permlane16_swap(__float_as_uint(v), __float_as_uint(v), false, false); return fmaxf(__uint_as_float(r[0]), __uint_as_float(r[1])); }
__device__ __forceinline__ float xor32_max(float v) { auto r = __builtin_amdgcn_permlane32_swap(__float_as_uint(v), __float_as_uint(v), false, false); return fmaxf(__uint_as_float(r[0]), __uint_as_float(r[1])); }
__device__ __forceinline__ float xor16_sum(float v) { auto r = __builtin_amdgcn_permlane16_swap(__float_as_uint(v), __float_as_uint(v), false, false); return __uint_as_float(r[0]) + __uint_as_float(r[1]); }
__device__ __forceinline__ float xor32_sum(float v) { auto r = __builtin_amdgcn_permlane32_swap(__float_as_uint(v), __float_as_uint(v), false, false); return __uint_as_float(r[0]) + __uint_as_float(r[1]); }
__device__ __forceinline__ float bf2f(bf16 v) { return __uint_as_float(((unsigned)v) << 16); }
__device__ __forceinline__ float silu_f(float v) { return v / (1.f + __expf(-v)); }
__device__ __forceinline__ float sigmoid_f(float v) { return 1.f / (1.f + __expf(-v)); }
__device__ __forceinline__ float wave_sum(float v) {
#pragma unroll
    for (int o = 1; o < 64; o <<= 1) v += __shfl_xor(v, o);
    return v;
}
__device__ __forceinline__ float rdlane(float v, int i) { return __int_as_float(__builtin_amdgcn_readlane(__float_as_int(v), i)); }


#ifndef PROBE_T
#define PROBE_T 0
#endif
#define TS_LDS(F) ((volatile LAS unsigned long long*)((F).lds + LDSCTL_OFF + 128))
#define TS_START(F, id) do { if (PROBE_T == (id) && blockIdx.x == 0 && (F).tid == 0) TS_LDS(F)[1] = __builtin_amdgcn_s_memtime(); } while (0)
#define TS_STOP(F, id)  do { if (PROBE_T == (id) && blockIdx.x == 0 && (F).tid == 0) TS_LDS(F)[0] += __builtin_amdgcn_s_memtime() - TS_LDS(F)[1]; } while (0)
#define XB_TMO      128
#define XB_XCNT(j)  (256  + 64 * (j))
#define XB_XSUB(j)  (1280 + 64 * (j))
#define XB_XGEN(j)  (2304 + 64 * (j))
#define XB_TOP      3328
#define XB_TOPGEN   3392
#define XCD_BAR_WORDS 3456
#define XB_SPIN_CAP (1u << 18)

__device__ __forceinline__ unsigned xb_ld(unsigned* p)              { return __hip_atomic_load(p, __ATOMIC_RELAXED, __HIP_MEMORY_SCOPE_AGENT); }
__device__ __forceinline__ unsigned xb_add(unsigned* p, unsigned v) { return __hip_atomic_fetch_add(p, v, __ATOMIC_RELAXED, __HIP_MEMORY_SCOPE_AGENT); }
__device__ __forceinline__ unsigned xb_xcc_id() { return (unsigned)__builtin_amdgcn_s_getreg((3 << 11) | 20) & 0xFu; }
#define XB_SPIN(cond, bar) do { unsigned _sp = 0; while (cond) { __builtin_amdgcn_s_sleep(1); \
    if ((++_sp & 255u) == 0u) { if (xb_ld(&(bar)[XB_TMO])) break; if (_sp > XB_SPIN_CAP) { atomicAdd(&(bar)[XB_TMO], 1u); break; } } } } while (0)

struct XcdBarrier {
    unsigned* bar; unsigned x;
    volatile LAS unsigned* st;
};

__device__ __forceinline__ XcdBarrier xcd_barrier_post(unsigned* bar, volatile LAS unsigned* st) {
    XcdBarrier b; b.bar = bar; b.x = xb_xcc_id(); b.st = st;
    if (threadIdx.x == 0) (void)xb_add(&bar[XB_XCNT(b.x)], 1u);
    return b;
}
__device__ __forceinline__ void xcd_barrier_complete(unsigned* bar, unsigned x, unsigned& nloc, unsigned& nx) {
    const unsigned G = gridDim.x * gridDim.y * gridDim.z;
    unsigned sum, cnt, mine, sp = 0u;
    for (;;) {
        sum = 0u; cnt = 0u; mine = 0u;
#pragma unroll
        for (unsigned j = 0; j < 16; ++j) { const unsigned c = xb_ld(&bar[XB_XCNT(j)]); sum += c; cnt += (c > 0u) ? 1u : 0u; mine = (j == x) ? c : mine; }
        if (sum == G) break;
        __builtin_amdgcn_s_sleep(1);
        if ((++sp & 255u) == 0u) { if (xb_ld(&bar[XB_TMO])) break; if (sp > XB_SPIN_CAP) { atomicAdd(&bar[XB_TMO], 1u); break; } }
    }
    nloc = mine > 0u ? mine : 1u; nx = cnt > 0u ? cnt : 1u;
}

__device__ __forceinline__ void xcd_barrier(const XcdBarrier& b) {
    asm volatile("s_waitcnt vmcnt(0)" ::: "memory");
    __syncthreads();
    if (threadIdx.x == 0) {
        unsigned* bar = b.bar;
        __builtin_amdgcn_s_waitcnt(0);
        unsigned nloc = b.st[0], nx = b.st[1];
        if (nloc == 0u) { xcd_barrier_complete(bar, b.x, nloc, nx); b.st[0] = nloc; b.st[1] = nx; }
        const unsigned old = xb_add(&bar[XB_XSUB(b.x)], 1u);
        const unsigned gen = old / nloc;
        if (old + 1u == (gen + 1u) * nloc) {
            __builtin_amdgcn_fence(__ATOMIC_RELEASE, "agent");
            asm volatile("s_waitcnt vmcnt(0)" ::: "memory");
            const unsigned og = xb_add(&bar[XB_TOP], 1u);
            const unsigned tg = og / nx;
            if (og + 1u == (tg + 1u) * nx) xb_add(&bar[XB_TOPGEN], 1u);
            else XB_SPIN(xb_ld(&bar[XB_TOPGEN]) == tg, bar);
            __builtin_amdgcn_fence(__ATOMIC_ACQUIRE, "agent");
            xb_add(&bar[XB_XGEN(b.x)], 1u);
            asm volatile("s_waitcnt vmcnt(0)" ::: "memory");
        } else {
            XB_SPIN(xb_ld(&bar[XB_XGEN(b.x)]) == gen, bar);
            __builtin_amdgcn_fence(__ATOMIC_ACQUIRE, "agent");
            asm volatile("s_waitcnt vmcnt(0)" ::: "memory");
        }
    }
    __syncthreads();
}

struct Ctx {
    LAS unsigned char* lds; int tid, lane, wave, vcu, G, gw, NGW;
    const float *x, *c, *ctx, *c_ctx, *w_mod, *b_mod, *g_pre, *g_post, *w_in, *w_out, *hgrn_lb, *hgrn_gn, *gate_b, *mlstm_gn, *na_rpb;
    float* out; bf16 *wt_in, *wt_out, *hxy, *P; float *mod, *gates, *ctx1, *stm, *sth, *rope; bf16 *otm, *oth, *UX;
};

__device__ __forceinline__ void transpose_item(const float* W, int N, int Nnew, bool remap, bf16* WT, LAS float* scr, int item, int lane) {
    const int nblk = Nnew / 32, kb = item / nblk, nb = item % nblk, k0 = 64 * kb, n0 = 32 * nb;
    const int nn = n0 + (lane & 31);
    int no = nn; if (remap) no = nn < 3200 ? nn : (nn < 4736 ? nn + 16 : (nn < 4752 ? 3200 + nn - 4736 : -1));
#pragma unroll 8
    for (int i = 0; i < 32; ++i) { const int kk = 2 * i + (lane >> 5); scr[kk * 33 + (lane & 31)] = no >= 0 ? W[(size_t)(k0 + kk) * N + no] : 0.f; }
    LDS_WAIT(); asm volatile("" ::: "memory");
    const int c = lane & 7;
#pragma unroll
    for (int j = 0; j < 4; ++j) { const int n = (lane >> 3) + 8 * j; const LAS float* s = scr + (8 * c) * 33 + n;
        v4u o; o.x = pk2(s[0 * 33], s[1 * 33]); o.y = pk2(s[2 * 33], s[3 * 33]); o.z = pk2(s[4 * 33], s[5 * 33]); o.w = pk2(s[6 * 33], s[7 * 33]);
        *(GAS v4u*)(WT + (size_t)(n0 + n) * 1024 + k0 + 8 * c) = o; }
    LDS_WAIT(); asm volatile("" ::: "memory");
}
__device__ __forceinline__ void phase_p0(const Ctx& F) {
    if (F.vcu < 96) {
        LAS float* tab = (LAS float*)(F.lds);
        LAS float* part = (LAS float*)(F.lds + 36864);
        for (int i = F.tid; i < 9 * 1024; i += 512) { const int r = i >> 10, k = i & 1023; const float v = r < 8 ? F.c[r * 1024 + k] : F.c_ctx[k]; tab[i] = silu_f(v); }
        __syncthreads();
        for (int it = F.vcu; it < 96; it += F.G) {
            const int l = it / 48, jb = it % 48, col = jb * 64 + F.lane;
            float acc[9];
#pragma unroll
            for (int r = 0; r < 9; ++r) acc[r] = 0.f;
            const float* wp = F.w_mod + ((size_t)l * 1024 + F.wave * 128) * 3072 + col;
#pragma unroll 4
            for (int k = 0; k < 128; ++k) { const float wv = wp[(size_t)k * 3072];
#pragma unroll
                for (int r = 0; r < 9; ++r) acc[r] += tab[r * 1024 + F.wave * 128 + k] * wv; }
#pragma unroll
            for (int r = 0; r < 9; ++r) part[(F.wave * 9 + r) * 64 + F.lane] = acc[r];
            __syncthreads();
            for (int i = F.tid; i < 9 * 64; i += 512) { const int r = i >> 6, j = i & 63; float s = 0.f;
#pragma unroll
                for (int w = 0; w < 8; ++w) s += part[(w * 9 + r) * 64 + j];
                F.mod[((size_t)l * 9 + r) * 3072 + jb * 64 + j] = s + F.b_mod[l * 3072 + jb * 64 + j]; }
            __syncthreads();
        }
    }
    if (F.vcu == 96 % F.G) for (int i = F.tid; i < 64 * 24; i += 512) { const int pos = i / 24, f = i % 24; const float ang = (float)pos * expf(-(float)(2 * f) * (1.f / 48.f) * 9.210340371976184f); F.rope[2 * i] = cosf(ang); F.rope[2 * i + 1] = sinf(ang); }
    __syncthreads();
    LAS float* scr = (LAS float*)(F.lds + F.wave * 16384);
    constexpr int I_IN = 16 * (NPAD / 32);
    const int gwr = F.NGW - 1 - F.gw;
    for (int it = gwr; it < I_IN; it += F.NGW) transpose_item(F.w_in, PIN, NPAD, true, F.wt_in, scr, it, F.lane);
}
__device__ __forceinline__ void phase_p1_transposes(const Ctx& F) {
    LAS float* scr = (LAS float*)(F.lds + F.wave * 16384);
    constexpr int I_IN = 16 * (NPAD / 32), I_OUT = 16 * 32;
    for (int it = F.gw; it < I_IN + 2 * I_OUT; it += F.NGW) {
        if (it < I_OUT) transpose_item(F.w_out, 1024, 1024, false, F.wt_out, scr, it, F.lane);
        else if (it < I_OUT + I_IN) transpose_item(F.w_in + (size_t)1024 * PIN, PIN, NPAD, true, F.wt_in + (size_t)NPAD * 1024, scr, it - I_OUT, F.lane);
        else transpose_item(F.w_out + (size_t)1024 * 1024, 1024, 1024, false, F.wt_out + (size_t)1024 * 1024, scr, it - I_OUT - I_IN, F.lane);
    }
}

__device__ __forceinline__ void prenorm_row(const float4 (&v)[4], float ss, const float* mod_r, const float* g_pre_l, bf16* dst, int lane) {
    const float rinv = 1.f / sqrtf(ss * (1.f / 1024.f) + EPS);
    const float* sh = mod_r; const float* sc = mod_r + 1024;
#pragma unroll
    for (int j = 0; j < 4; ++j) {
        const int d = 4 * (lane + 64 * j);
        const float4 g = *(const float4*)(g_pre_l + d), s1 = *(const float4*)(sc + d), s0 = *(const float4*)(sh + d);
        const float o0 = v[j].x * rinv * g.x * (1.f + s1.x) + s0.x, o1 = v[j].y * rinv * g.y * (1.f + s1.y) + s0.y;
        const float o2 = v[j].z * rinv * g.z * (1.f + s1.z) + s0.z, o3 = v[j].w * rinv * g.w * (1.f + s1.w) + s0.w;
        uint2 w; w.x = pk2(o0, o1); w.y = pk2(o2, o3);
        *(uint2*)(dst + d) = w;
    }
}
__device__ __forceinline__ void phase_prenorm0(const Ctx& F) {
    for (int m = F.gw; m < M; m += F.NGW) {
        const float* src; int r;
        if (m < MX) { src = F.x + (size_t)m * 1024; r = m / S; } else { src = F.ctx + (size_t)(m - MX) * 1024; r = 8; }
        float4 v[4]; float ss = 0.f;
#pragma unroll
        for (int j = 0; j < 4; ++j) { v[j] = ((const float4*)src)[F.lane + 64 * j]; ss += v[j].x * v[j].x + v[j].y * v[j].y + v[j].z * v[j].z + v[j].w * v[j].w; }
        ss = wave_sum(ss);
        prenorm_row(v, ss, F.mod + (size_t)r * 3072, F.g_pre, F.hxy + (size_t)m * 1024, F.lane);
    }
}
__device__ __forceinline__ void phase_post(const Ctx& F, int l) {
    const int Ml = l == 0 ? M : MX;
    const float* mod_l = F.mod + (size_t)l * 9 * 3072; const float* g_post_l = F.g_post + l * 1024;
    for (int m = F.gw; m < Ml; m += F.NGW) {
        const float* src; float* dst; int r;
        if (m < MX) { src = (l == 0 ? F.x : F.out) + (size_t)m * 1024; dst = F.out + (size_t)m * 1024; r = m / S; }
        else { src = F.ctx + (size_t)(m - MX) * 1024; dst = F.ctx1 + (size_t)(m - MX) * 1024; r = 8; }
        const bf16* ur = F.UX + (size_t)m * 1024;
        float4 u[4]; float ss = 0.f;
#pragma unroll
        for (int j = 0; j < 4; ++j) { const uint2 w = ((const uint2*)ur)[F.lane + 64 * j];
            u[j].x = __uint_as_float(w.x << 16); u[j].y = __uint_as_float(w.x & 0xffff0000u); u[j].z = __uint_as_float(w.y << 16); u[j].w = __uint_as_float(w.y & 0xffff0000u);
            ss += u[j].x * u[j].x + u[j].y * u[j].y + u[j].z * u[j].z + u[j].w * u[j].w; }
        ss = wave_sum(ss);
        const float rinv = 1.f / sqrtf(ss * (1.f / 1024.f) + EPS);
        const float* gt = mod_l + r * 3072 + 2048;
        float ss2 = 0.f;
#pragma unroll
        for (int j = 0; j < 4; ++j) {
            const int d = 4 * (F.lane + 64 * j);
            const float4 g = *(const float4*)(g_post_l + d), t = *(const float4*)(gt + d), xv = *(const float4*)(src + d);
            float4 o; o.x = xv.x + t.x * (u[j].x * rinv * g.x); o.y = xv.y + t.y * (u[j].y * rinv * g.y); o.z = xv.z + t.z * (u[j].z * rinv * g.z); o.w = xv.w + t.w * (u[j].w * rinv * g.w);
            *(float4*)(dst + d) = o; u[j] = o; ss2 += o.x * o.x + o.y * o.y + o.z * o.z + o.w * o.w;
        }
        if (l == 0) { ss2 = wave_sum(ss2); prenorm_row(u, ss2, F.mod + (size_t)(9 + r) * 3072, F.g_pre + 1024, F.hxy + (size_t)m * 1024, F.lane); }
    }
}

__device__ __forceinline__ int seq_row(int b, int step, int dir) {
    if (step < CTX) { const int n = dir ? CTX - 1 - step : step; return MX + b * CTX + n; }
    int t = step - CTX; if (dir) t = S - 1 - t; return b * S + t;
}
#ifndef DUP_SUB
#define DUP_SUB 0
#endif

typedef short s16x4 __attribute__((ext_vector_type(4)));
typedef short v4i16_t __attribute__((ext_vector_type(4)));
__device__ __forceinline__ s16x4 tr_read(const LAS bf16* p) { return __builtin_bit_cast(s16x4, __builtin_amdgcn_ds_read_tr16_b64_v4i16((LAS v4i16_t*)p)); }
__device__ __forceinline__ bf16x8 tr_frag(const LAS bf16* T, int stride, int rowA, int rowB, int col0, int lane) {
    const int q = (lane >> 2) & 3, p = lane & 3;
    const s16x4 lo = tr_read(T + (rowA + q) * stride + col0 + 4 * p), hi = tr_read(T + (rowB + q) * stride + col0 + 4 * p);
    return (bf16x8){lo[0], lo[1], lo[2], lo[3], hi[0], hi[1], hi[2], hi[3]};
}
__device__ __forceinline__ bf16x8 rm_frag(const LAS bf16* T, int stride, int row, int k0) { return *(const LAS bf16x8*)(T + row * stride + k0); }
__device__ __forceinline__ f32x4 mfma16(bf16x8 a, bf16x8 b, f32x4 c) { return __builtin_amdgcn_mfma_f32_16x16x32_bf16(a, b, c, 0, 0, 0); }
typedef unsigned v2u __attribute__((ext_vector_type(2)));
typedef float f32x2 __attribute__((ext_vector_type(2)));
__device__ __forceinline__ void unpack8(const v4u w, float* f) {
    f[0] = __uint_as_float(w.x << 16); f[1] = __uint_as_float(w.x & 0xffff0000u); f[2] = __uint_as_float(w.y << 16); f[3] = __uint_as_float(w.y & 0xffff0000u);
    f[4] = __uint_as_float(w.z << 16); f[5] = __uint_as_float(w.z & 0xffff0000u); f[6] = __uint_as_float(w.w << 16); f[7] = __uint_as_float(w.w & 0xffff0000u);
}
__device__ __forceinline__ v4u pack8(const float* f) { v4u w; w.x = pk2(f[0], f[1]); w.y = pk2(f[2], f[3]); w.z = pk2(f[4], f[5]); w.w = pk2(f[6], f[7]); return w; }

#ifndef PROBE_ML
#define PROBE_ML 0
#endif
__device__ __forceinline__ float wave_scan_incl(float x) {
    int v = __float_as_int(x);
#define DPP_ADD(ctrl, rmask) v = __float_as_int(__int_as_float(v) + __int_as_float(__builtin_amdgcn_update_dpp(0, v, ctrl, rmask, 0xF, false)))
    DPP_ADD(0x111, 0xF); DPP_ADD(0x112, 0xF); DPP_ADD(0x114, 0xF); DPP_ADD(0x118, 0xF); DPP_ADD(0x142, 0xA); DPP_ADD(0x143, 0xC);
#undef DPP_ADD
    return __int_as_float(v);
}
#define LDS_FENCE() asm volatile("" ::: "memory")
namespace ml {
constexpr int QSTR = 104, VSTR = 120;
constexpr int OFF_QS = 0, OFF_KS = OFF_QS + 64 * QSTR * 2, OFF_VS = OFF_KS + 64 * QSTR * 2, OFF_CT = OFF_VS + 64 * VSTR * 2;
constexpr int OFF_HT = OFF_CT + 2 * 112 * QSTR * 2, OFF_DEN = OFF_HT + 64 * 100 * 4, OFF_ROPE = OFF_DEN + 256, OFF_END = OFF_ROPE + 64 * 24 * 8;
static_assert(OFF_END <= RING_BYTES && 6 * 7 * 64 * 16 <= OFF_HT, "mlstm LDS");
constexpr int ST_FLOATS = 96 * 112 + 16;
}
constexpr int NSEG = 4, SEGTOK = S / NSEG, SEGCH = SEGTOK / 64;
struct MlJob { int b, h, isctx, t0, nchunk; };

__device__ __forceinline__ void mlstm_dir(const Ctx& F, int l, const MlJob jb, int dir, int fold_r, int emit_slot, int mode, bf16* otmp, float* ST) {
    using namespace ml;
    int tid_ = F.tid; asm volatile("" : "+v"(tid_));
    const int w = __builtin_amdgcn_readfirstlane(tid_ >> 6);
    const bool tsel = (mode != 0) && !jb.isctx && l == 0;
    if (tsel) TS_START(F, 10);
    LAS bf16* QS = (LAS bf16*)(F.lds + OFF_QS); LAS bf16* KS = (LAS bf16*)(F.lds + OFF_KS); LAS bf16* VS = (LAS bf16*)(F.lds + OFF_VS);
    LAS bf16* CT0 = (LAS bf16*)(F.lds + OFF_CT); LAS float* HT = (LAS float*)(F.lds + OFF_HT); LAS float* DEN = (LAS float*)(F.lds + OFF_DEN);
    const LAS f32x2* ROPE = (const LAS f32x2*)(F.lds + OFF_ROPE);
    const int rowbase = jb.isctx ? MX + jb.b * CTX : jb.b * S;
    const int h = jb.h; const bf16* P = F.P;
    float* STd = ST + (size_t)(((jb.b * 4 + h) * 2 + dir) * 8) * ST_FLOATS;
    f32x4 Cst[7];
#pragma unroll
    for (int et = 0; et < 7; ++et) Cst[et] = (f32x4){0.f, 0.f, 0.f, 0.f};
    if (fold_r >= 0) {
        LAS f32x4* FOLD = (LAS f32x4*)(F.lds + OFF_QS);
        float wk[8];
        { float bs[8]; bs[0] = 0.f;
#pragma unroll
          for (int k = 1; k < NSEG; ++k) bs[k] = STd[(size_t)k * ST_FLOATS + 96 * 112];
          float run = 1.f;
#pragma unroll
          for (int k = NSEG - 1; k >= 0; --k) { wk[k] = (k <= fold_r) ? run : 0.f; run = (k >= 1 && k <= fold_r) ? run * __expf(bs[k]) : run; } }
#pragma unroll 2
        for (int p = tid_; p < 6 * 7 * 64; p += 512) {
            f32x4 v[8];
#pragma unroll
            for (int k = 0; k < NSEG; ++k) v[k] = *(const f32x4*)(STd + (size_t)k * ST_FLOATS + 4 * p);
            f32x4 acc = v[0] * wk[0];
#pragma unroll
            for (int k = 1; k < NSEG; ++k) acc += v[k] * wk[k];
            FOLD[p] = acc;
        }
        __syncthreads();
        if (w < 6) {
#pragma unroll
            for (int et = 0; et < 7; ++et) Cst[et] = FOLD[(w * 7 + et) * 64 + (tid_ & 63)];
        }
        __syncthreads();
    }
    asm volatile("" : "+v"(tid_));
    const int tid = tid_, lane = tid & 63, g = lane >> 4, c = lane & 15;
    float Btot = 0.f;
    for (int i = tid; i < 64 * 16; i += 512) { const int s = i >> 4, e = 96 + (i & 15); VS[s * VSTR + e] = (e == 96) ? (bf16)0x3F80 : (bf16)0; }
    if (w < 6) {
#pragma unroll
        for (int et = 0; et < 7; ++et) { v2u v; v.x = pk2(Cst[et][0], Cst[et][1]); v.y = pk2(Cst[et][2], Cst[et][3]); *(LAS v2u*)(CT0 + (16 * et + c) * QSTR + 16 * w + 4 * g) = v; }
    }
    const bool hasqk = tid < 384; const int qk_tok = tid / 6, qk_pi = tid % 6, qk_part = qk_pi / 3, qk_pp = qk_pi % 3, qk_d0 = 48 * qk_part + 8 * qk_pp;
    const int v1_tok = tid / 12, v1_pc = tid % 12; const bool hasv2 = tid < 256; const int v2_tok = (512 + tid) / 12, v2_pc = (512 + tid) % 12;
    struct LoadSet { v4u q0, q1, k0, k1, v1, v2; float ig, lf; };
    LoadSet LA, LB;
    v2u ft[3], fo[3], fz[3];
    const int fi_i = tid >> 3, fi_e0 = 12 * (tid & 7);
#pragma unroll
    for (int q4 = 0; q4 < 3; ++q4) { ft[q4] = (v2u){0u, 0u}; fo[q4] = (v2u){0u, 0u}; fz[q4] = (v2u){0u, 0u}; }
    LA.q0 = LA.q1 = LA.k0 = LA.k1 = LA.v1 = LA.v2 = (v4u){0u, 0u, 0u, 0u}; LA.ig = LA.lf = 0.f; LB = LA;
    auto tok_of = [&](int ci, int i) -> int { return dir == 0 ? jb.t0 + 64 * ci + i : jb.t0 + 64 * (jb.nchunk - 1 - ci) + (63 - i); };
    auto issue_loads = [&](LoadSet& L, int ci) {
        if (hasqk) { const bf16* pr = P + (size_t)(rowbase + tok_of(ci, qk_tok)) * PLD + h * 96 + qk_d0;
            if (mode != 0) { L.q0 = *(const v4u*)(pr + B_Q); L.q1 = *(const v4u*)(pr + B_Q + 24); }
            L.k0 = *(const v4u*)(pr + B_K); L.k1 = *(const v4u*)(pr + B_K + 24); }
        L.v1 = *(const v4u*)(P + (size_t)(rowbase + tok_of(ci, v1_tok)) * PLD + B_V + h * 96 + 8 * v1_pc);
        if (hasv2) L.v2 = *(const v4u*)(P + (size_t)(rowbase + tok_of(ci, v2_tok)) * PLD + B_V + h * 96 + 8 * v2_pc);
        const float* gp = F.gates + (size_t)(rowbase + tok_of(ci, lane)) * 16 + dir * 4 + h; L.ig = gp[0]; L.lf = gp[8];
    };
    auto issue_fin = [&](int ci) {
        const int m = rowbase + tok_of(ci, fi_i); const bf16* tp = otmp + (size_t)m * 384 + h * 96 + fi_e0; const bf16* pr = P + (size_t)m * PLD + h * 96 + fi_e0;
#pragma unroll
        for (int q4 = 0; q4 < 3; ++q4) { ft[q4] = *(const v2u*)(tp + 4 * q4); fo[q4] = *(const v2u*)(pr + B_O + 4 * q4); fz[q4] = *(const v2u*)(pr + B_Z + 4 * q4); }
    };
    auto finalize = [&](int ci) {
            const int i = tid >> 3, sub = tid & 7, e0 = 12 * sub; const int m = rowbase + tok_of(ci, i);
            float hv[12]; const float rden = 1.f / fmaxf(fabsf(DEN[i]), 1.f);
#pragma unroll
            for (int q4 = 0; q4 < 3; ++q4) { const f32x4 v = *(const LAS f32x4*)(HT + i * 100 + e0 + 4 * q4); hv[4 * q4] = v[0] * rden; hv[4 * q4 + 1] = v[1] * rden; hv[4 * q4 + 2] = v[2] * rden; hv[4 * q4 + 3] = v[3] * rden; }
            bf16* tp = otmp + (size_t)m * 384 + h * 96 + e0;
            if (mode == 1) {
#pragma unroll
                for (int q4 = 0; q4 < 3; ++q4) { v2u v; v.x = pk2(hv[4 * q4], hv[4 * q4 + 1]); v.y = pk2(hv[4 * q4 + 2], hv[4 * q4 + 3]); *(v2u*)(tp + 4 * q4) = v; }
            } else {
                float ss = 0.f;
#pragma unroll
                for (int q4 = 0; q4 < 3; ++q4) { const v2u v = ft[q4];
                    hv[4 * q4] += __uint_as_float(v.x << 16); hv[4 * q4 + 1] += __uint_as_float(v.x & 0xffff0000u); hv[4 * q4 + 2] += __uint_as_float(v.y << 16); hv[4 * q4 + 3] += __uint_as_float(v.y & 0xffff0000u); }
#pragma unroll
                for (int e = 0; e < 12; ++e) ss += hv[e] * hv[e];
                ss += __shfl_xor(ss, 1); ss += __shfl_xor(ss, 2); ss += __shfl_xor(ss, 4);
                const float rinv = 1.f / sqrtf(ss * (1.f / 96.f) + EPS);
                bf16* yp = F.hxy + (size_t)m * 1024 + 256 + h * 96 + e0; const float* gnv = F.mlstm_gn + l * 384 + h * 96 + e0;
#pragma unroll
                for (int q4 = 0; q4 < 3; ++q4) { const v2u ov = fo[q4], zv = fz[q4];
                    const float og[4] = {__uint_as_float(ov.x << 16), __uint_as_float(ov.x & 0xffff0000u), __uint_as_float(ov.y << 16), __uint_as_float(ov.y & 0xffff0000u)};
                    const float zg[4] = {__uint_as_float(zv.x << 16), __uint_as_float(zv.x & 0xffff0000u), __uint_as_float(zv.y << 16), __uint_as_float(zv.y & 0xffff0000u)};
                    float o[4];
#pragma unroll
                    for (int e = 0; e < 4; ++e) o[e] = og[e] * (hv[4 * q4 + e] * rinv * gnv[4 * q4 + e]) * zg[e];
                    v2u v; v.x = pk2(o[0], o[1]); v.y = pk2(o[2], o[3]); *(v2u*)(yp + 4 * q4) = v; }
            }
    };
    issue_loads(LA, 0); if (jb.nchunk > 1) issue_loads(LB, 1);
    __syncthreads();
    if (tsel) TS_STOP(F, 10);
    auto chunk_step = [&](LoadSet& L, int ci) {
        if (tsel) TS_START(F, 11);
        LAS bf16* CTc = CT0 + (ci & 1) * 112 * QSTR; LAS bf16* CTn = CT0 + ((ci + 1) & 1) * 112 * QSTR;
        const float bcs = wave_scan_incl(L.lf);
        const float qsc = __expf(bcs), ksc = __expf(L.ig - bcs);
        const float bL = rdlane(bcs, 63), ebL = __expf(bL);
        for (int rep_ = 0; rep_ < (PROBE_ML == 1 ? 2 : 1); ++rep_)
        if (hasqk) {
            const float ks_t = __shfl(ksc, qk_tok), qs_t = __shfl(qsc, qk_tok);
            float cs[8], sn[8];
            if (!jb.isctx) { const int t = tok_of(ci, qk_tok); const int pos = qk_part ? (t & 63) : (t >> 6);
#pragma unroll
                for (int e = 0; e < 8; ++e) { const f32x2 v = ROPE[pos * 24 + 8 * qk_pp + e]; cs[e] = v[0]; sn[e] = v[1]; } }
            else {
#pragma unroll
                for (int e = 0; e < 8; ++e) { cs[e] = 1.f; sn[e] = 0.f; } }
            float a[8], b2[8], o0[8], o1[8];
            unpack8(L.k0, a); unpack8(L.k1, b2);
#pragma unroll
            for (int e = 0; e < 8; ++e) { o0[e] = (a[e] * cs[e] - b2[e] * sn[e]) * ks_t; o1[e] = (b2[e] * cs[e] + a[e] * sn[e]) * ks_t; }
            *(LAS v4u*)(KS + qk_tok * QSTR + qk_d0) = pack8(o0); *(LAS v4u*)(KS + qk_tok * QSTR + qk_d0 + 24) = pack8(o1);
            if (mode != 0) {
                unpack8(L.q0, a); unpack8(L.q1, b2);
#pragma unroll
                for (int e = 0; e < 8; ++e) { o0[e] = (a[e] * cs[e] - b2[e] * sn[e]) * qs_t; o1[e] = (b2[e] * cs[e] + a[e] * sn[e]) * qs_t; }
                *(LAS v4u*)(QS + qk_tok * QSTR + qk_d0) = pack8(o0); *(LAS v4u*)(QS + qk_tok * QSTR + qk_d0 + 24) = pack8(o1);
            }
        } else { (void)__shfl(ksc, 0); (void)__shfl(qsc, 0); }
        *(LAS v4u*)(VS + v1_tok * VSTR + 8 * v1_pc) = L.v1;
        if (hasv2) *(LAS v4u*)(VS + v2_tok * VSTR + 8 * v2_pc) = L.v2;
        if (mode == 2 && ci > 0) { finalize(ci - 1); if (PROBE_ML == 4) finalize(ci - 1); }
        if (ci + 2 < jb.nchunk) issue_loads(L, ci + 2);
        if (tsel) { TS_STOP(F, 11); TS_START(F, 12); }
        __syncthreads();
        if (tsel) { TS_STOP(F, 12); TS_START(F, 13); }
        for (int rep_ = 0; rep_ < (PROBE_ML == 2 ? 2 : 1); ++rep_)
        if (mode != 0) {
            const int tt = w & 3, jh = w >> 2;
            bf16x8 qf[3], kf[4][3];
#pragma unroll
            for (int ks = 0; ks < 3; ++ks) qf[ks] = rm_frag(QS, QSTR, 16 * tt + c, 32 * ks + 8 * g);
#pragma unroll
            for (int ss = 0; ss < 4; ++ss) if (ss <= tt) {
#pragma unroll
                for (int ks = 0; ks < 3; ++ks) kf[ss][ks] = rm_frag(KS, QSTR, 16 * ss + c, 32 * ks + 8 * g); }
            LDS_FENCE();
            f32x4 st[4];
#pragma unroll
            for (int ss = 0; ss < 4; ++ss) { st[ss] = (f32x4){0.f, 0.f, 0.f, 0.f};
                if (ss <= tt) {
#pragma unroll
                    for (int ks = 0; ks < 3; ++ks) st[ss] = mfma16(kf[ss][ks], qf[ks], st[ss]);
                    if (ss == tt) {
#pragma unroll
                        for (int r = 0; r < 4; ++r) if (4 * g + r > c) st[ss][r] = 0.f; }
                } }
            bf16x8 pf[2];
#pragma unroll
            for (int kk = 0; kk < 2; ++kk) { const unsigned u0 = pk2(st[2 * kk][0], st[2 * kk][1]), u1 = pk2(st[2 * kk][2], st[2 * kk][3]), u2 = pk2(st[2 * kk + 1][0], st[2 * kk + 1][1]), u3 = pk2(st[2 * kk + 1][2], st[2 * kk + 1][3]);
                pf[kk] = __builtin_bit_cast(bf16x8, (v4u){u0, u1, u2, u3}); }
#pragma unroll
            for (int eb = 0; eb < 4; eb += 2) {
                bf16x8 vf[2][2], cf[2][3];
#pragma unroll
                for (int e2 = 0; e2 < 2; ++e2) { const int et = 4 * jh + eb + e2;
                    if (et < 7) {
#pragma unroll
                        for (int kk = 0; kk < 2; ++kk) if (2 * kk <= tt) vf[e2][kk] = tr_frag(VS, VSTR, 32 * kk + 4 * g, 32 * kk + 16 + 4 * g, 16 * et, lane);
#pragma unroll
                        for (int ks = 0; ks < 3; ++ks) cf[e2][ks] = rm_frag(CTc, QSTR, 16 * et + c, 32 * ks + 8 * g); } }
                LDS_FENCE();
#pragma unroll
                for (int e2 = 0; e2 < 2; ++e2) { const int et = 4 * jh + eb + e2;
                    if (et < 7) {
                        f32x4 acc = (f32x4){0.f, 0.f, 0.f, 0.f};
#pragma unroll
                        for (int kk = 0; kk < 2; ++kk) if (2 * kk <= tt) acc = mfma16(vf[e2][kk], pf[kk], acc);
#pragma unroll
                        for (int ks = 0; ks < 3; ++ks) acc = mfma16(cf[e2][ks], qf[ks], acc);
                        if (et < 6) *(LAS f32x4*)(HT + (16 * tt + c) * 100 + 16 * et + 4 * g) = acc;
                        else if (g == 0) DEN[16 * tt + c] = acc[0];
                    } }
            }
        }
        if (w < 6) {
#pragma unroll
            for (int kk = 0; kk < 2; ++kk) {
                bf16x8 vf[7]; const bf16x8 af = tr_frag(KS, QSTR, 32 * kk + 8 * g, 32 * kk + 8 * g + 4, 16 * w, lane);
#pragma unroll
                for (int et = 0; et < 7; ++et) vf[et] = tr_frag(VS, VSTR, 32 * kk + 8 * g, 32 * kk + 8 * g + 4, 16 * et, lane);
                LDS_FENCE();
#pragma unroll
                for (int et = 0; et < 7; ++et) Cst[et] = mfma16(af, vf[et], Cst[et]);
            }
#pragma unroll
            for (int et = 0; et < 7; ++et) { Cst[et] = Cst[et] * ebL;
                if (mode != 0) { v2u v; v.x = pk2(Cst[et][0], Cst[et][1]); v.y = pk2(Cst[et][2], Cst[et][3]); *(LAS v2u*)(CTn + (16 * et + c) * QSTR + 16 * w + 4 * g) = v; } }
        }
        Btot += bL;
        if (PROBE_ML == 3) { __syncthreads(); __syncthreads(); }
        if (tsel) { TS_STOP(F, 13); TS_START(F, 14); }
        __syncthreads();
        if (tsel) { TS_STOP(F, 14); TS_START(F, 15); }
        if (mode == 1) { finalize(ci); if (PROBE_ML == 4) finalize(ci); } else if (mode == 2) issue_fin(ci);
        if (tsel) TS_STOP(F, 15);
    };
    for (int ci = 0; ci < jb.nchunk; ci += 2) { chunk_step(LA, ci); chunk_step(LB, ci + 1); }
    if (mode == 2) finalize(jb.nchunk - 1);
    if (emit_slot >= 0 && w < 6) {
        float* sl = STd + (size_t)emit_slot * ST_FLOATS;
#pragma unroll
        for (int et = 0; et < 7; ++et) *(f32x4*)(sl + ((w * 7 + et) * 64 + lane) * 4) = Cst[et];
        if (w == 0 && lane == 0) sl[96 * 112] = Btot;
    }
    __syncthreads();
}
__device__ __forceinline__ void mlstm_load_rope(const Ctx& F, const float* rope_tab) {
    LAS f32x2* ROPE = (LAS f32x2*)(F.lds + ml::OFF_ROPE);
    for (int i = F.tid; i < 64 * 24; i += 512) ROPE[i] = ((const f32x2*)rope_tab)[i];
}
__device__ __forceinline__ void mlstm_itemA(const Ctx& F, int l, int bh, int it, bf16* otmp, float* ST) {
    const int b = bh >> 2, h = bh & 3;
    if (it == 0) {
        const MlJob jb{b, h, 1, 0, 4};
        mlstm_dir(F, l, jb, 0, -1, 0, l == 0 ? 1 : 0, otmp, ST);
        mlstm_dir(F, l, jb, 1, -1, 0, l == 0 ? 2 : 0, otmp, ST);
    } else {
        const int dir = (it - 1) / (NSEG - 1), k = (it - 1) % (NSEG - 1), seg = dir == 0 ? k : NSEG - 1 - k;
        const MlJob jb{b, h, 0, SEGTOK * seg, SEGCH};
        mlstm_dir(F, l, jb, dir, -1, 1 + k, 0, otmp, ST);
    }
}
__device__ __forceinline__ void mlstm_itemC(const Ctx& F, int l, int bh, int seg, bf16* otmp, float* ST) {
    const MlJob jb{bh >> 2, bh & 3, 0, SEGTOK * seg, SEGCH};
    mlstm_dir(F, l, jb, 0, seg, -1, 1, otmp, ST);
    mlstm_dir(F, l, jb, 1, NSEG - 1 - seg, -1, 2, otmp, ST);
}

namespace hg {
constexpr int STR = 72;
constexpr int IMG = 64 * STR * 2;
constexpr int OFF_KO = 0, OFF_KH = IMG, OFF_VS = 2 * IMG, OFF_QJ = 3 * IMG, OFF_ST = 7 * IMG, OFF_HT = 9 * IMG, OFF_TOT = OFF_HT + 64 * 68 * 4, OFF_BL = OFF_TOT + 8 * 64 * 4, OFF_END = OFF_BL + 512;
static_assert(OFF_END <= RING_BYTES, "hgrn LDS");
constexpr int ST_FLOATS = 64 * 64 + 64;
}
__device__ __forceinline__ void hgrn_dir(const Ctx& F, int l, const MlJob jb, int dir, int fold_r, int emit_slot, int mode, bf16* otmp, float* ST) {
    using namespace hg;
    int tid_ = F.tid; asm volatile("" : "+v"(tid_));
    const int tid = tid_, lane = tid & 63, w = __builtin_amdgcn_readfirstlane(tid >> 6), g = lane >> 4, c = lane & 15;
    LAS bf16* KO = (LAS bf16*)(F.lds + OFF_KO); LAS bf16* KH = (LAS bf16*)(F.lds + OFF_KH); LAS bf16* VS = (LAS bf16*)(F.lds + OFF_VS); LAS bf16* QJ = (LAS bf16*)(F.lds + OFF_QJ);
    LAS bf16* ST0 = (LAS bf16*)(F.lds + OFF_ST); LAS float* HT = (LAS float*)(F.lds + OFF_HT); LAS float* TOT = (LAS float*)(F.lds + OFF_TOT); LAS float* BL = (LAS float*)(F.lds + OFF_BL);
    const int rowbase = jb.isctx ? MX + jb.b * CTX : jb.b * S;
    const int h = jb.h; const bf16* P = F.P;
    float* STd = ST + (size_t)(((jb.b * 4 + h) * 2 + dir) * 8) * ST_FLOATS;
    const int dt = w >> 1, et0 = 2 * (w & 1);
    f32x4 Sst[2]; float Btot[4];
#pragma unroll
    for (int i = 0; i < 2; ++i) Sst[i] = (f32x4){0.f, 0.f, 0.f, 0.f};
#pragma unroll
    for (int r = 0; r < 4; ++r) Btot[r] = 0.f;
    if (fold_r >= 0) {
        f32x4 v[8][2], dk[8];
#pragma unroll
        for (int k = 0; k < NSEG; ++k) { const float* sl = STd + (size_t)k * ST_FLOATS; v[k][0] = *(const f32x4*)(sl + ((w * 2 + 0) * 64 + lane) * 4); v[k][1] = *(const f32x4*)(sl + ((w * 2 + 1) * 64 + lane) * 4);
            dk[k] = *(const f32x4*)(sl + 64 * 64 + 16 * dt + 4 * g); }
        f32x4 run = (f32x4){1.f, 1.f, 1.f, 1.f};
#pragma unroll
        for (int k = NSEG - 1; k >= 0; --k) { const float on = (k <= fold_r) ? 1.f : 0.f; Sst[0] += v[k][0] * (run * on); Sst[1] += v[k][1] * (run * on);
            if (k >= 1) { const bool use = k <= fold_r; run[0] *= use ? __expf(dk[k][0]) : 1.f; run[1] *= use ? __expf(dk[k][1]) : 1.f; run[2] *= use ? __expf(dk[k][2]) : 1.f; run[3] *= use ? __expf(dk[k][3]) : 1.f; } }
    }
    if (mode != 0) {
#pragma unroll
        for (int i = 0; i < 2; ++i) { v2u v; v.x = pk2(Sst[i][0], Sst[i][1]); v.y = pk2(Sst[i][2], Sst[i][3]); *(LAS v2u*)(ST0 + (16 * (et0 + i) + c) * STR + 16 * dt + 4 * g) = v; }
    }
    const int ps = tid >> 3, oct = tid & 7, d0 = 8 * oct;
    float lbv[8];
#pragma unroll
    for (int e = 0; e < 8; ++e) { lbv[e] = 0.f;
        if (l == 1) { const float v0 = F.hgrn_lb[(0 * 2 + dir) * 256 + h * 64 + d0 + e], v1 = F.hgrn_lb[(1 * 2 + dir) * 256 + h * 64 + d0 + e]; lbv[e] = 1.f / (1.f + expf(v0 - v1)); } }
    const int fcol = dir ? A_FB : A_FF;
    auto tok_of = [&](int ci, int i) -> int { return dir == 0 ? jb.t0 + 64 * ci + i : jb.t0 + 64 * (jb.nchunk - 1 - ci) + (63 - i); };
    v4u rq, rf, rv; rq = rf = rv = (v4u){0u, 0u, 0u, 0u};
    v4u ft = (v4u){0u, 0u, 0u, 0u}, fz = (v4u){0u, 0u, 0u, 0u};
    const int fi_i = tid >> 3, fi_e0 = 8 * (tid & 7);
    float gnv[8];
#pragma unroll
    for (int e = 0; e < 8; ++e) gnv[e] = (mode == 2) ? F.hgrn_gn[l * 256 + h * 64 + fi_e0 + e] : 0.f;
    auto issue_loads = [&](int ci) {
        const bf16* pr = P + (size_t)(rowbase + tok_of(ci, ps)) * PLD + h * 64 + d0;
        if (mode != 0) rq = *(const v4u*)(pr + A_Q);
        rf = *(const v4u*)(pr + fcol); rv = *(const v4u*)(pr + A_I);
    };
    auto issue_fin = [&](int ci) { const int m = rowbase + tok_of(ci, fi_i); ft = *(const v4u*)(otmp + (size_t)m * 256 + h * 64 + fi_e0); fz = *(const v4u*)(P + (size_t)m * PLD + A_Z + h * 64 + fi_e0); };
    issue_loads(0);
    __syncthreads();
    for (int ci = 0; ci < jb.nchunk; ++ci) {
        LAS bf16* STc = ST0 + (ci & 1) * 64 * STR; LAS bf16* STn = ST0 + ((ci + 1) & 1) * 64 * STR;
        float qv[8], kk[8], bb[8], fl[8];
        unpack8(rf, fl);
#pragma unroll
        for (int e = 0; e < 8; ++e) { const float sg = sigmoid_f(fl[e]); const float f = lbv[e] + (1.f - lbv[e]) * sg; bb[e] = __logf(f); kk[e] = (1.f - lbv[e]) * (1.f - sg); }
        if (mode != 0) unpack8(rq, qv);
        const v4u vraw = rv;
        if (ci + 1 < jb.nchunk) issue_loads(ci + 1);
        if (mode == 2) issue_fin(ci);
#pragma unroll
        for (int o = 8; o < 64; o <<= 1) {
#pragma unroll
            for (int e = 0; e < 8; ++e) { const float t = __shfl_up(bb[e], o); if (lane >= o) bb[e] += t; } }
        if (lane >= 56) { *(LAS f32x4*)(TOT + w * 64 + d0) = (f32x4){bb[0], bb[1], bb[2], bb[3]}; *(LAS f32x4*)(TOT + w * 64 + d0 + 4) = (f32x4){bb[4], bb[5], bb[6], bb[7]}; }
        __syncthreads();
        {
            float run[8], pre[8], ref1[8], ref2[8], ref3[8];
#pragma unroll
            for (int e = 0; e < 8; ++e) { run[e] = 0.f; pre[e] = 0.f; ref1[e] = ref2[e] = ref3[e] = 0.f; }
#pragma unroll
            for (int ww = 0; ww < 8; ++ww) {
                if (ww == w) {
#pragma unroll
                    for (int e = 0; e < 8; ++e) pre[e] = run[e]; }
                if (ww == 2) {
#pragma unroll
                    for (int e = 0; e < 8; ++e) ref1[e] = run[e]; }
                if (ww == 4) {
#pragma unroll
                    for (int e = 0; e < 8; ++e) ref2[e] = run[e]; }
                if (ww == 6) {
#pragma unroll
                    for (int e = 0; e < 8; ++e) ref3[e] = run[e]; }
                const f32x4 t0 = *(const LAS f32x4*)(TOT + ww * 64 + d0), t1 = *(const LAS f32x4*)(TOT + ww * 64 + d0 + 4);
                run[0] += t0[0]; run[1] += t0[1]; run[2] += t0[2]; run[3] += t0[3]; run[4] += t1[0]; run[5] += t1[1]; run[6] += t1[2]; run[7] += t1[3];
            }
            const int sub = ps >> 4;
            float o8[8];
#pragma unroll
            for (int e = 0; e < 8; ++e) bb[e] += pre[e];
#pragma unroll
            for (int e = 0; e < 8; ++e) { const float rown = sub == 0 ? 0.f : (sub == 1 ? ref1[e] : (sub == 2 ? ref2[e] : ref3[e])); o8[e] = kk[e] * __expf(rown - bb[e]); }
            if (mode != 0) *(LAS v4u*)(KO + ps * STR + d0) = pack8(o8);
#pragma unroll
            for (int e = 0; e < 8; ++e) o8[e] = kk[e] * __expf(run[e] - bb[e]);
            *(LAS v4u*)(KH + ps * STR + d0) = pack8(o8);
            *(LAS v4u*)(VS + ps * STR + d0) = vraw;
            if (mode != 0) {
#pragma unroll
                for (int e = 0; e < 8; ++e) o8[e] = qv[e] * __expf(bb[e]);
                *(LAS v4u*)(QJ + ps * STR + d0) = pack8(o8);
                if (sub >= 1) {
#pragma unroll
                    for (int e = 0; e < 8; ++e) o8[e] = qv[e] * __expf(bb[e] - ref1[e]);
                    *(LAS v4u*)(QJ + (64 + ps) * STR + d0) = pack8(o8); }
                if (sub >= 2) {
#pragma unroll
                    for (int e = 0; e < 8; ++e) o8[e] = qv[e] * __expf(bb[e] - ref2[e]);
                    *(LAS v4u*)(QJ + (128 + ps) * STR + d0) = pack8(o8); }
                if (sub >= 3) {
#pragma unroll
                    for (int e = 0; e < 8; ++e) o8[e] = qv[e] * __expf(bb[e] - ref3[e]);
                    *(LAS v4u*)(QJ + (192 + ps) * STR + d0) = pack8(o8); }
            }
            if (ps == 0) { *(LAS f32x4*)(BL + d0) = (f32x4){run[0], run[1], run[2], run[3]}; *(LAS f32x4*)(BL + d0 + 4) = (f32x4){run[4], run[5], run[6], run[7]}; }
        }
        __syncthreads();
        if (mode != 0) {
            const int tt = w & 3, eh = w >> 2;
            f32x4 at[4];
            { bf16x8 kf[4][2], qjf[4][2];
#pragma unroll
              for (int j = 0; j < 4; ++j) if (j <= tt) {
#pragma unroll
                  for (int ks = 0; ks < 2; ++ks) { kf[j][ks] = rm_frag(KO, STR, 16 * j + c, 32 * ks + 8 * g); qjf[j][ks] = rm_frag(QJ + j * 64 * STR, STR, 16 * tt + c, 32 * ks + 8 * g); } }
              LDS_FENCE();
#pragma unroll
              for (int j = 0; j < 4; ++j) { at[j] = (f32x4){0.f, 0.f, 0.f, 0.f};
                  if (j <= tt) {
#pragma unroll
                      for (int ks = 0; ks < 2; ++ks) at[j] = mfma16(kf[j][ks], qjf[j][ks], at[j]);
                      if (j == tt) {
#pragma unroll
                          for (int r = 0; r < 4; ++r) if (4 * g + r > c) at[j][r] = 0.f; }
                  } } }
            bf16x8 pf[2];
#pragma unroll
            for (int k2 = 0; k2 < 2; ++k2) { const unsigned u0 = pk2(at[2 * k2][0], at[2 * k2][1]), u1 = pk2(at[2 * k2][2], at[2 * k2][3]), u2 = pk2(at[2 * k2 + 1][0], at[2 * k2 + 1][1]), u3 = pk2(at[2 * k2 + 1][2], at[2 * k2 + 1][3]);
                pf[k2] = __builtin_bit_cast(bf16x8, (v4u){u0, u1, u2, u3}); }
            { bf16x8 qf[2], vf[2][2], sf[2][2];
#pragma unroll
              for (int ks = 0; ks < 2; ++ks) qf[ks] = rm_frag(QJ, STR, 16 * tt + c, 32 * ks + 8 * g);
#pragma unroll
              for (int ei = 0; ei < 2; ++ei) { const int et = 2 * eh + ei;
#pragma unroll
                  for (int k2 = 0; k2 < 2; ++k2) if (2 * k2 <= tt) vf[ei][k2] = tr_frag(VS, STR, 32 * k2 + 4 * g, 32 * k2 + 16 + 4 * g, 16 * et, lane);
#pragma unroll
                  for (int ks = 0; ks < 2; ++ks) sf[ei][ks] = rm_frag(STc, STR, 16 * et + c, 32 * ks + 8 * g); }
              LDS_FENCE();
#pragma unroll
              for (int ei = 0; ei < 2; ++ei) { const int et = 2 * eh + ei;
                  f32x4 acc = (f32x4){0.f, 0.f, 0.f, 0.f};
#pragma unroll
                  for (int k2 = 0; k2 < 2; ++k2) if (2 * k2 <= tt) acc = mfma16(vf[ei][k2], pf[k2], acc);
#pragma unroll
                  for (int ks = 0; ks < 2; ++ks) acc = mfma16(sf[ei][ks], qf[ks], acc);
                  *(LAS f32x4*)(HT + (16 * tt + c) * 68 + 16 * et + 4 * g) = acc; } }
        }
        {
            const f32x4 blv = *(const LAS f32x4*)(BL + 16 * dt + 4 * g);
#pragma unroll
            for (int r = 0; r < 4; ++r) { const float dec = __expf(blv[r]); Sst[0][r] *= dec; Sst[1][r] *= dec; Btot[r] += blv[r]; }
            { bf16x8 af[2], vf[2][2];
#pragma unroll
              for (int k2 = 0; k2 < 2; ++k2) { af[k2] = tr_frag(KH, STR, 32 * k2 + 8 * g, 32 * k2 + 8 * g + 4, 16 * dt, lane);
#pragma unroll
                  for (int i = 0; i < 2; ++i) vf[k2][i] = tr_frag(VS, STR, 32 * k2 + 8 * g, 32 * k2 + 8 * g + 4, 16 * (et0 + i), lane); }
              LDS_FENCE();
#pragma unroll
              for (int k2 = 0; k2 < 2; ++k2)
#pragma unroll
                  for (int i = 0; i < 2; ++i) Sst[i] = mfma16(af[k2], vf[k2][i], Sst[i]); }
            if (mode != 0) {
#pragma unroll
                for (int i = 0; i < 2; ++i) { v2u v; v.x = pk2(Sst[i][0], Sst[i][1]); v.y = pk2(Sst[i][2], Sst[i][3]); *(LAS v2u*)(STn + (16 * (et0 + i) + c) * STR + 16 * dt + 4 * g) = v; } }
        }
        __syncthreads();
        if (mode != 0) {
            const int i = tid >> 3, sub8 = tid & 7, e0 = 8 * sub8; const int m = rowbase + tok_of(ci, i);
            float hv[8];
            { const f32x4 a0 = *(const LAS f32x4*)(HT + i * 68 + e0), a1 = *(const LAS f32x4*)(HT + i * 68 + e0 + 4); hv[0] = a0[0]; hv[1] = a0[1]; hv[2] = a0[2]; hv[3] = a0[3]; hv[4] = a1[0]; hv[5] = a1[1]; hv[6] = a1[2]; hv[7] = a1[3]; }
            bf16* tp = otmp + (size_t)m * 256 + h * 64 + e0;
            if (mode == 1) *(v4u*)tp = pack8(hv);
            else {
                float tv[8]; unpack8(ft, tv);
                float ss = 0.f;
#pragma unroll
                for (int e = 0; e < 8; ++e) { hv[e] += tv[e]; ss += hv[e] * hv[e]; }
                ss += __shfl_xor(ss, 1); ss += __shfl_xor(ss, 2); ss += __shfl_xor(ss, 4);
                const float rinv = 1.f / sqrtf(ss * (1.f / 64.f) + EPS);
                float zv[8]; unpack8(fz, zv);
#pragma unroll
                for (int e = 0; e < 8; ++e) hv[e] = hv[e] * rinv * gnv[e] * zv[e];
                *(v4u*)(F.hxy + (size_t)m * 1024 + h * 64 + e0) = pack8(hv);
            }
        }
    }
    if (emit_slot >= 0) {
        float* sl = STd + (size_t)emit_slot * ST_FLOATS;
        *(f32x4*)(sl + ((w * 2 + 0) * 64 + lane) * 4) = Sst[0]; *(f32x4*)(sl + ((w * 2 + 1) * 64 + lane) * 4) = Sst[1];
        if ((w & 1) == 0 && c == 0) *(f32x4*)(sl + 64 * 64 + 16 * dt + 4 * g) = (f32x4){Btot[0], Btot[1], Btot[2], Btot[3]};
    }
    __syncthreads();
}
__device__ __forceinline__ void hgrn_itemA(const Ctx& F, int l, int bh, int it, bf16* otmp, float* ST) {
    const int b = bh >> 2, h = bh & 3;
    if (it == 0) {
        const MlJob jb{b, h, 1, 0, 4};
        hgrn_dir(F, l, jb, 0, -1, 0, l == 0 ? 1 : 0, otmp, ST);
        hgrn_dir(F, l, jb, 1, -1, 0, l == 0 ? 2 : 0, otmp, ST);
    } else {
        const int dir = (it - 1) / (NSEG - 1), k = (it - 1) % (NSEG - 1), seg = dir == 0 ? k : NSEG - 1 - k;
        const MlJob jb{b, h, 0, SEGTOK * seg, SEGCH};
        hgrn_dir(F, l, jb, dir, -1, 1 + k, 0, otmp, ST);
    }
}
__device__ __forceinline__ void hgrn_itemC(const Ctx& F, int l, int bh, int seg, bf16* otmp, float* ST) {
    const MlJob jb{bh >> 2, bh & 3, 0, SEGTOK * seg, SEGCH};
    hgrn_dir(F, l, jb, 0, seg, -1, 1, otmp, ST);
    hgrn_dir(F, l, jb, 1, NSEG - 1 - seg, -1, 2, otmp, ST);
}

namespace nat {
constexpr int STR = 72, IMG = 64 * STR * 2;
constexpr int OFF_K = 0, OFF_V = 2 * IMG, OFF_RPB = 4 * IMG, OFF_END = OFF_RPB + 2048;
static_assert(OFF_END <= RING_BYTES, "na LDS");
}
template <int CH, bool WIN>
__device__ __forceinline__ void na_block(const LAS bf16* Kc, const LAS bf16* Vc, const LAS float* RPB, const bf16x8 (&qf)[2][2], f32x4 (&oacc)[2][4], float (&mrun)[2], float (&lrun)[2],
                                         const int g, const int c, const int lane, const int dr, const int (&qcol)[2], const int (&csq)[2]) {
    constexpr int STR = nat::STR;
    constexpr int KLO[2] = {WIN ? (CH == 0 ? 0 : 1) : 0, WIN ? (CH == 0 ? 0 : 2) : 0}, KHI[2] = {WIN ? (CH == 0 ? 1 : 3) : 3, WIN ? (CH == 0 ? 2 : 3) : 3};
    constexpr int ULO = KLO[0] < KLO[1] ? KLO[0] : KLO[1], UHI = KHI[0] > KHI[1] ? KHI[0] : KHI[1];
    f32x4 st[2][4];
    { bf16x8 kf[4][2];
#pragma unroll
      for (int kt = ULO; kt <= UHI; ++kt)
#pragma unroll
          for (int ks = 0; ks < 2; ++ks) kf[kt][ks] = rm_frag(Kc, STR, 16 * kt + c, 32 * ks + 8 * g);
      LDS_FENCE();
#pragma unroll
      for (int qt = 0; qt < 2; ++qt)
#pragma unroll
          for (int kt = 0; kt < 4; ++kt) { st[qt][kt] = (f32x4){0.f, 0.f, 0.f, 0.f};
              if (kt >= KLO[qt] && kt <= KHI[qt]) {
#pragma unroll
                  for (int ks = 0; ks < 2; ++ks) st[qt][kt] = mfma16(kf[kt][ks], qf[qt][ks], st[qt][kt]); } } }
    if (WIN) {
#pragma unroll
        for (int qt = 0; qt < 2; ++qt) { const int boff = dr * 31 + 15 - qcol[qt];
#pragma unroll
            for (int kt = KLO[qt]; kt <= KHI[qt]; ++kt)
#pragma unroll
                for (int r = 0; r < 4; ++r) { const int kc = 16 * kt + 4 * g + r; const float bias = RPB[min(max(boff + kc, 0), 464)]; const float v = st[qt][kt][r] + bias; st[qt][kt][r] = ((unsigned)(kc - csq[qt]) < 16u) ? v : -1e30f; } }
    }
    float alpha[2]; bf16x8 pf[2][2];
#pragma unroll
    for (int qt = 0; qt < 2; ++qt) {
        float bm = -1e30f;
#pragma unroll
        for (int kt = KLO[qt]; kt <= KHI[qt]; ++kt)
#pragma unroll
            for (int r = 0; r < 4; ++r) bm = fmaxf(bm, st[qt][kt][r]);
        bm = xor32_max(xor16_max(bm));
        const float mnew = fmaxf(mrun[qt], bm); alpha[qt] = __builtin_amdgcn_exp2f(mrun[qt] - mnew); mrun[qt] = mnew;
        float ps = 0.f;
#pragma unroll
        for (int kt = KLO[qt]; kt <= KHI[qt]; ++kt)
#pragma unroll
            for (int r = 0; r < 4; ++r) { const float p = __builtin_amdgcn_exp2f(st[qt][kt][r] - mnew); st[qt][kt][r] = p; ps += p; }
        lrun[qt] = lrun[qt] * alpha[qt] + ps;
#pragma unroll
        for (int k2 = 0; k2 < 2; ++k2) { const unsigned u0 = pk2(st[qt][2 * k2][0], st[qt][2 * k2][1]), u1 = pk2(st[qt][2 * k2][2], st[qt][2 * k2][3]), u2 = pk2(st[qt][2 * k2 + 1][0], st[qt][2 * k2 + 1][1]), u3 = pk2(st[qt][2 * k2 + 1][2], st[qt][2 * k2 + 1][3]);
            pf[qt][k2] = __builtin_bit_cast(bf16x8, (v4u){u0, u1, u2, u3}); }
    }
    { bf16x8 vf[4][2];
#pragma unroll
      for (int dtl = 0; dtl < 4; ++dtl)
#pragma unroll
          for (int k2 = ULO / 2; k2 <= UHI / 2; ++k2) vf[dtl][k2] = tr_frag(Vc, STR, 32 * k2 + 4 * g, 32 * k2 + 16 + 4 * g, 16 * dtl, lane);
      LDS_FENCE();
#pragma unroll
      for (int qt = 0; qt < 2; ++qt)
#pragma unroll
          for (int dtl = 0; dtl < 4; ++dtl) { f32x4 a = oacc[qt][dtl] * alpha[qt];
#pragma unroll
              for (int k2 = KLO[qt] / 2; k2 <= KHI[qt] / 2; ++k2) a = mfma16(vf[dtl][k2], pf[qt][k2], a);
              oacc[qt][dtl] = a; } }
}
__device__ __forceinline__ void na_item(const Ctx& F, int l, int b, int h, int R0) {
    using namespace nat;
    int tid_ = F.tid; asm volatile("" : "+v"(tid_));
    const int tid = tid_, lane = tid & 63, w = __builtin_amdgcn_readfirstlane(tid >> 6), g = lane >> 4, c = lane & 15;
    LAS bf16* KT = (LAS bf16*)(F.lds + OFF_K); LAS bf16* VT = (LAS bf16*)(F.lds + OFF_V); LAS float* RPB = (LAS float*)(F.lds + OFF_RPB);
    const bf16* P = F.P; const bool lat = R0 >= 0;
    const int R = R0 + (w >> 1), ch = w & 1;
    const int rsR = min(max(R - 4, 0), 56);
    const int kr0 = lat ? min(max(R0 - 4, 0), 56) : 0;
    const int nwin = lat ? (min(max(R0 + 3 - 4, 0), 56) + 8 - kr0) : 0, nblk = nwin + 4;
    if (lat) for (int i = tid; i < 15 * 31; i += 512) RPB[i] = F.na_rpb[((size_t)l * 6 + h) * 465 + i] * 1.4426950408889634f;
    int mq[2]; bf16x8 qf[2][2]; int csq[2], qcol[2];
#pragma unroll
    for (int qt = 0; qt < 2; ++qt) {
        if (lat) { qcol[qt] = 32 * ch + 16 * qt + c; mq[qt] = b * S + R * 64 + qcol[qt]; } else { qcol[qt] = 0; mq[qt] = MX + b * CTX + 32 * w + 16 * qt + c; }
        csq[qt] = min(max(qcol[qt] - 8, 0), 48);
#pragma unroll
        for (int ks = 0; ks < 2; ++ks) qf[qt][ks] = *(const bf16x8*)(P + (size_t)mq[qt] * PLD + C_Q + h * 64 + 32 * ks + 8 * g);
    }
    f32x4 oacc[2][4]; float mrun[2], lrun[2];
#pragma unroll
    for (int qt = 0; qt < 2; ++qt) { mrun[qt] = -1e30f; lrun[qt] = 0.f;
#pragma unroll
        for (int dtl = 0; dtl < 4; ++dtl) oacc[qt][dtl] = (f32x4){0.f, 0.f, 0.f, 0.f}; }
    const int stok = tid >> 3, spc = tid & 7;
    auto blk_row = [&](int i) -> int { return i < nwin ? b * S + (kr0 + i) * 64 + stok : MX + b * CTX + 64 * (i - nwin) + stok; };
    v4u rk0, rv0, rk1, rv1, rk2, rv2;
    auto ld = [&](int i, v4u& k_, v4u& v_) { const int ii = i < nblk ? i : nblk - 1; const bf16* pr = P + (size_t)blk_row(ii) * PLD + h * 64 + 8 * spc; k_ = *(const v4u*)(pr + C_K); v_ = *(const v4u*)(pr + C_V); };
    ld(0, rk0, rv0); ld(1, rk1, rv1); ld(2, rk2, rv2);
    __syncthreads();
    *(LAS v4u*)(KT + stok * STR + 8 * spc) = rk0; *(LAS v4u*)(VT + stok * STR + 8 * spc) = rv0;
    ld(3, rk0, rv0);
    __syncthreads();
    auto step = [&](int i, v4u& kn, v4u& vn) {
        const LAS bf16* Kc = KT + (i & 1) * 64 * STR; const LAS bf16* Vc = VT + (i & 1) * 64 * STR;
        if (i + 1 < nblk) { LAS bf16* Kn = KT + ((i + 1) & 1) * 64 * STR; LAS bf16* Vn = VT + ((i + 1) & 1) * 64 * STR;
            *(LAS v4u*)(Kn + stok * STR + 8 * spc) = kn; *(LAS v4u*)(Vn + stok * STR + 8 * spc) = vn;
            if (i + 4 < nblk) ld(i + 4, kn, vn); }
        const bool win = i < nwin; const int kr = kr0 + i;
        const bool active = !win || (kr >= rsR && kr < rsR + 8);
        if (active) {
            if (!win) na_block<0, false>(Kc, Vc, RPB, qf, oacc, mrun, lrun, g, c, lane, 0, qcol, csq);
            else if (ch == 0) na_block<0, true>(Kc, Vc, RPB, qf, oacc, mrun, lrun, g, c, lane, kr - R + 7, qcol, csq);
            else na_block<1, true>(Kc, Vc, RPB, qf, oacc, mrun, lrun, g, c, lane, kr - R + 7, qcol, csq);
        }
        __syncthreads();
    };
    for (int i = 0; i < nblk; i += 3) { step(i, rk1, rv1); if (i + 1 < nblk) step(i + 1, rk2, rv2); if (i + 2 < nblk) step(i + 2, rk0, rv0); }
#pragma unroll
    for (int qt = 0; qt < 2; ++qt) {
        const float lt = xor32_sum(xor16_sum(lrun[qt]));
        const float rl = 1.f / lt;
        const bf16* zr = P + (size_t)mq[qt] * PLD + C_Z + h * 64; bf16* yr = F.hxy + (size_t)mq[qt] * 1024 + 640 + h * 64;
#pragma unroll
        for (int dtl = 0; dtl < 4; ++dtl) { const int d = 16 * dtl + 4 * g; const v2u zv = *(const v2u*)(zr + d);
            const float z0 = __uint_as_float(zv.x << 16), z1 = __uint_as_float(zv.x & 0xffff0000u), z2 = __uint_as_float(zv.y << 16), z3 = __uint_as_float(zv.y & 0xffff0000u);
            v2u o; o.x = pk2(oacc[qt][dtl][0] * rl * z0, oacc[qt][dtl][1] * rl * z1); o.y = pk2(oacc[qt][dtl][2] * rl * z2, oacc[qt][dtl][3] * rl * z3);
            *(v2u*)(yr + d) = o; }
    }
}

__device__ __forceinline__ void phase_mixA(const Ctx& F, int l, unsigned* ticket) {
    mlstm_load_rope(F, F.rope);
    volatile LAS unsigned* slot = (volatile LAS unsigned*)(F.lds + MISC_OFF) + 16;
    const int n_ctx = 64, n_na = 768, n_loc = 2 * 32 * 2 * (NSEG - 1), n_nactx = (l == 0) ? 48 : 0, n_all = n_ctx + n_na + n_loc + n_nactx;
    unsigned cur = 0;
    if (F.tid == 0) *slot = __hip_atomic_fetch_add(ticket, 1u, __ATOMIC_RELAXED, __HIP_MEMORY_SCOPE_AGENT);
    __syncthreads();
    cur = *slot;
    while ((int)cur < n_all) {
        unsigned nxt = 0;
        if (F.tid == 0) nxt = __hip_atomic_fetch_add(ticket, 1u, __ATOMIC_RELAXED, __HIP_MEMORY_SCOPE_AGENT);
        int it = (int)cur;
        const int tkind = it < n_ctx ? 22 : (it < n_ctx + n_na ? 20 : (it < n_ctx + n_na + n_loc ? (it < n_ctx + n_na + n_loc / 2 ? 21 : 23) : 24));
        if (l == 0) { TS_START(F, tkind); if (PROBE_T == 25 && blockIdx.x == 0 && F.tid == 0) TS_LDS(F)[0] += 2000; }
        if (it < n_ctx) { if (it < 32) mlstm_itemA(F, l, it, 0, F.otm, F.stm); else hgrn_itemA(F, l, it - 32, 0, F.oth, F.sth); }
        else if ((it -= n_ctx) < n_na) na_item(F, l, it / 96, (it / 16) % 6, 4 * (it % 16));
        else if ((it -= n_na) < n_loc) { constexpr int NL = 2 * (NSEG - 1); if (it < 32 * NL) mlstm_itemA(F, l, it / NL, 1 + it % NL, F.otm, F.stm); else { it -= 32 * NL; hgrn_itemA(F, l, it / NL, 1 + it % NL, F.oth, F.sth); } }
        else { it -= n_loc; na_item(F, l, it / 6, it % 6, -1); }
        if (l == 0) TS_STOP(F, tkind);
        __syncthreads();
        if (F.tid == 0) *slot = nxt;
        __syncthreads();
        cur = *slot;
    }
}
#ifndef PROBE_MEM
#define PROBE_MEM 0
#endif
__device__ __forceinline__ void phase_mixC(const Ctx& F, int l) {
    if (PROBE_MEM != 0 && l == 0) {
        const int it = F.vcu, bh = it >> 3, seg = it & 7, b = bh >> 2, h = bh & 3, tid = F.tid, lane = F.lane;
        const bf16* P = F.P; unsigned accx = 0;
        const int qk_tok = tid / 6, qk_pi = tid % 6, qk_d0 = 48 * (qk_pi / 3) + 8 * (qk_pi % 3), v1_tok = tid / 12, v1_pc = tid % 12, v2_tok = (512 + tid) / 12, v2_pc = (512 + tid) % 12;
        for (int dir = 0; dir < 2; ++dir)
            for (int ci = 0; ci < 8; ++ci) {
                v4u r[6]; float g0 = 0.f, g1 = 0.f;
#pragma unroll
                for (int k = 0; k < 6; ++k) r[k] = (v4u){0u, 0u, 0u, 0u};
                if (PROBE_MEM == 1) {
                    auto tok = [&](int i) -> int { return dir == 0 ? 512 * seg + 64 * ci + i : 512 * seg + 64 * (7 - ci) + (63 - i); };
                    if (tid < 384) { const bf16* pr = P + (size_t)(b * S + tok(qk_tok)) * PLD + h * 96 + qk_d0; r[0] = *(const v4u*)(pr + B_Q); r[1] = *(const v4u*)(pr + B_Q + 24); r[2] = *(const v4u*)(pr + B_K); r[3] = *(const v4u*)(pr + B_K + 24); }
                    r[4] = *(const v4u*)(P + (size_t)(b * S + tok(v1_tok)) * PLD + B_V + h * 96 + 8 * v1_pc);
                    if (tid < 256) r[5] = *(const v4u*)(P + (size_t)(b * S + tok(v2_tok)) * PLD + B_V + h * 96 + 8 * v2_pc);
                    const float* gp = F.gates + (size_t)(b * S + tok(lane)) * 16 + dir * 4 + h; g0 = gp[0]; g1 = gp[8];
                } else {
                    const bf16* base = P + ((size_t)((it * 2 + dir) * 8 + ci)) * 24576;
                    if (tid < 384) { r[0] = *(const v4u*)(base + tid * 8); r[1] = *(const v4u*)(base + 3072 + tid * 8); r[2] = *(const v4u*)(base + 6144 + tid * 8); r[3] = *(const v4u*)(base + 9216 + tid * 8); }
                    r[4] = *(const v4u*)(base + 12288 + tid * 8);
                    if (tid < 256) r[5] = *(const v4u*)(base + 16384 + tid * 8);
                    const float* gp = F.gates + (size_t)((it * 2 + dir) * 8 + ci) * 1024 + lane; g0 = gp[0]; g1 = gp[64];
                }
#pragma unroll
                for (int k = 0; k < 6; ++k) accx ^= r[k].x ^ r[k].y ^ r[k].z ^ r[k].w;
                accx ^= __float_as_uint(g0) ^ __float_as_uint(g1);
            }
        if (accx == 0x1234567u) F.stm[tid] = 1.f;
        __syncthreads();
    }
    mlstm_load_rope(F, F.rope);
    for (int it = F.vcu; it < 2 * 32 * NSEG; it += F.G) {
        if (it < 32 * NSEG) mlstm_itemC(F, l, it / NSEG, it % NSEG, F.otm, F.stm);
        else hgrn_itemC(F, l, (it - 32 * NSEG) / NSEG, it % NSEG, F.oth, F.sth);
    }
}

constexpr int NPH = 12;
struct Args { const float* in[15]; float* out; unsigned char* ws; int ph_lo, ph_hi; };
__global__ void __launch_bounds__(512, 2) mega_fwd(Args args) {
    extern __shared__ __attribute__((aligned(16))) unsigned char lds[];
    Ctx F;
    F.lds = (LAS unsigned char*)lds;
    F.tid = threadIdx.x; F.lane = F.tid & 63; F.wave = __builtin_amdgcn_readfirstlane(F.tid >> 6);
    F.G = gridDim.x; { const int bx = blockIdx.x; F.vcu = (F.G % 8 == 0) ? (bx % 8) * (F.G / 8) + bx / 8 : bx; }
    F.gw = F.vcu * 8 + F.wave; F.NGW = F.G * 8;
    unsigned char* ws = args.ws;
    F.x = args.in[0]; F.c = args.in[1]; F.ctx = args.in[2]; F.c_ctx = args.in[3]; F.w_mod = args.in[4]; F.b_mod = args.in[5]; F.g_pre = args.in[6]; F.g_post = args.in[7];
    F.w_in = args.in[8]; F.w_out = args.in[9]; F.hgrn_lb = args.in[10]; F.hgrn_gn = args.in[11]; F.gate_b = args.in[12]; F.mlstm_gn = args.in[13]; F.na_rpb = args.in[14];
    F.out = args.out;
    F.wt_in = (bf16*)(ws + WS_WT_IN); F.wt_out = (bf16*)(ws + WS_WT_OUT); F.mod = (float*)(ws + WS_MOD); F.gates = (float*)(ws + WS_GATES); F.ctx1 = (float*)(ws + WS_CTX1);
    F.hxy = (bf16*)(ws + WS_HXY); F.P = (bf16*)(ws + WS_P); F.UX = (bf16*)(ws + WS_P); F.oth = (bf16*)(ws + WS_OH); F.sth = (float*)(ws + WS_STH); F.otm = (bf16*)(ws + WS_OM); F.stm = (float*)(ws + WS_STM); F.rope = (float*)(ws + WS_ROPE);
    for (int u = F.tid; u < (LDS_BYTES - LDSCTL_OFF) / 4; u += 512) ((LAS unsigned*)(F.lds + LDSCTL_OFF))[u] = 0u;
    __syncthreads();
    XcdBarrier bar = xcd_barrier_post((unsigned*)(ws + WS_CTL) + CW_BAR, (volatile LAS unsigned*)(F.lds + MISC_OFF) + 8);

    const int lo = args.ph_lo, hi = args.ph_hi;
#ifndef DUP_PHASE
#define DUP_PHASE -1
#endif
#define IN(k) (lo <= (k) && (k) < hi)
#define SEAM(k) do { if ((k) + 1 < hi) xcd_barrier(bar); } while (0)
#define PHASE(k, ...) if (IN(k)) { TS_START(F, 100 + (k)); __VA_ARGS__; if ((k) == DUP_PHASE) { xcd_barrier(bar); __VA_ARGS__; } SEAM(k); TS_STOP(F, 100 + (k)); }
    PHASE(0, phase_p0(F))
    PHASE(1, { phase_prenorm0(F); phase_p1_transposes(F); })
#define LAYER(l) \
    PHASE(2 + 5 * (l), { \
        pg8::Gemm g{F.hxy, F.wt_in + (size_t)(l) * NPAD * 1024, M, NPAD, 1024}; \
        pg8::EpiIn E{F.P, F.gates, F.gate_b + (l) * 16}; \
        if ((l) == 0) { pg8::StaticOrder SO; SO.init(M, NPAD, F.G, (int)blockIdx.x); pg8::gemm_phase<pg8::EpiIn, pg8::StaticOrder, true, true>(F.lds + RING_OFF, g, SO, E); } \
        else { pg8::SkipOrder SO; SO.init(F.G, (int)blockIdx.x); pg8::gemm_phase<pg8::EpiIn, pg8::SkipOrder, true, true>(F.lds + RING_OFF, g, SO, E); } }) \
    PHASE(3 + 5 * (l), phase_mixA(F, (l), (unsigned*)(args.ws + WS_CTL) + 8192 + 64 * (l))) \
    PHASE(4 + 5 * (l), phase_mixC(F, (l))) \
    PHASE(5 + 5 * (l), { \
        constexpr int Ml = (l) == 0 ? M : MX; \
        pg8::Gemm g{F.hxy, F.wt_out + (size_t)(l) * 1024 * 1024, Ml, 1024, 1024}; pg8::StaticOrder SO; SO.init(Ml, 1024, F.G, (int)blockIdx.x); \
        pg8::EpiOut E{F.UX}; \
        pg8::gemm_phase<pg8::EpiOut, pg8::StaticOrder, true, true>(F.lds + RING_OFF, g, SO, E); }) \
    PHASE(6 + 5 * (l), phase_post(F, (l)))
    LAYER(0)
    LAYER(1)
#undef LAYER
#undef PHASE
#undef IN
#undef SEAM
    if (PROBE_T != 0 && blockIdx.x == 0 && F.tid == 0) { const unsigned long long t0 = __builtin_amdgcn_s_memtime(), dt = 8ull * TS_LDS(F)[0]; while (__builtin_amdgcn_s_memtime() - t0 < dt) __builtin_amdgcn_s_sleep(8); }
}

extern "C" void kernel_launch(void* const* d_in, const int* in_sizes, int n_in, void* d_out, int out_size, void* d_ws, size_t ws_size, hipStream_t stream) {
    static int grid = 0;
    if (grid == 0) {
        if (n_in != 15 || ws_size < WS_END) { fprintf(stderr, "kernel_launch: unexpected n_in %d / ws_size %zu (need %zu); nothing launched\n", n_in, ws_size, (size_t)WS_END); grid = -1; return; }
        int dev = 0, cus = 0, per_cu = 0;
        if (hipGetDevice(&dev) != hipSuccess || hipDeviceGetAttribute(&cus, hipDeviceAttributeMultiprocessorCount, dev) != hipSuccess) { grid = -1; return; }
        if (hipFuncSetAttribute((const void*)mega_fwd, hipFuncAttributeMaxDynamicSharedMemorySize, LDS_BYTES) != hipSuccess) { fprintf(stderr, "kernel_launch: hipFuncSetAttribute failed\n"); grid = -1; return; }
        if (hipOccupancyMaxActiveBlocksPerMultiprocessor(&per_cu, (const void*)mega_fwd, 512, LDS_BYTES) != hipSuccess || per_cu < 1) { fprintf(stderr, "kernel_launch: occupancy query says %d blocks/CU\n", per_cu); (void)hipGetLastError(); grid = -1; return; }
        grid = cus;
    }
    if (grid < 0) return;
    (void)hipMemsetAsync((char*)d_ws + WS_CTL, 0, CTL_BYTES, stream);
    Args a{};
    for (int i = 0; i < 15; ++i) a.in[i] = (const float*)d_in[i];
    a.out = (float*)d_out; a.ws = (unsigned char*)d_ws; a.ph_lo = 0; a.ph_hi = NPH;
    hipLaunchKernelGGL(mega_fwd, dim3(grid), dim3(512), LDS_BYTES, stream, a);
}
```

```cpp
#include <hip/hip_runtime.h>
#include <stdint.h>
#include <cstdio>

namespace cfg {
constexpr int D = 1024, NB = 8, S = 4096, CTX = 256;
constexpr int MX = NB * S, MC = NB * CTX, M = MX + MC;
constexpr int PIN = 4752, NPAD = 4864, PLD = 4736;
constexpr int A_Q = 0, A_FF = 256, A_FB = 512, A_I = 768, A_Z = 1024, B_Q = 1280, B_K = 1664, B_V = 2048, B_O = 2432, B_Z = 2816,
              C_Q = 3200, C_K = 3584, C_V = 3968, C_Z = 4352;
constexpr float EPS = 1e-6f;
constexpr size_t WS_CTL = 0, CTL_BYTES = 65536;
constexpr size_t WS_WT_IN = WS_CTL + CTL_BYTES;
constexpr size_t WS_WT_OUT = WS_WT_IN + 2ull * NPAD * 1024 * 2;
constexpr size_t WS_MOD = WS_WT_OUT + 2ull * 1024 * 1024 * 2;
constexpr size_t WS_GATES = WS_MOD + 2ull * 9 * 3072 * 4;
constexpr size_t WS_CTX1 = WS_GATES + (size_t)M * 16 * 4;
constexpr size_t WS_HXY = WS_CTX1 + (size_t)MC * 1024 * 4;
constexpr size_t WS_P = WS_HXY + (size_t)M * 1024 * 2;
constexpr size_t WS_OH = WS_P + (size_t)M * PLD * 2;
constexpr size_t WS_OM = WS_OH + (size_t)M * 256 * 4;
constexpr size_t WS_STM = WS_OM + (size_t)M * 384 * 2;
constexpr size_t WS_ROPE = WS_STM + 32ull * 2 * 8 * (96 * 112 + 16) * 4;
constexpr size_t WS_STH = WS_ROPE + 64 * 24 * 8;
constexpr size_t WS_END = WS_STH + 32ull * 2 * 8 * (64 * 64 + 64) * 4;
static_assert(WS_END <= 536870912ull, "workspace");
static_assert(WS_WT_IN % 256 == 0 && WS_MOD % 256 == 0 && WS_GATES % 256 == 0 && WS_CTX1 % 256 == 0 && WS_HXY % 256 == 0 && WS_P % 256 == 0 && WS_OH % 256 == 0 && WS_OM % 256 == 0 && WS_STM % 256 == 0 && WS_ROPE % 256 == 0 && WS_STH % 256 == 0, "align");
}
using namespace cfg;

namespace pg8 {
#define PG8_LAS __attribute__((address_space(3)))
typedef unsigned short bf16_t;
typedef short bf16x8 __attribute__((ext_vector_type(8)));
typedef float f32x4 __attribute__((ext_vector_type(4)));
typedef unsigned u32x4 __attribute__((ext_vector_type(4)));
constexpr int BM = 256, BK = 64, HALF = 128, HTB = HALF * BK * 2  , STAGE_BYTES = 8 * HTB, NXCD = 8, WGM = 8;

__host__ __device__ __forceinline__ int lds_byte(int r, int c) { const int st = (r >> 4) * 2 + (c >> 5), rr = r & 15, cc = c & 31, ob = rr * 64 + cc * 2; return st * 1024 + (ob ^ (((ob >> 9) & 1) << 5)); }
__host__ __device__ __forceinline__ void stage_rc(int b, int& R, int& C) { const int st = b / 1024, sb = b % 1024, swz = sb ^ (((sb >> 9) & 1) << 5); R = (st >> 1) * 16 + swz / 64; C = (st & 1) * 32 + (swz % 64) / 2; }
__host__ __device__ __forceinline__ int perm32(int rho) { const int n = rho >> 4, i = rho & 15; return 8 * (i >> 2) + 4 * n + (i & 3); }

struct Unit { int pm, pn; };
struct Gemm { const bf16_t* A; const bf16_t* Bt; int M, N, K; };

struct StaticOrder {
    int nM, nN, nwg, G, c;
    __host__ __device__ void init(int M, int N, int G_, int c_) { nM = M / BM; nN = N / BM; nwg = nM * nN; G = G_; c = c_; }
    __host__ __device__ bool next(int i, Unit& u) const {
        const long L = (long)i * G + c; if (L >= nwg) return false;
        int wgid = (int)L; { const int q = nwg / NXCD, r = nwg % NXCD, xcd = wgid % NXCD, off = wgid / NXCD; wgid = (xcd < r ? xcd * (q + 1) : r * (q + 1) + (xcd - r) * q) + off; }
        const int nig = WGM * nN, gid = wgid / nig, fm = gid * WGM, gsz = (nM - fm) < WGM ? (nM - fm) : WGM;
        u.pm = fm + ((wgid % nig) % gsz); u.pn = (wgid % nig) / gsz; return true;
    }
    __device__ __forceinline__ void a_ready(const Unit&) const {}
    __device__ __forceinline__ void done(const Unit&) const {}
};

__device__ __forceinline__ unsigned cvt_pk_bf16(float lo, float hi) { unsigned r; asm volatile("v_cvt_pk_bf16_f32 %0, %1, %2" : "=v"(r) : "v"(lo), "v"(hi)); return r; }
__device__ __forceinline__ float logsigmoid_e(float v) { return fminf(v, 0.f) - log1pf(__expf(-fabsf(v))); }

struct EpiIn {
    static constexpr bool PERM = true, AFTER_DRAIN = false;
    bf16_t* P; float* gates; const float* gate_b;
    __device__ __forceinline__ void operator()(const f32x4 (&acc)[2][2][4][2], const Unit& u, int wr, int wc, int fr, int fq) const {
        const int row0 = u.pm * BM + wr * 64 + fr, col0 = u.pn * BM + wc * 32 + 8 * fq;
#pragma unroll
        for (int bj = 0; bj < 2; ++bj) {
            const int col = col0 + bj * HALF;
            if (col < cfg::PLD) {
                const int act = col < 256 ? 1 : col < 1024 ? 0 : col < 1280 ? 2 : col < 1664 ? 3 : col < 2432 ? 0 : col < 2816 ? 4 : col < 3200 ? 2 : col < 3584 ? 5 : col < 4352 ? 0 : 2;
#pragma unroll
                for (int ai = 0; ai < 2; ++ai)
#pragma unroll
                    for (int m = 0; m < 4; ++m) { f32x4 v0 = acc[ai][bj][m][0], v1 = acc[ai][bj][m][1];
                        if (act == 1 || act == 2 || act == 4) { const float sc = act == 1 ? 0.125f : 1.f;
#pragma unroll
                            for (int e = 0; e < 4; ++e) { const float s0 = __builtin_amdgcn_rcpf(1.f + __expf(-v0[e])), s1 = __builtin_amdgcn_rcpf(1.f + __expf(-v1[e])); v0[e] = act == 4 ? s0 : v0[e] * s0 * sc; v1[e] = act == 4 ? s1 : v1[e] * s1 * sc; } }
                        else if (act == 3) { v0 = v0 * 0.10206207261596575f; v1 = v1 * 0.10206207261596575f; }
                        else if (act == 5) { v0 = v0 * (0.125f * 1.4426950408889634f); v1 = v1 * (0.125f * 1.4426950408889634f); }
                        u32x4 w; w.x = cvt_pk_bf16(v0[0], v0[1]); w.y = cvt_pk_bf16(v0[2], v0[3]); w.z = cvt_pk_bf16(v1[0], v1[1]); w.w = cvt_pk_bf16(v1[2], v1[3]);
                        *(u32x4*)(P + (size_t)(row0 + ai * HALF + m * 16) * cfg::PLD + col) = w; }
            } else if (col < cfg::PIN) {
                const int g0 = col - cfg::PLD;
                const f32x4 b0 = *(const f32x4*)(gate_b + g0), b1 = *(const f32x4*)(gate_b + g0 + 4);
#pragma unroll
                for (int ai = 0; ai < 2; ++ai)
#pragma unroll
                    for (int m = 0; m < 4; ++m) { f32x4 v0 = acc[ai][bj][m][0] + b0, v1 = acc[ai][bj][m][1] + b1;
                        if (g0 >= 8) {
#pragma unroll
                            for (int e = 0; e < 4; ++e) { v0[e] = logsigmoid_e(v0[e]); v1[e] = logsigmoid_e(v1[e]); } }
                        float* gp = gates + (size_t)(row0 + ai * HALF + m * 16) * 16 + g0;
                        *(f32x4*)gp = v0; *(f32x4*)(gp + 4) = v1; }
            }
        }
    }
};
struct EpiOut {
    static constexpr bool PERM = true, AFTER_DRAIN = false;
    bf16_t* C;
    __device__ __forceinline__ void operator()(const f32x4 (&acc)[2][2][4][2], const Unit& u, int wr, int wc, int fr, int fq) const {
        const int row0 = u.pm * BM + wr * 64 + fr, col0 = u.pn * BM + wc * 32 + 8 * fq;
#pragma unroll
        for (int ai = 0; ai < 2; ++ai)
#pragma unroll
            for (int m = 0; m < 4; ++m) { bf16_t* rowp = C + (size_t)(row0 + ai * HALF + m * 16) * 1024 + col0;
#pragma unroll
                for (int bj = 0; bj < 2; ++bj) { const f32x4 v0 = acc[ai][bj][m][0], v1 = acc[ai][bj][m][1];
                    u32x4 w; w.x = cvt_pk_bf16(v0[0], v0[1]); w.y = cvt_pk_bf16(v0[2], v0[3]); w.z = cvt_pk_bf16(v1[0], v1[1]); w.w = cvt_pk_bf16(v1[2], v1[3]);
                    *(u32x4*)(rowp + bj * HALF) = w; } }
    }
};

template <class Epi, class Sched, bool ALIGN_EPI = false, bool SP2 = false>
__device__ __forceinline__ void gemm_phase(PG8_LAS unsigned char* lds, const Gemm g, const Sched& S, const Epi& E) {
    const int tid = threadIdx.x, wid = __builtin_amdgcn_readfirstlane(tid >> 6), lane = tid & 63, wr = wid >> 2, wc = wid & 3, fr = lane & 15, fq = lane >> 4;
    const int K = g.K, nt = K / BK;
    unsigned voffA[2], voffB[2];
#pragma unroll
    for (int i = 0; i < 2; ++i) { int R, C; stage_rc(tid * 16 + i * 8192, R, C); const int Rb = Epi::PERM ? ((R & ~31) + perm32(R & 31)) : R;
        voffA[i] = (unsigned)(R * K + C) * 2u; voffB[i] = (unsigned)(Rb * K + C) * 2u; }
    const size_t kstep = (size_t)(BK * 2);
    const size_t hstep = (size_t)HALF * K * 2;
    const size_t tstep = 2 * hstep;
    const unsigned ldsw = (unsigned)wid * 1024u;
    const int aoff = lds_byte(wr * 64 + fr, fq * 8), boff = lds_byte(wc * 32 + fr, fq * 8);
#define PG8_SA(b, h) (((b) * 2 + (h)) * HTB)
#define PG8_SB(b, h) ((4 + (b) * 2 + (h)) * HTB)
#define PG8_STAGE(bufoff, gbase, voff) do { _Pragma("unroll") for (int _i = 0; _i < 2; ++_i) \
        __builtin_amdgcn_global_load_lds((const unsigned*)((const char*)(gbase) + (voff)[_i]), (PG8_LAS unsigned*)(lds + (bufoff) + ldsw + _i * 8192), 16, 0, 0); } while (0)
#define PG8_LDA(dst, b, h) do { _Pragma("unroll") for (int m = 0; m < 4; ++m) _Pragma("unroll") for (int k = 0; k < 2; ++k) dst[m][k] = *(const PG8_LAS bf16x8*)(lds + PG8_SA(b, h) + aoff + m * 2048 + k * 1024); } while (0)
#define PG8_LDB(dst, b, h) do { _Pragma("unroll") for (int n = 0; n < 2; ++n) _Pragma("unroll") for (int k = 0; k < 2; ++k) dst[n][k] = *(const PG8_LAS bf16x8*)(lds + PG8_SB(b, h) + boff + n * 2048 + k * 1024); } while (0)
#define PG8_MMA(ai, bj, At, Bt) do { __builtin_amdgcn_s_setprio(1); _Pragma("unroll") for (int m = 0; m < 4; ++m) _Pragma("unroll") for (int n = 0; n < 2; ++n) _Pragma("unroll") for (int k = 0; k < 2; ++k) \
        acc[ai][bj][m][n] = __builtin_amdgcn_mfma_f32_16x16x32_bf16(Bt[n][k], At[m][k], acc[ai][bj][m][n], 0, 0, 0); __builtin_amdgcn_s_setprio(0); } while (0)
#define PG8_WAIT_V(n) asm volatile("s_waitcnt vmcnt(" #n ")" ::: "memory")
#define PG8_WAIT_L(n) asm volatile("s_waitcnt lgkmcnt(" #n ")" ::: "memory")
#define PG8_BAR __builtin_amdgcn_s_barrier()
#define PG8_SCHED __builtin_amdgcn_sched_barrier(0)
    Unit cur, nxt; int ui = 0;
    if (!S.next(0, cur)) return;
    f32x4 acc[2][2][4][2];
#pragma unroll
    for (int a = 0; a < 2; ++a)
#pragma unroll
        for (int b = 0; b < 2; ++b)
#pragma unroll
            for (int m = 0; m < 4; ++m)
#pragma unroll
                for (int n = 0; n < 2; ++n) acc[a][b][m][n] = (f32x4){0.f, 0.f, 0.f, 0.f};
    bf16x8 At[4][2], B0[2][2], B1[2][2];
    const char* cA = (const char*)g.A + (size_t)cur.pm * tstep; const char* cB = (const char*)g.Bt + (size_t)cur.pn * tstep;
    S.a_ready(cur);
    if constexpr (SP2) {
        PG8_STAGE(PG8_SB(0, 0), cB, voffB); PG8_STAGE(PG8_SB(0, 1), cB + hstep, voffB); PG8_STAGE(PG8_SA(0, 0), cA, voffA); PG8_STAGE(PG8_SA(0, 1), cA + hstep, voffA);
        if (wr == 1) PG8_BAR;
        PG8_WAIT_V(2); PG8_BAR;
        PG8_STAGE(PG8_SB(1, 0), cB + kstep, voffB); PG8_STAGE(PG8_SA(1, 0), cA + kstep, voffA); PG8_STAGE(PG8_SB(1, 1), cB + hstep + kstep, voffB);
        PG8_WAIT_V(6); PG8_BAR;
    } else {
        PG8_STAGE(PG8_SB(0, 0), cB, voffB); PG8_STAGE(PG8_SA(0, 0), cA, voffA); PG8_STAGE(PG8_SB(0, 1), cB + hstep, voffB); PG8_STAGE(PG8_SA(0, 1), cA + hstep, voffA);
        if (wr == 1) PG8_BAR;
        PG8_WAIT_V(4); PG8_BAR;
        PG8_STAGE(PG8_SB(1, 0), cB + kstep, voffB); PG8_STAGE(PG8_SA(1, 0), cA + kstep, voffA); PG8_STAGE(PG8_SB(1, 1), cB + hstep + kstep, voffB);
        PG8_WAIT_V(6); PG8_BAR;
    }
    for (;;) {
        const bool has_next = S.next(ui + 1, nxt);
        const char* nA = has_next ? (const char*)g.A + (size_t)nxt.pm * tstep : cA; const char* nB = has_next ? (const char*)g.Bt + (size_t)nxt.pn * tstep : cB;
        for (int t = 0; t < nt; t += 2) {
            const bool last = (t == nt - 2);
            const char* a1 = cA + (size_t)(t + 1) * kstep;
            const char* a2 = last ? nA : cA + (size_t)(t + 2) * kstep; const char* b2 = last ? nB : cB + (size_t)(t + 2) * kstep;
            const char* a3 = a2 + kstep; const char* b3 = b2 + kstep;
            if (last && has_next) S.a_ready(nxt);
            if constexpr (SP2) {
            PG8_LDB(B0, 0, 0); PG8_LDB(B1, 0, 1); PG8_SCHED; PG8_LDA(At, 0, 0); PG8_STAGE(PG8_SA(1, 1), a1 + hstep, voffA);
            PG8_WAIT_V(8); PG8_WAIT_L(0); PG8_BAR; PG8_MMA(0, 0, At, B0); PG8_MMA(0, 1, At, B1); PG8_BAR; PG8_SCHED;
            PG8_LDA(At, 0, 1); PG8_STAGE(PG8_SB(0, 0), b2, voffB); PG8_STAGE(PG8_SB(0, 1), b2 + hstep, voffB); PG8_STAGE(PG8_SA(0, 0), a2, voffA);
            PG8_WAIT_V(8); PG8_WAIT_L(0); PG8_BAR; PG8_MMA(1, 0, At, B0); PG8_MMA(1, 1, At, B1); PG8_BAR; PG8_SCHED;
            PG8_LDB(B0, 1, 0); PG8_LDB(B1, 1, 1); PG8_SCHED; PG8_LDA(At, 1, 0); PG8_STAGE(PG8_SA(0, 1), a2 + hstep, voffA);
            PG8_WAIT_V(8); PG8_WAIT_L(0); PG8_BAR; PG8_MMA(0, 0, At, B0); PG8_MMA(0, 1, At, B1); PG8_BAR; PG8_SCHED;
            PG8_LDA(At, 1, 1); PG8_STAGE(PG8_SB(1, 0), b3, voffB); PG8_STAGE(PG8_SB(1, 1), b3 + hstep, voffB); PG8_STAGE(PG8_SA(1, 0), a3, voffA);
            PG8_WAIT_V(8); PG8_WAIT_L(0); PG8_BAR; PG8_MMA(1, 0, At, B0); PG8_MMA(1, 1, At, B1); PG8_BAR; PG8_SCHED;
            } else {
            PG8_LDB(B0, 0, 0); PG8_SCHED; PG8_LDA(At, 0, 0); PG8_STAGE(PG8_SA(1, 1), a1 + hstep, voffA);
            PG8_WAIT_L(8); PG8_BAR; PG8_WAIT_L(0); PG8_MMA(0, 0, At, B0); PG8_BAR; PG8_SCHED;
            PG8_LDB(B1, 0, 1); PG8_STAGE(PG8_SB(0, 0), b2, voffB);
            PG8_BAR; PG8_WAIT_L(0); PG8_MMA(0, 1, At, B1); PG8_BAR;
            PG8_LDA(At, 0, 1); PG8_STAGE(PG8_SA(0, 0), a2, voffA);
            PG8_BAR; PG8_WAIT_L(0); PG8_MMA(1, 0, At, B0); PG8_BAR; PG8_SCHED;
            PG8_STAGE(PG8_SB(0, 1), b2 + hstep, voffB);
            PG8_WAIT_V(6); PG8_BAR; PG8_MMA(1, 1, At, B1); PG8_BAR;
            PG8_LDB(B0, 1, 0); PG8_SCHED; PG8_LDA(At, 1, 0); PG8_STAGE(PG8_SA(0, 1), a2 + hstep, voffA);
            PG8_WAIT_L(8); PG8_BAR; PG8_WAIT_L(0); PG8_MMA(0, 0, At, B0); PG8_BAR; PG8_SCHED;
            PG8_LDB(B1, 1, 1); PG8_STAGE(PG8_SB(1, 0), b3, voffB);
            PG8_BAR; PG8_WAIT_L(0); PG8_MMA(0, 1, At, B1); PG8_BAR;
            PG8_LDA(At, 1, 1); PG8_STAGE(PG8_SA(1, 0), a3, voffA);
            PG8_BAR; PG8_WAIT_L(0); PG8_MMA(1, 0, At, B0); PG8_BAR; PG8_SCHED;
            PG8_STAGE(PG8_SB(1, 1), b3 + hstep, voffB);
            PG8_WAIT_V(6); PG8_BAR; PG8_MMA(1, 1, At, B1); PG8_BAR;
            }
        }
        if constexpr (ALIGN_EPI) { if (wr == 0) PG8_BAR; }
        if constexpr (!Epi::AFTER_DRAIN) { E(acc, cur, wr, wc, fr, fq); S.done(cur); }
        if (!has_next) break;
#pragma unroll
        for (int a = 0; a < 2; ++a)
#pragma unroll
            for (int b = 0; b < 2; ++b)
#pragma unroll
                for (int m = 0; m < 4; ++m)
#pragma unroll
                    for (int n = 0; n < 2; ++n) acc[a][b][m][n] = (f32x4){0.f, 0.f, 0.f, 0.f};
        cur = nxt; cA = nA; cB = nB; ++ui;
        if constexpr (ALIGN_EPI) { if (wr == 1) PG8_BAR; }
    }
    PG8_WAIT_V(0);
    if constexpr (!ALIGN_EPI) { if (wr == 0) PG8_BAR; }
    PG8_BAR;
    if constexpr (Epi::AFTER_DRAIN) { E.fused(acc, cur, wr, wc, fr, fq, lds, wid, lane); S.done(cur); }
#undef PG8_SA
#undef PG8_SB
#undef PG8_STAGE
#undef PG8_LDA
#undef PG8_LDB
#undef PG8_MMA
#undef PG8_WAIT_V
#undef PG8_WAIT_L
#undef PG8_BAR
#undef PG8_SCHED
}
}
constexpr int RING_OFF = 0, RING_BYTES = 131072;
constexpr int LDSCTL_OFF = RING_BYTES, MISC_OFF = LDSCTL_OFF + 320;
constexpr int LDS_BYTES = 147456;
constexpr int CW_BAR = 4096;

#define GAS __attribute__((address_space(1)))
#define LAS __attribute__((address_space(3)))
typedef unsigned short bf16;
typedef unsigned v4u __attribute__((ext_vector_type(4)));
typedef float f32x4 __attribute__((ext_vector_type(4)));
typedef short bf16x8 __attribute__((ext_vector_type(8)));
typedef GAS unsigned gu32;
#define RLX_AGENT __ATOMIC_RELAXED, __HIP_MEMORY_SCOPE_AGENT
#define LDS_WAIT() asm volatile("s_waitcnt lgkmcnt(0)" ::: "memory")
#define VM_WAIT() asm volatile("s_waitcnt vmcnt(0)" ::: "memory")
__device__ __forceinline__ unsigned f2bfu(float f) { unsigned u = __builtin_bit_cast(unsigned, f); return (u + 0x7fffu + ((u >> 16) & 1u)) >> 16; }
__device__ __forceinline__ bf16 f2bf(float f) { return (bf16)f2bfu(f); }
typedef float f32x2_t __attribute__((ext_vector_type(2))); typedef __bf16 bf16x2_t __attribute__((ext_vector_type(2)));
__device__ __forceinline__ unsigned pk2(float lo, float hi) { f32x2_t v = {lo, hi}; bf16x2_t b = __builtin_convertvector(v, bf16x2_t); return __builtin_bit_cast(unsigned, b); }
__device__ __forceinline__ float xor16_max(float v) { auto r = __builtin_amdgcn_permlane16_swap(__float_as_uint(v), __float_as_uint(v), false, false); return fmaxf(__uint_as_float(r[0]), __uint_as_float(r[1])); }
__device__ __forceinline__ float xor32_max(float v) { auto r = __builtin_amdgcn_permlane32_swap(__float_as_uint(v), __float_as_uint(v), false, false); return fmaxf(__uint_as_float(r[0]), __uint_as_float(r[1])); }
__device__ __forceinline__ float xor16_sum(float v) { auto r = __builtin_amdgcn_permlane16_swap(__float_as_uint(v), __float_as_uint(v), false, false); return __uint_as_float(r[0]) + __uint_as_float(r[1]); }
__device__ __forceinline__ float xor32_sum(float v) { auto r = __builtin_amdgcn_permlane32_swap(__float_as_uint(v), __float_as_uint(v), false, false); return __uint_as_float(r[0]) + __uint_as_float(r[1]); }
__device__ __forceinline__ float bf2f(bf16 v) { return __uint_as_float(((unsigned)v) << 16); }
__device__ __forceinline__ float silu_f(float v) { return v / (1.f + __expf(-v)); }
__device__ __forceinline__ float sigmoid_f(float v) { return 1.f / (1.f + __expf(-v)); }
__device__ __forceinline__ float wave_sum(float v) {
#pragma unroll
    for (int o = 1; o < 64; o <<= 1) v += __shfl_xor(v, o);
    return v;
}
__device__ __forceinline__ float rdlane(float v, int i) { return __int_as_float(__builtin_amdgcn_readlane(__float_as_int(v), i)); }


#ifndef PROBE_T
#define PROBE_T 0
#endif
#define TS_LDS(F) ((volatile LAS unsigned long long*)((F).lds + LDSCTL_OFF + 128))
#define TS_START(F, id) do { if (PROBE_T == (id) && blockIdx.x == 0 && (F).tid == 0) TS_LDS(F)[1] = __builtin_amdgcn_s_memtime(); } while (0)
#define TS_STOP(F, id)  do { if (PROBE_T == (id) && blockIdx.x == 0 && (F).tid == 0) TS_LDS(F)[0] += __builtin_amdgcn_s_memtime() - TS_LDS(F)[1]; } while (0)
#define XB_TMO      128
#define XB_XCNT(j)  (256  + 64 * (j))
#define XB_XSUB(j)  (1280 + 64 * (j))
#define XB_XGEN(j)  (2304 + 64 * (j))
#define XB_TOP      3328
#define XB_TOPGEN   3392
#define XCD_BAR_WORDS 3456
#define XB_SPIN_CAP (1u << 18)

__device__ __forceinline__ unsigned xb_ld(unsigned* p)              { return __hip_atomic_load(p, __ATOMIC_RELAXED, __HIP_MEMORY_SCOPE_AGENT); }
__device__ __forceinline__ unsigned xb_add(unsigned* p, unsigned v) { return __hip_atomic_fetch_add(p, v, __ATOMIC_RELAXED, __HIP_MEMORY_SCOPE_AGENT); }
__device__ __forceinline__ unsigned xb_xcc_id() { return (unsigned)__builtin_amdgcn_s_getreg((3 << 11) | 20) & 0xFu; }
#define XB_SPIN(cond, bar) do { unsigned _sp = 0; while (cond) { __builtin_amdgcn_s_sleep(1); \
    if ((++_sp & 255u) == 0u) { if (xb_ld(&(bar)[XB_TMO])) break; if (_sp > XB_SPIN_CAP) { atomicAdd(&(bar)[XB_TMO], 1u); break; } } } } while (0)

struct XcdBarrier {
    unsigned* bar; unsigned x;
    volatile LAS unsigned* st;
};

__device__ __forceinline__ XcdBarrier xcd_barrier_post(unsigned* bar, volatile LAS unsigned* st) {
    XcdBarrier b; b.bar = bar; b.x = xb_xcc_id(); b.st = st;
    if (threadIdx.x == 0) (void)xb_add(&bar[XB_XCNT(b.x)], 1u);
    return b;
}
__device__ __forceinline__ void xcd_barrier_complete(unsigned* bar, unsigned x, unsigned& nloc, unsigned& nx) {
    const unsigned G = gridDim.x * gridDim.y * gridDim.z;
    unsigned sum, cnt, mine, sp = 0u;
    for (;;) {
        sum = 0u; cnt = 0u; mine = 0u;
#pragma unroll
        for (unsigned j = 0; j < 16; ++j) { const unsigned c = xb_ld(&bar[XB_XCNT(j)]); sum += c; cnt += (c > 0u) ? 1u : 0u; mine = (j == x) ? c : mine; }
        if (sum == G) break;
        __builtin_amdgcn_s_sleep(1);
        if ((++sp & 255u) == 0u) { if (xb_ld(&bar[XB_TMO])) break; if (sp > XB_SPIN_CAP) { atomicAdd(&bar[XB_TMO], 1u); break; } }
    }
    nloc = mine > 0u ? mine : 1u; nx = cnt > 0u ? cnt : 1u;
}

__device__ __forceinline__ void xcd_barrier(const XcdBarrier& b) {
    asm volatile("s_waitcnt vmcnt(0)" ::: "memory");
    __syncthreads();
    if (threadIdx.x == 0) {
        unsigned* bar = b.bar;
        __builtin_amdgcn_s_waitcnt(0);
        unsigned nloc = b.st[0], nx = b.st[1];
        if (nloc == 0u) { xcd_barrier_complete(bar, b.x, nloc, nx); b.st[0] = nloc; b.st[1] = nx; }
        const unsigned old = xb_add(&bar[XB_XSUB(b.x)], 1u);
        const unsigned gen = old / nloc;
        if (old + 1u == (gen + 1u) * nloc) {
            __builtin_amdgcn_fence(__ATOMIC_RELEASE, "agent");
            asm volatile("s_waitcnt vmcnt(0)" ::: "memory");
            const unsigned og = xb_add(&bar[XB_TOP], 1u);
            const unsigned tg = og / nx;
            if (og + 1u == (tg + 1u) * nx) xb_add(&bar[XB_TOPGEN], 1u);
            else XB_SPIN(xb_ld(&bar[XB_TOPGEN]) == tg, bar);
            __builtin_amdgcn_fence(__ATOMIC_ACQUIRE, "agent");
            xb_add(&bar[XB_XGEN(b.x)], 1u);
            asm volatile("s_waitcnt vmcnt(0)" ::: "memory");
        } else {
            XB_SPIN(xb_ld(&bar[XB_XGEN(b.x)]) == gen, bar);
            __builtin_amdgcn_fence(__ATOMIC_ACQUIRE, "agent");
            asm volatile("s_waitcnt vmcnt(0)" ::: "memory");
        }
    }
    __syncthreads();
}

struct Ctx {
    LAS unsigned char* lds; int tid, lane, wave, vcu, G, gw, NGW;
    const float *x, *c, *ctx, *c_ctx, *w_mod, *b_mod, *g_pre, *g_post, *w_in, *w_out, *hgrn_lb, *hgrn_gn, *gate_b, *mlstm_gn, *na_rpb;
    float* out; bf16 *wt_in, *wt_out, *hxy, *P; float *mod, *gates, *ctx1, *stm, *sth, *rope; bf16 *otm, *oth, *UX;
};

__device__ __forceinline__ void transpose_item(const float* W, int N, int Nnew, bool remap, bf16* WT, LAS float* scr, int item, int lane) {
    const int nblk = Nnew / 32, kb = item / nblk, nb = item % nblk, k0 = 64 * kb, n0 = 32 * nb;
    const int rg = lane >> 3, c4 = (lane & 7) * 4, nn = n0 + c4;
    int no = nn; if (remap) no = nn < 3200 ? nn : (nn < 4736 ? nn + 16 : (nn < 4752 ? 3200 + nn - 4736 : -1));
    f32x4 v[8];
#pragma unroll
    for (int j = 0; j < 8; ++j) v[j] = no >= 0 ? *(const f32x4*)(W + (size_t)(k0 + 8 * j + rg) * N + no) : (f32x4){0.f, 0.f, 0.f, 0.f};
#pragma unroll
    for (int j = 0; j < 8; ++j) { LAS float* d = scr + (8 * j + rg) * 33 + c4; d[0] = v[j][0]; d[1] = v[j][1]; d[2] = v[j][2]; d[3] = v[j][3]; }
    LDS_WAIT(); asm volatile("" ::: "memory");
    const int c = lane & 7;
#pragma unroll
    for (int j = 0; j < 4; ++j) { const int n = (lane >> 3) + 8 * j; const LAS float* s = scr + (8 * c) * 33 + n;
        v4u o; o.x = pk2(s[0 * 33], s[1 * 33]); o.y = pk2(s[2 * 33], s[3 * 33]); o.z = pk2(s[4 * 33], s[5 * 33]); o.w = pk2(s[6 * 33], s[7 * 33]);
        *(GAS v4u*)(WT + (size_t)(n0 + n) * 1024 + k0 + 8 * c) = o; }
    LDS_WAIT(); asm volatile("" ::: "memory");
}
__device__ __forceinline__ void phase_p0(const Ctx& F) {
    if (F.vcu < 96) {
        LAS float* tab = (LAS float*)(F.lds);
        LAS float* part = (LAS float*)(F.lds + 36864);
        for (int i = F.tid; i < 9 * 1024; i += 512) { const int r = i >> 10, k = i & 1023; const float v = r < 8 ? F.c[r * 1024 + k] : F.c_ctx[k]; tab[i] = silu_f(v); }
        __syncthreads();
        for (int it = F.vcu; it < 96; it += F.G) {
            const int l = it / 48, jb = it % 48, col = jb * 64 + F.lane;
            float acc[9];
#pragma unroll
            for (int r = 0; r < 9; ++r) acc[r] = 0.f;
            const float* wp = F.w_mod + ((size_t)l * 1024 + F.wave * 128) * 3072 + col;
            for (int kb = 0; kb < 128; kb += 32) {
                float wv[32];
#pragma unroll
                for (int k = 0; k < 32; ++k) wv[k] = wp[(size_t)(kb + k) * 3072];
#pragma unroll
                for (int k = 0; k < 32; ++k)
#pragma unroll
                    for (int r = 0; r < 9; ++r) acc[r] += tab[r * 1024 + F.wave * 128 + kb + k] * wv[k]; }
#pragma unroll
            for (int r = 0; r < 9; ++r) part[(F.wave * 9 + r) * 64 + F.lane] = acc[r];
            __syncthreads();
            for (int i = F.tid; i < 9 * 64; i += 512) { const int r = i >> 6, j = i & 63; float s = 0.f;
#pragma unroll
                for (int w = 0; w < 8; ++w) s += part[(w * 9 + r) * 64 + j];
                F.mod[((size_t)l * 9 + r) * 3072 + jb * 64 + j] = s + F.b_mod[l * 3072 + jb * 64 + j]; }
            __syncthreads();
        }
    }
    if (F.vcu == 96 % F.G) for (int i = F.tid; i < 64 * 24; i += 512) { const int pos = i / 24, f = i % 24; const float ang = (float)pos * expf(-(float)(2 * f) * (1.f / 48.f) * 9.210340371976184f); F.rope[2 * i] = cosf(ang); F.rope[2 * i + 1] = sinf(ang); }
    __syncthreads();
    LAS float* scr = (LAS float*)(F.lds + F.wave * 16384);
    constexpr int I_IN = 16 * (NPAD / 32);
    const int gwr = F.NGW - 1 - F.gw;
    for (int it = gwr; it < I_IN; it += F.NGW) transpose_item(F.w_in, PIN, NPAD, true, F.wt_in, scr, it, F.lane);
}
__device__ __forceinline__ void phase_p1_transposes(const Ctx& F) {
    LAS float* scr = (LAS float*)(F.lds + F.wave * 16384);
    constexpr int I_IN = 16 * (NPAD / 32), I_OUT = 16 * 32;
    for (int it = F.gw; it < I_IN + 2 * I_OUT; it += F.NGW) {
        if (it < I_OUT) transpose_item(F.w_out, 1024, 1024, false, F.wt_out, scr, it, F.lane);
        else if (it < I_OUT + I_IN) transpose_item(F.w_in + (size_t)1024 * PIN, PIN, NPAD, true, F.wt_in + (size_t)NPAD * 1024, scr, it - I_OUT, F.lane);
        else transpose_item(F.w_out + (size_t)1024 * 1024, 1024, 1024, false, F.wt_out + (size_t)1024 * 1024, scr, it - I_OUT - I_IN, F.lane);
    }
}

struct RowPar { float4 g[4], a[4], b[4]; };
__device__ __forceinline__ void load_par(RowPar& p, const float* g, const float* a, const float* b, int lane) {
#pragma unroll
    for (int j = 0; j < 4; ++j) { const int d = 4 * (lane + 64 * j); p.g[j] = *(const float4*)(g + d); p.a[j] = *(const float4*)(a + d); p.b[j] = *(const float4*)(b + d); }
}
__device__ __forceinline__ void prenorm_store(const float4 (&v)[4], float ss, const RowPar& p, bf16* dst, int lane) {
    const float rinv = 1.f / sqrtf(ss * (1.f / 1024.f) + EPS);
#pragma unroll
    for (int j = 0; j < 4; ++j) {
        const int d = 4 * (lane + 64 * j);
        const float o0 = v[j].x * rinv * p.g[j].x * (1.f + p.a[j].x) + p.b[j].x, o1 = v[j].y * rinv * p.g[j].y * (1.f + p.a[j].y) + p.b[j].y;
        const float o2 = v[j].z * rinv * p.g[j].z * (1.f + p.a[j].z) + p.b[j].z, o3 = v[j].w * rinv * p.g[j].w * (1.f + p.a[j].w) + p.b[j].w;
        uint2 w; w.x = pk2(o0, o1); w.y = pk2(o2, o3);
        *(uint2*)(dst + d) = w;
    }
}
__device__ __forceinline__ void phase_prenorm0(const Ctx& F) {
    auto rowsrc = [&](int m) -> const float* { return m < MX ? F.x + (size_t)m * 1024 : F.ctx + (size_t)(m - MX) * 1024; };
    int m = F.gw; if (m >= M) return;
    float4 nv[4];
#pragma unroll
    for (int j = 0; j < 4; ++j) nv[j] = ((const float4*)rowsrc(m))[F.lane + 64 * j];
    while (m < M) {
        const float* mod_r = F.mod + (size_t)(m < MX ? m / S : 8) * 3072;
        RowPar p; load_par(p, F.g_pre, mod_r + 1024, mod_r, F.lane);
        float4 v[4];
#pragma unroll
        for (int j = 0; j < 4; ++j) v[j] = nv[j];
        const int mn = m + F.NGW;
        if (mn < M) {
#pragma unroll
            for (int j = 0; j < 4; ++j) nv[j] = ((const float4*)rowsrc(mn))[F.lane + 64 * j]; }
        float ss = 0.f;
#pragma unroll
        for (int j = 0; j < 4; ++j) ss += v[j].x * v[j].x + v[j].y * v[j].y + v[j].z * v[j].z + v[j].w * v[j].w;
        ss = wave_sum(ss);
        prenorm_store(v, ss, p, F.hxy + (size_t)m * 1024, F.lane);
        m = mn;
    }
}
__device__ __forceinline__ void phase_post(const Ctx& F, int l) {
    const int Ml = l == 0 ? M : MX;
    const float* mod_l = F.mod + (size_t)l * 9 * 3072; const float* g_post_l = F.g_post + l * 1024;
    auto rowsrc = [&](int m) -> const float* { return m < MX ? (l == 0 ? F.x : F.out) + (size_t)m * 1024 : F.ctx + (size_t)(m - MX) * 1024; };
    int m = F.gw; if (m >= Ml) return;
    float4 nx[4]; uint2 nu[4];
#pragma unroll
    for (int j = 0; j < 4; ++j) { nx[j] = ((const float4*)rowsrc(m))[F.lane + 64 * j]; nu[j] = ((const uint2*)(F.UX + (size_t)m * 1024))[F.lane + 64 * j]; }
    while (m < Ml) {
        float* dst; int r;
        if (m < MX) { dst = F.out + (size_t)m * 1024; r = m / S; } else { dst = F.ctx1 + (size_t)(m - MX) * 1024; r = 8; }
        float4 pg[4], pt[4]; RowPar p2;
#pragma unroll
        for (int j = 0; j < 4; ++j) { const int d = 4 * (F.lane + 64 * j); pg[j] = *(const float4*)(g_post_l + d); pt[j] = *(const float4*)(mod_l + r * 3072 + 2048 + d); }
        if (l == 0) load_par(p2, F.g_pre + 1024, F.mod + (size_t)(9 + r) * 3072 + 1024, F.mod + (size_t)(9 + r) * 3072, F.lane);
        float4 xr[4], u[4]; float ss = 0.f;
#pragma unroll
        for (int j = 0; j < 4; ++j) { xr[j] = nx[j]; const uint2 w = nu[j];
            u[j].x = __uint_as_float(w.x << 16); u[j].y = __uint_as_float(w.x & 0xffff0000u); u[j].z = __uint_as_float(w.y << 16); u[j].w = __uint_as_float(w.y & 0xffff0000u);
            ss += u[j].x * u[j].x + u[j].y * u[j].y + u[j].z * u[j].z + u[j].w * u[j].w; }
        const int mn = m + F.NGW;
        if (mn < Ml) {
#pragma unroll
            for (int j = 0; j < 4; ++j) { nx[j] = ((const float4*)rowsrc(mn))[F.lane + 64 * j]; nu[j] = ((const uint2*)(F.UX + (size_t)mn * 1024))[F.lane + 64 * j]; } }
        ss = wave_sum(ss);
        const float rinv = 1.f / sqrtf(ss * (1.f / 1024.f) + EPS);
        float ss2 = 0.f;
#pragma unroll
        for (int j = 0; j < 4; ++j) {
            const int d = 4 * (F.lane + 64 * j);
            const float4 g = pg[j], t = pt[j], xv = xr[j];
            float4 o; o.x = xv.x + t.x * (u[j].x * rinv * g.x); o.y = xv.y + t.y * (u[j].y * rinv * g.y); o.z = xv.z + t.z * (u[j].z * rinv * g.z); o.w = xv.w + t.w * (u[j].w * rinv * g.w);
            *(float4*)(dst + d) = o; u[j] = o; ss2 += o.x * o.x + o.y * o.y + o.z * o.z + o.w * o.w;
        }
        if (l == 0) { ss2 = wave_sum(ss2); prenorm_store(u, ss2, p2, F.hxy + (size_t)m * 1024, F.lane); }
        m = mn;
    }
}

__device__ __forceinline__ int seq_row(int b, int step, int dir) {
    if (step < CTX) { const int n = dir ? CTX - 1 - step : step; return MX + b * CTX + n; }
    int t = step - CTX; if (dir) t = S - 1 - t; return b * S + t;
}
#ifndef DUP_SUB
#define DUP_SUB 0
#endif

typedef short s16x4 __attribute__((ext_vector_type(4)));
typedef short v4i16_t __attribute__((ext_vector_type(4)));
__device__ __forceinline__ s16x4 tr_read(const LAS bf16* p) { return __builtin_bit_cast(s16x4, __builtin_amdgcn_ds_read_tr16_b64_v4i16((LAS v4i16_t*)p)); }
__device__ __forceinline__ bf16x8 tr_frag(const LAS bf16* T, int stride, int rowA, int rowB, int col0, int lane) {
    const int q = (lane >> 2) & 3, p = lane & 3;
    const s16x4 lo = tr_read(T + (rowA + q) * stride + col0 + 4 * p), hi = tr_read(T + (rowB + q) * stride + col0 + 4 * p);
    return (bf16x8){lo[0], lo[1], lo[2], lo[3], hi[0], hi[1], hi[2], hi[3]};
}
__device__ __forceinline__ bf16x8 rm_frag(const LAS bf16* T, int stride, int row, int k0) { return *(const LAS bf16x8*)(T + row * stride + k0); }
__device__ __forceinline__ f32x4 mfma16(bf16x8 a, bf16x8 b, f32x4 c) { return __builtin_amdgcn_mfma_f32_16x16x32_bf16(a, b, c, 0, 0, 0); }
typedef unsigned v2u __attribute__((ext_vector_type(2)));
typedef float f32x2 __attribute__((ext_vector_type(2)));
__device__ __forceinline__ void unpack8(const v4u w, float* f) {
    f[0] = __uint_as_float(w.x << 16); f[1] = __uint_as_float(w.x & 0xffff0000u); f[2] = __uint_as_float(w.y << 16); f[3] = __uint_as_float(w.y & 0xffff0000u);
    f[4] = __uint_as_float(w.z << 16); f[5] = __uint_as_float(w.z & 0xffff0000u); f[6] = __uint_as_float(w.w << 16); f[7] = __uint_as_float(w.w & 0xffff0000u);
}
__device__ __forceinline__ v4u pack8(const float* f) { v4u w; w.x = pk2(f[0], f[1]); w.y = pk2(f[2], f[3]); w.z = pk2(f[4], f[5]); w.w = pk2(f[6], f[7]); return w; }

#ifndef PROBE_ML
#define PROBE_ML 0
#endif
__device__ __forceinline__ float wave_scan_incl(float x) {
    int v = __float_as_int(x);
#define DPP_ADD(ctrl, rmask) v = __float_as_int(__int_as_float(v) + __int_as_float(__builtin_amdgcn_update_dpp(0, v, ctrl, rmask, 0xF, false)))
    DPP_ADD(0x111, 0xF); DPP_ADD(0x112, 0xF); DPP_ADD(0x114, 0xF); DPP_ADD(0x118, 0xF); DPP_ADD(0x142, 0xA); DPP_ADD(0x143, 0xC);
#undef DPP_ADD
    return __int_as_float(v);
}
#define LDS_FENCE() asm volatile("" ::: "memory")
namespace ml {
constexpr int QSTR = 104, VSTR = 120;
constexpr int OFF_QS = 0, OFF_KS = OFF_QS + 64 * QSTR * 2, OFF_VS = OFF_KS + 64 * QSTR * 2, OFF_CT = OFF_VS + 64 * VSTR * 2;
constexpr int OFF_HT = OFF_CT + 2 * 112 * QSTR * 2, OFF_DEN = OFF_HT + 64 * 100 * 4, OFF_ROPE = OFF_DEN + 256, OFF_END = OFF_ROPE + 64 * 24 * 8;
static_assert(OFF_END <= RING_BYTES && 6 * 7 * 64 * 16 <= OFF_HT, "mlstm LDS");
constexpr int ST_FLOATS = 96 * 112 + 16;
}
constexpr int NSEG = 4, SEGTOK = S / NSEG, SEGCH = SEGTOK / 64;
struct MlJob { int b, h, isctx, t0, nchunk; };

__device__ __forceinline__ void mlstm_dir(const Ctx& F, int l, const MlJob jb, int dir, int fold_r, int emit_slot, int mode, bf16* otmp, float* ST) {
    using namespace ml;
    int tid_ = F.tid; asm volatile("" : "+v"(tid_));
    const int w = __builtin_amdgcn_readfirstlane(tid_ >> 6);
    const bool tsel = (mode != 0) && !jb.isctx && l == 0;
    if (tsel) TS_START(F, 10);
    LAS bf16* QS = (LAS bf16*)(F.lds + OFF_QS); LAS bf16* KS = (LAS bf16*)(F.lds + OFF_KS); LAS bf16* VS = (LAS bf16*)(F.lds + OFF_VS);
    LAS bf16* CT0 = (LAS bf16*)(F.lds + OFF_CT); LAS float* HT = (LAS float*)(F.lds + OFF_HT); LAS float* DEN = (LAS float*)(F.lds + OFF_DEN);
    const LAS f32x2* ROPE = (const LAS f32x2*)(F.lds + OFF_ROPE);
    const int rowbase = jb.isctx ? MX + jb.b * CTX : jb.b * S;
    const int h = jb.h; const bf16* P = F.P;
    float* STd = ST + (size_t)(((jb.b * 4 + h) * 2 + dir) * 8) * ST_FLOATS;
    f32x4 Cst[7];
#pragma unroll
    for (int et = 0; et < 7; ++et) Cst[et] = (f32x4){0.f, 0.f, 0.f, 0.f};
    if (fold_r >= 0) {
        LAS f32x4* FOLD = (LAS f32x4*)(F.lds + OFF_QS);
        float wk[8];
        { float bs[8]; bs[0] = 0.f;
#pragma unroll
          for (int k = 1; k < NSEG; ++k) bs[k] = STd[(size_t)k * ST_FLOATS + 96 * 112];
          float run = 1.f;
#pragma unroll
          for (int k = NSEG - 1; k >= 0; --k) { wk[k] = (k <= fold_r) ? run : 0.f; run = (k >= 1 && k <= fold_r) ? run * __expf(bs[k]) : run; } }
#pragma unroll 2
        for (int p = tid_; p < 6 * 7 * 64; p += 512) {
            f32x4 v[8];
#pragma unroll
            for (int k = 0; k < NSEG; ++k) v[k] = *(const f32x4*)(STd + (size_t)k * ST_FLOATS + 4 * p);
            f32x4 acc = v[0] * wk[0];
#pragma unroll
            for (int k = 1; k < NSEG; ++k) acc += v[k] * wk[k];
            FOLD[p] = acc;
        }
        __syncthreads();
        if (w < 6) {
#pragma unroll
            for (int et = 0; et < 7; ++et) Cst[et] = FOLD[(w * 7 + et) * 64 + (tid_ & 63)];
        }
        __syncthreads();
    }
    asm volatile("" : "+v"(tid_));
    const int tid = tid_, lane = tid & 63, g = lane >> 4, c = lane & 15;
    float Btot = 0.f;
    for (int i = tid; i < 64 * 16; i += 512) { const int s = i >> 4, e = 96 + (i & 15); VS[s * VSTR + e] = (e == 96) ? (bf16)0x3F80 : (bf16)0; }
    if (w < 6) {
#pragma unroll
        for (int et = 0; et < 7; ++et) { v2u v; v.x = pk2(Cst[et][0], Cst[et][1]); v.y = pk2(Cst[et][2], Cst[et][3]); *(LAS v2u*)(CT0 + (16 * et + c) * QSTR + 16 * w + 4 * g) = v; }
    }
    const bool hasqk = tid < 384; const int qk_tok = tid / 6, qk_pi = tid % 6, qk_part = qk_pi / 3, qk_pp = qk_pi % 3, qk_d0 = 48 * qk_part + 8 * qk_pp;
    const int v1_tok = tid / 12, v1_pc = tid % 12; const bool hasv2 = tid < 256; const int v2_tok = (512 + tid) / 12, v2_pc = (512 + tid) % 12;
    struct LoadSet { v4u q0, q1, k0, k1, v1, v2; float ig, lf; };
    LoadSet LA, LB;
    v2u ft[3], fo[3], fz[3];
    const int fi_i = tid >> 3, fi_e0 = 12 * (tid & 7);
#pragma unroll
    for (int q4 = 0; q4 < 3; ++q4) { ft[q4] = (v2u){0u, 0u}; fo[q4] = (v2u){0u, 0u}; fz[q4] = (v2u){0u, 0u}; }
    LA.q0 = LA.q1 = LA.k0 = LA.k1 = LA.v1 = LA.v2 = (v4u){0u, 0u, 0u, 0u}; LA.ig = LA.lf = 0.f; LB = LA;
    auto tok_of = [&](int ci, int i) -> int { return dir == 0 ? jb.t0 + 64 * ci + i : jb.t0 + 64 * (jb.nchunk - 1 - ci) + (63 - i); };
    auto issue_loads = [&](LoadSet& L, int ci) {
        if (hasqk) { const bf16* pr = P + (size_t)(rowbase + tok_of(ci, qk_tok)) * PLD + h * 96 + qk_d0;
            if (mode != 0) { L.q0 = *(const v4u*)(pr + B_Q); L.q1 = *(const v4u*)(pr + B_Q + 24); }
            L.k0 = *(const v4u*)(pr + B_K); L.k1 = *(const v4u*)(pr + B_K + 24); }
        L.v1 = *(const v4u*)(P + (size_t)(rowbase + tok_of(ci, v1_tok)) * PLD + B_V + h * 96 + 8 * v1_pc);
        if (hasv2) L.v2 = *(const v4u*)(P + (size_t)(rowbase + tok_of(ci, v2_tok)) * PLD + B_V + h * 96 + 8 * v2_pc);
        const float* gp = F.gates + (size_t)(rowbase + tok_of(ci, lane)) * 16 + dir * 4 + h; L.ig = gp[0]; L.lf = gp[8];
    };
    auto issue_fin = [&](int ci) {
        const int m = rowbase + tok_of(ci, fi_i); const bf16* tp = otmp + (size_t)m * 384 + h * 96 + fi_e0; const bf16* pr = P + (size_t)m * PLD + h * 96 + fi_e0;
#pragma unroll
        for (int q4 = 0; q4 < 3; ++q4) { ft[q4] = *(const v2u*)(tp + 4 * q4); fo[q4] = *(const v2u*)(pr + B_O + 4 * q4); fz[q4] = *(const v2u*)(pr + B_Z + 4 * q4); }
    };
    auto finalize = [&](int ci) {
            const int i = tid >> 3, sub = tid & 7, e0 = 12 * sub; const int m = rowbase + tok_of(ci, i);
            float hv[12]; const float rden = 1.f / fmaxf(fabsf(DEN[i]), 1.f);
#pragma unroll
            for (int q4 = 0; q4 < 3; ++q4) { const f32x4 v = *(const LAS f32x4*)(HT + i * 100 + e0 + 4 * q4); hv[4 * q4] = v[0] * rden; hv[4 * q4 + 1] = v[1] * rden; hv[4 * q4 + 2] = v[2] * rden; hv[4 * q4 + 3] = v[3] * rden; }
            bf16* tp = otmp + (size_t)m * 384 + h * 96 + e0;
            if (mode == 1) {
#pragma unroll
                for (int q4 = 0; q4 < 3; ++q4) { v2u v; v.x = pk2(hv[4 * q4], hv[4 * q4 + 1]); v.y = pk2(hv[4 * q4 + 2], hv[4 * q4 + 3]); *(v2u*)(tp + 4 * q4) = v; }
            } else {
                float ss = 0.f;
#pragma unroll
                for (int q4 = 0; q4 < 3; ++q4) { const v2u v = ft[q4];
                    hv[4 * q4] += __uint_as_float(v.x << 16); hv[4 * q4 + 1] += __uint_as_float(v.x & 0xffff0000u); hv[4 * q4 + 2] += __uint_as_float(v.y << 16); hv[4 * q4 + 3] += __uint_as_float(v.y & 0xffff0000u); }
#pragma unroll
                for (int e = 0; e < 12; ++e) ss += hv[e] * hv[e];
                ss += __shfl_xor(ss, 1); ss += __shfl_xor(ss, 2); ss += __shfl_xor(ss, 4);
                const float rinv = 1.f / sqrtf(ss * (1.f / 96.f) + EPS);
                bf16* yp = F.hxy + (size_t)m * 1024 + 256 + h * 96 + e0; const float* gnv = F.mlstm_gn + l * 384 + h * 96 + e0;
#pragma unroll
                for (int q4 = 0; q4 < 3; ++q4) { const v2u ov = fo[q4], zv = fz[q4];
                    const float og[4] = {__uint_as_float(ov.x << 16), __uint_as_float(ov.x & 0xffff0000u), __uint_as_float(ov.y << 16), __uint_as_float(ov.y & 0xffff0000u)};
                    const float zg[4] = {__uint_as_float(zv.x << 16), __uint_as_float(zv.x & 0xffff0000u), __uint_as_float(zv.y << 16), __uint_as_float(zv.y & 0xffff0000u)};
                    float o[4];
#pragma unroll
                    for (int e = 0; e < 4; ++e) o[e] = og[e] * (hv[4 * q4 + e] * rinv * gnv[4 * q4 + e]) * zg[e];
                    v2u v; v.x = pk2(o[0], o[1]); v.y = pk2(o[2], o[3]); *(v2u*)(yp + 4 * q4) = v; }
            }
    };
    issue_loads(LA, 0); if (jb.nchunk > 1) issue_loads(LB, 1);
    __syncthreads();
    if (tsel) TS_STOP(F, 10);
    auto chunk_step = [&](LoadSet& L, int ci) {
        if (tsel) TS_START(F, 11);
        LAS bf16* CTc = CT0 + (ci & 1) * 112 * QSTR; LAS bf16* CTn = CT0 + ((ci + 1) & 1) * 112 * QSTR;
        const float bcs = wave_scan_incl(L.lf);
        const float qsc = __expf(bcs), ksc = __expf(L.ig - bcs);
        const float bL = rdlane(bcs, 63), ebL = __expf(bL);
        for (int rep_ = 0; rep_ < (PROBE_ML == 1 ? 2 : 1); ++rep_)
        if (hasqk) {
            const float ks_t = __shfl(ksc, qk_tok), qs_t = __shfl(qsc, qk_tok);
            float cs[8], sn[8];
            if (!jb.isctx) { const int t = tok_of(ci, qk_tok); const int pos = qk_part ? (t & 63) : (t >> 6);
#pragma unroll
                for (int e = 0; e < 8; ++e) { const f32x2 v = ROPE[pos * 24 + 8 * qk_pp + e]; cs[e] = v[0]; sn[e] = v[1]; } }
            else {
#pragma unroll
                for (int e = 0; e < 8; ++e) { cs[e] = 1.f; sn[e] = 0.f; } }
            float a[8], b2[8], o0[8], o1[8];
            unpack8(L.k0, a); unpack8(L.k1, b2);
#pragma unroll
            for (int e = 0; e < 8; ++e) { o0[e] = (a[e] * cs[e] - b2[e] * sn[e]) * ks_t; o1[e] = (b2[e] * cs[e] + a[e] * sn[e]) * ks_t; }
            *(LAS v4u*)(KS + qk_tok * QSTR + qk_d0) = pack8(o0); *(LAS v4u*)(KS + qk_tok * QSTR + qk_d0 + 24) = pack8(o1);
            if (mode != 0) {
                unpack8(L.q0, a); unpack8(L.q1, b2);
#pragma unroll
                for (int e = 0; e < 8; ++e) { o0[e] = (a[e] * cs[e] - b2[e] * sn[e]) * qs_t; o1[e] = (b2[e] * cs[e] + a[e] * sn[e]) * qs_t; }
                *(LAS v4u*)(QS + qk_tok * QSTR + qk_d0) = pack8(o0); *(LAS v4u*)(QS + qk_tok * QSTR + qk_d0 + 24) = pack8(o1);
            }
        } else { (void)__shfl(ksc, 0); (void)__shfl(qsc, 0); }
        *(LAS v4u*)(VS + v1_tok * VSTR + 8 * v1_pc) = L.v1;
        if (hasv2) *(LAS v4u*)(VS + v2_tok * VSTR + 8 * v2_pc) = L.v2;
        if (mode == 2 && ci > 0) { finalize(ci - 1); if (PROBE_ML == 4) finalize(ci - 1); }
        if (ci + 2 < jb.nchunk) issue_loads(L, ci + 2);
        if (tsel) { TS_STOP(F, 11); TS_START(F, 12); }
        __syncthreads();
        if (tsel) { TS_STOP(F, 12); TS_START(F, 13); }
        for (int rep_ = 0; rep_ < (PROBE_ML == 2 ? 2 : 1); ++rep_)
        if (mode != 0) {
            const int tt = w & 3, jh = w >> 2;
            bf16x8 qf[3], kf[4][3];
#pragma unroll
            for (int ks = 0; ks < 3; ++ks) qf[ks] = rm_frag(QS, QSTR, 16 * tt + c, 32 * ks + 8 * g);
#pragma unroll
            for (int ss = 0; ss < 4; ++ss) if (ss <= tt) {
#pragma unroll
                for (int ks = 0; ks < 3; ++ks) kf[ss][ks] = rm_frag(KS, QSTR, 16 * ss + c, 32 * ks + 8 * g); }
            LDS_FENCE();
            f32x4 st[4];
#pragma unroll
            for (int ss = 0; ss < 4; ++ss) { st[ss] = (f32x4){0.f, 0.f, 0.f, 0.f};
                if (ss <= tt) {
#pragma unroll
                    for (int ks = 0; ks < 3; ++ks) st[ss] = mfma16(kf[ss][ks], qf[ks], st[ss]);
                    if (ss == tt) {
#pragma unroll
                        for (int r = 0; r < 4; ++r) if (4 * g + r > c) st[ss][r] = 0.f; }
                } }
            bf16x8 pf[2];
#pragma unroll
            for (int kk = 0; kk < 2; ++kk) { const unsigned u0 = pk2(st[2 * kk][0], st[2 * kk][1]), u1 = pk2(st[2 * kk][2], st[2 * kk][3]), u2 = pk2(st[2 * kk + 1][0], st[2 * kk + 1][1]), u3 = pk2(st[2 * kk + 1][2], st[2 * kk + 1][3]);
                pf[kk] = __builtin_bit_cast(bf16x8, (v4u){u0, u1, u2, u3}); }
#pragma unroll
            for (int eb = 0; eb < 4; eb += 2) {
                bf16x8 vf[2][2], cf[2][3];
#pragma unroll
                for (int e2 = 0; e2 < 2; ++e2) { const int et = 4 * jh + eb + e2;
                    if (et < 7) {
#pragma unroll
                        for (int kk = 0; kk < 2; ++kk) if (2 * kk <= tt) vf[e2][kk] = tr_frag(VS, VSTR, 32 * kk + 4 * g, 32 * kk + 16 + 4 * g, 16 * et, lane);
#pragma unroll
                        for (int ks = 0; ks < 3; ++ks) cf[e2][ks] = rm_frag(CTc, QSTR, 16 * et + c, 32 * ks + 8 * g); } }
                LDS_FENCE();
#pragma unroll
                for (int e2 = 0; e2 < 2; ++e2) { const int et = 4 * jh + eb + e2;
                    if (et < 7) {
                        f32x4 acc = (f32x4){0.f, 0.f, 0.f, 0.f};
#pragma unroll
                        for (int kk = 0; kk < 2; ++kk) if (2 * kk <= tt) acc = mfma16(vf[e2][kk], pf[kk], acc);
#pragma unroll
                        for (int ks = 0; ks < 3; ++ks) acc = mfma16(cf[e2][ks], qf[ks], acc);
                        if (et < 6) *(LAS f32x4*)(HT + (16 * tt + c) * 100 + 16 * et + 4 * g) = acc;
                        else if (g == 0) DEN[16 * tt + c] = acc[0];
                    } }
            }
        }
        if (w < 6) {
#pragma unroll
            for (int kk = 0; kk < 2; ++kk) {
                bf16x8 vf[7]; const bf16x8 af = tr_frag(KS, QSTR, 32 * kk + 8 * g, 32 * kk + 8 * g + 4, 16 * w, lane);
#pragma unroll
                for (int et = 0; et < 7; ++et) vf[et] = tr_frag(VS, VSTR, 32 * kk + 8 * g, 32 * kk + 8 * g + 4, 16 * et, lane);
                LDS_FENCE();
#pragma unroll
                for (int et = 0; et < 7; ++et) Cst[et] = mfma16(af, vf[et], Cst[et]);
            }
#pragma unroll
            for (int et = 0; et < 7; ++et) { Cst[et] = Cst[et] * ebL;
                if (mode != 0) { v2u v; v.x = pk2(Cst[et][0], Cst[et][1]); v.y = pk2(Cst[et][2], Cst[et][3]); *(LAS v2u*)(CTn + (16 * et + c) * QSTR + 16 * w + 4 * g) = v; } }
        }
        Btot += bL;
        if (PROBE_ML == 3) { __syncthreads(); __syncthreads(); }
        if (tsel) { TS_STOP(F, 13); TS_START(F, 14); }
        __syncthreads();
        if (tsel) { TS_STOP(F, 14); TS_START(F, 15); }
        if (mode == 1) { finalize(ci); if (PROBE_ML == 4) finalize(ci); } else if (mode == 2) issue_fin(ci);
        if (tsel) TS_STOP(F, 15);
    };
    for (int ci = 0; ci < jb.nchunk; ci += 2) { chunk_step(LA, ci); chunk_step(LB, ci + 1); }
    if (mode == 2) finalize(jb.nchunk - 1);
    if (emit_slot >= 0 && w < 6) {
        float* sl = STd + (size_t)emit_slot * ST_FLOATS;
#pragma unroll
        for (int et = 0; et < 7; ++et) *(f32x4*)(sl + ((w * 7 + et) * 64 + lane) * 4) = Cst[et];
        if (w == 0 && lane == 0) sl[96 * 112] = Btot;
    }
    __syncthreads();
}
__device__ __forceinline__ void mlstm_load_rope(const Ctx& F, const float* rope_tab) {
    LAS f32x2* ROPE = (LAS f32x2*)(F.lds + ml::OFF_ROPE);
    for (int i = F.tid; i < 64 * 24; i += 512) ROPE[i] = ((const f32x2*)rope_tab)[i];
}
__device__ __forceinline__ void mlstm_itemA(const Ctx& F, int l, int bh, int it, bf16* otmp, float* ST) {
    const int b = bh >> 2, h = bh & 3;
    if (it == 0) {
        const MlJob jb{b, h, 1, 0, 4};
        mlstm_dir(F, l, jb, 0, -1, 0, l == 0 ? 1 : 0, otmp, ST);
        mlstm_dir(F, l, jb, 1, -1, 0, l == 0 ? 2 : 0, otmp, ST);
    } else {
        const int dir = (it - 1) / (NSEG - 1), k = (it - 1) % (NSEG - 1), seg = dir == 0 ? k : NSEG - 1 - k;
        const MlJob jb{b, h, 0, SEGTOK * seg, SEGCH};
        mlstm_dir(F, l, jb, dir, -1, 1 + k, 0, otmp, ST);
    }
}
__device__ __forceinline__ void mlstm_itemC(const Ctx& F, int l, int bh, int seg, bf16* otmp, float* ST) {
    const MlJob jb{bh >> 2, bh & 3, 0, SEGTOK * seg, SEGCH};
    mlstm_dir(F, l, jb, 0, seg, -1, 1, otmp, ST);
    mlstm_dir(F, l, jb, 1, NSEG - 1 - seg, -1, 2, otmp, ST);
}

namespace hg {
constexpr int STR = 72;
constexpr int IMG = 64 * STR * 2;
constexpr int OFF_KO = 0, OFF_KH = IMG, OFF_VS = 2 * IMG, OFF_QJ = 3 * IMG, OFF_ST = 7 * IMG, OFF_HT = 9 * IMG, OFF_TOT = OFF_HT + 64 * 68 * 4, OFF_BL = OFF_TOT + 8 * 64 * 4, OFF_END = OFF_BL + 512;
static_assert(OFF_END <= RING_BYTES, "hgrn LDS");
constexpr int ST_FLOATS = 64 * 64 + 64;
}
__device__ __forceinline__ void hgrn_dir(const Ctx& F, int l, const MlJob jb, int dir, int fold_r, int emit_slot, int mode, bf16* otmp, float* ST) {
    using namespace hg;
    int tid_ = F.tid; asm volatile("" : "+v"(tid_));
    const int tid = tid_, lane = tid & 63, w = __builtin_amdgcn_readfirstlane(tid >> 6), g = lane >> 4, c = lane & 15;
    LAS bf16* KO = (LAS bf16*)(F.lds + OFF_KO); LAS bf16* KH = (LAS bf16*)(F.lds + OFF_KH); LAS bf16* VS = (LAS bf16*)(F.lds + OFF_VS); LAS bf16* QJ = (LAS bf16*)(F.lds + OFF_QJ);
    LAS bf16* ST0 = (LAS bf16*)(F.lds + OFF_ST); LAS float* HT = (LAS float*)(F.lds + OFF_HT); LAS float* TOT = (LAS float*)(F.lds + OFF_TOT); LAS float* BL = (LAS float*)(F.lds + OFF_BL);
    const int rowbase = jb.isctx ? MX + jb.b * CTX : jb.b * S;
    const int h = jb.h; const bf16* P = F.P;
    float* STd = ST + (size_t)(((jb.b * 4 + h) * 2 + dir) * 8) * ST_FLOATS;
    const int dt = w >> 1, et0 = 2 * (w & 1);
    f32x4 Sst[2]; float Btot[4];
#pragma unroll
    for (int i = 0; i < 2; ++i) Sst[i] = (f32x4){0.f, 0.f, 0.f, 0.f};
#pragma unroll
    for (int r = 0; r < 4; ++r) Btot[r] = 0.f;
    if (fold_r >= 0) {
        f32x4 v[8][2], dk[8];
#pragma unroll
        for (int k = 0; k < NSEG; ++k) { const float* sl = STd + (size_t)k * ST_FLOATS; v[k][0] = *(const f32x4*)(sl + ((w * 2 + 0) * 64 + lane) * 4); v[k][1] = *(const f32x4*)(sl + ((w * 2 + 1) * 64 + lane) * 4);
            dk[k] = *(const f32x4*)(sl + 64 * 64 + 16 * dt + 4 * g); }
        f32x4 run = (f32x4){1.f, 1.f, 1.f, 1.f};
#pragma unroll
        for (int k = NSEG - 1; k >= 0; --k) { const float on = (k <= fold_r) ? 1.f : 0.f; Sst[0] += v[k][0] * (run * on); Sst[1] += v[k][1] * (run * on);
            if (k >= 1) { const bool use = k <= fold_r; run[0] *= use ? __expf(dk[k][0]) : 1.f; run[1] *= use ? __expf(dk[k][1]) : 1.f; run[2] *= use ? __expf(dk[k][2]) : 1.f; run[3] *= use ? __expf(dk[k][3]) : 1.f; } }
    }
    if (mode != 0) {
#pragma unroll
        for (int i = 0; i < 2; ++i) { v2u v; v.x = pk2(Sst[i][0], Sst[i][1]); v.y = pk2(Sst[i][2], Sst[i][3]); *(LAS v2u*)(ST0 + (16 * (et0 + i) + c) * STR + 16 * dt + 4 * g) = v; }
    }
    const int ps = tid >> 3, oct = tid & 7, d0 = 8 * oct;
    float lbv[8];
#pragma unroll
    for (int e = 0; e < 8; ++e) { lbv[e] = 0.f;
        if (l == 1) { const float v0 = F.hgrn_lb[(0 * 2 + dir) * 256 + h * 64 + d0 + e], v1 = F.hgrn_lb[(1 * 2 + dir) * 256 + h * 64 + d0 + e]; lbv[e] = 1.f / (1.f + expf(v0 - v1)); } }
    const int fcol = dir ? A_FB : A_FF;
    auto tok_of = [&](int ci, int i) -> int { return dir == 0 ? jb.t0 + 64 * ci + i : jb.t0 + 64 * (jb.nchunk - 1 - ci) + (63 - i); };
    v4u rq, rf, rv; rq = rf = rv = (v4u){0u, 0u, 0u, 0u};
    v4u ft = (v4u){0u, 0u, 0u, 0u}, fz = (v4u){0u, 0u, 0u, 0u};
    const int fi_i = tid >> 3, fi_e0 = 8 * (tid & 7);
    float gnv[8];
#pragma unroll
    for (int e = 0; e < 8; ++e) gnv[e] = (mode == 2) ? F.hgrn_gn[l * 256 + h * 64 + fi_e0 + e] : 0.f;
    auto issue_loads = [&](int ci) {
        const bf16* pr = P + (size_t)(rowbase + tok_of(ci, ps)) * PLD + h * 64 + d0;
        if (mode != 0) rq = *(const v4u*)(pr + A_Q);
        rf = *(const v4u*)(pr + fcol); rv = *(const v4u*)(pr + A_I);
    };
    auto issue_fin = [&](int ci) { const int m = rowbase + tok_of(ci, fi_i); ft = *(const v4u*)(otmp + (size_t)m * 256 + h * 64 + fi_e0); fz = *(const v4u*)(P + (size_t)m * PLD + A_Z + h * 64 + fi_e0); };
    issue_loads(0);
    __syncthreads();
    for (int ci = 0; ci < jb.nchunk; ++ci) {
        LAS bf16* STc = ST0 + (ci & 1) * 64 * STR; LAS bf16* STn = ST0 + ((ci + 1) & 1) * 64 * STR;
        float qv[8], kk[8], bb[8], fl[8];
        unpack8(rf, fl);
#pragma unroll
        for (int e = 0; e < 8; ++e) { const float sg = sigmoid_f(fl[e]); const float f = lbv[e] + (1.f - lbv[e]) * sg; bb[e] = __logf(f); kk[e] = (1.f - lbv[e]) * (1.f - sg); }
        if (mode != 0) unpack8(rq, qv);
        const v4u vraw = rv;
        if (ci + 1 < jb.nchunk) issue_loads(ci + 1);
        if (mode == 2) issue_fin(ci);
#pragma unroll
        for (int o = 8; o < 64; o <<= 1) {
#pragma unroll
            for (int e = 0; e < 8; ++e) { const float t = __shfl_up(bb[e], o); if (lane >= o) bb[e] += t; } }
        if (lane >= 56) { *(LAS f32x4*)(TOT + w * 64 + d0) = (f32x4){bb[0], bb[1], bb[2], bb[3]}; *(LAS f32x4*)(TOT + w * 64 + d0 + 4) = (f32x4){bb[4], bb[5], bb[6], bb[7]}; }
        __syncthreads();
        {
            float run[8], pre[8], ref1[8], ref2[8], ref3[8];
#pragma unroll
            for (int e = 0; e < 8; ++e) { run[e] = 0.f; pre[e] = 0.f; ref1[e] = ref2[e] = ref3[e] = 0.f; }
#pragma unroll
            for (int ww = 0; ww < 8; ++ww) {
                if (ww == w) {
#pragma unroll
                    for (int e = 0; e < 8; ++e) pre[e] = run[e]; }
                if (ww == 2) {
#pragma unroll
                    for (int e = 0; e < 8; ++e) ref1[e] = run[e]; }
                if (ww == 4) {
#pragma unroll
                    for (int e = 0; e < 8; ++e) ref2[e] = run[e]; }
                if (ww == 6) {
#pragma unroll
                    for (int e = 0; e < 8; ++e) ref3[e] = run[e]; }
                const f32x4 t0 = *(const LAS f32x4*)(TOT + ww * 64 + d0), t1 = *(const LAS f32x4*)(TOT + ww * 64 + d0 + 4);
                run[0] += t0[0]; run[1] += t0[1]; run[2] += t0[2]; run[3] += t0[3]; run[4] += t1[0]; run[5] += t1[1]; run[6] += t1[2]; run[7] += t1[3];
            }
            const int sub = ps >> 4;
            float o8[8];
#pragma unroll
            for (int e = 0; e < 8; ++e) bb[e] += pre[e];
#pragma unroll
            for (int e = 0; e < 8; ++e) { const float rown = sub == 0 ? 0.f : (sub == 1 ? ref1[e] : (sub == 2 ? ref2[e] : ref3[e])); o8[e] = kk[e] * __expf(rown - bb[e]); }
            if (mode != 0) *(LAS v4u*)(KO + ps * STR + d0) = pack8(o8);
#pragma unroll
            for (int e = 0; e < 8; ++e) o8[e] = kk[e] * __expf(run[e] - bb[e]);
            *(LAS v4u*)(KH + ps * STR + d0) = pack8(o8);
            *(LAS v4u*)(VS + ps * STR + d0) = vraw;
            if (mode != 0) {
#pragma unroll
                for (int e = 0; e < 8; ++e) o8[e] = qv[e] * __expf(bb[e]);
                *(LAS v4u*)(QJ + ps * STR + d0) = pack8(o8);
                if (sub >= 1) {
#pragma unroll
                    for (int e = 0; e < 8; ++e) o8[e] = qv[e] * __expf(bb[e] - ref1[e]);
                    *(LAS v4u*)(QJ + (64 + ps) * STR + d0) = pack8(o8); }
                if (sub >= 2) {
#pragma unroll
                    for (int e = 0; e < 8; ++e) o8[e] = qv[e] * __expf(bb[e] - ref2[e]);
                    *(LAS v4u*)(QJ + (128 + ps) * STR + d0) = pack8(o8); }
                if (sub >= 3) {
#pragma unroll
                    for (int e = 0; e < 8; ++e) o8[e] = qv[e] * __expf(bb[e] - ref3[e]);
                    *(LAS v4u*)(QJ + (192 + ps) * STR + d0) = pack8(o8); }
            }
            if (ps == 0) { *(LAS f32x4*)(BL + d0) = (f32x4){run[0], run[1], run[2], run[3]}; *(LAS f32x4*)(BL + d0 + 4) = (f32x4){run[4], run[5], run[6], run[7]}; }
        }
        __syncthreads();
        if (mode != 0) {
            const int tt = w & 3, eh = w >> 2;
            f32x4 at[4];
            { bf16x8 kf[4][2], qjf[4][2];
#pragma unroll
              for (int j = 0; j < 4; ++j) if (j <= tt) {
#pragma unroll
                  for (int ks = 0; ks < 2; ++ks) { kf[j][ks] = rm_frag(KO, STR, 16 * j + c, 32 * ks + 8 * g); qjf[j][ks] = rm_frag(QJ + j * 64 * STR, STR, 16 * tt + c, 32 * ks + 8 * g); } }
              LDS_FENCE();
#pragma unroll
              for (int j = 0; j < 4; ++j) { at[j] = (f32x4){0.f, 0.f, 0.f, 0.f};
                  if (j <= tt) {
#pragma unroll
                      for (int ks = 0; ks < 2; ++ks) at[j] = mfma16(kf[j][ks], qjf[j][ks], at[j]);
                      if (j == tt) {
#pragma unroll
                          for (int r = 0; r < 4; ++r) if (4 * g + r > c) at[j][r] = 0.f; }
                  } } }
            bf16x8 pf[2];
#pragma unroll
            for (int k2 = 0; k2 < 2; ++k2) { const unsigned u0 = pk2(at[2 * k2][0], at[2 * k2][1]), u1 = pk2(at[2 * k2][2], at[2 * k2][3]), u2 = pk2(at[2 * k2 + 1][0], at[2 * k2 + 1][1]), u3 = pk2(at[2 * k2 + 1][2], at[2 * k2 + 1][3]);
                pf[k2] = __builtin_bit_cast(bf16x8, (v4u){u0, u1, u2, u3}); }
            { bf16x8 qf[2], vf[2][2], sf[2][2];
#pragma unroll
              for (int ks = 0; ks < 2; ++ks) qf[ks] = rm_frag(QJ, STR, 16 * tt + c, 32 * ks + 8 * g);
#pragma unroll
              for (int ei = 0; ei < 2; ++ei) { const int et = 2 * eh + ei;
#pragma unroll
                  for (int k2 = 0; k2 < 2; ++k2) if (2 * k2 <= tt) vf[ei][k2] = tr_frag(VS, STR, 32 * k2 + 4 * g, 32 * k2 + 16 + 4 * g, 16 * et, lane);
#pragma unroll
                  for (int ks = 0; ks < 2; ++ks) sf[ei][ks] = rm_frag(STc, STR, 16 * et + c, 32 * ks + 8 * g); }
              LDS_FENCE();
#pragma unroll
              for (int ei = 0; ei < 2; ++ei) { const int et = 2 * eh + ei;
                  f32x4 acc = (f32x4){0.f, 0.f, 0.f, 0.f};
#pragma unroll
                  for (int k2 = 0; k2 < 2; ++k2) if (2 * k2 <= tt) acc = mfma16(vf[ei][k2], pf[k2], acc);
#pragma unroll
                  for (int ks = 0; ks < 2; ++ks) acc = mfma16(sf[ei][ks], qf[ks], acc);
                  *(LAS f32x4*)(HT + (16 * tt + c) * 68 + 16 * et + 4 * g) = acc; } }
        }
        {
            const f32x4 blv = *(const LAS f32x4*)(BL + 16 * dt + 4 * g);
#pragma unroll
            for (int r = 0; r < 4; ++r) { const float dec = __expf(blv[r]); Sst[0][r] *= dec; Sst[1][r] *= dec; Btot[r] += blv[r]; }
            { bf16x8 af[2], vf[2][2];
#pragma unroll
              for (int k2 = 0; k2 < 2; ++k2) { af[k2] = tr_frag(KH, STR, 32 * k2 + 8 * g, 32 * k2 + 8 * g + 4, 16 * dt, lane);
#pragma unroll
                  for (int i = 0; i < 2; ++i) vf[k2][i] = tr_frag(VS, STR, 32 * k2 + 8 * g, 32 * k2 + 8 * g + 4, 16 * (et0 + i), lane); }
              LDS_FENCE();
#pragma unroll
              for (int k2 = 0; k2 < 2; ++k2)
#pragma unroll
                  for (int i = 0; i < 2; ++i) Sst[i] = mfma16(af[k2], vf[k2][i], Sst[i]); }
            if (mode != 0) {
#pragma unroll
                for (int i = 0; i < 2; ++i) { v2u v; v.x = pk2(Sst[i][0], Sst[i][1]); v.y = pk2(Sst[i][2], Sst[i][3]); *(LAS v2u*)(STn + (16 * (et0 + i) + c) * STR + 16 * dt + 4 * g) = v; } }
        }
        __syncthreads();
        if (mode != 0) {
            const int i = tid >> 3, sub8 = tid & 7, e0 = 8 * sub8; const int m = rowbase + tok_of(ci, i);
            float hv[8];
            { const f32x4 a0 = *(const LAS f32x4*)(HT + i * 68 + e0), a1 = *(const LAS f32x4*)(HT + i * 68 + e0 + 4); hv[0] = a0[0]; hv[1] = a0[1]; hv[2] = a0[2]; hv[3] = a0[3]; hv[4] = a1[0]; hv[5] = a1[1]; hv[6] = a1[2]; hv[7] = a1[3]; }
            bf16* tp = otmp + (size_t)m * 256 + h * 64 + e0;
            if (mode == 1) *(v4u*)tp = pack8(hv);
            else {
                float tv[8]; unpack8(ft, tv);
                float ss = 0.f;
#pragma unroll
                for (int e = 0; e < 8; ++e) { hv[e] += tv[e]; ss += hv[e] * hv[e]; }
                ss += __shfl_xor(ss, 1); ss += __shfl_xor(ss, 2); ss += __shfl_xor(ss, 4);
                const float rinv = 1.f / sqrtf(ss * (1.f / 64.f) + EPS);
                float zv[8]; unpack8(fz, zv);
#pragma unroll
                for (int e = 0; e < 8; ++e) hv[e] = hv[e] * rinv * gnv[e] * zv[e];
                *(v4u*)(F.hxy + (size_t)m * 1024 + h * 64 + e0) = pack8(hv);
            }
        }
    }
    if (emit_slot >= 0) {
        float* sl = STd + (size_t)emit_slot * ST_FLOATS;
        *(f32x4*)(sl + ((w * 2 + 0) * 64 + lane) * 4) = Sst[0]; *(f32x4*)(sl + ((w * 2 + 1) * 64 + lane) * 4) = Sst[1];
        if ((w & 1) == 0 && c == 0) *(f32x4*)(sl + 64 * 64 + 16 * dt + 4 * g) = (f32x4){Btot[0], Btot[1], Btot[2], Btot[3]};
    }
    __syncthreads();
}
__device__ __forceinline__ void hgrn_itemA(const Ctx& F, int l, int bh, int it, bf16* otmp, float* ST) {
    const int b = bh >> 2, h = bh & 3;
    if (it == 0) {
        const MlJob jb{b, h, 1, 0, 4};
        hgrn_dir(F, l, jb, 0, -1, 0, l == 0 ? 1 : 0, otmp, ST);
        hgrn_dir(F, l, jb, 1, -1, 0, l == 0 ? 2 : 0, otmp, ST);
    } else {
        const int dir = (it - 1) / (NSEG - 1), k = (it - 1) % (NSEG - 1), seg = dir == 0 ? k : NSEG - 1 - k;
        const MlJob jb{b, h, 0, SEGTOK * seg, SEGCH};
        hgrn_dir(F, l, jb, dir, -1, 1 + k, 0, otmp, ST);
    }
}
__device__ __forceinline__ void hgrn_itemC(const Ctx& F, int l, int bh, int seg, bf16* otmp, float* ST) {
    const MlJob jb{bh >> 2, bh & 3, 0, SEGTOK * seg, SEGCH};
    hgrn_dir(F, l, jb, 0, seg, -1, 1, otmp, ST);
    hgrn_dir(F, l, jb, 1, NSEG - 1 - seg, -1, 2, otmp, ST);
}

namespace nat {
constexpr int STR = 72, IMG = 64 * STR * 2;
constexpr int OFF_K = 0, OFF_V = 2 * IMG, OFF_RPB = 4 * IMG, OFF_END = OFF_RPB + 2048;
static_assert(OFF_END <= RING_BYTES, "na LDS");
}
template <int CH, bool WIN>
__device__ __forceinline__ void na_block(const LAS bf16* Kc, const LAS bf16* Vc, const LAS float* RPB, const bf16x8 (&qf)[2][2], f32x4 (&oacc)[2][4], float (&mrun)[2], float (&lrun)[2],
                                         const int g, const int c, const int lane, const int dr, const int (&qcol)[2], const int (&csq)[2]) {
    constexpr int STR = nat::STR;
    constexpr int KLO[2] = {WIN ? (CH == 0 ? 0 : 1) : 0, WIN ? (CH == 0 ? 0 : 2) : 0}, KHI[2] = {WIN ? (CH == 0 ? 1 : 3) : 3, WIN ? (CH == 0 ? 2 : 3) : 3};
    constexpr int ULO = KLO[0] < KLO[1] ? KLO[0] : KLO[1], UHI = KHI[0] > KHI[1] ? KHI[0] : KHI[1];
    f32x4 st[2][4];
    { bf16x8 kf[4][2];
#pragma unroll
      for (int kt = ULO; kt <= UHI; ++kt)
#pragma unroll
          for (int ks = 0; ks < 2; ++ks) kf[kt][ks] = rm_frag(Kc, STR, 16 * kt + c, 32 * ks + 8 * g);
      LDS_FENCE();
#pragma unroll
      for (int qt = 0; qt < 2; ++qt)
#pragma unroll
          for (int kt = 0; kt < 4; ++kt) { st[qt][kt] = (f32x4){0.f, 0.f, 0.f, 0.f};
              if (kt >= KLO[qt] && kt <= KHI[qt]) {
#pragma unroll
                  for (int ks = 0; ks < 2; ++ks) st[qt][kt] = mfma16(kf[kt][ks], qf[qt][ks], st[qt][kt]); } } }
    if (WIN) {
#pragma unroll
        for (int qt = 0; qt < 2; ++qt) { const int boff = dr * 31 + 15 - qcol[qt];
#pragma unroll
            for (int kt = KLO[qt]; kt <= KHI[qt]; ++kt)
#pragma unroll
                for (int r = 0; r < 4; ++r) { const int kc = 16 * kt + 4 * g + r; const float bias = RPB[min(max(boff + kc, 0), 464)]; const float v = st[qt][kt][r] + bias; st[qt][kt][r] = ((unsigned)(kc - csq[qt]) < 16u) ? v : -1e30f; } }
    }
    float alpha[2]; bf16x8 pf[2][2];
#pragma unroll
    for (int qt = 0; qt < 2; ++qt) {
        float bm = -1e30f;
#pragma unroll
        for (int kt = KLO[qt]; kt <= KHI[qt]; ++kt)
#pragma unroll
            for (int r = 0; r < 4; ++r) bm = fmaxf(bm, st[qt][kt][r]);
        bm = xor32_max(xor16_max(bm));
        const float mnew = fmaxf(mrun[qt], bm); alpha[qt] = __builtin_amdgcn_exp2f(mrun[qt] - mnew); mrun[qt] = mnew;
        float ps = 0.f;
#pragma unroll
        for (int kt = KLO[qt]; kt <= KHI[qt]; ++kt)
#pragma unroll
            for (int r = 0; r < 4; ++r) { const float p = __builtin_amdgcn_exp2f(st[qt][kt][r] - mnew); st[qt][kt][r] = p; ps += p; }
        lrun[qt] = lrun[qt] * alpha[qt] + ps;
#pragma unroll
        for (int k2 = 0; k2 < 2; ++k2) { const unsigned u0 = pk2(st[qt][2 * k2][0], st[qt][2 * k2][1]), u1 = pk2(st[qt][2 * k2][2], st[qt][2 * k2][3]), u2 = pk2(st[qt][2 * k2 + 1][0], st[qt][2 * k2 + 1][1]), u3 = pk2(st[qt][2 * k2 + 1][2], st[qt][2 * k2 + 1][3]);
            pf[qt][k2] = __builtin_bit_cast(bf16x8, (v4u){u0, u1, u2, u3}); }
    }
    { bf16x8 vf[4][2];
#pragma unroll
      for (int dtl = 0; dtl < 4; ++dtl)
#pragma unroll
          for (int k2 = ULO / 2; k2 <= UHI / 2; ++k2) vf[dtl][k2] = tr_frag(Vc, STR, 32 * k2 + 4 * g, 32 * k2 + 16 + 4 * g, 16 * dtl, lane);
      LDS_FENCE();
#pragma unroll
      for (int qt = 0; qt < 2; ++qt)
#pragma unroll
          for (int dtl = 0; dtl < 4; ++dtl) { f32x4 a = oacc[qt][dtl] * alpha[qt];
#pragma unroll
              for (int k2 = KLO[qt] / 2; k2 <= KHI[qt] / 2; ++k2) a = mfma16(vf[dtl][k2], pf[qt][k2], a);
              oacc[qt][dtl] = a; } }
}
__device__ __forceinline__ void na_item(const Ctx& F, int l, int b, int h, int R0) {
    using namespace nat;
    int tid_ = F.tid; asm volatile("" : "+v"(tid_));
    const int tid = tid_, lane = tid & 63, w = __builtin_amdgcn_readfirstlane(tid >> 6), g = lane >> 4, c = lane & 15;
    LAS bf16* KT = (LAS bf16*)(F.lds + OFF_K); LAS bf16* VT = (LAS bf16*)(F.lds + OFF_V); LAS float* RPB = (LAS float*)(F.lds + OFF_RPB);
    const bf16* P = F.P; const bool lat = R0 >= 0;
    const int R = R0 + (w >> 1), ch = w & 1;
    const int rsR = min(max(R - 4, 0), 56);
    const int kr0 = lat ? min(max(R0 - 4, 0), 56) : 0;
    const int nwin = lat ? (min(max(R0 + 3 - 4, 0), 56) + 8 - kr0) : 0, nblk = nwin + 4;
    if (lat) for (int i = tid; i < 15 * 31; i += 512) RPB[i] = F.na_rpb[((size_t)l * 6 + h) * 465 + i] * 1.4426950408889634f;
    int mq[2]; bf16x8 qf[2][2]; int csq[2], qcol[2];
#pragma unroll
    for (int qt = 0; qt < 2; ++qt) {
        if (lat) { qcol[qt] = 32 * ch + 16 * qt + c; mq[qt] = b * S + R * 64 + qcol[qt]; } else { qcol[qt] = 0; mq[qt] = MX + b * CTX + 32 * w + 16 * qt + c; }
        csq[qt] = min(max(qcol[qt] - 8, 0), 48);
#pragma unroll
        for (int ks = 0; ks < 2; ++ks) qf[qt][ks] = *(const bf16x8*)(P + (size_t)mq[qt] * PLD + C_Q + h * 64 + 32 * ks + 8 * g);
    }
    f32x4 oacc[2][4]; float mrun[2], lrun[2];
#pragma unroll
    for (int qt = 0; qt < 2; ++qt) { mrun[qt] = -1e30f; lrun[qt] = 0.f;
#pragma unroll
        for (int dtl = 0; dtl < 4; ++dtl) oacc[qt][dtl] = (f32x4){0.f, 0.f, 0.f, 0.f}; }
    const int stok = tid >> 3, spc = tid & 7;
    auto blk_row = [&](int i) -> int { return i < nwin ? b * S + (kr0 + i) * 64 + stok : MX + b * CTX + 64 * (i - nwin) + stok; };
    v4u rk0, rv0, rk1, rv1, rk2, rv2;
    auto ld = [&](int i, v4u& k_, v4u& v_) { const int ii = i < nblk ? i : nblk - 1; const bf16* pr = P + (size_t)blk_row(ii) * PLD + h * 64 + 8 * spc; k_ = *(const v4u*)(pr + C_K); v_ = *(const v4u*)(pr + C_V); };
    ld(0, rk0, rv0); ld(1, rk1, rv1); ld(2, rk2, rv2);
    __syncthreads();
    *(LAS v4u*)(KT + stok * STR + 8 * spc) = rk0; *(LAS v4u*)(VT + stok * STR + 8 * spc) = rv0;
    ld(3, rk0, rv0);
    __syncthreads();
    auto step = [&](int i, v4u& kn, v4u& vn) {
        const LAS bf16* Kc = KT + (i & 1) * 64 * STR; const LAS bf16* Vc = VT + (i & 1) * 64 * STR;
        if (i + 1 < nblk) { LAS bf16* Kn = KT + ((i + 1) & 1) * 64 * STR; LAS bf16* Vn = VT + ((i + 1) & 1) * 64 * STR;
            *(LAS v4u*)(Kn + stok * STR + 8 * spc) = kn; *(LAS v4u*)(Vn + stok * STR + 8 * spc) = vn;
            if (i + 4 < nblk) ld(i + 4, kn, vn); }
        const bool win = i < nwin; const int kr = kr0 + i;
        const bool active = !win || (kr >= rsR && kr < rsR + 8);
        if (active) {
            if (!win) na_block<0, false>(Kc, Vc, RPB, qf, oacc, mrun, lrun, g, c, lane, 0, qcol, csq);
            else if (ch == 0) na_block<0, true>(Kc, Vc, RPB, qf, oacc, mrun, lrun, g, c, lane, kr - R + 7, qcol, csq);
            else na_block<1, true>(Kc, Vc, RPB, qf, oacc, mrun, lrun, g, c, lane, kr - R + 7, qcol, csq);
        }
        __syncthreads();
    };
    for (int i = 0; i < nblk; i += 3) { step(i, rk1, rv1); if (i + 1 < nblk) step(i + 1, rk2, rv2); if (i + 2 < nblk) step(i + 2, rk0, rv0); }
#pragma unroll
    for (int qt = 0; qt < 2; ++qt) {
        const float lt = xor32_sum(xor16_sum(lrun[qt]));
        const float rl = 1.f / lt;
        const bf16* zr = P + (size_t)mq[qt] * PLD + C_Z + h * 64; bf16* yr = F.hxy + (size_t)mq[qt] * 1024 + 640 + h * 64;
#pragma unroll
        for (int dtl = 0; dtl < 4; ++dtl) { const int d = 16 * dtl + 4 * g; const v2u zv = *(const v2u*)(zr + d);
            const float z0 = __uint_as_float(zv.x << 16), z1 = __uint_as_float(zv.x & 0xffff0000u), z2 = __uint_as_float(zv.y << 16), z3 = __uint_as_float(zv.y & 0xffff0000u);
            v2u o; o.x = pk2(oacc[qt][dtl][0] * rl * z0, oacc[qt][dtl][1] * rl * z1); o.y = pk2(oacc[qt][dtl][2] * rl * z2, oacc[qt][dtl][3] * rl * z3);
            *(v2u*)(yr + d) = o; }
    }
}

__device__ __forceinline__ void phase_mixA(const Ctx& F, int l, unsigned* ticket) {
    mlstm_load_rope(F, F.rope);
    volatile LAS unsigned* slot = (volatile LAS unsigned*)(F.lds + MISC_OFF) + 16;
    const int n_ctx = 64, n_na = 768, n_loc = 2 * 32 * 2 * (NSEG - 1), n_nactx = (l == 0) ? 48 : 0, n_all = n_ctx + n_na + n_loc + n_nactx;
    unsigned cur = 0;
    if (F.tid == 0) *slot = __hip_atomic_fetch_add(ticket, 1u, __ATOMIC_RELAXED, __HIP_MEMORY_SCOPE_AGENT);
    __syncthreads();
    cur = *slot;
    while ((int)cur < n_all) {
        unsigned nxt = 0;
        if (F.tid == 0) nxt = __hip_atomic_fetch_add(ticket, 1u, __ATOMIC_RELAXED, __HIP_MEMORY_SCOPE_AGENT);
        int it = (int)cur;
        const int tkind = it < n_ctx ? 22 : (it < n_ctx + n_na ? 20 : (it < n_ctx + n_na + n_loc ? (it < n_ctx + n_na + n_loc / 2 ? 21 : 23) : 24));
        if (l == 0) { TS_START(F, tkind); if (PROBE_T == 25 && blockIdx.x == 0 && F.tid == 0) TS_LDS(F)[0] += 2000; }
        if (it < n_ctx) { if (it < 32) mlstm_itemA(F, l, it, 0, F.otm, F.stm); else hgrn_itemA(F, l, it - 32, 0, F.oth, F.sth); }
        else if ((it -= n_ctx) < n_na) na_item(F, l, it / 96, (it / 16) % 6, 4 * (it % 16));
        else if ((it -= n_na) < n_loc) { constexpr int NL = 2 * (NSEG - 1); if (it < 32 * NL) mlstm_itemA(F, l, it / NL, 1 + it % NL, F.otm, F.stm); else { it -= 32 * NL; hgrn_itemA(F, l, it / NL, 1 + it % NL, F.oth, F.sth); } }
        else { it -= n_loc; na_item(F, l, it / 6, it % 6, -1); }
        if (l == 0) TS_STOP(F, tkind);
        __syncthreads();
        if (F.tid == 0) *slot = nxt;
        __syncthreads();
        cur = *slot;
    }
}
__device__ __forceinline__ void phase_mixC(const Ctx& F, int l) {
    mlstm_load_rope(F, F.rope);
    for (int it = F.vcu; it < 2 * 32 * NSEG; it += F.G) {
        if (it < 32 * NSEG) mlstm_itemC(F, l, it / NSEG, it % NSEG, F.otm, F.stm);
        else hgrn_itemC(F, l, (it - 32 * NSEG) / NSEG, it % NSEG, F.oth, F.sth);
    }
}

constexpr int NPH = 12;
struct Args { const float* in[15]; float* out; unsigned char* ws; int ph_lo, ph_hi; };
__global__ void __launch_bounds__(512, 2) mega_fwd(Args args) {
    extern __shared__ __attribute__((aligned(16))) unsigned char lds[];
    Ctx F;
    F.lds = (LAS unsigned char*)lds;
    F.tid = threadIdx.x; F.lane = F.tid & 63; F.wave = __builtin_amdgcn_readfirstlane(F.tid >> 6);
    F.G = gridDim.x; { const int bx = blockIdx.x; F.vcu = (F.G % 8 == 0) ? (bx % 8) * (F.G / 8) + bx / 8 : bx; }
    F.gw = F.vcu * 8 + F.wave; F.NGW = F.G * 8;
    unsigned char* ws = args.ws;
    F.x = args.in[0]; F.c = args.in[1]; F.ctx = args.in[2]; F.c_ctx = args.in[3]; F.w_mod = args.in[4]; F.b_mod = args.in[5]; F.g_pre = args.in[6]; F.g_post = args.in[7];
    F.w_in = args.in[8]; F.w_out = args.in[9]; F.hgrn_lb = args.in[10]; F.hgrn_gn = args.in[11]; F.gate_b = args.in[12]; F.mlstm_gn = args.in[13]; F.na_rpb = args.in[14];
    F.out = args.out;
    F.wt_in = (bf16*)(ws + WS_WT_IN); F.wt_out = (bf16*)(ws + WS_WT_OUT); F.mod = (float*)(ws + WS_MOD); F.gates = (float*)(ws + WS_GATES); F.ctx1 = (float*)(ws + WS_CTX1);
    F.hxy = (bf16*)(ws + WS_HXY); F.P = (bf16*)(ws + WS_P); F.UX = (bf16*)(ws + WS_P); F.oth = (bf16*)(ws + WS_OH); F.sth = (float*)(ws + WS_STH); F.otm = (bf16*)(ws + WS_OM); F.stm = (float*)(ws + WS_STM); F.rope = (float*)(ws + WS_ROPE);
    for (int u = F.tid; u < (LDS_BYTES - LDSCTL_OFF) / 4; u += 512) ((LAS unsigned*)(F.lds + LDSCTL_OFF))[u] = 0u;
    __syncthreads();
    XcdBarrier bar = xcd_barrier_post((unsigned*)(ws + WS_CTL) + CW_BAR, (volatile LAS unsigned*)(F.lds + MISC_OFF) + 8);

    const int lo = args.ph_lo, hi = args.ph_hi;
#ifndef DUP_PHASE
#define DUP_PHASE -1
#endif
#define IN(k) (lo <= (k) && (k) < hi)
#define SEAM(k) do { if ((k) + 1 < hi) xcd_barrier(bar); } while (0)
#define PHASE(k, ...) if (IN(k)) { TS_START(F, 100 + (k)); __VA_ARGS__; if ((k) == DUP_PHASE) { xcd_barrier(bar); __VA_ARGS__; } SEAM(k); TS_STOP(F, 100 + (k)); }
    PHASE(0, phase_p0(F))
    PHASE(1, { phase_prenorm0(F); phase_p1_transposes(F); })
#define LAYER(l) \
    PHASE(2 + 5 * (l), { \
        pg8::Gemm g{F.hxy, F.wt_in + (size_t)(l) * NPAD * 1024, M, NPAD, 1024}; \
        pg8::EpiIn E{F.P, F.gates, F.gate_b + (l) * 16}; \
        pg8::StaticOrder SO; SO.init(M, NPAD, F.G, (int)blockIdx.x); pg8::gemm_phase<pg8::EpiIn, pg8::StaticOrder, true, true>(F.lds + RING_OFF, g, SO, E); }) \
    PHASE(3 + 5 * (l), phase_mixA(F, (l), (unsigned*)(args.ws + WS_CTL) + 8192 + 64 * (l))) \
    PHASE(4 + 5 * (l), phase_mixC(F, (l))) \
    PHASE(5 + 5 * (l), { \
        constexpr int Ml = (l) == 0 ? M : MX; \
        pg8::Gemm g{F.hxy, F.wt_out + (size_t)(l) * 1024 * 1024, Ml, 1024, 1024}; pg8::StaticOrder SO; SO.init(Ml, 1024, F.G, (int)blockIdx.x); \
        pg8::EpiOut E{F.UX}; \
        pg8::gemm_phase<pg8::EpiOut, pg8::StaticOrder, true, true>(F.lds + RING_OFF, g, SO, E); }) \
    PHASE(6 + 5 * (l), phase_post(F, (l)))
    LAYER(0)
    LAYER(1)
#undef LAYER
#undef PHASE
#undef IN
#undef SEAM
    if (PROBE_T != 0 && blockIdx.x == 0 && F.tid == 0) { const unsigned long long t0 = __builtin_amdgcn_s_memtime(), dt = 8ull * TS_LDS(F)[0]; while (__builtin_amdgcn_s_memtime() - t0 < dt) __builtin_amdgcn_s_sleep(8); }
}

extern "C" void kernel_launch(void* const* d_in, const int* in_sizes, int n_in, void* d_out, int out_size, void* d_ws, size_t ws_size, hipStream_t stream) {
    static int grid = 0;
    if (grid == 0) {
        if (n_in != 15 || ws_size < WS_END) { fprintf(stderr, "kernel_launch: unexpected n_in %d / ws_size %zu (need %zu); nothing launched\n", n_in, ws_size, (size_t)WS_END); grid = -1; return; }
        int dev = 0, cus = 0, per_cu = 0;
        if (hipGetDevice(&dev) != hipSuccess || hipDeviceGetAttribute(&cus, hipDeviceAttributeMultiprocessorCount, dev) != hipSuccess) { grid = -1; return; }
        if (hipFuncSetAttribute((const void*)mega_fwd, hipFuncAttributeMaxDynamicSharedMemorySize, LDS_BYTES) != hipSuccess) { fprintf(stderr, "kernel_launch: hipFuncSetAttribute failed\n"); grid = -1; return; }
        if (hipOccupancyMaxActiveBlocksPerMultiprocessor(&per_cu, (const void*)mega_fwd, 512, LDS_BYTES) != hipSuccess || per_cu < 1) { fprintf(stderr, "kernel_launch: occupancy query says %d blocks/CU\n", per_cu); (void)hipGetLastError(); grid = -1; return; }
        grid = cus;
    }
    if (grid < 0) return;
    (void)hipMemsetAsync((char*)d_ws + WS_CTL, 0, CTL_BYTES, stream);
    Args a{};
    for (int i = 0; i < 15; ++i) a.in[i] = (const float*)d_in[i];
    a.out = (float*)d_out; a.ws = (unsigned char*)d_ws; a.ph_lo = 0; a.ph_hi = NPH;
    hipLaunchKernelGGL(mega_fwd, dim3(grid), dim3(512), LDS_BYTES, stream, a);
}
```

```cpp
#include <hip/hip_runtime.h>
#include <stdint.h>
#include <cstdio>

namespace cfg {
constexpr int D = 1024, NB = 8, S = 4096, CTX = 256;
constexpr int MX = NB * S, MC = NB * CTX, M = MX + MC;
constexpr int PIN = 4752, NPAD = 4864, PLD = 4736;
constexpr int A_Q = 0, A_FF = 256, A_FB = 512, A_I = 768, A_Z = 1024, B_Q = 1280, B_K = 1664, B_V = 2048, B_O = 2432, B_Z = 2816,
              C_Q = 3200, C_K = 3584, C_V = 3968, C_Z = 4352;
constexpr float EPS = 1e-6f;
constexpr size_t WS_CTL = 0, CTL_BYTES = 65536;
constexpr size_t WS_WT_IN = WS_CTL + CTL_BYTES;
constexpr size_t WS_WT_OUT = WS_WT_IN + 2ull * NPAD * 1024 * 2;
constexpr size_t WS_MOD = WS_WT_OUT + 2ull * 1024 * 1024 * 2;
constexpr size_t WS_GATES = WS_MOD + 2ull * 9 * 3072 * 4;
constexpr size_t WS_CTX1 = WS_GATES + (size_t)M * 16 * 4;
constexpr size_t WS_HXY = WS_CTX1 + (size_t)MC * 1024 * 4;
constexpr size_t WS_P = WS_HXY + (size_t)M * 1024 * 2;
constexpr size_t WS_OH = WS_P + (size_t)M * PLD * 2;
constexpr size_t WS_OM = WS_OH + (size_t)M * 256 * 4;
constexpr size_t WS_STM = WS_OM + (size_t)M * 384 * 2;
constexpr size_t WS_ROPE = WS_STM + 32ull * 2 * 8 * (96 * 112 + 16) * 4;
constexpr size_t WS_STH = WS_ROPE + 64 * 24 * 8;
constexpr size_t WS_END = WS_STH + 32ull * 2 * 8 * (64 * 64 + 64) * 4;
static_assert(WS_END <= 536870912ull, "workspace");
static_assert(WS_WT_IN % 256 == 0 && WS_MOD % 256 == 0 && WS_GATES % 256 == 0 && WS_CTX1 % 256 == 0 && WS_HXY % 256 == 0 && WS_P % 256 == 0 && WS_OH % 256 == 0 && WS_OM % 256 == 0 && WS_STM % 256 == 0 && WS_ROPE % 256 == 0 && WS_STH % 256 == 0, "align");
}
using namespace cfg;

namespace pg8 {
#define PG8_LAS __attribute__((address_space(3)))
typedef unsigned short bf16_t;
typedef short bf16x8 __attribute__((ext_vector_type(8)));
typedef float f32x4 __attribute__((ext_vector_type(4)));
typedef unsigned u32x4 __attribute__((ext_vector_type(4)));
constexpr int BM = 256, BK = 64, HALF = 128, HTB = HALF * BK * 2  , STAGE_BYTES = 8 * HTB, NXCD = 8, WGM = 8;

__host__ __device__ __forceinline__ int lds_byte(int r, int c) { const int st = (r >> 4) * 2 + (c >> 5), rr = r & 15, cc = c & 31, ob = rr * 64 + cc * 2; return st * 1024 + (ob ^ (((ob >> 9) & 1) << 5)); }
__host__ __device__ __forceinline__ void stage_rc(int b, int& R, int& C) { const int st = b / 1024, sb = b % 1024, swz = sb ^ (((sb >> 9) & 1) << 5); R = (st >> 1) * 16 + swz / 64; C = (st & 1) * 32 + (swz % 64) / 2; }
__host__ __device__ __forceinline__ int perm32(int rho) { const int n = rho >> 4, i = rho & 15; return 8 * (i >> 2) + 4 * n + (i & 3); }

struct Unit { int pm, pn; };
struct Gemm { const bf16_t* A; const bf16_t* Bt; int M, N, K; };

struct StaticOrder {
    int nM, nN, nwg, G, c;
    __host__ __device__ void init(int M, int N, int G_, int c_) { nM = M / BM; nN = N / BM; nwg = nM * nN; G = G_; c = c_; }
    __host__ __device__ bool next(int i, Unit& u) const {
        const long L = (long)i * G + c; if (L >= nwg) return false;
        int wgid = (int)L; { const int q = nwg / NXCD, r = nwg % NXCD, xcd = wgid % NXCD, off = wgid / NXCD; wgid = (xcd < r ? xcd * (q + 1) : r * (q + 1) + (xcd - r) * q) + off; }
        const int nig = WGM * nN, gid = wgid / nig, fm = gid * WGM, gsz = (nM - fm) < WGM ? (nM - fm) : WGM;
        u.pm = fm + ((wgid % nig) % gsz); u.pn = (wgid % nig) / gsz; return true;
    }
    __device__ __forceinline__ void a_ready(const Unit&) const {}
    __device__ __forceinline__ void done(const Unit&) const {}
};

__device__ __forceinline__ unsigned cvt_pk_bf16(float lo, float hi) { unsigned r; asm volatile("v_cvt_pk_bf16_f32 %0, %1, %2" : "=v"(r) : "v"(lo), "v"(hi)); return r; }
__device__ __forceinline__ float logsigmoid_e(float v) { return fminf(v, 0.f) - log1pf(__expf(-fabsf(v))); }

struct EpiIn {
    static constexpr bool PERM = true, AFTER_DRAIN = false;
    bf16_t* P; float* gates; const float* gate_b;
    __device__ __forceinline__ void operator()(const f32x4 (&acc)[2][2][4][2], const Unit& u, int wr, int wc, int fr, int fq) const {
        const int row0 = u.pm * BM + wr * 64 + fr, col0 = u.pn * BM + wc * 32 + 8 * fq;
#pragma unroll
        for (int bj = 0; bj < 2; ++bj) {
            const int col = col0 + bj * HALF;
            if (col < cfg::PLD) {
                const int act = col < 256 ? 1 : col < 1024 ? 0 : col < 1280 ? 2 : col < 1664 ? 3 : col < 2432 ? 0 : col < 2816 ? 4 : col < 3200 ? 2 : col < 3584 ? 5 : col < 4352 ? 0 : 2;
#pragma unroll
                for (int ai = 0; ai < 2; ++ai)
#pragma unroll
                    for (int m = 0; m < 4; ++m) { f32x4 v0 = acc[ai][bj][m][0], v1 = acc[ai][bj][m][1];
                        if (act == 1 || act == 2 || act == 4) { const float sc = act == 1 ? 0.125f : 1.f;
#pragma unroll
                            for (int e = 0; e < 4; ++e) { const float s0 = __builtin_amdgcn_rcpf(1.f + __expf(-v0[e])), s1 = __builtin_amdgcn_rcpf(1.f + __expf(-v1[e])); v0[e] = act == 4 ? s0 : v0[e] * s0 * sc; v1[e] = act == 4 ? s1 : v1[e] * s1 * sc; } }
                        else if (act == 3) { v0 = v0 * 0.10206207261596575f; v1 = v1 * 0.10206207261596575f; }
                        else if (act == 5) { v0 = v0 * (0.125f * 1.4426950408889634f); v1 = v1 * (0.125f * 1.4426950408889634f); }
                        u32x4 w; w.x = cvt_pk_bf16(v0[0], v0[1]); w.y = cvt_pk_bf16(v0[2], v0[3]); w.z = cvt_pk_bf16(v1[0], v1[1]); w.w = cvt_pk_bf16(v1[2], v1[3]);
                        *(u32x4*)(P + (size_t)(row0 + ai * HALF + m * 16) * cfg::PLD + col) = w; }
            } else if (col < cfg::PIN) {
                const int g0 = col - cfg::PLD;
                const f32x4 b0 = *(const f32x4*)(gate_b + g0), b1 = *(const f32x4*)(gate_b + g0 + 4);
#pragma unroll
                for (int ai = 0; ai < 2; ++ai)
#pragma unroll
                    for (int m = 0; m < 4; ++m) { f32x4 v0 = acc[ai][bj][m][0] + b0, v1 = acc[ai][bj][m][1] + b1;
                        if (g0 >= 8) {
#pragma unroll
                            for (int e = 0; e < 4; ++e) { v0[e] = logsigmoid_e(v0[e]); v1[e] = logsigmoid_e(v1[e]); } }
                        float* gp = gates + (size_t)(row0 + ai * HALF + m * 16) * 16 + g0;
                        *(f32x4*)gp = v0; *(f32x4*)(gp + 4) = v1; }
            }
        }
    }
};
struct EpiOut {
    static constexpr bool PERM = true, AFTER_DRAIN = false;
    bf16_t* C;
    __device__ __forceinline__ void operator()(const f32x4 (&acc)[2][2][4][2], const Unit& u, int wr, int wc, int fr, int fq) const {
        const int row0 = u.pm * BM + wr * 64 + fr, col0 = u.pn * BM + wc * 32 + 8 * fq;
#pragma unroll
        for (int ai = 0; ai < 2; ++ai)
#pragma unroll
            for (int m = 0; m < 4; ++m) { bf16_t* rowp = C + (size_t)(row0 + ai * HALF + m * 16) * 1024 + col0;
#pragma unroll
                for (int bj = 0; bj < 2; ++bj) { const f32x4 v0 = acc[ai][bj][m][0], v1 = acc[ai][bj][m][1];
                    u32x4 w; w.x = cvt_pk_bf16(v0[0], v0[1]); w.y = cvt_pk_bf16(v0[2], v0[3]); w.z = cvt_pk_bf16(v1[0], v1[1]); w.w = cvt_pk_bf16(v1[2], v1[3]);
                    *(u32x4*)(rowp + bj * HALF) = w; } }
    }
};

template <class Epi, class Sched, bool ALIGN_EPI = false, bool SP2 = false>
__device__ __forceinline__ void gemm_phase(PG8_LAS unsigned char* lds, const Gemm g, const Sched& S, const Epi& E) {
    const int tid = threadIdx.x, wid = __builtin_amdgcn_readfirstlane(tid >> 6), lane = tid & 63, wr = wid >> 2, wc = wid & 3, fr = lane & 15, fq = lane >> 4;
    const int K = g.K, nt = K / BK;
    unsigned voffA[2], voffB[2];
#pragma unroll
    for (int i = 0; i < 2; ++i) { int R, C; stage_rc(tid * 16 + i * 8192, R, C); const int Rb = Epi::PERM ? ((R & ~31) + perm32(R & 31)) : R;
        voffA[i] = (unsigned)(R * K + C) * 2u; voffB[i] = (unsigned)(Rb * K + C) * 2u; }
    const size_t kstep = (size_t)(BK * 2);
    const size_t hstep = (size_t)HALF * K * 2;
    const size_t tstep = 2 * hstep;
    const unsigned ldsw = (unsigned)wid * 1024u;
    const int aoff = lds_byte(wr * 64 + fr, fq * 8), boff = lds_byte(wc * 32 + fr, fq * 8);
#define PG8_SA(b, h) (((b) * 2 + (h)) * HTB)
#define PG8_SB(b, h) ((4 + (b) * 2 + (h)) * HTB)
#define PG8_STAGE(bufoff, gbase, voff) do { _Pragma("unroll") for (int _i = 0; _i < 2; ++_i) \
        __builtin_amdgcn_global_load_lds((const unsigned*)((const char*)(gbase) + (voff)[_i]), (PG8_LAS unsigned*)(lds + (bufoff) + ldsw + _i * 8192), 16, 0, 0); } while (0)
#define PG8_LDA(dst, b, h) do { _Pragma("unroll") for (int m = 0; m < 4; ++m) _Pragma("unroll") for (int k = 0; k < 2; ++k) dst[m][k] = *(const PG8_LAS bf16x8*)(lds + PG8_SA(b, h) + aoff + m * 2048 + k * 1024); } while (0)
#define PG8_LDB(dst, b, h) do { _Pragma("unroll") for (int n = 0; n < 2; ++n) _Pragma("unroll") for (int k = 0; k < 2; ++k) dst[n][k] = *(const PG8_LAS bf16x8*)(lds + PG8_SB(b, h) + boff + n * 2048 + k * 1024); } while (0)
#define PG8_MMA(ai, bj, At, Bt) do { __builtin_amdgcn_s_setprio(1); _Pragma("unroll") for (int m = 0; m < 4; ++m) _Pragma("unroll") for (int n = 0; n < 2; ++n) _Pragma("unroll") for (int k = 0; k < 2; ++k) \
        acc[ai][bj][m][n] = __builtin_amdgcn_mfma_f32_16x16x32_bf16(Bt[n][k], At[m][k], acc[ai][bj][m][n], 0, 0, 0); __builtin_amdgcn_s_setprio(0); } while (0)
#define PG8_WAIT_V(n) asm volatile("s_waitcnt vmcnt(" #n ")" ::: "memory")
#define PG8_WAIT_L(n) asm volatile("s_waitcnt lgkmcnt(" #n ")" ::: "memory")
#define PG8_BAR __builtin_amdgcn_s_barrier()
#define PG8_SCHED __builtin_amdgcn_sched_barrier(0)
    Unit cur, nxt; int ui = 0;
    if (!S.next(0, cur)) return;
    f32x4 acc[2][2][4][2];
#pragma unroll
    for (int a = 0; a < 2; ++a)
#pragma unroll
        for (int b = 0; b < 2; ++b)
#pragma unroll
            for (int m = 0; m < 4; ++m)
#pragma unroll
                for (int n = 0; n < 2; ++n) acc[a][b][m][n] = (f32x4){0.f, 0.f, 0.f, 0.f};
    bf16x8 At[4][2], B0[2][2], B1[2][2];
    const char* cA = (const char*)g.A + (size_t)cur.pm * tstep; const char* cB = (const char*)g.Bt + (size_t)cur.pn * tstep;
    S.a_ready(cur);
    if constexpr (SP2) {
        PG8_STAGE(PG8_SB(0, 0), cB, voffB); PG8_STAGE(PG8_SB(0, 1), cB + hstep, voffB); PG8_STAGE(PG8_SA(0, 0), cA, voffA); PG8_STAGE(PG8_SA(0, 1), cA + hstep, voffA);
        if (wr == 1) PG8_BAR;
        PG8_WAIT_V(2); PG8_BAR;
        PG8_STAGE(PG8_SB(1, 0), cB + kstep, voffB); PG8_STAGE(PG8_SA(1, 0), cA + kstep, voffA); PG8_STAGE(PG8_SB(1, 1), cB + hstep + kstep, voffB);
        PG8_WAIT_V(6); PG8_BAR;
    } else {
        PG8_STAGE(PG8_SB(0, 0), cB, voffB); PG8_STAGE(PG8_SA(0, 0), cA, voffA); PG8_STAGE(PG8_SB(0, 1), cB + hstep, voffB); PG8_STAGE(PG8_SA(0, 1), cA + hstep, voffA);
        if (wr == 1) PG8_BAR;
        PG8_WAIT_V(4); PG8_BAR;
        PG8_STAGE(PG8_SB(1, 0), cB + kstep, voffB); PG8_STAGE(PG8_SA(1, 0), cA + kstep, voffA); PG8_STAGE(PG8_SB(1, 1), cB + hstep + kstep, voffB);
        PG8_WAIT_V(6); PG8_BAR;
    }
    for (;;) {
        const bool has_next = S.next(ui + 1, nxt);
        const char* nA = has_next ? (const char*)g.A + (size_t)nxt.pm * tstep : cA; const char* nB = has_next ? (const char*)g.Bt + (size_t)nxt.pn * tstep : cB;
        for (int t = 0; t < nt; t += 2) {
            const bool last = (t == nt - 2);
            const char* a1 = cA + (size_t)(t + 1) * kstep;
            const char* a2 = last ? nA : cA + (size_t)(t + 2) * kstep; const char* b2 = last ? nB : cB + (size_t)(t + 2) * kstep;
            const char* a3 = a2 + kstep; const char* b3 = b2 + kstep;
            if (last && has_next) S.a_ready(nxt);
            if constexpr (SP2) {
            PG8_LDB(B0, 0, 0); PG8_LDB(B1, 0, 1); PG8_SCHED; PG8_LDA(At, 0, 0); PG8_STAGE(PG8_SA(1, 1), a1 + hstep, voffA);
            PG8_WAIT_V(8); PG8_WAIT_L(0); PG8_BAR; PG8_MMA(0, 0, At, B0); PG8_MMA(0, 1, At, B1); PG8_BAR; PG8_SCHED;
            PG8_LDA(At, 0, 1); PG8_STAGE(PG8_SB(0, 0), b2, voffB); PG8_STAGE(PG8_SB(0, 1), b2 + hstep, voffB); PG8_STAGE(PG8_SA(0, 0), a2, voffA);
            PG8_WAIT_V(8); PG8_WAIT_L(0); PG8_BAR; PG8_MMA(1, 0, At, B0); PG8_MMA(1, 1, At, B1); PG8_BAR; PG8_SCHED;
            PG8_LDB(B0, 1, 0); PG8_LDB(B1, 1, 1); PG8_SCHED; PG8_LDA(At, 1, 0); PG8_STAGE(PG8_SA(0, 1), a2 + hstep, voffA);
            PG8_WAIT_V(8); PG8_WAIT_L(0); PG8_BAR; PG8_MMA(0, 0, At, B0); PG8_MMA(0, 1, At, B1); PG8_BAR; PG8_SCHED;
            PG8_LDA(At, 1, 1); PG8_STAGE(PG8_SB(1, 0), b3, voffB); PG8_STAGE(PG8_SB(1, 1), b3 + hstep, voffB); PG8_STAGE(PG8_SA(1, 0), a3, voffA);
            PG8_WAIT_V(8); PG8_WAIT_L(0); PG8_BAR; PG8_MMA(1, 0, At, B0); PG8_MMA(1, 1, At, B1); PG8_BAR; PG8_SCHED;
            } else {
            PG8_LDB(B0, 0, 0); PG8_SCHED; PG8_LDA(At, 0, 0); PG8_STAGE(PG8_SA(1, 1), a1 + hstep, voffA);
            PG8_WAIT_L(8); PG8_BAR; PG8_WAIT_L(0); PG8_MMA(0, 0, At, B0); PG8_BAR; PG8_SCHED;
            PG8_LDB(B1, 0, 1); PG8_STAGE(PG8_SB(0, 0), b2, voffB);
            PG8_BAR; PG8_WAIT_L(0); PG8_MMA(0, 1, At, B1); PG8_BAR;
            PG8_LDA(At, 0, 1); PG8_STAGE(PG8_SA(0, 0), a2, voffA);
            PG8_BAR; PG8_WAIT_L(0); PG8_MMA(1, 0, At, B0); PG8_BAR; PG8_SCHED;
            PG8_STAGE(PG8_SB(0, 1), b2 + hstep, voffB);
            PG8_WAIT_V(6); PG8_BAR; PG8_MMA(1, 1, At, B1); PG8_BAR;
            PG8_LDB(B0, 1, 0); PG8_SCHED; PG8_LDA(At, 1, 0); PG8_STAGE(PG8_SA(0, 1), a2 + hstep, voffA);
            PG8_WAIT_L(8); PG8_BAR; PG8_WAIT_L(0); PG8_MMA(0, 0, At, B0); PG8_BAR; PG8_SCHED;
            PG8_LDB(B1, 1, 1); PG8_STAGE(PG8_SB(1, 0), b3, voffB);
            PG8_BAR; PG8_WAIT_L(0); PG8_MMA(0, 1, At, B1); PG8_BAR;
            PG8_LDA(At, 1, 1); PG8_STAGE(PG8_SA(1, 0), a3, voffA);
            PG8_BAR; PG8_WAIT_L(0); PG8_MMA(1, 0, At, B0); PG8_BAR; PG8_SCHED;
            PG8_STAGE(PG8_SB(1, 1), b3 + hstep, voffB);
            PG8_WAIT_V(6); PG8_BAR; PG8_MMA(1, 1, At, B1); PG8_BAR;
            }
        }
        if constexpr (ALIGN_EPI) { if (wr == 0) PG8_BAR; }
        if constexpr (!Epi::AFTER_DRAIN) { E(acc, cur, wr, wc, fr, fq); S.done(cur); }
        if (!has_next) break;
#pragma unroll
        for (int a = 0; a < 2; ++a)
#pragma unroll
            for (int b = 0; b < 2; ++b)
#pragma unroll
                for (int m = 0; m < 4; ++m)
#pragma unroll
                    for (int n = 0; n < 2; ++n) acc[a][b][m][n] = (f32x4){0.f, 0.f, 0.f, 0.f};
        cur = nxt; cA = nA; cB = nB; ++ui;
        if constexpr (ALIGN_EPI) { if (wr == 1) PG8_BAR; }
    }
    PG8_WAIT_V(0);
    if constexpr (!ALIGN_EPI) { if (wr == 0) PG8_BAR; }
    PG8_BAR;
    if constexpr (Epi::AFTER_DRAIN) { E.fused(acc, cur, wr, wc, fr, fq, lds, wid, lane); S.done(cur); }
#undef PG8_SA
#undef PG8_SB
#undef PG8_STAGE
#undef PG8_LDA
#undef PG8_LDB
#undef PG8_MMA
#undef PG8_WAIT_V
#undef PG8_WAIT_L
#undef PG8_BAR
#undef PG8_SCHED
}
}
constexpr int RING_OFF = 0, RING_BYTES = 131072;
constexpr int LDSCTL_OFF = RING_BYTES, MISC_OFF = LDSCTL_OFF + 320;
constexpr int LDS_BYTES = 147456;
constexpr int CW_BAR = 4096;

#define GAS __attribute__((address_space(1)))
#define LAS __attribute__((address_space(3)))
typedef unsigned short bf16;
typedef unsigned v4u __attribute__((ext_vector_type(4)));
typedef float f32x4 __attribute__((ext_vector_type(4)));
typedef short bf16x8 __attribute__((ext_vector_type(8)));
typedef GAS unsigned gu32;
#define RLX_AGENT __ATOMIC_RELAXED, __HIP_MEMORY_SCOPE_AGENT
#define LDS_WAIT() asm volatile("s_waitcnt lgkmcnt(0)" ::: "memory")
#define VM_WAIT() asm volatile("s_waitcnt vmcnt(0)" ::: "memory")
__device__ __forceinline__ unsigned f2bfu(float f) { unsigned u = __builtin_bit_cast(unsigned, f); return (u + 0x7fffu + ((u >> 16) & 1u)) >> 16; }
__device__ __forceinline__ bf16 f2bf(float f) { return (bf16)f2bfu(f); }
typedef float f32x2_t __attribute__((ext_vector_type(2))); typedef __bf16 bf16x2_t __attribute__((ext_vector_type(2)));
__device__ __forceinline__ unsigned pk2(float lo, float hi) { f32x2_t v = {lo, hi}; bf16x2_t b = __builtin_convertvector(v, bf16x2_t); return __builtin_bit_cast(unsigned, b); }
__device__ __forceinline__ float xor16_max(float v) { auto r = __builtin_amdgcn_permlane16_swap(__float_as_uint(v), __float_as_uint(v), false, false); return fmaxf(__uint_as_float(r[0]), __uint_as_float(r[1])); }
__device__ __forceinline__ float xor32_max(float v) { auto r = __builtin_amdgcn_permlane32_swap(__float_as_uint(v), __float_as_uint(v), false, false); return fmaxf(__uint_as_float(r[0]), __uint_as_float(r[1])); }
__device__ __forceinline__ float xor16_sum(float v) { auto r = __builtin_amdgcn_permlane16_swap(__float_as_uint(v), __float_as_uint(v), false, false); return __uint_as_float(r[0]) + __uint_as_float(r[1]); }
__device__ __forceinline__ float xor32_sum(float v) { auto r = __builtin_amdgcn_permlane32_swap(__float_as_uint(v), __float_as_uint(v), false, false); return __uint_as_float(r[0]) + __uint_as_float(r[1]); }
__device__ __forceinline__ float bf2f(bf16 v) { return __uint_as_float(((unsigned)v) << 16); }
__device__ __forceinline__ float silu_f(float v) { return v / (1.f + __expf(-v)); }
__device__ __forceinline__ float sigmoid_f(float v) { return 1.f / (1.f + __expf(-v)); }
#define DPP_ADD_(v, ctrl) ((v) + __int_as_float(__builtin_amdgcn_update_dpp(0, __float_as_int(v), (ctrl), 0xF, 0xF, false)))
__device__ __forceinline__ float group8_sum(float v) {
    v = DPP_ADD_(v, 0xB1); v = DPP_ADD_(v, 0x4E); v = DPP_ADD_(v, 0x141); return v; }
__device__ __forceinline__ float wave_sum(float v) {
    v = group8_sum(v); v = DPP_ADD_(v, 0x140);
    { auto r = __builtin_amdgcn_permlane16_swap(__float_as_uint(v), __float_as_uint(v), false, false); v = __uint_as_float(r[0]) + __uint_as_float(r[1]); }
    { auto r = __builtin_amdgcn_permlane32_swap(__float_as_uint(v), __float_as_uint(v), false, false); v = __uint_as_float(r[0]) + __uint_as_float(r[1]); }
    return v;
}
__device__ __forceinline__ float rdlane(float v, int i) { return __int_as_float(__builtin_amdgcn_readlane(__float_as_int(v), i)); }


#ifndef PROBE_T
#define PROBE_T 0
#endif
#define TS_LDS(F) ((volatile LAS unsigned long long*)((F).lds + LDSCTL_OFF + 128))
#define TS_START(F, id) do { if (PROBE_T == (id) && blockIdx.x == 0 && (F).tid == 0) TS_LDS(F)[1] = __builtin_amdgcn_s_memtime(); } while (0)
#define TS_STOP(F, id)  do { if (PROBE_T == (id) && blockIdx.x == 0 && (F).tid == 0) TS_LDS(F)[0] += __builtin_amdgcn_s_memtime() - TS_LDS(F)[1]; } while (0)
#define XB_TMO      128
#define XB_XCNT(j)  (256  + 64 * (j))
#define XB_XSUB(j)  (1280 + 64 * (j))
#define XB_XGEN(j)  (2304 + 64 * (j))
#define XB_TOP      3328
#define XB_TOPGEN   3392
#define XCD_BAR_WORDS 3456
#define XB_SPIN_CAP (1u << 18)

__device__ __forceinline__ unsigned xb_ld(unsigned* p)              { return __hip_atomic_load(p, __ATOMIC_RELAXED, __HIP_MEMORY_SCOPE_AGENT); }
__device__ __forceinline__ unsigned xb_add(unsigned* p, unsigned v) { return __hip_atomic_fetch_add(p, v, __ATOMIC_RELAXED, __HIP_MEMORY_SCOPE_AGENT); }
__device__ __forceinline__ unsigned xb_xcc_id() { return (unsigned)__builtin_amdgcn_s_getreg((3 << 11) | 20) & 0xFu; }
#define XB_SPIN(cond, bar) do { unsigned _sp = 0; while (cond) { __builtin_amdgcn_s_sleep(1); \
    if ((++_sp & 255u) == 0u) { if (xb_ld(&(bar)[XB_TMO])) break; if (_sp > XB_SPIN_CAP) { atomicAdd(&(bar)[XB_TMO], 1u); break; } } } } while (0)

struct XcdBarrier {
    unsigned* bar; unsigned x;
    volatile LAS unsigned* st;
};

__device__ __forceinline__ XcdBarrier xcd_barrier_post(unsigned* bar, volatile LAS unsigned* st) {
    XcdBarrier b; b.bar = bar; b.x = xb_xcc_id(); b.st = st;
    if (threadIdx.x == 0) (void)xb_add(&bar[XB_XCNT(b.x)], 1u);
    return b;
}
__device__ __forceinline__ void xcd_barrier_complete(unsigned* bar, unsigned x, unsigned& nloc, unsigned& nx) {
    const unsigned G = gridDim.x * gridDim.y * gridDim.z;
    unsigned sum, cnt, mine, sp = 0u;
    for (;;) {
        sum = 0u; cnt = 0u; mine = 0u;
#pragma unroll
        for (unsigned j = 0; j < 16; ++j) { const unsigned c = xb_ld(&bar[XB_XCNT(j)]); sum += c; cnt += (c > 0u) ? 1u : 0u; mine = (j == x) ? c : mine; }
        if (sum == G) break;
        __builtin_amdgcn_s_sleep(1);
        if ((++sp & 255u) == 0u) { if (xb_ld(&bar[XB_TMO])) break; if (sp > XB_SPIN_CAP) { atomicAdd(&bar[XB_TMO], 1u); break; } }
    }
    nloc = mine > 0u ? mine : 1u; nx = cnt > 0u ? cnt : 1u;
}

__device__ __forceinline__ void xcd_barrier(const XcdBarrier& b) {
    asm volatile("s_waitcnt vmcnt(0)" ::: "memory");
    __syncthreads();
    if (threadIdx.x == 0) {
        unsigned* bar = b.bar;
        __builtin_amdgcn_s_waitcnt(0);
        unsigned nloc = b.st[0], nx = b.st[1];
        if (nloc == 0u) { xcd_barrier_complete(bar, b.x, nloc, nx); b.st[0] = nloc; b.st[1] = nx; }
        const unsigned old = xb_add(&bar[XB_XSUB(b.x)], 1u);
        const unsigned gen = old / nloc;
        if (old + 1u == (gen + 1u) * nloc) {
            __builtin_amdgcn_fence(__ATOMIC_RELEASE, "agent");
            asm volatile("s_waitcnt vmcnt(0)" ::: "memory");
            const unsigned og = xb_add(&bar[XB_TOP], 1u);
            const unsigned tg = og / nx;
            if (og + 1u == (tg + 1u) * nx) xb_add(&bar[XB_TOPGEN], 1u);
            else XB_SPIN(xb_ld(&bar[XB_TOPGEN]) == tg, bar);
            __builtin_amdgcn_fence(__ATOMIC_ACQUIRE, "agent");
            xb_add(&bar[XB_XGEN(b.x)], 1u);
            asm volatile("s_waitcnt vmcnt(0)" ::: "memory");
        } else {
            XB_SPIN(xb_ld(&bar[XB_XGEN(b.x)]) == gen, bar);
            __builtin_amdgcn_fence(__ATOMIC_ACQUIRE, "agent");
            asm volatile("s_waitcnt vmcnt(0)" ::: "memory");
        }
    }
    __syncthreads();
}

struct Ctx {
    LAS unsigned char* lds; int tid, lane, wave, vcu, G, gw, NGW;
    const float *x, *c, *ctx, *c_ctx, *w_mod, *b_mod, *g_pre, *g_post, *w_in, *w_out, *hgrn_lb, *hgrn_gn, *gate_b, *mlstm_gn, *na_rpb;
    float* out; bf16 *wt_in, *wt_out, *hxy, *P; float *mod, *gates, *ctx1, *stm, *sth, *rope; bf16 *otm, *oth, *UX;
};

__device__ __forceinline__ void transpose_item(const float* W, int N, int Nnew, bool remap, bf16* WT, LAS float* scr, int item, int lane) {
    const int nblk = Nnew / 32, kb = item / nblk, nb = item % nblk, k0 = 64 * kb, n0 = 32 * nb;
    const int rg = lane >> 3, c4 = (lane & 7) * 4, nn = n0 + c4;
    int no = nn; if (remap) no = nn < 3200 ? nn : (nn < 4736 ? nn + 16 : (nn < 4752 ? 3200 + nn - 4736 : -1));
    f32x4 v[8];
#pragma unroll
    for (int j = 0; j < 8; ++j) v[j] = no >= 0 ? *(const f32x4*)(W + (size_t)(k0 + 8 * j + rg) * N + no) : (f32x4){0.f, 0.f, 0.f, 0.f};
#pragma unroll
    for (int j = 0; j < 8; ++j) { LAS float* d = scr + (8 * j + rg) * 33 + c4; d[0] = v[j][0]; d[1] = v[j][1]; d[2] = v[j][2]; d[3] = v[j][3]; }
    LDS_WAIT(); asm volatile("" ::: "memory");
    const int c = lane & 7;
#pragma unroll
    for (int j = 0; j < 4; ++j) { const int n = (lane >> 3) + 8 * j; const LAS float* s = scr + (8 * c) * 33 + n;
        v4u o; o.x = pk2(s[0 * 33], s[1 * 33]); o.y = pk2(s[2 * 33], s[3 * 33]); o.z = pk2(s[4 * 33], s[5 * 33]); o.w = pk2(s[6 * 33], s[7 * 33]);
        *(GAS v4u*)(WT + (size_t)(n0 + n) * 1024 + k0 + 8 * c) = o; }
    LDS_WAIT(); asm volatile("" ::: "memory");
}
__device__ __forceinline__ void phase_p0(const Ctx& F) {
    if (F.vcu < 96) {
        LAS float* tab = (LAS float*)(F.lds);
        LAS float* part = (LAS float*)(F.lds + 36864);
        for (int i = F.tid; i < 9 * 1024; i += 512) { const int r = i >> 10, k = i & 1023; const float v = r < 8 ? F.c[r * 1024 + k] : F.c_ctx[k]; tab[i] = silu_f(v); }
        __syncthreads();
        for (int it = F.vcu; it < 96; it += F.G) {
            const int l = it / 48, jb = it % 48, col = jb * 64 + F.lane;
            float acc[9];
#pragma unroll
            for (int r = 0; r < 9; ++r) acc[r] = 0.f;
            const float* wp = F.w_mod + ((size_t)l * 1024 + F.wave * 128) * 3072 + col;
            for (int kb = 0; kb < 128; kb += 32) {
                float wv[32];
#pragma unroll
                for (int k = 0; k < 32; ++k) wv[k] = wp[(size_t)(kb + k) * 3072];
#pragma unroll
                for (int k = 0; k < 32; ++k)
#pragma unroll
                    for (int r = 0; r < 9; ++r) acc[r] += tab[r * 1024 + F.wave * 128 + kb + k] * wv[k]; }
#pragma unroll
            for (int r = 0; r < 9; ++r) part[(F.wave * 9 + r) * 64 + F.lane] = acc[r];
            __syncthreads();
            for (int i = F.tid; i < 9 * 64; i += 512) { const int r = i >> 6, j = i & 63; float s = 0.f;
#pragma unroll
                for (int w = 0; w < 8; ++w) s += part[(w * 9 + r) * 64 + j];
                F.mod[((size_t)l * 9 + r) * 3072 + jb * 64 + j] = s + F.b_mod[l * 3072 + jb * 64 + j]; }
            __syncthreads();
        }
    }
    if (F.vcu == 96 % F.G) for (int i = F.tid; i < 64 * 24; i += 512) { const int pos = i / 24, f = i % 24; const float ang = (float)pos * expf(-(float)(2 * f) * (1.f / 48.f) * 9.210340371976184f); F.rope[2 * i] = cosf(ang); F.rope[2 * i + 1] = sinf(ang); }
    __syncthreads();
    LAS float* scr = (LAS float*)(F.lds + F.wave * 16384);
    constexpr int I_IN = 16 * (NPAD / 32);
    const int gwr = F.NGW - 1 - F.gw;
    for (int it = gwr; it < I_IN; it += F.NGW) transpose_item(F.w_in, PIN, NPAD, true, F.wt_in, scr, it, F.lane);
}
__device__ __forceinline__ void phase_p1_transposes(const Ctx& F) {
    LAS float* scr = (LAS float*)(F.lds + F.wave * 16384);
    constexpr int I_IN = 16 * (NPAD / 32), I_OUT = 16 * 32;
    for (int it = F.gw; it < I_IN + 2 * I_OUT; it += F.NGW) {
        if (it < I_OUT) transpose_item(F.w_out, 1024, 1024, false, F.wt_out, scr, it, F.lane);
        else if (it < I_OUT + I_IN) transpose_item(F.w_in + (size_t)1024 * PIN, PIN, NPAD, true, F.wt_in + (size_t)NPAD * 1024, scr, it - I_OUT, F.lane);
        else transpose_item(F.w_out + (size_t)1024 * 1024, 1024, 1024, false, F.wt_out + (size_t)1024 * 1024, scr, it - I_OUT - I_IN, F.lane);
    }
}

struct RowPar { float4 g[4], a[4], b[4]; };
__device__ __forceinline__ void load_par(RowPar& p, const float* g, const float* a, const float* b, int lane) {
#pragma unroll
    for (int j = 0; j < 4; ++j) { const int d = 4 * (lane + 64 * j); p.g[j] = *(const float4*)(g + d); p.a[j] = *(const float4*)(a + d); p.b[j] = *(const float4*)(b + d); }
}
__device__ __forceinline__ void prenorm_store(const float4 (&v)[4], float ss, const RowPar& p, bf16* dst, int lane) {
    const float rinv = 1.f / sqrtf(ss * (1.f / 1024.f) + EPS);
#pragma unroll
    for (int j = 0; j < 4; ++j) {
        const int d = 4 * (lane + 64 * j);
        const float o0 = v[j].x * rinv * p.g[j].x * (1.f + p.a[j].x) + p.b[j].x, o1 = v[j].y * rinv * p.g[j].y * (1.f + p.a[j].y) + p.b[j].y;
        const float o2 = v[j].z * rinv * p.g[j].z * (1.f + p.a[j].z) + p.b[j].z, o3 = v[j].w * rinv * p.g[j].w * (1.f + p.a[j].w) + p.b[j].w;
        uint2 w; w.x = pk2(o0, o1); w.y = pk2(o2, o3);
        *(uint2*)(dst + d) = w;
    }
}
__device__ __forceinline__ void phase_prenorm0(const Ctx& F) {
    auto rowsrc = [&](int m) -> const float* { return m < MX ? F.x + (size_t)m * 1024 : F.ctx + (size_t)(m - MX) * 1024; };
    int m = F.gw; if (m >= M) return;
    float4 nv[4];
#pragma unroll
    for (int j = 0; j < 4; ++j) nv[j] = ((const float4*)rowsrc(m))[F.lane + 64 * j];
    while (m < M) {
        const float* mod_r = F.mod + (size_t)(m < MX ? m / S : 8) * 3072;
        RowPar p; load_par(p, F.g_pre, mod_r + 1024, mod_r, F.lane);
        float4 v[4];
#pragma unroll
        for (int j = 0; j < 4; ++j) v[j] = nv[j];
        const int mn = m + F.NGW;
        if (mn < M) {
#pragma unroll
            for (int j = 0; j < 4; ++j) nv[j] = ((const float4*)rowsrc(mn))[F.lane + 64 * j]; }
        float ss = 0.f;
#pragma unroll
        for (int j = 0; j < 4; ++j) ss += v[j].x * v[j].x + v[j].y * v[j].y + v[j].z * v[j].z + v[j].w * v[j].w;
        ss = wave_sum(ss);
        prenorm_store(v, ss, p, F.hxy + (size_t)m * 1024, F.lane);
        m = mn;
    }
}
__device__ __forceinline__ void phase_post(const Ctx& F, int l) {
    const int Ml = l == 0 ? M : MX;
    const float* mod_l = F.mod + (size_t)l * 9 * 3072; const float* g_post_l = F.g_post + l * 1024;
    auto rowsrc = [&](int m) -> const float* { return m < MX ? (l == 0 ? F.x : F.out) + (size_t)m * 1024 : F.ctx + (size_t)(m - MX) * 1024; };
    int m = F.gw; if (m >= Ml) return;
    float4 nx[4]; uint2 nu[4];
#pragma unroll
    for (int j = 0; j < 4; ++j) { nx[j] = ((const float4*)rowsrc(m))[F.lane + 64 * j]; nu[j] = ((const uint2*)(F.UX + (size_t)m * 1024))[F.lane + 64 * j]; }
    while (m < Ml) {
        float* dst; int r;
        if (m < MX) { dst = F.out + (size_t)m * 1024; r = m / S; } else { dst = F.ctx1 + (size_t)(m - MX) * 1024; r = 8; }
        float4 pg[4], pt[4]; RowPar p2;
#pragma unroll
        for (int j = 0; j < 4; ++j) { const int d = 4 * (F.lane + 64 * j); pg[j] = *(const float4*)(g_post_l + d); pt[j] = *(const float4*)(mod_l + r * 3072 + 2048 + d); }
        if (l == 0) load_par(p2, F.g_pre + 1024, F.mod + (size_t)(9 + r) * 3072 + 1024, F.mod + (size_t)(9 + r) * 3072, F.lane);
        float4 xr[4], u[4]; float ss = 0.f;
#pragma unroll
        for (int j = 0; j < 4; ++j) { xr[j] = nx[j]; const uint2 w = nu[j];
            u[j].x = __uint_as_float(w.x << 16); u[j].y = __uint_as_float(w.x & 0xffff0000u); u[j].z = __uint_as_float(w.y << 16); u[j].w = __uint_as_float(w.y & 0xffff0000u);
            ss += u[j].x * u[j].x + u[j].y * u[j].y + u[j].z * u[j].z + u[j].w * u[j].w; }
        const int mn = m + F.NGW;
        if (mn < Ml) {
#pragma unroll
            for (int j = 0; j < 4; ++j) { nx[j] = ((const float4*)rowsrc(mn))[F.lane + 64 * j]; nu[j] = ((const uint2*)(F.UX + (size_t)mn * 1024))[F.lane + 64 * j]; } }
        ss = wave_sum(ss);
        const float rinv = 1.f / sqrtf(ss * (1.f / 1024.f) + EPS);
        float ss2 = 0.f;
#pragma unroll
        for (int j = 0; j < 4; ++j) {
            const int d = 4 * (F.lane + 64 * j);
            const float4 g = pg[j], t = pt[j], xv = xr[j];
            float4 o; o.x = xv.x + t.x * (u[j].x * rinv * g.x); o.y = xv.y + t.y * (u[j].y * rinv * g.y); o.z = xv.z + t.z * (u[j].z * rinv * g.z); o.w = xv.w + t.w * (u[j].w * rinv * g.w);
            *(float4*)(dst + d) = o; u[j] = o; ss2 += o.x * o.x + o.y * o.y + o.z * o.z + o.w * o.w;
        }
        if (l == 0) { ss2 = wave_sum(ss2); prenorm_store(u, ss2, p2, F.hxy + (size_t)m * 1024, F.lane); }
        m = mn;
    }
}


typedef short s16x4 __attribute__((ext_vector_type(4)));
typedef short v4i16_t __attribute__((ext_vector_type(4)));
__device__ __forceinline__ s16x4 tr_read(const LAS bf16* p) { return __builtin_bit_cast(s16x4, __builtin_amdgcn_ds_read_tr16_b64_v4i16((LAS v4i16_t*)p)); }
__device__ __forceinline__ bf16x8 tr_frag(const LAS bf16* T, int stride, int rowA, int rowB, int col0, int lane) {
    const int q = (lane >> 2) & 3, p = lane & 3;
    const s16x4 lo = tr_read(T + (rowA + q) * stride + col0 + 4 * p), hi = tr_read(T + (rowB + q) * stride + col0 + 4 * p);
    return (bf16x8){lo[0], lo[1], lo[2], lo[3], hi[0], hi[1], hi[2], hi[3]};
}
__device__ __forceinline__ bf16x8 rm_frag(const LAS bf16* T, int stride, int row, int k0) { return *(const LAS bf16x8*)(T + row * stride + k0); }
__device__ __forceinline__ f32x4 mfma16(bf16x8 a, bf16x8 b, f32x4 c) { return __builtin_amdgcn_mfma_f32_16x16x32_bf16(a, b, c, 0, 0, 0); }
typedef unsigned v2u __attribute__((ext_vector_type(2)));
typedef float f32x2 __attribute__((ext_vector_type(2)));
__device__ __forceinline__ void unpack8(const v4u w, float* f) {
    f[0] = __uint_as_float(w.x << 16); f[1] = __uint_as_float(w.x & 0xffff0000u); f[2] = __uint_as_float(w.y << 16); f[3] = __uint_as_float(w.y & 0xffff0000u);
    f[4] = __uint_as_float(w.z << 16); f[5] = __uint_as_float(w.z & 0xffff0000u); f[6] = __uint_as_float(w.w << 16); f[7] = __uint_as_float(w.w & 0xffff0000u);
}
__device__ __forceinline__ v4u pack8(const float* f) { v4u w; w.x = pk2(f[0], f[1]); w.y = pk2(f[2], f[3]); w.z = pk2(f[4], f[5]); w.w = pk2(f[6], f[7]); return w; }

__device__ __forceinline__ float wave_scan_incl(float x) {
    int v = __float_as_int(x);
#define DPP_ADD(ctrl, rmask) v = __float_as_int(__int_as_float(v) + __int_as_float(__builtin_amdgcn_update_dpp(0, v, ctrl, rmask, 0xF, false)))
    DPP_ADD(0x111, 0xF); DPP_ADD(0x112, 0xF); DPP_ADD(0x114, 0xF); DPP_ADD(0x118, 0xF); DPP_ADD(0x142, 0xA); DPP_ADD(0x143, 0xC);
#undef DPP_ADD
    return __int_as_float(v);
}
#define LDS_FENCE() asm volatile("" ::: "memory")
namespace ml {
constexpr int QSTR = 104, VSTR = 120;
constexpr int OFF_QS = 0, OFF_KS = OFF_QS + 64 * QSTR * 2, OFF_VS = OFF_KS + 64 * QSTR * 2, OFF_CT = OFF_VS + 64 * VSTR * 2;
constexpr int OFF_HT = OFF_CT + 2 * 112 * QSTR * 2, OFF_DEN = OFF_HT + 64 * 100 * 4, OFF_ROPE = OFF_DEN + 256, OFF_END = OFF_ROPE + 64 * 24 * 8;
static_assert(OFF_END <= RING_BYTES && 6 * 7 * 64 * 16 <= OFF_HT, "mlstm LDS");
constexpr int ST_FLOATS = 96 * 112 + 16;
}
constexpr int NSEG = 4, SEGTOK = S / NSEG, SEGCH = SEGTOK / 64;
struct MlJob { int b, h, isctx, t0, nchunk; };

__device__ __forceinline__ void mlstm_dir(const Ctx& F, int l, const MlJob jb, int dir, int fold_r, int emit_slot, int mode, bf16* otmp, float* ST) {
    using namespace ml;
    int tid_ = F.tid; asm volatile("" : "+v"(tid_));
    const int w = __builtin_amdgcn_readfirstlane(tid_ >> 6);
    const bool tsel = (mode != 0) && !jb.isctx && l == 0;
    if (tsel) TS_START(F, 10);
    LAS bf16* QS = (LAS bf16*)(F.lds + OFF_QS); LAS bf16* KS = (LAS bf16*)(F.lds + OFF_KS); LAS bf16* VS = (LAS bf16*)(F.lds + OFF_VS);
    LAS bf16* CT0 = (LAS bf16*)(F.lds + OFF_CT); LAS float* HT = (LAS float*)(F.lds + OFF_HT); LAS float* DEN = (LAS float*)(F.lds + OFF_DEN);
    const LAS f32x2* ROPE = (const LAS f32x2*)(F.lds + OFF_ROPE);
    const int rowbase = jb.isctx ? MX + jb.b * CTX : jb.b * S;
    const int h = jb.h; const bf16* P = F.P;
    float* STd = ST + (size_t)(((jb.b * 4 + h) * 2 + dir) * 8) * ST_FLOATS;
    f32x4 Cst[7];
#pragma unroll
    for (int et = 0; et < 7; ++et) Cst[et] = (f32x4){0.f, 0.f, 0.f, 0.f};
    if (fold_r >= 0) {
        LAS f32x4* FOLD = (LAS f32x4*)(F.lds + OFF_QS);
        float wk[8];
        { float bs[8]; bs[0] = 0.f;
#pragma unroll
          for (int k = 1; k < NSEG; ++k) bs[k] = STd[(size_t)k * ST_FLOATS + 96 * 112];
          float run = 1.f;
#pragma unroll
          for (int k = NSEG - 1; k >= 0; --k) { wk[k] = (k <= fold_r) ? run : 0.f; run = (k >= 1 && k <= fold_r) ? run * __expf(bs[k]) : run; } }
#pragma unroll 2
        for (int p = tid_; p < 6 * 7 * 64; p += 512) {
            f32x4 v[8];
#pragma unroll
            for (int k = 0; k < NSEG; ++k) v[k] = *(const f32x4*)(STd + (size_t)k * ST_FLOATS + 4 * p);
            f32x4 acc = v[0] * wk[0];
#pragma unroll
            for (int k = 1; k < NSEG; ++k) acc += v[k] * wk[k];
            FOLD[p] = acc;
        }
        __syncthreads();
        if (w < 6) {
#pragma unroll
            for (int et = 0; et < 7; ++et) Cst[et] = FOLD[(w * 7 + et) * 64 + (tid_ & 63)];
        }
        __syncthreads();
    }
    asm volatile("" : "+v"(tid_));
    const int tid = tid_, lane = tid & 63, g = lane >> 4, c = lane & 15;
    float Btot = 0.f;
    for (int i = tid; i < 64 * 16; i += 512) { const int s = i >> 4, e = 96 + (i & 15); VS[s * VSTR + e] = (e == 96) ? (bf16)0x3F80 : (bf16)0; }
    if (w < 6) {
#pragma unroll
        for (int et = 0; et < 7; ++et) { v2u v; v.x = pk2(Cst[et][0], Cst[et][1]); v.y = pk2(Cst[et][2], Cst[et][3]); *(LAS v2u*)(CT0 + (16 * et + c) * QSTR + 16 * w + 4 * g) = v; }
    }
    const bool hasqk = tid < 384; const int qk_tok = tid / 6, qk_pi = tid % 6, qk_part = qk_pi / 3, qk_pp = qk_pi % 3, qk_d0 = 48 * qk_part + 8 * qk_pp;
    const int v1_tok = tid / 12, v1_pc = tid % 12; const bool hasv2 = tid < 256; const int v2_tok = (512 + tid) / 12, v2_pc = (512 + tid) % 12;
    struct LoadSet { v4u q0, q1, k0, k1, v1, v2; float ig, lf; };
    LoadSet LA, LB;
    v2u ft[3], fo[3], fz[3];
    const int fi_i = tid >> 3, fi_e0 = 12 * (tid & 7);
#pragma unroll
    for (int q4 = 0; q4 < 3; ++q4) { ft[q4] = (v2u){0u, 0u}; fo[q4] = (v2u){0u, 0u}; fz[q4] = (v2u){0u, 0u}; }
    LA.q0 = LA.q1 = LA.k0 = LA.k1 = LA.v1 = LA.v2 = (v4u){0u, 0u, 0u, 0u}; LA.ig = LA.lf = 0.f; LB = LA;
    auto tok_of = [&](int ci, int i) -> int { return dir == 0 ? jb.t0 + 64 * ci + i : jb.t0 + 64 * (jb.nchunk - 1 - ci) + (63 - i); };
    auto issue_loads = [&](LoadSet& L, int ci) {
        if (hasqk) { const bf16* pr = P + (size_t)(rowbase + tok_of(ci, qk_tok)) * PLD + h * 96 + qk_d0;
            if (mode != 0) { L.q0 = *(const v4u*)(pr + B_Q); L.q1 = *(const v4u*)(pr + B_Q + 24); }
            L.k0 = *(const v4u*)(pr + B_K); L.k1 = *(const v4u*)(pr + B_K + 24); }
        L.v1 = *(const v4u*)(P + (size_t)(rowbase + tok_of(ci, v1_tok)) * PLD + B_V + h * 96 + 8 * v1_pc);
        if (hasv2) L.v2 = *(const v4u*)(P + (size_t)(rowbase + tok_of(ci, v2_tok)) * PLD + B_V + h * 96 + 8 * v2_pc);
        const float* gp = F.gates + (size_t)(rowbase + tok_of(ci, lane)) * 16 + dir * 4 + h; L.ig = gp[0]; L.lf = gp[8];
    };
    auto issue_fin = [&](int ci) {
        const int m = rowbase + tok_of(ci, fi_i); const bf16* tp = otmp + (size_t)m * 384 + h * 96 + fi_e0; const bf16* pr = P + (size_t)m * PLD + h * 96 + fi_e0;
#pragma unroll
        for (int q4 = 0; q4 < 3; ++q4) { ft[q4] = *(const v2u*)(tp + 4 * q4); fo[q4] = *(const v2u*)(pr + B_O + 4 * q4); fz[q4] = *(const v2u*)(pr + B_Z + 4 * q4); }
    };
    auto finalize = [&](int ci) {
            const int i = tid >> 3, sub = tid & 7, e0 = 12 * sub; const int m = rowbase + tok_of(ci, i);
            float hv[12]; const float rden = 1.f / fmaxf(fabsf(DEN[i]), 1.f);
#pragma unroll
            for (int q4 = 0; q4 < 3; ++q4) { const f32x4 v = *(const LAS f32x4*)(HT + i * 100 + e0 + 4 * q4); hv[4 * q4] = v[0] * rden; hv[4 * q4 + 1] = v[1] * rden; hv[4 * q4 + 2] = v[2] * rden; hv[4 * q4 + 3] = v[3] * rden; }
            bf16* tp = otmp + (size_t)m * 384 + h * 96 + e0;
            if (mode == 1) {
#pragma unroll
                for (int q4 = 0; q4 < 3; ++q4) { v2u v; v.x = pk2(hv[4 * q4], hv[4 * q4 + 1]); v.y = pk2(hv[4 * q4 + 2], hv[4 * q4 + 3]); *(v2u*)(tp + 4 * q4) = v; }
            } else {
                float ss = 0.f;
#pragma unroll
                for (int q4 = 0; q4 < 3; ++q4) { const v2u v = ft[q4];
                    hv[4 * q4] += __uint_as_float(v.x << 16); hv[4 * q4 + 1] += __uint_as_float(v.x & 0xffff0000u); hv[4 * q4 + 2] += __uint_as_float(v.y << 16); hv[4 * q4 + 3] += __uint_as_float(v.y & 0xffff0000u); }
#pragma unroll
                for (int e = 0; e < 12; ++e) ss += hv[e] * hv[e];
                ss = group8_sum(ss);
                const float rinv = 1.f / sqrtf(ss * (1.f / 96.f) + EPS);
                bf16* yp = F.hxy + (size_t)m * 1024 + 256 + h * 96 + e0; const float* gnv = F.mlstm_gn + l * 384 + h * 96 + e0;
#pragma unroll
                for (int q4 = 0; q4 < 3; ++q4) { const v2u ov = fo[q4], zv = fz[q4];
                    const float og[4] = {__uint_as_float(ov.x << 16), __uint_as_float(ov.x & 0xffff0000u), __uint_as_float(ov.y << 16), __uint_as_float(ov.y & 0xffff0000u)};
                    const float zg[4] = {__uint_as_float(zv.x << 16), __uint_as_float(zv.x & 0xffff0000u), __uint_as_float(zv.y << 16), __uint_as_float(zv.y & 0xffff0000u)};
                    float o[4];
#pragma unroll
                    for (int e = 0; e < 4; ++e) o[e] = og[e] * (hv[4 * q4 + e] * rinv * gnv[4 * q4 + e]) * zg[e];
                    v2u v; v.x = pk2(o[0], o[1]); v.y = pk2(o[2], o[3]); *(v2u*)(yp + 4 * q4) = v; }
            }
    };
    issue_loads(LA, 0); if (jb.nchunk > 1) issue_loads(LB, 1);
    __syncthreads();
    if (tsel) TS_STOP(F, 10);
    auto chunk_step = [&](LoadSet& L, int ci) {
        if (tsel) TS_START(F, 11);
        LAS bf16* CTc = CT0 + (ci & 1) * 112 * QSTR; LAS bf16* CTn = CT0 + ((ci + 1) & 1) * 112 * QSTR;
        const float bcs = wave_scan_incl(L.lf);
        const float qsc = __expf(bcs), ksc = __expf(L.ig - bcs);
        const float bL = rdlane(bcs, 63), ebL = __expf(bL);
        if (hasqk) {
            const float ks_t = __shfl(ksc, qk_tok), qs_t = __shfl(qsc, qk_tok);
            float cs[8], sn[8];
            if (!jb.isctx) { const int t = tok_of(ci, qk_tok); const int pos = qk_part ? (t & 63) : (t >> 6);
#pragma unroll
                for (int e = 0; e < 8; ++e) { const f32x2 v = ROPE[pos * 24 + 8 * qk_pp + e]; cs[e] = v[0]; sn[e] = v[1]; } }
            else {
#pragma unroll
                for (int e = 0; e < 8; ++e) { cs[e] = 1.f; sn[e] = 0.f; } }
            float a[8], b2[8], o0[8], o1[8];
            unpack8(L.k0, a); unpack8(L.k1, b2);
#pragma unroll
            for (int e = 0; e < 8; ++e) { o0[e] = (a[e] * cs[e] - b2[e] * sn[e]) * ks_t; o1[e] = (b2[e] * cs[e] + a[e] * sn[e]) * ks_t; }
            *(LAS v4u*)(KS + qk_tok * QSTR + qk_d0) = pack8(o0); *(LAS v4u*)(KS + qk_tok * QSTR + qk_d0 + 24) = pack8(o1);
            if (mode != 0) {
                unpack8(L.q0, a); unpack8(L.q1, b2);
#pragma unroll
                for (int e = 0; e < 8; ++e) { o0[e] = (a[e] * cs[e] - b2[e] * sn[e]) * qs_t; o1[e] = (b2[e] * cs[e] + a[e] * sn[e]) * qs_t; }
                *(LAS v4u*)(QS + qk_tok * QSTR + qk_d0) = pack8(o0); *(LAS v4u*)(QS + qk_tok * QSTR + qk_d0 + 24) = pack8(o1);
            }
        } else { (void)__shfl(ksc, 0); (void)__shfl(qsc, 0); }
        *(LAS v4u*)(VS + v1_tok * VSTR + 8 * v1_pc) = L.v1;
        if (hasv2) *(LAS v4u*)(VS + v2_tok * VSTR + 8 * v2_pc) = L.v2;
        if (mode == 2 && ci > 0) finalize(ci - 1);
        if (ci + 2 < jb.nchunk) issue_loads(L, ci + 2);
        if (tsel) { TS_STOP(F, 11); TS_START(F, 12); }
        __syncthreads();
        if (tsel) { TS_STOP(F, 12); TS_START(F, 13); }
        if (mode != 0) {
            const int tt = w & 3, jh = w >> 2;
            bf16x8 qf[3], kf[4][3];
#pragma unroll
            for (int ks = 0; ks < 3; ++ks) qf[ks] = rm_frag(QS, QSTR, 16 * tt + c, 32 * ks + 8 * g);
#pragma unroll
            for (int ss = 0; ss < 4; ++ss) if (ss <= tt) {
#pragma unroll
                for (int ks = 0; ks < 3; ++ks) kf[ss][ks] = rm_frag(KS, QSTR, 16 * ss + c, 32 * ks + 8 * g); }
            LDS_FENCE();
            f32x4 st[4];
#pragma unroll
            for (int ss = 0; ss < 4; ++ss) { st[ss] = (f32x4){0.f, 0.f, 0.f, 0.f};
                if (ss <= tt) {
#pragma unroll
                    for (int ks = 0; ks < 3; ++ks) st[ss] = mfma16(kf[ss][ks], qf[ks], st[ss]);
                    if (ss == tt) {
#pragma unroll
                        for (int r = 0; r < 4; ++r) if (4 * g + r > c) st[ss][r] = 0.f; }
                } }
            bf16x8 pf[2];
#pragma unroll
            for (int kk = 0; kk < 2; ++kk) { const unsigned u0 = pk2(st[2 * kk][0], st[2 * kk][1]), u1 = pk2(st[2 * kk][2], st[2 * kk][3]), u2 = pk2(st[2 * kk + 1][0], st[2 * kk + 1][1]), u3 = pk2(st[2 * kk + 1][2], st[2 * kk + 1][3]);
                pf[kk] = __builtin_bit_cast(bf16x8, (v4u){u0, u1, u2, u3}); }
#pragma unroll
            for (int eb = 0; eb < 4; eb += 2) {
                bf16x8 vf[2][2], cf[2][3];
#pragma unroll
                for (int e2 = 0; e2 < 2; ++e2) { const int et = 4 * jh + eb + e2;
                    if (et < 7) {
#pragma unroll
                        for (int kk = 0; kk < 2; ++kk) if (2 * kk <= tt) vf[e2][kk] = tr_frag(VS, VSTR, 32 * kk + 4 * g, 32 * kk + 16 + 4 * g, 16 * et, lane);
#pragma unroll
                        for (int ks = 0; ks < 3; ++ks) cf[e2][ks] = rm_frag(CTc, QSTR, 16 * et + c, 32 * ks + 8 * g); } }
                LDS_FENCE();
#pragma unroll
                for (int e2 = 0; e2 < 2; ++e2) { const int et = 4 * jh + eb + e2;
                    if (et < 7) {
                        f32x4 acc = (f32x4){0.f, 0.f, 0.f, 0.f};
#pragma unroll
                        for (int kk = 0; kk < 2; ++kk) if (2 * kk <= tt) acc = mfma16(vf[e2][kk], pf[kk], acc);
#pragma unroll
                        for (int ks = 0; ks < 3; ++ks) acc = mfma16(cf[e2][ks], qf[ks], acc);
                        if (et < 6) *(LAS f32x4*)(HT + (16 * tt + c) * 100 + 16 * et + 4 * g) = acc;
                        else if (g == 0) DEN[16 * tt + c] = acc[0];
                    } }
            }
        }
        if (w < 6) {
#pragma unroll
            for (int kk = 0; kk < 2; ++kk) {
                bf16x8 vf[7]; const bf16x8 af = tr_frag(KS, QSTR, 32 * kk + 8 * g, 32 * kk + 8 * g + 4, 16 * w, lane);
#pragma unroll
                for (int et = 0; et < 7; ++et) vf[et] = tr_frag(VS, VSTR, 32 * kk + 8 * g, 32 * kk + 8 * g + 4, 16 * et, lane);
                LDS_FENCE();
#pragma unroll
                for (int et = 0; et < 7; ++et) Cst[et] = mfma16(af, vf[et], Cst[et]);
            }
#pragma unroll
            for (int et = 0; et < 7; ++et) { Cst[et] = Cst[et] * ebL;
                if (mode != 0) { v2u v; v.x = pk2(Cst[et][0], Cst[et][1]); v.y = pk2(Cst[et][2], Cst[et][3]); *(LAS v2u*)(CTn + (16 * et + c) * QSTR + 16 * w + 4 * g) = v; } }
        }
        Btot += bL;
        if (tsel) { TS_STOP(F, 13); TS_START(F, 14); }
        __syncthreads();
        if (tsel) { TS_STOP(F, 14); TS_START(F, 15); }
        if (mode == 1) finalize(ci); else if (mode == 2) issue_fin(ci);
        if (tsel) TS_STOP(F, 15);
    };
    for (int ci = 0; ci < jb.nchunk; ci += 2) { chunk_step(LA, ci); chunk_step(LB, ci + 1); }
    if (mode == 2) finalize(jb.nchunk - 1);
    if (emit_slot >= 0 && w < 6) {
        float* sl = STd + (size_t)emit_slot * ST_FLOATS;
#pragma unroll
        for (int et = 0; et < 7; ++et) *(f32x4*)(sl + ((w * 7 + et) * 64 + lane) * 4) = Cst[et];
        if (w == 0 && lane == 0) sl[96 * 112] = Btot;
    }
    __syncthreads();
}
__device__ __forceinline__ void mlstm_load_rope(const Ctx& F, const float* rope_tab) {
    LAS f32x2* ROPE = (LAS f32x2*)(F.lds + ml::OFF_ROPE);
    for (int i = F.tid; i < 64 * 24; i += 512) ROPE[i] = ((const f32x2*)rope_tab)[i];
}
__device__ __forceinline__ void mlstm_itemA(const Ctx& F, int l, int bh, int it, bf16* otmp, float* ST) {
    const int b = bh >> 2, h = bh & 3;
    if (it == 0) {
        const MlJob jb{b, h, 1, 0, 4};
        mlstm_dir(F, l, jb, 0, -1, 0, l == 0 ? 1 : 0, otmp, ST);
        mlstm_dir(F, l, jb, 1, -1, 0, l == 0 ? 2 : 0, otmp, ST);
    } else {
        const int dir = (it - 1) / (NSEG - 1), k = (it - 1) % (NSEG - 1), seg = dir == 0 ? k : NSEG - 1 - k;
        const MlJob jb{b, h, 0, SEGTOK * seg, SEGCH};
        mlstm_dir(F, l, jb, dir, -1, 1 + k, 0, otmp, ST);
    }
}
__device__ __forceinline__ void mlstm_itemC(const Ctx& F, int l, int bh, int seg, bf16* otmp, float* ST) {
    const MlJob jb{bh >> 2, bh & 3, 0, SEGTOK * seg, SEGCH};
    mlstm_dir(F, l, jb, 0, seg, -1, 1, otmp, ST);
    mlstm_dir(F, l, jb, 1, NSEG - 1 - seg, -1, 2, otmp, ST);
}

namespace hg {
constexpr int STR = 72;
constexpr int IMG = 64 * STR * 2;
constexpr int OFF_KO = 0, OFF_KH = IMG, OFF_VS = 2 * IMG, OFF_QJ = 3 * IMG, OFF_ST = 7 * IMG, OFF_HT = 9 * IMG, OFF_TOT = OFF_HT + 64 * 68 * 4, OFF_BL = OFF_TOT + 8 * 64 * 4, OFF_END = OFF_BL + 512;
static_assert(OFF_END <= RING_BYTES, "hgrn LDS");
constexpr int ST_FLOATS = 64 * 64 + 64;
}
__device__ __forceinline__ void hgrn_dir(const Ctx& F, int l, const MlJob jb, int dir, int fold_r, int emit_slot, int mode, bf16* otmp, float* ST) {
    using namespace hg;
    int tid_ = F.tid; asm volatile("" : "+v"(tid_));
    const int tid = tid_, lane = tid & 63, w = __builtin_amdgcn_readfirstlane(tid >> 6), g = lane >> 4, c = lane & 15;
    LAS bf16* KO = (LAS bf16*)(F.lds + OFF_KO); LAS bf16* KH = (LAS bf16*)(F.lds + OFF_KH); LAS bf16* VS = (LAS bf16*)(F.lds + OFF_VS); LAS bf16* QJ = (LAS bf16*)(F.lds + OFF_QJ);
    LAS bf16* ST0 = (LAS bf16*)(F.lds + OFF_ST); LAS float* HT = (LAS float*)(F.lds + OFF_HT); LAS float* TOT = (LAS float*)(F.lds + OFF_TOT); LAS float* BL = (LAS float*)(F.lds + OFF_BL);
    const int rowbase = jb.isctx ? MX + jb.b * CTX : jb.b * S;
    const int h = jb.h; const bf16* P = F.P;
    float* STd = ST + (size_t)(((jb.b * 4 + h) * 2 + dir) * 8) * ST_FLOATS;
    const int dt = w >> 1, et0 = 2 * (w & 1);
    f32x4 Sst[2]; float Btot[4];
#pragma unroll
    for (int i = 0; i < 2; ++i) Sst[i] = (f32x4){0.f, 0.f, 0.f, 0.f};
#pragma unroll
    for (int r = 0; r < 4; ++r) Btot[r] = 0.f;
    if (fold_r >= 0) {
        f32x4 v[8][2], dk[8];
#pragma unroll
        for (int k = 0; k < NSEG; ++k) { const float* sl = STd + (size_t)k * ST_FLOATS; v[k][0] = *(const f32x4*)(sl + ((w * 2 + 0) * 64 + lane) * 4); v[k][1] = *(const f32x4*)(sl + ((w * 2 + 1) * 64 + lane) * 4);
            dk[k] = *(const f32x4*)(sl + 64 * 64 + 16 * dt + 4 * g); }
        f32x4 run = (f32x4){1.f, 1.f, 1.f, 1.f};
#pragma unroll
        for (int k = NSEG - 1; k >= 0; --k) { const float on = (k <= fold_r) ? 1.f : 0.f; Sst[0] += v[k][0] * (run * on); Sst[1] += v[k][1] * (run * on);
            if (k >= 1) { const bool use = k <= fold_r; run[0] *= use ? __expf(dk[k][0]) : 1.f; run[1] *= use ? __expf(dk[k][1]) : 1.f; run[2] *= use ? __expf(dk[k][2]) : 1.f; run[3] *= use ? __expf(dk[k][3]) : 1.f; } }
    }
    if (mode != 0) {
#pragma unroll
        for (int i = 0; i < 2; ++i) { v2u v; v.x = pk2(Sst[i][0], Sst[i][1]); v.y = pk2(Sst[i][2], Sst[i][3]); *(LAS v2u*)(ST0 + (16 * (et0 + i) + c) * STR + 16 * dt + 4 * g) = v; }
    }
    const int ps = tid >> 3, oct = tid & 7, d0 = 8 * oct;
    float lbv[8];
#pragma unroll
    for (int e = 0; e < 8; ++e) { lbv[e] = 0.f;
        if (l == 1) { const float v0 = F.hgrn_lb[(0 * 2 + dir) * 256 + h * 64 + d0 + e], v1 = F.hgrn_lb[(1 * 2 + dir) * 256 + h * 64 + d0 + e]; lbv[e] = 1.f / (1.f + expf(v0 - v1)); } }
    const int fcol = dir ? A_FB : A_FF;
    auto tok_of = [&](int ci, int i) -> int { return dir == 0 ? jb.t0 + 64 * ci + i : jb.t0 + 64 * (jb.nchunk - 1 - ci) + (63 - i); };
    v4u rq, rf, rv; rq = rf = rv = (v4u){0u, 0u, 0u, 0u};
    v4u ft = (v4u){0u, 0u, 0u, 0u}, fz = (v4u){0u, 0u, 0u, 0u};
    const int fi_i = tid >> 3, fi_e0 = 8 * (tid & 7);
    float gnv[8];
#pragma unroll
    for (int e = 0; e < 8; ++e) gnv[e] = (mode == 2) ? F.hgrn_gn[l * 256 + h * 64 + fi_e0 + e] : 0.f;
    auto issue_loads = [&](int ci) {
        const bf16* pr = P + (size_t)(rowbase + tok_of(ci, ps)) * PLD + h * 64 + d0;
        if (mode != 0) rq = *(const v4u*)(pr + A_Q);
        rf = *(const v4u*)(pr + fcol); rv = *(const v4u*)(pr + A_I);
    };
    auto issue_fin = [&](int ci) { const int m = rowbase + tok_of(ci, fi_i); ft = *(const v4u*)(otmp + (size_t)m * 256 + h * 64 + fi_e0); fz = *(const v4u*)(P + (size_t)m * PLD + A_Z + h * 64 + fi_e0); };
    issue_loads(0);
    __syncthreads();
    for (int ci = 0; ci < jb.nchunk; ++ci) {
        LAS bf16* STc = ST0 + (ci & 1) * 64 * STR; LAS bf16* STn = ST0 + ((ci + 1) & 1) * 64 * STR;
        float qv[8], kk[8], bb[8], fl[8];
        unpack8(rf, fl);
#pragma unroll
        for (int e = 0; e < 8; ++e) { const float sg = sigmoid_f(fl[e]); const float f = lbv[e] + (1.f - lbv[e]) * sg; bb[e] = __logf(f); kk[e] = (1.f - lbv[e]) * (1.f - sg); }
        if (mode != 0) unpack8(rq, qv);
        const v4u vraw = rv;
        if (ci + 1 < jb.nchunk) issue_loads(ci + 1);
        if (mode == 2) issue_fin(ci);
#pragma unroll
        for (int o = 8; o < 64; o <<= 1) {
#pragma unroll
            for (int e = 0; e < 8; ++e) { const float t = __shfl_up(bb[e], o); if (lane >= o) bb[e] += t; } }
        if (lane >= 56) { *(LAS f32x4*)(TOT + w * 64 + d0) = (f32x4){bb[0], bb[1], bb[2], bb[3]}; *(LAS f32x4*)(TOT + w * 64 + d0 + 4) = (f32x4){bb[4], bb[5], bb[6], bb[7]}; }
        __syncthreads();
        {
            float run[8], pre[8], ref1[8], ref2[8], ref3[8];
#pragma unroll
            for (int e = 0; e < 8; ++e) { run[e] = 0.f; pre[e] = 0.f; ref1[e] = ref2[e] = ref3[e] = 0.f; }
#pragma unroll
            for (int ww = 0; ww < 8; ++ww) {
                if (ww == w) {
#pragma unroll
                    for (int e = 0; e < 8; ++e) pre[e] = run[e]; }
                if (ww == 2) {
#pragma unroll
                    for (int e = 0; e < 8; ++e) ref1[e] = run[e]; }
                if (ww == 4) {
#pragma unroll
                    for (int e = 0; e < 8; ++e) ref2[e] = run[e]; }
                if (ww == 6) {
#pragma unroll
                    for (int e = 0; e < 8; ++e) ref3[e] = run[e]; }
                const f32x4 t0 = *(const LAS f32x4*)(TOT + ww * 64 + d0), t1 = *(const LAS f32x4*)(TOT + ww * 64 + d0 + 4);
                run[0] += t0[0]; run[1] += t0[1]; run[2] += t0[2]; run[3] += t0[3]; run[4] += t1[0]; run[5] += t1[1]; run[6] += t1[2]; run[7] += t1[3];
            }
            const int sub = ps >> 4;
            float o8[8];
#pragma unroll
            for (int e = 0; e < 8; ++e) bb[e] += pre[e];
#pragma unroll
            for (int e = 0; e < 8; ++e) { const float rown = sub == 0 ? 0.f : (sub == 1 ? ref1[e] : (sub == 2 ? ref2[e] : ref3[e])); o8[e] = kk[e] * __expf(rown - bb[e]); }
            if (mode != 0) *(LAS v4u*)(KO + ps * STR + d0) = pack8(o8);
#pragma unroll
            for (int e = 0; e < 8; ++e) o8[e] = kk[e] * __expf(run[e] - bb[e]);
            *(LAS v4u*)(KH + ps * STR + d0) = pack8(o8);
            *(LAS v4u*)(VS + ps * STR + d0) = vraw;
            if (mode != 0) {
#pragma unroll
                for (int e = 0; e < 8; ++e) o8[e] = qv[e] * __expf(bb[e]);
                *(LAS v4u*)(QJ + ps * STR + d0) = pack8(o8);
                if (sub >= 1) {
#pragma unroll
                    for (int e = 0; e < 8; ++e) o8[e] = qv[e] * __expf(bb[e] - ref1[e]);
                    *(LAS v4u*)(QJ + (64 + ps) * STR + d0) = pack8(o8); }
                if (sub >= 2) {
#pragma unroll
                    for (int e = 0; e < 8; ++e) o8[e] = qv[e] * __expf(bb[e] - ref2[e]);
                    *(LAS v4u*)(QJ + (128 + ps) * STR + d0) = pack8(o8); }
                if (sub >= 3) {
#pragma unroll
                    for (int e = 0; e < 8; ++e) o8[e] = qv[e] * __expf(bb[e] - ref3[e]);
                    *(LAS v4u*)(QJ + (192 + ps) * STR + d0) = pack8(o8); }
            }
            if (ps == 0) { *(LAS f32x4*)(BL + d0) = (f32x4){run[0], run[1], run[2], run[3]}; *(LAS f32x4*)(BL + d0 + 4) = (f32x4){run[4], run[5], run[6], run[7]}; }
        }
        __syncthreads();
        if (mode != 0) {
            const int tt = w & 3, eh = w >> 2;
            f32x4 at[4];
            { bf16x8 kf[4][2], qjf[4][2];
#pragma unroll
              for (int j = 0; j < 4; ++j) if (j <= tt) {
#pragma unroll
                  for (int ks = 0; ks < 2; ++ks) { kf[j][ks] = rm_frag(KO, STR, 16 * j + c, 32 * ks + 8 * g); qjf[j][ks] = rm_frag(QJ + j * 64 * STR, STR, 16 * tt + c, 32 * ks + 8 * g); } }
              LDS_FENCE();
#pragma unroll
              for (int j = 0; j < 4; ++j) { at[j] = (f32x4){0.f, 0.f, 0.f, 0.f};
                  if (j <= tt) {
#pragma unroll
                      for (int ks = 0; ks < 2; ++ks) at[j] = mfma16(kf[j][ks], qjf[j][ks], at[j]);
                      if (j == tt) {
#pragma unroll
                          for (int r = 0; r < 4; ++r) if (4 * g + r > c) at[j][r] = 0.f; }
                  } } }
            bf16x8 pf[2];
#pragma unroll
            for (int k2 = 0; k2 < 2; ++k2) { const unsigned u0 = pk2(at[2 * k2][0], at[2 * k2][1]), u1 = pk2(at[2 * k2][2], at[2 * k2][3]), u2 = pk2(at[2 * k2 + 1][0], at[2 * k2 + 1][1]), u3 = pk2(at[2 * k2 + 1][2], at[2 * k2 + 1][3]);
                pf[k2] = __builtin_bit_cast(bf16x8, (v4u){u0, u1, u2, u3}); }
            { bf16x8 qf[2], vf[2][2], sf[2][2];
#pragma unroll
              for (int ks = 0; ks < 2; ++ks) qf[ks] = rm_frag(QJ, STR, 16 * tt + c, 32 * ks + 8 * g);
#pragma unroll
              for (int ei = 0; ei < 2; ++ei) { const int et = 2 * eh + ei;
#pragma unroll
                  for (int k2 = 0; k2 < 2; ++k2) if (2 * k2 <= tt) vf[ei][k2] = tr_frag(VS, STR, 32 * k2 + 4 * g, 32 * k2 + 16 + 4 * g, 16 * et, lane);
#pragma unroll
                  for (int ks = 0; ks < 2; ++ks) sf[ei][ks] = rm_frag(STc, STR, 16 * et + c, 32 * ks + 8 * g); }
              LDS_FENCE();
#pragma unroll
              for (int ei = 0; ei < 2; ++ei) { const int et = 2 * eh + ei;
                  f32x4 acc = (f32x4){0.f, 0.f, 0.f, 0.f};
#pragma unroll
                  for (int k2 = 0; k2 < 2; ++k2) if (2 * k2 <= tt) acc = mfma16(vf[ei][k2], pf[k2], acc);
#pragma unroll
                  for (int ks = 0; ks < 2; ++ks) acc = mfma16(sf[ei][ks], qf[ks], acc);
                  *(LAS f32x4*)(HT + (16 * tt + c) * 68 + 16 * et + 4 * g) = acc; } }
        }
        {
            const f32x4 blv = *(const LAS f32x4*)(BL + 16 * dt + 4 * g);
#pragma unroll
            for (int r = 0; r < 4; ++r) { const float dec = __expf(blv[r]); Sst[0][r] *= dec; Sst[1][r] *= dec; Btot[r] += blv[r]; }
            { bf16x8 af[2], vf[2][2];
#pragma unroll
              for (int k2 = 0; k2 < 2; ++k2) { af[k2] = tr_frag(KH, STR, 32 * k2 + 8 * g, 32 * k2 + 8 * g + 4, 16 * dt, lane);
#pragma unroll
                  for (int i = 0; i < 2; ++i) vf[k2][i] = tr_frag(VS, STR, 32 * k2 + 8 * g, 32 * k2 + 8 * g + 4, 16 * (et0 + i), lane); }
              LDS_FENCE();
#pragma unroll
              for (int k2 = 0; k2 < 2; ++k2)
#pragma unroll
                  for (int i = 0; i < 2; ++i) Sst[i] = mfma16(af[k2], vf[k2][i], Sst[i]); }
            if (mode != 0) {
#pragma unroll
                for (int i = 0; i < 2; ++i) { v2u v; v.x = pk2(Sst[i][0], Sst[i][1]); v.y = pk2(Sst[i][2], Sst[i][3]); *(LAS v2u*)(STn + (16 * (et0 + i) + c) * STR + 16 * dt + 4 * g) = v; } }
        }
        __syncthreads();
        if (mode != 0) {
            const int i = tid >> 3, sub8 = tid & 7, e0 = 8 * sub8; const int m = rowbase + tok_of(ci, i);
            float hv[8];
            { const f32x4 a0 = *(const LAS f32x4*)(HT + i * 68 + e0), a1 = *(const LAS f32x4*)(HT + i * 68 + e0 + 4); hv[0] = a0[0]; hv[1] = a0[1]; hv[2] = a0[2]; hv[3] = a0[3]; hv[4] = a1[0]; hv[5] = a1[1]; hv[6] = a1[2]; hv[7] = a1[3]; }
            bf16* tp = otmp + (size_t)m * 256 + h * 64 + e0;
            if (mode == 1) *(v4u*)tp = pack8(hv);
            else {
                float tv[8]; unpack8(ft, tv);
                float ss = 0.f;
#pragma unroll
                for (int e = 0; e < 8; ++e) { hv[e] += tv[e]; ss += hv[e] * hv[e]; }
                ss = group8_sum(ss);
                const float rinv = 1.f / sqrtf(ss * (1.f / 64.f) + EPS);
                float zv[8]; unpack8(fz, zv);
#pragma unroll
                for (int e = 0; e < 8; ++e) hv[e] = hv[e] * rinv * gnv[e] * zv[e];
                *(v4u*)(F.hxy + (size_t)m * 1024 + h * 64 + e0) = pack8(hv);
            }
        }
    }
    if (emit_slot >= 0) {
        float* sl = STd + (size_t)emit_slot * ST_FLOATS;
        *(f32x4*)(sl + ((w * 2 + 0) * 64 + lane) * 4) = Sst[0]; *(f32x4*)(sl + ((w * 2 + 1) * 64 + lane) * 4) = Sst[1];
        if ((w & 1) == 0 && c == 0) *(f32x4*)(sl + 64 * 64 + 16 * dt + 4 * g) = (f32x4){Btot[0], Btot[1], Btot[2], Btot[3]};
    }
    __syncthreads();
}
__device__ __forceinline__ void hgrn_itemA(const Ctx& F, int l, int bh, int it, bf16* otmp, float* ST) {
    const int b = bh >> 2, h = bh & 3;
    if (it == 0) {
        const MlJob jb{b, h, 1, 0, 4};
        hgrn_dir(F, l, jb, 0, -1, 0, l == 0 ? 1 : 0, otmp, ST);
        hgrn_dir(F, l, jb, 1, -1, 0, l == 0 ? 2 : 0, otmp, ST);
    } else {
        const int dir = (it - 1) / (NSEG - 1), k = (it - 1) % (NSEG - 1), seg = dir == 0 ? k : NSEG - 1 - k;
        const MlJob jb{b, h, 0, SEGTOK * seg, SEGCH};
        hgrn_dir(F, l, jb, dir, -1, 1 + k, 0, otmp, ST);
    }
}
__device__ __forceinline__ void hgrn_itemC(const Ctx& F, int l, int bh, int seg, bf16* otmp, float* ST) {
    const MlJob jb{bh >> 2, bh & 3, 0, SEGTOK * seg, SEGCH};
    hgrn_dir(F, l, jb, 0, seg, -1, 1, otmp, ST);
    hgrn_dir(F, l, jb, 1, NSEG - 1 - seg, -1, 2, otmp, ST);
}

namespace nat {
constexpr int STR = 72, IMG = 64 * STR * 2;
constexpr int OFF_K = 0, OFF_V = 2 * IMG, OFF_RPB = 4 * IMG, OFF_END = OFF_RPB + 2048;
static_assert(OFF_END <= RING_BYTES, "na LDS");
}
template <int CH, bool WIN>
__device__ __forceinline__ void na_block(const LAS bf16* Kc, const LAS bf16* Vc, const LAS float* RPB, const bf16x8 (&qf)[2][2], f32x4 (&oacc)[2][4], float (&mrun)[2], float (&lrun)[2],
                                         const int g, const int c, const int lane, const int dr, const int (&qcol)[2], const int (&csq)[2]) {
    constexpr int STR = nat::STR;
    constexpr int KLO[2] = {WIN ? (CH == 0 ? 0 : 1) : 0, WIN ? (CH == 0 ? 0 : 2) : 0}, KHI[2] = {WIN ? (CH == 0 ? 1 : 3) : 3, WIN ? (CH == 0 ? 2 : 3) : 3};
    constexpr int ULO = KLO[0] < KLO[1] ? KLO[0] : KLO[1], UHI = KHI[0] > KHI[1] ? KHI[0] : KHI[1];
    f32x4 st[2][4];
    { bf16x8 kf[4][2];
#pragma unroll
      for (int kt = ULO; kt <= UHI; ++kt)
#pragma unroll
          for (int ks = 0; ks < 2; ++ks) kf[kt][ks] = rm_frag(Kc, STR, 16 * kt + c, 32 * ks + 8 * g);
      LDS_FENCE();
#pragma unroll
      for (int qt = 0; qt < 2; ++qt)
#pragma unroll
          for (int kt = 0; kt < 4; ++kt) { st[qt][kt] = (f32x4){0.f, 0.f, 0.f, 0.f};
              if (kt >= KLO[qt] && kt <= KHI[qt]) {
#pragma unroll
                  for (int ks = 0; ks < 2; ++ks) st[qt][kt] = mfma16(kf[kt][ks], qf[qt][ks], st[qt][kt]); } } }
    if (WIN) {
#pragma unroll
        for (int qt = 0; qt < 2; ++qt) { const int boff = dr * 31 + 15 - qcol[qt];
#pragma unroll
            for (int kt = KLO[qt]; kt <= KHI[qt]; ++kt)
#pragma unroll
                for (int r = 0; r < 4; ++r) { const int kc = 16 * kt + 4 * g + r; const float bias = RPB[min(max(boff + kc, 0), 464)]; const float v = st[qt][kt][r] + bias; st[qt][kt][r] = ((unsigned)(kc - csq[qt]) < 16u) ? v : -1e30f; } }
    }
    float alpha[2]; bf16x8 pf[2][2];
#pragma unroll
    for (int qt = 0; qt < 2; ++qt) {
        float bm = -1e30f;
#pragma unroll
        for (int kt = KLO[qt]; kt <= KHI[qt]; ++kt)
#pragma unroll
            for (int r = 0; r < 4; ++r) bm = fmaxf(bm, st[qt][kt][r]);
        bm = xor32_max(xor16_max(bm));
        const float mnew = fmaxf(mrun[qt], bm); alpha[qt] = __builtin_amdgcn_exp2f(mrun[qt] - mnew); mrun[qt] = mnew;
        float ps = 0.f;
#pragma unroll
        for (int kt = KLO[qt]; kt <= KHI[qt]; ++kt)
#pragma unroll
            for (int r = 0; r < 4; ++r) { const float p = __builtin_amdgcn_exp2f(st[qt][kt][r] - mnew); st[qt][kt][r] = p; ps += p; }
        lrun[qt] = lrun[qt] * alpha[qt] + ps;
#pragma unroll
        for (int k2 = 0; k2 < 2; ++k2) { const unsigned u0 = pk2(st[qt][2 * k2][0], st[qt][2 * k2][1]), u1 = pk2(st[qt][2 * k2][2], st[qt][2 * k2][3]), u2 = pk2(st[qt][2 * k2 + 1][0], st[qt][2 * k2 + 1][1]), u3 = pk2(st[qt][2 * k2 + 1][2], st[qt][2 * k2 + 1][3]);
            pf[qt][k2] = __builtin_bit_cast(bf16x8, (v4u){u0, u1, u2, u3}); }
    }
    { bf16x8 vf[4][2];
#pragma unroll
      for (int dtl = 0; dtl < 4; ++dtl)
#pragma unroll
          for (int k2 = ULO / 2; k2 <= UHI / 2; ++k2) vf[dtl][k2] = tr_frag(Vc, STR, 32 * k2 + 4 * g, 32 * k2 + 16 + 4 * g, 16 * dtl, lane);
      LDS_FENCE();
#pragma unroll
      for (int qt = 0; qt < 2; ++qt)
#pragma unroll
          for (int dtl = 0; dtl < 4; ++dtl) { f32x4 a = oacc[qt][dtl] * alpha[qt];
#pragma unroll
              for (int k2 = KLO[qt] / 2; k2 <= KHI[qt] / 2; ++k2) a = mfma16(vf[dtl][k2], pf[qt][k2], a);
              oacc[qt][dtl] = a; } }
}
__device__ __forceinline__ void na_item(const Ctx& F, int l, int b, int h, int R0) {
    using namespace nat;
    int tid_ = F.tid; asm volatile("" : "+v"(tid_));
    const int tid = tid_, lane = tid & 63, w = __builtin_amdgcn_readfirstlane(tid >> 6), g = lane >> 4, c = lane & 15;
    LAS bf16* KT = (LAS bf16*)(F.lds + OFF_K); LAS bf16* VT = (LAS bf16*)(F.lds + OFF_V); LAS float* RPB = (LAS float*)(F.lds + OFF_RPB);
    const bf16* P = F.P; const bool lat = R0 >= 0;
    const int R = R0 + (w >> 1), ch = w & 1;
    const int rsR = min(max(R - 4, 0), 56);
    const int kr0 = lat ? min(max(R0 - 4, 0), 56) : 0;
    const int nwin = lat ? (min(max(R0 + 3 - 4, 0), 56) + 8 - kr0) : 0, nblk = nwin + 4;
    if (lat) for (int i = tid; i < 15 * 31; i += 512) RPB[i] = F.na_rpb[((size_t)l * 6 + h) * 465 + i] * 1.4426950408889634f;
    int mq[2]; bf16x8 qf[2][2]; int csq[2], qcol[2];
#pragma unroll
    for (int qt = 0; qt < 2; ++qt) {
        if (lat) { qcol[qt] = 32 * ch + 16 * qt + c; mq[qt] = b * S + R * 64 + qcol[qt]; } else { qcol[qt] = 0; mq[qt] = MX + b * CTX + 32 * w + 16 * qt + c; }
        csq[qt] = min(max(qcol[qt] - 8, 0), 48);
#pragma unroll
        for (int ks = 0; ks < 2; ++ks) qf[qt][ks] = *(const bf16x8*)(P + (size_t)mq[qt] * PLD + C_Q + h * 64 + 32 * ks + 8 * g);
    }
    f32x4 oacc[2][4]; float mrun[2], lrun[2];
#pragma unroll
    for (int qt = 0; qt < 2; ++qt) { mrun[qt] = -1e30f; lrun[qt] = 0.f;
#pragma unroll
        for (int dtl = 0; dtl < 4; ++dtl) oacc[qt][dtl] = (f32x4){0.f, 0.f, 0.f, 0.f}; }
    const int stok = tid >> 3, spc = tid & 7;
    auto blk_row = [&](int i) -> int { return i < nwin ? b * S + (kr0 + i) * 64 + stok : MX + b * CTX + 64 * (i - nwin) + stok; };
    v4u rk0, rv0, rk1, rv1, rk2, rv2;
    auto ld = [&](int i, v4u& k_, v4u& v_) { const int ii = i < nblk ? i : nblk - 1; const bf16* pr = P + (size_t)blk_row(ii) * PLD + h * 64 + 8 * spc; k_ = *(const v4u*)(pr + C_K); v_ = *(const v4u*)(pr + C_V); };
    ld(0, rk0, rv0); ld(1, rk1, rv1); ld(2, rk2, rv2);
    __syncthreads();
    *(LAS v4u*)(KT + stok * STR + 8 * spc) = rk0; *(LAS v4u*)(VT + stok * STR + 8 * spc) = rv0;
    ld(3, rk0, rv0);
    __syncthreads();
    auto step = [&](int i, v4u& kn, v4u& vn) {
        const LAS bf16* Kc = KT + (i & 1) * 64 * STR; const LAS bf16* Vc = VT + (i & 1) * 64 * STR;
        if (i + 1 < nblk) { LAS bf16* Kn = KT + ((i + 1) & 1) * 64 * STR; LAS bf16* Vn = VT + ((i + 1) & 1) * 64 * STR;
            *(LAS v4u*)(Kn + stok * STR + 8 * spc) = kn; *(LAS v4u*)(Vn + stok * STR + 8 * spc) = vn;
            if (i + 4 < nblk) ld(i + 4, kn, vn); }
        const bool win = i < nwin; const int kr = kr0 + i;
        const bool active = !win || (kr >= rsR && kr < rsR + 8);
        if (active) {
            if (!win) na_block<0, false>(Kc, Vc, RPB, qf, oacc, mrun, lrun, g, c, lane, 0, qcol, csq);
            else if (ch == 0) na_block<0, true>(Kc, Vc, RPB, qf, oacc, mrun, lrun, g, c, lane, kr - R + 7, qcol, csq);
            else na_block<1, true>(Kc, Vc, RPB, qf, oacc, mrun, lrun, g, c, lane, kr - R + 7, qcol, csq);
        }
        __syncthreads();
    };
    for (int i = 0; i < nblk; i += 3) { step(i, rk1, rv1); if (i + 1 < nblk) step(i + 1, rk2, rv2); if (i + 2 < nblk) step(i + 2, rk0, rv0); }
#pragma unroll
    for (int qt = 0; qt < 2; ++qt) {
        const float lt = xor32_sum(xor16_sum(lrun[qt]));
        const float rl = 1.f / lt;
        const bf16* zr = P + (size_t)mq[qt] * PLD + C_Z + h * 64; bf16* yr = F.hxy + (size_t)mq[qt] * 1024 + 640 + h * 64;
#pragma unroll
        for (int dtl = 0; dtl < 4; ++dtl) { const int d = 16 * dtl + 4 * g; const v2u zv = *(const v2u*)(zr + d);
            const float z0 = __uint_as_float(zv.x << 16), z1 = __uint_as_float(zv.x & 0xffff0000u), z2 = __uint_as_float(zv.y << 16), z3 = __uint_as_float(zv.y & 0xffff0000u);
            v2u o; o.x = pk2(oacc[qt][dtl][0] * rl * z0, oacc[qt][dtl][1] * rl * z1); o.y = pk2(oacc[qt][dtl][2] * rl * z2, oacc[qt][dtl][3] * rl * z3);
            *(v2u*)(yr + d) = o; }
    }
}

__device__ __forceinline__ void phase_mixA(const Ctx& F, int l, unsigned* ticket) {
    mlstm_load_rope(F, F.rope);
    volatile LAS unsigned* slot = (volatile LAS unsigned*)(F.lds + MISC_OFF) + 16;
    const int n_ctx = 64, n_na = 768, n_loc = 2 * 32 * 2 * (NSEG - 1), n_nactx = (l == 0) ? 48 : 0, n_all = n_ctx + n_na + n_loc + n_nactx;
    unsigned cur = 0;
    if (F.tid == 0) *slot = __hip_atomic_fetch_add(ticket, 1u, __ATOMIC_RELAXED, __HIP_MEMORY_SCOPE_AGENT);
    __syncthreads();
    cur = *slot;
    while ((int)cur < n_all) {
        unsigned nxt = 0;
        if (F.tid == 0) nxt = __hip_atomic_fetch_add(ticket, 1u, __ATOMIC_RELAXED, __HIP_MEMORY_SCOPE_AGENT);
        int it = (int)cur;
        const int tkind = it < n_ctx ? 22 : (it < n_ctx + n_na ? 20 : (it < n_ctx + n_na + n_loc ? (it < n_ctx + n_na + n_loc / 2 ? 21 : 23) : 24));
        if (l == 0) { TS_START(F, tkind); if (PROBE_T == 25 && blockIdx.x == 0 && F.tid == 0) TS_LDS(F)[0] += 2000; }
        if (it < n_ctx) { if (it < 32) mlstm_itemA(F, l, it, 0, F.otm, F.stm); else hgrn_itemA(F, l, it - 32, 0, F.oth, F.sth); }
        else if ((it -= n_ctx) < n_na) na_item(F, l, it / 96, (it / 16) % 6, 4 * (it % 16));
        else if ((it -= n_na) < n_loc) { constexpr int NL = 2 * (NSEG - 1); if (it < 32 * NL) mlstm_itemA(F, l, it / NL, 1 + it % NL, F.otm, F.stm); else { it -= 32 * NL; hgrn_itemA(F, l, it / NL, 1 + it % NL, F.oth, F.sth); } }
        else { it -= n_loc; na_item(F, l, it / 6, it % 6, -1); }
        if (l == 0) TS_STOP(F, tkind);
        __syncthreads();
        if (F.tid == 0) *slot = nxt;
        __syncthreads();
        cur = *slot;
    }
}
__device__ __forceinline__ void phase_mixC(const Ctx& F, int l) {
    mlstm_load_rope(F, F.rope);
    for (int it = F.vcu; it < 2 * 32 * NSEG; it += F.G) {
        if (it < 32 * NSEG) mlstm_itemC(F, l, it / NSEG, it % NSEG, F.otm, F.stm);
        else hgrn_itemC(F, l, (it - 32 * NSEG) / NSEG, it % NSEG, F.oth, F.sth);
    }
}

constexpr int NPH = 12;
struct Args { const float* in[15]; float* out; unsigned char* ws; int ph_lo, ph_hi; };
__global__ void __launch_bounds__(512, 2) mega_fwd(Args args) {
    extern __shared__ __attribute__((aligned(16))) unsigned char lds[];
    Ctx F;
    F.lds = (LAS unsigned char*)lds;
    F.tid = threadIdx.x; F.lane = F.tid & 63; F.wave = __builtin_amdgcn_readfirstlane(F.tid >> 6);
    F.G = gridDim.x; { const int bx = blockIdx.x; F.vcu = (F.G % 8 == 0) ? (bx % 8) * (F.G / 8) + bx / 8 : bx; }
    F.gw = F.vcu * 8 + F.wave; F.NGW = F.G * 8;
    unsigned char* ws = args.ws;
    F.x = args.in[0]; F.c = args.in[1]; F.ctx = args.in[2]; F.c_ctx = args.in[3]; F.w_mod = args.in[4]; F.b_mod = args.in[5]; F.g_pre = args.in[6]; F.g_post = args.in[7];
    F.w_in = args.in[8]; F.w_out = args.in[9]; F.hgrn_lb = args.in[10]; F.hgrn_gn = args.in[11]; F.gate_b = args.in[12]; F.mlstm_gn = args.in[13]; F.na_rpb = args.in[14];
    F.out = args.out;
    F.wt_in = (bf16*)(ws + WS_WT_IN); F.wt_out = (bf16*)(ws + WS_WT_OUT); F.mod = (float*)(ws + WS_MOD); F.gates = (float*)(ws + WS_GATES); F.ctx1 = (float*)(ws + WS_CTX1);
    F.hxy = (bf16*)(ws + WS_HXY); F.P = (bf16*)(ws + WS_P); F.UX = (bf16*)(ws + WS_P); F.oth = (bf16*)(ws + WS_OH); F.sth = (float*)(ws + WS_STH); F.otm = (bf16*)(ws + WS_OM); F.stm = (float*)(ws + WS_STM); F.rope = (float*)(ws + WS_ROPE);
    for (int u = F.tid; u < (LDS_BYTES - LDSCTL_OFF) / 4; u += 512) ((LAS unsigned*)(F.lds + LDSCTL_OFF))[u] = 0u;
    __syncthreads();
    XcdBarrier bar = xcd_barrier_post((unsigned*)(ws + WS_CTL) + CW_BAR, (volatile LAS unsigned*)(F.lds + MISC_OFF) + 8);

    const int lo = args.ph_lo, hi = args.ph_hi;
#ifndef DUP_PHASE
#define DUP_PHASE -1
#endif
#define IN(k) (lo <= (k) && (k) < hi)
#define SEAM(k) do { if ((k) + 1 < hi) xcd_barrier(bar); } while (0)
#define PHASE(k, ...) if (IN(k)) { TS_START(F, 100 + (k)); __VA_ARGS__; if ((k) == DUP_PHASE) { xcd_barrier(bar); __VA_ARGS__; } SEAM(k); TS_STOP(F, 100 + (k)); }
    PHASE(0, phase_p0(F))
    PHASE(1, { phase_prenorm0(F); phase_p1_transposes(F); })
#define LAYER(l) \
    PHASE(2 + 5 * (l), { \
        pg8::Gemm g{F.hxy, F.wt_in + (size_t)(l) * NPAD * 1024, M, NPAD, 1024}; \
        pg8::EpiIn E{F.P, F.gates, F.gate_b + (l) * 16}; \
        pg8::StaticOrder SO; SO.init(M, NPAD, F.G, (int)blockIdx.x); pg8::gemm_phase<pg8::EpiIn, pg8::StaticOrder, true, true>(F.lds + RING_OFF, g, SO, E); }) \
    PHASE(3 + 5 * (l), phase_mixA(F, (l), (unsigned*)(args.ws + WS_CTL) + 8192 + 64 * (l))) \
    PHASE(4 + 5 * (l), phase_mixC(F, (l))) \
    PHASE(5 + 5 * (l), { \
        constexpr int Ml = (l) == 0 ? M : MX; \
        pg8::Gemm g{F.hxy, F.wt_out + (size_t)(l) * 1024 * 1024, Ml, 1024, 1024}; pg8::StaticOrder SO; SO.init(Ml, 1024, F.G, (int)blockIdx.x); \
        pg8::EpiOut E{F.UX}; \
        pg8::gemm_phase<pg8::EpiOut, pg8::StaticOrder, true, true>(F.lds + RING_OFF, g, SO, E); }) \
    PHASE(6 + 5 * (l), phase_post(F, (l)))
    LAYER(0)
    LAYER(1)
#undef LAYER
#undef PHASE
#undef IN
#undef SEAM
    if (PROBE_T != 0 && blockIdx.x == 0 && F.tid == 0) { const unsigned long long t0 = __builtin_amdgcn_s_memtime(), dt = 8ull * TS_LDS(F)[0]; while (__builtin_amdgcn_s_memtime() - t0 < dt) __builtin_amdgcn_s_sleep(8); }
}

extern "C" void kernel_launch(void* const* d_in, const int* in_sizes, int n_in, void* d_out, int out_size, void* d_ws, size_t ws_size, hipStream_t stream) {
    static int grid = 0;
    if (grid == 0) {
        if (n_in != 15 || ws_size < WS_END) { fprintf(stderr, "kernel_launch: unexpected n_in %d / ws_size %zu (need %zu); nothing launched\n", n_in, ws_size, (size_t)WS_END); grid = -1; return; }
        int dev = 0, cus = 0, per_cu = 0;
        if (hipGetDevice(&dev) != hipSuccess || hipDeviceGetAttribute(&cus, hipDeviceAttributeMultiprocessorCount, dev) != hipSuccess) { grid = -1; return; }
        if (hipFuncSetAttribute((const void*)mega_fwd, hipFuncAttributeMaxDynamicSharedMemorySize, LDS_BYTES) != hipSuccess) { fprintf(stderr, "kernel_launch: hipFuncSetAttribute failed\n"); grid = -1; return; }
        if (hipOccupancyMaxActiveBlocksPerMultiprocessor(&per_cu, (const void*)mega_fwd, 512, LDS_BYTES) != hipSuccess || per_cu < 1) { fprintf(stderr, "kernel_launch: occupancy query says %d blocks/CU\n", per_cu); (void)hipGetLastError(); grid = -1; return; }
        grid = cus;
    }
    if (grid < 0) return;
    (void)hipMemsetAsync((char*)d_ws + WS_CTL, 0, CTL_BYTES, stream);
    Args a{};
    for (int i = 0; i < 15; ++i) a.in[i] = (const float*)d_in[i];
    a.out = (float*)d_out; a.ws = (unsigned char*)d_ws; a.ph_lo = 0; a.ph_hi = NPH;
    hipLaunchKernelGGL(mega_fwd, dim3(grid), dim3(512), LDS_BYTES, stream, a);
}
```

```cpp
#include <hip/hip_runtime.h>
#include <stdint.h>
#include <cstdio>

namespace cfg {
constexpr int D = 1024, NB = 8, S = 4096, CTX = 256;
constexpr int MX = NB * S, MC = NB * CTX, M = MX + MC;
constexpr int PIN = 4752, NPAD = 4864, PLD = 4736;
constexpr int A_Q = 0, A_FF = 256, A_FB = 512, A_I = 768, A_Z = 1024, B_Q = 1280, B_K = 1664, B_V = 2048, B_O = 2432, B_Z = 2816,
              C_Q = 3200, C_K = 3584, C_V = 3968, C_Z = 4352;
constexpr float EPS = 1e-6f;
constexpr size_t WS_CTL = 0, CTL_BYTES = 65536;
constexpr size_t WS_WT_IN = WS_CTL + CTL_BYTES;
constexpr size_t WS_WT_OUT = WS_WT_IN + 2ull * NPAD * 1024 * 2;
constexpr size_t WS_MOD = WS_WT_OUT + 2ull * 1024 * 1024 * 2;
constexpr size_t WS_GATES = WS_MOD + 2ull * 9 * 3072 * 4;
constexpr size_t WS_CTX1 = WS_GATES + (size_t)M * 16 * 4;
constexpr size_t WS_HXY = WS_CTX1 + (size_t)MC * 1024 * 4;
constexpr size_t WS_P = WS_HXY + (size_t)M * 1024 * 2;
constexpr size_t WS_OH = WS_P + (size_t)M * PLD * 2;
constexpr size_t WS_OM = WS_OH + (size_t)M * 256 * 4;
constexpr size_t WS_STM = WS_OM + (size_t)M * 384 * 2;
constexpr size_t WS_ROPE = WS_STM + 32ull * 2 * 8 * (96 * 112 + 16) * 4;
constexpr size_t WS_STH = WS_ROPE + 64 * 24 * 8;
constexpr size_t WS_END = WS_STH + 32ull * 2 * 8 * (64 * 64 + 64) * 4;
static_assert(WS_END <= 536870912ull, "workspace");
static_assert(WS_WT_IN % 256 == 0 && WS_MOD % 256 == 0 && WS_GATES % 256 == 0 && WS_CTX1 % 256 == 0 && WS_HXY % 256 == 0 && WS_P % 256 == 0 && WS_OH % 256 == 0 && WS_OM % 256 == 0 && WS_STM % 256 == 0 && WS_ROPE % 256 == 0 && WS_STH % 256 == 0, "align");
}
using namespace cfg;

namespace pg8 {
#define PG8_LAS __attribute__((address_space(3)))
typedef unsigned short bf16_t;
typedef short bf16x8 __attribute__((ext_vector_type(8)));
typedef float f32x4 __attribute__((ext_vector_type(4)));
typedef unsigned u32x4 __attribute__((ext_vector_type(4)));
constexpr int BM = 256, BK = 64, HALF = 128, HTB = HALF * BK * 2  , STAGE_BYTES = 8 * HTB, NXCD = 8, WGM = 8;

__host__ __device__ __forceinline__ int lds_byte(int r, int c) { const int st = (r >> 4) * 2 + (c >> 5), rr = r & 15, cc = c & 31, ob = rr * 64 + cc * 2; return st * 1024 + (ob ^ (((ob >> 9) & 1) << 5)); }
__host__ __device__ __forceinline__ void stage_rc(int b, int& R, int& C) { const int st = b / 1024, sb = b % 1024, swz = sb ^ (((sb >> 9) & 1) << 5); R = (st >> 1) * 16 + swz / 64; C = (st & 1) * 32 + (swz % 64) / 2; }
__host__ __device__ __forceinline__ int perm32(int rho) { const int n = rho >> 4, i = rho & 15; return 8 * (i >> 2) + 4 * n + (i & 3); }

struct Unit { int pm, pn; };
struct Gemm { const bf16_t* A; const bf16_t* Bt; int M, N, K; };

struct StaticOrder {
    int nM, nN, nwg, G, c;
    __host__ __device__ void init(int M, int N, int G_, int c_) { nM = M / BM; nN = N / BM; nwg = nM * nN; G = G_; c = c_; }
    __host__ __device__ bool next(int i, Unit& u) const {
        const long L = (long)i * G + c; if (L >= nwg) return false;
        int wgid = (int)L; { const int q = nwg / NXCD, r = nwg % NXCD, xcd = wgid % NXCD, off = wgid / NXCD; wgid = (xcd < r ? xcd * (q + 1) : r * (q + 1) + (xcd - r) * q) + off; }
        const int nig = WGM * nN, gid = wgid / nig, fm = gid * WGM, gsz = (nM - fm) < WGM ? (nM - fm) : WGM;
        u.pm = fm + ((wgid % nig) % gsz); u.pn = (wgid % nig) / gsz; return true;
    }
    __device__ __forceinline__ void a_ready(const Unit&) const {}
    __device__ __forceinline__ void done(const Unit&) const {}
};

__device__ __forceinline__ unsigned cvt_pk_bf16(float lo, float hi) { unsigned r; asm volatile("v_cvt_pk_bf16_f32 %0, %1, %2" : "=v"(r) : "v"(lo), "v"(hi)); return r; }
__device__ __forceinline__ float logsigmoid_e(float v) { return fminf(v, 0.f) - log1pf(__expf(-fabsf(v))); }

struct EpiIn {
    static constexpr bool PERM = true, AFTER_DRAIN = false;
    bf16_t* P; float* gates; const float* gate_b;
    __device__ __forceinline__ void operator()(const f32x4 (&acc)[2][2][4][2], const Unit& u, int wr, int wc, int fr, int fq) const {
        const int row0 = u.pm * BM + wr * 64 + fr, col0 = u.pn * BM + wc * 32 + 8 * fq;
#pragma unroll
        for (int bj = 0; bj < 2; ++bj) {
            const int col = col0 + bj * HALF;
            if (col < cfg::PLD) {
                const int act = col < 256 ? 1 : col < 1024 ? 0 : col < 1280 ? 2 : col < 1664 ? 3 : col < 2432 ? 0 : col < 2816 ? 4 : col < 3200 ? 2 : col < 3584 ? 5 : col < 4352 ? 0 : 2;
#pragma unroll
                for (int ai = 0; ai < 2; ++ai)
#pragma unroll
                    for (int m = 0; m < 4; ++m) { f32x4 v0 = acc[ai][bj][m][0], v1 = acc[ai][bj][m][1];
                        if (act == 1 || act == 2 || act == 4) { const float sc = act == 1 ? 0.125f : 1.f;
#pragma unroll
                            for (int e = 0; e < 4; ++e) { const float s0 = __builtin_amdgcn_rcpf(1.f + __expf(-v0[e])), s1 = __builtin_amdgcn_rcpf(1.f + __expf(-v1[e])); v0[e] = act == 4 ? s0 : v0[e] * s0 * sc; v1[e] = act == 4 ? s1 : v1[e] * s1 * sc; } }
                        else if (act == 3) { v0 = v0 * 0.10206207261596575f; v1 = v1 * 0.10206207261596575f; }
                        else if (act == 5) { v0 = v0 * (0.125f * 1.4426950408889634f); v1 = v1 * (0.125f * 1.4426950408889634f); }
                        u32x4 w; w.x = cvt_pk_bf16(v0[0], v0[1]); w.y = cvt_pk_bf16(v0[2], v0[3]); w.z = cvt_pk_bf16(v1[0], v1[1]); w.w = cvt_pk_bf16(v1[2], v1[3]);
                        *(u32x4*)(P + (size_t)(row0 + ai * HALF + m * 16) * cfg::PLD + col) = w; }
            } else if (col < cfg::PIN) {
                const int g0 = col - cfg::PLD;
                const f32x4 b0 = *(const f32x4*)(gate_b + g0), b1 = *(const f32x4*)(gate_b + g0 + 4);
#pragma unroll
                for (int ai = 0; ai < 2; ++ai)
#pragma unroll
                    for (int m = 0; m < 4; ++m) { f32x4 v0 = acc[ai][bj][m][0] + b0, v1 = acc[ai][bj][m][1] + b1;
                        if (g0 >= 8) {
#pragma unroll
                            for (int e = 0; e < 4; ++e) { v0[e] = logsigmoid_e(v0[e]); v1[e] = logsigmoid_e(v1[e]); } }
                        float* gp = gates + (size_t)(row0 + ai * HALF + m * 16) * 16 + g0;
                        *(f32x4*)gp = v0; *(f32x4*)(gp + 4) = v1; }
            }
        }
    }
};
struct EpiOut {
    static constexpr bool PERM = true, AFTER_DRAIN = false;
    bf16_t* C;
    __device__ __forceinline__ void operator()(const f32x4 (&acc)[2][2][4][2], const Unit& u, int wr, int wc, int fr, int fq) const {
        const int row0 = u.pm * BM + wr * 64 + fr, col0 = u.pn * BM + wc * 32 + 8 * fq;
#pragma unroll
        for (int ai = 0; ai < 2; ++ai)
#pragma unroll
            for (int m = 0; m < 4; ++m) { bf16_t* rowp = C + (size_t)(row0 + ai * HALF + m * 16) * 1024 + col0;
#pragma unroll
                for (int bj = 0; bj < 2; ++bj) { const f32x4 v0 = acc[ai][bj][m][0], v1 = acc[ai][bj][m][1];
                    u32x4 w; w.x = cvt_pk_bf16(v0[0], v0[1]); w.y = cvt_pk_bf16(v0[2], v0[3]); w.z = cvt_pk_bf16(v1[0], v1[1]); w.w = cvt_pk_bf16(v1[2], v1[3]);
                    *(u32x4*)(rowp + bj * HALF) = w; } }
    }
};

template <class Epi, class Sched, bool ALIGN_EPI = false, bool SP2 = false>
__device__ __forceinline__ void gemm_phase(PG8_LAS unsigned char* lds, const Gemm g, const Sched& S, const Epi& E) {
    const int tid = threadIdx.x, wid = __builtin_amdgcn_readfirstlane(tid >> 6), lane = tid & 63, wr = wid >> 2, wc = wid & 3, fr = lane & 15, fq = lane >> 4;
    const int K = g.K, nt = K / BK;
    unsigned voffA[2], voffB[2];
#pragma unroll
    for (int i = 0; i < 2; ++i) { int R, C; stage_rc(tid * 16 + i * 8192, R, C); const int Rb = Epi::PERM ? ((R & ~31) + perm32(R & 31)) : R;
        voffA[i] = (unsigned)(R * K + C) * 2u; voffB[i] = (unsigned)(Rb * K + C) * 2u; }
    const size_t kstep = (size_t)(BK * 2);
    const size_t hstep = (size_t)HALF * K * 2;
    const size_t tstep = 2 * hstep;
    const unsigned ldsw = (unsigned)wid * 1024u;
    const int aoff = lds_byte(wr * 64 + fr, fq * 8), boff = lds_byte(wc * 32 + fr, fq * 8);
#define PG8_SA(b, h) (((b) * 2 + (h)) * HTB)
#define PG8_SB(b, h) ((4 + (b) * 2 + (h)) * HTB)
#define PG8_STAGE(bufoff, gbase, voff) do { _Pragma("unroll") for (int _i = 0; _i < 2; ++_i) \
        __builtin_amdgcn_global_load_lds((const unsigned*)((const char*)(gbase) + (voff)[_i]), (PG8_LAS unsigned*)(lds + (bufoff) + ldsw + _i * 8192), 16, 0, 0); } while (0)
#define PG8_LDA(dst, b, h) do { _Pragma("unroll") for (int m = 0; m < 4; ++m) _Pragma("unroll") for (int k = 0; k < 2; ++k) dst[m][k] = *(const PG8_LAS bf16x8*)(lds + PG8_SA(b, h) + aoff + m * 2048 + k * 1024); } while (0)
#define PG8_LDB(dst, b, h) do { _Pragma("unroll") for (int n = 0; n < 2; ++n) _Pragma("unroll") for (int k = 0; k < 2; ++k) dst[n][k] = *(const PG8_LAS bf16x8*)(lds + PG8_SB(b, h) + boff + n * 2048 + k * 1024); } while (0)
#define PG8_MMA(ai, bj, At, Bt) do { __builtin_amdgcn_s_setprio(1); _Pragma("unroll") for (int m = 0; m < 4; ++m) _Pragma("unroll") for (int n = 0; n < 2; ++n) _Pragma("unroll") for (int k = 0; k < 2; ++k) \
        acc[ai][bj][m][n] = __builtin_amdgcn_mfma_f32_16x16x32_bf16(Bt[n][k], At[m][k], acc[ai][bj][m][n], 0, 0, 0); __builtin_amdgcn_s_setprio(0); } while (0)
#define PG8_WAIT_V(n) asm volatile("s_waitcnt vmcnt(" #n ")" ::: "memory")
#define PG8_WAIT_L(n) asm volatile("s_waitcnt lgkmcnt(" #n ")" ::: "memory")
#define PG8_BAR __builtin_amdgcn_s_barrier()
#define PG8_SCHED __builtin_amdgcn_sched_barrier(0)
    Unit cur, nxt; int ui = 0;
    if (!S.next(0, cur)) return;
    f32x4 acc[2][2][4][2];
#pragma unroll
    for (int a = 0; a < 2; ++a)
#pragma unroll
        for (int b = 0; b < 2; ++b)
#pragma unroll
            for (int m = 0; m < 4; ++m)
#pragma unroll
                for (int n = 0; n < 2; ++n) acc[a][b][m][n] = (f32x4){0.f, 0.f, 0.f, 0.f};
    bf16x8 At[4][2], B0[2][2], B1[2][2];
    const char* cA = (const char*)g.A + (size_t)cur.pm * tstep; const char* cB = (const char*)g.Bt + (size_t)cur.pn * tstep;
    S.a_ready(cur);
    if constexpr (SP2) {
        PG8_STAGE(PG8_SB(0, 0), cB, voffB); PG8_STAGE(PG8_SB(0, 1), cB + hstep, voffB); PG8_STAGE(PG8_SA(0, 0), cA, voffA); PG8_STAGE(PG8_SA(0, 1), cA + hstep, voffA);
        if (wr == 1) PG8_BAR;
        PG8_WAIT_V(2); PG8_BAR;
        PG8_STAGE(PG8_SB(1, 0), cB + kstep, voffB); PG8_STAGE(PG8_SA(1, 0), cA + kstep, voffA); PG8_STAGE(PG8_SB(1, 1), cB + hstep + kstep, voffB);
        PG8_WAIT_V(6); PG8_BAR;
    } else {
        PG8_STAGE(PG8_SB(0, 0), cB, voffB); PG8_STAGE(PG8_SA(0, 0), cA, voffA); PG8_STAGE(PG8_SB(0, 1), cB + hstep, voffB); PG8_STAGE(PG8_SA(0, 1), cA + hstep, voffA);
        if (wr == 1) PG8_BAR;
        PG8_WAIT_V(4); PG8_BAR;
        PG8_STAGE(PG8_SB(1, 0), cB + kstep, voffB); PG8_STAGE(PG8_SA(1, 0), cA + kstep, voffA); PG8_STAGE(PG8_SB(1, 1), cB + hstep + kstep, voffB);
        PG8_WAIT_V(6); PG8_BAR;
    }
    for (;;) {
        const bool has_next = S.next(ui + 1, nxt);
        const char* nA = has_next ? (const char*)g.A + (size_t)nxt.pm * tstep : cA; const char* nB = has_next ? (const char*)g.Bt + (size_t)nxt.pn * tstep : cB;
        for (int t = 0; t < nt; t += 2) {
            const bool last = (t == nt - 2);
            const char* a1 = cA + (size_t)(t + 1) * kstep;
            const char* a2 = last ? nA : cA + (size_t)(t + 2) * kstep; const char* b2 = last ? nB : cB + (size_t)(t + 2) * kstep;
            const char* a3 = a2 + kstep; const char* b3 = b2 + kstep;
            if (last && has_next) S.a_ready(nxt);
            if constexpr (SP2) {
            PG8_LDB(B0, 0, 0); PG8_LDB(B1, 0, 1); PG8_SCHED; PG8_LDA(At, 0, 0); PG8_STAGE(PG8_SA(1, 1), a1 + hstep, voffA);
            PG8_WAIT_V(8); PG8_WAIT_L(0); PG8_BAR; PG8_MMA(0, 0, At, B0); PG8_MMA(0, 1, At, B1); PG8_BAR; PG8_SCHED;
            PG8_LDA(At, 0, 1); PG8_STAGE(PG8_SB(0, 0), b2, voffB); PG8_STAGE(PG8_SB(0, 1), b2 + hstep, voffB); PG8_STAGE(PG8_SA(0, 0), a2, voffA);
            PG8_WAIT_V(8); PG8_WAIT_L(0); PG8_BAR; PG8_MMA(1, 0, At, B0); PG8_MMA(1, 1, At, B1); PG8_BAR; PG8_SCHED;
            PG8_LDB(B0, 1, 0); PG8_LDB(B1, 1, 1); PG8_SCHED; PG8_LDA(At, 1, 0); PG8_STAGE(PG8_SA(0, 1), a2 + hstep, voffA);
            PG8_WAIT_V(8); PG8_WAIT_L(0); PG8_BAR; PG8_MMA(0, 0, At, B0); PG8_MMA(0, 1, At, B1); PG8_BAR; PG8_SCHED;
            PG8_LDA(At, 1, 1); PG8_STAGE(PG8_SB(1, 0), b3, voffB); PG8_STAGE(PG8_SB(1, 1), b3 + hstep, voffB); PG8_STAGE(PG8_SA(1, 0), a3, voffA);
            PG8_WAIT_V(8); PG8_WAIT_L(0); PG8_BAR; PG8_MMA(1, 0, At, B0); PG8_MMA(1, 1, At, B1); PG8_BAR; PG8_SCHED;
            } else {
            PG8_LDB(B0, 0, 0); PG8_SCHED; PG8_LDA(At, 0, 0); PG8_STAGE(PG8_SA(1, 1), a1 + hstep, voffA);
            PG8_WAIT_L(8); PG8_BAR; PG8_WAIT_L(0); PG8_MMA(0, 0, At, B0); PG8_BAR; PG8_SCHED;
            PG8_LDB(B1, 0, 1); PG8_STAGE(PG8_SB(0, 0), b2, voffB);
            PG8_BAR; PG8_WAIT_L(0); PG8_MMA(0, 1, At, B1); PG8_BAR;
            PG8_LDA(At, 0, 1); PG8_STAGE(PG8_SA(0, 0), a2, voffA);
            PG8_BAR; PG8_WAIT_L(0); PG8_MMA(1, 0, At, B0); PG8_BAR; PG8_SCHED;
            PG8_STAGE(PG8_SB(0, 1), b2 + hstep, voffB);
            PG8_WAIT_V(6); PG8_BAR; PG8_MMA(1, 1, At, B1); PG8_BAR;
            PG8_LDB(B0, 1, 0); PG8_SCHED; PG8_LDA(At, 1, 0); PG8_STAGE(PG8_SA(0, 1), a2 + hstep, voffA);
            PG8_WAIT_L(8); PG8_BAR; PG8_WAIT_L(0); PG8_MMA(0, 0, At, B0); PG8_BAR; PG8_SCHED;
            PG8_LDB(B1, 1, 1); PG8_STAGE(PG8_SB(1, 0), b3, voffB);
            PG8_BAR; PG8_WAIT_L(0); PG8_MMA(0, 1, At, B1); PG8_BAR;
            PG8_LDA(At, 1, 1); PG8_STAGE(PG8_SA(1, 0), a3, voffA);
            PG8_BAR; PG8_WAIT_L(0); PG8_MMA(1, 0, At, B0); PG8_BAR; PG8_SCHED;
            PG8_STAGE(PG8_SB(1, 1), b3 + hstep, voffB);
            PG8_WAIT_V(6); PG8_BAR; PG8_MMA(1, 1, At, B1); PG8_BAR;
            }
        }
        if constexpr (ALIGN_EPI) { if (wr == 0) PG8_BAR; }
        if constexpr (!Epi::AFTER_DRAIN) { E(acc, cur, wr, wc, fr, fq); S.done(cur); }
        if (!has_next) break;
#pragma unroll
        for (int a = 0; a < 2; ++a)
#pragma unroll
            for (int b = 0; b < 2; ++b)
#pragma unroll
                for (int m = 0; m < 4; ++m)
#pragma unroll
                    for (int n = 0; n < 2; ++n) acc[a][b][m][n] = (f32x4){0.f, 0.f, 0.f, 0.f};
        cur = nxt; cA = nA; cB = nB; ++ui;
        if constexpr (ALIGN_EPI) { if (wr == 1) PG8_BAR; }
    }
    PG8_WAIT_V(0);
    if constexpr (!ALIGN_EPI) { if (wr == 0) PG8_BAR; }
    PG8_BAR;
    if constexpr (Epi::AFTER_DRAIN) { E.fused(acc, cur, wr, wc, fr, fq, lds, wid, lane); S.done(cur); }
#undef PG8_SA
#undef PG8_SB
#undef PG8_STAGE
#undef PG8_LDA
#undef PG8_LDB
#undef PG8_MMA
#undef PG8_WAIT_V
#undef PG8_WAIT_L
#undef PG8_BAR
#undef PG8_SCHED
}
}
constexpr int RING_OFF = 0, RING_BYTES = 131072;
constexpr int LDSCTL_OFF = RING_BYTES, MISC_OFF = LDSCTL_OFF + 320;
constexpr int LDS_BYTES = 147456;
constexpr int CW_BAR = 4096;

#define GAS __attribute__((address_space(1)))
#define LAS __attribute__((address_space(3)))
typedef unsigned short bf16;
typedef unsigned v4u __attribute__((ext_vector_type(4)));
typedef float f32x4 __attribute__((ext_vector_type(4)));
typedef short bf16x8 __attribute__((ext_vector_type(8)));
typedef GAS unsigned gu32;
#define RLX_AGENT __ATOMIC_RELAXED, __HIP_MEMORY_SCOPE_AGENT
#define LDS_WAIT() asm volatile("s_waitcnt lgkmcnt(0)" ::: "memory")
#define VM_WAIT() asm volatile("s_waitcnt vmcnt(0)" ::: "memory")
__device__ __forceinline__ unsigned f2bfu(float f) { unsigned u = __builtin_bit_cast(unsigned, f); return (u + 0x7fffu + ((u >> 16) & 1u)) >> 16; }
__device__ __forceinline__ bf16 f2bf(float f) { return (bf16)f2bfu(f); }
typedef float f32x2_t __attribute__((ext_vector_type(2))); typedef __bf16 bf16x2_t __attribute__((ext_vector_type(2)));
__device__ __forceinline__ unsigned pk2(float lo, float hi) { f32x2_t v = {lo, hi}; bf16x2_t b = __builtin_convertvector(v, bf16x2_t); return __builtin_bit_cast(unsigned, b); }
__device__ __forceinline__ float xor16_max(float v) { auto r = __builtin_amdgcn_permlane16_swap(__float_as_uint(v), __float_as_uint(v), false, false); return fmaxf(__uint_as_float(r[0]), __uint_as_float(r[1])); }
__device__ __forceinline__ float xor32_max(float v) { auto r = __builtin_amdgcn_permlane32_swap(__float_as_uint(v), __float_as_uint(v), false, false); return fmaxf(__uint_as_float(r[0]), __uint_as_float(r[1])); }
__device__ __forceinline__ float xor16_sum(float v) { auto r = __builtin_amdgcn_permlane16_swap(__float_as_uint(v), __float_as_uint(v), false, false); return __uint_as_float(r[0]) + __uint_as_float(r[1]); }
__device__ __forceinline__ float xor32_sum(float v) { auto r = __builtin_amdgcn_permlane32_swap(__float_as_uint(v), __float_as_uint(v), false, false); return __uint_as_float(r[0]) + __uint_as_float(r[1]); }
__device__ __forceinline__ float bf2f(bf16 v) { return __uint_as_float(((unsigned)v) << 16); }
__device__ __forceinline__ float silu_f(float v) { return v * __builtin_amdgcn_rcpf(1.f + __expf(-v)); }
__device__ __forceinline__ float sigmoid_f(float v) { return __builtin_amdgcn_rcpf(1.f + __expf(-v)); }
#define DPP_ADD_(v, ctrl) ((v) + __int_as_float(__builtin_amdgcn_update_dpp(0, __float_as_int(v), (ctrl), 0xF, 0xF, false)))
__device__ __forceinline__ float group8_sum(float v) {
    v = DPP_ADD_(v, 0xB1); v = DPP_ADD_(v, 0x4E); v = DPP_ADD_(v, 0x141); return v; }
__device__ __forceinline__ float wave_sum(float v) {
    v = group8_sum(v); v = DPP_ADD_(v, 0x140);
    { auto r = __builtin_amdgcn_permlane16_swap(__float_as_uint(v), __float_as_uint(v), false, false); v = __uint_as_float(r[0]) + __uint_as_float(r[1]); }
    { auto r = __builtin_amdgcn_permlane32_swap(__float_as_uint(v), __float_as_uint(v), false, false); v = __uint_as_float(r[0]) + __uint_as_float(r[1]); }
    return v;
}
__device__ __forceinline__ float rdlane(float v, int i) { return __int_as_float(__builtin_amdgcn_readlane(__float_as_int(v), i)); }


#ifndef PROBE_T
#define PROBE_T 0
#endif
#define TS_LDS(F) ((volatile LAS unsigned long long*)((F).lds + LDSCTL_OFF + 128))
#define TS_START(F, id) do { if (PROBE_T == (id) && blockIdx.x == 0 && (F).tid == 0) TS_LDS(F)[1] = __builtin_amdgcn_s_memtime(); } while (0)
#define TS_STOP(F, id)  do { if (PROBE_T == (id) && blockIdx.x == 0 && (F).tid == 0) TS_LDS(F)[0] += __builtin_amdgcn_s_memtime() - TS_LDS(F)[1]; } while (0)
#define XB_TMO      128
#define XB_XCNT(j)  (256  + 64 * (j))
#define XB_XSUB(j)  (1280 + 64 * (j))
#define XB_XGEN(j)  (2304 + 64 * (j))
#define XB_TOP      3328
#define XB_TOPGEN   3392
#define XCD_BAR_WORDS 3456
#define XB_SPIN_CAP (1u << 18)

__device__ __forceinline__ unsigned xb_ld(unsigned* p)              { return __hip_atomic_load(p, __ATOMIC_RELAXED, __HIP_MEMORY_SCOPE_AGENT); }
__device__ __forceinline__ unsigned xb_add(unsigned* p, unsigned v) { return __hip_atomic_fetch_add(p, v, __ATOMIC_RELAXED, __HIP_MEMORY_SCOPE_AGENT); }
__device__ __forceinline__ unsigned xb_xcc_id() { return (unsigned)__builtin_amdgcn_s_getreg((3 << 11) | 20) & 0xFu; }
#define XB_SPIN(cond, bar) do { unsigned _sp = 0; while (cond) { __builtin_amdgcn_s_sleep(1); \
    if ((++_sp & 255u) == 0u) { if (xb_ld(&(bar)[XB_TMO])) break; if (_sp > XB_SPIN_CAP) { atomicAdd(&(bar)[XB_TMO], 1u); break; } } } } while (0)

struct XcdBarrier {
    unsigned* bar; unsigned x;
    volatile LAS unsigned* st;
};

__device__ __forceinline__ XcdBarrier xcd_barrier_post(unsigned* bar, volatile LAS unsigned* st) {
    XcdBarrier b; b.bar = bar; b.x = xb_xcc_id(); b.st = st;
    if (threadIdx.x == 0) (void)xb_add(&bar[XB_XCNT(b.x)], 1u);
    return b;
}
__device__ __forceinline__ void xcd_barrier_complete(unsigned* bar, unsigned x, unsigned& nloc, unsigned& nx) {
    const unsigned G = gridDim.x * gridDim.y * gridDim.z;
    unsigned sum, cnt, mine, sp = 0u;
    for (;;) {
        sum = 0u; cnt = 0u; mine = 0u;
#pragma unroll
        for (unsigned j = 0; j < 16; ++j) { const unsigned c = xb_ld(&bar[XB_XCNT(j)]); sum += c; cnt += (c > 0u) ? 1u : 0u; mine = (j == x) ? c : mine; }
        if (sum == G) break;
        __builtin_amdgcn_s_sleep(1);
        if ((++sp & 255u) == 0u) { if (xb_ld(&bar[XB_TMO])) break; if (sp > XB_SPIN_CAP) { atomicAdd(&bar[XB_TMO], 1u); break; } }
    }
    nloc = mine > 0u ? mine : 1u; nx = cnt > 0u ? cnt : 1u;
}

__device__ __forceinline__ void xcd_barrier(const XcdBarrier& b) {
    asm volatile("s_waitcnt vmcnt(0)" ::: "memory");
    __syncthreads();
    if (threadIdx.x == 0) {
        unsigned* bar = b.bar;
        __builtin_amdgcn_s_waitcnt(0);
        unsigned nloc = b.st[0], nx = b.st[1];
        if (nloc == 0u) { xcd_barrier_complete(bar, b.x, nloc, nx); b.st[0] = nloc; b.st[1] = nx; }
        const unsigned old = xb_add(&bar[XB_XSUB(b.x)], 1u);
        const unsigned gen = old / nloc;
        if (old + 1u == (gen + 1u) * nloc) {
            __builtin_amdgcn_fence(__ATOMIC_RELEASE, "agent");
            asm volatile("s_waitcnt vmcnt(0)" ::: "memory");
            const unsigned og = xb_add(&bar[XB_TOP], 1u);
            const unsigned tg = og / nx;
            if (og + 1u == (tg + 1u) * nx) xb_add(&bar[XB_TOPGEN], 1u);
            else XB_SPIN(xb_ld(&bar[XB_TOPGEN]) == tg, bar);
            __builtin_amdgcn_fence(__ATOMIC_ACQUIRE, "agent");
            xb_add(&bar[XB_XGEN(b.x)], 1u);
            asm volatile("s_waitcnt vmcnt(0)" ::: "memory");
        } else {
            XB_SPIN(xb_ld(&bar[XB_XGEN(b.x)]) == gen, bar);
            __builtin_amdgcn_fence(__ATOMIC_ACQUIRE, "agent");
            asm volatile("s_waitcnt vmcnt(0)" ::: "memory");
        }
    }
    __syncthreads();
}

struct Ctx {
    LAS unsigned char* lds; int tid, lane, wave, vcu, G, gw, NGW;
    const float *x, *c, *ctx, *c_ctx, *w_mod, *b_mod, *g_pre, *g_post, *w_in, *w_out, *hgrn_lb, *hgrn_gn, *gate_b, *mlstm_gn, *na_rpb;
    float* out; bf16 *wt_in, *wt_out, *hxy, *P; float *mod, *gates, *ctx1, *stm, *sth, *rope; bf16 *otm, *oth, *UX;
};

__device__ __forceinline__ void transpose_item(const float* W, int N, int Nnew, bool remap, bf16* WT, LAS float* scr, int item, int lane) {
    const int nblk = Nnew / 32, kb = item / nblk, nb = item % nblk, k0 = 64 * kb, n0 = 32 * nb;
    const int rg = lane >> 3, c4 = (lane & 7) * 4, nn = n0 + c4;
    int no = nn; if (remap) no = nn < 3200 ? nn : (nn < 4736 ? nn + 16 : (nn < 4752 ? 3200 + nn - 4736 : -1));
    f32x4 v[8];
#pragma unroll
    for (int j = 0; j < 8; ++j) v[j] = no >= 0 ? *(const f32x4*)(W + (size_t)(k0 + 8 * j + rg) * N + no) : (f32x4){0.f, 0.f, 0.f, 0.f};
#pragma unroll
    for (int j = 0; j < 8; ++j) { LAS float* d = scr + (8 * j + rg) * 33 + c4; d[0] = v[j][0]; d[1] = v[j][1]; d[2] = v[j][2]; d[3] = v[j][3]; }
    LDS_WAIT(); asm volatile("" ::: "memory");
    const int c = lane & 7;
#pragma unroll
    for (int j = 0; j < 4; ++j) { const int n = (lane >> 3) + 8 * j; const LAS float* s = scr + (8 * c) * 33 + n;
        v4u o; o.x = pk2(s[0 * 33], s[1 * 33]); o.y = pk2(s[2 * 33], s[3 * 33]); o.z = pk2(s[4 * 33], s[5 * 33]); o.w = pk2(s[6 * 33], s[7 * 33]);
        *(GAS v4u*)(WT + (size_t)(n0 + n) * 1024 + k0 + 8 * c) = o; }
    LDS_WAIT(); asm volatile("" ::: "memory");
}
__device__ __forceinline__ void phase_p0(const Ctx& F) {
    if (F.vcu < 96) {
        LAS float* tab = (LAS float*)(F.lds);
        LAS float* part = (LAS float*)(F.lds + 36864);
        for (int i = F.tid; i < 9 * 1024; i += 512) { const int r = i >> 10, k = i & 1023; const float v = r < 8 ? F.c[r * 1024 + k] : F.c_ctx[k]; tab[i] = silu_f(v); }
        __syncthreads();
        for (int it = F.vcu; it < 96; it += F.G) {
            const int l = it / 48, jb = it % 48, col = jb * 64 + F.lane;
            float acc[9];
#pragma unroll
            for (int r = 0; r < 9; ++r) acc[r] = 0.f;
            const float* wp = F.w_mod + ((size_t)l * 1024 + F.wave * 128) * 3072 + col;
            for (int kb = 0; kb < 128; kb += 32) {
                float wv[32];
#pragma unroll
                for (int k = 0; k < 32; ++k) wv[k] = wp[(size_t)(kb + k) * 3072];
#pragma unroll
                for (int k = 0; k < 32; ++k)
#pragma unroll
                    for (int r = 0; r < 9; ++r) acc[r] += tab[r * 1024 + F.wave * 128 + kb + k] * wv[k]; }
#pragma unroll
            for (int r = 0; r < 9; ++r) part[(F.wave * 9 + r) * 64 + F.lane] = acc[r];
            __syncthreads();
            for (int i = F.tid; i < 9 * 64; i += 512) { const int r = i >> 6, j = i & 63; float s = 0.f;
#pragma unroll
                for (int w = 0; w < 8; ++w) s += part[(w * 9 + r) * 64 + j];
                F.mod[((size_t)l * 9 + r) * 3072 + jb * 64 + j] = s + F.b_mod[l * 3072 + jb * 64 + j]; }
            __syncthreads();
        }
    }
    if (F.vcu == 96 % F.G) for (int i = F.tid; i < 64 * 24; i += 512) { const int pos = i / 24, f = i % 24; const float ang = (float)pos * expf(-(float)(2 * f) * (1.f / 48.f) * 9.210340371976184f); F.rope[2 * i] = cosf(ang); F.rope[2 * i + 1] = sinf(ang); }
    __syncthreads();
    LAS float* scr = (LAS float*)(F.lds + F.wave * 16384);
    constexpr int I_IN = 16 * (NPAD / 32);
    const int gwr = F.NGW - 1 - F.gw;
    for (int it = gwr; it < I_IN; it += F.NGW) transpose_item(F.w_in, PIN, NPAD, true, F.wt_in, scr, it, F.lane);
}
__device__ __forceinline__ void phase_p1_transposes(const Ctx& F) {
    LAS float* scr = (LAS float*)(F.lds + F.wave * 16384);
    constexpr int I_IN = 16 * (NPAD / 32), I_OUT = 16 * 32;
    for (int it = F.gw; it < I_IN + 2 * I_OUT; it += F.NGW) {
        if (it < I_OUT) transpose_item(F.w_out, 1024, 1024, false, F.wt_out, scr, it, F.lane);
        else if (it < I_OUT + I_IN) transpose_item(F.w_in + (size_t)1024 * PIN, PIN, NPAD, true, F.wt_in + (size_t)NPAD * 1024, scr, it - I_OUT, F.lane);
        else transpose_item(F.w_out + (size_t)1024 * 1024, 1024, 1024, false, F.wt_out + (size_t)1024 * 1024, scr, it - I_OUT - I_IN, F.lane);
    }
}

struct RowPar { float4 g[4], a[4], b[4]; };
__device__ __forceinline__ void load_par(RowPar& p, const float* g, const float* a, const float* b, int lane) {
#pragma unroll
    for (int j = 0; j < 4; ++j) { const int d = 4 * (lane + 64 * j); p.g[j] = *(const float4*)(g + d); p.a[j] = *(const float4*)(a + d); p.b[j] = *(const float4*)(b + d); }
}
__device__ __forceinline__ void prenorm_store(const float4 (&v)[4], float ss, const RowPar& p, bf16* dst, int lane) {
    const float rinv = __builtin_amdgcn_rsqf(ss * (1.f / 1024.f) + EPS);
#pragma unroll
    for (int j = 0; j < 4; ++j) {
        const int d = 4 * (lane + 64 * j);
        const float o0 = v[j].x * rinv * p.g[j].x * (1.f + p.a[j].x) + p.b[j].x, o1 = v[j].y * rinv * p.g[j].y * (1.f + p.a[j].y) + p.b[j].y;
        const float o2 = v[j].z * rinv * p.g[j].z * (1.f + p.a[j].z) + p.b[j].z, o3 = v[j].w * rinv * p.g[j].w * (1.f + p.a[j].w) + p.b[j].w;
        uint2 w; w.x = pk2(o0, o1); w.y = pk2(o2, o3);
        *(uint2*)(dst + d) = w;
    }
}
__device__ __forceinline__ void phase_prenorm0(const Ctx& F) {
    auto rowsrc = [&](int m) -> const float* { return m < MX ? F.x + (size_t)m * 1024 : F.ctx + (size_t)(m - MX) * 1024; };
    int m = F.gw; if (m >= M) return;
    float4 nv[4];
#pragma unroll
    for (int j = 0; j < 4; ++j) nv[j] = ((const float4*)rowsrc(m))[F.lane + 64 * j];
    while (m < M) {
        const float* mod_r = F.mod + (size_t)(m < MX ? m / S : 8) * 3072;
        RowPar p; load_par(p, F.g_pre, mod_r + 1024, mod_r, F.lane);
        float4 v[4];
#pragma unroll
        for (int j = 0; j < 4; ++j) v[j] = nv[j];
        const int mn = m + F.NGW;
        if (mn < M) {
#pragma unroll
            for (int j = 0; j < 4; ++j) nv[j] = ((const float4*)rowsrc(mn))[F.lane + 64 * j]; }
        float ss = 0.f;
#pragma unroll
        for (int j = 0; j < 4; ++j) ss += v[j].x * v[j].x + v[j].y * v[j].y + v[j].z * v[j].z + v[j].w * v[j].w;
        ss = wave_sum(ss);
        prenorm_store(v, ss, p, F.hxy + (size_t)m * 1024, F.lane);
        m = mn;
    }
}
__device__ __forceinline__ void phase_post(const Ctx& F, int l) {
    const int Ml = l == 0 ? M : MX;
    const float* mod_l = F.mod + (size_t)l * 9 * 3072; const float* g_post_l = F.g_post + l * 1024;
    auto rowsrc = [&](int m) -> const float* { return m < MX ? (l == 0 ? F.x : F.out) + (size_t)m * 1024 : F.ctx + (size_t)(m - MX) * 1024; };
    int m = F.gw; if (m >= Ml) return;
    float4 nx[4]; uint2 nu[4];
#pragma unroll
    for (int j = 0; j < 4; ++j) { nx[j] = ((const float4*)rowsrc(m))[F.lane + 64 * j]; nu[j] = ((const uint2*)(F.UX + (size_t)m * 1024))[F.lane + 64 * j]; }
    while (m < Ml) {
        float* dst; int r;
        if (m < MX) { dst = F.out + (size_t)m * 1024; r = m / S; } else { dst = F.ctx1 + (size_t)(m - MX) * 1024; r = 8; }
        float4 pg[4], pt[4]; RowPar p2;
#pragma unroll
        for (int j = 0; j < 4; ++j) { const int d = 4 * (F.lane + 64 * j); pg[j] = *(const float4*)(g_post_l + d); pt[j] = *(const float4*)(mod_l + r * 3072 + 2048 + d); }
        if (l == 0) load_par(p2, F.g_pre + 1024, F.mod + (size_t)(9 + r) * 3072 + 1024, F.mod + (size_t)(9 + r) * 3072, F.lane);
        float4 xr[4], u[4]; float ss = 0.f;
#pragma unroll
        for (int j = 0; j < 4; ++j) { xr[j] = nx[j]; const uint2 w = nu[j];
            u[j].x = __uint_as_float(w.x << 16); u[j].y = __uint_as_float(w.x & 0xffff0000u); u[j].z = __uint_as_float(w.y << 16); u[j].w = __uint_as_float(w.y & 0xffff0000u);
            ss += u[j].x * u[j].x + u[j].y * u[j].y + u[j].z * u[j].z + u[j].w * u[j].w; }
        const int mn = m + F.NGW;
        if (mn < Ml) {
#pragma unroll
            for (int j = 0; j < 4; ++j) { nx[j] = ((const float4*)rowsrc(mn))[F.lane + 64 * j]; nu[j] = ((const uint2*)(F.UX + (size_t)mn * 1024))[F.lane + 64 * j]; } }
        ss = wave_sum(ss);
        const float rinv = __builtin_amdgcn_rsqf(ss * (1.f / 1024.f) + EPS);
        float ss2 = 0.f;
#pragma unroll
        for (int j = 0; j < 4; ++j) {
            const int d = 4 * (F.lane + 64 * j);
            const float4 g = pg[j], t = pt[j], xv = xr[j];
            float4 o; o.x = xv.x + t.x * (u[j].x * rinv * g.x); o.y = xv.y + t.y * (u[j].y * rinv * g.y); o.z = xv.z + t.z * (u[j].z * rinv * g.z); o.w = xv.w + t.w * (u[j].w * rinv * g.w);
            *(float4*)(dst + d) = o; u[j] = o; ss2 += o.x * o.x + o.y * o.y + o.z * o.z + o.w * o.w;
        }
        if (l == 0) { ss2 = wave_sum(ss2); prenorm_store(u, ss2, p2, F.hxy + (size_t)m * 1024, F.lane); }
        m = mn;
    }
}


typedef short s16x4 __attribute__((ext_vector_type(4)));
typedef short v4i16_t __attribute__((ext_vector_type(4)));
__device__ __forceinline__ s16x4 tr_read(const LAS bf16* p) { return __builtin_bit_cast(s16x4, __builtin_amdgcn_ds_read_tr16_b64_v4i16((LAS v4i16_t*)p)); }
__device__ __forceinline__ bf16x8 tr_frag(const LAS bf16* T, int stride, int rowA, int rowB, int col0, int lane) {
    const int q = (lane >> 2) & 3, p = lane & 3;
    const s16x4 lo = tr_read(T + (rowA + q) * stride + col0 + 4 * p), hi = tr_read(T + (rowB + q) * stride + col0 + 4 * p);
    return (bf16x8){lo[0], lo[1], lo[2], lo[3], hi[0], hi[1], hi[2], hi[3]};
}
__device__ __forceinline__ bf16x8 rm_frag(const LAS bf16* T, int stride, int row, int k0) { return *(const LAS bf16x8*)(T + row * stride + k0); }
__device__ __forceinline__ f32x4 mfma16(bf16x8 a, bf16x8 b, f32x4 c) { return __builtin_amdgcn_mfma_f32_16x16x32_bf16(a, b, c, 0, 0, 0); }
typedef unsigned v2u __attribute__((ext_vector_type(2)));
typedef float f32x2 __attribute__((ext_vector_type(2)));
__device__ __forceinline__ void unpack8(const v4u w, float* f) {
    f[0] = __uint_as_float(w.x << 16); f[1] = __uint_as_float(w.x & 0xffff0000u); f[2] = __uint_as_float(w.y << 16); f[3] = __uint_as_float(w.y & 0xffff0000u);
    f[4] = __uint_as_float(w.z << 16); f[5] = __uint_as_float(w.z & 0xffff0000u); f[6] = __uint_as_float(w.w << 16); f[7] = __uint_as_float(w.w & 0xffff0000u);
}
__device__ __forceinline__ v4u pack8(const float* f) { v4u w; w.x = pk2(f[0], f[1]); w.y = pk2(f[2], f[3]); w.z = pk2(f[4], f[5]); w.w = pk2(f[6], f[7]); return w; }

__device__ __forceinline__ float wave_scan_incl(float x) {
    int v = __float_as_int(x);
#define DPP_ADD(ctrl, rmask) v = __float_as_int(__int_as_float(v) + __int_as_float(__builtin_amdgcn_update_dpp(0, v, ctrl, rmask, 0xF, false)))
    DPP_ADD(0x111, 0xF); DPP_ADD(0x112, 0xF); DPP_ADD(0x114, 0xF); DPP_ADD(0x118, 0xF); DPP_ADD(0x142, 0xA); DPP_ADD(0x143, 0xC);
#undef DPP_ADD
    return __int_as_float(v);
}
#define LDS_FENCE() asm volatile("" ::: "memory")
namespace ml {
constexpr int QSTR = 104, VSTR = 120;
constexpr int OFF_QS = 0, OFF_KS = OFF_QS + 64 * QSTR * 2, OFF_VS = OFF_KS + 64 * QSTR * 2, OFF_CT = OFF_VS + 64 * VSTR * 2;
constexpr int OFF_HT = OFF_CT + 2 * 112 * QSTR * 2, OFF_DEN = OFF_HT + 64 * 100 * 4, OFF_ROPE = OFF_DEN + 256, OFF_END = OFF_ROPE + 64 * 24 * 8;
static_assert(OFF_END <= RING_BYTES && 6 * 7 * 64 * 16 <= OFF_HT, "mlstm LDS");
constexpr int ST_FLOATS = 96 * 112 + 16;
}
constexpr int NSEG = 4, SEGTOK = S / NSEG, SEGCH = SEGTOK / 64;
struct MlJob { int b, h, isctx, t0, nchunk; };

__device__ __forceinline__ void mlstm_dir(const Ctx& F, int l, const MlJob jb, int dir, int fold_r, int emit_slot, int mode, bf16* otmp, float* ST) {
    using namespace ml;
    int tid_ = F.tid; asm volatile("" : "+v"(tid_));
    const int w = __builtin_amdgcn_readfirstlane(tid_ >> 6);
    const bool tsel = (mode != 0) && !jb.isctx && l == 0;
    if (tsel) TS_START(F, 10);
    LAS bf16* QS = (LAS bf16*)(F.lds + OFF_QS); LAS bf16* KS = (LAS bf16*)(F.lds + OFF_KS); LAS bf16* VS = (LAS bf16*)(F.lds + OFF_VS);
    LAS bf16* CT0 = (LAS bf16*)(F.lds + OFF_CT); LAS float* HT = (LAS float*)(F.lds + OFF_HT); LAS float* DEN = (LAS float*)(F.lds + OFF_DEN);
    const LAS f32x2* ROPE = (const LAS f32x2*)(F.lds + OFF_ROPE);
    const int rowbase = jb.isctx ? MX + jb.b * CTX : jb.b * S;
    const int h = jb.h; const bf16* P = F.P;
    float* STd = ST + (size_t)(((jb.b * 4 + h) * 2 + dir) * 8) * ST_FLOATS;
    f32x4 Cst[7];
#pragma unroll
    for (int et = 0; et < 7; ++et) Cst[et] = (f32x4){0.f, 0.f, 0.f, 0.f};
    if (fold_r >= 0) {
        LAS f32x4* FOLD = (LAS f32x4*)(F.lds + OFF_QS);
        float wk[8];
        { float bs[8]; bs[0] = 0.f;
#pragma unroll
          for (int k = 1; k < NSEG; ++k) bs[k] = STd[(size_t)k * ST_FLOATS + 96 * 112];
          float run = 1.f;
#pragma unroll
          for (int k = NSEG - 1; k >= 0; --k) { wk[k] = (k <= fold_r) ? run : 0.f; run = (k >= 1 && k <= fold_r) ? run * __expf(bs[k]) : run; } }
#pragma unroll 2
        for (int p = tid_; p < 6 * 7 * 64; p += 512) {
            f32x4 v[8];
#pragma unroll
            for (int k = 0; k < NSEG; ++k) v[k] = *(const f32x4*)(STd + (size_t)k * ST_FLOATS + 4 * p);
            f32x4 acc = v[0] * wk[0];
#pragma unroll
            for (int k = 1; k < NSEG; ++k) acc += v[k] * wk[k];
            FOLD[p] = acc;
        }
        __syncthreads();
        if (w < 6) {
#pragma unroll
            for (int et = 0; et < 7; ++et) Cst[et] = FOLD[(w * 7 + et) * 64 + (tid_ & 63)];
        }
        __syncthreads();
    }
    asm volatile("" : "+v"(tid_));
    const int tid = tid_, lane = tid & 63, g = lane >> 4, c = lane & 15;
    float Btot = 0.f;
    for (int i = tid; i < 64 * 16; i += 512) { const int s = i >> 4, e = 96 + (i & 15); VS[s * VSTR + e] = (e == 96) ? (bf16)0x3F80 : (bf16)0; }
    if (w < 6) {
#pragma unroll
        for (int et = 0; et < 7; ++et) { v2u v; v.x = pk2(Cst[et][0], Cst[et][1]); v.y = pk2(Cst[et][2], Cst[et][3]); *(LAS v2u*)(CT0 + (16 * et + c) * QSTR + 16 * w + 4 * g) = v; }
    }
    const bool hasqk = tid < 384; const int qk_tok = tid / 6, qk_pi = tid % 6, qk_part = qk_pi / 3, qk_pp = qk_pi % 3, qk_d0 = 48 * qk_part + 8 * qk_pp;
    const int v1_tok = tid / 12, v1_pc = tid % 12; const bool hasv2 = tid < 256; const int v2_tok = (512 + tid) / 12, v2_pc = (512 + tid) % 12;
    struct LoadSet { v4u q0, q1, k0, k1, v1, v2; float ig, lf; };
    LoadSet LA;
    v2u ft[3], fo[3], fz[3];
    const int fi_i = tid >> 3, fi_e0 = 12 * (tid & 7);
#pragma unroll
    for (int q4 = 0; q4 < 3; ++q4) { ft[q4] = (v2u){0u, 0u}; fo[q4] = (v2u){0u, 0u}; fz[q4] = (v2u){0u, 0u}; }
    LA.q0 = LA.q1 = LA.k0 = LA.k1 = LA.v1 = LA.v2 = (v4u){0u, 0u, 0u, 0u}; LA.ig = LA.lf = 0.f;
    auto tok_of = [&](int ci, int i) -> int { return dir == 0 ? jb.t0 + 64 * ci + i : jb.t0 + 64 * (jb.nchunk - 1 - ci) + (63 - i); };
    auto issue_loads = [&](LoadSet& L, int ci) {
        if (hasqk) { const bf16* pr = P + (size_t)(rowbase + tok_of(ci, qk_tok)) * PLD + h * 96 + qk_d0;
            if (mode != 0) { L.q0 = *(const v4u*)(pr + B_Q); L.q1 = *(const v4u*)(pr + B_Q + 24); }
            L.k0 = *(const v4u*)(pr + B_K); L.k1 = *(const v4u*)(pr + B_K + 24); }
        L.v1 = *(const v4u*)(P + (size_t)(rowbase + tok_of(ci, v1_tok)) * PLD + B_V + h * 96 + 8 * v1_pc);
        if (hasv2) L.v2 = *(const v4u*)(P + (size_t)(rowbase + tok_of(ci, v2_tok)) * PLD + B_V + h * 96 + 8 * v2_pc);
        const float* gp = F.gates + (size_t)(rowbase + tok_of(ci, lane)) * 16 + dir * 4 + h; L.ig = gp[0]; L.lf = gp[8];
    };
    auto issue_fin = [&](int ci) {
        const int m = rowbase + tok_of(ci, fi_i); const bf16* tp = otmp + (size_t)m * 384 + h * 96 + fi_e0; const bf16* pr = P + (size_t)m * PLD + h * 96 + fi_e0;
#pragma unroll
        for (int q4 = 0; q4 < 3; ++q4) { ft[q4] = *(const v2u*)(tp + 4 * q4); fo[q4] = *(const v2u*)(pr + B_O + 4 * q4); fz[q4] = *(const v2u*)(pr + B_Z + 4 * q4); }
    };
    auto finalize = [&](int ci) {
            const int i = tid >> 3, sub = tid & 7, e0 = 12 * sub; const int m = rowbase + tok_of(ci, i);
            float hv[12]; const float rden = __builtin_amdgcn_rcpf(fmaxf(fabsf(DEN[i]), 1.f));
#pragma unroll
            for (int q4 = 0; q4 < 3; ++q4) { const f32x4 v = *(const LAS f32x4*)(HT + i * 100 + e0 + 4 * q4); hv[4 * q4] = v[0] * rden; hv[4 * q4 + 1] = v[1] * rden; hv[4 * q4 + 2] = v[2] * rden; hv[4 * q4 + 3] = v[3] * rden; }
            bf16* tp = otmp + (size_t)m * 384 + h * 96 + e0;
            if (mode == 1) {
#pragma unroll
                for (int q4 = 0; q4 < 3; ++q4) { v2u v; v.x = pk2(hv[4 * q4], hv[4 * q4 + 1]); v.y = pk2(hv[4 * q4 + 2], hv[4 * q4 + 3]); *(v2u*)(tp + 4 * q4) = v; }
            } else {
                float ss = 0.f;
#pragma unroll
                for (int q4 = 0; q4 < 3; ++q4) { const v2u v = ft[q4];
                    hv[4 * q4] += __uint_as_float(v.x << 16); hv[4 * q4 + 1] += __uint_as_float(v.x & 0xffff0000u); hv[4 * q4 + 2] += __uint_as_float(v.y << 16); hv[4 * q4 + 3] += __uint_as_float(v.y & 0xffff0000u); }
#pragma unroll
                for (int e = 0; e < 12; ++e) ss += hv[e] * hv[e];
                ss = group8_sum(ss);
                const float rinv = __builtin_amdgcn_rsqf(ss * (1.f / 96.f) + EPS);
                bf16* yp = F.hxy + (size_t)m * 1024 + 256 + h * 96 + e0; const float* gnv = F.mlstm_gn + l * 384 + h * 96 + e0;
#pragma unroll
                for (int q4 = 0; q4 < 3; ++q4) { const v2u ov = fo[q4], zv = fz[q4];
                    const float og[4] = {__uint_as_float(ov.x << 16), __uint_as_float(ov.x & 0xffff0000u), __uint_as_float(ov.y << 16), __uint_as_float(ov.y & 0xffff0000u)};
                    const float zg[4] = {__uint_as_float(zv.x << 16), __uint_as_float(zv.x & 0xffff0000u), __uint_as_float(zv.y << 16), __uint_as_float(zv.y & 0xffff0000u)};
                    float o[4];
#pragma unroll
                    for (int e = 0; e < 4; ++e) o[e] = og[e] * (hv[4 * q4 + e] * rinv * gnv[4 * q4 + e]) * zg[e];
                    v2u v; v.x = pk2(o[0], o[1]); v.y = pk2(o[2], o[3]); *(v2u*)(yp + 4 * q4) = v; }
            }
    };
    struct Packed { v4u k0, k1, q0, q1, v1, v2; float bL, ebL; };
    auto stage_math = [&](LoadSet& L, int ci, Packed& K) {
        const float bcs = wave_scan_incl(L.lf);
        const float qsc = __expf(bcs), ksc = __expf(L.ig - bcs);
        K.bL = rdlane(bcs, 63); K.ebL = __expf(K.bL);
        if (hasqk) {
            const float ks_t = __shfl(ksc, qk_tok), qs_t = __shfl(qsc, qk_tok);
            float cs[8], sn[8];
            if (!jb.isctx) { const int t = tok_of(ci, qk_tok); const int pos = qk_part ? (t & 63) : (t >> 6);
#pragma unroll
                for (int e = 0; e < 8; ++e) { const f32x2 v = ROPE[pos * 24 + 8 * qk_pp + e]; cs[e] = v[0]; sn[e] = v[1]; } }
            else {
#pragma unroll
                for (int e = 0; e < 8; ++e) { cs[e] = 1.f; sn[e] = 0.f; } }
            float a[8], b2[8], o0[8], o1[8];
            unpack8(L.k0, a); unpack8(L.k1, b2);
#pragma unroll
            for (int e = 0; e < 8; ++e) { o0[e] = (a[e] * cs[e] - b2[e] * sn[e]) * ks_t; o1[e] = (b2[e] * cs[e] + a[e] * sn[e]) * ks_t; }
            K.k0 = pack8(o0); K.k1 = pack8(o1);
            if (mode != 0) {
                unpack8(L.q0, a); unpack8(L.q1, b2);
#pragma unroll
                for (int e = 0; e < 8; ++e) { o0[e] = (a[e] * cs[e] - b2[e] * sn[e]) * qs_t; o1[e] = (b2[e] * cs[e] + a[e] * sn[e]) * qs_t; }
                K.q0 = pack8(o0); K.q1 = pack8(o1);
            }
        } else { (void)__shfl(ksc, 0); (void)__shfl(qsc, 0); }
        K.v1 = L.v1; K.v2 = L.v2;
    };
    auto stage_write = [&](const Packed& K) {
        if (hasqk) {
            *(LAS v4u*)(KS + qk_tok * QSTR + qk_d0) = K.k0; *(LAS v4u*)(KS + qk_tok * QSTR + qk_d0 + 24) = K.k1;
            if (mode != 0) { *(LAS v4u*)(QS + qk_tok * QSTR + qk_d0) = K.q0; *(LAS v4u*)(QS + qk_tok * QSTR + qk_d0 + 24) = K.q1; }
        }
        *(LAS v4u*)(VS + v1_tok * VSTR + 8 * v1_pc) = K.v1;
        if (hasv2) *(LAS v4u*)(VS + v2_tok * VSTR + 8 * v2_pc) = K.v2;
    };
    Packed PK; PK.k0 = PK.k1 = PK.q0 = PK.q1 = PK.v1 = PK.v2 = (v4u){0u, 0u, 0u, 0u}; PK.bL = 0.f; PK.ebL = 1.f;
    issue_loads(LA, 0);
    __syncthreads();
    stage_math(LA, 0, PK); stage_write(PK);
    if (jb.nchunk > 1) issue_loads(LA, 1);
    float bL = PK.bL, ebL = PK.ebL;
    __syncthreads();
    if (tsel) TS_STOP(F, 10);
    auto chunk_step = [&](LoadSet& Lnext, int ci) {
        LAS bf16* CTc = CT0 + (ci & 1) * 112 * QSTR; LAS bf16* CTn = CT0 + ((ci + 1) & 1) * 112 * QSTR;
        if (mode == 2) issue_fin(ci);
        if (ci + 1 < jb.nchunk) { stage_math(Lnext, ci + 1, PK); if (ci + 2 < jb.nchunk) issue_loads(Lnext, ci + 2); }
        if (mode != 0) {
            const int tt = w & 3, jh = w >> 2;
            bf16x8 qf[3], kf[4][3];
#pragma unroll
            for (int ks = 0; ks < 3; ++ks) qf[ks] = rm_frag(QS, QSTR, 16 * tt + c, 32 * ks + 8 * g);
#pragma unroll
            for (int ss = 0; ss < 4; ++ss) if (ss <= tt) {
#pragma unroll
                for (int ks = 0; ks < 3; ++ks) kf[ss][ks] = rm_frag(KS, QSTR, 16 * ss + c, 32 * ks + 8 * g); }
            LDS_FENCE();
            f32x4 st[4];
#pragma unroll
            for (int ss = 0; ss < 4; ++ss) { st[ss] = (f32x4){0.f, 0.f, 0.f, 0.f};
                if (ss <= tt) {
#pragma unroll
                    for (int ks = 0; ks < 3; ++ks) st[ss] = mfma16(kf[ss][ks], qf[ks], st[ss]);
                    if (ss == tt) {
#pragma unroll
                        for (int r = 0; r < 4; ++r) if (4 * g + r > c) st[ss][r] = 0.f; }
                } }
            bf16x8 pf[2];
#pragma unroll
            for (int kk = 0; kk < 2; ++kk) { const unsigned u0 = pk2(st[2 * kk][0], st[2 * kk][1]), u1 = pk2(st[2 * kk][2], st[2 * kk][3]), u2 = pk2(st[2 * kk + 1][0], st[2 * kk + 1][1]), u3 = pk2(st[2 * kk + 1][2], st[2 * kk + 1][3]);
                pf[kk] = __builtin_bit_cast(bf16x8, (v4u){u0, u1, u2, u3}); }
#pragma unroll
            for (int eb = 0; eb < 4; eb += 2) {
                bf16x8 vf[2][2], cf[2][3];
#pragma unroll
                for (int e2 = 0; e2 < 2; ++e2) { const int et = 4 * jh + eb + e2;
                    if (et < 7) {
#pragma unroll
                        for (int kk = 0; kk < 2; ++kk) if (2 * kk <= tt) vf[e2][kk] = tr_frag(VS, VSTR, 32 * kk + 4 * g, 32 * kk + 16 + 4 * g, 16 * et, lane);
#pragma unroll
                        for (int ks = 0; ks < 3; ++ks) cf[e2][ks] = rm_frag(CTc, QSTR, 16 * et + c, 32 * ks + 8 * g); } }
                LDS_FENCE();
#pragma unroll
                for (int e2 = 0; e2 < 2; ++e2) { const int et = 4 * jh + eb + e2;
                    if (et < 7) {
                        f32x4 acc = (f32x4){0.f, 0.f, 0.f, 0.f};
#pragma unroll
                        for (int kk = 0; kk < 2; ++kk) if (2 * kk <= tt) acc = mfma16(vf[e2][kk], pf[kk], acc);
#pragma unroll
                        for (int ks = 0; ks < 3; ++ks) acc = mfma16(cf[e2][ks], qf[ks], acc);
                        if (et < 6) *(LAS f32x4*)(HT + (16 * tt + c) * 100 + 16 * et + 4 * g) = acc;
                        else if (g == 0) DEN[16 * tt + c] = acc[0];
                    } }
            }
        }
        if (w < 6) {
#pragma unroll
            for (int kk = 0; kk < 2; ++kk) {
                bf16x8 vf[7]; const bf16x8 af = tr_frag(KS, QSTR, 32 * kk + 8 * g, 32 * kk + 8 * g + 4, 16 * w, lane);
#pragma unroll
                for (int et = 0; et < 7; ++et) vf[et] = tr_frag(VS, VSTR, 32 * kk + 8 * g, 32 * kk + 8 * g + 4, 16 * et, lane);
                LDS_FENCE();
#pragma unroll
                for (int et = 0; et < 7; ++et) Cst[et] = mfma16(af, vf[et], Cst[et]);
            }
#pragma unroll
            for (int et = 0; et < 7; ++et) { Cst[et] = Cst[et] * ebL;
                if (mode != 0) { v2u v; v.x = pk2(Cst[et][0], Cst[et][1]); v.y = pk2(Cst[et][2], Cst[et][3]); *(LAS v2u*)(CTn + (16 * et + c) * QSTR + 16 * w + 4 * g) = v; } }
        }
        Btot += bL;
        __syncthreads();
        if (ci + 1 < jb.nchunk) { stage_write(PK); bL = PK.bL; ebL = PK.ebL; }
        if (mode != 0) finalize(ci);
        __syncthreads();
    };
    for (int ci = 0; ci < jb.nchunk; ++ci) chunk_step(LA, ci);
    if (emit_slot >= 0 && w < 6) {
        float* sl = STd + (size_t)emit_slot * ST_FLOATS;
#pragma unroll
        for (int et = 0; et < 7; ++et) *(f32x4*)(sl + ((w * 7 + et) * 64 + lane) * 4) = Cst[et];
        if (w == 0 && lane == 0) sl[96 * 112] = Btot;
    }
    __syncthreads();
}
__device__ __forceinline__ void mlstm_load_rope(const Ctx& F, const float* rope_tab) {
    LAS f32x2* ROPE = (LAS f32x2*)(F.lds + ml::OFF_ROPE);
    for (int i = F.tid; i < 64 * 24; i += 512) ROPE[i] = ((const f32x2*)rope_tab)[i];
}
__device__ __forceinline__ void mlstm_itemA(const Ctx& F, int l, int bh, int it, bf16* otmp, float* ST) {
    const int b = bh >> 2, h = bh & 3;
    if (it == 0) {
        const MlJob jb{b, h, 1, 0, 4};
        mlstm_dir(F, l, jb, 0, -1, 0, l == 0 ? 1 : 0, otmp, ST);
        mlstm_dir(F, l, jb, 1, -1, 0, l == 0 ? 2 : 0, otmp, ST);
    } else {
        const int dir = (it - 1) / (NSEG - 1), k = (it - 1) % (NSEG - 1), seg = dir == 0 ? k : NSEG - 1 - k;
        const MlJob jb{b, h, 0, SEGTOK * seg, SEGCH};
        mlstm_dir(F, l, jb, dir, -1, 1 + k, 0, otmp, ST);
    }
}
__device__ __forceinline__ void mlstm_itemC(const Ctx& F, int l, int bh, int seg, bf16* otmp, float* ST) {
    const MlJob jb{bh >> 2, bh & 3, 0, SEGTOK * seg, SEGCH};
    mlstm_dir(F, l, jb, 0, seg, -1, 1, otmp, ST);
    mlstm_dir(F, l, jb, 1, NSEG - 1 - seg, -1, 2, otmp, ST);
}

namespace hg {
constexpr int STR = 72;
constexpr int IMG = 64 * STR * 2;
constexpr int OFF_KO = 0, OFF_KH = IMG, OFF_VS = 2 * IMG, OFF_QJ = 3 * IMG, OFF_ST = 7 * IMG, OFF_HT = 9 * IMG, OFF_TOT = OFF_HT + 64 * 68 * 4, OFF_BL = OFF_TOT + 8 * 64 * 4, OFF_END = OFF_BL + 512;
static_assert(OFF_END <= RING_BYTES, "hgrn LDS");
constexpr int ST_FLOATS = 64 * 64 + 64;
}
__device__ __forceinline__ void hgrn_dir(const Ctx& F, int l, const MlJob jb, int dir, int fold_r, int emit_slot, int mode, bf16* otmp, float* ST) {
    using namespace hg;
    int tid_ = F.tid; asm volatile("" : "+v"(tid_));
    const int tid = tid_, lane = tid & 63, w = __builtin_amdgcn_readfirstlane(tid >> 6), g = lane >> 4, c = lane & 15;
    LAS bf16* KO = (LAS bf16*)(F.lds + OFF_KO); LAS bf16* KH = (LAS bf16*)(F.lds + OFF_KH); LAS bf16* VS = (LAS bf16*)(F.lds + OFF_VS); LAS bf16* QJ = (LAS bf16*)(F.lds + OFF_QJ);
    LAS bf16* ST0 = (LAS bf16*)(F.lds + OFF_ST); LAS float* HT = (LAS float*)(F.lds + OFF_HT); LAS float* TOT = (LAS float*)(F.lds + OFF_TOT); LAS float* BL = (LAS float*)(F.lds + OFF_BL);
    const int rowbase = jb.isctx ? MX + jb.b * CTX : jb.b * S;
    const int h = jb.h; const bf16* P = F.P;
    float* STd = ST + (size_t)(((jb.b * 4 + h) * 2 + dir) * 8) * ST_FLOATS;
    const int dt = w >> 1, et0 = 2 * (w & 1);
    f32x4 Sst[2]; float Btot[4];
#pragma unroll
    for (int i = 0; i < 2; ++i) Sst[i] = (f32x4){0.f, 0.f, 0.f, 0.f};
#pragma unroll
    for (int r = 0; r < 4; ++r) Btot[r] = 0.f;
    if (fold_r >= 0) {
        f32x4 v[8][2], dk[8];
#pragma unroll
        for (int k = 0; k < NSEG; ++k) { const float* sl = STd + (size_t)k * ST_FLOATS; v[k][0] = *(const f32x4*)(sl + ((w * 2 + 0) * 64 + lane) * 4); v[k][1] = *(const f32x4*)(sl + ((w * 2 + 1) * 64 + lane) * 4);
            dk[k] = *(const f32x4*)(sl + 64 * 64 + 16 * dt + 4 * g); }
        f32x4 run = (f32x4){1.f, 1.f, 1.f, 1.f};
#pragma unroll
        for (int k = NSEG - 1; k >= 0; --k) { const float on = (k <= fold_r) ? 1.f : 0.f; Sst[0] += v[k][0] * (run * on); Sst[1] += v[k][1] * (run * on);
            if (k >= 1) { const bool use = k <= fold_r; run[0] *= use ? __expf(dk[k][0]) : 1.f; run[1] *= use ? __expf(dk[k][1]) : 1.f; run[2] *= use ? __expf(dk[k][2]) : 1.f; run[3] *= use ? __expf(dk[k][3]) : 1.f; } }
    }
    if (mode != 0) {
#pragma unroll
        for (int i = 0; i < 2; ++i) { v2u v; v.x = pk2(Sst[i][0], Sst[i][1]); v.y = pk2(Sst[i][2], Sst[i][3]); *(LAS v2u*)(ST0 + (16 * (et0 + i) + c) * STR + 16 * dt + 4 * g) = v; }
    }
    const int ps = lane, d0 = 8 * w;
    float lbv[8];
#pragma unroll
    for (int e = 0; e < 8; ++e) { lbv[e] = 0.f;
        if (l == 1) { const float v0 = F.hgrn_lb[(0 * 2 + dir) * 256 + h * 64 + d0 + e], v1 = F.hgrn_lb[(1 * 2 + dir) * 256 + h * 64 + d0 + e]; lbv[e] = 1.f / (1.f + expf(v0 - v1)); } }
    const int fcol = dir ? A_FB : A_FF;
    auto tok_of = [&](int ci, int i) -> int { return dir == 0 ? jb.t0 + 64 * ci + i : jb.t0 + 64 * (jb.nchunk - 1 - ci) + (63 - i); };
    v4u rq, rf, rv; rq = rf = rv = (v4u){0u, 0u, 0u, 0u};
    v4u ft = (v4u){0u, 0u, 0u, 0u}, fz = (v4u){0u, 0u, 0u, 0u};
    const int fi_i = tid >> 3, fi_e0 = 8 * (tid & 7);
    float gnv[8];
#pragma unroll
    for (int e = 0; e < 8; ++e) gnv[e] = (mode == 2) ? F.hgrn_gn[l * 256 + h * 64 + fi_e0 + e] : 0.f;
    auto issue_loads = [&](int ci) {
        const bf16* pr = P + (size_t)(rowbase + tok_of(ci, ps)) * PLD + h * 64 + d0;
        if (mode != 0) rq = *(const v4u*)(pr + A_Q);
        rf = *(const v4u*)(pr + fcol); rv = *(const v4u*)(pr + A_I);
    };
    auto issue_fin = [&](int ci) { const int m = rowbase + tok_of(ci, fi_i); ft = *(const v4u*)(otmp + (size_t)m * 256 + h * 64 + fi_e0); fz = *(const v4u*)(P + (size_t)m * PLD + A_Z + h * 64 + fi_e0); };
    issue_loads(0);
    __syncthreads();
    for (int ci = 0; ci < jb.nchunk; ++ci) {
        LAS bf16* STc = ST0 + (ci & 1) * 64 * STR; LAS bf16* STn = ST0 + ((ci + 1) & 1) * 64 * STR;
        {
            float qv[8], kk[8], bb[8], fl[8];
            unpack8(rf, fl);
#pragma unroll
            for (int e = 0; e < 8; ++e) { const float sg = sigmoid_f(fl[e]); const float f = lbv[e] + (1.f - lbv[e]) * sg; bb[e] = __logf(f); kk[e] = (1.f - lbv[e]) * (1.f - sg); }
            if (mode != 0) unpack8(rq, qv);
            const v4u vraw = rv;
            if (ci + 1 < jb.nchunk) issue_loads(ci + 1);
            if (mode == 2) issue_fin(ci);
            float ref1[8], ref2[8], ref3[8], bl[8];
#pragma unroll
            for (int e = 0; e < 8; ++e) { bb[e] = wave_scan_incl(bb[e]); ref1[e] = rdlane(bb[e], 15); ref2[e] = rdlane(bb[e], 31); ref3[e] = rdlane(bb[e], 47); bl[e] = rdlane(bb[e], 63); }
            const int sub = lane >> 4;
            float o8[8];
            if (mode != 0) {
#pragma unroll
                for (int e = 0; e < 8; ++e) { const float rown = sub == 0 ? 0.f : (sub == 1 ? ref1[e] : (sub == 2 ? ref2[e] : ref3[e])); o8[e] = kk[e] * __expf(rown - bb[e]); }
                *(LAS v4u*)(KO + ps * STR + d0) = pack8(o8); }
#pragma unroll
            for (int e = 0; e < 8; ++e) o8[e] = kk[e] * __expf(bl[e] - bb[e]);
            *(LAS v4u*)(KH + ps * STR + d0) = pack8(o8);
            *(LAS v4u*)(VS + ps * STR + d0) = vraw;
            if (mode != 0) {
#pragma unroll
                for (int e = 0; e < 8; ++e) o8[e] = qv[e] * __expf(bb[e]);
                *(LAS v4u*)(QJ + ps * STR + d0) = pack8(o8);
                if (sub >= 1) {
#pragma unroll
                    for (int e = 0; e < 8; ++e) o8[e] = qv[e] * __expf(bb[e] - ref1[e]);
                    *(LAS v4u*)(QJ + (64 + ps) * STR + d0) = pack8(o8); }
                if (sub >= 2) {
#pragma unroll
                    for (int e = 0; e < 8; ++e) o8[e] = qv[e] * __expf(bb[e] - ref2[e]);
                    *(LAS v4u*)(QJ + (128 + ps) * STR + d0) = pack8(o8); }
                if (sub >= 3) {
#pragma unroll
                    for (int e = 0; e < 8; ++e) o8[e] = qv[e] * __expf(bb[e] - ref3[e]);
                    *(LAS v4u*)(QJ + (192 + ps) * STR + d0) = pack8(o8); }
            }
            if (lane == 0) { *(LAS f32x4*)(BL + d0) = (f32x4){bl[0], bl[1], bl[2], bl[3]}; *(LAS f32x4*)(BL + d0 + 4) = (f32x4){bl[4], bl[5], bl[6], bl[7]}; }
        }
        __syncthreads();
        if (mode != 0) {
            const int tt = w & 3, eh = w >> 2;
            f32x4 at[4];
            { bf16x8 kf[4][2], qjf[4][2];
#pragma unroll
              for (int j = 0; j < 4; ++j) if (j <= tt) {
#pragma unroll
                  for (int ks = 0; ks < 2; ++ks) { kf[j][ks] = rm_frag(KO, STR, 16 * j + c, 32 * ks + 8 * g); qjf[j][ks] = rm_frag(QJ + j * 64 * STR, STR, 16 * tt + c, 32 * ks + 8 * g); } }
              LDS_FENCE();
#pragma unroll
              for (int j = 0; j < 4; ++j) { at[j] = (f32x4){0.f, 0.f, 0.f, 0.f};
                  if (j <= tt) {
#pragma unroll
                      for (int ks = 0; ks < 2; ++ks) at[j] = mfma16(kf[j][ks], qjf[j][ks], at[j]);
                      if (j == tt) {
#pragma unroll
                          for (int r = 0; r < 4; ++r) if (4 * g + r > c) at[j][r] = 0.f; }
                  } } }
            bf16x8 pf[2];
#pragma unroll
            for (int k2 = 0; k2 < 2; ++k2) { const unsigned u0 = pk2(at[2 * k2][0], at[2 * k2][1]), u1 = pk2(at[2 * k2][2], at[2 * k2][3]), u2 = pk2(at[2 * k2 + 1][0], at[2 * k2 + 1][1]), u3 = pk2(at[2 * k2 + 1][2], at[2 * k2 + 1][3]);
                pf[k2] = __builtin_bit_cast(bf16x8, (v4u){u0, u1, u2, u3}); }
            { bf16x8 qf[2], vf[2][2], sf[2][2];
#pragma unroll
              for (int ks = 0; ks < 2; ++ks) qf[ks] = rm_frag(QJ, STR, 16 * tt + c, 32 * ks + 8 * g);
#pragma unroll
              for (int ei = 0; ei < 2; ++ei) { const int et = 2 * eh + ei;
#pragma unroll
                  for (int k2 = 0; k2 < 2; ++k2) if (2 * k2 <= tt) vf[ei][k2] = tr_frag(VS, STR, 32 * k2 + 4 * g, 32 * k2 + 16 + 4 * g, 16 * et, lane);
#pragma unroll
                  for (int ks = 0; ks < 2; ++ks) sf[ei][ks] = rm_frag(STc, STR, 16 * et + c, 32 * ks + 8 * g); }
              LDS_FENCE();
#pragma unroll
              for (int ei = 0; ei < 2; ++ei) { const int et = 2 * eh + ei;
                  f32x4 acc = (f32x4){0.f, 0.f, 0.f, 0.f};
#pragma unroll
                  for (int k2 = 0; k2 < 2; ++k2) if (2 * k2 <= tt) acc = mfma16(vf[ei][k2], pf[k2], acc);
#pragma unroll
                  for (int ks = 0; ks < 2; ++ks) acc = mfma16(sf[ei][ks], qf[ks], acc);
                  *(LAS f32x4*)(HT + (16 * tt + c) * 68 + 16 * et + 4 * g) = acc; } }
        }
        {
            const f32x4 blv = *(const LAS f32x4*)(BL + 16 * dt + 4 * g);
#pragma unroll
            for (int r = 0; r < 4; ++r) { const float dec = __expf(blv[r]); Sst[0][r] *= dec; Sst[1][r] *= dec; Btot[r] += blv[r]; }
            { bf16x8 af[2], vf[2][2];
#pragma unroll
              for (int k2 = 0; k2 < 2; ++k2) { af[k2] = tr_frag(KH, STR, 32 * k2 + 8 * g, 32 * k2 + 8 * g + 4, 16 * dt, lane);
#pragma unroll
                  for (int i = 0; i < 2; ++i) vf[k2][i] = tr_frag(VS, STR, 32 * k2 + 8 * g, 32 * k2 + 8 * g + 4, 16 * (et0 + i), lane); }
              LDS_FENCE();
#pragma unroll
              for (int k2 = 0; k2 < 2; ++k2)
#pragma unroll
                  for (int i = 0; i < 2; ++i) Sst[i] = mfma16(af[k2], vf[k2][i], Sst[i]); }
            if (mode != 0) {
#pragma unroll
                for (int i = 0; i < 2; ++i) { v2u v; v.x = pk2(Sst[i][0], Sst[i][1]); v.y = pk2(Sst[i][2], Sst[i][3]); *(LAS v2u*)(STn + (16 * (et0 + i) + c) * STR + 16 * dt + 4 * g) = v; } }
        }
        __syncthreads();
        if (mode != 0) {
            const int i = tid >> 3, sub8 = tid & 7, e0 = 8 * sub8; const int m = rowbase + tok_of(ci, i);
            float hv[8];
            { const f32x4 a0 = *(const LAS f32x4*)(HT + i * 68 + e0), a1 = *(const LAS f32x4*)(HT + i * 68 + e0 + 4); hv[0] = a0[0]; hv[1] = a0[1]; hv[2] = a0[2]; hv[3] = a0[3]; hv[4] = a1[0]; hv[5] = a1[1]; hv[6] = a1[2]; hv[7] = a1[3]; }
            bf16* tp = otmp + (size_t)m * 256 + h * 64 + e0;
            if (mode == 1) *(v4u*)tp = pack8(hv);
            else {
                float tv[8]; unpack8(ft, tv);
                float ss = 0.f;
#pragma unroll
                for (int e = 0; e < 8; ++e) { hv[e] += tv[e]; ss += hv[e] * hv[e]; }
                ss = group8_sum(ss);
                const float rinv = __builtin_amdgcn_rsqf(ss * (1.f / 64.f) + EPS);
                float zv[8]; unpack8(fz, zv);
#pragma unroll
                for (int e = 0; e < 8; ++e) hv[e] = hv[e] * rinv * gnv[e] * zv[e];
                *(v4u*)(F.hxy + (size_t)m * 1024 + h * 64 + e0) = pack8(hv);
            }
        }
    }
    if (emit_slot >= 0) {
        float* sl = STd + (size_t)emit_slot * ST_FLOATS;
        *(f32x4*)(sl + ((w * 2 + 0) * 64 + lane) * 4) = Sst[0]; *(f32x4*)(sl + ((w * 2 + 1) * 64 + lane) * 4) = Sst[1];
        if ((w & 1) == 0 && c == 0) *(f32x4*)(sl + 64 * 64 + 16 * dt + 4 * g) = (f32x4){Btot[0], Btot[1], Btot[2], Btot[3]};
    }
    __syncthreads();
}
__device__ __forceinline__ void hgrn_itemA(const Ctx& F, int l, int bh, int it, bf16* otmp, float* ST) {
    const int b = bh >> 2, h = bh & 3;
    if (it == 0) {
        const MlJob jb{b, h, 1, 0, 4};
        hgrn_dir(F, l, jb, 0, -1, 0, l == 0 ? 1 : 0, otmp, ST);
        hgrn_dir(F, l, jb, 1, -1, 0, l == 0 ? 2 : 0, otmp, ST);
    } else {
        const int dir = (it - 1) / (NSEG - 1), k = (it - 1) % (NSEG - 1), seg = dir == 0 ? k : NSEG - 1 - k;
        const MlJob jb{b, h, 0, SEGTOK * seg, SEGCH};
        hgrn_dir(F, l, jb, dir, -1, 1 + k, 0, otmp, ST);
    }
}
__device__ __forceinline__ void hgrn_itemC(const Ctx& F, int l, int bh, int seg, bf16* otmp, float* ST) {
    const MlJob jb{bh >> 2, bh & 3, 0, SEGTOK * seg, SEGCH};
    hgrn_dir(F, l, jb, 0, seg, -1, 1, otmp, ST);
    hgrn_dir(F, l, jb, 1, NSEG - 1 - seg, -1, 2, otmp, ST);
}

namespace nat {
constexpr int STR = 72, IMG = 64 * STR * 2;
constexpr int OFF_K = 0, OFF_V = 2 * IMG, OFF_RPB = 4 * IMG, OFF_END = OFF_RPB + 2048;
static_assert(OFF_END <= RING_BYTES, "na LDS");
}
template <int CH, bool WIN>
__device__ __forceinline__ void na_block(const LAS bf16* Kc, const LAS bf16* Vc, const LAS float* RPB, const bf16x8 (&qf)[2][2], f32x4 (&oacc)[2][4], float (&mrun)[2], float (&lrun)[2],
                                         const int g, const int c, const int lane, const int dr, const int (&qcol)[2], const int (&csq)[2]) {
    constexpr int STR = nat::STR;
    constexpr int KLO[2] = {WIN ? (CH == 0 ? 0 : 1) : 0, WIN ? (CH == 0 ? 0 : 2) : 0}, KHI[2] = {WIN ? (CH == 0 ? 1 : 3) : 3, WIN ? (CH == 0 ? 2 : 3) : 3};
    constexpr int ULO = KLO[0] < KLO[1] ? KLO[0] : KLO[1], UHI = KHI[0] > KHI[1] ? KHI[0] : KHI[1];
    f32x4 st[2][4];
    { bf16x8 kf[4][2];
#pragma unroll
      for (int kt = ULO; kt <= UHI; ++kt)
#pragma unroll
          for (int ks = 0; ks < 2; ++ks) kf[kt][ks] = rm_frag(Kc, STR, 16 * kt + c, 32 * ks + 8 * g);
      LDS_FENCE();
#pragma unroll
      for (int qt = 0; qt < 2; ++qt)
#pragma unroll
          for (int kt = 0; kt < 4; ++kt) { st[qt][kt] = (f32x4){0.f, 0.f, 0.f, 0.f};
              if (kt >= KLO[qt] && kt <= KHI[qt]) {
#pragma unroll
                  for (int ks = 0; ks < 2; ++ks) st[qt][kt] = mfma16(kf[kt][ks], qf[qt][ks], st[qt][kt]); } } }
    if (WIN) {
#pragma unroll
        for (int qt = 0; qt < 2; ++qt) { const int boff = dr * 31 + 15 - qcol[qt];
#pragma unroll
            for (int kt = KLO[qt]; kt <= KHI[qt]; ++kt)
#pragma unroll
                for (int r = 0; r < 4; ++r) { const int kc = 16 * kt + 4 * g + r; const float bias = RPB[min(max(boff + kc, 0), 464)]; const float v = st[qt][kt][r] + bias; st[qt][kt][r] = ((unsigned)(kc - csq[qt]) < 16u) ? v : -1e30f; } }
    }
    float alpha[2]; bf16x8 pf[2][2];
#pragma unroll
    for (int qt = 0; qt < 2; ++qt) {
        float bm = -1e30f;
#pragma unroll
        for (int kt = KLO[qt]; kt <= KHI[qt]; ++kt)
#pragma unroll
            for (int r = 0; r < 4; ++r) bm = fmaxf(bm, st[qt][kt][r]);
        bm = xor32_max(xor16_max(bm));
        const float mnew = fmaxf(mrun[qt], bm); alpha[qt] = __builtin_amdgcn_exp2f(mrun[qt] - mnew); mrun[qt] = mnew;
        float ps = 0.f;
#pragma unroll
        for (int kt = KLO[qt]; kt <= KHI[qt]; ++kt)
#pragma unroll
            for (int r = 0; r < 4; ++r) { const float p = __builtin_amdgcn_exp2f(st[qt][kt][r] - mnew); st[qt][kt][r] = p; ps += p; }
        lrun[qt] = lrun[qt] * alpha[qt] + ps;
#pragma unroll
        for (int k2 = 0; k2 < 2; ++k2) { const unsigned u0 = pk2(st[qt][2 * k2][0], st[qt][2 * k2][1]), u1 = pk2(st[qt][2 * k2][2], st[qt][2 * k2][3]), u2 = pk2(st[qt][2 * k2 + 1][0], st[qt][2 * k2 + 1][1]), u3 = pk2(st[qt][2 * k2 + 1][2], st[qt][2 * k2 + 1][3]);
            pf[qt][k2] = __builtin_bit_cast(bf16x8, (v4u){u0, u1, u2, u3}); }
    }
    { bf16x8 vf[4][2];
#pragma unroll
      for (int dtl = 0; dtl < 4; ++dtl)
#pragma unroll
          for (int k2 = ULO / 2; k2 <= UHI / 2; ++k2) vf[dtl][k2] = tr_frag(Vc, STR, 32 * k2 + 4 * g, 32 * k2 + 16 + 4 * g, 16 * dtl, lane);
      LDS_FENCE();
#pragma unroll
      for (int qt = 0; qt < 2; ++qt)
#pragma unroll
          for (int dtl = 0; dtl < 4; ++dtl) { f32x4 a = oacc[qt][dtl] * alpha[qt];
#pragma unroll
              for (int k2 = KLO[qt] / 2; k2 <= KHI[qt] / 2; ++k2) a = mfma16(vf[dtl][k2], pf[qt][k2], a);
              oacc[qt][dtl] = a; } }
}
__device__ __forceinline__ void na_item(const Ctx& F, int l, int b, int h, int R0) {
    using namespace nat;
    int tid_ = F.tid; asm volatile("" : "+v"(tid_));
    const int tid = tid_, lane = tid & 63, w = __builtin_amdgcn_readfirstlane(tid >> 6), g = lane >> 4, c = lane & 15;
    LAS bf16* KT = (LAS bf16*)(F.lds + OFF_K); LAS bf16* VT = (LAS bf16*)(F.lds + OFF_V); LAS float* RPB = (LAS float*)(F.lds + OFF_RPB);
    const bf16* P = F.P; const bool lat = R0 >= 0;
    const int R = R0 + (w >> 1), ch = w & 1;
    const int rsR = min(max(R - 4, 0), 56);
    const int kr0 = lat ? min(max(R0 - 4, 0), 56) : 0;
    const int nwin = lat ? (min(max(R0 + 3 - 4, 0), 56) + 8 - kr0) : 0, nblk = nwin + 4;
    if (lat) for (int i = tid; i < 15 * 31; i += 512) RPB[i] = F.na_rpb[((size_t)l * 6 + h) * 465 + i] * 1.4426950408889634f;
    int mq[2]; bf16x8 qf[2][2]; int csq[2], qcol[2];
#pragma unroll
    for (int qt = 0; qt < 2; ++qt) {
        if (lat) { qcol[qt] = 32 * ch + 16 * qt + c; mq[qt] = b * S + R * 64 + qcol[qt]; } else { qcol[qt] = 0; mq[qt] = MX + b * CTX + 32 * w + 16 * qt + c; }
        csq[qt] = min(max(qcol[qt] - 8, 0), 48);
#pragma unroll
        for (int ks = 0; ks < 2; ++ks) qf[qt][ks] = *(const bf16x8*)(P + (size_t)mq[qt] * PLD + C_Q + h * 64 + 32 * ks + 8 * g);
    }
    f32x4 oacc[2][4]; float mrun[2], lrun[2];
#pragma unroll
    for (int qt = 0; qt < 2; ++qt) { mrun[qt] = -1e30f; lrun[qt] = 0.f;
#pragma unroll
        for (int dtl = 0; dtl < 4; ++dtl) oacc[qt][dtl] = (f32x4){0.f, 0.f, 0.f, 0.f}; }
    const int stok = tid >> 3, spc = tid & 7;
    auto blk_row = [&](int i) -> int { return i < nwin ? b * S + (kr0 + i) * 64 + stok : MX + b * CTX + 64 * (i - nwin) + stok; };
    v4u rk0, rv0, rk1, rv1, rk2, rv2;
    auto ld = [&](int i, v4u& k_, v4u& v_) { const int ii = i < nblk ? i : nblk - 1; const bf16* pr = P + (size_t)blk_row(ii) * PLD + h * 64 + 8 * spc; k_ = *(const v4u*)(pr + C_K); v_ = *(const v4u*)(pr + C_V); };
    ld(0, rk0, rv0); ld(1, rk1, rv1); ld(2, rk2, rv2);
    __syncthreads();
    *(LAS v4u*)(KT + stok * STR + 8 * spc) = rk0; *(LAS v4u*)(VT + stok * STR + 8 * spc) = rv0;
    ld(3, rk0, rv0);
    __syncthreads();
    auto step = [&](int i, v4u& kn, v4u& vn) {
        const LAS bf16* Kc = KT + (i & 1) * 64 * STR; const LAS bf16* Vc = VT + (i & 1) * 64 * STR;
        if (i + 1 < nblk) { LAS bf16* Kn = KT + ((i + 1) & 1) * 64 * STR; LAS bf16* Vn = VT + ((i + 1) & 1) * 64 * STR;
            *(LAS v4u*)(Kn + stok * STR + 8 * spc) = kn; *(LAS v4u*)(Vn + stok * STR + 8 * spc) = vn;
            if (i + 4 < nblk) ld(i + 4, kn, vn); }
        const bool win = i < nwin; const int kr = kr0 + i;
        const bool active = !win || (kr >= rsR && kr < rsR + 8);
        if (active) {
            if (!win) na_block<0, false>(Kc, Vc, RPB, qf, oacc, mrun, lrun, g, c, lane, 0, qcol, csq);
            else if (ch == 0) na_block<0, true>(Kc, Vc, RPB, qf, oacc, mrun, lrun, g, c, lane, kr - R + 7, qcol, csq);
            else na_block<1, true>(Kc, Vc, RPB, qf, oacc, mrun, lrun, g, c, lane, kr - R + 7, qcol, csq);
        }
        __syncthreads();
    };
    for (int i = 0; i < nblk; i += 3) { step(i, rk1, rv1); if (i + 1 < nblk) step(i + 1, rk2, rv2); if (i + 2 < nblk) step(i + 2, rk0, rv0); }
#pragma unroll
    for (int qt = 0; qt < 2; ++qt) {
        const float lt = xor32_sum(xor16_sum(lrun[qt]));
        const float rl = __builtin_amdgcn_rcpf(lt);
        const bf16* zr = P + (size_t)mq[qt] * PLD + C_Z + h * 64; bf16* yr = F.hxy + (size_t)mq[qt] * 1024 + 640 + h * 64;
#pragma unroll
        for (int dtl = 0; dtl < 4; ++dtl) { const int d = 16 * dtl + 4 * g; const v2u zv = *(const v2u*)(zr + d);
            const float z0 = __uint_as_float(zv.x << 16), z1 = __uint_as_float(zv.x & 0xffff0000u), z2 = __uint_as_float(zv.y << 16), z3 = __uint_as_float(zv.y & 0xffff0000u);
            v2u o; o.x = pk2(oacc[qt][dtl][0] * rl * z0, oacc[qt][dtl][1] * rl * z1); o.y = pk2(oacc[qt][dtl][2] * rl * z2, oacc[qt][dtl][3] * rl * z3);
            *(v2u*)(yr + d) = o; }
    }
}

__device__ __forceinline__ void phase_mixA(const Ctx& F, int l, unsigned* ticket) {
    mlstm_load_rope(F, F.rope);
    volatile LAS unsigned* slot = (volatile LAS unsigned*)(F.lds + MISC_OFF) + 16;
    const int n_ctx = 64, n_na = 768, n_loc = 2 * 32 * 2 * (NSEG - 1), n_nactx = (l == 0) ? 48 : 0, n_all = n_ctx + n_na + n_loc + n_nactx;
    unsigned cur = 0;
    if (F.tid == 0) *slot = __hip_atomic_fetch_add(ticket, 1u, __ATOMIC_RELAXED, __HIP_MEMORY_SCOPE_AGENT);
    __syncthreads();
    cur = *slot;
    while ((int)cur < n_all) {
        unsigned nxt = 0;
        if (F.tid == 0) nxt = __hip_atomic_fetch_add(ticket, 1u, __ATOMIC_RELAXED, __HIP_MEMORY_SCOPE_AGENT);
        int it = (int)cur;
        const int tkind = it < n_ctx ? 22 : (it < n_ctx + n_na ? 20 : (it < n_ctx + n_na + n_loc ? (it < n_ctx + n_na + n_loc / 2 ? 21 : 23) : 24));
        if (l == 0) { TS_START(F, tkind); if (PROBE_T == 25 && blockIdx.x == 0 && F.tid == 0) TS_LDS(F)[0] += 2000; }
        if (it < n_ctx) { if (it < 32) mlstm_itemA(F, l, it, 0, F.otm, F.stm); else hgrn_itemA(F, l, it - 32, 0, F.oth, F.sth); }
        else if ((it -= n_ctx) < n_na) na_item(F, l, it / 96, (it / 16) % 6, 4 * (it % 16));
        else if ((it -= n_na) < n_loc) { constexpr int NL = 2 * (NSEG - 1); if (it < 32 * NL) mlstm_itemA(F, l, it / NL, 1 + it % NL, F.otm, F.stm); else { it -= 32 * NL; hgrn_itemA(F, l, it / NL, 1 + it % NL, F.oth, F.sth); } }
        else { it -= n_loc; na_item(F, l, it / 6, it % 6, -1); }
        if (l == 0) TS_STOP(F, tkind);
        __syncthreads();
        if (F.tid == 0) *slot = nxt;
        __syncthreads();
        cur = *slot;
    }
}
__device__ __forceinline__ void phase_mixC(const Ctx& F, int l) {
    mlstm_load_rope(F, F.rope);
    for (int it = F.vcu; it < 2 * 32 * NSEG; it += F.G) {
        if (it < 32 * NSEG) mlstm_itemC(F, l, it / NSEG, it % NSEG, F.otm, F.stm);
        else hgrn_itemC(F, l, (it - 32 * NSEG) / NSEG, it % NSEG, F.oth, F.sth);
    }
}

constexpr int NPH = 12;
struct Args { const float* in[15]; float* out; unsigned char* ws; int ph_lo, ph_hi; };
__global__ void __launch_bounds__(512, 2) mega_fwd(Args args) {
    extern __shared__ __attribute__((aligned(16))) unsigned char lds[];
    Ctx F;
    F.lds = (LAS unsigned char*)lds;
    F.tid = threadIdx.x; F.lane = F.tid & 63; F.wave = __builtin_amdgcn_readfirstlane(F.tid >> 6);
    F.G = gridDim.x; { const int bx = blockIdx.x; F.vcu = (F.G % 8 == 0) ? (bx % 8) * (F.G / 8) + bx / 8 : bx; }
    F.gw = F.vcu * 8 + F.wave; F.NGW = F.G * 8;
    unsigned char* ws = args.ws;
    F.x = args.in[0]; F.c = args.in[1]; F.ctx = args.in[2]; F.c_ctx = args.in[3]; F.w_mod = args.in[4]; F.b_mod = args.in[5]; F.g_pre = args.in[6]; F.g_post = args.in[7];
    F.w_in = args.in[8]; F.w_out = args.in[9]; F.hgrn_lb = args.in[10]; F.hgrn_gn = args.in[11]; F.gate_b = args.in[12]; F.mlstm_gn = args.in[13]; F.na_rpb = args.in[14];
    F.out = args.out;
    F.wt_in = (bf16*)(ws + WS_WT_IN); F.wt_out = (bf16*)(ws + WS_WT_OUT); F.mod = (float*)(ws + WS_MOD); F.gates = (float*)(ws + WS_GATES); F.ctx1 = (float*)(ws + WS_CTX1);
    F.hxy = (bf16*)(ws + WS_HXY); F.P = (bf16*)(ws + WS_P); F.UX = (bf16*)(ws + WS_P); F.oth = (bf16*)(ws + WS_OH); F.sth = (float*)(ws + WS_STH); F.otm = (bf16*)(ws + WS_OM); F.stm = (float*)(ws + WS_STM); F.rope = (float*)(ws + WS_ROPE);
    for (int u = F.tid; u < (LDS_BYTES - LDSCTL_OFF) / 4; u += 512) ((LAS unsigned*)(F.lds + LDSCTL_OFF))[u] = 0u;
    __syncthreads();
    XcdBarrier bar = xcd_barrier_post((unsigned*)(ws + WS_CTL) + CW_BAR, (volatile LAS unsigned*)(F.lds + MISC_OFF) + 8);

    const int lo = args.ph_lo, hi = args.ph_hi;
#ifndef DUP_PHASE
#define DUP_PHASE -1
#endif
#define IN(k) (lo <= (k) && (k) < hi)
#define SEAM(k) do { if ((k) + 1 < hi) xcd_barrier(bar); } while (0)
#define PHASE(k, ...) if (IN(k)) { TS_START(F, 100 + (k)); __VA_ARGS__; if ((k) == DUP_PHASE) { xcd_barrier(bar); __VA_ARGS__; } SEAM(k); TS_STOP(F, 100 + (k)); }
    PHASE(0, phase_p0(F))
    PHASE(1, { phase_prenorm0(F); phase_p1_transposes(F); })
#define LAYER(l) \
    PHASE(2 + 5 * (l), { \
        pg8::Gemm g{F.hxy, F.wt_in + (size_t)(l) * NPAD * 1024, M, NPAD, 1024}; \
        pg8::EpiIn E{F.P, F.gates, F.gate_b + (l) * 16}; \
        pg8::StaticOrder SO; SO.init(M, NPAD, F.G, (int)blockIdx.x); pg8::gemm_phase<pg8::EpiIn, pg8::StaticOrder, true, true>(F.lds + RING_OFF, g, SO, E); }) \
    PHASE(3 + 5 * (l), phase_mixA(F, (l), (unsigned*)(args.ws + WS_CTL) + 8192 + 64 * (l))) \
    PHASE(4 + 5 * (l), phase_mixC(F, (l))) \
    PHASE(5 + 5 * (l), { \
        constexpr int Ml = (l) == 0 ? M : MX; \
        pg8::Gemm g{F.hxy, F.wt_out + (size_t)(l) * 1024 * 1024, Ml, 1024, 1024}; pg8::StaticOrder SO; SO.init(Ml, 1024, F.G, (int)blockIdx.x); \
        pg8::EpiOut E{F.UX}; \
        pg8::gemm_phase<pg8::EpiOut, pg8::StaticOrder, true, true>(F.lds + RING_OFF, g, SO, E); }) \
    PHASE(6 + 5 * (l), phase_post(F, (l)))
    LAYER(0)
    LAYER(1)
#undef LAYER
#undef PHASE
#undef IN
#undef SEAM
    if (PROBE_T != 0 && blockIdx.x == 0 && F.tid == 0) { const unsigned long long t0 = __builtin_amdgcn_s_memtime(), dt = 8ull * TS_LDS(F)[0]; while (__builtin_amdgcn_s_memtime() - t0 < dt) __builtin_amdgcn_s_sleep(8); }
}

extern "C" void kernel_launch(void* const* d_in, const int* in_sizes, int n_in, void* d_out, int out_size, void* d_ws, size_t ws_size, hipStream_t stream) {
    static int grid = 0;
    if (grid == 0) {
        if (n_in != 15 || ws_size < WS_END) { fprintf(stderr, "kernel_launch: unexpected n_in %d / ws_size %zu (need %zu); nothing launched\n", n_in, ws_size, (size_t)WS_END); grid = -1; return; }
        int dev = 0, cus = 0, per_cu = 0;
        if (hipGetDevice(&dev) != hipSuccess || hipDeviceGetAttribute(&cus, hipDeviceAttributeMultiprocessorCount, dev) != hipSuccess) { grid = -1; return; }
        if (hipFuncSetAttribute((const void*)mega_fwd, hipFuncAttributeMaxDynamicSharedMemorySize, LDS_BYTES) != hipSuccess) { fprintf(stderr, "kernel_launch: hipFuncSetAttribute failed\n"); grid = -1; return; }
        if (hipOccupancyMaxActiveBlocksPerMultiprocessor(&per_cu, (const void*)mega_fwd, 512, LDS_BYTES) != hipSuccess || per_cu < 1) { fprintf(stderr, "kernel_launch: occupancy query says %d blocks/CU\n", per_cu); (void)hipGetLastError(); grid = -1; return; }
        grid = cus;
    }
    if (grid < 0) return;
    (void)hipMemsetAsync((char*)d_ws + WS_CTL, 0, CTL_BYTES, stream);
    Args a{};
    for (int i = 0; i < 15; ++i) a.in[i] = (const float*)d_in[i];
    a.out = (float*)d_out; a.ws = (unsigned char*)d_ws; a.ph_lo = 0; a.ph_hi = NPH;
    hipLaunchKernelGGL(mega_fwd, dim3(grid), dim3(512), LDS_BYTES, stream, a);
}
```

```cpp
#include <hip/hip_runtime.h>
#include <stdint.h>
#include <cstdio>

namespace cfg {
constexpr int D = 1024, NB = 8, S = 4096, CTX = 256;
constexpr int MX = NB * S, MC = NB * CTX, M = MX + MC;
constexpr int PIN = 4752, NPAD = 4864, PLD = 4736;
constexpr int A_Q = 0, A_FF = 256, A_FB = 512, A_I = 768, A_Z = 1024, B_Q = 1280, B_K = 1664, B_V = 2048, B_O = 2432, B_Z = 2816,
              C_Q = 3200, C_K = 3584, C_V = 3968, C_Z = 4352;
constexpr float EPS = 1e-6f;
constexpr size_t WS_CTL = 0, CTL_BYTES = 65536;
constexpr size_t WS_WT_IN = WS_CTL + CTL_BYTES;
constexpr size_t WS_WT_OUT = WS_WT_IN + 2ull * NPAD * 1024 * 2;
constexpr size_t WS_MOD = WS_WT_OUT + 2ull * 1024 * 1024 * 2;
constexpr size_t WS_GATES = WS_MOD + 2ull * 9 * 3072 * 4;
constexpr size_t WS_CTX1 = WS_GATES + (size_t)M * 16 * 4;
constexpr size_t WS_HXY = WS_CTX1 + (size_t)MC * 1024 * 4;
constexpr size_t WS_P = WS_HXY + (size_t)M * 1024 * 2;
constexpr size_t WS_OH = WS_P + (size_t)M * PLD * 2;
constexpr size_t WS_OM = WS_OH + (size_t)M * 256 * 4;
constexpr size_t WS_STM = WS_OM + (size_t)M * 384 * 2;
constexpr size_t WS_ROPE = WS_STM + 32ull * 2 * 8 * (96 * 112 + 16) * 4;
constexpr size_t WS_STH = WS_ROPE + 64 * 24 * 8;
constexpr size_t WS_END = WS_STH + 32ull * 2 * 8 * (64 * 64 + 64) * 4;
static_assert(WS_END <= 536870912ull, "workspace");
static_assert(WS_WT_IN % 256 == 0 && WS_MOD % 256 == 0 && WS_GATES % 256 == 0 && WS_CTX1 % 256 == 0 && WS_HXY % 256 == 0 && WS_P % 256 == 0 && WS_OH % 256 == 0 && WS_OM % 256 == 0 && WS_STM % 256 == 0 && WS_ROPE % 256 == 0 && WS_STH % 256 == 0, "align");
}
using namespace cfg;

namespace pg8 {
#define PG8_LAS __attribute__((address_space(3)))
typedef unsigned short bf16_t;
typedef short bf16x8 __attribute__((ext_vector_type(8)));
typedef float f32x4 __attribute__((ext_vector_type(4)));
typedef unsigned u32x4 __attribute__((ext_vector_type(4)));
constexpr int BM = 256, BK = 64, HALF = 128, HTB = HALF * BK * 2  , STAGE_BYTES = 8 * HTB, NXCD = 8, WGM = 8;

__host__ __device__ __forceinline__ int lds_byte(int r, int c) { const int st = (r >> 4) * 2 + (c >> 5), rr = r & 15, cc = c & 31, ob = rr * 64 + cc * 2; return st * 1024 + (ob ^ (((ob >> 9) & 1) << 5)); }
__host__ __device__ __forceinline__ void stage_rc(int b, int& R, int& C) { const int st = b / 1024, sb = b % 1024, swz = sb ^ (((sb >> 9) & 1) << 5); R = (st >> 1) * 16 + swz / 64; C = (st & 1) * 32 + (swz % 64) / 2; }
__host__ __device__ __forceinline__ int perm32(int rho) { const int n = rho >> 4, i = rho & 15; return 8 * (i >> 2) + 4 * n + (i & 3); }

struct Unit { int pm, pn; };
struct Gemm { const bf16_t* A; const bf16_t* Bt; int M, N, K; };

struct StaticOrder {
    int nM, nN, nwg, G, c;
    __host__ __device__ void init(int M, int N, int G_, int c_) { nM = M / BM; nN = N / BM; nwg = nM * nN; G = G_; c = c_; }
    __host__ __device__ bool next(int i, Unit& u) const {
        const long L = (long)i * G + c; if (L >= nwg) return false;
        int wgid = (int)L; { const int q = nwg / NXCD, r = nwg % NXCD, xcd = wgid % NXCD, off = wgid / NXCD; wgid = (xcd < r ? xcd * (q + 1) : r * (q + 1) + (xcd - r) * q) + off; }
        const int nig = WGM * nN, gid = wgid / nig, fm = gid * WGM, gsz = (nM - fm) < WGM ? (nM - fm) : WGM;
        u.pm = fm + ((wgid % nig) % gsz); u.pn = (wgid % nig) / gsz; return true;
    }
    __device__ __forceinline__ void a_ready(const Unit&) const {}
    __device__ __forceinline__ void done(const Unit&) const {}
};

__device__ __forceinline__ unsigned cvt_pk_bf16(float lo, float hi) { unsigned r; asm volatile("v_cvt_pk_bf16_f32 %0, %1, %2" : "=v"(r) : "v"(lo), "v"(hi)); return r; }
__device__ __forceinline__ float logsigmoid_e(float v) { return fminf(v, 0.f) - log1pf(__expf(-fabsf(v))); }

struct EpiIn {
    static constexpr bool PERM = true, AFTER_DRAIN = false;
    bf16_t* P; float* gates; const float* gate_b;
    __device__ __forceinline__ void operator()(const f32x4 (&acc)[2][2][4][2], const Unit& u, int wr, int wc, int fr, int fq) const {
        const int row0 = u.pm * BM + wr * 64 + fr, col0 = u.pn * BM + wc * 32 + 8 * fq;
#pragma unroll
        for (int bj = 0; bj < 2; ++bj) {
            const int col = col0 + bj * HALF;
            if (col < cfg::PLD) {
                const int act = col < 256 ? 1 : col < 1024 ? 0 : col < 1280 ? 2 : col < 1664 ? 3 : col < 2432 ? 0 : col < 2816 ? 4 : col < 3200 ? 2 : col < 3584 ? 5 : col < 4352 ? 0 : 2;
#pragma unroll
                for (int ai = 0; ai < 2; ++ai)
#pragma unroll
                    for (int m = 0; m < 4; ++m) { f32x4 v0 = acc[ai][bj][m][0], v1 = acc[ai][bj][m][1];
                        if (act == 1 || act == 2 || act == 4) { const float sc = act == 1 ? 0.125f : 1.f;
#pragma unroll
                            for (int e = 0; e < 4; ++e) { const float s0 = __builtin_amdgcn_rcpf(1.f + __expf(-v0[e])), s1 = __builtin_amdgcn_rcpf(1.f + __expf(-v1[e])); v0[e] = act == 4 ? s0 : v0[e] * s0 * sc; v1[e] = act == 4 ? s1 : v1[e] * s1 * sc; } }
                        else if (act == 3) { v0 = v0 * 0.10206207261596575f; v1 = v1 * 0.10206207261596575f; }
                        else if (act == 5) { v0 = v0 * (0.125f * 1.4426950408889634f); v1 = v1 * (0.125f * 1.4426950408889634f); }
                        u32x4 w; w.x = cvt_pk_bf16(v0[0], v0[1]); w.y = cvt_pk_bf16(v0[2], v0[3]); w.z = cvt_pk_bf16(v1[0], v1[1]); w.w = cvt_pk_bf16(v1[2], v1[3]);
                        *(u32x4*)(P + (size_t)(row0 + ai * HALF + m * 16) * cfg::PLD + col) = w; }
            } else if (col < cfg::PIN) {
                const int g0 = col - cfg::PLD;
                const f32x4 b0 = *(const f32x4*)(gate_b + g0), b1 = *(const f32x4*)(gate_b + g0 + 4);
#pragma unroll
                for (int ai = 0; ai < 2; ++ai)
#pragma unroll
                    for (int m = 0; m < 4; ++m) { f32x4 v0 = acc[ai][bj][m][0] + b0, v1 = acc[ai][bj][m][1] + b1;
                        if (g0 >= 8) {
#pragma unroll
                            for (int e = 0; e < 4; ++e) { v0[e] = logsigmoid_e(v0[e]); v1[e] = logsigmoid_e(v1[e]); } }
                        float* gp = gates + (size_t)(row0 + ai * HALF + m * 16) * 16 + g0;
                        *(f32x4*)gp = v0; *(f32x4*)(gp + 4) = v1; }
            }
        }
    }
};
struct EpiOut {
    static constexpr bool PERM = true, AFTER_DRAIN = false;
    bf16_t* C;
    __device__ __forceinline__ void operator()(const f32x4 (&acc)[2][2][4][2], const Unit& u, int wr, int wc, int fr, int fq) const {
        const int row0 = u.pm * BM + wr * 64 + fr, col0 = u.pn * BM + wc * 32 + 8 * fq;
#pragma unroll
        for (int ai = 0; ai < 2; ++ai)
#pragma unroll
            for (int m = 0; m < 4; ++m) { bf16_t* rowp = C + (size_t)(row0 + ai * HALF + m * 16) * 1024 + col0;
#pragma unroll
                for (int bj = 0; bj < 2; ++bj) { const f32x4 v0 = acc[ai][bj][m][0], v1 = acc[ai][bj][m][1];
                    u32x4 w; w.x = cvt_pk_bf16(v0[0], v0[1]); w.y = cvt_pk_bf16(v0[2], v0[3]); w.z = cvt_pk_bf16(v1[0], v1[1]); w.w = cvt_pk_bf16(v1[2], v1[3]);
                    *(u32x4*)(rowp + bj * HALF) = w; } }
    }
};

template <class Epi, class Sched, bool ALIGN_EPI = false, bool SP2 = false>
__device__ __forceinline__ void gemm_phase(PG8_LAS unsigned char* lds, const Gemm g, const Sched& S, const Epi& E) {
    const int tid = threadIdx.x, wid = __builtin_amdgcn_readfirstlane(tid >> 6), lane = tid & 63, wr = wid >> 2, wc = wid & 3, fr = lane & 15, fq = lane >> 4;
    const int K = g.K, nt = K / BK;
    unsigned voffA[2], voffB[2];
#pragma unroll
    for (int i = 0; i < 2; ++i) { int R, C; stage_rc(tid * 16 + i * 8192, R, C); const int Rb = Epi::PERM ? ((R & ~31) + perm32(R & 31)) : R;
        voffA[i] = (unsigned)(R * K + C) * 2u; voffB[i] = (unsigned)(Rb * K + C) * 2u; }
    const size_t kstep = (size_t)(BK * 2);
    const size_t hstep = (size_t)HALF * K * 2;
    const size_t tstep = 2 * hstep;
    const unsigned ldsw = (unsigned)wid * 1024u;
    const int aoff = lds_byte(wr * 64 + fr, fq * 8), boff = lds_byte(wc * 32 + fr, fq * 8);
#define PG8_SA(b, h) (((b) * 2 + (h)) * HTB)
#define PG8_SB(b, h) ((4 + (b) * 2 + (h)) * HTB)
#define PG8_STAGE(bufoff, gbase, voff) do { _Pragma("unroll") for (int _i = 0; _i < 2; ++_i) \
        __builtin_amdgcn_global_load_lds((const unsigned*)((const char*)(gbase) + (voff)[_i]), (PG8_LAS unsigned*)(lds + (bufoff) + ldsw + _i * 8192), 16, 0, 0); } while (0)
#define PG8_LDA(dst, b, h) do { _Pragma("unroll") for (int m = 0; m < 4; ++m) _Pragma("unroll") for (int k = 0; k < 2; ++k) dst[m][k] = *(const PG8_LAS bf16x8*)(lds + PG8_SA(b, h) + aoff + m * 2048 + k * 1024); } while (0)
#define PG8_LDB(dst, b, h) do { _Pragma("unroll") for (int n = 0; n < 2; ++n) _Pragma("unroll") for (int k = 0; k < 2; ++k) dst[n][k] = *(const PG8_LAS bf16x8*)(lds + PG8_SB(b, h) + boff + n * 2048 + k * 1024); } while (0)
#define PG8_MMA(ai, bj, At, Bt) do { __builtin_amdgcn_s_setprio(1); _Pragma("unroll") for (int m = 0; m < 4; ++m) _Pragma("unroll") for (int n = 0; n < 2; ++n) _Pragma("unroll") for (int k = 0; k < 2; ++k) \
        acc[ai][bj][m][n] = __builtin_amdgcn_mfma_f32_16x16x32_bf16(Bt[n][k], At[m][k], acc[ai][bj][m][n], 0, 0, 0); __builtin_amdgcn_s_setprio(0); } while (0)
#define PG8_WAIT_V(n) asm volatile("s_waitcnt vmcnt(" #n ")" ::: "memory")
#define PG8_WAIT_L(n) asm volatile("s_waitcnt lgkmcnt(" #n ")" ::: "memory")
#define PG8_BAR __builtin_amdgcn_s_barrier()
#define PG8_SCHED __builtin_amdgcn_sched_barrier(0)
    Unit cur, nxt; int ui = 0;
    if (!S.next(0, cur)) return;
    f32x4 acc[2][2][4][2];
#pragma unroll
    for (int a = 0; a < 2; ++a)
#pragma unroll
        for (int b = 0; b < 2; ++b)
#pragma unroll
            for (int m = 0; m < 4; ++m)
#pragma unroll
                for (int n = 0; n < 2; ++n) acc[a][b][m][n] = (f32x4){0.f, 0.f, 0.f, 0.f};
    bf16x8 At[4][2], B0[2][2], B1[2][2];
    const char* cA = (const char*)g.A + (size_t)cur.pm * tstep; const char* cB = (const char*)g.Bt + (size_t)cur.pn * tstep;
    S.a_ready(cur);
    if constexpr (SP2) {
        PG8_STAGE(PG8_SB(0, 0), cB, voffB); PG8_STAGE(PG8_SB(0, 1), cB + hstep, voffB); PG8_STAGE(PG8_SA(0, 0), cA, voffA); PG8_STAGE(PG8_SA(0, 1), cA + hstep, voffA);
        if (wr == 1) PG8_BAR;
        PG8_WAIT_V(2); PG8_BAR;
        PG8_STAGE(PG8_SB(1, 0), cB + kstep, voffB); PG8_STAGE(PG8_SA(1, 0), cA + kstep, voffA); PG8_STAGE(PG8_SB(1, 1), cB + hstep + kstep, voffB);
        PG8_WAIT_V(6); PG8_BAR;
    } else {
        PG8_STAGE(PG8_SB(0, 0), cB, voffB); PG8_STAGE(PG8_SA(0, 0), cA, voffA); PG8_STAGE(PG8_SB(0, 1), cB + hstep, voffB); PG8_STAGE(PG8_SA(0, 1), cA + hstep, voffA);
        if (wr == 1) PG8_BAR;
        PG8_WAIT_V(4); PG8_BAR;
        PG8_STAGE(PG8_SB(1, 0), cB + kstep, voffB); PG8_STAGE(PG8_SA(1, 0), cA + kstep, voffA); PG8_STAGE(PG8_SB(1, 1), cB + hstep + kstep, voffB);
        PG8_WAIT_V(6); PG8_BAR;
    }
    for (;;) {
        const bool has_next = S.next(ui + 1, nxt);
        const char* nA = has_next ? (const char*)g.A + (size_t)nxt.pm * tstep : cA; const char* nB = has_next ? (const char*)g.Bt + (size_t)nxt.pn * tstep : cB;
        for (int t = 0; t < nt; t += 2) {
            const bool last = (t == nt - 2);
            const char* a1 = cA + (size_t)(t + 1) * kstep;
            const char* a2 = last ? nA : cA + (size_t)(t + 2) * kstep; const char* b2 = last ? nB : cB + (size_t)(t + 2) * kstep;
            const char* a3 = a2 + kstep; const char* b3 = b2 + kstep;
            if (last && has_next) S.a_ready(nxt);
            if constexpr (SP2) {
            PG8_LDB(B0, 0, 0); PG8_LDB(B1, 0, 1); PG8_SCHED; PG8_LDA(At, 0, 0); PG8_STAGE(PG8_SA(1, 1), a1 + hstep, voffA);
            PG8_WAIT_V(8); PG8_WAIT_L(0); PG8_BAR; PG8_MMA(0, 0, At, B0); PG8_MMA(0, 1, At, B1); PG8_BAR; PG8_SCHED;
            PG8_LDA(At, 0, 1); PG8_STAGE(PG8_SB(0, 0), b2, voffB); PG8_STAGE(PG8_SB(0, 1), b2 + hstep, voffB); PG8_STAGE(PG8_SA(0, 0), a2, voffA);
            PG8_WAIT_V(8); PG8_WAIT_L(0); PG8_BAR; PG8_MMA(1, 0, At, B0); PG8_MMA(1, 1, At, B1); PG8_BAR; PG8_SCHED;
            PG8_LDB(B0, 1, 0); PG8_LDB(B1, 1, 1); PG8_SCHED; PG8_LDA(At, 1, 0); PG8_STAGE(PG8_SA(0, 1), a2 + hstep, voffA);
            PG8_WAIT_V(8); PG8_WAIT_L(0); PG8_BAR; PG8_MMA(0, 0, At, B0); PG8_MMA(0, 1, At, B1); PG8_BAR; PG8_SCHED;
            PG8_LDA(At, 1, 1); PG8_STAGE(PG8_SB(1, 0), b3, voffB); PG8_STAGE(PG8_SB(1, 1), b3 + hstep, voffB); PG8_STAGE(PG8_SA(1, 0), a3, voffA);
            PG8_WAIT_V(8); PG8_WAIT_L(0); PG8_BAR; PG8_MMA(1, 0, At, B0); PG8_MMA(1, 1, At, B1); PG8_BAR; PG8_SCHED;
            } else {
            PG8_LDB(B0, 0, 0); PG8_SCHED; PG8_LDA(At, 0, 0); PG8_STAGE(PG8_SA(1, 1), a1 + hstep, voffA);
            PG8_WAIT_L(8); PG8_BAR; PG8_WAIT_L(0); PG8_MMA(0, 0, At, B0); PG8_BAR; PG8_SCHED;
            PG8_LDB(B1, 0, 1); PG8_STAGE(PG8_SB(0, 0), b2, voffB);
            PG8_BAR; PG8_WAIT_L(0); PG8_MMA(0, 1, At, B1); PG8_BAR;
            PG8_LDA(At, 0, 1); PG8_STAGE(PG8_SA(0, 0), a2, voffA);
            PG8_BAR; PG8_WAIT_L(0); PG8_MMA(1, 0, At, B0); PG8_BAR; PG8_SCHED;
            PG8_STAGE(PG8_SB(0, 1), b2 + hstep, voffB);
            PG8_WAIT_V(6); PG8_BAR; PG8_MMA(1, 1, At, B1); PG8_BAR;
            PG8_LDB(B0, 1, 0); PG8_SCHED; PG8_LDA(At, 1, 0); PG8_STAGE(PG8_SA(0, 1), a2 + hstep, voffA);
            PG8_WAIT_L(8); PG8_BAR; PG8_WAIT_L(0); PG8_MMA(0, 0, At, B0); PG8_BAR; PG8_SCHED;
            PG8_LDB(B1, 1, 1); PG8_STAGE(PG8_SB(1, 0), b3, voffB);
            PG8_BAR; PG8_WAIT_L(0); PG8_MMA(0, 1, At, B1); PG8_BAR;
            PG8_LDA(At, 1, 1); PG8_STAGE(PG8_SA(1, 0), a3, voffA);
            PG8_BAR; PG8_WAIT_L(0); PG8_MMA(1, 0, At, B0); PG8_BAR; PG8_SCHED;
            PG8_STAGE(PG8_SB(1, 1), b3 + hstep, voffB);
            PG8_WAIT_V(6); PG8_BAR; PG8_MMA(1, 1, At, B1); PG8_BAR;
            }
        }
        if constexpr (ALIGN_EPI) { if (wr == 0) PG8_BAR; }
        if constexpr (!Epi::AFTER_DRAIN) { E(acc, cur, wr, wc, fr, fq); S.done(cur); }
        if (!has_next) break;
#pragma unroll
        for (int a = 0; a < 2; ++a)
#pragma unroll
            for (int b = 0; b < 2; ++b)
#pragma unroll
                for (int m = 0; m < 4; ++m)
#pragma unroll
                    for (int n = 0; n < 2; ++n) acc[a][b][m][n] = (f32x4){0.f, 0.f, 0.f, 0.f};
        cur = nxt; cA = nA; cB = nB; ++ui;
        if constexpr (ALIGN_EPI) { if (wr == 1) PG8_BAR; }
    }
    PG8_WAIT_V(0);
    if constexpr (!ALIGN_EPI) { if (wr == 0) PG8_BAR; }
    PG8_BAR;
    if constexpr (Epi::AFTER_DRAIN) { E.fused(acc, cur, wr, wc, fr, fq, lds, wid, lane); S.done(cur); }
#undef PG8_SA
#undef PG8_SB
#undef PG8_STAGE
#undef PG8_LDA
#undef PG8_LDB
#undef PG8_MMA
#undef PG8_WAIT_V
#undef PG8_WAIT_L
#undef PG8_BAR
#undef PG8_SCHED
}
}
constexpr int RING_OFF = 0, RING_BYTES = 131072;
constexpr int LDSCTL_OFF = RING_BYTES, MISC_OFF = LDSCTL_OFF + 320;
constexpr int LDS_BYTES = 147456;
constexpr int CW_BAR = 4096;

#define GAS __attribute__((address_space(1)))
#define LAS __attribute__((address_space(3)))
typedef unsigned short bf16;
typedef unsigned v4u __attribute__((ext_vector_type(4)));
typedef float f32x4 __attribute__((ext_vector_type(4)));
typedef short bf16x8 __attribute__((ext_vector_type(8)));
typedef GAS unsigned gu32;
#define RLX_AGENT __ATOMIC_RELAXED, __HIP_MEMORY_SCOPE_AGENT
#define LDS_WAIT() asm volatile("s_waitcnt lgkmcnt(0)" ::: "memory")
#define VM_WAIT() asm volatile("s_waitcnt vmcnt(0)" ::: "memory")
__device__ __forceinline__ unsigned f2bfu(float f) { unsigned u = __builtin_bit_cast(unsigned, f); return (u + 0x7fffu + ((u >> 16) & 1u)) >> 16; }
__device__ __forceinline__ bf16 f2bf(float f) { return (bf16)f2bfu(f); }
typedef float f32x2_t __attribute__((ext_vector_type(2))); typedef __bf16 bf16x2_t __attribute__((ext_vector_type(2)));
__device__ __forceinline__ unsigned pk2(float lo, float hi) { f32x2_t v = {lo, hi}; bf16x2_t b = __builtin_convertvector(v, bf16x2_t); return __builtin_bit_cast(unsigned, b); }
__device__ __forceinline__ float xor16_max(float v) { auto r = __builtin_amdgcn_permlane16_swap(__float_as_uint(v), __float_as_uint(v), false, false); return fmaxf(__uint_as_float(r[0]), __uint_as_float(r[1])); }
__device__ __forceinline__ float xor32_max(float v) { auto r = __builtin_amdgcn_permlane32_swap(__float_as_uint(v), __float_as_uint(v), false, false); return fmaxf(__uint_as_float(r[0]), __uint_as_float(r[1])); }
__device__ __forceinline__ float xor16_sum(float v) { auto r = __builtin_amdgcn_permlane16_swap(__float_as_uint(v), __float_as_uint(v), false, false); return __uint_as_float(r[0]) + __uint_as_float(r[1]); }
__device__ __forceinline__ float xor32_sum(float v) { auto r = __builtin_amdgcn_permlane32_swap(__float_as_uint(v), __float_as_uint(v), false, false); return __uint_as_float(r[0]) + __uint_as_float(r[1]); }
__device__ __forceinline__ float bf2f(bf16 v) { return __uint_as_float(((unsigned)v) << 16); }
__device__ __forceinline__ float silu_f(float v) { return v * __builtin_amdgcn_rcpf(1.f + __expf(-v)); }
__device__ __forceinline__ float sigmoid_f(float v) { return __builtin_amdgcn_rcpf(1.f + __expf(-v)); }
#define DPP_ADD_(v, ctrl) ((v) + __int_as_float(__builtin_amdgcn_update_dpp(0, __float_as_int(v), (ctrl), 0xF, 0xF, false)))
__device__ __forceinline__ float group8_sum(float v) {
    v = DPP_ADD_(v, 0xB1); v = DPP_ADD_(v, 0x4E); v = DPP_ADD_(v, 0x141); return v; }
__device__ __forceinline__ float wave_sum(float v) {
    v = group8_sum(v); v = DPP_ADD_(v, 0x140);
    { auto r = __builtin_amdgcn_permlane16_swap(__float_as_uint(v), __float_as_uint(v), false, false); v = __uint_as_float(r[0]) + __uint_as_float(r[1]); }
    { auto r = __builtin_amdgcn_permlane32_swap(__float_as_uint(v), __float_as_uint(v), false, false); v = __uint_as_float(r[0]) + __uint_as_float(r[1]); }
    return v;
}
__device__ __forceinline__ float rdlane(float v, int i) { return __int_as_float(__builtin_amdgcn_readlane(__float_as_int(v), i)); }


#ifndef PROBE_T
#define PROBE_T 0
#endif
#define TS_LDS(F) ((volatile LAS unsigned long long*)((F).lds + LDSCTL_OFF + 128))
#define TS_START(F, id) do { if (PROBE_T == (id) && blockIdx.x == 0 && (F).tid == 0) TS_LDS(F)[1] = __builtin_amdgcn_s_memtime(); } while (0)
#define TS_STOP(F, id)  do { if (PROBE_T == (id) && blockIdx.x == 0 && (F).tid == 0) TS_LDS(F)[0] += __builtin_amdgcn_s_memtime() - TS_LDS(F)[1]; } while (0)
#define XB_TMO      128
#define XB_XCNT(j)  (256  + 64 * (j))
#define XB_XSUB(j)  (1280 + 64 * (j))
#define XB_XGEN(j)  (2304 + 64 * (j))
#define XB_TOP      3328
#define XB_TOPGEN   3392
#define XCD_BAR_WORDS 3456
#define XB_SPIN_CAP (1u << 18)

__device__ __forceinline__ unsigned xb_ld(unsigned* p)              { return __hip_atomic_load(p, __ATOMIC_RELAXED, __HIP_MEMORY_SCOPE_AGENT); }
__device__ __forceinline__ unsigned xb_add(unsigned* p, unsigned v) { return __hip_atomic_fetch_add(p, v, __ATOMIC_RELAXED, __HIP_MEMORY_SCOPE_AGENT); }
__device__ __forceinline__ unsigned xb_xcc_id() { return (unsigned)__builtin_amdgcn_s_getreg((3 << 11) | 20) & 0xFu; }
#define XB_SPIN(cond, bar) do { unsigned _sp = 0; while (cond) { __builtin_amdgcn_s_sleep(1); \
    if ((++_sp & 255u) == 0u) { if (xb_ld(&(bar)[XB_TMO])) break; if (_sp > XB_SPIN_CAP) { atomicAdd(&(bar)[XB_TMO], 1u); break; } } } } while (0)

struct XcdBarrier {
    unsigned* bar; unsigned x;
    volatile LAS unsigned* st;
};

__device__ __forceinline__ XcdBarrier xcd_barrier_post(unsigned* bar, volatile LAS unsigned* st) {
    XcdBarrier b; b.bar = bar; b.x = xb_xcc_id(); b.st = st;
    if (threadIdx.x == 0) (void)xb_add(&bar[XB_XCNT(b.x)], 1u);
    return b;
}
__device__ __forceinline__ void xcd_barrier_complete(unsigned* bar, unsigned x, unsigned& nloc, unsigned& nx) {
    const unsigned G = gridDim.x * gridDim.y * gridDim.z;
    unsigned sum, cnt, mine, sp = 0u;
    for (;;) {
        sum = 0u; cnt = 0u; mine = 0u;
#pragma unroll
        for (unsigned j = 0; j < 16; ++j) { const unsigned c = xb_ld(&bar[XB_XCNT(j)]); sum += c; cnt += (c > 0u) ? 1u : 0u; mine = (j == x) ? c : mine; }
        if (sum == G) break;
        __builtin_amdgcn_s_sleep(1);
        if ((++sp & 255u) == 0u) { if (xb_ld(&bar[XB_TMO])) break; if (sp > XB_SPIN_CAP) { atomicAdd(&bar[XB_TMO], 1u); break; } }
    }
    nloc = mine > 0u ? mine : 1u; nx = cnt > 0u ? cnt : 1u;
}

__device__ __forceinline__ void xcd_barrier(const XcdBarrier& b) {
    asm volatile("s_waitcnt vmcnt(0)" ::: "memory");
    __syncthreads();
    if (threadIdx.x == 0) {
        unsigned* bar = b.bar;
        __builtin_amdgcn_s_waitcnt(0);
        unsigned nloc = b.st[0], nx = b.st[1];
        if (nloc == 0u) { xcd_barrier_complete(bar, b.x, nloc, nx); b.st[0] = nloc; b.st[1] = nx; }
        const unsigned old = xb_add(&bar[XB_XSUB(b.x)], 1u);
        const unsigned gen = old / nloc;
        if (old + 1u == (gen + 1u) * nloc) {
            __builtin_amdgcn_fence(__ATOMIC_RELEASE, "agent");
            asm volatile("s_waitcnt vmcnt(0)" ::: "memory");
            const unsigned og = xb_add(&bar[XB_TOP], 1u);
            const unsigned tg = og / nx;
            if (og + 1u == (tg + 1u) * nx) xb_add(&bar[XB_TOPGEN], 1u);
            else XB_SPIN(xb_ld(&bar[XB_TOPGEN]) == tg, bar);
            __builtin_amdgcn_fence(__ATOMIC_ACQUIRE, "agent");
            xb_add(&bar[XB_XGEN(b.x)], 1u);
            asm volatile("s_waitcnt vmcnt(0)" ::: "memory");
        } else {
            XB_SPIN(xb_ld(&bar[XB_XGEN(b.x)]) == gen, bar);
            __builtin_amdgcn_fence(__ATOMIC_ACQUIRE, "agent");
            asm volatile("s_waitcnt vmcnt(0)" ::: "memory");
        }
    }
    __syncthreads();
}

struct Ctx {
    LAS unsigned char* lds; int tid, lane, wave, vcu, G, gw, NGW;
    const float *x, *c, *ctx, *c_ctx, *w_mod, *b_mod, *g_pre, *g_post, *w_in, *w_out, *hgrn_lb, *hgrn_gn, *gate_b, *mlstm_gn, *na_rpb;
    float* out; bf16 *wt_in, *wt_out, *hxy, *P; float *mod, *gates, *ctx1, *stm, *sth, *rope; bf16 *otm, *oth, *UX;
};

__device__ __forceinline__ void transpose_item(const float* W, int N, int Nnew, bool remap, bf16* WT, LAS float* scr, int item, int lane) {
    const int nblk = Nnew / 32, kb = item / nblk, nb = item % nblk, k0 = 64 * kb, n0 = 32 * nb;
    const int rg = lane >> 3, c4 = (lane & 7) * 4, nn = n0 + c4;
    int no = nn; if (remap) no = nn < 3200 ? nn : (nn < 4736 ? nn + 16 : (nn < 4752 ? 3200 + nn - 4736 : -1));
    f32x4 v[8];
#pragma unroll
    for (int j = 0; j < 8; ++j) v[j] = no >= 0 ? *(const f32x4*)(W + (size_t)(k0 + 8 * j + rg) * N + no) : (f32x4){0.f, 0.f, 0.f, 0.f};
#pragma unroll
    for (int j = 0; j < 8; ++j) { LAS float* d = scr + (8 * j + rg) * 33 + c4; d[0] = v[j][0]; d[1] = v[j][1]; d[2] = v[j][2]; d[3] = v[j][3]; }
    LDS_WAIT(); asm volatile("" ::: "memory");
    const int c = lane & 7;
#pragma unroll
    for (int j = 0; j < 4; ++j) { const int n = (lane >> 3) + 8 * j; const LAS float* s = scr + (8 * c) * 33 + n;
        v4u o; o.x = pk2(s[0 * 33], s[1 * 33]); o.y = pk2(s[2 * 33], s[3 * 33]); o.z = pk2(s[4 * 33], s[5 * 33]); o.w = pk2(s[6 * 33], s[7 * 33]);
        *(GAS v4u*)(WT + (size_t)(n0 + n) * 1024 + k0 + 8 * c) = o; }
    LDS_WAIT(); asm volatile("" ::: "memory");
}
__device__ __forceinline__ void phase_p0(const Ctx& F) {
    if (F.vcu < 96) {
        LAS float* tab = (LAS float*)(F.lds);
        LAS float* part = (LAS float*)(F.lds + 36864);
        for (int i = F.tid; i < 9 * 1024; i += 512) { const int r = i >> 10, k = i & 1023; const float v = r < 8 ? F.c[r * 1024 + k] : F.c_ctx[k]; tab[i] = silu_f(v); }
        __syncthreads();
        for (int it = F.vcu; it < 96; it += F.G) {
            const int l = it / 48, jb = it % 48, col = jb * 64 + F.lane;
            float acc[9];
#pragma unroll
            for (int r = 0; r < 9; ++r) acc[r] = 0.f;
            const float* wp = F.w_mod + ((size_t)l * 1024 + F.wave * 128) * 3072 + col;
            for (int kb = 0; kb < 128; kb += 32) {
                float wv[32];
#pragma unroll
                for (int k = 0; k < 32; ++k) wv[k] = wp[(size_t)(kb + k) * 3072];
#pragma unroll
                for (int k = 0; k < 32; ++k)
#pragma unroll
                    for (int r = 0; r < 9; ++r) acc[r] += tab[r * 1024 + F.wave * 128 + kb + k] * wv[k]; }
#pragma unroll
            for (int r = 0; r < 9; ++r) part[(F.wave * 9 + r) * 64 + F.lane] = acc[r];
            __syncthreads();
            for (int i = F.tid; i < 9 * 64; i += 512) { const int r = i >> 6, j = i & 63; float s = 0.f;
#pragma unroll
                for (int w = 0; w < 8; ++w) s += part[(w * 9 + r) * 64 + j];
                F.mod[((size_t)l * 9 + r) * 3072 + jb * 64 + j] = s + F.b_mod[l * 3072 + jb * 64 + j]; }
            __syncthreads();
        }
    }
    if (F.vcu == 96 % F.G) for (int i = F.tid; i < 64 * 24; i += 512) { const int pos = i / 24, f = i % 24; const float ang = (float)pos * expf(-(float)(2 * f) * (1.f / 48.f) * 9.210340371976184f); F.rope[2 * i] = cosf(ang); F.rope[2 * i + 1] = sinf(ang); }
    __syncthreads();
    LAS float* scr = (LAS float*)(F.lds + F.wave * 16384);
    constexpr int I_IN = 16 * (NPAD / 32);
    const int gwr = F.NGW - 1 - F.gw;
    for (int it = gwr; it < I_IN; it += F.NGW) transpose_item(F.w_in, PIN, NPAD, true, F.wt_in, scr, it, F.lane);
}
__device__ __forceinline__ void phase_p1_transposes(const Ctx& F) {
    LAS float* scr = (LAS float*)(F.lds + F.wave * 16384);
    constexpr int I_IN = 16 * (NPAD / 32), I_OUT = 16 * 32;
    for (int it = F.gw; it < I_IN + 2 * I_OUT; it += F.NGW) {
        if (it < I_OUT) transpose_item(F.w_out, 1024, 1024, false, F.wt_out, scr, it, F.lane);
        else if (it < I_OUT + I_IN) transpose_item(F.w_in + (size_t)1024 * PIN, PIN, NPAD, true, F.wt_in + (size_t)NPAD * 1024, scr, it - I_OUT, F.lane);
        else transpose_item(F.w_out + (size_t)1024 * 1024, 1024, 1024, false, F.wt_out + (size_t)1024 * 1024, scr, it - I_OUT - I_IN, F.lane);
    }
}

struct RowPar { float4 g[4], a[4], b[4]; };
__device__ __forceinline__ void load_par(RowPar& p, const float* g, const float* a, const float* b, int lane) {
#pragma unroll
    for (int j = 0; j < 4; ++j) { const int d = 4 * (lane + 64 * j); p.g[j] = *(const float4*)(g + d); p.a[j] = *(const float4*)(a + d); p.b[j] = *(const float4*)(b + d); }
}
__device__ __forceinline__ void prenorm_store(const float4 (&v)[4], float ss, const RowPar& p, bf16* dst, int lane) {
    const float rinv = __builtin_amdgcn_rsqf(ss * (1.f / 1024.f) + EPS);
#pragma unroll
    for (int j = 0; j < 4; ++j) {
        const int d = 4 * (lane + 64 * j);
        const float o0 = v[j].x * rinv * p.g[j].x * (1.f + p.a[j].x) + p.b[j].x, o1 = v[j].y * rinv * p.g[j].y * (1.f + p.a[j].y) + p.b[j].y;
        const float o2 = v[j].z * rinv * p.g[j].z * (1.f + p.a[j].z) + p.b[j].z, o3 = v[j].w * rinv * p.g[j].w * (1.f + p.a[j].w) + p.b[j].w;
        uint2 w; w.x = pk2(o0, o1); w.y = pk2(o2, o3);
        *(uint2*)(dst + d) = w;
    }
}
__device__ __forceinline__ void phase_prenorm0(const Ctx& F) {
    auto rowsrc = [&](int m) -> const float* { return m < MX ? F.x + (size_t)m * 1024 : F.ctx + (size_t)(m - MX) * 1024; };
    const int nrow = (M + F.NGW - 1) / F.NGW, m0 = F.gw * nrow, m1 = min(m0 + nrow, M);
    if (m0 >= m1) return;
    float4 nv[4];
#pragma unroll
    for (int j = 0; j < 4; ++j) nv[j] = ((const float4*)rowsrc(m0))[F.lane + 64 * j];
    RowPar p; int rcur = -1;
    for (int m = m0; m < m1; ++m) {
        const int r = m < MX ? m / S : 8;
        if (r != rcur) { const float* mod_r = F.mod + (size_t)r * 3072; load_par(p, F.g_pre, mod_r + 1024, mod_r, F.lane); rcur = r; }
        float4 v[4];
#pragma unroll
        for (int j = 0; j < 4; ++j) v[j] = nv[j];
        if (m + 1 < m1) {
#pragma unroll
            for (int j = 0; j < 4; ++j) nv[j] = ((const float4*)rowsrc(m + 1))[F.lane + 64 * j]; }
        float ss = 0.f;
#pragma unroll
        for (int j = 0; j < 4; ++j) ss += v[j].x * v[j].x + v[j].y * v[j].y + v[j].z * v[j].z + v[j].w * v[j].w;
        ss = wave_sum(ss);
        prenorm_store(v, ss, p, F.hxy + (size_t)m * 1024, F.lane);
    }
}
__device__ __forceinline__ void phase_post(const Ctx& F, int l) {
    const int Ml = l == 0 ? M : MX;
    const float* mod_l = F.mod + (size_t)l * 9 * 3072; const float* g_post_l = F.g_post + l * 1024;
    auto rowsrc = [&](int m) -> const float* { return m < MX ? (l == 0 ? F.x : F.out) + (size_t)m * 1024 : F.ctx + (size_t)(m - MX) * 1024; };
    const int nrow = (Ml + F.NGW - 1) / F.NGW, m0 = F.gw * nrow, m1 = min(m0 + nrow, Ml);
    if (m0 >= m1) return;
    float4 nx[4]; uint2 nu[4];
#pragma unroll
    for (int j = 0; j < 4; ++j) { nx[j] = ((const float4*)rowsrc(m0))[F.lane + 64 * j]; nu[j] = ((const uint2*)(F.UX + (size_t)m0 * 1024))[F.lane + 64 * j]; }
    float4 pg[4], pt[4]; RowPar p2; int rcur = -1;
#pragma unroll
    for (int j = 0; j < 4; ++j) pg[j] = *(const float4*)(g_post_l + 4 * (F.lane + 64 * j));
    for (int m = m0; m < m1; ++m) {
        float* dst; int r;
        if (m < MX) { dst = F.out + (size_t)m * 1024; r = m / S; } else { dst = F.ctx1 + (size_t)(m - MX) * 1024; r = 8; }
        if (r != rcur) {
#pragma unroll
            for (int j = 0; j < 4; ++j) pt[j] = *(const float4*)(mod_l + r * 3072 + 2048 + 4 * (F.lane + 64 * j));
            if (l == 0) load_par(p2, F.g_pre + 1024, F.mod + (size_t)(9 + r) * 3072 + 1024, F.mod + (size_t)(9 + r) * 3072, F.lane);
            rcur = r; }
        float4 xr[4], u[4]; float ss = 0.f;
#pragma unroll
        for (int j = 0; j < 4; ++j) { xr[j] = nx[j]; const uint2 w = nu[j];
            u[j].x = __uint_as_float(w.x << 16); u[j].y = __uint_as_float(w.x & 0xffff0000u); u[j].z = __uint_as_float(w.y << 16); u[j].w = __uint_as_float(w.y & 0xffff0000u);
            ss += u[j].x * u[j].x + u[j].y * u[j].y + u[j].z * u[j].z + u[j].w * u[j].w; }
        if (m + 1 < m1) {
#pragma unroll
            for (int j = 0; j < 4; ++j) { nx[j] = ((const float4*)rowsrc(m + 1))[F.lane + 64 * j]; nu[j] = ((const uint2*)(F.UX + (size_t)(m + 1) * 1024))[F.lane + 64 * j]; } }
        ss = wave_sum(ss);
        const float rinv = __builtin_amdgcn_rsqf(ss * (1.f / 1024.f) + EPS);
        float ss2 = 0.f;
#pragma unroll
        for (int j = 0; j < 4; ++j) {
            const int d = 4 * (F.lane + 64 * j);
            const float4 g = pg[j], t = pt[j], xv = xr[j];
            float4 o; o.x = xv.x + t.x * (u[j].x * rinv * g.x); o.y = xv.y + t.y * (u[j].y * rinv * g.y); o.z = xv.z + t.z * (u[j].z * rinv * g.z); o.w = xv.w + t.w * (u[j].w * rinv * g.w);
            *(float4*)(dst + d) = o; u[j] = o; ss2 += o.x * o.x + o.y * o.y + o.z * o.z + o.w * o.w;
        }
        if (l == 0) { ss2 = wave_sum(ss2); prenorm_store(u, ss2, p2, F.hxy + (size_t)m * 1024, F.lane); }
    }
}


typedef short s16x4 __attribute__((ext_vector_type(4)));
typedef short v4i16_t __attribute__((ext_vector_type(4)));
__device__ __forceinline__ s16x4 tr_read(const LAS bf16* p) { return __builtin_bit_cast(s16x4, __builtin_amdgcn_ds_read_tr16_b64_v4i16((LAS v4i16_t*)p)); }
__device__ __forceinline__ bf16x8 tr_frag(const LAS bf16* T, int stride, int rowA, int rowB, int col0, int lane) {
    const int q = (lane >> 2) & 3, p = lane & 3;
    const s16x4 lo = tr_read(T + (rowA + q) * stride + col0 + 4 * p), hi = tr_read(T + (rowB + q) * stride + col0 + 4 * p);
    return (bf16x8){lo[0], lo[1], lo[2], lo[3], hi[0], hi[1], hi[2], hi[3]};
}
__device__ __forceinline__ bf16x8 rm_frag(const LAS bf16* T, int stride, int row, int k0) { return *(const LAS bf16x8*)(T + row * stride + k0); }
__device__ __forceinline__ f32x4 mfma16(bf16x8 a, bf16x8 b, f32x4 c) { return __builtin_amdgcn_mfma_f32_16x16x32_bf16(a, b, c, 0, 0, 0); }
typedef unsigned v2u __attribute__((ext_vector_type(2)));
typedef float f32x2 __attribute__((ext_vector_type(2)));
__device__ __forceinline__ void unpack8(const v4u w, float* f) {
    f[0] = __uint_as_float(w.x << 16); f[1] = __uint_as_float(w.x & 0xffff0000u); f[2] = __uint_as_float(w.y << 16); f[3] = __uint_as_float(w.y & 0xffff0000u);
    f[4] = __uint_as_float(w.z << 16); f[5] = __uint_as_float(w.z & 0xffff0000u); f[6] = __uint_as_float(w.w << 16); f[7] = __uint_as_float(w.w & 0xffff0000u);
}
__device__ __forceinline__ v4u pack8(const float* f) { v4u w; w.x = pk2(f[0], f[1]); w.y = pk2(f[2], f[3]); w.z = pk2(f[4], f[5]); w.w = pk2(f[6], f[7]); return w; }

__device__ __forceinline__ float wave_scan_incl(float x) {
    int v = __float_as_int(x);
#define DPP_ADD(ctrl, rmask) v = __float_as_int(__int_as_float(v) + __int_as_float(__builtin_amdgcn_update_dpp(0, v, ctrl, rmask, 0xF, false)))
    DPP_ADD(0x111, 0xF); DPP_ADD(0x112, 0xF); DPP_ADD(0x114, 0xF); DPP_ADD(0x118, 0xF); DPP_ADD(0x142, 0xA); DPP_ADD(0x143, 0xC);
#undef DPP_ADD
    return __int_as_float(v);
}
#define LDS_FENCE() asm volatile("" ::: "memory")
namespace ml {
constexpr int QSTR = 104, VSTR = 120;
constexpr int OFF_QS = 0, OFF_KS = OFF_QS + 64 * QSTR * 2, OFF_VS = OFF_KS + 64 * QSTR * 2, OFF_CT = OFF_VS + 64 * VSTR * 2;
constexpr int OFF_HT = OFF_CT + 2 * 112 * QSTR * 2, OFF_DEN = OFF_HT + 64 * 100 * 4, OFF_ROPE = OFF_DEN + 256, OFF_END = OFF_ROPE + 64 * 24 * 8;
static_assert(OFF_END <= RING_BYTES && 6 * 7 * 64 * 16 <= OFF_HT, "mlstm LDS");
constexpr int ST_FLOATS = 96 * 112 + 16;
}
constexpr int NSEG = 4, SEGTOK = S / NSEG, SEGCH = SEGTOK / 64;
struct MlJob { int b, h, isctx, t0, nchunk; };

__device__ __forceinline__ void mlstm_dir(const Ctx& F, int l, const MlJob jb, int dir, int fold_r, int emit_slot, int mode, bf16* otmp, float* ST) {
    using namespace ml;
    int tid_ = F.tid; asm volatile("" : "+v"(tid_));
    const int w = __builtin_amdgcn_readfirstlane(tid_ >> 6);
    const bool tsel = (mode != 0) && !jb.isctx && l == 0;
    if (tsel) TS_START(F, 10);
    LAS bf16* QS = (LAS bf16*)(F.lds + OFF_QS); LAS bf16* KS = (LAS bf16*)(F.lds + OFF_KS); LAS bf16* VS = (LAS bf16*)(F.lds + OFF_VS);
    LAS bf16* CT0 = (LAS bf16*)(F.lds + OFF_CT); LAS float* HT = (LAS float*)(F.lds + OFF_HT); LAS float* DEN = (LAS float*)(F.lds + OFF_DEN);
    const LAS f32x2* ROPE = (const LAS f32x2*)(F.lds + OFF_ROPE);
    const int rowbase = jb.isctx ? MX + jb.b * CTX : jb.b * S;
    const int h = jb.h; const bf16* P = F.P;
    float* STd = ST + (size_t)(((jb.b * 4 + h) * 2 + dir) * 8) * ST_FLOATS;
    f32x4 Cst[7];
#pragma unroll
    for (int et = 0; et < 7; ++et) Cst[et] = (f32x4){0.f, 0.f, 0.f, 0.f};
    if (fold_r >= 0) {
        LAS f32x4* FOLD = (LAS f32x4*)(F.lds + OFF_QS);
        float wk[8];
        { float bs[8]; bs[0] = 0.f;
#pragma unroll
          for (int k = 1; k < NSEG; ++k) bs[k] = STd[(size_t)k * ST_FLOATS + 96 * 112];
          float run = 1.f;
#pragma unroll
          for (int k = NSEG - 1; k >= 0; --k) { wk[k] = (k <= fold_r) ? run : 0.f; run = (k >= 1 && k <= fold_r) ? run * __expf(bs[k]) : run; } }
#pragma unroll 2
        for (int p = tid_; p < 6 * 7 * 64; p += 512) {
            f32x4 v[8];
#pragma unroll
            for (int k = 0; k < NSEG; ++k) v[k] = *(const f32x4*)(STd + (size_t)k * ST_FLOATS + 4 * p);
            f32x4 acc = v[0] * wk[0];
#pragma unroll
            for (int k = 1; k < NSEG; ++k) acc += v[k] * wk[k];
            FOLD[p] = acc;
        }
        __syncthreads();
        if (w < 6) {
#pragma unroll
            for (int et = 0; et < 7; ++et) Cst[et] = FOLD[(w * 7 + et) * 64 + (tid_ & 63)];
        }
        __syncthreads();
    }
    asm volatile("" : "+v"(tid_));
    const int tid = tid_, lane = tid & 63, g = lane >> 4, c = lane & 15;
    float Btot = 0.f;
    for (int i = tid; i < 64 * 16; i += 512) { const int s = i >> 4, e = 96 + (i & 15); VS[s * VSTR + e] = (e == 96) ? (bf16)0x3F80 : (bf16)0; }
    if (w < 6) {
#pragma unroll
        for (int et = 0; et < 7; ++et) { v2u v; v.x = pk2(Cst[et][0], Cst[et][1]); v.y = pk2(Cst[et][2], Cst[et][3]); *(LAS v2u*)(CT0 + (16 * et + c) * QSTR + 16 * w + 4 * g) = v; }
    }
    const bool hasqk = tid < 384; const int qk_tok = tid / 6, qk_pi = tid % 6, qk_part = qk_pi / 3, qk_pp = qk_pi % 3, qk_d0 = 48 * qk_part + 8 * qk_pp;
    const int v1_tok = tid / 12, v1_pc = tid % 12; const bool hasv2 = tid < 256; const int v2_tok = (512 + tid) / 12, v2_pc = (512 + tid) % 12;
    struct LoadSet { v4u q0, q1, k0, k1, v1, v2; float ig, lf; };
    LoadSet LA;
    v2u ft[3], fo[3], fz[3];
    const int fi_i = tid >> 3, fi_e0 = 12 * (tid & 7);
#pragma unroll
    for (int q4 = 0; q4 < 3; ++q4) { ft[q4] = (v2u){0u, 0u}; fo[q4] = (v2u){0u, 0u}; fz[q4] = (v2u){0u, 0u}; }
    LA.q0 = LA.q1 = LA.k0 = LA.k1 = LA.v1 = LA.v2 = (v4u){0u, 0u, 0u, 0u}; LA.ig = LA.lf = 0.f;
    auto tok_of = [&](int ci, int i) -> int { return dir == 0 ? jb.t0 + 64 * ci + i : jb.t0 + 64 * (jb.nchunk - 1 - ci) + (63 - i); };
    auto issue_loads = [&](LoadSet& L, int ci) {
        if (hasqk) { const bf16* pr = P + (size_t)(rowbase + tok_of(ci, qk_tok)) * PLD + h * 96 + qk_d0;
            if (mode != 0) { L.q0 = *(const v4u*)(pr + B_Q); L.q1 = *(const v4u*)(pr + B_Q + 24); }
            L.k0 = *(const v4u*)(pr + B_K); L.k1 = *(const v4u*)(pr + B_K + 24); }
        L.v1 = *(const v4u*)(P + (size_t)(rowbase + tok_of(ci, v1_tok)) * PLD + B_V + h * 96 + 8 * v1_pc);
        if (hasv2) L.v2 = *(const v4u*)(P + (size_t)(rowbase + tok_of(ci, v2_tok)) * PLD + B_V + h * 96 + 8 * v2_pc);
        const float* gp = F.gates + (size_t)(rowbase + tok_of(ci, lane)) * 16 + dir * 4 + h; L.ig = gp[0]; L.lf = gp[8];
    };
    auto issue_fin = [&](int ci) {
        const int m = rowbase + tok_of(ci, fi_i); const bf16* tp = otmp + (size_t)m * 384 + h * 96 + fi_e0; const bf16* pr = P + (size_t)m * PLD + h * 96 + fi_e0;
#pragma unroll
        for (int q4 = 0; q4 < 3; ++q4) { ft[q4] = *(const v2u*)(tp + 4 * q4); fo[q4] = *(const v2u*)(pr + B_O + 4 * q4); fz[q4] = *(const v2u*)(pr + B_Z + 4 * q4); }
    };
    auto finalize = [&](int ci) {
            const int i = tid >> 3, sub = tid & 7, e0 = 12 * sub; const int m = rowbase + tok_of(ci, i);
            float hv[12]; const float rden = __builtin_amdgcn_rcpf(fmaxf(fabsf(DEN[i]), 1.f));
#pragma unroll
            for (int q4 = 0; q4 < 3; ++q4) { const f32x4 v = *(const LAS f32x4*)(HT + i * 100 + e0 + 4 * q4); hv[4 * q4] = v[0] * rden; hv[4 * q4 + 1] = v[1] * rden; hv[4 * q4 + 2] = v[2] * rden; hv[4 * q4 + 3] = v[3] * rden; }
            bf16* tp = otmp + (size_t)m * 384 + h * 96 + e0;
            if (mode == 1) {
#pragma unroll
                for (int q4 = 0; q4 < 3; ++q4) { v2u v; v.x = pk2(hv[4 * q4], hv[4 * q4 + 1]); v.y = pk2(hv[4 * q4 + 2], hv[4 * q4 + 3]); *(v2u*)(tp + 4 * q4) = v; }
            } else {
                float ss = 0.f;
#pragma unroll
                for (int q4 = 0; q4 < 3; ++q4) { const v2u v = ft[q4];
                    hv[4 * q4] += __uint_as_float(v.x << 16); hv[4 * q4 + 1] += __uint_as_float(v.x & 0xffff0000u); hv[4 * q4 + 2] += __uint_as_float(v.y << 16); hv[4 * q4 + 3] += __uint_as_float(v.y & 0xffff0000u); }
#pragma unroll
                for (int e = 0; e < 12; ++e) ss += hv[e] * hv[e];
                ss = group8_sum(ss);
                const float rinv = __builtin_amdgcn_rsqf(ss * (1.f / 96.f) + EPS);
                bf16* yp = F.hxy + (size_t)m * 1024 + 256 + h * 96 + e0; const float* gnv = F.mlstm_gn + l * 384 + h * 96 + e0;
#pragma unroll
                for (int q4 = 0; q4 < 3; ++q4) { const v2u ov = fo[q4], zv = fz[q4];
                    const float og[4] = {__uint_as_float(ov.x << 16), __uint_as_float(ov.x & 0xffff0000u), __uint_as_float(ov.y << 16), __uint_as_float(ov.y & 0xffff0000u)};
                    const float zg[4] = {__uint_as_float(zv.x << 16), __uint_as_float(zv.x & 0xffff0000u), __uint_as_float(zv.y << 16), __uint_as_float(zv.y & 0xffff0000u)};
                    float o[4];
#pragma unroll
                    for (int e = 0; e < 4; ++e) o[e] = og[e] * (hv[4 * q4 + e] * rinv * gnv[4 * q4 + e]) * zg[e];
                    v2u v; v.x = pk2(o[0], o[1]); v.y = pk2(o[2], o[3]); *(v2u*)(yp + 4 * q4) = v; }
            }
    };
    struct Packed { v4u k0, k1, q0, q1, v1, v2; float bL, ebL; };
    auto stage_math = [&](LoadSet& L, int ci, Packed& K) {
        const float bcs = wave_scan_incl(L.lf);
        const float qsc = __expf(bcs), ksc = __expf(L.ig - bcs);
        K.bL = rdlane(bcs, 63); K.ebL = __expf(K.bL);
        if (hasqk) {
            const float ks_t = __shfl(ksc, qk_tok), qs_t = __shfl(qsc, qk_tok);
            float cs[8], sn[8];
            if (!jb.isctx) { const int t = tok_of(ci, qk_tok); const int pos = qk_part ? (t & 63) : (t >> 6);
#pragma unroll
                for (int e = 0; e < 8; ++e) { const f32x2 v = ROPE[pos * 24 + 8 * qk_pp + e]; cs[e] = v[0]; sn[e] = v[1]; } }
            else {
#pragma unroll
                for (int e = 0; e < 8; ++e) { cs[e] = 1.f; sn[e] = 0.f; } }
            float a[8], b2[8], o0[8], o1[8];
            unpack8(L.k0, a); unpack8(L.k1, b2);
#pragma unroll
            for (int e = 0; e < 8; ++e) { o0[e] = (a[e] * cs[e] - b2[e] * sn[e]) * ks_t; o1[e] = (b2[e] * cs[e] + a[e] * sn[e]) * ks_t; }
            K.k0 = pack8(o0); K.k1 = pack8(o1);
            if (mode != 0) {
                unpack8(L.q0, a); unpack8(L.q1, b2);
#pragma unroll
                for (int e = 0; e < 8; ++e) { o0[e] = (a[e] * cs[e] - b2[e] * sn[e]) * qs_t; o1[e] = (b2[e] * cs[e] + a[e] * sn[e]) * qs_t; }
                K.q0 = pack8(o0); K.q1 = pack8(o1);
            }
        } else { (void)__shfl(ksc, 0); (void)__shfl(qsc, 0); }
        K.v1 = L.v1; K.v2 = L.v2;
    };
    auto stage_write = [&](const Packed& K) {
        if (hasqk) {
            *(LAS v4u*)(KS + qk_tok * QSTR + qk_d0) = K.k0; *(LAS v4u*)(KS + qk_tok * QSTR + qk_d0 + 24) = K.k1;
            if (mode != 0) { *(LAS v4u*)(QS + qk_tok * QSTR + qk_d0) = K.q0; *(LAS v4u*)(QS + qk_tok * QSTR + qk_d0 + 24) = K.q1; }
        }
        *(LAS v4u*)(VS + v1_tok * VSTR + 8 * v1_pc) = K.v1;
        if (hasv2) *(LAS v4u*)(VS + v2_tok * VSTR + 8 * v2_pc) = K.v2;
    };
    Packed PK; PK.k0 = PK.k1 = PK.q0 = PK.q1 = PK.v1 = PK.v2 = (v4u){0u, 0u, 0u, 0u}; PK.bL = 0.f; PK.ebL = 1.f;
    issue_loads(LA, 0);
    __syncthreads();
    stage_math(LA, 0, PK); stage_write(PK);
    if (jb.nchunk > 1) issue_loads(LA, 1);
    float bL = PK.bL, ebL = PK.ebL;
    __syncthreads();
    if (tsel) TS_STOP(F, 10);
    auto chunk_step = [&](LoadSet& Lnext, int ci) {
        LAS bf16* CTc = CT0 + (ci & 1) * 112 * QSTR; LAS bf16* CTn = CT0 + ((ci + 1) & 1) * 112 * QSTR;
        if (mode == 2) issue_fin(ci);
        if (ci + 1 < jb.nchunk) { stage_math(Lnext, ci + 1, PK); if (ci + 2 < jb.nchunk) issue_loads(Lnext, ci + 2); }
        if (mode != 0) {
            const int tt = w & 3, jh = w >> 2;
            bf16x8 qf[3], kf[4][3];
#pragma unroll
            for (int ks = 0; ks < 3; ++ks) qf[ks] = rm_frag(QS, QSTR, 16 * tt + c, 32 * ks + 8 * g);
#pragma unroll
            for (int ss = 0; ss < 4; ++ss) if (ss <= tt) {
#pragma unroll
                for (int ks = 0; ks < 3; ++ks) kf[ss][ks] = rm_frag(KS, QSTR, 16 * ss + c, 32 * ks + 8 * g); }
            LDS_FENCE();
            f32x4 st[4];
#pragma unroll
            for (int ss = 0; ss < 4; ++ss) { st[ss] = (f32x4){0.f, 0.f, 0.f, 0.f};
                if (ss <= tt) {
#pragma unroll
                    for (int ks = 0; ks < 3; ++ks) st[ss] = mfma16(kf[ss][ks], qf[ks], st[ss]);
                    if (ss == tt) {
#pragma unroll
                        for (int r = 0; r < 4; ++r) if (4 * g + r > c) st[ss][r] = 0.f; }
                } }
            bf16x8 pf[2];
#pragma unroll
            for (int kk = 0; kk < 2; ++kk) { const unsigned u0 = pk2(st[2 * kk][0], st[2 * kk][1]), u1 = pk2(st[2 * kk][2], st[2 * kk][3]), u2 = pk2(st[2 * kk + 1][0], st[2 * kk + 1][1]), u3 = pk2(st[2 * kk + 1][2], st[2 * kk + 1][3]);
                pf[kk] = __builtin_bit_cast(bf16x8, (v4u){u0, u1, u2, u3}); }
#pragma unroll
            for (int eb = 0; eb < 4; eb += 2) {
                bf16x8 vf[2][2], cf[2][3];
#pragma unroll
                for (int e2 = 0; e2 < 2; ++e2) { const int et = 4 * jh + eb + e2;
                    if (et < 7) {
#pragma unroll
                        for (int kk = 0; kk < 2; ++kk) if (2 * kk <= tt) vf[e2][kk] = tr_frag(VS, VSTR, 32 * kk + 4 * g, 32 * kk + 16 + 4 * g, 16 * et, lane);
#pragma unroll
                        for (int ks = 0; ks < 3; ++ks) cf[e2][ks] = rm_frag(CTc, QSTR, 16 * et + c, 32 * ks + 8 * g); } }
                LDS_FENCE();
#pragma unroll
                for (int e2 = 0; e2 < 2; ++e2) { const int et = 4 * jh + eb + e2;
                    if (et < 7) {
                        f32x4 acc = (f32x4){0.f, 0.f, 0.f, 0.f};
#pragma unroll
                        for (int kk = 0; kk < 2; ++kk) if (2 * kk <= tt) acc = mfma16(vf[e2][kk], pf[kk], acc);
#pragma unroll
                        for (int ks = 0; ks < 3; ++ks) acc = mfma16(cf[e2][ks], qf[ks], acc);
                        if (et < 6) *(LAS f32x4*)(HT + (16 * tt + c) * 100 + 16 * et + 4 * g) = acc;
                        else if (g == 0) DEN[16 * tt + c] = acc[0];
                    } }
            }
        }
        if (w < 6) {
#pragma unroll
            for (int kk = 0; kk < 2; ++kk) {
                bf16x8 vf[7]; const bf16x8 af = tr_frag(KS, QSTR, 32 * kk + 8 * g, 32 * kk + 8 * g + 4, 16 * w, lane);
#pragma unroll
                for (int et = 0; et < 7; ++et) vf[et] = tr_frag(VS, VSTR, 32 * kk + 8 * g, 32 * kk + 8 * g + 4, 16 * et, lane);
                LDS_FENCE();
#pragma unroll
                for (int et = 0; et < 7; ++et) Cst[et] = mfma16(af, vf[et], Cst[et]);
            }
#pragma unroll
            for (int et = 0; et < 7; ++et) { Cst[et] = Cst[et] * ebL;
                if (mode != 0) { v2u v; v.x = pk2(Cst[et][0], Cst[et][1]); v.y = pk2(Cst[et][2], Cst[et][3]); *(LAS v2u*)(CTn + (16 * et + c) * QSTR + 16 * w + 4 * g) = v; } }
        }
        Btot += bL;
        __syncthreads();
        if (ci + 1 < jb.nchunk) { stage_write(PK); bL = PK.bL; ebL = PK.ebL; }
        if (mode != 0) finalize(ci);
        __syncthreads();
    };
    for (int ci = 0; ci < jb.nchunk; ++ci) chunk_step(LA, ci);
    if (emit_slot >= 0 && w < 6) {
        float* sl = STd + (size_t)emit_slot * ST_FLOATS;
#pragma unroll
        for (int et = 0; et < 7; ++et) *(f32x4*)(sl + ((w * 7 + et) * 64 + lane) * 4) = Cst[et];
        if (w == 0 && lane == 0) sl[96 * 112] = Btot;
    }
    __syncthreads();
}
__device__ __forceinline__ void mlstm_load_rope(const Ctx& F, const float* rope_tab) {
    LAS f32x2* ROPE = (LAS f32x2*)(F.lds + ml::OFF_ROPE);
    for (int i = F.tid; i < 64 * 24; i += 512) ROPE[i] = ((const f32x2*)rope_tab)[i];
}
__device__ __forceinline__ void mlstm_itemA(const Ctx& F, int l, int bh, int it, bf16* otmp, float* ST) {
    const int b = bh >> 2, h = bh & 3;
    if (it == 0) {
        const MlJob jb{b, h, 1, 0, 4};
        mlstm_dir(F, l, jb, 0, -1, 0, l == 0 ? 1 : 0, otmp, ST);
        mlstm_dir(F, l, jb, 1, -1, 0, l == 0 ? 2 : 0, otmp, ST);
    } else {
        const int dir = (it - 1) / (NSEG - 1), k = (it - 1) % (NSEG - 1), seg = dir == 0 ? k : NSEG - 1 - k;
        const MlJob jb{b, h, 0, SEGTOK * seg, SEGCH};
        mlstm_dir(F, l, jb, dir, -1, 1 + k, 0, otmp, ST);
    }
}
__device__ __forceinline__ void mlstm_itemC(const Ctx& F, int l, int bh, int seg, bf16* otmp, float* ST) {
    const MlJob jb{bh >> 2, bh & 3, 0, SEGTOK * seg, SEGCH};
    mlstm_dir(F, l, jb, 0, seg, -1, 1, otmp, ST);
    mlstm_dir(F, l, jb, 1, NSEG - 1 - seg, -1, 2, otmp, ST);
}

namespace hg {
constexpr int STR = 72;
constexpr int IMG = 64 * STR * 2;
constexpr int OFF_KO = 0, OFF_KH = IMG, OFF_VS = 2 * IMG, OFF_QJ = 3 * IMG, OFF_ST = 7 * IMG, OFF_HT = 9 * IMG, OFF_TOT = OFF_HT + 64 * 68 * 4, OFF_BL = OFF_TOT + 8 * 64 * 4, OFF_END = OFF_BL + 512;
static_assert(OFF_END <= RING_BYTES, "hgrn LDS");
constexpr int ST_FLOATS = 64 * 64 + 64;
}
__device__ __forceinline__ void hgrn_dir(const Ctx& F, int l, const MlJob jb, int dir, int fold_r, int emit_slot, int mode, bf16* otmp, float* ST) {
    using namespace hg;
    int tid_ = F.tid; asm volatile("" : "+v"(tid_));
    const int tid = tid_, lane = tid & 63, w = __builtin_amdgcn_readfirstlane(tid >> 6), g = lane >> 4, c = lane & 15;
    LAS bf16* KO = (LAS bf16*)(F.lds + OFF_KO); LAS bf16* KH = (LAS bf16*)(F.lds + OFF_KH); LAS bf16* VS = (LAS bf16*)(F.lds + OFF_VS); LAS bf16* QJ = (LAS bf16*)(F.lds + OFF_QJ);
    LAS bf16* ST0 = (LAS bf16*)(F.lds + OFF_ST); LAS float* HT = (LAS float*)(F.lds + OFF_HT); LAS float* TOT = (LAS float*)(F.lds + OFF_TOT); LAS float* BL = (LAS float*)(F.lds + OFF_BL);
    const int rowbase = jb.isctx ? MX + jb.b * CTX : jb.b * S;
    const int h = jb.h; const bf16* P = F.P;
    float* STd = ST + (size_t)(((jb.b * 4 + h) * 2 + dir) * 8) * ST_FLOATS;
    const int dt = w >> 1, et0 = 2 * (w & 1);
    f32x4 Sst[2]; float Btot[4];
#pragma unroll
    for (int i = 0; i < 2; ++i) Sst[i] = (f32x4){0.f, 0.f, 0.f, 0.f};
#pragma unroll
    for (int r = 0; r < 4; ++r) Btot[r] = 0.f;
    if (fold_r >= 0) {
        f32x4 v[8][2], dk[8];
#pragma unroll
        for (int k = 0; k < NSEG; ++k) { const float* sl = STd + (size_t)k * ST_FLOATS; v[k][0] = *(const f32x4*)(sl + ((w * 2 + 0) * 64 + lane) * 4); v[k][1] = *(const f32x4*)(sl + ((w * 2 + 1) * 64 + lane) * 4);
            dk[k] = *(const f32x4*)(sl + 64 * 64 + 16 * dt + 4 * g); }
        f32x4 run = (f32x4){1.f, 1.f, 1.f, 1.f};
#pragma unroll
        for (int k = NSEG - 1; k >= 0; --k) { const float on = (k <= fold_r) ? 1.f : 0.f; Sst[0] += v[k][0] * (run * on); Sst[1] += v[k][1] * (run * on);
            if (k >= 1) { const bool use = k <= fold_r; run[0] *= use ? __expf(dk[k][0]) : 1.f; run[1] *= use ? __expf(dk[k][1]) : 1.f; run[2] *= use ? __expf(dk[k][2]) : 1.f; run[3] *= use ? __expf(dk[k][3]) : 1.f; } }
    }
    if (mode != 0) {
#pragma unroll
        for (int i = 0; i < 2; ++i) { v2u v; v.x = pk2(Sst[i][0], Sst[i][1]); v.y = pk2(Sst[i][2], Sst[i][3]); *(LAS v2u*)(ST0 + (16 * (et0 + i) + c) * STR + 16 * dt + 4 * g) = v; }
    }
    const int ps = lane, d0 = 8 * w;
    float lbv[8];
#pragma unroll
    for (int e = 0; e < 8; ++e) { lbv[e] = 0.f;
        if (l == 1) { const float v0 = F.hgrn_lb[(0 * 2 + dir) * 256 + h * 64 + d0 + e], v1 = F.hgrn_lb[(1 * 2 + dir) * 256 + h * 64 + d0 + e]; lbv[e] = 1.f / (1.f + expf(v0 - v1)); } }
    const int fcol = dir ? A_FB : A_FF;
    auto tok_of = [&](int ci, int i) -> int { return dir == 0 ? jb.t0 + 64 * ci + i : jb.t0 + 64 * (jb.nchunk - 1 - ci) + (63 - i); };
    v4u rq, rf, rv; rq = rf = rv = (v4u){0u, 0u, 0u, 0u};
    v4u ft = (v4u){0u, 0u, 0u, 0u}, fz = (v4u){0u, 0u, 0u, 0u};
    const int fi_i = tid >> 3, fi_e0 = 8 * (tid & 7);
    float gnv[8];
#pragma unroll
    for (int e = 0; e < 8; ++e) gnv[e] = (mode == 2) ? F.hgrn_gn[l * 256 + h * 64 + fi_e0 + e] : 0.f;
    auto issue_loads = [&](int ci) {
        const bf16* pr = P + (size_t)(rowbase + tok_of(ci, ps)) * PLD + h * 64 + d0;
        if (mode != 0) rq = *(const v4u*)(pr + A_Q);
        rf = *(const v4u*)(pr + fcol); rv = *(const v4u*)(pr + A_I);
    };
    auto issue_fin = [&](int ci) { const int m = rowbase + tok_of(ci, fi_i); ft = *(const v4u*)(otmp + (size_t)m * 256 + h * 64 + fi_e0); fz = *(const v4u*)(P + (size_t)m * PLD + A_Z + h * 64 + fi_e0); };
    issue_loads(0);
    __syncthreads();
    for (int ci = 0; ci < jb.nchunk; ++ci) {
        LAS bf16* STc = ST0 + (ci & 1) * 64 * STR; LAS bf16* STn = ST0 + ((ci + 1) & 1) * 64 * STR;
        {
            float qv[8], kk[8], bb[8], fl[8];
            unpack8(rf, fl);
#pragma unroll
            for (int e = 0; e < 8; ++e) { const float sg = sigmoid_f(fl[e]); const float f = lbv[e] + (1.f - lbv[e]) * sg; bb[e] = __logf(f); kk[e] = (1.f - lbv[e]) * (1.f - sg); }
            if (mode != 0) unpack8(rq, qv);
            const v4u vraw = rv;
            if (ci + 1 < jb.nchunk) issue_loads(ci + 1);
            if (mode == 2) issue_fin(ci);
            float ref1[8], ref2[8], ref3[8], bl[8];
#pragma unroll
            for (int e = 0; e < 8; ++e) { bb[e] = wave_scan_incl(bb[e]); ref1[e] = rdlane(bb[e], 15); ref2[e] = rdlane(bb[e], 31); ref3[e] = rdlane(bb[e], 47); bl[e] = rdlane(bb[e], 63); }
            const int sub = lane >> 4;
            float o8[8];
            if (mode != 0) {
#pragma unroll
                for (int e = 0; e < 8; ++e) { const float rown = sub == 0 ? 0.f : (sub == 1 ? ref1[e] : (sub == 2 ? ref2[e] : ref3[e])); o8[e] = kk[e] * __expf(rown - bb[e]); }
                *(LAS v4u*)(KO + ps * STR + d0) = pack8(o8); }
#pragma unroll
            for (int e = 0; e < 8; ++e) o8[e] = kk[e] * __expf(bl[e] - bb[e]);
            *(LAS v4u*)(KH + ps * STR + d0) = pack8(o8);
            *(LAS v4u*)(VS + ps * STR + d0) = vraw;
            if (mode != 0) {
#pragma unroll
                for (int e = 0; e < 8; ++e) o8[e] = qv[e] * __expf(bb[e]);
                *(LAS v4u*)(QJ + ps * STR + d0) = pack8(o8);
                if (sub >= 1) {
#pragma unroll
                    for (int e = 0; e < 8; ++e) o8[e] = qv[e] * __expf(bb[e] - ref1[e]);
                    *(LAS v4u*)(QJ + (64 + ps) * STR + d0) = pack8(o8); }
                if (sub >= 2) {
#pragma unroll
                    for (int e = 0; e < 8; ++e) o8[e] = qv[e] * __expf(bb[e] - ref2[e]);
                    *(LAS v4u*)(QJ + (128 + ps) * STR + d0) = pack8(o8); }
                if (sub >= 3) {
#pragma unroll
                    for (int e = 0; e < 8; ++e) o8[e] = qv[e] * __expf(bb[e] - ref3[e]);
                    *(LAS v4u*)(QJ + (192 + ps) * STR + d0) = pack8(o8); }
            }
            if (lane == 0) { *(LAS f32x4*)(BL + d0) = (f32x4){bl[0], bl[1], bl[2], bl[3]}; *(LAS f32x4*)(BL + d0 + 4) = (f32x4){bl[4], bl[5], bl[6], bl[7]}; }
        }
        __syncthreads();
        if (mode != 0) {
            const int tt = w & 3, eh = w >> 2;
            f32x4 at[4];
            { bf16x8 kf[4][2], qjf[4][2];
#pragma unroll
              for (int j = 0; j < 4; ++j) if (j <= tt) {
#pragma unroll
                  for (int ks = 0; ks < 2; ++ks) { kf[j][ks] = rm_frag(KO, STR, 16 * j + c, 32 * ks + 8 * g); qjf[j][ks] = rm_frag(QJ + j * 64 * STR, STR, 16 * tt + c, 32 * ks + 8 * g); } }
              LDS_FENCE();
#pragma unroll
              for (int j = 0; j < 4; ++j) { at[j] = (f32x4){0.f, 0.f, 0.f, 0.f};
                  if (j <= tt) {
#pragma unroll
                      for (int ks = 0; ks < 2; ++ks) at[j] = mfma16(kf[j][ks], qjf[j][ks], at[j]);
                      if (j == tt) {
#pragma unroll
                          for (int r = 0; r < 4; ++r) if (4 * g + r > c) at[j][r] = 0.f; }
                  } } }
            bf16x8 pf[2];
#pragma unroll
            for (int k2 = 0; k2 < 2; ++k2) { const unsigned u0 = pk2(at[2 * k2][0], at[2 * k2][1]), u1 = pk2(at[2 * k2][2], at[2 * k2][3]), u2 = pk2(at[2 * k2 + 1][0], at[2 * k2 + 1][1]), u3 = pk2(at[2 * k2 + 1][2], at[2 * k2 + 1][3]);
                pf[k2] = __builtin_bit_cast(bf16x8, (v4u){u0, u1, u2, u3}); }
            { bf16x8 qf[2], vf[2][2], sf[2][2];
#pragma unroll
              for (int ks = 0; ks < 2; ++ks) qf[ks] = rm_frag(QJ, STR, 16 * tt + c, 32 * ks + 8 * g);
#pragma unroll
              for (int ei = 0; ei < 2; ++ei) { const int et = 2 * eh + ei;
#pragma unroll
                  for (int k2 = 0; k2 < 2; ++k2) if (2 * k2 <= tt) vf[ei][k2] = tr_frag(VS, STR, 32 * k2 + 4 * g, 32 * k2 + 16 + 4 * g, 16 * et, lane);
#pragma unroll
                  for (int ks = 0; ks < 2; ++ks) sf[ei][ks] = rm_frag(STc, STR, 16 * et + c, 32 * ks + 8 * g); }
              LDS_FENCE();
#pragma unroll
              for (int ei = 0; ei < 2; ++ei) { const int et = 2 * eh + ei;
                  f32x4 acc = (f32x4){0.f, 0.f, 0.f, 0.f};
#pragma unroll
                  for (int k2 = 0; k2 < 2; ++k2) if (2 * k2 <= tt) acc = mfma16(vf[ei][k2], pf[k2], acc);
#pragma unroll
                  for (int ks = 0; ks < 2; ++ks) acc = mfma16(sf[ei][ks], qf[ks], acc);
                  *(LAS f32x4*)(HT + (16 * tt + c) * 68 + 16 * et + 4 * g) = acc; } }
        }
        {
            const f32x4 blv = *(const LAS f32x4*)(BL + 16 * dt + 4 * g);
#pragma unroll
            for (int r = 0; r < 4; ++r) { const float dec = __expf(blv[r]); Sst[0][r] *= dec; Sst[1][r] *= dec; Btot[r] += blv[r]; }
            { bf16x8 af[2], vf[2][2];
#pragma unroll
              for (int k2 = 0; k2 < 2; ++k2) { af[k2] = tr_frag(KH, STR, 32 * k2 + 8 * g, 32 * k2 + 8 * g + 4, 16 * dt, lane);
#pragma unroll
                  for (int i = 0; i < 2; ++i) vf[k2][i] = tr_frag(VS, STR, 32 * k2 + 8 * g, 32 * k2 + 8 * g + 4, 16 * (et0 + i), lane); }
              LDS_FENCE();
#pragma unroll
              for (int k2 = 0; k2 < 2; ++k2)
#pragma unroll
                  for (int i = 0; i < 2; ++i) Sst[i] = mfma16(af[k2], vf[k2][i], Sst[i]); }
            if (mode != 0) {
#pragma unroll
                for (int i = 0; i < 2; ++i) { v2u v; v.x = pk2(Sst[i][0], Sst[i][1]); v.y = pk2(Sst[i][2], Sst[i][3]); *(LAS v2u*)(STn + (16 * (et0 + i) + c) * STR + 16 * dt + 4 * g) = v; } }
        }
        __syncthreads();
        if (mode != 0) {
            const int i = tid >> 3, sub8 = tid & 7, e0 = 8 * sub8; const int m = rowbase + tok_of(ci, i);
            float hv[8];
            { const f32x4 a0 = *(const LAS f32x4*)(HT + i * 68 + e0), a1 = *(const LAS f32x4*)(HT + i * 68 + e0 + 4); hv[0] = a0[0]; hv[1] = a0[1]; hv[2] = a0[2]; hv[3] = a0[3]; hv[4] = a1[0]; hv[5] = a1[1]; hv[6] = a1[2]; hv[7] = a1[3]; }
            bf16* tp = otmp + (size_t)m * 256 + h * 64 + e0;
            if (mode == 1) *(v4u*)tp = pack8(hv);
            else {
                float tv[8]; unpack8(ft, tv);
                float ss = 0.f;
#pragma unroll
                for (int e = 0; e < 8; ++e) { hv[e] += tv[e]; ss += hv[e] * hv[e]; }
                ss = group8_sum(ss);
                const float rinv = __builtin_amdgcn_rsqf(ss * (1.f / 64.f) + EPS);
                float zv[8]; unpack8(fz, zv);
#pragma unroll
                for (int e = 0; e < 8; ++e) hv[e] = hv[e] * rinv * gnv[e] * zv[e];
                *(v4u*)(F.hxy + (size_t)m * 1024 + h * 64 + e0) = pack8(hv);
            }
        }
    }
    if (emit_slot >= 0) {
        float* sl = STd + (size_t)emit_slot * ST_FLOATS;
        *(f32x4*)(sl + ((w * 2 + 0) * 64 + lane) * 4) = Sst[0]; *(f32x4*)(sl + ((w * 2 + 1) * 64 + lane) * 4) = Sst[1];
        if ((w & 1) == 0 && c == 0) *(f32x4*)(sl + 64 * 64 + 16 * dt + 4 * g) = (f32x4){Btot[0], Btot[1], Btot[2], Btot[3]};
    }
    __syncthreads();
}
__device__ __forceinline__ void hgrn_itemA(const Ctx& F, int l, int bh, int it, bf16* otmp, float* ST) {
    const int b = bh >> 2, h = bh & 3;
    if (it == 0) {
        const MlJob jb{b, h, 1, 0, 4};
        hgrn_dir(F, l, jb, 0, -1, 0, l == 0 ? 1 : 0, otmp, ST);
        hgrn_dir(F, l, jb, 1, -1, 0, l == 0 ? 2 : 0, otmp, ST);
    } else {
        const int dir = (it - 1) / (NSEG - 1), k = (it - 1) % (NSEG - 1), seg = dir == 0 ? k : NSEG - 1 - k;
        const MlJob jb{b, h, 0, SEGTOK * seg, SEGCH};
        hgrn_dir(F, l, jb, dir, -1, 1 + k, 0, otmp, ST);
    }
}
__device__ __forceinline__ void hgrn_itemC(const Ctx& F, int l, int bh, int seg, bf16* otmp, float* ST) {
    const MlJob jb{bh >> 2, bh & 3, 0, SEGTOK * seg, SEGCH};
    hgrn_dir(F, l, jb, 0, seg, -1, 1, otmp, ST);
    hgrn_dir(F, l, jb, 1, NSEG - 1 - seg, -1, 2, otmp, ST);
}

namespace nat {
constexpr int STR = 72, IMG = 64 * STR * 2;
constexpr int OFF_K = 0, OFF_V = 2 * IMG, OFF_RPB = 4 * IMG, OFF_END = OFF_RPB + 2048;
static_assert(OFF_END <= RING_BYTES, "na LDS");
}
template <int CH, bool WIN>
__device__ __forceinline__ void na_block(const LAS bf16* Kc, const LAS bf16* Vc, const LAS float* RPB, const bf16x8 (&qf)[2][2], f32x4 (&oacc)[2][4], float (&mrun)[2], float (&lrun)[2],
                                         const int g, const int c, const int lane, const int dr, const int (&qcol)[2], const int (&csq)[2]) {
    constexpr int STR = nat::STR;
    constexpr int KLO[2] = {WIN ? (CH == 0 ? 0 : 1) : 0, WIN ? (CH == 0 ? 0 : 2) : 0}, KHI[2] = {WIN ? (CH == 0 ? 1 : 3) : 3, WIN ? (CH == 0 ? 2 : 3) : 3};
    constexpr int ULO = KLO[0] < KLO[1] ? KLO[0] : KLO[1], UHI = KHI[0] > KHI[1] ? KHI[0] : KHI[1];
    f32x4 st[2][4];
    { bf16x8 kf[4][2];
#pragma unroll
      for (int kt = ULO; kt <= UHI; ++kt)
#pragma unroll
          for (int ks = 0; ks < 2; ++ks) kf[kt][ks] = rm_frag(Kc, STR, 16 * kt + c, 32 * ks + 8 * g);
      LDS_FENCE();
#pragma unroll
      for (int qt = 0; qt < 2; ++qt)
#pragma unroll
          for (int kt = 0; kt < 4; ++kt) { st[qt][kt] = (f32x4){0.f, 0.f, 0.f, 0.f};
              if (kt >= KLO[qt] && kt <= KHI[qt]) {
#pragma unroll
                  for (int ks = 0; ks < 2; ++ks) st[qt][kt] = mfma16(kf[kt][ks], qf[qt][ks], st[qt][kt]); } } }
    if (WIN) {
#pragma unroll
        for (int qt = 0; qt < 2; ++qt) { const int boff = dr * 31 + 15 - qcol[qt];
#pragma unroll
            for (int kt = KLO[qt]; kt <= KHI[qt]; ++kt)
#pragma unroll
                for (int r = 0; r < 4; ++r) { const int kc = 16 * kt + 4 * g + r; const float bias = RPB[min(max(boff + kc, 0), 464)]; const float v = st[qt][kt][r] + bias; st[qt][kt][r] = ((unsigned)(kc - csq[qt]) < 16u) ? v : -1e30f; } }
    }
    float alpha[2]; bf16x8 pf[2][2];
#pragma unroll
    for (int qt = 0; qt < 2; ++qt) {
        float bm = -1e30f;
#pragma unroll
        for (int kt = KLO[qt]; kt <= KHI[qt]; ++kt)
#pragma unroll
            for (int r = 0; r < 4; ++r) bm = fmaxf(bm, st[qt][kt][r]);
        bm = xor32_max(xor16_max(bm));
        const float mnew = fmaxf(mrun[qt], bm); alpha[qt] = __builtin_amdgcn_exp2f(mrun[qt] - mnew); mrun[qt] = mnew;
        float ps = 0.f;
#pragma unroll
        for (int kt = KLO[qt]; kt <= KHI[qt]; ++kt)
#pragma unroll
            for (int r = 0; r < 4; ++r) { const float p = __builtin_amdgcn_exp2f(st[qt][kt][r] - mnew); st[qt][kt][r] = p; ps += p; }
        lrun[qt] = lrun[qt] * alpha[qt] + ps;
#pragma unroll
        for (int k2 = 0; k2 < 2; ++k2) { const unsigned u0 = pk2(st[qt][2 * k2][0], st[qt][2 * k2][1]), u1 = pk2(st[qt][2 * k2][2], st[qt][2 * k2][3]), u2 = pk2(st[qt][2 * k2 + 1][0], st[qt][2 * k2 + 1][1]), u3 = pk2(st[qt][2 * k2 + 1][2], st[qt][2 * k2 + 1][3]);
            pf[qt][k2] = __builtin_bit_cast(bf16x8, (v4u){u0, u1, u2, u3}); }
    }
    { bf16x8 vf[4][2];
#pragma unroll
      for (int dtl = 0; dtl < 4; ++dtl)
#pragma unroll
          for (int k2 = ULO / 2; k2 <= UHI / 2; ++k2) vf[dtl][k2] = tr_frag(Vc, STR, 32 * k2 + 4 * g, 32 * k2 + 16 + 4 * g, 16 * dtl, lane);
      LDS_FENCE();
#pragma unroll
      for (int qt = 0; qt < 2; ++qt)
#pragma unroll
          for (int dtl = 0; dtl < 4; ++dtl) { f32x4 a = oacc[qt][dtl] * alpha[qt];
#pragma unroll
              for (int k2 = KLO[qt] / 2; k2 <= KHI[qt] / 2; ++k2) a = mfma16(vf[dtl][k2], pf[qt][k2], a);
              oacc[qt][dtl] = a; } }
}
__device__ __forceinline__ void na_item(const Ctx& F, int l, int b, int h, int R0) {
    using namespace nat;
    int tid_ = F.tid; asm volatile("" : "+v"(tid_));
    const int tid = tid_, lane = tid & 63, w = __builtin_amdgcn_readfirstlane(tid >> 6), g = lane >> 4, c = lane & 15;
    LAS bf16* KT = (LAS bf16*)(F.lds + OFF_K); LAS bf16* VT = (LAS bf16*)(F.lds + OFF_V); LAS float* RPB = (LAS float*)(F.lds + OFF_RPB);
    const bf16* P = F.P; const bool lat = R0 >= 0;
    const int R = R0 + (w >> 1), ch = w & 1;
    const int rsR = min(max(R - 4, 0), 56);
    const int kr0 = lat ? min(max(R0 - 4, 0), 56) : 0;
    const int nwin = lat ? (min(max(R0 + 3 - 4, 0), 56) + 8 - kr0) : 0, nblk = nwin + 4;
    if (lat) for (int i = tid; i < 15 * 31; i += 512) RPB[i] = F.na_rpb[((size_t)l * 6 + h) * 465 + i] * 1.4426950408889634f;
    int mq[2]; bf16x8 qf[2][2]; int csq[2], qcol[2];
#pragma unroll
    for (int qt = 0; qt < 2; ++qt) {
        if (lat) { qcol[qt] = 32 * ch + 16 * qt + c; mq[qt] = b * S + R * 64 + qcol[qt]; } else { qcol[qt] = 0; mq[qt] = MX + b * CTX + 32 * w + 16 * qt + c; }
        csq[qt] = min(max(qcol[qt] - 8, 0), 48);
#pragma unroll
        for (int ks = 0; ks < 2; ++ks) qf[qt][ks] = *(const bf16x8*)(P + (size_t)mq[qt] * PLD + C_Q + h * 64 + 32 * ks + 8 * g);
    }
    f32x4 oacc[2][4]; float mrun[2], lrun[2];
#pragma unroll
    for (int qt = 0; qt < 2; ++qt) { mrun[qt] = -1e30f; lrun[qt] = 0.f;
#pragma unroll
        for (int dtl = 0; dtl < 4; ++dtl) oacc[qt][dtl] = (f32x4){0.f, 0.f, 0.f, 0.f}; }
    const int stok = tid >> 3, spc = tid & 7;
    auto blk_row = [&](int i) -> int { return i < nwin ? b * S + (kr0 + i) * 64 + stok : MX + b * CTX + 64 * (i - nwin) + stok; };
    v4u rk0, rv0, rk1, rv1, rk2, rv2;
    auto ld = [&](int i, v4u& k_, v4u& v_) { const int ii = i < nblk ? i : nblk - 1; const bf16* pr = P + (size_t)blk_row(ii) * PLD + h * 64 + 8 * spc; k_ = *(const v4u*)(pr + C_K); v_ = *(const v4u*)(pr + C_V); };
    ld(0, rk0, rv0); ld(1, rk1, rv1); ld(2, rk2, rv2);
    __syncthreads();
    *(LAS v4u*)(KT + stok * STR + 8 * spc) = rk0; *(LAS v4u*)(VT + stok * STR + 8 * spc) = rv0;
    ld(3, rk0, rv0);
    __syncthreads();
    auto step = [&](int i, v4u& kn, v4u& vn) {
        const LAS bf16* Kc = KT + (i & 1) * 64 * STR; const LAS bf16* Vc = VT + (i & 1) * 64 * STR;
        if (i + 1 < nblk) { LAS bf16* Kn = KT + ((i + 1) & 1) * 64 * STR; LAS bf16* Vn = VT + ((i + 1) & 1) * 64 * STR;
            *(LAS v4u*)(Kn + stok * STR + 8 * spc) = kn; *(LAS v4u*)(Vn + stok * STR + 8 * spc) = vn;
            if (i + 4 < nblk) ld(i + 4, kn, vn); }
        const bool win = i < nwin; const int kr = kr0 + i;
        const bool active = !win || (kr >= rsR && kr < rsR + 8);
        if (active) {
            if (!win) na_block<0, false>(Kc, Vc, RPB, qf, oacc, mrun, lrun, g, c, lane, 0, qcol, csq);
            else if (ch == 0) na_block<0, true>(Kc, Vc, RPB, qf, oacc, mrun, lrun, g, c, lane, kr - R + 7, qcol, csq);
            else na_block<1, true>(Kc, Vc, RPB, qf, oacc, mrun, lrun, g, c, lane, kr - R + 7, qcol, csq);
        }
        __syncthreads();
    };
    for (int i = 0; i < nblk; i += 3) { step(i, rk1, rv1); if (i + 1 < nblk) step(i + 1, rk2, rv2); if (i + 2 < nblk) step(i + 2, rk0, rv0); }
#pragma unroll
    for (int qt = 0; qt < 2; ++qt) {
        const float lt = xor32_sum(xor16_sum(lrun[qt]));
        const float rl = __builtin_amdgcn_rcpf(lt);
        const bf16* zr = P + (size_t)mq[qt] * PLD + C_Z + h * 64; bf16* yr = F.hxy + (size_t)mq[qt] * 1024 + 640 + h * 64;
#pragma unroll
        for (int dtl = 0; dtl < 4; ++dtl) { const int d = 16 * dtl + 4 * g; const v2u zv = *(const v2u*)(zr + d);
            const float z0 = __uint_as_float(zv.x << 16), z1 = __uint_as_float(zv.x & 0xffff0000u), z2 = __uint_as_float(zv.y << 16), z3 = __uint_as_float(zv.y & 0xffff0000u);
            v2u o; o.x = pk2(oacc[qt][dtl][0] * rl * z0, oacc[qt][dtl][1] * rl * z1); o.y = pk2(oacc[qt][dtl][2] * rl * z2, oacc[qt][dtl][3] * rl * z3);
            *(v2u*)(yr + d) = o; }
    }
}

__device__ __forceinline__ void phase_mixA(const Ctx& F, int l, unsigned* ticket) {
    mlstm_load_rope(F, F.rope);
    volatile LAS unsigned* slot = (volatile LAS unsigned*)(F.lds + MISC_OFF) + 16;
    const int n_ctx = 64, n_na = 768, n_loc = 2 * 32 * 2 * (NSEG - 1), n_nactx = (l == 0) ? 48 : 0, n_all = n_ctx + n_na + n_loc + n_nactx;
    unsigned cur = 0;
    if (F.tid == 0) *slot = __hip_atomic_fetch_add(ticket, 1u, __ATOMIC_RELAXED, __HIP_MEMORY_SCOPE_AGENT);
    __syncthreads();
    cur = *slot;
    while ((int)cur < n_all) {
        unsigned nxt = 0;
        if (F.tid == 0) nxt = __hip_atomic_fetch_add(ticket, 1u, __ATOMIC_RELAXED, __HIP_MEMORY_SCOPE_AGENT);
        int it = (int)cur;
        const int tkind = it < n_ctx ? 22 : (it < n_ctx + n_loc ? 21 : 20);
        if (l == 0) { TS_START(F, tkind); if (PROBE_T == 25 && blockIdx.x == 0 && F.tid == 0) TS_LDS(F)[0] += 2000; }
        if (it < n_ctx) { if (it < 32) mlstm_itemA(F, l, it, 0, F.otm, F.stm); else hgrn_itemA(F, l, it - 32, 0, F.oth, F.sth); }
        else if ((it -= n_ctx) < n_loc) { constexpr int NL = 2 * (NSEG - 1); if (it < 32 * NL) mlstm_itemA(F, l, it / NL, 1 + it % NL, F.otm, F.stm); else { it -= 32 * NL; hgrn_itemA(F, l, it / NL, 1 + it % NL, F.oth, F.sth); } }
        else if ((it -= n_loc) < n_na) na_item(F, l, it / 96, (it / 16) % 6, 4 * (it % 16));
        else { it -= n_na; na_item(F, l, it / 6, it % 6, -1); }
        if (l == 0) TS_STOP(F, tkind);
        __syncthreads();
        if (F.tid == 0) *slot = nxt;
        __syncthreads();
        cur = *slot;
    }
}
__device__ __forceinline__ void phase_mixC(const Ctx& F, int l) {
    mlstm_load_rope(F, F.rope);
    for (int it = F.vcu; it < 2 * 32 * NSEG; it += F.G) {
        if (it < 32 * NSEG) mlstm_itemC(F, l, it / NSEG, it % NSEG, F.otm, F.stm);
        else hgrn_itemC(F, l, (it - 32 * NSEG) / NSEG, it % NSEG, F.oth, F.sth);
    }
}

constexpr int NPH = 12;
struct Args { const float* in[15]; float* out; unsigned char* ws; int ph_lo, ph_hi; };
__global__ void __launch_bounds__(512, 2) mega_fwd(Args args) {
    extern __shared__ __attribute__((aligned(16))) unsigned char lds[];
    Ctx F;
    F.lds = (LAS unsigned char*)lds;
    F.tid = threadIdx.x; F.lane = F.tid & 63; F.wave = __builtin_amdgcn_readfirstlane(F.tid >> 6);
    F.G = gridDim.x; { const int bx = blockIdx.x; F.vcu = (F.G % 8 == 0) ? (bx % 8) * (F.G / 8) + bx / 8 : bx; }
    F.gw = F.vcu * 8 + F.wave; F.NGW = F.G * 8;
    unsigned char* ws = args.ws;
    F.x = args.in[0]; F.c = args.in[1]; F.ctx = args.in[2]; F.c_ctx = args.in[3]; F.w_mod = args.in[4]; F.b_mod = args.in[5]; F.g_pre = args.in[6]; F.g_post = args.in[7];
    F.w_in = args.in[8]; F.w_out = args.in[9]; F.hgrn_lb = args.in[10]; F.hgrn_gn = args.in[11]; F.gate_b = args.in[12]; F.mlstm_gn = args.in[13]; F.na_rpb = args.in[14];
    F.out = args.out;
    F.wt_in = (bf16*)(ws + WS_WT_IN); F.wt_out = (bf16*)(ws + WS_WT_OUT); F.mod = (float*)(ws + WS_MOD); F.gates = (float*)(ws + WS_GATES); F.ctx1 = (float*)(ws + WS_CTX1);
    F.hxy = (bf16*)(ws + WS_HXY); F.P = (bf16*)(ws + WS_P); F.UX = (bf16*)(ws + WS_P); F.oth = (bf16*)(ws + WS_OH); F.sth = (float*)(ws + WS_STH); F.otm = (bf16*)(ws + WS_OM); F.stm = (float*)(ws + WS_STM); F.rope = (float*)(ws + WS_ROPE);
    for (int u = F.tid; u < (LDS_BYTES - LDSCTL_OFF) / 4; u += 512) ((LAS unsigned*)(F.lds + LDSCTL_OFF))[u] = 0u;
    __syncthreads();
    XcdBarrier bar = xcd_barrier_post((unsigned*)(ws + WS_CTL) + CW_BAR, (volatile LAS unsigned*)(F.lds + MISC_OFF) + 8);

    const int lo = args.ph_lo, hi = args.ph_hi;
#ifndef DUP_PHASE
#define DUP_PHASE -1
#endif
#define IN(k) (lo <= (k) && (k) < hi)
#define SEAM(k) do { if ((k) + 1 < hi) xcd_barrier(bar); } while (0)
#define PHASE(k, ...) if (IN(k)) { TS_START(F, 100 + (k)); __VA_ARGS__; if ((k) == DUP_PHASE) { xcd_barrier(bar); __VA_ARGS__; } SEAM(k); TS_STOP(F, 100 + (k)); }
    PHASE(0, phase_p0(F))
    PHASE(1, { phase_prenorm0(F); phase_p1_transposes(F); })
#define LAYER(l) \
    PHASE(2 + 5 * (l), { \
        pg8::Gemm g{F.hxy, F.wt_in + (size_t)(l) * NPAD * 1024, M, NPAD, 1024}; \
        pg8::EpiIn E{F.P, F.gates, F.gate_b + (l) * 16}; \
        pg8::StaticOrder SO; SO.init(M, NPAD, F.G, (int)blockIdx.x); pg8::gemm_phase<pg8::EpiIn, pg8::StaticOrder, true, true>(F.lds + RING_OFF, g, SO, E); }) \
    PHASE(3 + 5 * (l), phase_mixA(F, (l), (unsigned*)(args.ws + WS_CTL) + 8192 + 64 * (l))) \
    PHASE(4 + 5 * (l), phase_mixC(F, (l))) \
    PHASE(5 + 5 * (l), { \
        constexpr int Ml = (l) == 0 ? M : MX; \
        pg8::Gemm g{F.hxy, F.wt_out + (size_t)(l) * 1024 * 1024, Ml, 1024, 1024}; pg8::StaticOrder SO; SO.init(Ml, 1024, F.G, (int)blockIdx.x); \
        pg8::EpiOut E{F.UX}; \
        pg8::gemm_phase<pg8::EpiOut, pg8::StaticOrder, true, true>(F.lds + RING_OFF, g, SO, E); }) \
    PHASE(6 + 5 * (l), phase_post(F, (l)))
    LAYER(0)
    LAYER(1)
#undef LAYER
#undef PHASE
#undef IN
#undef SEAM
    if (PROBE_T != 0 && blockIdx.x == 0 && F.tid == 0) { const unsigned long long t0 = __builtin_amdgcn_s_memtime(), dt = 8ull * TS_LDS(F)[0]; while (__builtin_amdgcn_s_memtime() - t0 < dt) __builtin_amdgcn_s_sleep(8); }
}

extern "C" void kernel_launch(void* const* d_in, const int* in_sizes, int n_in, void* d_out, int out_size, void* d_ws, size_t ws_size, hipStream_t stream) {
    static int grid = 0;
    if (grid == 0) {
        if (n_in != 15 || ws_size < WS_END) { fprintf(stderr, "kernel_launch: unexpected n_in %d / ws_size %zu (need %zu); nothing launched\n", n_in, ws_size, (size_t)WS_END); grid = -1; return; }
        int dev = 0, cus = 0, per_cu = 0;
        if (hipGetDevice(&dev) != hipSuccess || hipDeviceGetAttribute(&cus, hipDeviceAttributeMultiprocessorCount, dev) != hipSuccess) { grid = -1; return; }
        if (hipFuncSetAttribute((const void*)mega_fwd, hipFuncAttributeMaxDynamicSharedMemorySize, LDS_BYTES) != hipSuccess) { fprintf(stderr, "kernel_launch: hipFuncSetAttribute failed\n"); grid = -1; return; }
        if (hipOccupancyMaxActiveBlocksPerMultiprocessor(&per_cu, (const void*)mega_fwd, 512, LDS_BYTES) != hipSuccess || per_cu < 1) { fprintf(stderr, "kernel_launch: occupancy query says %d blocks/CU\n", per_cu); (void)hipGetLastError(); grid = -1; return; }
        grid = cus;
    }
    if (grid < 0) return;
    (void)hipMemsetAsync((char*)d_ws + WS_CTL, 0, CTL_BYTES, stream);
    Args a{};
    for (int i = 0; i < 15; ++i) a.in[i] = (const float*)d_in[i];
    a.out = (float*)d_out; a.ws = (unsigned char*)d_ws; a.ph_lo = 0; a.ph_hi = NPH;
    hipLaunchKernelGGL(mega_fwd, dim3(grid), dim3(512), LDS_BYTES, stream, a);
}
```

```cpp
#include <hip/hip_runtime.h>
#include <stdint.h>
#include <cstdio>

namespace cfg {
constexpr int D = 1024, NB = 8, S = 4096, CTX = 256;
constexpr int MX = NB * S, MC = NB * CTX, M = MX + MC;
constexpr int PIN = 4752, NPAD = 4864, PLD = 4736;
constexpr int A_Q = 0, A_FF = 256, A_FB = 512, A_I = 768, A_Z = 1024, B_Q = 1280, B_K = 1664, B_V = 2048, B_O = 2432, B_Z = 2816,
              C_Q = 3200, C_K = 3584, C_V = 3968, C_Z = 4352;
constexpr float EPS = 1e-6f;
constexpr size_t WS_CTL = 0, CTL_BYTES = 65536;
constexpr size_t WS_WT_IN = WS_CTL + CTL_BYTES;
constexpr size_t WS_WT_OUT = WS_WT_IN + 2ull * NPAD * 1024 * 2;
constexpr size_t WS_MOD = WS_WT_OUT + 2ull * 1024 * 1024 * 2;
constexpr size_t WS_GATES = WS_MOD + 2ull * 9 * 3072 * 4;
constexpr size_t WS_CTX1 = WS_GATES + (size_t)M * 16 * 4;
constexpr size_t WS_HXY = WS_CTX1 + (size_t)MC * 1024 * 4;
constexpr size_t WS_P = WS_HXY + (size_t)M * 1024 * 2;
constexpr size_t WS_OH = WS_P + (size_t)M * PLD * 2;
constexpr size_t WS_OM = WS_OH + (size_t)M * 256 * 4;
constexpr size_t WS_STM = WS_OM + (size_t)M * 384 * 2;
constexpr size_t WS_ROPE = WS_STM + 32ull * 2 * 8 * (96 * 112 + 16) * 4;
constexpr size_t WS_STH = WS_ROPE + 64 * 24 * 8;
constexpr size_t WS_END = WS_STH + 32ull * 2 * 8 * (64 * 64 + 64) * 4;
static_assert(WS_END <= 536870912ull, "workspace");
static_assert(WS_WT_IN % 256 == 0 && WS_MOD % 256 == 0 && WS_GATES % 256 == 0 && WS_CTX1 % 256 == 0 && WS_HXY % 256 == 0 && WS_P % 256 == 0 && WS_OH % 256 == 0 && WS_OM % 256 == 0 && WS_STM % 256 == 0 && WS_ROPE % 256 == 0 && WS_STH % 256 == 0, "align");
}
using namespace cfg;

namespace pg8 {
#define PG8_LAS __attribute__((address_space(3)))
typedef unsigned short bf16_t;
typedef short bf16x8 __attribute__((ext_vector_type(8)));
typedef float f32x4 __attribute__((ext_vector_type(4)));
typedef unsigned u32x4 __attribute__((ext_vector_type(4)));
constexpr int BM = 256, BK = 64, HALF = 128, HTB = HALF * BK * 2  , STAGE_BYTES = 8 * HTB, NXCD = 8, WGM = 8;

__host__ __device__ __forceinline__ int lds_byte(int r, int c) { const int st = (r >> 4) * 2 + (c >> 5), rr = r & 15, cc = c & 31, ob = rr * 64 + cc * 2; return st * 1024 + (ob ^ (((ob >> 9) & 1) << 5)); }
__host__ __device__ __forceinline__ void stage_rc(int b, int& R, int& C) { const int st = b / 1024, sb = b % 1024, swz = sb ^ (((sb >> 9) & 1) << 5); R = (st >> 1) * 16 + swz / 64; C = (st & 1) * 32 + (swz % 64) / 2; }
__host__ __device__ __forceinline__ int perm32(int rho) { const int n = rho >> 4, i = rho & 15; return 8 * (i >> 2) + 4 * n + (i & 3); }

struct Unit { int pm, pn; };
struct Gemm { const bf16_t* A; const bf16_t* Bt; int M, N, K; };

struct StaticOrder {
    int nM, nN, nwg, G, c;
    __host__ __device__ void init(int M, int N, int G_, int c_) { nM = M / BM; nN = N / BM; nwg = nM * nN; G = G_; c = c_; }
    __host__ __device__ bool next(int i, Unit& u) const {
        const long L = (long)i * G + c; if (L >= nwg) return false;
        int wgid = (int)L; { const int q = nwg / NXCD, r = nwg % NXCD, xcd = wgid % NXCD, off = wgid / NXCD; wgid = (xcd < r ? xcd * (q + 1) : r * (q + 1) + (xcd - r) * q) + off; }
        const int nig = WGM * nN, gid = wgid / nig, fm = gid * WGM, gsz = (nM - fm) < WGM ? (nM - fm) : WGM;
        u.pm = fm + ((wgid % nig) % gsz); u.pn = (wgid % nig) / gsz; return true;
    }
    __device__ __forceinline__ void a_ready(const Unit&) const {}
    __device__ __forceinline__ void done(const Unit&) const {}
};

__device__ __forceinline__ unsigned cvt_pk_bf16(float lo, float hi) { unsigned r; asm volatile("v_cvt_pk_bf16_f32 %0, %1, %2" : "=v"(r) : "v"(lo), "v"(hi)); return r; }
__device__ __forceinline__ float logsigmoid_e(float v) { return fminf(v, 0.f) - log1pf(__expf(-fabsf(v))); }

struct EpiIn {
    static constexpr bool PERM = true, AFTER_DRAIN = false;
    bf16_t* P; float* gates; const float* gate_b;
    __device__ __forceinline__ void operator()(const f32x4 (&acc)[2][2][4][2], const Unit& u, int wr, int wc, int fr, int fq) const {
        const int row0 = u.pm * BM + wr * 64 + fr, col0 = u.pn * BM + wc * 32 + 8 * fq;
#pragma unroll
        for (int bj = 0; bj < 2; ++bj) {
            const int col = col0 + bj * HALF;
            if (col < cfg::PLD) {
                const int act = col < 256 ? 1 : col < 1024 ? 0 : col < 1280 ? 2 : col < 1664 ? 3 : col < 2432 ? 0 : col < 2816 ? 4 : col < 3200 ? 2 : col < 3584 ? 5 : col < 4352 ? 0 : 2;
#pragma unroll
                for (int ai = 0; ai < 2; ++ai)
#pragma unroll
                    for (int m = 0; m < 4; ++m) { f32x4 v0 = acc[ai][bj][m][0], v1 = acc[ai][bj][m][1];
                        if (act == 1 || act == 2 || act == 4) { const float sc = act == 1 ? 0.125f : 1.f;
#pragma unroll
                            for (int e = 0; e < 4; ++e) { const float s0 = __builtin_amdgcn_rcpf(1.f + __expf(-v0[e])), s1 = __builtin_amdgcn_rcpf(1.f + __expf(-v1[e])); v0[e] = act == 4 ? s0 : v0[e] * s0 * sc; v1[e] = act == 4 ? s1 : v1[e] * s1 * sc; } }
                        else if (act == 3) { v0 = v0 * 0.10206207261596575f; v1 = v1 * 0.10206207261596575f; }
                        else if (act == 5) { v0 = v0 * (0.125f * 1.4426950408889634f); v1 = v1 * (0.125f * 1.4426950408889634f); }
                        u32x4 w; w.x = cvt_pk_bf16(v0[0], v0[1]); w.y = cvt_pk_bf16(v0[2], v0[3]); w.z = cvt_pk_bf16(v1[0], v1[1]); w.w = cvt_pk_bf16(v1[2], v1[3]);
                        *(u32x4*)(P + (size_t)(row0 + ai * HALF + m * 16) * cfg::PLD + col) = w; }
            } else if (col < cfg::PIN) {
                const int g0 = col - cfg::PLD;
                const f32x4 b0 = *(const f32x4*)(gate_b + g0), b1 = *(const f32x4*)(gate_b + g0 + 4);
#pragma unroll
                for (int ai = 0; ai < 2; ++ai)
#pragma unroll
                    for (int m = 0; m < 4; ++m) { f32x4 v0 = acc[ai][bj][m][0] + b0, v1 = acc[ai][bj][m][1] + b1;
                        if (g0 >= 8) {
#pragma unroll
                            for (int e = 0; e < 4; ++e) { v0[e] = logsigmoid_e(v0[e]); v1[e] = logsigmoid_e(v1[e]); } }
                        float* gp = gates + (size_t)(row0 + ai * HALF + m * 16) * 16 + g0;
                        *(f32x4*)gp = v0; *(f32x4*)(gp + 4) = v1; }
            }
        }
    }
};
struct EpiOut {
    static constexpr bool PERM = true, AFTER_DRAIN = false;
    bf16_t* C;
    __device__ __forceinline__ void operator()(const f32x4 (&acc)[2][2][4][2], const Unit& u, int wr, int wc, int fr, int fq) const {
        const int row0 = u.pm * BM + wr * 64 + fr, col0 = u.pn * BM + wc * 32 + 8 * fq;
#pragma unroll
        for (int ai = 0; ai < 2; ++ai)
#pragma unroll
            for (int m = 0; m < 4; ++m) { bf16_t* rowp = C + (size_t)(row0 + ai * HALF + m * 16) * 1024 + col0;
#pragma unroll
                for (int bj = 0; bj < 2; ++bj) { const f32x4 v0 = acc[ai][bj][m][0], v1 = acc[ai][bj][m][1];
                    u32x4 w; w.x = cvt_pk_bf16(v0[0], v0[1]); w.y = cvt_pk_bf16(v0[2], v0[3]); w.z = cvt_pk_bf16(v1[0], v1[1]); w.w = cvt_pk_bf16(v1[2], v1[3]);
                    *(u32x4*)(rowp + bj * HALF) = w; } }
    }
};

template <class Epi, class Sched, bool ALIGN_EPI = false, bool SP2 = false>
__device__ __forceinline__ void gemm_phase(PG8_LAS unsigned char* lds, const Gemm g, const Sched& S, const Epi& E) {
    const int tid = threadIdx.x, wid = __builtin_amdgcn_readfirstlane(tid >> 6), lane = tid & 63, wr = wid >> 2, wc = wid & 3, fr = lane & 15, fq = lane >> 4;
    const int K = g.K, nt = K / BK;
    unsigned voffA[2], voffB[2];
#pragma unroll
    for (int i = 0; i < 2; ++i) { int R, C; stage_rc(tid * 16 + i * 8192, R, C); const int Rb = Epi::PERM ? ((R & ~31) + perm32(R & 31)) : R;
        voffA[i] = (unsigned)(R * K + C) * 2u; voffB[i] = (unsigned)(Rb * K + C) * 2u; }
    const size_t kstep = (size_t)(BK * 2);
    const size_t hstep = (size_t)HALF * K * 2;
    const size_t tstep = 2 * hstep;
    const unsigned ldsw = (unsigned)wid * 1024u;
    const int aoff = lds_byte(wr * 64 + fr, fq * 8), boff = lds_byte(wc * 32 + fr, fq * 8);
#define PG8_SA(b, h) (((b) * 2 + (h)) * HTB)
#define PG8_SB(b, h) ((4 + (b) * 2 + (h)) * HTB)
#define PG8_STAGE(bufoff, gbase, voff) do { _Pragma("unroll") for (int _i = 0; _i < 2; ++_i) \
        __builtin_amdgcn_global_load_lds((const unsigned*)((const char*)(gbase) + (voff)[_i]), (PG8_LAS unsigned*)(lds + (bufoff) + ldsw + _i * 8192), 16, 0, 0); } while (0)
#define PG8_LDA(dst, b, h) do { _Pragma("unroll") for (int m = 0; m < 4; ++m) _Pragma("unroll") for (int k = 0; k < 2; ++k) dst[m][k] = *(const PG8_LAS bf16x8*)(lds + PG8_SA(b, h) + aoff + m * 2048 + k * 1024); } while (0)
#define PG8_LDB(dst, b, h) do { _Pragma("unroll") for (int n = 0; n < 2; ++n) _Pragma("unroll") for (int k = 0; k < 2; ++k) dst[n][k] = *(const PG8_LAS bf16x8*)(lds + PG8_SB(b, h) + boff + n * 2048 + k * 1024); } while (0)
#define PG8_MMA(ai, bj, At, Bt) do { __builtin_amdgcn_s_setprio(1); _Pragma("unroll") for (int m = 0; m < 4; ++m) _Pragma("unroll") for (int n = 0; n < 2; ++n) _Pragma("unroll") for (int k = 0; k < 2; ++k) \
        acc[ai][bj][m][n] = __builtin_amdgcn_mfma_f32_16x16x32_bf16(Bt[n][k], At[m][k], acc[ai][bj][m][n], 0, 0, 0); __builtin_amdgcn_s_setprio(0); } while (0)
#define PG8_WAIT_V(n) asm volatile("s_waitcnt vmcnt(" #n ")" ::: "memory")
#define PG8_WAIT_L(n) asm volatile("s_waitcnt lgkmcnt(" #n ")" ::: "memory")
#define PG8_BAR __builtin_amdgcn_s_barrier()
#define PG8_SCHED __builtin_amdgcn_sched_barrier(0)
    Unit cur, nxt; int ui = 0;
    if (!S.next(0, cur)) return;
    f32x4 acc[2][2][4][2];
#pragma unroll
    for (int a = 0; a < 2; ++a)
#pragma unroll
        for (int b = 0; b < 2; ++b)
#pragma unroll
            for (int m = 0; m < 4; ++m)
#pragma unroll
                for (int n = 0; n < 2; ++n) acc[a][b][m][n] = (f32x4){0.f, 0.f, 0.f, 0.f};
    bf16x8 At[4][2], B0[2][2], B1[2][2];
    const char* cA = (const char*)g.A + (size_t)cur.pm * tstep; const char* cB = (const char*)g.Bt + (size_t)cur.pn * tstep;
    S.a_ready(cur);
    if constexpr (SP2) {
        PG8_STAGE(PG8_SB(0, 0), cB, voffB); PG8_STAGE(PG8_SB(0, 1), cB + hstep, voffB); PG8_STAGE(PG8_SA(0, 0), cA, voffA); PG8_STAGE(PG8_SA(0, 1), cA + hstep, voffA);
        if (wr == 1) PG8_BAR;
        PG8_WAIT_V(2); PG8_BAR;
        PG8_STAGE(PG8_SB(1, 0), cB + kstep, voffB); PG8_STAGE(PG8_SA(1, 0), cA + kstep, voffA); PG8_STAGE(PG8_SB(1, 1), cB + hstep + kstep, voffB);
        PG8_WAIT_V(6); PG8_BAR;
    } else {
        PG8_STAGE(PG8_SB(0, 0), cB, voffB); PG8_STAGE(PG8_SA(0, 0), cA, voffA); PG8_STAGE(PG8_SB(0, 1), cB + hstep, voffB); PG8_STAGE(PG8_SA(0, 1), cA + hstep, voffA);
        if (wr == 1) PG8_BAR;
        PG8_WAIT_V(4); PG8_BAR;
        PG8_STAGE(PG8_SB(1, 0), cB + kstep, voffB); PG8_STAGE(PG8_SA(1, 0), cA + kstep, voffA); PG8_STAGE(PG8_SB(1, 1), cB + hstep + kstep, voffB);
        PG8_WAIT_V(6); PG8_BAR;
    }
    for (;;) {
        const bool has_next = S.next(ui + 1, nxt);
        const char* nA = has_next ? (const char*)g.A + (size_t)nxt.pm * tstep : cA; const char* nB = has_next ? (const char*)g.Bt + (size_t)nxt.pn * tstep : cB;
        for (int t = 0; t < nt; t += 2) {
            const bool last = (t == nt - 2);
            const char* a1 = cA + (size_t)(t + 1) * kstep;
            const char* a2 = last ? nA : cA + (size_t)(t + 2) * kstep; const char* b2 = last ? nB : cB + (size_t)(t + 2) * kstep;
            const char* a3 = a2 + kstep; const char* b3 = b2 + kstep;
            if (last && has_next) S.a_ready(nxt);
            if constexpr (SP2) {
            PG8_LDB(B0, 0, 0); PG8_LDB(B1, 0, 1); PG8_SCHED; PG8_LDA(At, 0, 0); PG8_STAGE(PG8_SA(1, 1), a1 + hstep, voffA);
            PG8_WAIT_V(8); PG8_WAIT_L(0); PG8_BAR; PG8_MMA(0, 0, At, B0); PG8_MMA(0, 1, At, B1); PG8_BAR; PG8_SCHED;
            PG8_LDA(At, 0, 1); PG8_STAGE(PG8_SB(0, 0), b2, voffB); PG8_STAGE(PG8_SB(0, 1), b2 + hstep, voffB); PG8_STAGE(PG8_SA(0, 0), a2, voffA);
            PG8_WAIT_V(8); PG8_WAIT_L(0); PG8_BAR; PG8_MMA(1, 0, At, B0); PG8_MMA(1, 1, At, B1); PG8_BAR; PG8_SCHED;
            PG8_LDB(B0, 1, 0); PG8_LDB(B1, 1, 1); PG8_SCHED; PG8_LDA(At, 1, 0); PG8_STAGE(PG8_SA(0, 1), a2 + hstep, voffA);
            PG8_WAIT_V(8); PG8_WAIT_L(0); PG8_BAR; PG8_MMA(0, 0, At, B0); PG8_MMA(0, 1, At, B1); PG8_BAR; PG8_SCHED;
            PG8_LDA(At, 1, 1); PG8_STAGE(PG8_SB(1, 0), b3, voffB); PG8_STAGE(PG8_SB(1, 1), b3 + hstep, voffB); PG8_STAGE(PG8_SA(1, 0), a3, voffA);
            PG8_WAIT_V(8); PG8_WAIT_L(0); PG8_BAR; PG8_MMA(1, 0, At, B0); PG8_MMA(1, 1, At, B1); PG8_BAR; PG8_SCHED;
            } else {
            PG8_LDB(B0, 0, 0); PG8_SCHED; PG8_LDA(At, 0, 0); PG8_STAGE(PG8_SA(1, 1), a1 + hstep, voffA);
            PG8_WAIT_L(8); PG8_BAR; PG8_WAIT_L(0); PG8_MMA(0, 0, At, B0); PG8_BAR; PG8_SCHED;
            PG8_LDB(B1, 0, 1); PG8_STAGE(PG8_SB(0, 0), b2, voffB);
            PG8_BAR; PG8_WAIT_L(0); PG8_MMA(0, 1, At, B1); PG8_BAR;
            PG8_LDA(At, 0, 1); PG8_STAGE(PG8_SA(0, 0), a2, voffA);
            PG8_BAR; PG8_WAIT_L(0); PG8_MMA(1, 0, At, B0); PG8_BAR; PG8_SCHED;
            PG8_STAGE(PG8_SB(0, 1), b2 + hstep, voffB);
            PG8_WAIT_V(6); PG8_BAR; PG8_MMA(1, 1, At, B1); PG8_BAR;
            PG8_LDB(B0, 1, 0); PG8_SCHED; PG8_LDA(At, 1, 0); PG8_STAGE(PG8_SA(0, 1), a2 + hstep, voffA);
            PG8_WAIT_L(8); PG8_BAR; PG8_WAIT_L(0); PG8_MMA(0, 0, At, B0); PG8_BAR; PG8_SCHED;
            PG8_LDB(B1, 1, 1); PG8_STAGE(PG8_SB(1, 0), b3, voffB);
            PG8_BAR; PG8_WAIT_L(0); PG8_MMA(0, 1, At, B1); PG8_BAR;
            PG8_LDA(At, 1, 1); PG8_STAGE(PG8_SA(1, 0), a3, voffA);
            PG8_BAR; PG8_WAIT_L(0); PG8_MMA(1, 0, At, B0); PG8_BAR; PG8_SCHED;
            PG8_STAGE(PG8_SB(1, 1), b3 + hstep, voffB);
            PG8_WAIT_V(6); PG8_BAR; PG8_MMA(1, 1, At, B1); PG8_BAR;
            }
        }
        if constexpr (ALIGN_EPI) { if (wr == 0) PG8_BAR; }
        if constexpr (!Epi::AFTER_DRAIN) { E(acc, cur, wr, wc, fr, fq); S.done(cur); }
        if (!has_next) break;
#pragma unroll
        for (int a = 0; a < 2; ++a)
#pragma unroll
            for (int b = 0; b < 2; ++b)
#pragma unroll
                for (int m = 0; m < 4; ++m)
#pragma unroll
                    for (int n = 0; n < 2; ++n) acc[a][b][m][n] = (f32x4){0.f, 0.f, 0.f, 0.f};
        cur = nxt; cA = nA; cB = nB; ++ui;
        if constexpr (ALIGN_EPI) { if (wr == 1) PG8_BAR; }
    }
    PG8_WAIT_V(0);
    if constexpr (!ALIGN_EPI) { if (wr == 0) PG8_BAR; }
    PG8_BAR;
    if constexpr (Epi::AFTER_DRAIN) { E.fused(acc, cur, wr, wc, fr, fq, lds, wid, lane); S.done(cur); }
#undef PG8_SA
#undef PG8_SB
#undef PG8_STAGE
#undef PG8_LDA
#undef PG8_LDB
#undef PG8_MMA
#undef PG8_WAIT_V
#undef PG8_WAIT_L
#undef PG8_BAR
#undef PG8_SCHED
}
}
constexpr int RING_OFF = 0, RING_BYTES = 131072;
constexpr int LDSCTL_OFF = RING_BYTES, MISC_OFF = LDSCTL_OFF + 320;
constexpr int LDS_BYTES = 147456;
constexpr int CW_BAR = 4096;

#define GAS __attribute__((address_space(1)))
#define LAS __attribute__((address_space(3)))
typedef unsigned short bf16;
typedef unsigned v4u __attribute__((ext_vector_type(4)));
typedef float f32x4 __attribute__((ext_vector_type(4)));
typedef short bf16x8 __attribute__((ext_vector_type(8)));
typedef GAS unsigned gu32;
#define RLX_AGENT __ATOMIC_RELAXED, __HIP_MEMORY_SCOPE_AGENT
#define LDS_WAIT() asm volatile("s_waitcnt lgkmcnt(0)" ::: "memory")
#define VM_WAIT() asm volatile("s_waitcnt vmcnt(0)" ::: "memory")
__device__ __forceinline__ unsigned f2bfu(float f) { unsigned u = __builtin_bit_cast(unsigned, f); return (u + 0x7fffu + ((u >> 16) & 1u)) >> 16; }
__device__ __forceinline__ bf16 f2bf(float f) { return (bf16)f2bfu(f); }
typedef float f32x2_t __attribute__((ext_vector_type(2))); typedef __bf16 bf16x2_t __attribute__((ext_vector_type(2)));
__device__ __forceinline__ unsigned pk2(float lo, float hi) { f32x2_t v = {lo, hi}; bf16x2_t b = __builtin_convertvector(v, bf16x2_t); return __builtin_bit_cast(unsigned, b); }
__device__ __forceinline__ float xor16_max(float v) { auto r = __builtin_amdgcn_permlane16_swap(__float_as_uint(v), __float_as_uint(v), false, false); return fmaxf(__uint_as_float(r[0]), __uint_as_float(r[1])); }
__device__ __forceinline__ float xor32_max(float v) { auto r = __builtin_amdgcn_permlane32_swap(__float_as_uint(v), __float_as_uint(v), false, false); return fmaxf(__uint_as_float(r[0]), __uint_as_float(r[1])); }
__device__ __forceinline__ float xor16_sum(float v) { auto r = __builtin_amdgcn_permlane16_swap(__float_as_uint(v), __float_as_uint(v), false, false); return __uint_as_float(r[0]) + __uint_as_float(r[1]); }
__device__ __forceinline__ float xor32_sum(float v) { auto r = __builtin_amdgcn_permlane32_swap(__float_as_uint(v), __float_as_uint(v), false, false); return __uint_as_float(r[0]) + __uint_as_float(r[1]); }
__device__ __forceinline__ float bf2f(bf16 v) { return __uint_as_float(((unsigned)v) << 16); }
__device__ __forceinline__ float silu_f(float v) { return v * __builtin_amdgcn_rcpf(1.f + __expf(-v)); }
__device__ __forceinline__ float sigmoid_f(float v) { return __builtin_amdgcn_rcpf(1.f + __expf(-v)); }
#define DPP_ADD_(v, ctrl) ((v) + __int_as_float(__builtin_amdgcn_update_dpp(0, __float_as_int(v), (ctrl), 0xF, 0xF, false)))
__device__ __forceinline__ float group8_sum(float v) {
    v = DPP_ADD_(v, 0xB1); v = DPP_ADD_(v, 0x4E); v = DPP_ADD_(v, 0x141); return v; }
__device__ __forceinline__ float wave_sum(float v) {
    v = group8_sum(v); v = DPP_ADD_(v, 0x140);
    { auto r = __builtin_amdgcn_permlane16_swap(__float_as_uint(v), __float_as_uint(v), false, false); v = __uint_as_float(r[0]) + __uint_as_float(r[1]); }
    { auto r = __builtin_amdgcn_permlane32_swap(__float_as_uint(v), __float_as_uint(v), false, false); v = __uint_as_float(r[0]) + __uint_as_float(r[1]); }
    return v;
}
__device__ __forceinline__ float rdlane(float v, int i) { return __int_as_float(__builtin_amdgcn_readlane(__float_as_int(v), i)); }


#ifndef PROBE_T
#define PROBE_T 0
#endif
#define TS_LDS(F) ((volatile LAS unsigned long long*)((F).lds + LDSCTL_OFF + 128))
#define TS_START(F, id) do { if (PROBE_T == (id) && blockIdx.x == 0 && (F).tid == 0) TS_LDS(F)[1] = __builtin_amdgcn_s_memtime(); } while (0)
#define TS_STOP(F, id)  do { if (PROBE_T == (id) && blockIdx.x == 0 && (F).tid == 0) TS_LDS(F)[0] += __builtin_amdgcn_s_memtime() - TS_LDS(F)[1]; } while (0)
#define XB_TMO      128
#define XB_XCNT(j)  (256  + 64 * (j))
#define XB_XSUB(j)  (1280 + 64 * (j))
#define XB_XGEN(j)  (2304 + 64 * (j))
#define XB_TOP      3328
#define XB_TOPGEN   3392
#define XCD_BAR_WORDS 3456
#define XB_SPIN_CAP (1u << 18)

__device__ __forceinline__ unsigned xb_ld(unsigned* p)              { return __hip_atomic_load(p, __ATOMIC_RELAXED, __HIP_MEMORY_SCOPE_AGENT); }
__device__ __forceinline__ unsigned xb_add(unsigned* p, unsigned v) { return __hip_atomic_fetch_add(p, v, __ATOMIC_RELAXED, __HIP_MEMORY_SCOPE_AGENT); }
__device__ __forceinline__ unsigned xb_xcc_id() { return (unsigned)__builtin_amdgcn_s_getreg((3 << 11) | 20) & 0xFu; }
#define XB_SPIN(cond, bar) do { unsigned _sp = 0; while (cond) { __builtin_amdgcn_s_sleep(1); \
    if ((++_sp & 255u) == 0u) { if (xb_ld(&(bar)[XB_TMO])) break; if (_sp > XB_SPIN_CAP) { atomicAdd(&(bar)[XB_TMO], 1u); break; } } } } while (0)

struct XcdBarrier {
    unsigned* bar; unsigned x;
    volatile LAS unsigned* st;
};

__device__ __forceinline__ XcdBarrier xcd_barrier_post(unsigned* bar, volatile LAS unsigned* st) {
    XcdBarrier b; b.bar = bar; b.x = xb_xcc_id(); b.st = st;
    if (threadIdx.x == 0) (void)xb_add(&bar[XB_XCNT(b.x)], 1u);
    return b;
}
__device__ __forceinline__ void xcd_barrier_complete(unsigned* bar, unsigned x, unsigned& nloc, unsigned& nx) {
    const unsigned G = gridDim.x * gridDim.y * gridDim.z;
    unsigned sum, cnt, mine, sp = 0u;
    for (;;) {
        sum = 0u; cnt = 0u; mine = 0u;
#pragma unroll
        for (unsigned j = 0; j < 16; ++j) { const unsigned c = xb_ld(&bar[XB_XCNT(j)]); sum += c; cnt += (c > 0u) ? 1u : 0u; mine = (j == x) ? c : mine; }
        if (sum == G) break;
        __builtin_amdgcn_s_sleep(1);
        if ((++sp & 255u) == 0u) { if (xb_ld(&bar[XB_TMO])) break; if (sp > XB_SPIN_CAP) { atomicAdd(&bar[XB_TMO], 1u); break; } }
    }
    nloc = mine > 0u ? mine : 1u; nx = cnt > 0u ? cnt : 1u;
}

__device__ __forceinline__ void xcd_barrier(const XcdBarrier& b) {
    asm volatile("s_waitcnt vmcnt(0)" ::: "memory");
    __syncthreads();
    if (threadIdx.x == 0) {
        unsigned* bar = b.bar;
        __builtin_amdgcn_s_waitcnt(0);
        unsigned nloc = b.st[0], nx = b.st[1];
        if (nloc == 0u) { xcd_barrier_complete(bar, b.x, nloc, nx); b.st[0] = nloc; b.st[1] = nx; }
        const unsigned old = xb_add(&bar[XB_XSUB(b.x)], 1u);
        const unsigned gen = old / nloc;
        if (old + 1u == (gen + 1u) * nloc) {
            __builtin_amdgcn_fence(__ATOMIC_RELEASE, "agent");
            asm volatile("s_waitcnt vmcnt(0)" ::: "memory");
            const unsigned og = xb_add(&bar[XB_TOP], 1u);
            const unsigned tg = og / nx;
            if (og + 1u == (tg + 1u) * nx) xb_add(&bar[XB_TOPGEN], 1u);
            else XB_SPIN(xb_ld(&bar[XB_TOPGEN]) == tg, bar);
            __builtin_amdgcn_fence(__ATOMIC_ACQUIRE, "agent");
            xb_add(&bar[XB_XGEN(b.x)], 1u);
            asm volatile("s_waitcnt vmcnt(0)" ::: "memory");
        } else {
            XB_SPIN(xb_ld(&bar[XB_XGEN(b.x)]) == gen, bar);
            __builtin_amdgcn_fence(__ATOMIC_ACQUIRE, "agent");
            asm volatile("s_waitcnt vmcnt(0)" ::: "memory");
        }
    }
    __syncthreads();
}

struct Ctx {
    LAS unsigned char* lds; int tid, lane, wave, vcu, G, gw, NGW;
    const float *x, *c, *ctx, *c_ctx, *w_mod, *b_mod, *g_pre, *g_post, *w_in, *w_out, *hgrn_lb, *hgrn_gn, *gate_b, *mlstm_gn, *na_rpb;
    float* out; bf16 *wt_in, *wt_out, *hxy, *P; float *mod, *gates, *ctx1, *stm, *sth, *rope; bf16 *otm, *oth, *UX;
};

__device__ __forceinline__ void transpose_item(const float* W, int N, int Nnew, bool remap, bf16* WT, LAS float* scr, int item, int lane) {
    const int nblk = Nnew / 32, kb = item / nblk, nb = item % nblk, k0 = 64 * kb, n0 = 32 * nb;
    const int rg = lane >> 3, c4 = (lane & 7) * 4, nn = n0 + c4;
    int no = nn; if (remap) no = nn < 3200 ? nn : (nn < 4736 ? nn + 16 : (nn < 4752 ? 3200 + nn - 4736 : -1));
    f32x4 v[8];
#pragma unroll
    for (int j = 0; j < 8; ++j) v[j] = no >= 0 ? *(const f32x4*)(W + (size_t)(k0 + 8 * j + rg) * N + no) : (f32x4){0.f, 0.f, 0.f, 0.f};
#pragma unroll
    for (int j = 0; j < 8; ++j) { LAS float* d = scr + (8 * j + rg) * 33 + c4; d[0] = v[j][0]; d[1] = v[j][1]; d[2] = v[j][2]; d[3] = v[j][3]; }
    LDS_WAIT(); asm volatile("" ::: "memory");
    const int c = lane & 7;
#pragma unroll
    for (int j = 0; j < 4; ++j) { const int n = (lane >> 3) + 8 * j; const LAS float* s = scr + (8 * c) * 33 + n;
        v4u o; o.x = pk2(s[0 * 33], s[1 * 33]); o.y = pk2(s[2 * 33], s[3 * 33]); o.z = pk2(s[4 * 33], s[5 * 33]); o.w = pk2(s[6 * 33], s[7 * 33]);
        *(GAS v4u*)(WT + (size_t)(n0 + n) * 1024 + k0 + 8 * c) = o; }
    LDS_WAIT(); asm volatile("" ::: "memory");
}
__device__ __forceinline__ void phase_p0(const Ctx& F) {
    if (F.vcu < 96) {
        LAS float* tab = (LAS float*)(F.lds);
        LAS float* part = (LAS float*)(F.lds + 36864);
        for (int i = F.tid; i < 9 * 1024; i += 512) { const int r = i >> 10, k = i & 1023; const float v = r < 8 ? F.c[r * 1024 + k] : F.c_ctx[k]; tab[i] = silu_f(v); }
        __syncthreads();
        for (int it = F.vcu; it < 96; it += F.G) {
            const int l = it / 48, jb = it % 48, col = jb * 64 + F.lane;
            float acc[9];
#pragma unroll
            for (int r = 0; r < 9; ++r) acc[r] = 0.f;
            const float* wp = F.w_mod + ((size_t)l * 1024 + F.wave * 128) * 3072 + col;
            for (int kb = 0; kb < 128; kb += 32) {
                float wv[32];
#pragma unroll
                for (int k = 0; k < 32; ++k) wv[k] = wp[(size_t)(kb + k) * 3072];
#pragma unroll
                for (int k = 0; k < 32; ++k)
#pragma unroll
                    for (int r = 0; r < 9; ++r) acc[r] += tab[r * 1024 + F.wave * 128 + kb + k] * wv[k]; }
#pragma unroll
            for (int r = 0; r < 9; ++r) part[(F.wave * 9 + r) * 64 + F.lane] = acc[r];
            __syncthreads();
            for (int i = F.tid; i < 9 * 64; i += 512) { const int r = i >> 6, j = i & 63; float s = 0.f;
#pragma unroll
                for (int w = 0; w < 8; ++w) s += part[(w * 9 + r) * 64 + j];
                F.mod[((size_t)l * 9 + r) * 3072 + jb * 64 + j] = s + F.b_mod[l * 3072 + jb * 64 + j]; }
            __syncthreads();
        }
    }
    if (F.vcu == 96 % F.G) for (int i = F.tid; i < 64 * 24; i += 512) { const int pos = i / 24, f = i % 24; const float ang = (float)pos * expf(-(float)(2 * f) * (1.f / 48.f) * 9.210340371976184f); F.rope[2 * i] = cosf(ang); F.rope[2 * i + 1] = sinf(ang); }
    __syncthreads();
    LAS float* scr = (LAS float*)(F.lds + F.wave * 16384);
    constexpr int I_IN = 16 * (NPAD / 32);
    const int gwr = F.NGW - 1 - F.gw;
    for (int it = gwr; it < I_IN; it += F.NGW) transpose_item(F.w_in, PIN, NPAD, true, F.wt_in, scr, it, F.lane);
}
__device__ __forceinline__ void phase_p1_transposes(const Ctx& F) {
    LAS float* scr = (LAS float*)(F.lds + F.wave * 16384);
    constexpr int I_IN = 16 * (NPAD / 32), I_OUT = 16 * 32;
    for (int it = F.gw; it < I_IN + 2 * I_OUT; it += F.NGW) {
        if (it < I_OUT) transpose_item(F.w_out, 1024, 1024, false, F.wt_out, scr, it, F.lane);
        else if (it < I_OUT + I_IN) transpose_item(F.w_in + (size_t)1024 * PIN, PIN, NPAD, true, F.wt_in + (size_t)NPAD * 1024, scr, it - I_OUT, F.lane);
        else transpose_item(F.w_out + (size_t)1024 * 1024, 1024, 1024, false, F.wt_out + (size_t)1024 * 1024, scr, it - I_OUT - I_IN, F.lane);
    }
}

struct RowPar { float4 g[4], a[4], b[4]; };
__device__ __forceinline__ void load_par(RowPar& p, const float* g, const float* a, const float* b, int lane) {
#pragma unroll
    for (int j = 0; j < 4; ++j) { const int d = 4 * (lane + 64 * j); p.g[j] = *(const float4*)(g + d); p.a[j] = *(const float4*)(a + d); p.b[j] = *(const float4*)(b + d); }
}
__device__ __forceinline__ void prenorm_store(const float4 (&v)[4], float ss, const RowPar& p, bf16* dst, int lane) {
    const float rinv = __builtin_amdgcn_rsqf(ss * (1.f / 1024.f) + EPS);
#pragma unroll
    for (int j = 0; j < 4; ++j) {
        const int d = 4 * (lane + 64 * j);
        const float o0 = v[j].x * rinv * p.g[j].x * (1.f + p.a[j].x) + p.b[j].x, o1 = v[j].y * rinv * p.g[j].y * (1.f + p.a[j].y) + p.b[j].y;
        const float o2 = v[j].z * rinv * p.g[j].z * (1.f + p.a[j].z) + p.b[j].z, o3 = v[j].w * rinv * p.g[j].w * (1.f + p.a[j].w) + p.b[j].w;
        uint2 w; w.x = pk2(o0, o1); w.y = pk2(o2, o3);
        *(uint2*)(dst + d) = w;
    }
}
__device__ __forceinline__ void phase_prenorm0(const Ctx& F) {
    auto rowsrc = [&](int m) -> const float* { return m < MX ? F.x + (size_t)m * 1024 : F.ctx + (size_t)(m - MX) * 1024; };
    const int nrow = (M + F.NGW - 1) / F.NGW, m0 = F.gw * nrow, m1 = min(m0 + nrow, M);
    if (m0 >= m1) return;
    float4 nv[4];
#pragma unroll
    for (int j = 0; j < 4; ++j) nv[j] = ((const float4*)rowsrc(m0))[F.lane + 64 * j];
    RowPar p; int rcur = -1;
    for (int m = m0; m < m1; ++m) {
        const int r = m < MX ? m / S : 8;
        if (r != rcur) { const float* mod_r = F.mod + (size_t)r * 3072; load_par(p, F.g_pre, mod_r + 1024, mod_r, F.lane); rcur = r; }
        float4 v[4];
#pragma unroll
        for (int j = 0; j < 4; ++j) v[j] = nv[j];
        if (m + 1 < m1) {
#pragma unroll
            for (int j = 0; j < 4; ++j) nv[j] = ((const float4*)rowsrc(m + 1))[F.lane + 64 * j]; }
        float ss = 0.f;
#pragma unroll
        for (int j = 0; j < 4; ++j) ss += v[j].x * v[j].x + v[j].y * v[j].y + v[j].z * v[j].z + v[j].w * v[j].w;
        ss = wave_sum(ss);
        prenorm_store(v, ss, p, F.hxy + (size_t)m * 1024, F.lane);
    }
}
__device__ __forceinline__ void phase_post(const Ctx& F, int l) {
    const int Ml = l == 0 ? M : MX;
    const float* mod_l = F.mod + (size_t)l * 9 * 3072; const float* g_post_l = F.g_post + l * 1024;
    auto rowsrc = [&](int m) -> const float* { return m < MX ? (l == 0 ? F.x : F.out) + (size_t)m * 1024 : F.ctx + (size_t)(m - MX) * 1024; };
    const int nrow = (Ml + F.NGW - 1) / F.NGW, m0 = F.gw * nrow, m1 = min(m0 + nrow, Ml);
    if (m0 >= m1) return;
    float4 nx[4]; uint2 nu[4];
#pragma unroll
    for (int j = 0; j < 4; ++j) { nx[j] = ((const float4*)rowsrc(m0))[F.lane + 64 * j]; nu[j] = ((const uint2*)(F.UX + (size_t)m0 * 1024))[F.lane + 64 * j]; }
    float4 pg[4], pt[4]; RowPar p2; int rcur = -1;
#pragma unroll
    for (int j = 0; j < 4; ++j) pg[j] = *(const float4*)(g_post_l + 4 * (F.lane + 64 * j));
    for (int m = m0; m < m1; ++m) {
        float* dst; int r;
        if (m < MX) { dst = F.out + (size_t)m * 1024; r = m / S; } else { dst = F.ctx1 + (size_t)(m - MX) * 1024; r = 8; }
        if (r != rcur) {
#pragma unroll
            for (int j = 0; j < 4; ++j) pt[j] = *(const float4*)(mod_l + r * 3072 + 2048 + 4 * (F.lane + 64 * j));
            if (l == 0) load_par(p2, F.g_pre + 1024, F.mod + (size_t)(9 + r) * 3072 + 1024, F.mod + (size_t)(9 + r) * 3072, F.lane);
            rcur = r; }
        float4 xr[4], u[4]; float ss = 0.f;
#pragma unroll
        for (int j = 0; j < 4; ++j) { xr[j] = nx[j]; const uint2 w = nu[j];
            u[j].x = __uint_as_float(w.x << 16); u[j].y = __uint_as_float(w.x & 0xffff0000u); u[j].z = __uint_as_float(w.y << 16); u[j].w = __uint_as_float(w.y & 0xffff0000u);
            ss += u[j].x * u[j].x + u[j].y * u[j].y + u[j].z * u[j].z + u[j].w * u[j].w; }
        if (m + 1 < m1) {
#pragma unroll
            for (int j = 0; j < 4; ++j) { nx[j] = ((const float4*)rowsrc(m + 1))[F.lane + 64 * j]; nu[j] = ((const uint2*)(F.UX + (size_t)(m + 1) * 1024))[F.lane + 64 * j]; } }
        ss = wave_sum(ss);
        const float rinv = __builtin_amdgcn_rsqf(ss * (1.f / 1024.f) + EPS);
        float ss2 = 0.f;
#pragma unroll
        for (int j = 0; j < 4; ++j) {
            const int d = 4 * (F.lane + 64 * j);
            const float4 g = pg[j], t = pt[j], xv = xr[j];
            float4 o; o.x = xv.x + t.x * (u[j].x * rinv * g.x); o.y = xv.y + t.y * (u[j].y * rinv * g.y); o.z = xv.z + t.z * (u[j].z * rinv * g.z); o.w = xv.w + t.w * (u[j].w * rinv * g.w);
            *(float4*)(dst + d) = o; u[j] = o; ss2 += o.x * o.x + o.y * o.y + o.z * o.z + o.w * o.w;
        }
        if (l == 0) { ss2 = wave_sum(ss2); prenorm_store(u, ss2, p2, F.hxy + (size_t)m * 1024, F.lane); }
    }
}


typedef short s16x4 __attribute__((ext_vector_type(4)));
typedef short v4i16_t __attribute__((ext_vector_type(4)));
__device__ __forceinline__ s16x4 tr_read(const LAS bf16* p) { return __builtin_bit_cast(s16x4, __builtin_amdgcn_ds_read_tr16_b64_v4i16((LAS v4i16_t*)p)); }
__device__ __forceinline__ bf16x8 tr_frag(const LAS bf16* T, int stride, int rowA, int rowB, int col0, int lane) {
    const int q = (lane >> 2) & 3, p = lane & 3;
    const s16x4 lo = tr_read(T + (rowA + q) * stride + col0 + 4 * p), hi = tr_read(T + (rowB + q) * stride + col0 + 4 * p);
    return (bf16x8){lo[0], lo[1], lo[2], lo[3], hi[0], hi[1], hi[2], hi[3]};
}
__device__ __forceinline__ bf16x8 rm_frag(const LAS bf16* T, int stride, int row, int k0) { return *(const LAS bf16x8*)(T + row * stride + k0); }
__device__ __forceinline__ f32x4 mfma16(bf16x8 a, bf16x8 b, f32x4 c) { return __builtin_amdgcn_mfma_f32_16x16x32_bf16(a, b, c, 0, 0, 0); }
typedef unsigned v2u __attribute__((ext_vector_type(2)));
typedef float f32x2 __attribute__((ext_vector_type(2)));
__device__ __forceinline__ void unpack8(const v4u w, float* f) {
    f[0] = __uint_as_float(w.x << 16); f[1] = __uint_as_float(w.x & 0xffff0000u); f[2] = __uint_as_float(w.y << 16); f[3] = __uint_as_float(w.y & 0xffff0000u);
    f[4] = __uint_as_float(w.z << 16); f[5] = __uint_as_float(w.z & 0xffff0000u); f[6] = __uint_as_float(w.w << 16); f[7] = __uint_as_float(w.w & 0xffff0000u);
}
__device__ __forceinline__ v4u pack8(const float* f) { v4u w; w.x = pk2(f[0], f[1]); w.y = pk2(f[2], f[3]); w.z = pk2(f[4], f[5]); w.w = pk2(f[6], f[7]); return w; }

__device__ __forceinline__ float wave_scan_incl(float x) {
    int v = __float_as_int(x);
#define DPP_ADD(ctrl, rmask) v = __float_as_int(__int_as_float(v) + __int_as_float(__builtin_amdgcn_update_dpp(0, v, ctrl, rmask, 0xF, false)))
    DPP_ADD(0x111, 0xF); DPP_ADD(0x112, 0xF); DPP_ADD(0x114, 0xF); DPP_ADD(0x118, 0xF); DPP_ADD(0x142, 0xA); DPP_ADD(0x143, 0xC);
#undef DPP_ADD
    return __int_as_float(v);
}
#define LDS_FENCE() asm volatile("" ::: "memory")
namespace ml {
constexpr int QSTR = 104, VSTR = 120;
constexpr int OFF_QS = 0, OFF_KS = OFF_QS + 64 * QSTR * 2, OFF_VS = OFF_KS + 64 * QSTR * 2, OFF_CT = OFF_VS + 64 * VSTR * 2;
constexpr int OFF_HT = OFF_CT + 2 * 112 * QSTR * 2, OFF_DEN = OFF_HT + 64 * 100 * 4, OFF_ROPE = OFF_DEN + 256, OFF_END = OFF_ROPE + 64 * 24 * 8;
static_assert(OFF_END <= RING_BYTES && 6 * 7 * 64 * 16 <= OFF_HT, "mlstm LDS");
constexpr int ST_FLOATS = 96 * 112 + 16;
}
constexpr int NSEG = 4, SEGTOK = S / NSEG, SEGCH = SEGTOK / 64;
struct MlJob { int b, h, isctx, t0, nchunk; };

__device__ __forceinline__ void mlstm_dir(const Ctx& F, int l, const MlJob jb, int dir, int fold_r, int emit_slot, int mode, bf16* otmp, float* ST) {
    using namespace ml;
    int tid_ = F.tid; asm volatile("" : "+v"(tid_));
    const int w = __builtin_amdgcn_readfirstlane(tid_ >> 6);
    const bool tsel = (mode != 0) && !jb.isctx && l == 0;
    if (tsel) TS_START(F, 10);
    LAS bf16* QS = (LAS bf16*)(F.lds + OFF_QS); LAS bf16* KS = (LAS bf16*)(F.lds + OFF_KS); LAS bf16* VS = (LAS bf16*)(F.lds + OFF_VS);
    LAS bf16* CT0 = (LAS bf16*)(F.lds + OFF_CT); LAS float* HT = (LAS float*)(F.lds + OFF_HT); LAS float* DEN = (LAS float*)(F.lds + OFF_DEN);
    const LAS f32x2* ROPE = (const LAS f32x2*)(F.lds + OFF_ROPE);
    const int rowbase = jb.isctx ? MX + jb.b * CTX : jb.b * S;
    const int h = jb.h; const bf16* P = F.P;
    float* STd = ST + (size_t)(((jb.b * 4 + h) * 2 + dir) * 8) * ST_FLOATS;
    f32x4 Cst[7];
#pragma unroll
    for (int et = 0; et < 7; ++et) Cst[et] = (f32x4){0.f, 0.f, 0.f, 0.f};
    if (fold_r >= 0) {
        LAS f32x4* FOLD = (LAS f32x4*)(F.lds + OFF_QS);
        float wk[8];
        { float bs[8]; bs[0] = 0.f;
#pragma unroll
          for (int k = 1; k < NSEG; ++k) bs[k] = STd[(size_t)k * ST_FLOATS + 96 * 112];
          float run = 1.f;
#pragma unroll
          for (int k = NSEG - 1; k >= 0; --k) { wk[k] = (k <= fold_r) ? run : 0.f; run = (k >= 1 && k <= fold_r) ? run * __expf(bs[k]) : run; } }
#pragma unroll 2
        for (int p = tid_; p < 6 * 7 * 64; p += 512) {
            f32x4 v[8];
#pragma unroll
            for (int k = 0; k < NSEG; ++k) v[k] = *(const f32x4*)(STd + (size_t)k * ST_FLOATS + 4 * p);
            f32x4 acc = v[0] * wk[0];
#pragma unroll
            for (int k = 1; k < NSEG; ++k) acc += v[k] * wk[k];
            FOLD[p] = acc;
        }
        __syncthreads();
        if (w < 6) {
#pragma unroll
            for (int et = 0; et < 7; ++et) Cst[et] = FOLD[(w * 7 + et) * 64 + (tid_ & 63)];
        }
        __syncthreads();
    }
    asm volatile("" : "+v"(tid_));
    const int tid = tid_, lane = tid & 63, g = lane >> 4, c = lane & 15;
    float Btot = 0.f;
    for (int i = tid; i < 64 * 16; i += 512) { const int s = i >> 4, e = 96 + (i & 15); VS[s * VSTR + e] = (e == 96) ? (bf16)0x3F80 : (bf16)0; }
    if (w < 6) {
#pragma unroll
        for (int et = 0; et < 7; ++et) { v2u v; v.x = pk2(Cst[et][0], Cst[et][1]); v.y = pk2(Cst[et][2], Cst[et][3]); *(LAS v2u*)(CT0 + (16 * et + c) * QSTR + 16 * w + 4 * g) = v; }
    }
    const bool hasqk = tid < 384; const int qk_tok = tid / 6, qk_pi = tid % 6, qk_part = qk_pi / 3, qk_pp = qk_pi % 3, qk_d0 = 48 * qk_part + 8 * qk_pp;
    const int v1_tok = tid / 12, v1_pc = tid % 12; const bool hasv2 = tid < 256; const int v2_tok = (512 + tid) / 12, v2_pc = (512 + tid) % 12;
    struct LoadSet { v4u q0, q1, k0, k1, v1, v2; float ig, lf; };
    LoadSet LA;
    v2u ft[3], fo[3], fz[3];
    const int fi_i = tid >> 3, fi_e0 = 12 * (tid & 7);
#pragma unroll
    for (int q4 = 0; q4 < 3; ++q4) { ft[q4] = (v2u){0u, 0u}; fo[q4] = (v2u){0u, 0u}; fz[q4] = (v2u){0u, 0u}; }
    LA.q0 = LA.q1 = LA.k0 = LA.k1 = LA.v1 = LA.v2 = (v4u){0u, 0u, 0u, 0u}; LA.ig = LA.lf = 0.f;
    auto tok_of = [&](int ci, int i) -> int { return dir == 0 ? jb.t0 + 64 * ci + i : jb.t0 + 64 * (jb.nchunk - 1 - ci) + (63 - i); };
    auto issue_loads = [&](LoadSet& L, int ci) {
        if (hasqk) { const bf16* pr = P + (size_t)(rowbase + tok_of(ci, qk_tok)) * PLD + h * 96 + qk_d0;
            if (mode != 0) { L.q0 = *(const v4u*)(pr + B_Q); L.q1 = *(const v4u*)(pr + B_Q + 24); }
            L.k0 = *(const v4u*)(pr + B_K); L.k1 = *(const v4u*)(pr + B_K + 24); }
        L.v1 = *(const v4u*)(P + (size_t)(rowbase + tok_of(ci, v1_tok)) * PLD + B_V + h * 96 + 8 * v1_pc);
        if (hasv2) L.v2 = *(const v4u*)(P + (size_t)(rowbase + tok_of(ci, v2_tok)) * PLD + B_V + h * 96 + 8 * v2_pc);
        const float* gp = F.gates + (size_t)(rowbase + tok_of(ci, lane)) * 16 + dir * 4 + h; L.ig = gp[0]; L.lf = gp[8];
    };
    auto issue_fin = [&](int ci) {
        const int m = rowbase + tok_of(ci, fi_i); const bf16* tp = otmp + (size_t)m * 384 + h * 96 + fi_e0; const bf16* pr = P + (size_t)m * PLD + h * 96 + fi_e0;
#pragma unroll
        for (int q4 = 0; q4 < 3; ++q4) { ft[q4] = *(const v2u*)(tp + 4 * q4); fo[q4] = *(const v2u*)(pr + B_O + 4 * q4); fz[q4] = *(const v2u*)(pr + B_Z + 4 * q4); }
    };
    auto finalize = [&](int ci) {
            const int i = tid >> 3, sub = tid & 7, e0 = 12 * sub; const int m = rowbase + tok_of(ci, i);
            float hv[12]; const float rden = __builtin_amdgcn_rcpf(fmaxf(fabsf(DEN[i]), 1.f));
#pragma unroll
            for (int q4 = 0; q4 < 3; ++q4) { const f32x4 v = *(const LAS f32x4*)(HT + i * 100 + e0 + 4 * q4); hv[4 * q4] = v[0] * rden; hv[4 * q4 + 1] = v[1] * rden; hv[4 * q4 + 2] = v[2] * rden; hv[4 * q4 + 3] = v[3] * rden; }
            bf16* tp = otmp + (size_t)m * 384 + h * 96 + e0;
            if (mode == 1) {
#pragma unroll
                for (int q4 = 0; q4 < 3; ++q4) { v2u v; v.x = pk2(hv[4 * q4], hv[4 * q4 + 1]); v.y = pk2(hv[4 * q4 + 2], hv[4 * q4 + 3]); *(v2u*)(tp + 4 * q4) = v; }
            } else {
                float ss = 0.f;
#pragma unroll
                for (int q4 = 0; q4 < 3; ++q4) { const v2u v = ft[q4];
                    hv[4 * q4] += __uint_as_float(v.x << 16); hv[4 * q4 + 1] += __uint_as_float(v.x & 0xffff0000u); hv[4 * q4 + 2] += __uint_as_float(v.y << 16); hv[4 * q4 + 3] += __uint_as_float(v.y & 0xffff0000u); }
#pragma unroll
                for (int e = 0; e < 12; ++e) ss += hv[e] * hv[e];
                ss = group8_sum(ss);
                const float rinv = __builtin_amdgcn_rsqf(ss * (1.f / 96.f) + EPS);
                bf16* yp = F.hxy + (size_t)m * 1024 + 256 + h * 96 + e0; const float* gnv = F.mlstm_gn + l * 384 + h * 96 + e0;
#pragma unroll
                for (int q4 = 0; q4 < 3; ++q4) { const v2u ov = fo[q4], zv = fz[q4];
                    const float og[4] = {__uint_as_float(ov.x << 16), __uint_as_float(ov.x & 0xffff0000u), __uint_as_float(ov.y << 16), __uint_as_float(ov.y & 0xffff0000u)};
                    const float zg[4] = {__uint_as_float(zv.x << 16), __uint_as_float(zv.x & 0xffff0000u), __uint_as_float(zv.y << 16), __uint_as_float(zv.y & 0xffff0000u)};
                    float o[4];
#pragma unroll
                    for (int e = 0; e < 4; ++e) o[e] = og[e] * (hv[4 * q4 + e] * rinv * gnv[4 * q4 + e]) * zg[e];
                    v2u v; v.x = pk2(o[0], o[1]); v.y = pk2(o[2], o[3]); *(v2u*)(yp + 4 * q4) = v; }
            }
    };
    struct Packed { v4u k0, k1, q0, q1, v1, v2; float bL, ebL; };
    auto stage_math = [&](LoadSet& L, int ci, Packed& K) {
        const float bcs = wave_scan_incl(L.lf);
        const float qsc = __expf(bcs), ksc = __expf(L.ig - bcs);
        K.bL = rdlane(bcs, 63); K.ebL = __expf(K.bL);
        if (hasqk) {
            const float ks_t = __shfl(ksc, qk_tok), qs_t = __shfl(qsc, qk_tok);
            float cs[8], sn[8];
            if (!jb.isctx) { const int t = tok_of(ci, qk_tok); const int pos = qk_part ? (t & 63) : (t >> 6);
#pragma unroll
                for (int e = 0; e < 8; ++e) { const f32x2 v = ROPE[pos * 24 + 8 * qk_pp + e]; cs[e] = v[0]; sn[e] = v[1]; } }
            else {
#pragma unroll
                for (int e = 0; e < 8; ++e) { cs[e] = 1.f; sn[e] = 0.f; } }
            float a[8], b2[8], o0[8], o1[8];
            unpack8(L.k0, a); unpack8(L.k1, b2);
#pragma unroll
            for (int e = 0; e < 8; ++e) { o0[e] = (a[e] * cs[e] - b2[e] * sn[e]) * ks_t; o1[e] = (b2[e] * cs[e] + a[e] * sn[e]) * ks_t; }
            K.k0 = pack8(o0); K.k1 = pack8(o1);
            if (mode != 0) {
                unpack8(L.q0, a); unpack8(L.q1, b2);
#pragma unroll
                for (int e = 0; e < 8; ++e) { o0[e] = (a[e] * cs[e] - b2[e] * sn[e]) * qs_t; o1[e] = (b2[e] * cs[e] + a[e] * sn[e]) * qs_t; }
                K.q0 = pack8(o0); K.q1 = pack8(o1);
            }
        } else { (void)__shfl(ksc, 0); (void)__shfl(qsc, 0); }
        K.v1 = L.v1; K.v2 = L.v2;
    };
    auto stage_write = [&](const Packed& K) {
        if (hasqk) {
            *(LAS v4u*)(KS + qk_tok * QSTR + qk_d0) = K.k0; *(LAS v4u*)(KS + qk_tok * QSTR + qk_d0 + 24) = K.k1;
            if (mode != 0) { *(LAS v4u*)(QS + qk_tok * QSTR + qk_d0) = K.q0; *(LAS v4u*)(QS + qk_tok * QSTR + qk_d0 + 24) = K.q1; }
        }
        *(LAS v4u*)(VS + v1_tok * VSTR + 8 * v1_pc) = K.v1;
        if (hasv2) *(LAS v4u*)(VS + v2_tok * VSTR + 8 * v2_pc) = K.v2;
    };
    Packed PK; PK.k0 = PK.k1 = PK.q0 = PK.q1 = PK.v1 = PK.v2 = (v4u){0u, 0u, 0u, 0u}; PK.bL = 0.f; PK.ebL = 1.f;
    issue_loads(LA, 0);
    __syncthreads();
    stage_math(LA, 0, PK); stage_write(PK);
    if (jb.nchunk > 1) issue_loads(LA, 1);
    float bL = PK.bL, ebL = PK.ebL;
    __syncthreads();
    if (tsel) TS_STOP(F, 10);
    auto chunk_step = [&](LoadSet& Lnext, int ci) {
        LAS bf16* CTc = CT0 + (ci & 1) * 112 * QSTR; LAS bf16* CTn = CT0 + ((ci + 1) & 1) * 112 * QSTR;
        if (mode == 2) issue_fin(ci);
        if (ci + 1 < jb.nchunk) { stage_math(Lnext, ci + 1, PK); if (ci + 2 < jb.nchunk) issue_loads(Lnext, ci + 2); }
        if (mode != 0) {
            const int tt = w & 3, jh = w >> 2;
            bf16x8 qf[3], kf[4][3];
#pragma unroll
            for (int ks = 0; ks < 3; ++ks) qf[ks] = rm_frag(QS, QSTR, 16 * tt + c, 32 * ks + 8 * g);
#pragma unroll
            for (int ss = 0; ss < 4; ++ss) if (ss <= tt) {
#pragma unroll
                for (int ks = 0; ks < 3; ++ks) kf[ss][ks] = rm_frag(KS, QSTR, 16 * ss + c, 32 * ks + 8 * g); }
            LDS_FENCE();
            f32x4 st[4];
#pragma unroll
            for (int ss = 0; ss < 4; ++ss) { st[ss] = (f32x4){0.f, 0.f, 0.f, 0.f};
                if (ss <= tt) {
#pragma unroll
                    for (int ks = 0; ks < 3; ++ks) st[ss] = mfma16(kf[ss][ks], qf[ks], st[ss]);
                    if (ss == tt) {
#pragma unroll
                        for (int r = 0; r < 4; ++r) if (4 * g + r > c) st[ss][r] = 0.f; }
                } }
            bf16x8 pf[2];
#pragma unroll
            for (int kk = 0; kk < 2; ++kk) { const unsigned u0 = pk2(st[2 * kk][0], st[2 * kk][1]), u1 = pk2(st[2 * kk][2], st[2 * kk][3]), u2 = pk2(st[2 * kk + 1][0], st[2 * kk + 1][1]), u3 = pk2(st[2 * kk + 1][2], st[2 * kk + 1][3]);
                pf[kk] = __builtin_bit_cast(bf16x8, (v4u){u0, u1, u2, u3}); }
#pragma unroll
            for (int eb = 0; eb < 4; eb += 2) {
                bf16x8 vf[2][2], cf[2][3];
#pragma unroll
                for (int e2 = 0; e2 < 2; ++e2) { const int et = 4 * jh + eb + e2;
                    if (et < 7) {
#pragma unroll
                        for (int kk = 0; kk < 2; ++kk) if (2 * kk <= tt) vf[e2][kk] = tr_frag(VS, VSTR, 32 * kk + 4 * g, 32 * kk + 16 + 4 * g, 16 * et, lane);
#pragma unroll
                        for (int ks = 0; ks < 3; ++ks) cf[e2][ks] = rm_frag(CTc, QSTR, 16 * et + c, 32 * ks + 8 * g); } }
                LDS_FENCE();
#pragma unroll
                for (int e2 = 0; e2 < 2; ++e2) { const int et = 4 * jh + eb + e2;
                    if (et < 7) {
                        f32x4 acc = (f32x4){0.f, 0.f, 0.f, 0.f};
#pragma unroll
                        for (int kk = 0; kk < 2; ++kk) if (2 * kk <= tt) acc = mfma16(vf[e2][kk], pf[kk], acc);
#pragma unroll
                        for (int ks = 0; ks < 3; ++ks) acc = mfma16(cf[e2][ks], qf[ks], acc);
                        if (et < 6) *(LAS f32x4*)(HT + (16 * tt + c) * 100 + 16 * et + 4 * g) = acc;
                        else if (g == 0) DEN[16 * tt + c] = acc[0];
                    } }
            }
        }
        if (w < 6) {
#pragma unroll
            for (int kk = 0; kk < 2; ++kk) {
                bf16x8 vf[7]; const bf16x8 af = tr_frag(KS, QSTR, 32 * kk + 8 * g, 32 * kk + 8 * g + 4, 16 * w, lane);
#pragma unroll
                for (int et = 0; et < 7; ++et) vf[et] = tr_frag(VS, VSTR, 32 * kk + 8 * g, 32 * kk + 8 * g + 4, 16 * et, lane);
                LDS_FENCE();
#pragma unroll
                for (int et = 0; et < 7; ++et) Cst[et] = mfma16(af, vf[et], Cst[et]);
            }
#pragma unroll
            for (int et = 0; et < 7; ++et) { Cst[et] = Cst[et] * ebL;
                if (mode != 0) { v2u v; v.x = pk2(Cst[et][0], Cst[et][1]); v.y = pk2(Cst[et][2], Cst[et][3]); *(LAS v2u*)(CTn + (16 * et + c) * QSTR + 16 * w + 4 * g) = v; } }
        }
        Btot += bL;
        __syncthreads();
        if (ci + 1 < jb.nchunk) { stage_write(PK); bL = PK.bL; ebL = PK.ebL; }
        if (mode != 0) finalize(ci);
        __syncthreads();
    };
    for (int ci = 0; ci < jb.nchunk; ++ci) chunk_step(LA, ci);
    if (emit_slot >= 0 && w < 6) {
        float* sl = STd + (size_t)emit_slot * ST_FLOATS;
#pragma unroll
        for (int et = 0; et < 7; ++et) *(f32x4*)(sl + ((w * 7 + et) * 64 + lane) * 4) = Cst[et];
        if (w == 0 && lane == 0) sl[96 * 112] = Btot;
    }
    __syncthreads();
}
__device__ __forceinline__ void mlstm_load_rope(const Ctx& F, const float* rope_tab) {
    LAS f32x2* ROPE = (LAS f32x2*)(F.lds + ml::OFF_ROPE);
    for (int i = F.tid; i < 64 * 24; i += 512) ROPE[i] = ((const f32x2*)rope_tab)[i];
}
__device__ __forceinline__ void mlstm_itemA(const Ctx& F, int l, int bh, int it, bf16* otmp, float* ST) {
    const int b = bh >> 2, h = bh & 3;
    if (it == 0) {
        const MlJob jb{b, h, 1, 0, 4};
        mlstm_dir(F, l, jb, 0, -1, 0, l == 0 ? 1 : 0, otmp, ST);
        mlstm_dir(F, l, jb, 1, -1, 0, l == 0 ? 2 : 0, otmp, ST);
    } else {
        const int dir = (it - 1) / (NSEG - 1), k = (it - 1) % (NSEG - 1), seg = dir == 0 ? k : NSEG - 1 - k;
        const MlJob jb{b, h, 0, SEGTOK * seg, SEGCH};
        mlstm_dir(F, l, jb, dir, -1, 1 + k, 0, otmp, ST);
    }
}
__device__ __forceinline__ void mlstm_itemC(const Ctx& F, int l, int bh, int seg, bf16* otmp, float* ST) {
    const MlJob jb{bh >> 2, bh & 3, 0, SEGTOK * seg, SEGCH};
    mlstm_dir(F, l, jb, 0, seg, -1, 1, otmp, ST);
    mlstm_dir(F, l, jb, 1, NSEG - 1 - seg, -1, 2, otmp, ST);
}

namespace hg {
constexpr int STR = 72;
constexpr int IMG = 64 * STR * 2;
constexpr int OFF_KO = 0, OFF_KH = IMG, OFF_VS = 2 * IMG, OFF_QJ = 3 * IMG, OFF_ST = 7 * IMG, OFF_HT = 9 * IMG, OFF_TOT = OFF_HT + 64 * 68 * 4, OFF_BL = OFF_TOT + 8 * 64 * 4, OFF_END = OFF_BL + 512;
static_assert(OFF_END <= RING_BYTES, "hgrn LDS");
constexpr int ST_FLOATS = 64 * 64 + 64;
}
__device__ __forceinline__ void hgrn_dir(const Ctx& F, int l, const MlJob jb, int dir, int fold_r, int emit_slot, int mode, bf16* otmp, float* ST) {
    using namespace hg;
    int tid_ = F.tid; asm volatile("" : "+v"(tid_));
    const int tid = tid_, lane = tid & 63, w = __builtin_amdgcn_readfirstlane(tid >> 6), g = lane >> 4, c = lane & 15;
    LAS bf16* KO = (LAS bf16*)(F.lds + OFF_KO); LAS bf16* KH = (LAS bf16*)(F.lds + OFF_KH); LAS bf16* VS = (LAS bf16*)(F.lds + OFF_VS); LAS bf16* QJ = (LAS bf16*)(F.lds + OFF_QJ);
    LAS bf16* ST0 = (LAS bf16*)(F.lds + OFF_ST); LAS float* HT = (LAS float*)(F.lds + OFF_HT); LAS float* TOT = (LAS float*)(F.lds + OFF_TOT); LAS float* BL = (LAS float*)(F.lds + OFF_BL);
    const int rowbase = jb.isctx ? MX + jb.b * CTX : jb.b * S;
    const int h = jb.h; const bf16* P = F.P;
    float* STd = ST + (size_t)(((jb.b * 4 + h) * 2 + dir) * 8) * ST_FLOATS;
    const int dt = w >> 1, et0 = 2 * (w & 1);
    f32x4 Sst[2]; float Btot[4];
#pragma unroll
    for (int i = 0; i < 2; ++i) Sst[i] = (f32x4){0.f, 0.f, 0.f, 0.f};
#pragma unroll
    for (int r = 0; r < 4; ++r) Btot[r] = 0.f;
    if (fold_r >= 0) {
        f32x4 v[8][2], dk[8];
#pragma unroll
        for (int k = 0; k < NSEG; ++k) { const float* sl = STd + (size_t)k * ST_FLOATS; v[k][0] = *(const f32x4*)(sl + ((w * 2 + 0) * 64 + lane) * 4); v[k][1] = *(const f32x4*)(sl + ((w * 2 + 1) * 64 + lane) * 4);
            dk[k] = *(const f32x4*)(sl + 64 * 64 + 16 * dt + 4 * g); }
        f32x4 run = (f32x4){1.f, 1.f, 1.f, 1.f};
#pragma unroll
        for (int k = NSEG - 1; k >= 0; --k) { const float on = (k <= fold_r) ? 1.f : 0.f; Sst[0] += v[k][0] * (run * on); Sst[1] += v[k][1] * (run * on);
            if (k >= 1) { const bool use = k <= fold_r; run[0] *= use ? __expf(dk[k][0]) : 1.f; run[1] *= use ? __expf(dk[k][1]) : 1.f; run[2] *= use ? __expf(dk[k][2]) : 1.f; run[3] *= use ? __expf(dk[k][3]) : 1.f; } }
    }
    if (mode != 0) {
#pragma unroll
        for (int i = 0; i < 2; ++i) { v2u v; v.x = pk2(Sst[i][0], Sst[i][1]); v.y = pk2(Sst[i][2], Sst[i][3]); *(LAS v2u*)(ST0 + (16 * (et0 + i) + c) * STR + 16 * dt + 4 * g) = v; }
    }
    const int ps = lane, d0 = 8 * w;
    float lbv[8];
#pragma unroll
    for (int e = 0; e < 8; ++e) { lbv[e] = 0.f;
        if (l == 1) { const float v0 = F.hgrn_lb[(0 * 2 + dir) * 256 + h * 64 + d0 + e], v1 = F.hgrn_lb[(1 * 2 + dir) * 256 + h * 64 + d0 + e]; lbv[e] = 1.f / (1.f + expf(v0 - v1)); } }
    const int fcol = dir ? A_FB : A_FF;
    auto tok_of = [&](int ci, int i) -> int { return dir == 0 ? jb.t0 + 64 * ci + i : jb.t0 + 64 * (jb.nchunk - 1 - ci) + (63 - i); };
    v4u rq, rf, rv; rq = rf = rv = (v4u){0u, 0u, 0u, 0u};
    v4u ft = (v4u){0u, 0u, 0u, 0u}, fz = (v4u){0u, 0u, 0u, 0u};
    const int fi_i = tid >> 3, fi_e0 = 8 * (tid & 7);
    float gnv[8];
#pragma unroll
    for (int e = 0; e < 8; ++e) gnv[e] = (mode == 2) ? F.hgrn_gn[l * 256 + h * 64 + fi_e0 + e] : 0.f;
    auto issue_loads = [&](int ci) {
        const bf16* pr = P + (size_t)(rowbase + tok_of(ci, ps)) * PLD + h * 64 + d0;
        if (mode != 0) rq = *(const v4u*)(pr + A_Q);
        rf = *(const v4u*)(pr + fcol); rv = *(const v4u*)(pr + A_I);
    };
    auto issue_fin = [&](int ci) { const int m = rowbase + tok_of(ci, fi_i); ft = *(const v4u*)(otmp + (size_t)m * 256 + h * 64 + fi_e0); fz = *(const v4u*)(P + (size_t)m * PLD + A_Z + h * 64 + fi_e0); };
    issue_loads(0);
    __syncthreads();
    for (int ci = 0; ci < jb.nchunk; ++ci) {
        LAS bf16* STc = ST0 + (ci & 1) * 64 * STR; LAS bf16* STn = ST0 + ((ci + 1) & 1) * 64 * STR;
        {
            float qv[8], kk[8], bb[8], fl[8];
            unpack8(rf, fl);
#pragma unroll
            for (int e = 0; e < 8; ++e) { const float sg = sigmoid_f(fl[e]); const float f = lbv[e] + (1.f - lbv[e]) * sg; bb[e] = __logf(f); kk[e] = (1.f - lbv[e]) * (1.f - sg); }
            if (mode != 0) unpack8(rq, qv);
            const v4u vraw = rv;
            if (ci + 1 < jb.nchunk) issue_loads(ci + 1);
            if (mode == 2) issue_fin(ci);
            float ref1[8], ref2[8], ref3[8], bl[8];
#pragma unroll
            for (int e = 0; e < 8; ++e) { bb[e] = wave_scan_incl(bb[e]); ref1[e] = rdlane(bb[e], 15); ref2[e] = rdlane(bb[e], 31); ref3[e] = rdlane(bb[e], 47); bl[e] = rdlane(bb[e], 63); }
            const int sub = lane >> 4;
            float o8[8];
            if (mode != 0) {
#pragma unroll
                for (int e = 0; e < 8; ++e) { const float rown = sub == 0 ? 0.f : (sub == 1 ? ref1[e] : (sub == 2 ? ref2[e] : ref3[e])); o8[e] = kk[e] * __expf(rown - bb[e]); }
                *(LAS v4u*)(KO + ps * STR + d0) = pack8(o8); }
#pragma unroll
            for (int e = 0; e < 8; ++e) o8[e] = kk[e] * __expf(bl[e] - bb[e]);
            *(LAS v4u*)(KH + ps * STR + d0) = pack8(o8);
            *(LAS v4u*)(VS + ps * STR + d0) = vraw;
            if (mode != 0) {
#pragma unroll
                for (int e = 0; e < 8; ++e) o8[e] = qv[e] * __expf(bb[e]);
                *(LAS v4u*)(QJ + ps * STR + d0) = pack8(o8);
                if (sub >= 1) {
#pragma unroll
                    for (int e = 0; e < 8; ++e) o8[e] = qv[e] * __expf(bb[e] - ref1[e]);
                    *(LAS v4u*)(QJ + (64 + ps) * STR + d0) = pack8(o8); }
                if (sub >= 2) {
#pragma unroll
                    for (int e = 0; e < 8; ++e) o8[e] = qv[e] * __expf(bb[e] - ref2[e]);
                    *(LAS v4u*)(QJ + (128 + ps) * STR + d0) = pack8(o8); }
                if (sub >= 3) {
#pragma unroll
                    for (int e = 0; e < 8; ++e) o8[e] = qv[e] * __expf(bb[e] - ref3[e]);
                    *(LAS v4u*)(QJ + (192 + ps) * STR + d0) = pack8(o8); }
            }
            if (lane == 0) { *(LAS f32x4*)(BL + d0) = (f32x4){bl[0], bl[1], bl[2], bl[3]}; *(LAS f32x4*)(BL + d0 + 4) = (f32x4){bl[4], bl[5], bl[6], bl[7]}; }
        }
        __syncthreads();
        if (mode != 0) {
            const int tt = w & 3, eh = w >> 2;
            f32x4 at[4];
            { bf16x8 kf[4][2], qjf[4][2];
#pragma unroll
              for (int j = 0; j < 4; ++j) if (j <= tt) {
#pragma unroll
                  for (int ks = 0; ks < 2; ++ks) { kf[j][ks] = rm_frag(KO, STR, 16 * j + c, 32 * ks + 8 * g); qjf[j][ks] = rm_frag(QJ + j * 64 * STR, STR, 16 * tt + c, 32 * ks + 8 * g); } }
              LDS_FENCE();
#pragma unroll
              for (int j = 0; j < 4; ++j) { at[j] = (f32x4){0.f, 0.f, 0.f, 0.f};
                  if (j <= tt) {
#pragma unroll
                      for (int ks = 0; ks < 2; ++ks) at[j] = mfma16(kf[j][ks], qjf[j][ks], at[j]);
                      if (j == tt) {
#pragma unroll
                          for (int r = 0; r < 4; ++r) if (4 * g + r > c) at[j][r] = 0.f; }
                  } } }
            bf16x8 pf[2];
#pragma unroll
            for (int k2 = 0; k2 < 2; ++k2) { const unsigned u0 = pk2(at[2 * k2][0], at[2 * k2][1]), u1 = pk2(at[2 * k2][2], at[2 * k2][3]), u2 = pk2(at[2 * k2 + 1][0], at[2 * k2 + 1][1]), u3 = pk2(at[2 * k2 + 1][2], at[2 * k2 + 1][3]);
                pf[k2] = __builtin_bit_cast(bf16x8, (v4u){u0, u1, u2, u3}); }
            { bf16x8 qf[2], vf[2][2], sf[2][2];
#pragma unroll
              for (int ks = 0; ks < 2; ++ks) qf[ks] = rm_frag(QJ, STR, 16 * tt + c, 32 * ks + 8 * g);
#pragma unroll
              for (int ei = 0; ei < 2; ++ei) { const int et = 2 * eh + ei;
#pragma unroll
                  for (int k2 = 0; k2 < 2; ++k2) if (2 * k2 <= tt) vf[ei][k2] = tr_frag(VS, STR, 32 * k2 + 4 * g, 32 * k2 + 16 + 4 * g, 16 * et, lane);
#pragma unroll
                  for (int ks = 0; ks < 2; ++ks) sf[ei][ks] = rm_frag(STc, STR, 16 * et + c, 32 * ks + 8 * g); }
              LDS_FENCE();
#pragma unroll
              for (int ei = 0; ei < 2; ++ei) { const int et = 2 * eh + ei;
                  f32x4 acc = (f32x4){0.f, 0.f, 0.f, 0.f};
#pragma unroll
                  for (int k2 = 0; k2 < 2; ++k2) if (2 * k2 <= tt) acc = mfma16(vf[ei][k2], pf[k2], acc);
#pragma unroll
                  for (int ks = 0; ks < 2; ++ks) acc = mfma16(sf[ei][ks], qf[ks], acc);
                  *(LAS f32x4*)(HT + (16 * tt + c) * 68 + 16 * et + 4 * g) = acc; } }
        }
        {
            const f32x4 blv = *(const LAS f32x4*)(BL + 16 * dt + 4 * g);
#pragma unroll
            for (int r = 0; r < 4; ++r) { const float dec = __expf(blv[r]); Sst[0][r] *= dec; Sst[1][r] *= dec; Btot[r] += blv[r]; }
            { bf16x8 af[2], vf[2][2];
#pragma unroll
              for (int k2 = 0; k2 < 2; ++k2) { af[k2] = tr_frag(KH, STR, 32 * k2 + 8 * g, 32 * k2 + 8 * g + 4, 16 * dt, lane);
#pragma unroll
                  for (int i = 0; i < 2; ++i) vf[k2][i] = tr_frag(VS, STR, 32 * k2 + 8 * g, 32 * k2 + 8 * g + 4, 16 * (et0 + i), lane); }
              LDS_FENCE();
#pragma unroll
              for (int k2 = 0; k2 < 2; ++k2)
#pragma unroll
                  for (int i = 0; i < 2; ++i) Sst[i] = mfma16(af[k2], vf[k2][i], Sst[i]); }
            if (mode != 0) {
#pragma unroll
                for (int i = 0; i < 2; ++i) { v2u v; v.x = pk2(Sst[i][0], Sst[i][1]); v.y = pk2(Sst[i][2], Sst[i][3]); *(LAS v2u*)(STn + (16 * (et0 + i) + c) * STR + 16 * dt + 4 * g) = v; } }
        }
        __syncthreads();
        if (mode != 0) {
            const int i = tid >> 3, sub8 = tid & 7, e0 = 8 * sub8; const int m = rowbase + tok_of(ci, i);
            float hv[8];
            { const f32x4 a0 = *(const LAS f32x4*)(HT + i * 68 + e0), a1 = *(const LAS f32x4*)(HT + i * 68 + e0 + 4); hv[0] = a0[0]; hv[1] = a0[1]; hv[2] = a0[2]; hv[3] = a0[3]; hv[4] = a1[0]; hv[5] = a1[1]; hv[6] = a1[2]; hv[7] = a1[3]; }
            bf16* tp = otmp + (size_t)m * 256 + h * 64 + e0;
            if (mode == 1) *(v4u*)tp = pack8(hv);
            else {
                float tv[8]; unpack8(ft, tv);
                float ss = 0.f;
#pragma unroll
                for (int e = 0; e < 8; ++e) { hv[e] += tv[e]; ss += hv[e] * hv[e]; }
                ss = group8_sum(ss);
                const float rinv = __builtin_amdgcn_rsqf(ss * (1.f / 64.f) + EPS);
                float zv[8]; unpack8(fz, zv);
#pragma unroll
                for (int e = 0; e < 8; ++e) hv[e] = hv[e] * rinv * gnv[e] * zv[e];
                *(v4u*)(F.hxy + (size_t)m * 1024 + h * 64 + e0) = pack8(hv);
            }
        }
    }
    if (emit_slot >= 0) {
        float* sl = STd + (size_t)emit_slot * ST_FLOATS;
        *(f32x4*)(sl + ((w * 2 + 0) * 64 + lane) * 4) = Sst[0]; *(f32x4*)(sl + ((w * 2 + 1) * 64 + lane) * 4) = Sst[1];
        if ((w & 1) == 0 && c == 0) *(f32x4*)(sl + 64 * 64 + 16 * dt + 4 * g) = (f32x4){Btot[0], Btot[1], Btot[2], Btot[3]};
    }
    __syncthreads();
}
__device__ __forceinline__ void hgrn_itemA(const Ctx& F, int l, int bh, int it, bf16* otmp, float* ST) {
    const int b = bh >> 2, h = bh & 3;
    if (it == 0) {
        const MlJob jb{b, h, 1, 0, 4};
        hgrn_dir(F, l, jb, 0, -1, 0, l == 0 ? 1 : 0, otmp, ST);
        hgrn_dir(F, l, jb, 1, -1, 0, l == 0 ? 2 : 0, otmp, ST);
    } else {
        const int dir = (it - 1) / (NSEG - 1), k = (it - 1) % (NSEG - 1), seg = dir == 0 ? k : NSEG - 1 - k;
        const MlJob jb{b, h, 0, SEGTOK * seg, SEGCH};
        hgrn_dir(F, l, jb, dir, -1, 1 + k, 0, otmp, ST);
    }
}
__device__ __forceinline__ void hgrn_itemC(const Ctx& F, int l, int bh, int seg, bf16* otmp, float* ST) {
    const MlJob jb{bh >> 2, bh & 3, 0, SEGTOK * seg, SEGCH};
    hgrn_dir(F, l, jb, 0, seg, -1, 1, otmp, ST);
    hgrn_dir(F, l, jb, 1, NSEG - 1 - seg, -1, 2, otmp, ST);
}

namespace nat {
constexpr int STR = 72, IMG = 64 * STR * 2;
constexpr int OFF_K = 0, OFF_V = 2 * IMG, OFF_RPB = 4 * IMG, OFF_END = OFF_RPB + 2048;
static_assert(OFF_END <= RING_BYTES, "na LDS");
}
template <int CH, bool WIN>
__device__ __forceinline__ void na_block(const LAS bf16* Kc, const LAS bf16* Vc, const LAS float* RPB, const bf16x8 (&qf)[2][2], f32x4 (&oacc)[2][4], float (&mrun)[2], float (&lrun)[2],
                                         const int g, const int c, const int lane, const int dr, const int (&qcol)[2], const int (&csq)[2]) {
    constexpr int STR = nat::STR;
    constexpr int KLO[2] = {WIN ? (CH == 0 ? 0 : 1) : 0, WIN ? (CH == 0 ? 0 : 2) : 0}, KHI[2] = {WIN ? (CH == 0 ? 1 : 3) : 3, WIN ? (CH == 0 ? 2 : 3) : 3};
    constexpr int ULO = KLO[0] < KLO[1] ? KLO[0] : KLO[1], UHI = KHI[0] > KHI[1] ? KHI[0] : KHI[1];
    f32x4 st[2][4];
    { bf16x8 kf[4][2];
#pragma unroll
      for (int kt = ULO; kt <= UHI; ++kt)
#pragma unroll
          for (int ks = 0; ks < 2; ++ks) kf[kt][ks] = rm_frag(Kc, STR, 16 * kt + c, 32 * ks + 8 * g);
      LDS_FENCE();
      __builtin_amdgcn_s_setprio(1);
#pragma unroll
      for (int qt = 0; qt < 2; ++qt)
#pragma unroll
          for (int kt = 0; kt < 4; ++kt) { st[qt][kt] = (f32x4){0.f, 0.f, 0.f, 0.f};
              if (kt >= KLO[qt] && kt <= KHI[qt]) {
#pragma unroll
                  for (int ks = 0; ks < 2; ++ks) st[qt][kt] = mfma16(kf[kt][ks], qf[qt][ks], st[qt][kt]); } }
      __builtin_amdgcn_s_setprio(0); }
    if (WIN) {
#pragma unroll
        for (int qt = 0; qt < 2; ++qt) { const int boff = dr * 31 + 15 - qcol[qt];
#pragma unroll
            for (int kt = KLO[qt]; kt <= KHI[qt]; ++kt)
#pragma unroll
                for (int r = 0; r < 4; ++r) { const int kc = 16 * kt + 4 * g + r; const float bias = RPB[min(max(boff + kc, 0), 464)]; const float v = st[qt][kt][r] + bias; st[qt][kt][r] = ((unsigned)(kc - csq[qt]) < 16u) ? v : -1e30f; } }
    }
    float alpha[2]; bf16x8 pf[2][2];
#pragma unroll
    for (int qt = 0; qt < 2; ++qt) {
        float bm = -1e30f;
#pragma unroll
        for (int kt = KLO[qt]; kt <= KHI[qt]; ++kt)
#pragma unroll
            for (int r = 0; r < 4; ++r) bm = fmaxf(bm, st[qt][kt][r]);
        bm = xor32_max(xor16_max(bm));
        const float mnew = fmaxf(mrun[qt], bm); alpha[qt] = __builtin_amdgcn_exp2f(mrun[qt] - mnew); mrun[qt] = mnew;
        float ps = 0.f;
#pragma unroll
        for (int kt = KLO[qt]; kt <= KHI[qt]; ++kt)
#pragma unroll
            for (int r = 0; r < 4; ++r) { const float p = __builtin_amdgcn_exp2f(st[qt][kt][r] - mnew); st[qt][kt][r] = p; ps += p; }
        lrun[qt] = lrun[qt] * alpha[qt] + ps;
#pragma unroll
        for (int k2 = 0; k2 < 2; ++k2) { const unsigned u0 = pk2(st[qt][2 * k2][0], st[qt][2 * k2][1]), u1 = pk2(st[qt][2 * k2][2], st[qt][2 * k2][3]), u2 = pk2(st[qt][2 * k2 + 1][0], st[qt][2 * k2 + 1][1]), u3 = pk2(st[qt][2 * k2 + 1][2], st[qt][2 * k2 + 1][3]);
            pf[qt][k2] = __builtin_bit_cast(bf16x8, (v4u){u0, u1, u2, u3}); }
    }
    { bf16x8 vf[4][2];
#pragma unroll
      for (int dtl = 0; dtl < 4; ++dtl)
#pragma unroll
          for (int k2 = ULO / 2; k2 <= UHI / 2; ++k2) vf[dtl][k2] = tr_frag(Vc, STR, 32 * k2 + 4 * g, 32 * k2 + 16 + 4 * g, 16 * dtl, lane);
      LDS_FENCE();
      __builtin_amdgcn_s_setprio(1);
#pragma unroll
      for (int qt = 0; qt < 2; ++qt)
#pragma unroll
          for (int dtl = 0; dtl < 4; ++dtl) { f32x4 a = oacc[qt][dtl] * alpha[qt];
#pragma unroll
              for (int k2 = KLO[qt] / 2; k2 <= KHI[qt] / 2; ++k2) a = mfma16(vf[dtl][k2], pf[qt][k2], a);
              oacc[qt][dtl] = a; }
      __builtin_amdgcn_s_setprio(0); }
}
__device__ __forceinline__ void na_item(const Ctx& F, int l, int b, int h, int R0) {
    using namespace nat;
    int tid_ = F.tid; asm volatile("" : "+v"(tid_));
    const int tid = tid_, lane = tid & 63, w = __builtin_amdgcn_readfirstlane(tid >> 6), g = lane >> 4, c = lane & 15;
    LAS bf16* KT = (LAS bf16*)(F.lds + OFF_K); LAS bf16* VT = (LAS bf16*)(F.lds + OFF_V); LAS float* RPB = (LAS float*)(F.lds + OFF_RPB);
    const bf16* P = F.P; const bool lat = R0 >= 0;
    const int R = R0 + (w >> 1), ch = w & 1;
    const int rsR = min(max(R - 4, 0), 56);
    const int kr0 = lat ? min(max(R0 - 4, 0), 56) : 0;
    const int nwin = lat ? (min(max(R0 + 3 - 4, 0), 56) + 8 - kr0) : 0, nblk = nwin + 4;
    if (lat) for (int i = tid; i < 15 * 31; i += 512) RPB[i] = F.na_rpb[((size_t)l * 6 + h) * 465 + i] * 1.4426950408889634f;
    int mq[2]; bf16x8 qf[2][2]; int csq[2], qcol[2];
#pragma unroll
    for (int qt = 0; qt < 2; ++qt) {
        if (lat) { qcol[qt] = 32 * ch + 16 * qt + c; mq[qt] = b * S + R * 64 + qcol[qt]; } else { qcol[qt] = 0; mq[qt] = MX + b * CTX + 32 * w + 16 * qt + c; }
        csq[qt] = min(max(qcol[qt] - 8, 0), 48);
#pragma unroll
        for (int ks = 0; ks < 2; ++ks) qf[qt][ks] = *(const bf16x8*)(P + (size_t)mq[qt] * PLD + C_Q + h * 64 + 32 * ks + 8 * g);
    }
    f32x4 oacc[2][4]; float mrun[2], lrun[2];
#pragma unroll
    for (int qt = 0; qt < 2; ++qt) { mrun[qt] = -1e30f; lrun[qt] = 0.f;
#pragma unroll
        for (int dtl = 0; dtl < 4; ++dtl) oacc[qt][dtl] = (f32x4){0.f, 0.f, 0.f, 0.f}; }
    const int stok = tid >> 3, spc = tid & 7;
    auto blk_row = [&](int i) -> int { return i < nwin ? b * S + (kr0 + i) * 64 + stok : MX + b * CTX + 64 * (i - nwin) + stok; };
    v4u rk0, rv0, rk1, rv1, rk2, rv2;
    auto ld = [&](int i, v4u& k_, v4u& v_) { const int ii = i < nblk ? i : nblk - 1; const bf16* pr = P + (size_t)blk_row(ii) * PLD + h * 64 + 8 * spc; k_ = *(const v4u*)(pr + C_K); v_ = *(const v4u*)(pr + C_V); };
    ld(0, rk0, rv0); ld(1, rk1, rv1); ld(2, rk2, rv2);
    __syncthreads();
    *(LAS v4u*)(KT + stok * STR + 8 * spc) = rk0; *(LAS v4u*)(VT + stok * STR + 8 * spc) = rv0;
    ld(3, rk0, rv0);
    __syncthreads();
    auto step = [&](int i, v4u& kn, v4u& vn) {
        const LAS bf16* Kc = KT + (i & 1) * 64 * STR; const LAS bf16* Vc = VT + (i & 1) * 64 * STR;
        if (i + 1 < nblk) { LAS bf16* Kn = KT + ((i + 1) & 1) * 64 * STR; LAS bf16* Vn = VT + ((i + 1) & 1) * 64 * STR;
            *(LAS v4u*)(Kn + stok * STR + 8 * spc) = kn; *(LAS v4u*)(Vn + stok * STR + 8 * spc) = vn;
            if (i + 4 < nblk) ld(i + 4, kn, vn); }
        const bool win = i < nwin; const int kr = kr0 + i;
        const bool active = !win || (kr >= rsR && kr < rsR + 8);
        if (active) {
            if (!win) na_block<0, false>(Kc, Vc, RPB, qf, oacc, mrun, lrun, g, c, lane, 0, qcol, csq);
            else if (ch == 0) na_block<0, true>(Kc, Vc, RPB, qf, oacc, mrun, lrun, g, c, lane, kr - R + 7, qcol, csq);
            else na_block<1, true>(Kc, Vc, RPB, qf, oacc, mrun, lrun, g, c, lane, kr - R + 7, qcol, csq);
        }
        __syncthreads();
    };
    for (int i = 0; i < nblk; i += 3) { step(i, rk1, rv1); if (i + 1 < nblk) step(i + 1, rk2, rv2); if (i + 2 < nblk) step(i + 2, rk0, rv0); }
#pragma unroll
    for (int qt = 0; qt < 2; ++qt) {
        const float lt = xor32_sum(xor16_sum(lrun[qt]));
        const float rl = __builtin_amdgcn_rcpf(lt);
        const bf16* zr = P + (size_t)mq[qt] * PLD + C_Z + h * 64; bf16* yr = F.hxy + (size_t)mq[qt] * 1024 + 640 + h * 64;
#pragma unroll
        for (int dtl = 0; dtl < 4; ++dtl) { const int d = 16 * dtl + 4 * g; const v2u zv = *(const v2u*)(zr + d);
            const float z0 = __uint_as_float(zv.x << 16), z1 = __uint_as_float(zv.x & 0xffff0000u), z2 = __uint_as_float(zv.y << 16), z3 = __uint_as_float(zv.y & 0xffff0000u);
            v2u o; o.x = pk2(oacc[qt][dtl][0] * rl * z0, oacc[qt][dtl][1] * rl * z1); o.y = pk2(oacc[qt][dtl][2] * rl * z2, oacc[qt][dtl][3] * rl * z3);
            *(v2u*)(yr + d) = o; }
    }
}

__device__ __forceinline__ void phase_mixA(const Ctx& F, int l, unsigned* ticket) {
    mlstm_load_rope(F, F.rope);
    volatile LAS unsigned* slot = (volatile LAS unsigned*)(F.lds + MISC_OFF) + 16;
    const int n_ctx = 64, n_na = 768, n_loc = 2 * 32 * 2 * (NSEG - 1), n_nactx = (l == 0) ? 48 : 0, n_all = n_ctx + n_na + n_loc + n_nactx;
    unsigned cur = 0;
    if (F.tid == 0) *slot = __hip_atomic_fetch_add(ticket, 1u, __ATOMIC_RELAXED, __HIP_MEMORY_SCOPE_AGENT);
    __syncthreads();
    cur = *slot;
    while ((int)cur < n_all) {
        unsigned nxt = 0;
        if (F.tid == 0) nxt = __hip_atomic_fetch_add(ticket, 1u, __ATOMIC_RELAXED, __HIP_MEMORY_SCOPE_AGENT);
        int it = (int)cur;
        const int tkind = it < n_ctx ? 22 : (it < n_ctx + n_loc ? 21 : 20);
        if (l == 0) { TS_START(F, tkind); if (PROBE_T == 25 && blockIdx.x == 0 && F.tid == 0) TS_LDS(F)[0] += 2000; }
        if (it < n_ctx) { if (it < 32) mlstm_itemA(F, l, it, 0, F.otm, F.stm); else hgrn_itemA(F, l, it - 32, 0, F.oth, F.sth); }
        else if ((it -= n_ctx) < n_loc) { constexpr int NL = 2 * (NSEG - 1); if (it < 32 * NL) mlstm_itemA(F, l, it / NL, 1 + it % NL, F.otm, F.stm); else { it -= 32 * NL; hgrn_itemA(F, l, it / NL, 1 + it % NL, F.oth, F.sth); } }
        else if ((it -= n_loc) < n_na) na_item(F, l, it / 96, (it / 16) % 6, 4 * (it % 16));
        else { it -= n_na; na_item(F, l, it / 6, it % 6, -1); }
        if (l == 0) TS_STOP(F, tkind);
        __syncthreads();
        if (F.tid == 0) *slot = nxt;
        __syncthreads();
        cur = *slot;
    }
}
__device__ __forceinline__ void phase_mixC(const Ctx& F, int l) {
    mlstm_load_rope(F, F.rope);
    for (int it = F.vcu; it < 2 * 32 * NSEG; it += F.G) {
        if (it < 32 * NSEG) mlstm_itemC(F, l, it / NSEG, it % NSEG, F.otm, F.stm);
        else hgrn_itemC(F, l, (it - 32 * NSEG) / NSEG, it % NSEG, F.oth, F.sth);
    }
}

constexpr int NPH = 12;
struct Args { const float* in[15]; float* out; unsigned char* ws; int ph_lo, ph_hi; };
__global__ void __launch_bounds__(512, 2) mega_fwd(Args args) {
    extern __shared__ __attribute__((aligned(16))) unsigned char lds[];
    Ctx F;
    F.lds = (LAS unsigned char*)lds;
    F.tid = threadIdx.x; F.lane = F.tid & 63; F.wave = __builtin_amdgcn_readfirstlane(F.tid >> 6);
    F.G = gridDim.x; { const int bx = blockIdx.x; F.vcu = (F.G % 8 == 0) ? (bx % 8) * (F.G / 8) + bx / 8 : bx; }
    F.gw = F.vcu * 8 + F.wave; F.NGW = F.G * 8;
    unsigned char* ws = args.ws;
    F.x = args.in[0]; F.c = args.in[1]; F.ctx = args.in[2]; F.c_ctx = args.in[3]; F.w_mod = args.in[4]; F.b_mod = args.in[5]; F.g_pre = args.in[6]; F.g_post = args.in[7];
    F.w_in = args.in[8]; F.w_out = args.in[9]; F.hgrn_lb = args.in[10]; F.hgrn_gn = args.in[11]; F.gate_b = args.in[12]; F.mlstm_gn = args.in[13]; F.na_rpb = args.in[14];
    F.out = args.out;
    F.wt_in = (bf16*)(ws + WS_WT_IN); F.wt_out = (bf16*)(ws + WS_WT_OUT); F.mod = (float*)(ws + WS_MOD); F.gates = (float*)(ws + WS_GATES); F.ctx1 = (float*)(ws + WS_CTX1);
    F.hxy = (bf16*)(ws + WS_HXY); F.P = (bf16*)(ws + WS_P); F.UX = (bf16*)(ws + WS_P); F.oth = (bf16*)(ws + WS_OH); F.sth = (float*)(ws + WS_STH); F.otm = (bf16*)(ws + WS_OM); F.stm = (float*)(ws + WS_STM); F.rope = (float*)(ws + WS_ROPE);
    for (int u = F.tid; u < (LDS_BYTES - LDSCTL_OFF) / 4; u += 512) ((LAS unsigned*)(F.lds + LDSCTL_OFF))[u] = 0u;
    __syncthreads();
    XcdBarrier bar = xcd_barrier_post((unsigned*)(ws + WS_CTL) + CW_BAR, (volatile LAS unsigned*)(F.lds + MISC_OFF) + 8);

    const int lo = args.ph_lo, hi = args.ph_hi;
#ifndef DUP_PHASE
#define DUP_PHASE -1
#endif
#define IN(k) (lo <= (k) && (k) < hi)
#define SEAM(k) do { if ((k) + 1 < hi) xcd_barrier(bar); } while (0)
#define PHASE(k, ...) if (IN(k)) { TS_START(F, 100 + (k)); __VA_ARGS__; if ((k) == DUP_PHASE) { xcd_barrier(bar); __VA_ARGS__; } SEAM(k); TS_STOP(F, 100 + (k)); }
    PHASE(0, phase_p0(F))
    PHASE(1, { phase_prenorm0(F); phase_p1_transposes(F); })
#define LAYER(l) \
    PHASE(2 + 5 * (l), { \
        pg8::Gemm g{F.hxy, F.wt_in + (size_t)(l) * NPAD * 1024, M, NPAD, 1024}; \
        pg8::EpiIn E{F.P, F.gates, F.gate_b + (l) * 16}; \
        pg8::StaticOrder SO; SO.init(M, NPAD, F.G, (int)blockIdx.x); pg8::gemm_phase<pg8::EpiIn, pg8::StaticOrder, true, true>(F.lds + RING_OFF, g, SO, E); }) \
    PHASE(3 + 5 * (l), phase_mixA(F, (l), (unsigned*)(args.ws + WS_CTL) + 8192 + 64 * (l))) \
    PHASE(4 + 5 * (l), phase_mixC(F, (l))) \
    PHASE(5 + 5 * (l), { \
        constexpr int Ml = (l) == 0 ? M : MX; \
        pg8::Gemm g{F.hxy, F.wt_out + (size_t)(l) * 1024 * 1024, Ml, 1024, 1024}; pg8::StaticOrder SO; SO.init(Ml, 1024, F.G, (int)blockIdx.x); \
        pg8::EpiOut E{F.UX}; \
        pg8::gemm_phase<pg8::EpiOut, pg8::StaticOrder, true, true>(F.lds + RING_OFF, g, SO, E); }) \
    PHASE(6 + 5 * (l), phase_post(F, (l)))
    LAYER(0)
    LAYER(1)
#undef LAYER
#undef PHASE
#undef IN
#undef SEAM
    if (PROBE_T != 0 && blockIdx.x == 0 && F.tid == 0) { const unsigned long long t0 = __builtin_amdgcn_s_memtime(), dt = 8ull * TS_LDS(F)[0]; while (__builtin_amdgcn_s_memtime() - t0 < dt) __builtin_amdgcn_s_sleep(8); }
}

extern "C" void kernel_launch(void* const* d_in, const int* in_sizes, int n_in, void* d_out, int out_size, void* d_ws, size_t ws_size, hipStream_t stream) {
    static int grid = 0;
    if (grid == 0) {
        if (n_in != 15 || ws_size < WS_END) { fprintf(stderr, "kernel_launch: unexpected n_in %d / ws_size %zu (need %zu); nothing launched\n", n_in, ws_size, (size_t)WS_END); grid = -1; return; }
        int dev = 0, cus = 0, per_cu = 0;
        if (hipGetDevice(&dev) != hipSuccess || hipDeviceGetAttribute(&cus, hipDeviceAttributeMultiprocessorCount, dev) != hipSuccess) { grid = -1; return; }
        if (hipFuncSetAttribute((const void*)mega_fwd, hipFuncAttributeMaxDynamicSharedMemorySize, LDS_BYTES) != hipSuccess) { fprintf(stderr, "kernel_launch: hipFuncSetAttribute failed\n"); grid = -1; return; }
        if (hipOccupancyMaxActiveBlocksPerMultiprocessor(&per_cu, (const void*)mega_fwd, 512, LDS_BYTES) != hipSuccess || per_cu < 1) { fprintf(stderr, "kernel_launch: occupancy query says %d blocks/CU\n", per_cu); (void)hipGetLastError(); grid = -1; return; }
        grid = cus;
    }
    if (grid < 0) return;
    (void)hipMemsetAsync((char*)d_ws + WS_CTL, 0, CTL_BYTES, stream);
    Args a{};
    for (int i = 0; i < 15; ++i) a.in[i] = (const float*)d_in[i];
    a.out = (float*)d_out; a.ws = (unsigned char*)d_ws; a.ph_lo = 0; a.ph_hi = NPH;
    hipLaunchKernelGGL(mega_fwd, dim3(grid), dim3(512), LDS_BYTES, stream, a);
}
```

```cpp
#include <hip/hip_runtime.h>
#include <stdint.h>
#include <cstdio>

namespace cfg {
constexpr int D = 1024, NB = 8, S = 4096, CTX = 256;
constexpr int MX = NB * S, MC = NB * CTX, M = MX + MC;
constexpr int PIN = 4752, NPAD = 4864, PLD = 4736;
constexpr int A_Q = 0, A_FF = 256, A_FB = 512, A_I = 768, A_Z = 1024, B_Q = 1280, B_K = 1664, B_V = 2048, B_O = 2432, B_Z = 2816,
              C_Q = 3200, C_K = 3584, C_V = 3968, C_Z = 4352;
constexpr float EPS = 1e-6f;
constexpr size_t WS_CTL = 0, CTL_BYTES = 65536;
constexpr size_t WS_WT_IN = WS_CTL + CTL_BYTES;
constexpr size_t WS_WT_OUT = WS_WT_IN + 2ull * NPAD * 1024 * 2;
constexpr size_t WS_MOD = WS_WT_OUT + 2ull * 1024 * 1024 * 2;
constexpr size_t WS_GATES = WS_MOD + 2ull * 9 * 3072 * 4;
constexpr size_t WS_CTX1 = WS_GATES + (size_t)M * 16 * 4;
constexpr size_t WS_HXY = WS_CTX1 + (size_t)MC * 1024 * 4;
constexpr size_t WS_P = WS_HXY + (size_t)M * 1024 * 2;
constexpr size_t WS_OH = WS_P + (size_t)M * PLD * 2;
constexpr size_t WS_OM = WS_OH + (size_t)M * 256 * 4;
constexpr size_t WS_STM = WS_OM + (size_t)M * 384 * 2;
constexpr size_t WS_ROPE = WS_STM + 32ull * 2 * 8 * (96 * 112 + 16) * 4;
constexpr size_t WS_STH = WS_ROPE + 64 * 24 * 8;
constexpr size_t WS_END = WS_STH + 32ull * 2 * 8 * (64 * 64 + 64) * 4;
static_assert(WS_END <= 536870912ull, "workspace");
static_assert(WS_WT_IN % 256 == 0 && WS_MOD % 256 == 0 && WS_GATES % 256 == 0 && WS_CTX1 % 256 == 0 && WS_HXY % 256 == 0 && WS_P % 256 == 0 && WS_OH % 256 == 0 && WS_OM % 256 == 0 && WS_STM % 256 == 0 && WS_ROPE % 256 == 0 && WS_STH % 256 == 0, "align");
}
using namespace cfg;

namespace pg8 {
#define PG8_LAS __attribute__((address_space(3)))
typedef unsigned short bf16_t;
typedef short bf16x8 __attribute__((ext_vector_type(8)));
typedef float f32x4 __attribute__((ext_vector_type(4)));
typedef unsigned u32x4 __attribute__((ext_vector_type(4)));
constexpr int BM = 256, BK = 64, HALF = 128, HTB = HALF * BK * 2  , STAGE_BYTES = 8 * HTB, NXCD = 8, WGM = 8;

__host__ __device__ __forceinline__ int lds_byte(int r, int c) { const int st = (r >> 4) * 2 + (c >> 5), rr = r & 15, cc = c & 31, ob = rr * 64 + cc * 2; return st * 1024 + (ob ^ (((ob >> 9) & 1) << 5)); }
__host__ __device__ __forceinline__ void stage_rc(int b, int& R, int& C) { const int st = b / 1024, sb = b % 1024, swz = sb ^ (((sb >> 9) & 1) << 5); R = (st >> 1) * 16 + swz / 64; C = (st & 1) * 32 + (swz % 64) / 2; }
__host__ __device__ __forceinline__ int perm32(int rho) { const int n = rho >> 4, i = rho & 15; return 8 * (i >> 2) + 4 * n + (i & 3); }

struct Unit { int pm, pn; };
struct Gemm { const bf16_t* A; const bf16_t* Bt; int M, N, K; };

struct StaticOrder {
    int nM, nN, nwg, G, c;
    __host__ __device__ void init(int M, int N, int G_, int c_) { nM = M / BM; nN = N / BM; nwg = nM * nN; G = G_; c = c_; }
    __host__ __device__ bool next(int i, Unit& u) const {
        const long L = (long)i * G + c; if (L >= nwg) return false;
        int wgid = (int)L; { const int q = nwg / NXCD, r = nwg % NXCD, xcd = wgid % NXCD, off = wgid / NXCD; wgid = (xcd < r ? xcd * (q + 1) : r * (q + 1) + (xcd - r) * q) + off; }
        const int nig = WGM * nN, gid = wgid / nig, fm = gid * WGM, gsz = (nM - fm) < WGM ? (nM - fm) : WGM;
        u.pm = fm + ((wgid % nig) % gsz); u.pn = (wgid % nig) / gsz; return true;
    }
    __device__ __forceinline__ void a_ready(const Unit&) const {}
    __device__ __forceinline__ void done(const Unit&) const {}
};

__device__ __forceinline__ unsigned cvt_pk_bf16(float lo, float hi) { unsigned r; asm volatile("v_cvt_pk_bf16_f32 %0, %1, %2" : "=v"(r) : "v"(lo), "v"(hi)); return r; }
__device__ __forceinline__ float logsigmoid_e(float v) { return fminf(v, 0.f) - log1pf(__expf(-fabsf(v))); }

struct EpiIn {
    static constexpr bool PERM = true, AFTER_DRAIN = false;
    bf16_t* P; float* gates; const float* gate_b;
    __device__ __forceinline__ void operator()(const f32x4 (&acc)[2][2][4][2], const Unit& u, int wr, int wc, int fr, int fq) const {
        const int row0 = u.pm * BM + wr * 64 + fr, col0 = u.pn * BM + wc * 32 + 8 * fq;
#pragma unroll
        for (int bj = 0; bj < 2; ++bj) {
            const int col = col0 + bj * HALF;
            if (col < cfg::PLD) {
                const int act = col < 256 ? 1 : col < 1024 ? 0 : col < 1280 ? 2 : col < 1664 ? 3 : col < 2432 ? 0 : col < 2816 ? 4 : col < 3200 ? 2 : col < 3584 ? 5 : col < 4352 ? 0 : 2;
#pragma unroll
                for (int ai = 0; ai < 2; ++ai)
#pragma unroll
                    for (int m = 0; m < 4; ++m) { f32x4 v0 = acc[ai][bj][m][0], v1 = acc[ai][bj][m][1];
                        if (act == 1 || act == 2 || act == 4) { const float sc = act == 1 ? 0.125f : 1.f;
#pragma unroll
                            for (int e = 0; e < 4; ++e) { const float s0 = __builtin_amdgcn_rcpf(1.f + __expf(-v0[e])), s1 = __builtin_amdgcn_rcpf(1.f + __expf(-v1[e])); v0[e] = act == 4 ? s0 : v0[e] * s0 * sc; v1[e] = act == 4 ? s1 : v1[e] * s1 * sc; } }
                        else if (act == 3) { v0 = v0 * 0.10206207261596575f; v1 = v1 * 0.10206207261596575f; }
                        else if (act == 5) { v0 = v0 * (0.125f * 1.4426950408889634f); v1 = v1 * (0.125f * 1.4426950408889634f); }
                        u32x4 w; w.x = cvt_pk_bf16(v0[0], v0[1]); w.y = cvt_pk_bf16(v0[2], v0[3]); w.z = cvt_pk_bf16(v1[0], v1[1]); w.w = cvt_pk_bf16(v1[2], v1[3]);
                        *(u32x4*)(P + (size_t)(row0 + ai * HALF + m * 16) * cfg::PLD + col) = w; }
            } else if (col < cfg::PIN) {
                const int g0 = col - cfg::PLD;
                const f32x4 b0 = *(const f32x4*)(gate_b + g0), b1 = *(const f32x4*)(gate_b + g0 + 4);
#pragma unroll
                for (int ai = 0; ai < 2; ++ai)
#pragma unroll
                    for (int m = 0; m < 4; ++m) { f32x4 v0 = acc[ai][bj][m][0] + b0, v1 = acc[ai][bj][m][1] + b1;
                        if (g0 >= 8) {
#pragma unroll
                            for (int e = 0; e < 4; ++e) { v0[e] = logsigmoid_e(v0[e]); v1[e] = logsigmoid_e(v1[e]); } }
                        float* gp = gates + (size_t)(row0 + ai * HALF + m * 16) * 16 + g0;
                        *(f32x4*)gp = v0; *(f32x4*)(gp + 4) = v1; }
            }
        }
    }
};
struct EpiOut {
    static constexpr bool PERM = true, AFTER_DRAIN = false;
    bf16_t* C;
    __device__ __forceinline__ void operator()(const f32x4 (&acc)[2][2][4][2], const Unit& u, int wr, int wc, int fr, int fq) const {
        const int row0 = u.pm * BM + wr * 64 + fr, col0 = u.pn * BM + wc * 32 + 8 * fq;
#pragma unroll
        for (int ai = 0; ai < 2; ++ai)
#pragma unroll
            for (int m = 0; m < 4; ++m) { bf16_t* rowp = C + (size_t)(row0 + ai * HALF + m * 16) * 1024 + col0;
#pragma unroll
                for (int bj = 0; bj < 2; ++bj) { const f32x4 v0 = acc[ai][bj][m][0], v1 = acc[ai][bj][m][1];
                    u32x4 w; w.x = cvt_pk_bf16(v0[0], v0[1]); w.y = cvt_pk_bf16(v0[2], v0[3]); w.z = cvt_pk_bf16(v1[0], v1[1]); w.w = cvt_pk_bf16(v1[2], v1[3]);
                    *(u32x4*)(rowp + bj * HALF) = w; } }
    }
};

template <class Epi, class Sched, bool ALIGN_EPI = false, bool SP2 = false>
__device__ __forceinline__ void gemm_phase(PG8_LAS unsigned char* lds, const Gemm g, const Sched& S, const Epi& E) {
    const int tid = threadIdx.x, wid = __builtin_amdgcn_readfirstlane(tid >> 6), lane = tid & 63, wr = wid >> 2, wc = wid & 3, fr = lane & 15, fq = lane >> 4;
    const int K = g.K, nt = K / BK;
    unsigned voffA[2], voffB[2];
#pragma unroll
    for (int i = 0; i < 2; ++i) { int R, C; stage_rc(tid * 16 + i * 8192, R, C); const int Rb = Epi::PERM ? ((R & ~31) + perm32(R & 31)) : R;
        voffA[i] = (unsigned)(R * K + C) * 2u; voffB[i] = (unsigned)(Rb * K + C) * 2u; }
    const size_t kstep = (size_t)(BK * 2);
    const size_t hstep = (size_t)HALF * K * 2;
    const size_t tstep = 2 * hstep;
    const unsigned ldsw = (unsigned)wid * 1024u;
    const int aoff = lds_byte(wr * 64 + fr, fq * 8), boff = lds_byte(wc * 32 + fr, fq * 8);
#define PG8_SA(b, h) (((b) * 2 + (h)) * HTB)
#define PG8_SB(b, h) ((4 + (b) * 2 + (h)) * HTB)
#define PG8_STAGE(bufoff, gbase, voff) do { _Pragma("unroll") for (int _i = 0; _i < 2; ++_i) \
        __builtin_amdgcn_global_load_lds((const unsigned*)((const char*)(gbase) + (voff)[_i]), (PG8_LAS unsigned*)(lds + (bufoff) + ldsw + _i * 8192), 16, 0, 0); } while (0)
#define PG8_LDA(dst, b, h) do { _Pragma("unroll") for (int m = 0; m < 4; ++m) _Pragma("unroll") for (int k = 0; k < 2; ++k) dst[m][k] = *(const PG8_LAS bf16x8*)(lds + PG8_SA(b, h) + aoff + m * 2048 + k * 1024); } while (0)
#define PG8_LDB(dst, b, h) do { _Pragma("unroll") for (int n = 0; n < 2; ++n) _Pragma("unroll") for (int k = 0; k < 2; ++k) dst[n][k] = *(const PG8_LAS bf16x8*)(lds + PG8_SB(b, h) + boff + n * 2048 + k * 1024); } while (0)
#define PG8_MMA(ai, bj, At, Bt) do { __builtin_amdgcn_s_setprio(1); _Pragma("unroll") for (int m = 0; m < 4; ++m) _Pragma("unroll") for (int n = 0; n < 2; ++n) _Pragma("unroll") for (int k = 0; k < 2; ++k) \
        acc[ai][bj][m][n] = __builtin_amdgcn_mfma_f32_16x16x32_bf16(Bt[n][k], At[m][k], acc[ai][bj][m][n], 0, 0, 0); __builtin_amdgcn_s_setprio(0); } while (0)
#define PG8_WAIT_V(n) asm volatile("s_waitcnt vmcnt(" #n ")" ::: "memory")
#define PG8_WAIT_L(n) asm volatile("s_waitcnt lgkmcnt(" #n ")" ::: "memory")
#define PG8_BAR __builtin_amdgcn_s_barrier()
#define PG8_SCHED __builtin_amdgcn_sched_barrier(0)
    Unit cur, nxt; int ui = 0;
    if (!S.next(0, cur)) return;
    f32x4 acc[2][2][4][2];
#pragma unroll
    for (int a = 0; a < 2; ++a)
#pragma unroll
        for (int b = 0; b < 2; ++b)
#pragma unroll
            for (int m = 0; m < 4; ++m)
#pragma unroll
                for (int n = 0; n < 2; ++n) acc[a][b][m][n] = (f32x4){0.f, 0.f, 0.f, 0.f};
    bf16x8 At[4][2], B0[2][2], B1[2][2];
    const char* cA = (const char*)g.A + (size_t)cur.pm * tstep; const char* cB = (const char*)g.Bt + (size_t)cur.pn * tstep;
    S.a_ready(cur);
    if constexpr (SP2) {
        PG8_STAGE(PG8_SB(0, 0), cB, voffB); PG8_STAGE(PG8_SB(0, 1), cB + hstep, voffB); PG8_STAGE(PG8_SA(0, 0), cA, voffA); PG8_STAGE(PG8_SA(0, 1), cA + hstep, voffA);
        if (wr == 1) PG8_BAR;
        PG8_WAIT_V(2); PG8_BAR;
        PG8_STAGE(PG8_SB(1, 0), cB + kstep, voffB); PG8_STAGE(PG8_SA(1, 0), cA + kstep, voffA); PG8_STAGE(PG8_SB(1, 1), cB + hstep + kstep, voffB);
        PG8_WAIT_V(6); PG8_BAR;
    } else {
        PG8_STAGE(PG8_SB(0, 0), cB, voffB); PG8_STAGE(PG8_SA(0, 0), cA, voffA); PG8_STAGE(PG8_SB(0, 1), cB + hstep, voffB); PG8_STAGE(PG8_SA(0, 1), cA + hstep, voffA);
        if (wr == 1) PG8_BAR;
        PG8_WAIT_V(4); PG8_BAR;
        PG8_STAGE(PG8_SB(1, 0), cB + kstep, voffB); PG8_STAGE(PG8_SA(1, 0), cA + kstep, voffA); PG8_STAGE(PG8_SB(1, 1), cB + hstep + kstep, voffB);
        PG8_WAIT_V(6); PG8_BAR;
    }
    for (;;) {
        const bool has_next = S.next(ui + 1, nxt);
        const char* nA = has_next ? (const char*)g.A + (size_t)nxt.pm * tstep : cA; const char* nB = has_next ? (const char*)g.Bt + (size_t)nxt.pn * tstep : cB;
        for (int t = 0; t < nt; t += 2) {
            const bool last = (t == nt - 2);
            const char* a1 = cA + (size_t)(t + 1) * kstep;
            const char* a2 = last ? nA : cA + (size_t)(t + 2) * kstep; const char* b2 = last ? nB : cB + (size_t)(t + 2) * kstep;
            const char* a3 = a2 + kstep; const char* b3 = b2 + kstep;
            if (last && has_next) S.a_ready(nxt);
            if constexpr (SP2) {
            PG8_LDB(B0, 0, 0); PG8_LDB(B1, 0, 1); PG8_SCHED; PG8_LDA(At, 0, 0); PG8_STAGE(PG8_SA(1, 1), a1 + hstep, voffA);
            PG8_WAIT_V(8); PG8_WAIT_L(0); PG8_BAR; PG8_MMA(0, 0, At, B0); PG8_MMA(0, 1, At, B1); PG8_BAR; PG8_SCHED;
            PG8_LDA(At, 0, 1); PG8_STAGE(PG8_SB(0, 0), b2, voffB); PG8_STAGE(PG8_SB(0, 1), b2 + hstep, voffB); PG8_STAGE(PG8_SA(0, 0), a2, voffA);
            PG8_WAIT_V(8); PG8_WAIT_L(0); PG8_BAR; PG8_MMA(1, 0, At, B0); PG8_MMA(1, 1, At, B1); PG8_BAR; PG8_SCHED;
            PG8_LDB(B0, 1, 0); PG8_LDB(B1, 1, 1); PG8_SCHED; PG8_LDA(At, 1, 0); PG8_STAGE(PG8_SA(0, 1), a2 + hstep, voffA);
            PG8_WAIT_V(8); PG8_WAIT_L(0); PG8_BAR; PG8_MMA(0, 0, At, B0); PG8_MMA(0, 1, At, B1); PG8_BAR; PG8_SCHED;
            PG8_LDA(At, 1, 1); PG8_STAGE(PG8_SB(1, 0), b3, voffB); PG8_STAGE(PG8_SB(1, 1), b3 + hstep, voffB); PG8_STAGE(PG8_SA(1, 0), a3, voffA);
            PG8_WAIT_V(8); PG8_WAIT_L(0); PG8_BAR; PG8_MMA(1, 0, At, B0); PG8_MMA(1, 1, At, B1); PG8_BAR; PG8_SCHED;
            } else {
            PG8_LDB(B0, 0, 0); PG8_SCHED; PG8_LDA(At, 0, 0); PG8_STAGE(PG8_SA(1, 1), a1 + hstep, voffA);
            PG8_WAIT_L(8); PG8_BAR; PG8_WAIT_L(0); PG8_MMA(0, 0, At, B0); PG8_BAR; PG8_SCHED;
            PG8_LDB(B1, 0, 1); PG8_STAGE(PG8_SB(0, 0), b2, voffB);
            PG8_BAR; PG8_WAIT_L(0); PG8_MMA(0, 1, At, B1); PG8_BAR;
            PG8_LDA(At, 0, 1); PG8_STAGE(PG8_SA(0, 0), a2, voffA);
            PG8_BAR; PG8_WAIT_L(0); PG8_MMA(1, 0, At, B0); PG8_BAR; PG8_SCHED;
            PG8_STAGE(PG8_SB(0, 1), b2 + hstep, voffB);
            PG8_WAIT_V(6); PG8_BAR; PG8_MMA(1, 1, At, B1); PG8_BAR;
            PG8_LDB(B0, 1, 0); PG8_SCHED; PG8_LDA(At, 1, 0); PG8_STAGE(PG8_SA(0, 1), a2 + hstep, voffA);
            PG8_WAIT_L(8); PG8_BAR; PG8_WAIT_L(0); PG8_MMA(0, 0, At, B0); PG8_BAR; PG8_SCHED;
            PG8_LDB(B1, 1, 1); PG8_STAGE(PG8_SB(1, 0), b3, voffB);
            PG8_BAR; PG8_WAIT_L(0); PG8_MMA(0, 1, At, B1); PG8_BAR;
            PG8_LDA(At, 1, 1); PG8_STAGE(PG8_SA(1, 0), a3, voffA);
            PG8_BAR; PG8_WAIT_L(0); PG8_MMA(1, 0, At, B0); PG8_BAR; PG8_SCHED;
            PG8_STAGE(PG8_SB(1, 1), b3 + hstep, voffB);
            PG8_WAIT_V(6); PG8_BAR; PG8_MMA(1, 1, At, B1); PG8_BAR;
            }
        }
        if constexpr (ALIGN_EPI) { if (wr == 0) PG8_BAR; }
        if constexpr (!Epi::AFTER_DRAIN) { E(acc, cur, wr, wc, fr, fq); S.done(cur); }
        if (!has_next) break;
#pragma unroll
        for (int a = 0; a < 2; ++a)
#pragma unroll
            for (int b = 0; b < 2; ++b)
#pragma unroll
                for (int m = 0; m < 4; ++m)
#pragma unroll
                    for (int n = 0; n < 2; ++n) acc[a][b][m][n] = (f32x4){0.f, 0.f, 0.f, 0.f};
        cur = nxt; cA = nA; cB = nB; ++ui;
        if constexpr (ALIGN_EPI) { if (wr == 1) PG8_BAR; }
    }
    PG8_WAIT_V(0);
    if constexpr (!ALIGN_EPI) { if (wr == 0) PG8_BAR; }
    PG8_BAR;
    if constexpr (Epi::AFTER_DRAIN) { E.fused(acc, cur, wr, wc, fr, fq, lds, wid, lane); S.done(cur); }
#undef PG8_SA
#undef PG8_SB
#undef PG8_STAGE
#undef PG8_LDA
#undef PG8_LDB
#undef PG8_MMA
#undef PG8_WAIT_V
#undef PG8_WAIT_L
#undef PG8_BAR
#undef PG8_SCHED
}
}
constexpr int RING_OFF = 0, RING_BYTES = 131072;
constexpr int LDSCTL_OFF = RING_BYTES, MISC_OFF = LDSCTL_OFF + 320;
constexpr int LDS_BYTES = 147456;
constexpr int CW_BAR = 4096;

#define GAS __attribute__((address_space(1)))
#define LAS __attribute__((address_space(3)))
typedef unsigned short bf16;
typedef unsigned v4u __attribute__((ext_vector_type(4)));
typedef float f32x4 __attribute__((ext_vector_type(4)));
typedef short bf16x8 __attribute__((ext_vector_type(8)));
typedef GAS unsigned gu32;
#define RLX_AGENT __ATOMIC_RELAXED, __HIP_MEMORY_SCOPE_AGENT
#define LDS_WAIT() asm volatile("s_waitcnt lgkmcnt(0)" ::: "memory")
#define VM_WAIT() asm volatile("s_waitcnt vmcnt(0)" ::: "memory")
__device__ __forceinline__ unsigned f2bfu(float f) { unsigned u = __builtin_bit_cast(unsigned, f); return (u + 0x7fffu + ((u >> 16) & 1u)) >> 16; }
__device__ __forceinline__ bf16 f2bf(float f) { return (bf16)f2bfu(f); }
typedef float f32x2_t __attribute__((ext_vector_type(2))); typedef __bf16 bf16x2_t __attribute__((ext_vector_type(2)));
__device__ __forceinline__ unsigned pk2(float lo, float hi) { f32x2_t v = {lo, hi}; bf16x2_t b = __builtin_convertvector(v, bf16x2_t); return __builtin_bit_cast(unsigned, b); }
__device__ __forceinline__ float xor16_max(float v) { auto r = __builtin_amdgcn_permlane16_swap(__float_as_uint(v), __float_as_uint(v), false, false); return fmaxf(__uint_as_float(r[0]), __uint_as_float(r[1])); }
__device__ __forceinline__ float xor32_max(float v) { auto r = __builtin_amdgcn_permlane32_swap(__float_as_uint(v), __float_as_uint(v), false, false); return fmaxf(__uint_as_float(r[0]), __uint_as_float(r[1])); }
__device__ __forceinline__ float xor16_sum(float v) { auto r = __builtin_amdgcn_permlane16_swap(__float_as_uint(v), __float_as_uint(v), false, false); return __uint_as_float(r[0]) + __uint_as_float(r[1]); }
__device__ __forceinline__ float xor32_sum(float v) { auto r = __builtin_amdgcn_permlane32_swap(__float_as_uint(v), __float_as_uint(v), false, false); return __uint_as_float(r[0]) + __uint_as_float(r[1]); }
__device__ __forceinline__ float bf2f(bf16 v) { return __uint_as_float(((unsigned)v) << 16); }
__device__ __forceinline__ float silu_f(float v) { return v * __builtin_amdgcn_rcpf(1.f + __expf(-v)); }
__device__ __forceinline__ float sigmoid_f(float v) { return __builtin_amdgcn_rcpf(1.f + __expf(-v)); }
#define DPP_ADD_(v, ctrl) ((v) + __int_as_float(__builtin_amdgcn_update_dpp(0, __float_as_int(v), (ctrl), 0xF, 0xF, false)))
__device__ __forceinline__ float group8_sum(float v) {
    v = DPP_ADD_(v, 0xB1); v = DPP_ADD_(v, 0x4E); v = DPP_ADD_(v, 0x141); return v; }
__device__ __forceinline__ float wave_sum(float v) {
    v = group8_sum(v); v = DPP_ADD_(v, 0x140);
    { auto r = __builtin_amdgcn_permlane16_swap(__float_as_uint(v), __float_as_uint(v), false, false); v = __uint_as_float(r[0]) + __uint_as_float(r[1]); }
    { auto r = __builtin_amdgcn_permlane32_swap(__float_as_uint(v), __float_as_uint(v), false, false); v = __uint_as_float(r[0]) + __uint_as_float(r[1]); }
    return v;
}
__device__ __forceinline__ float rdlane(float v, int i) { return __int_as_float(__builtin_amdgcn_readlane(__float_as_int(v), i)); }


#ifndef PROBE_T
#define PROBE_T 0
#endif
#define TS_LDS(F) ((volatile LAS unsigned long long*)((F).lds + LDSCTL_OFF + 128))
#define TS_START(F, id) do { if (PROBE_T == (id) && blockIdx.x == 0 && (F).tid == 0) TS_LDS(F)[1] = __builtin_amdgcn_s_memtime(); } while (0)
#define TS_STOP(F, id)  do { if (PROBE_T == (id) && blockIdx.x == 0 && (F).tid == 0) TS_LDS(F)[0] += __builtin_amdgcn_s_memtime() - TS_LDS(F)[1]; } while (0)
#define XB_TMO      128
#define XB_XCNT(j)  (256  + 64 * (j))
#define XB_XSUB(j)  (1280 + 64 * (j))
#define XB_XGEN(j)  (2304 + 64 * (j))
#define XB_TOP      3328
#define XB_TOPGEN   3392
#define XCD_BAR_WORDS 3456
#define XB_SPIN_CAP (1u << 18)

__device__ __forceinline__ unsigned xb_ld(unsigned* p)              { return __hip_atomic_load(p, __ATOMIC_RELAXED, __HIP_MEMORY_SCOPE_AGENT); }
__device__ __forceinline__ unsigned xb_add(unsigned* p, unsigned v) { return __hip_atomic_fetch_add(p, v, __ATOMIC_RELAXED, __HIP_MEMORY_SCOPE_AGENT); }
__device__ __forceinline__ unsigned xb_xcc_id() { return (unsigned)__builtin_amdgcn_s_getreg((3 << 11) | 20) & 0xFu; }
#define XB_SPIN(cond, bar) do { unsigned _sp = 0; while (cond) { __builtin_amdgcn_s_sleep(1); \
    if ((++_sp & 255u) == 0u) { if (xb_ld(&(bar)[XB_TMO])) break; if (_sp > XB_SPIN_CAP) { atomicAdd(&(bar)[XB_TMO], 1u); break; } } } } while (0)

struct XcdBarrier {
    unsigned* bar; unsigned x;
    volatile LAS unsigned* st;
};

__device__ __forceinline__ XcdBarrier xcd_barrier_post(unsigned* bar, volatile LAS unsigned* st) {
    XcdBarrier b; b.bar = bar; b.x = xb_xcc_id(); b.st = st;
    if (threadIdx.x == 0) (void)xb_add(&bar[XB_XCNT(b.x)], 1u);
    return b;
}
__device__ __forceinline__ void xcd_barrier_complete(unsigned* bar, unsigned x, unsigned& nloc, unsigned& nx) {
    const unsigned G = gridDim.x * gridDim.y * gridDim.z;
    unsigned sum, cnt, mine, sp = 0u;
    for (;;) {
        sum = 0u; cnt = 0u; mine = 0u;
#pragma unroll
        for (unsigned j = 0; j < 16; ++j) { const unsigned c = xb_ld(&bar[XB_XCNT(j)]); sum += c; cnt += (c > 0u) ? 1u : 0u; mine = (j == x) ? c : mine; }
        if (sum == G) break;
        __builtin_amdgcn_s_sleep(1);
        if ((++sp & 255u) == 0u) { if (xb_ld(&bar[XB_TMO])) break; if (sp > XB_SPIN_CAP) { atomicAdd(&bar[XB_TMO], 1u); break; } }
    }
    nloc = mine > 0u ? mine : 1u; nx = cnt > 0u ? cnt : 1u;
}

__device__ __forceinline__ void xcd_barrier(const XcdBarrier& b) {
    asm volatile("s_waitcnt vmcnt(0)" ::: "memory");
    __syncthreads();
    if (threadIdx.x == 0) {
        unsigned* bar = b.bar;
        __builtin_amdgcn_s_waitcnt(0);
        unsigned nloc = b.st[0], nx = b.st[1];
        if (nloc == 0u) { xcd_barrier_complete(bar, b.x, nloc, nx); b.st[0] = nloc; b.st[1] = nx; }
        const unsigned old = xb_add(&bar[XB_XSUB(b.x)], 1u);
        const unsigned gen = old / nloc;
        if (old + 1u == (gen + 1u) * nloc) {
            __builtin_amdgcn_fence(__ATOMIC_RELEASE, "agent");
            asm volatile("s_waitcnt vmcnt(0)" ::: "memory");
            const unsigned og = xb_add(&bar[XB_TOP], 1u);
            const unsigned tg = og / nx;
            if (og + 1u == (tg + 1u) * nx) xb_add(&bar[XB_TOPGEN], 1u);
            else XB_SPIN(xb_ld(&bar[XB_TOPGEN]) == tg, bar);
            __builtin_amdgcn_fence(__ATOMIC_ACQUIRE, "agent");
            xb_add(&bar[XB_XGEN(b.x)], 1u);
            asm volatile("s_waitcnt vmcnt(0)" ::: "memory");
        } else {
            XB_SPIN(xb_ld(&bar[XB_XGEN(b.x)]) == gen, bar);
            __builtin_amdgcn_fence(__ATOMIC_ACQUIRE, "agent");
            asm volatile("s_waitcnt vmcnt(0)" ::: "memory");
        }
    }
    __syncthreads();
}

struct Ctx {
    LAS unsigned char* lds; int tid, lane, wave, vcu, G, gw, NGW;
    const float *x, *c, *ctx, *c_ctx, *w_mod, *b_mod, *g_pre, *g_post, *w_in, *w_out, *hgrn_lb, *hgrn_gn, *gate_b, *mlstm_gn, *na_rpb;
    float* out; bf16 *wt_in, *wt_out, *hxy, *P; float *mod, *gates, *ctx1, *stm, *sth, *rope; bf16 *otm, *oth, *UX;
};

__device__ __forceinline__ void transpose_item(const float* W, int N, int Nnew, bool remap, bf16* WT, LAS float* scr, int item, int lane) {
    const int nblk = Nnew / 32, kb = item / nblk, nb = item % nblk, k0 = 64 * kb, n0 = 32 * nb;
    const int rg = lane >> 3, c4 = (lane & 7) * 4, nn = n0 + c4;
    int no = nn; if (remap) no = nn < 3200 ? nn : (nn < 4736 ? nn + 16 : (nn < 4752 ? 3200 + nn - 4736 : -1));
    f32x4 v[8];
#pragma unroll
    for (int j = 0; j < 8; ++j) v[j] = no >= 0 ? *(const f32x4*)(W + (size_t)(k0 + 8 * j + rg) * N + no) : (f32x4){0.f, 0.f, 0.f, 0.f};
#pragma unroll
    for (int j = 0; j < 8; ++j) { LAS float* d = scr + (8 * j + rg) * 33 + c4; d[0] = v[j][0]; d[1] = v[j][1]; d[2] = v[j][2]; d[3] = v[j][3]; }
    LDS_WAIT(); asm volatile("" ::: "memory");
    const int c = lane & 7;
#pragma unroll
    for (int j = 0; j < 4; ++j) { const int n = (lane >> 3) + 8 * j; const LAS float* s = scr + (8 * c) * 33 + n;
        v4u o; o.x = pk2(s[0 * 33], s[1 * 33]); o.y = pk2(s[2 * 33], s[3 * 33]); o.z = pk2(s[4 * 33], s[5 * 33]); o.w = pk2(s[6 * 33], s[7 * 33]);
        *(GAS v4u*)(WT + (size_t)(n0 + n) * 1024 + k0 + 8 * c) = o; }
    LDS_WAIT(); asm volatile("" ::: "memory");
}
__device__ __forceinline__ void phase_p0(const Ctx& F) {
    if (F.vcu < 96) {
        LAS float* tab = (LAS float*)(F.lds);
        LAS float* part = (LAS float*)(F.lds + 36864);
        for (int i = F.tid; i < 9 * 1024; i += 512) { const int r = i >> 10, k = i & 1023; const float v = r < 8 ? F.c[r * 1024 + k] : F.c_ctx[k]; tab[i] = silu_f(v); }
        __syncthreads();
        for (int it = F.vcu; it < 96; it += F.G) {
            const int l = it / 48, jb = it % 48;
            const int rsub = F.lane >> 4, c4 = (F.lane & 15) * 4;
            float acc[9][4];
#pragma unroll
            for (int r = 0; r < 9; ++r) { acc[r][0] = acc[r][1] = acc[r][2] = acc[r][3] = 0.f; }
            const float* wp = F.w_mod + ((size_t)l * 1024 + F.wave * 128 + rsub) * 3072 + jb * 64 + c4;
            f32x4 wv[32];
#pragma unroll
            for (int j = 0; j < 32; ++j) wv[j] = *(const f32x4*)(wp + (size_t)(4 * j) * 3072);
#pragma unroll
            for (int j = 0; j < 32; ++j)
#pragma unroll
                for (int r = 0; r < 9; ++r) { const float t = tab[r * 1024 + F.wave * 128 + 4 * j + rsub]; acc[r][0] += t * wv[j][0]; acc[r][1] += t * wv[j][1]; acc[r][2] += t * wv[j][2]; acc[r][3] += t * wv[j][3]; }
#pragma unroll
            for (int r = 0; r < 9; ++r)
#pragma unroll
                for (int e = 0; e < 4; ++e) acc[r][e] = xor32_sum(xor16_sum(acc[r][e]));
            if (rsub == 0) {
#pragma unroll
                for (int r = 0; r < 9; ++r) *(LAS f32x4*)(part + (F.wave * 9 + r) * 64 + c4) = (f32x4){acc[r][0], acc[r][1], acc[r][2], acc[r][3]}; }
            __syncthreads();
            for (int i = F.tid; i < 9 * 64; i += 512) { const int r = i >> 6, j = i & 63; float s = 0.f;
#pragma unroll
                for (int w = 0; w < 8; ++w) s += part[(w * 9 + r) * 64 + j];
                F.mod[((size_t)l * 9 + r) * 3072 + jb * 64 + j] = s + F.b_mod[l * 3072 + jb * 64 + j]; }
            __syncthreads();
        }
    }
    if (F.vcu == 96 % F.G) for (int i = F.tid; i < 64 * 24; i += 512) { const int pos = i / 24, f = i % 24; const float ang = (float)pos * expf(-(float)(2 * f) * (1.f / 48.f) * 9.210340371976184f); F.rope[2 * i] = cosf(ang); F.rope[2 * i + 1] = sinf(ang); }
    __syncthreads();
    LAS float* scr = (LAS float*)(F.lds + F.wave * 16384);
    constexpr int I_IN = 16 * (NPAD / 32);
    const int gwr = F.NGW - 1 - F.gw;
    for (int it = gwr; it < I_IN; it += F.NGW) transpose_item(F.w_in, PIN, NPAD, true, F.wt_in, scr, it, F.lane);
}
__device__ __forceinline__ void phase_p1_transposes(const Ctx& F) {
    LAS float* scr = (LAS float*)(F.lds + F.wave * 16384);
    constexpr int I_IN = 16 * (NPAD / 32), I_OUT = 16 * 32;
    for (int it = F.gw; it < I_IN + 2 * I_OUT; it += F.NGW) {
        if (it < I_OUT) transpose_item(F.w_out, 1024, 1024, false, F.wt_out, scr, it, F.lane);
        else if (it < I_OUT + I_IN) transpose_item(F.w_in + (size_t)1024 * PIN, PIN, NPAD, true, F.wt_in + (size_t)NPAD * 1024, scr, it - I_OUT, F.lane);
        else transpose_item(F.w_out + (size_t)1024 * 1024, 1024, 1024, false, F.wt_out + (size_t)1024 * 1024, scr, it - I_OUT - I_IN, F.lane);
    }
}

struct RowPar { float4 g[4], a[4], b[4]; };
__device__ __forceinline__ void load_par(RowPar& p, const float* g, const float* a, const float* b, int lane) {
#pragma unroll
    for (int j = 0; j < 4; ++j) { const int d = 4 * (lane + 64 * j); p.g[j] = *(const float4*)(g + d); p.a[j] = *(const float4*)(a + d); p.b[j] = *(const float4*)(b + d); }
}
__device__ __forceinline__ void prenorm_store(const float4 (&v)[4], float ss, const RowPar& p, bf16* dst, int lane) {
    const float rinv = __builtin_amdgcn_rsqf(ss * (1.f / 1024.f) + EPS);
#pragma unroll
    for (int j = 0; j < 4; ++j) {
        const int d = 4 * (lane + 64 * j);
        const float o0 = v[j].x * rinv * p.g[j].x * (1.f + p.a[j].x) + p.b[j].x, o1 = v[j].y * rinv * p.g[j].y * (1.f + p.a[j].y) + p.b[j].y;
        const float o2 = v[j].z * rinv * p.g[j].z * (1.f + p.a[j].z) + p.b[j].z, o3 = v[j].w * rinv * p.g[j].w * (1.f + p.a[j].w) + p.b[j].w;
        uint2 w; w.x = pk2(o0, o1); w.y = pk2(o2, o3);
        *(uint2*)(dst + d) = w;
    }
}
__device__ __forceinline__ void phase_prenorm0(const Ctx& F) {
    auto rowsrc = [&](int m) -> const float* { return m < MX ? F.x + (size_t)m * 1024 : F.ctx + (size_t)(m - MX) * 1024; };
    const int nrow = (M + F.NGW - 1) / F.NGW, m0 = F.gw * nrow, m1 = min(m0 + nrow, M);
    if (m0 >= m1) return;
    float4 nv[4];
#pragma unroll
    for (int j = 0; j < 4; ++j) nv[j] = ((const float4*)rowsrc(m0))[F.lane + 64 * j];
    RowPar p; int rcur = -1;
    for (int m = m0; m < m1; ++m) {
        const int r = m < MX ? m / S : 8;
        if (r != rcur) { const float* mod_r = F.mod + (size_t)r * 3072; load_par(p, F.g_pre, mod_r + 1024, mod_r, F.lane); rcur = r; }
        float4 v[4];
#pragma unroll
        for (int j = 0; j < 4; ++j) v[j] = nv[j];
        if (m + 1 < m1) {
#pragma unroll
            for (int j = 0; j < 4; ++j) nv[j] = ((const float4*)rowsrc(m + 1))[F.lane + 64 * j]; }
        float ss = 0.f;
#pragma unroll
        for (int j = 0; j < 4; ++j) ss += v[j].x * v[j].x + v[j].y * v[j].y + v[j].z * v[j].z + v[j].w * v[j].w;
        ss = wave_sum(ss);
        prenorm_store(v, ss, p, F.hxy + (size_t)m * 1024, F.lane);
    }
}
__device__ __forceinline__ void phase_post(const Ctx& F, int l) {
    const int Ml = l == 0 ? M : MX;
    const float* mod_l = F.mod + (size_t)l * 9 * 3072; const float* g_post_l = F.g_post + l * 1024;
    auto rowsrc = [&](int m) -> const float* { return m < MX ? (l == 0 ? F.x : F.out) + (size_t)m * 1024 : F.ctx + (size_t)(m - MX) * 1024; };
    const int nrow = (Ml + F.NGW - 1) / F.NGW, m0 = F.gw * nrow, m1 = min(m0 + nrow, Ml);
    if (m0 >= m1) return;
    float4 nx[4]; uint2 nu[4];
#pragma unroll
    for (int j = 0; j < 4; ++j) { nx[j] = ((const float4*)rowsrc(m0))[F.lane + 64 * j]; nu[j] = ((const uint2*)(F.UX + (size_t)m0 * 1024))[F.lane + 64 * j]; }
    float4 pg[4], pt[4]; RowPar p2; int rcur = -1;
#pragma unroll
    for (int j = 0; j < 4; ++j) pg[j] = *(const float4*)(g_post_l + 4 * (F.lane + 64 * j));
    for (int m = m0; m < m1; ++m) {
        float* dst; int r;
        if (m < MX) { dst = F.out + (size_t)m * 1024; r = m / S; } else { dst = F.ctx1 + (size_t)(m - MX) * 1024; r = 8; }
        if (r != rcur) {
#pragma unroll
            for (int j = 0; j < 4; ++j) pt[j] = *(const float4*)(mod_l + r * 3072 + 2048 + 4 * (F.lane + 64 * j));
            if (l == 0) load_par(p2, F.g_pre + 1024, F.mod + (size_t)(9 + r) * 3072 + 1024, F.mod + (size_t)(9 + r) * 3072, F.lane);
            rcur = r; }
        float4 xr[4], u[4]; float ss = 0.f;
#pragma unroll
        for (int j = 0; j < 4; ++j) { xr[j] = nx[j]; const uint2 w = nu[j];
            u[j].x = __uint_as_float(w.x << 16); u[j].y = __uint_as_float(w.x & 0xffff0000u); u[j].z = __uint_as_float(w.y << 16); u[j].w = __uint_as_float(w.y & 0xffff0000u);
            ss += u[j].x * u[j].x + u[j].y * u[j].y + u[j].z * u[j].z + u[j].w * u[j].w; }
        if (m + 1 < m1) {
#pragma unroll
            for (int j = 0; j < 4; ++j) { nx[j] = ((const float4*)rowsrc(m + 1))[F.lane + 64 * j]; nu[j] = ((const uint2*)(F.UX + (size_t)(m + 1) * 1024))[F.lane + 64 * j]; } }
        ss = wave_sum(ss);
        const float rinv = __builtin_amdgcn_rsqf(ss * (1.f / 1024.f) + EPS);
        float ss2 = 0.f;
#pragma unroll
        for (int j = 0; j < 4; ++j) {
            const int d = 4 * (F.lane + 64 * j);
            const float4 g = pg[j], t = pt[j], xv = xr[j];
            float4 o; o.x = xv.x + t.x * (u[j].x * rinv * g.x); o.y = xv.y + t.y * (u[j].y * rinv * g.y); o.z = xv.z + t.z * (u[j].z * rinv * g.z); o.w = xv.w + t.w * (u[j].w * rinv * g.w);
            *(float4*)(dst + d) = o; u[j] = o; ss2 += o.x * o.x + o.y * o.y + o.z * o.z + o.w * o.w;
        }
        if (l == 0) { ss2 = wave_sum(ss2); prenorm_store(u, ss2, p2, F.hxy + (size_t)m * 1024, F.lane); }
    }
}


typedef short s16x4 __attribute__((ext_vector_type(4)));
typedef short v4i16_t __attribute__((ext_vector_type(4)));
__device__ __forceinline__ s16x4 tr_read(const LAS bf16* p) { return __builtin_bit_cast(s16x4, __builtin_amdgcn_ds_read_tr16_b64_v4i16((LAS v4i16_t*)p)); }
__device__ __forceinline__ bf16x8 tr_frag(const LAS bf16* T, int stride, int rowA, int rowB, int col0, int lane) {
    const int q = (lane >> 2) & 3, p = lane & 3;
    const s16x4 lo = tr_read(T + (rowA + q) * stride + col0 + 4 * p), hi = tr_read(T + (rowB + q) * stride + col0 + 4 * p);
    return (bf16x8){lo[0], lo[1], lo[2], lo[3], hi[0], hi[1], hi[2], hi[3]};
}
__device__ __forceinline__ bf16x8 rm_frag(const LAS bf16* T, int stride, int row, int k0) { return *(const LAS bf16x8*)(T + row * stride + k0); }
__device__ __forceinline__ f32x4 mfma16(bf16x8 a, bf16x8 b, f32x4 c) { return __builtin_amdgcn_mfma_f32_16x16x32_bf16(a, b, c, 0, 0, 0); }
typedef unsigned v2u __attribute__((ext_vector_type(2)));
typedef float f32x2 __attribute__((ext_vector_type(2)));
__device__ __forceinline__ void unpack8(const v4u w, float* f) {
    f[0] = __uint_as_float(w.x << 16); f[1] = __uint_as_float(w.x & 0xffff0000u); f[2] = __uint_as_float(w.y << 16); f[3] = __uint_as_float(w.y & 0xffff0000u);
    f[4] = __uint_as_float(w.z << 16); f[5] = __uint_as_float(w.z & 0xffff0000u); f[6] = __uint_as_float(w.w << 16); f[7] = __uint_as_float(w.w & 0xffff0000u);
}
__device__ __forceinline__ v4u pack8(const float* f) { v4u w; w.x = pk2(f[0], f[1]); w.y = pk2(f[2], f[3]); w.z = pk2(f[4], f[5]); w.w = pk2(f[6], f[7]); return w; }

__device__ __forceinline__ float wave_scan_incl(float x) {
    int v = __float_as_int(x);
#define DPP_ADD(ctrl, rmask) v = __float_as_int(__int_as_float(v) + __int_as_float(__builtin_amdgcn_update_dpp(0, v, ctrl, rmask, 0xF, false)))
    DPP_ADD(0x111, 0xF); DPP_ADD(0x112, 0xF); DPP_ADD(0x114, 0xF); DPP_ADD(0x118, 0xF); DPP_ADD(0x142, 0xA); DPP_ADD(0x143, 0xC);
#undef DPP_ADD
    return __int_as_float(v);
}
#define LDS_FENCE() asm volatile("" ::: "memory")
namespace ml {
constexpr int QSTR = 104, VSTR = 120;
constexpr int OFF_QS = 0, OFF_KS = OFF_QS + 64 * QSTR * 2, OFF_VS = OFF_KS + 64 * QSTR * 2, OFF_CT = OFF_VS + 64 * VSTR * 2;
constexpr int OFF_HT = OFF_CT + 2 * 112 * QSTR * 2, OFF_DEN = OFF_HT + 64 * 100 * 4, OFF_ROPE = OFF_DEN + 256, OFF_END = OFF_ROPE + 64 * 24 * 8;
static_assert(OFF_END <= RING_BYTES && 6 * 7 * 64 * 16 <= OFF_HT, "mlstm LDS");
constexpr int ST_FLOATS = 96 * 112 + 16;
}
constexpr int NSEG = 4, SEGTOK = S / NSEG, SEGCH = SEGTOK / 64;
struct MlJob { int b, h, isctx, t0, nchunk; };

__device__ __forceinline__ void mlstm_dir(const Ctx& F, int l, const MlJob jb, int dir, int fold_r, int emit_slot, int mode, bf16* otmp, float* ST) {
    using namespace ml;
    int tid_ = F.tid; asm volatile("" : "+v"(tid_));
    const int w = __builtin_amdgcn_readfirstlane(tid_ >> 6);
    const bool tsel = (mode != 0) && !jb.isctx && l == 0;
    if (tsel) TS_START(F, 10);
    LAS bf16* QS = (LAS bf16*)(F.lds + OFF_QS); LAS bf16* KS = (LAS bf16*)(F.lds + OFF_KS); LAS bf16* VS = (LAS bf16*)(F.lds + OFF_VS);
    LAS bf16* CT0 = (LAS bf16*)(F.lds + OFF_CT); LAS float* HT = (LAS float*)(F.lds + OFF_HT); LAS float* DEN = (LAS float*)(F.lds + OFF_DEN);
    const LAS f32x2* ROPE = (const LAS f32x2*)(F.lds + OFF_ROPE);
    const int rowbase = jb.isctx ? MX + jb.b * CTX : jb.b * S;
    const int h = jb.h; const bf16* P = F.P;
    float* STd = ST + (size_t)(((jb.b * 4 + h) * 2 + dir) * 8) * ST_FLOATS;
    f32x4 Cst[7];
#pragma unroll
    for (int et = 0; et < 7; ++et) Cst[et] = (f32x4){0.f, 0.f, 0.f, 0.f};
    if (fold_r >= 0) {
        LAS f32x4* FOLD = (LAS f32x4*)(F.lds + OFF_QS);
        float wk[8];
        { float bs[8]; bs[0] = 0.f;
#pragma unroll
          for (int k = 1; k < NSEG; ++k) bs[k] = STd[(size_t)k * ST_FLOATS + 96 * 112];
          float run = 1.f;
#pragma unroll
          for (int k = NSEG - 1; k >= 0; --k) { wk[k] = (k <= fold_r) ? run : 0.f; run = (k >= 1 && k <= fold_r) ? run * __expf(bs[k]) : run; } }
#pragma unroll 2
        for (int p = tid_; p < 6 * 7 * 64; p += 512) {
            f32x4 v[8];
#pragma unroll
            for (int k = 0; k < NSEG; ++k) v[k] = *(const f32x4*)(STd + (size_t)k * ST_FLOATS + 4 * p);
            f32x4 acc = v[0] * wk[0];
#pragma unroll
            for (int k = 1; k < NSEG; ++k) acc += v[k] * wk[k];
            FOLD[p] = acc;
        }
        __syncthreads();
        if (w < 6) {
#pragma unroll
            for (int et = 0; et < 7; ++et) Cst[et] = FOLD[(w * 7 + et) * 64 + (tid_ & 63)];
        }
        __syncthreads();
    }
    asm volatile("" : "+v"(tid_));
    const int tid = tid_, lane = tid & 63, g = lane >> 4, c = lane & 15;
    float Btot = 0.f;
    for (int i = tid; i < 64 * 16; i += 512) { const int s = i >> 4, e = 96 + (i & 15); VS[s * VSTR + e] = (e == 96) ? (bf16)0x3F80 : (bf16)0; }
    if (w < 6) {
#pragma unroll
        for (int et = 0; et < 7; ++et) { v2u v; v.x = pk2(Cst[et][0], Cst[et][1]); v.y = pk2(Cst[et][2], Cst[et][3]); *(LAS v2u*)(CT0 + (16 * et + c) * QSTR + 16 * w + 4 * g) = v; }
    }
    const bool hasqk = tid < 384; const int qk_tok = tid / 6, qk_pi = tid % 6, qk_part = qk_pi / 3, qk_pp = qk_pi % 3, qk_d0 = 48 * qk_part + 8 * qk_pp;
    const int v1_tok = tid / 12, v1_pc = tid % 12; const bool hasv2 = tid < 256; const int v2_tok = (512 + tid) / 12, v2_pc = (512 + tid) % 12;
    struct LoadSet { v4u q0, q1, k0, k1, v1, v2; float ig, lf; };
    LoadSet LA;
    v2u ft[3], fo[3], fz[3];
    const int fi_i = tid >> 3, fi_e0 = 12 * (tid & 7);
#pragma unroll
    for (int q4 = 0; q4 < 3; ++q4) { ft[q4] = (v2u){0u, 0u}; fo[q4] = (v2u){0u, 0u}; fz[q4] = (v2u){0u, 0u}; }
    LA.q0 = LA.q1 = LA.k0 = LA.k1 = LA.v1 = LA.v2 = (v4u){0u, 0u, 0u, 0u}; LA.ig = LA.lf = 0.f;
    auto tok_of = [&](int ci, int i) -> int { return dir == 0 ? jb.t0 + 64 * ci + i : jb.t0 + 64 * (jb.nchunk - 1 - ci) + (63 - i); };
    auto issue_loads = [&](LoadSet& L, int ci) {
        if (hasqk) { const bf16* pr = P + (size_t)(rowbase + tok_of(ci, qk_tok)) * PLD + h * 96 + qk_d0;
            if (mode != 0) { L.q0 = *(const v4u*)(pr + B_Q); L.q1 = *(const v4u*)(pr + B_Q + 24); }
            L.k0 = *(const v4u*)(pr + B_K); L.k1 = *(const v4u*)(pr + B_K + 24); }
        L.v1 = *(const v4u*)(P + (size_t)(rowbase + tok_of(ci, v1_tok)) * PLD + B_V + h * 96 + 8 * v1_pc);
        if (hasv2) L.v2 = *(const v4u*)(P + (size_t)(rowbase + tok_of(ci, v2_tok)) * PLD + B_V + h * 96 + 8 * v2_pc);
        const float* gp = F.gates + (size_t)(rowbase + tok_of(ci, lane)) * 16 + dir * 4 + h; L.ig = gp[0]; L.lf = gp[8];
    };
    auto issue_fin = [&](int ci) {
        const int m = rowbase + tok_of(ci, fi_i); const bf16* tp = otmp + (size_t)m * 384 + h * 96 + fi_e0; const bf16* pr = P + (size_t)m * PLD + h * 96 + fi_e0;
#pragma unroll
        for (int q4 = 0; q4 < 3; ++q4) { ft[q4] = *(const v2u*)(tp + 4 * q4); fo[q4] = *(const v2u*)(pr + B_O + 4 * q4); fz[q4] = *(const v2u*)(pr + B_Z + 4 * q4); }
    };
    auto finalize = [&](int ci) {
            const int i = tid >> 3, sub = tid & 7, e0 = 12 * sub; const int m = rowbase + tok_of(ci, i);
            float hv[12]; const float rden = __builtin_amdgcn_rcpf(fmaxf(fabsf(DEN[i]), 1.f));
#pragma unroll
            for (int q4 = 0; q4 < 3; ++q4) { const f32x4 v = *(const LAS f32x4*)(HT + i * 100 + e0 + 4 * q4); hv[4 * q4] = v[0] * rden; hv[4 * q4 + 1] = v[1] * rden; hv[4 * q4 + 2] = v[2] * rden; hv[4 * q4 + 3] = v[3] * rden; }
            bf16* tp = otmp + (size_t)m * 384 + h * 96 + e0;
            if (mode == 1) {
#pragma unroll
                for (int q4 = 0; q4 < 3; ++q4) { v2u v; v.x = pk2(hv[4 * q4], hv[4 * q4 + 1]); v.y = pk2(hv[4 * q4 + 2], hv[4 * q4 + 3]); *(v2u*)(tp + 4 * q4) = v; }
            } else {
                float ss = 0.f;
#pragma unroll
                for (int q4 = 0; q4 < 3; ++q4) { const v2u v = ft[q4];
                    hv[4 * q4] += __uint_as_float(v.x << 16); hv[4 * q4 + 1] += __uint_as_float(v.x & 0xffff0000u); hv[4 * q4 + 2] += __uint_as_float(v.y << 16); hv[4 * q4 + 3] += __uint_as_float(v.y & 0xffff0000u); }
#pragma unroll
                for (int e = 0; e < 12; ++e) ss += hv[e] * hv[e];
                ss = group8_sum(ss);
                const float rinv = __builtin_amdgcn_rsqf(ss * (1.f / 96.f) + EPS);
                bf16* yp = F.hxy + (size_t)m * 1024 + 256 + h * 96 + e0; const float* gnv = F.mlstm_gn + l * 384 + h * 96 + e0;
#pragma unroll
                for (int q4 = 0; q4 < 3; ++q4) { const v2u ov = fo[q4], zv = fz[q4];
                    const float og[4] = {__uint_as_float(ov.x << 16), __uint_as_float(ov.x & 0xffff0000u), __uint_as_float(ov.y << 16), __uint_as_float(ov.y & 0xffff0000u)};
                    const float zg[4] = {__uint_as_float(zv.x << 16), __uint_as_float(zv.x & 0xffff0000u), __uint_as_float(zv.y << 16), __uint_as_float(zv.y & 0xffff0000u)};
                    float o[4];
#pragma unroll
                    for (int e = 0; e < 4; ++e) o[e] = og[e] * (hv[4 * q4 + e] * rinv * gnv[4 * q4 + e]) * zg[e];
                    v2u v; v.x = pk2(o[0], o[1]); v.y = pk2(o[2], o[3]); *(v2u*)(yp + 4 * q4) = v; }
            }
    };
    struct Packed { v4u k0, k1, q0, q1, v1, v2; float bL, ebL; };
    auto stage_math = [&](LoadSet& L, int ci, Packed& K) {
        const float bcs = wave_scan_incl(L.lf);
        const float qsc = __expf(bcs), ksc = __expf(L.ig - bcs);
        K.bL = rdlane(bcs, 63); K.ebL = __expf(K.bL);
        if (hasqk) {
            const float ks_t = __shfl(ksc, qk_tok), qs_t = __shfl(qsc, qk_tok);
            float cs[8], sn[8];
            if (!jb.isctx) { const int t = tok_of(ci, qk_tok); const int pos = qk_part ? (t & 63) : (t >> 6);
#pragma unroll
                for (int e = 0; e < 8; ++e) { const f32x2 v = ROPE[pos * 24 + 8 * qk_pp + e]; cs[e] = v[0]; sn[e] = v[1]; } }
            else {
#pragma unroll
                for (int e = 0; e < 8; ++e) { cs[e] = 1.f; sn[e] = 0.f; } }
            float a[8], b2[8], o0[8], o1[8];
            unpack8(L.k0, a); unpack8(L.k1, b2);
#pragma unroll
            for (int e = 0; e < 8; ++e) { o0[e] = (a[e] * cs[e] - b2[e] * sn[e]) * ks_t; o1[e] = (b2[e] * cs[e] + a[e] * sn[e]) * ks_t; }
            K.k0 = pack8(o0); K.k1 = pack8(o1);
            if (mode != 0) {
                unpack8(L.q0, a); unpack8(L.q1, b2);
#pragma unroll
                for (int e = 0; e < 8; ++e) { o0[e] = (a[e] * cs[e] - b2[e] * sn[e]) * qs_t; o1[e] = (b2[e] * cs[e] + a[e] * sn[e]) * qs_t; }
                K.q0 = pack8(o0); K.q1 = pack8(o1);
            }
        } else { (void)__shfl(ksc, 0); (void)__shfl(qsc, 0); }
        K.v1 = L.v1; K.v2 = L.v2;
    };
    auto stage_write = [&](const Packed& K) {
        if (hasqk) {
            *(LAS v4u*)(KS + qk_tok * QSTR + qk_d0) = K.k0; *(LAS v4u*)(KS + qk_tok * QSTR + qk_d0 + 24) = K.k1;
            if (mode != 0) { *(LAS v4u*)(QS + qk_tok * QSTR + qk_d0) = K.q0; *(LAS v4u*)(QS + qk_tok * QSTR + qk_d0 + 24) = K.q1; }
        }
        *(LAS v4u*)(VS + v1_tok * VSTR + 8 * v1_pc) = K.v1;
        if (hasv2) *(LAS v4u*)(VS + v2_tok * VSTR + 8 * v2_pc) = K.v2;
    };
    Packed PK; PK.k0 = PK.k1 = PK.q0 = PK.q1 = PK.v1 = PK.v2 = (v4u){0u, 0u, 0u, 0u}; PK.bL = 0.f; PK.ebL = 1.f;
    issue_loads(LA, 0);
    __syncthreads();
    stage_math(LA, 0, PK); stage_write(PK);
    if (jb.nchunk > 1) issue_loads(LA, 1);
    float bL = PK.bL, ebL = PK.ebL;
    __syncthreads();
    if (tsel) TS_STOP(F, 10);
    auto chunk_step = [&](LoadSet& Lnext, int ci) {
        LAS bf16* CTc = CT0 + (ci & 1) * 112 * QSTR; LAS bf16* CTn = CT0 + ((ci + 1) & 1) * 112 * QSTR;
        if (mode == 2) issue_fin(ci);
        if (ci + 1 < jb.nchunk) { stage_math(Lnext, ci + 1, PK); if (ci + 2 < jb.nchunk) issue_loads(Lnext, ci + 2); }
        if (mode != 0) {
            const int tt = w & 3, jh = w >> 2;
            bf16x8 qf[3], kf[4][3];
#pragma unroll
            for (int ks = 0; ks < 3; ++ks) qf[ks] = rm_frag(QS, QSTR, 16 * tt + c, 32 * ks + 8 * g);
#pragma unroll
            for (int ss = 0; ss < 4; ++ss) if (ss <= tt) {
#pragma unroll
                for (int ks = 0; ks < 3; ++ks) kf[ss][ks] = rm_frag(KS, QSTR, 16 * ss + c, 32 * ks + 8 * g); }
            LDS_FENCE();
            f32x4 st[4];
#pragma unroll
            for (int ss = 0; ss < 4; ++ss) { st[ss] = (f32x4){0.f, 0.f, 0.f, 0.f};
                if (ss <= tt) {
#pragma unroll
                    for (int ks = 0; ks < 3; ++ks) st[ss] = mfma16(kf[ss][ks], qf[ks], st[ss]);
                    if (ss == tt) {
#pragma unroll
                        for (int r = 0; r < 4; ++r) if (4 * g + r > c) st[ss][r] = 0.f; }
                } }
            bf16x8 pf[2];
#pragma unroll
            for (int kk = 0; kk < 2; ++kk) { const unsigned u0 = pk2(st[2 * kk][0], st[2 * kk][1]), u1 = pk2(st[2 * kk][2], st[2 * kk][3]), u2 = pk2(st[2 * kk + 1][0], st[2 * kk + 1][1]), u3 = pk2(st[2 * kk + 1][2], st[2 * kk + 1][3]);
                pf[kk] = __builtin_bit_cast(bf16x8, (v4u){u0, u1, u2, u3}); }
#pragma unroll
            for (int eb = 0; eb < 4; eb += 2) {
                bf16x8 vf[2][2], cf[2][3];
#pragma unroll
                for (int e2 = 0; e2 < 2; ++e2) { const int et = 4 * jh + eb + e2;
                    if (et < 7) {
#pragma unroll
                        for (int kk = 0; kk < 2; ++kk) if (2 * kk <= tt) vf[e2][kk] = tr_frag(VS, VSTR, 32 * kk + 4 * g, 32 * kk + 16 + 4 * g, 16 * et, lane);
#pragma unroll
                        for (int ks = 0; ks < 3; ++ks) cf[e2][ks] = rm_frag(CTc, QSTR, 16 * et + c, 32 * ks + 8 * g); } }
                LDS_FENCE();
#pragma unroll
                for (int e2 = 0; e2 < 2; ++e2) { const int et = 4 * jh + eb + e2;
                    if (et < 7) {
                        f32x4 acc = (f32x4){0.f, 0.f, 0.f, 0.f};
#pragma unroll
                        for (int kk = 0; kk < 2; ++kk) if (2 * kk <= tt) acc = mfma16(vf[e2][kk], pf[kk], acc);
#pragma unroll
                        for (int ks = 0; ks < 3; ++ks) acc = mfma16(cf[e2][ks], qf[ks], acc);
                        if (et < 6) *(LAS f32x4*)(HT + (16 * tt + c) * 100 + 16 * et + 4 * g) = acc;
                        else if (g == 0) DEN[16 * tt + c] = acc[0];
                    } }
            }
        }
        if (w < 6) {
#pragma unroll
            for (int kk = 0; kk < 2; ++kk) {
                bf16x8 vf[7]; const bf16x8 af = tr_frag(KS, QSTR, 32 * kk + 8 * g, 32 * kk + 8 * g + 4, 16 * w, lane);
#pragma unroll
                for (int et = 0; et < 7; ++et) vf[et] = tr_frag(VS, VSTR, 32 * kk + 8 * g, 32 * kk + 8 * g + 4, 16 * et, lane);
                LDS_FENCE();
#pragma unroll
                for (int et = 0; et < 7; ++et) Cst[et] = mfma16(af, vf[et], Cst[et]);
            }
#pragma unroll
            for (int et = 0; et < 7; ++et) { Cst[et] = Cst[et] * ebL;
                if (mode != 0) { v2u v; v.x = pk2(Cst[et][0], Cst[et][1]); v.y = pk2(Cst[et][2], Cst[et][3]); *(LAS v2u*)(CTn + (16 * et + c) * QSTR + 16 * w + 4 * g) = v; } }
        }
        Btot += bL;
        __syncthreads();
        if (ci + 1 < jb.nchunk) { stage_write(PK); bL = PK.bL; ebL = PK.ebL; }
        if (mode != 0) finalize(ci);
        __syncthreads();
    };
    for (int ci = 0; ci < jb.nchunk; ++ci) chunk_step(LA, ci);
    if (emit_slot >= 0 && w < 6) {
        float* sl = STd + (size_t)emit_slot * ST_FLOATS;
#pragma unroll
        for (int et = 0; et < 7; ++et) *(f32x4*)(sl + ((w * 7 + et) * 64 + lane) * 4) = Cst[et];
        if (w == 0 && lane == 0) sl[96 * 112] = Btot;
    }
    __syncthreads();
}
__device__ __forceinline__ void mlstm_load_rope(const Ctx& F, const float* rope_tab) {
    LAS f32x2* ROPE = (LAS f32x2*)(F.lds + ml::OFF_ROPE);
    for (int i = F.tid; i < 64 * 24; i += 512) ROPE[i] = ((const f32x2*)rope_tab)[i];
}
__device__ __forceinline__ void mlstm_itemA(const Ctx& F, int l, int bh, int it, bf16* otmp, float* ST) {
    const int b = bh >> 2, h = bh & 3;
    if (it == 0) {
        const MlJob jb{b, h, 1, 0, 4};
        mlstm_dir(F, l, jb, 0, -1, 0, l == 0 ? 1 : 0, otmp, ST);
        mlstm_dir(F, l, jb, 1, -1, 0, l == 0 ? 2 : 0, otmp, ST);
    } else {
        const int dir = (it - 1) / (NSEG - 1), k = (it - 1) % (NSEG - 1), seg = dir == 0 ? k : NSEG - 1 - k;
        const MlJob jb{b, h, 0, SEGTOK * seg, SEGCH};
        mlstm_dir(F, l, jb, dir, -1, 1 + k, 0, otmp, ST);
    }
}
__device__ __forceinline__ void mlstm_itemC(const Ctx& F, int l, int bh, int seg, bf16* otmp, float* ST) {
    const MlJob jb{bh >> 2, bh & 3, 0, SEGTOK * seg, SEGCH};
    mlstm_dir(F, l, jb, 0, seg, -1, 1, otmp, ST);
    mlstm_dir(F, l, jb, 1, NSEG - 1 - seg, -1, 2, otmp, ST);
}

namespace hg {
constexpr int STR = 72;
constexpr int IMG = 64 * STR * 2;
constexpr int OFF_KO = 0, OFF_KH = IMG, OFF_VS = 2 * IMG, OFF_QJ = 3 * IMG, OFF_ST = 7 * IMG, OFF_HT = 9 * IMG, OFF_TOT = OFF_HT + 64 * 68 * 4, OFF_BL = OFF_TOT + 8 * 64 * 4, OFF_END = OFF_BL + 512;
static_assert(OFF_END <= RING_BYTES, "hgrn LDS");
constexpr int ST_FLOATS = 64 * 64 + 64;
}
__device__ __forceinline__ void hgrn_dir(const Ctx& F, int l, const MlJob jb, int dir, int fold_r, int emit_slot, int mode, bf16* otmp, float* ST) {
    using namespace hg;
    int tid_ = F.tid; asm volatile("" : "+v"(tid_));
    const int tid = tid_, lane = tid & 63, w = __builtin_amdgcn_readfirstlane(tid >> 6), g = lane >> 4, c = lane & 15;
    LAS bf16* KO = (LAS bf16*)(F.lds + OFF_KO); LAS bf16* KH = (LAS bf16*)(F.lds + OFF_KH); LAS bf16* VS = (LAS bf16*)(F.lds + OFF_VS); LAS bf16* QJ = (LAS bf16*)(F.lds + OFF_QJ);
    LAS bf16* ST0 = (LAS bf16*)(F.lds + OFF_ST); LAS float* HT = (LAS float*)(F.lds + OFF_HT); LAS float* TOT = (LAS float*)(F.lds + OFF_TOT); LAS float* BL = (LAS float*)(F.lds + OFF_BL);
    const int rowbase = jb.isctx ? MX + jb.b * CTX : jb.b * S;
    const int h = jb.h; const bf16* P = F.P;
    float* STd = ST + (size_t)(((jb.b * 4 + h) * 2 + dir) * 8) * ST_FLOATS;
    const int dt = w >> 1, et0 = 2 * (w & 1);
    f32x4 Sst[2]; float Btot[4];
#pragma unroll
    for (int i = 0; i < 2; ++i) Sst[i] = (f32x4){0.f, 0.f, 0.f, 0.f};
#pragma unroll
    for (int r = 0; r < 4; ++r) Btot[r] = 0.f;
    if (fold_r >= 0) {
        f32x4 v[8][2], dk[8];
#pragma unroll
        for (int k = 0; k < NSEG; ++k) { const float* sl = STd + (size_t)k * ST_FLOATS; v[k][0] = *(const f32x4*)(sl + ((w * 2 + 0) * 64 + lane) * 4); v[k][1] = *(const f32x4*)(sl + ((w * 2 + 1) * 64 + lane) * 4);
            dk[k] = *(const f32x4*)(sl + 64 * 64 + 16 * dt + 4 * g); }
        f32x4 run = (f32x4){1.f, 1.f, 1.f, 1.f};
#pragma unroll
        for (int k = NSEG - 1; k >= 0; --k) { const float on = (k <= fold_r) ? 1.f : 0.f; Sst[0] += v[k][0] * (run * on); Sst[1] += v[k][1] * (run * on);
            if (k >= 1) { const bool use = k <= fold_r; run[0] *= use ? __expf(dk[k][0]) : 1.f; run[1] *= use ? __expf(dk[k][1]) : 1.f; run[2] *= use ? __expf(dk[k][2]) : 1.f; run[3] *= use ? __expf(dk[k][3]) : 1.f; } }
    }
    if (mode != 0) {
#pragma unroll
        for (int i = 0; i < 2; ++i) { v2u v; v.x = pk2(Sst[i][0], Sst[i][1]); v.y = pk2(Sst[i][2], Sst[i][3]); *(LAS v2u*)(ST0 + (16 * (et0 + i) + c) * STR + 16 * dt + 4 * g) = v; }
    }
    const int ps = lane, d0 = 8 * w;
    float lbv[8];
#pragma unroll
    for (int e = 0; e < 8; ++e) { lbv[e] = 0.f;
        if (l == 1) { const float v0 = F.hgrn_lb[(0 * 2 + dir) * 256 + h * 64 + d0 + e], v1 = F.hgrn_lb[(1 * 2 + dir) * 256 + h * 64 + d0 + e]; lbv[e] = 1.f / (1.f + expf(v0 - v1)); } }
    const int fcol = dir ? A_FB : A_FF;
    auto tok_of = [&](int ci, int i) -> int { return dir == 0 ? jb.t0 + 64 * ci + i : jb.t0 + 64 * (jb.nchunk - 1 - ci) + (63 - i); };
    v4u rq, rf, rv; rq = rf = rv = (v4u){0u, 0u, 0u, 0u};
    v4u ft = (v4u){0u, 0u, 0u, 0u}, fz = (v4u){0u, 0u, 0u, 0u};
    const int fi_i = tid >> 3, fi_e0 = 8 * (tid & 7);
    float gnv[8];
#pragma unroll
    for (int e = 0; e < 8; ++e) gnv[e] = (mode == 2) ? F.hgrn_gn[l * 256 + h * 64 + fi_e0 + e] : 0.f;
    auto issue_loads = [&](int ci) {
        const bf16* pr = P + (size_t)(rowbase + tok_of(ci, ps)) * PLD + h * 64 + d0;
        if (mode != 0) rq = *(const v4u*)(pr + A_Q);
        rf = *(const v4u*)(pr + fcol); rv = *(const v4u*)(pr + A_I);
    };
    auto issue_fin = [&](int ci) { const int m = rowbase + tok_of(ci, fi_i); ft = *(const v4u*)(otmp + (size_t)m * 256 + h * 64 + fi_e0); fz = *(const v4u*)(P + (size_t)m * PLD + A_Z + h * 64 + fi_e0); };
    issue_loads(0);
    __syncthreads();
    for (int ci = 0; ci < jb.nchunk; ++ci) {
        LAS bf16* STc = ST0 + (ci & 1) * 64 * STR; LAS bf16* STn = ST0 + ((ci + 1) & 1) * 64 * STR;
        {
            float qv[8], kk[8], bb[8], fl[8];
            unpack8(rf, fl);
#pragma unroll
            for (int e = 0; e < 8; ++e) { const float sg = sigmoid_f(fl[e]); const float f = lbv[e] + (1.f - lbv[e]) * sg; bb[e] = __logf(f); kk[e] = (1.f - lbv[e]) * (1.f - sg); }
            if (mode != 0) unpack8(rq, qv);
            const v4u vraw = rv;
            if (ci + 1 < jb.nchunk) issue_loads(ci + 1);
            if (mode == 2) issue_fin(ci);
            float ref1[8], ref2[8], ref3[8], bl[8];
#pragma unroll
            for (int e = 0; e < 8; ++e) { bb[e] = wave_scan_incl(bb[e]); ref1[e] = rdlane(bb[e], 15); ref2[e] = rdlane(bb[e], 31); ref3[e] = rdlane(bb[e], 47); bl[e] = rdlane(bb[e], 63); }
            const int sub = lane >> 4;
            float o8[8];
            if (mode != 0) {
#pragma unroll
                for (int e = 0; e < 8; ++e) { const float rown = sub == 0 ? 0.f : (sub == 1 ? ref1[e] : (sub == 2 ? ref2[e] : ref3[e])); o8[e] = kk[e] * __expf(rown - bb[e]); }
                *(LAS v4u*)(KO + ps * STR + d0) = pack8(o8); }
#pragma unroll
            for (int e = 0; e < 8; ++e) o8[e] = kk[e] * __expf(bl[e] - bb[e]);
            *(LAS v4u*)(KH + ps * STR + d0) = pack8(o8);
            *(LAS v4u*)(VS + ps * STR + d0) = vraw;
            if (mode != 0) {
#pragma unroll
                for (int e = 0; e < 8; ++e) o8[e] = qv[e] * __expf(bb[e]);
                *(LAS v4u*)(QJ + ps * STR + d0) = pack8(o8);
                if (sub >= 1) {
#pragma unroll
                    for (int e = 0; e < 8; ++e) o8[e] = qv[e] * __expf(bb[e] - ref1[e]);
                    *(LAS v4u*)(QJ + (64 + ps) * STR + d0) = pack8(o8); }
                if (sub >= 2) {
#pragma unroll
                    for (int e = 0; e < 8; ++e) o8[e] = qv[e] * __expf(bb[e] - ref2[e]);
                    *(LAS v4u*)(QJ + (128 + ps) * STR + d0) = pack8(o8); }
                if (sub >= 3) {
#pragma unroll
                    for (int e = 0; e < 8; ++e) o8[e] = qv[e] * __expf(bb[e] - ref3[e]);
                    *(LAS v4u*)(QJ + (192 + ps) * STR + d0) = pack8(o8); }
            }
            if (lane == 0) { *(LAS f32x4*)(BL + d0) = (f32x4){bl[0], bl[1], bl[2], bl[3]}; *(LAS f32x4*)(BL + d0 + 4) = (f32x4){bl[4], bl[5], bl[6], bl[7]}; }
        }
        __syncthreads();
        if (mode != 0) {
            const int tt = w & 3, eh = w >> 2;
            f32x4 at[4];
            { bf16x8 kf[4][2], qjf[4][2];
#pragma unroll
              for (int j = 0; j < 4; ++j) if (j <= tt) {
#pragma unroll
                  for (int ks = 0; ks < 2; ++ks) { kf[j][ks] = rm_frag(KO, STR, 16 * j + c, 32 * ks + 8 * g); qjf[j][ks] = rm_frag(QJ + j * 64 * STR, STR, 16 * tt + c, 32 * ks + 8 * g); } }
              LDS_FENCE();
#pragma unroll
              for (int j = 0; j < 4; ++j) { at[j] = (f32x4){0.f, 0.f, 0.f, 0.f};
                  if (j <= tt) {
#pragma unroll
                      for (int ks = 0; ks < 2; ++ks) at[j] = mfma16(kf[j][ks], qjf[j][ks], at[j]);
                      if (j == tt) {
#pragma unroll
                          for (int r = 0; r < 4; ++r) if (4 * g + r > c) at[j][r] = 0.f; }
                  } } }
            bf16x8 pf[2];
#pragma unroll
            for (int k2 = 0; k2 < 2; ++k2) { const unsigned u0 = pk2(at[2 * k2][0], at[2 * k2][1]), u1 = pk2(at[2 * k2][2], at[2 * k2][3]), u2 = pk2(at[2 * k2 + 1][0], at[2 * k2 + 1][1]), u3 = pk2(at[2 * k2 + 1][2], at[2 * k2 + 1][3]);
                pf[k2] = __builtin_bit_cast(bf16x8, (v4u){u0, u1, u2, u3}); }
            { bf16x8 qf[2], vf[2][2], sf[2][2];
#pragma unroll
              for (int ks = 0; ks < 2; ++ks) qf[ks] = rm_frag(QJ, STR, 16 * tt + c, 32 * ks + 8 * g);
#pragma unroll
              for (int ei = 0; ei < 2; ++ei) { const int et = 2 * eh + ei;
#pragma unroll
                  for (int k2 = 0; k2 < 2; ++k2) if (2 * k2 <= tt) vf[ei][k2] = tr_frag(VS, STR, 32 * k2 + 4 * g, 32 * k2 + 16 + 4 * g, 16 * et, lane);
#pragma unroll
                  for (int ks = 0; ks < 2; ++ks) sf[ei][ks] = rm_frag(STc, STR, 16 * et + c, 32 * ks + 8 * g); }
              LDS_FENCE();
#pragma unroll
              for (int ei = 0; ei < 2; ++ei) { const int et = 2 * eh + ei;
                  f32x4 acc = (f32x4){0.f, 0.f, 0.f, 0.f};
#pragma unroll
                  for (int k2 = 0; k2 < 2; ++k2) if (2 * k2 <= tt) acc = mfma16(vf[ei][k2], pf[k2], acc);
#pragma unroll
                  for (int ks = 0; ks < 2; ++ks) acc = mfma16(sf[ei][ks], qf[ks], acc);
                  *(LAS f32x4*)(HT + (16 * tt + c) * 68 + 16 * et + 4 * g) = acc; } }
        }
        {
            const f32x4 blv = *(const LAS f32x4*)(BL + 16 * dt + 4 * g);
#pragma unroll
            for (int r = 0; r < 4; ++r) { const float dec = __expf(blv[r]); Sst[0][r] *= dec; Sst[1][r] *= dec; Btot[r] += blv[r]; }
            { bf16x8 af[2], vf[2][2];
#pragma unroll
              for (int k2 = 0; k2 < 2; ++k2) { af[k2] = tr_frag(KH, STR, 32 * k2 + 8 * g, 32 * k2 + 8 * g + 4, 16 * dt, lane);
#pragma unroll
                  for (int i = 0; i < 2; ++i) vf[k2][i] = tr_frag(VS, STR, 32 * k2 + 8 * g, 32 * k2 + 8 * g + 4, 16 * (et0 + i), lane); }
              LDS_FENCE();
#pragma unroll
              for (int k2 = 0; k2 < 2; ++k2)
#pragma unroll
                  for (int i = 0; i < 2; ++i) Sst[i] = mfma16(af[k2], vf[k2][i], Sst[i]); }
            if (mode != 0) {
#pragma unroll
                for (int i = 0; i < 2; ++i) { v2u v; v.x = pk2(Sst[i][0], Sst[i][1]); v.y = pk2(Sst[i][2], Sst[i][3]); *(LAS v2u*)(STn + (16 * (et0 + i) + c) * STR + 16 * dt + 4 * g) = v; } }
        }
        __syncthreads();
        if (mode != 0) {
            const int i = tid >> 3, sub8 = tid & 7, e0 = 8 * sub8; const int m = rowbase + tok_of(ci, i);
            float hv[8];
            { const f32x4 a0 = *(const LAS f32x4*)(HT + i * 68 + e0), a1 = *(const LAS f32x4*)(HT + i * 68 + e0 + 4); hv[0] = a0[0]; hv[1] = a0[1]; hv[2] = a0[2]; hv[3] = a0[3]; hv[4] = a1[0]; hv[5] = a1[1]; hv[6] = a1[2]; hv[7] = a1[3]; }
            bf16* tp = otmp + (size_t)m * 256 + h * 64 + e0;
            if (mode == 1) *(v4u*)tp = pack8(hv);
            else {
                float tv[8]; unpack8(ft, tv);
                float ss = 0.f;
#pragma unroll
                for (int e = 0; e < 8; ++e) { hv[e] += tv[e]; ss += hv[e] * hv[e]; }
                ss = group8_sum(ss);
                const float rinv = __builtin_amdgcn_rsqf(ss * (1.f / 64.f) + EPS);
                float zv[8]; unpack8(fz, zv);
#pragma unroll
                for (int e = 0; e < 8; ++e) hv[e] = hv[e] * rinv * gnv[e] * zv[e];
                *(v4u*)(F.hxy + (size_t)m * 1024 + h * 64 + e0) = pack8(hv);
            }
        }
    }
    if (emit_slot >= 0) {
        float* sl = STd + (size_t)emit_slot * ST_FLOATS;
        *(f32x4*)(sl + ((w * 2 + 0) * 64 + lane) * 4) = Sst[0]; *(f32x4*)(sl + ((w * 2 + 1) * 64 + lane) * 4) = Sst[1];
        if ((w & 1) == 0 && c == 0) *(f32x4*)(sl + 64 * 64 + 16 * dt + 4 * g) = (f32x4){Btot[0], Btot[1], Btot[2], Btot[3]};
    }
    __syncthreads();
}
__device__ __forceinline__ void hgrn_itemA(const Ctx& F, int l, int bh, int it, bf16* otmp, float* ST) {
    const int b = bh >> 2, h = bh & 3;
    if (it == 0) {
        const MlJob jb{b, h, 1, 0, 4};
        hgrn_dir(F, l, jb, 0, -1, 0, l == 0 ? 1 : 0, otmp, ST);
        hgrn_dir(F, l, jb, 1, -1, 0, l == 0 ? 2 : 0, otmp, ST);
    } else {
        const int dir = (it - 1) / (NSEG - 1), k = (it - 1) % (NSEG - 1), seg = dir == 0 ? k : NSEG - 1 - k;
        const MlJob jb{b, h, 0, SEGTOK * seg, SEGCH};
        hgrn_dir(F, l, jb, dir, -1, 1 + k, 0, otmp, ST);
    }
}
__device__ __forceinline__ void hgrn_itemC(const Ctx& F, int l, int bh, int seg, bf16* otmp, float* ST) {
    const MlJob jb{bh >> 2, bh & 3, 0, SEGTOK * seg, SEGCH};
    hgrn_dir(F, l, jb, 0, seg, -1, 1, otmp, ST);
    hgrn_dir(F, l, jb, 1, NSEG - 1 - seg, -1, 2, otmp, ST);
}

namespace nat {
constexpr int STR = 72, IMG = 64 * STR * 2;
constexpr int OFF_K = 0, OFF_V = 2 * IMG, OFF_RPB = 4 * IMG, OFF_END = OFF_RPB + 2048;
static_assert(OFF_END <= RING_BYTES, "na LDS");
}
template <int CH, bool WIN>
__device__ __forceinline__ void na_block(const LAS bf16* Kc, const LAS bf16* Vc, const LAS float* RPB, const bf16x8 (&qf)[2][2], f32x4 (&oacc)[2][4], float (&mrun)[2], float (&lrun)[2],
                                         const int g, const int c, const int lane, const int dr, const int (&qcol)[2], const int (&csq)[2]) {
    constexpr int STR = nat::STR;
    constexpr int KLO[2] = {WIN ? (CH == 0 ? 0 : 1) : 0, WIN ? (CH == 0 ? 0 : 2) : 0}, KHI[2] = {WIN ? (CH == 0 ? 1 : 3) : 3, WIN ? (CH == 0 ? 2 : 3) : 3};
    constexpr int ULO = KLO[0] < KLO[1] ? KLO[0] : KLO[1], UHI = KHI[0] > KHI[1] ? KHI[0] : KHI[1];
    f32x4 st[2][4];
    { bf16x8 kf[4][2];
#pragma unroll
      for (int kt = ULO; kt <= UHI; ++kt)
#pragma unroll
          for (int ks = 0; ks < 2; ++ks) kf[kt][ks] = rm_frag(Kc, STR, 16 * kt + c, 32 * ks + 8 * g);
      LDS_FENCE();
      __builtin_amdgcn_s_setprio(1);
#pragma unroll
      for (int qt = 0; qt < 2; ++qt)
#pragma unroll
          for (int kt = 0; kt < 4; ++kt) { st[qt][kt] = (f32x4){0.f, 0.f, 0.f, 0.f};
              if (kt >= KLO[qt] && kt <= KHI[qt]) {
#pragma unroll
                  for (int ks = 0; ks < 2; ++ks) st[qt][kt] = mfma16(kf[kt][ks], qf[qt][ks], st[qt][kt]); } }
      __builtin_amdgcn_s_setprio(0); }
    if (WIN) {
#pragma unroll
        for (int qt = 0; qt < 2; ++qt) { const int boff = dr * 31 + 15 - qcol[qt];
#pragma unroll
            for (int kt = KLO[qt]; kt <= KHI[qt]; ++kt)
#pragma unroll
                for (int r = 0; r < 4; ++r) { const int kc = 16 * kt + 4 * g + r; const float bias = RPB[min(max(boff + kc, 0), 464)]; const float v = st[qt][kt][r] + bias; st[qt][kt][r] = ((unsigned)(kc - csq[qt]) < 16u) ? v : -1e30f; } }
    }
    float alpha[2]; bf16x8 pf[2][2];
#pragma unroll
    for (int qt = 0; qt < 2; ++qt) {
        float bm = -1e30f;
#pragma unroll
        for (int kt = KLO[qt]; kt <= KHI[qt]; ++kt)
#pragma unroll
            for (int r = 0; r < 4; ++r) bm = fmaxf(bm, st[qt][kt][r]);
        bm = xor32_max(xor16_max(bm));
        const float mnew = fmaxf(mrun[qt], bm); alpha[qt] = __builtin_amdgcn_exp2f(mrun[qt] - mnew); mrun[qt] = mnew;
        float ps = 0.f;
#pragma unroll
        for (int kt = KLO[qt]; kt <= KHI[qt]; ++kt)
#pragma unroll
            for (int r = 0; r < 4; ++r) { const float p = __builtin_amdgcn_exp2f(st[qt][kt][r] - mnew); st[qt][kt][r] = p; ps += p; }
        lrun[qt] = lrun[qt] * alpha[qt] + ps;
#pragma unroll
        for (int k2 = 0; k2 < 2; ++k2) { const unsigned u0 = pk2(st[qt][2 * k2][0], st[qt][2 * k2][1]), u1 = pk2(st[qt][2 * k2][2], st[qt][2 * k2][3]), u2 = pk2(st[qt][2 * k2 + 1][0], st[qt][2 * k2 + 1][1]), u3 = pk2(st[qt][2 * k2 + 1][2], st[qt][2 * k2 + 1][3]);
            pf[qt][k2] = __builtin_bit_cast(bf16x8, (v4u){u0, u1, u2, u3}); }
    }
    { bf16x8 vf[4][2];
#pragma unroll
      for (int dtl = 0; dtl < 4; ++dtl)
#pragma unroll
          for (int k2 = ULO / 2; k2 <= UHI / 2; ++k2) vf[dtl][k2] = tr_frag(Vc, STR, 32 * k2 + 4 * g, 32 * k2 + 16 + 4 * g, 16 * dtl, lane);
      LDS_FENCE();
      __builtin_amdgcn_s_setprio(1);
#pragma unroll
      for (int qt = 0; qt < 2; ++qt)
#pragma unroll
          for (int dtl = 0; dtl < 4; ++dtl) { f32x4 a = oacc[qt][dtl] * alpha[qt];
#pragma unroll
              for (int k2 = KLO[qt] / 2; k2 <= KHI[qt] / 2; ++k2) a = mfma16(vf[dtl][k2], pf[qt][k2], a);
              oacc[qt][dtl] = a; }
      __builtin_amdgcn_s_setprio(0); }
}
__device__ __forceinline__ void na_item(const Ctx& F, int l, int b, int h, int R0) {
    using namespace nat;
    int tid_ = F.tid; asm volatile("" : "+v"(tid_));
    const int tid = tid_, lane = tid & 63, w = __builtin_amdgcn_readfirstlane(tid >> 6), g = lane >> 4, c = lane & 15;
    LAS bf16* KT = (LAS bf16*)(F.lds + OFF_K); LAS bf16* VT = (LAS bf16*)(F.lds + OFF_V); LAS float* RPB = (LAS float*)(F.lds + OFF_RPB);
    const bf16* P = F.P; const bool lat = R0 >= 0;
    const int R = R0 + (w >> 1), ch = w & 1;
    const int rsR = min(max(R - 4, 0), 56);
    const int kr0 = lat ? min(max(R0 - 4, 0), 56) : 0;
    const int nwin = lat ? (min(max(R0 + 3 - 4, 0), 56) + 8 - kr0) : 0, nblk = nwin + 4;
    if (lat) for (int i = tid; i < 15 * 31; i += 512) RPB[i] = F.na_rpb[((size_t)l * 6 + h) * 465 + i] * 1.4426950408889634f;
    int mq[2]; bf16x8 qf[2][2]; int csq[2], qcol[2];
#pragma unroll
    for (int qt = 0; qt < 2; ++qt) {
        if (lat) { qcol[qt] = 32 * ch + 16 * qt + c; mq[qt] = b * S + R * 64 + qcol[qt]; } else { qcol[qt] = 0; mq[qt] = MX + b * CTX + 32 * w + 16 * qt + c; }
        csq[qt] = min(max(qcol[qt] - 8, 0), 48);
#pragma unroll
        for (int ks = 0; ks < 2; ++ks) qf[qt][ks] = *(const bf16x8*)(P + (size_t)mq[qt] * PLD + C_Q + h * 64 + 32 * ks + 8 * g);
    }
    f32x4 oacc[2][4]; float mrun[2], lrun[2];
#pragma unroll
    for (int qt = 0; qt < 2; ++qt) { mrun[qt] = -1e30f; lrun[qt] = 0.f;
#pragma unroll
        for (int dtl = 0; dtl < 4; ++dtl) oacc[qt][dtl] = (f32x4){0.f, 0.f, 0.f, 0.f}; }
    const int stok = tid >> 3, spc = tid & 7;
    auto blk_row = [&](int i) -> int { return i < nwin ? b * S + (kr0 + i) * 64 + stok : MX + b * CTX + 64 * (i - nwin) + stok; };
    v4u rk0, rv0, rk1, rv1, rk2, rv2;
    auto ld = [&](int i, v4u& k_, v4u& v_) { const int ii = i < nblk ? i : nblk - 1; const bf16* pr = P + (size_t)blk_row(ii) * PLD + h * 64 + 8 * spc; k_ = *(const v4u*)(pr + C_K); v_ = *(const v4u*)(pr + C_V); };
    ld(0, rk0, rv0); ld(1, rk1, rv1); ld(2, rk2, rv2);
    __syncthreads();
    *(LAS v4u*)(KT + stok * STR + 8 * spc) = rk0; *(LAS v4u*)(VT + stok * STR + 8 * spc) = rv0;
    ld(3, rk0, rv0);
    __syncthreads();
    auto step = [&](int i, v4u& kn, v4u& vn) {
        const LAS bf16* Kc = KT + (i & 1) * 64 * STR; const LAS bf16* Vc = VT + (i & 1) * 64 * STR;
        if (i + 1 < nblk) { LAS bf16* Kn = KT + ((i + 1) & 1) * 64 * STR; LAS bf16* Vn = VT + ((i + 1) & 1) * 64 * STR;
            *(LAS v4u*)(Kn + stok * STR + 8 * spc) = kn; *(LAS v4u*)(Vn + stok * STR + 8 * spc) = vn;
            if (i + 4 < nblk) ld(i + 4, kn, vn); }
        const bool win = i < nwin; const int kr = kr0 + i;
        const bool active = !win || (kr >= rsR && kr < rsR + 8);
        if (active) {
            if (!win) na_block<0, false>(Kc, Vc, RPB, qf, oacc, mrun, lrun, g, c, lane, 0, qcol, csq);
            else if (ch == 0) na_block<0, true>(Kc, Vc, RPB, qf, oacc, mrun, lrun, g, c, lane, kr - R + 7, qcol, csq);
            else na_block<1, true>(Kc, Vc, RPB, qf, oacc, mrun, lrun, g, c, lane, kr - R + 7, qcol, csq);
        }
        __syncthreads();
    };
    for (int i = 0; i < nblk; i += 3) { step(i, rk1, rv1); if (i + 1 < nblk) step(i + 1, rk2, rv2); if (i + 2 < nblk) step(i + 2, rk0, rv0); }
#pragma unroll
    for (int qt = 0; qt < 2; ++qt) {
        const float lt = xor32_sum(xor16_sum(lrun[qt]));
        const float rl = __builtin_amdgcn_rcpf(lt);
        const bf16* zr = P + (size_t)mq[qt] * PLD + C_Z + h * 64; bf16* yr = F.hxy + (size_t)mq[qt] * 1024 + 640 + h * 64;
#pragma unroll
        for (int dtl = 0; dtl < 4; ++dtl) { const int d = 16 * dtl + 4 * g; const v2u zv = *(const v2u*)(zr + d);
            const float z0 = __uint_as_float(zv.x << 16), z1 = __uint_as_float(zv.x & 0xffff0000u), z2 = __uint_as_float(zv.y << 16), z3 = __uint_as_float(zv.y & 0xffff0000u);
            v2u o; o.x = pk2(oacc[qt][dtl][0] * rl * z0, oacc[qt][dtl][1] * rl * z1); o.y = pk2(oacc[qt][dtl][2] * rl * z2, oacc[qt][dtl][3] * rl * z3);
            *(v2u*)(yr + d) = o; }
    }
}

__device__ __forceinline__ void phase_mixA(const Ctx& F, int l, unsigned* ticket) {
    mlstm_load_rope(F, F.rope);
    volatile LAS unsigned* slot = (volatile LAS unsigned*)(F.lds + MISC_OFF) + 16;
    const int n_ctx = 64, n_na = 768, n_loc = 2 * 32 * 2 * (NSEG - 1), n_nactx = (l == 0) ? 48 : 0, n_all = n_ctx + n_na + n_loc + n_nactx;
    unsigned cur = 0;
    if (F.tid == 0) *slot = __hip_atomic_fetch_add(ticket, 1u, __ATOMIC_RELAXED, __HIP_MEMORY_SCOPE_AGENT);
    __syncthreads();
    cur = *slot;
    while ((int)cur < n_all) {
        unsigned nxt = 0;
        if (F.tid == 0) nxt = __hip_atomic_fetch_add(ticket, 1u, __ATOMIC_RELAXED, __HIP_MEMORY_SCOPE_AGENT);
        int it = (int)cur;
        const int tkind = it < n_ctx ? 22 : (it < n_ctx + n_loc ? 21 : 20);
        if (l == 0) { TS_START(F, tkind); if (PROBE_T == 25 && blockIdx.x == 0 && F.tid == 0) TS_LDS(F)[0] += 2000; }
        if (it < n_ctx) { if (it < 32) mlstm_itemA(F, l, it, 0, F.otm, F.stm); else hgrn_itemA(F, l, it - 32, 0, F.oth, F.sth); }
        else if ((it -= n_ctx) < n_loc) { constexpr int NL = 2 * (NSEG - 1); if (it < 32 * NL) mlstm_itemA(F, l, it / NL, 1 + it % NL, F.otm, F.stm); else { it -= 32 * NL; hgrn_itemA(F, l, it / NL, 1 + it % NL, F.oth, F.sth); } }
        else if ((it -= n_loc) < n_na) na_item(F, l, it / 96, (it / 16) % 6, 4 * (it % 16));
        else { it -= n_na; na_item(F, l, it / 6, it % 6, -1); }
        if (l == 0) TS_STOP(F, tkind);
        __syncthreads();
        if (F.tid == 0) *slot = nxt;
        __syncthreads();
        cur = *slot;
    }
}
__device__ __forceinline__ void phase_mixC(const Ctx& F, int l) {
    mlstm_load_rope(F, F.rope);
    for (int it = F.vcu; it < 2 * 32 * NSEG; it += F.G) {
        if (it < 32 * NSEG) mlstm_itemC(F, l, it / NSEG, it % NSEG, F.otm, F.stm);
        else hgrn_itemC(F, l, (it - 32 * NSEG) / NSEG, it % NSEG, F.oth, F.sth);
    }
}

constexpr int NPH = 12;
struct Args { const float* in[15]; float* out; unsigned char* ws; int ph_lo, ph_hi; };
__global__ void __launch_bounds__(512, 2) mega_fwd(Args args) {
    extern __shared__ __attribute__((aligned(16))) unsigned char lds[];
    Ctx F;
    F.lds = (LAS unsigned char*)lds;
    F.tid = threadIdx.x; F.lane = F.tid & 63; F.wave = __builtin_amdgcn_readfirstlane(F.tid >> 6);
    F.G = gridDim.x; { const int bx = blockIdx.x; F.vcu = (F.G % 8 == 0) ? (bx % 8) * (F.G / 8) + bx / 8 : bx; }
    F.gw = F.vcu * 8 + F.wave; F.NGW = F.G * 8;
    unsigned char* ws = args.ws;
    F.x = args.in[0]; F.c = args.in[1]; F.ctx = args.in[2]; F.c_ctx = args.in[3]; F.w_mod = args.in[4]; F.b_mod = args.in[5]; F.g_pre = args.in[6]; F.g_post = args.in[7];
    F.w_in = args.in[8]; F.w_out = args.in[9]; F.hgrn_lb = args.in[10]; F.hgrn_gn = args.in[11]; F.gate_b = args.in[12]; F.mlstm_gn = args.in[13]; F.na_rpb = args.in[14];
    F.out = args.out;
    F.wt_in = (bf16*)(ws + WS_WT_IN); F.wt_out = (bf16*)(ws + WS_WT_OUT); F.mod = (float*)(ws + WS_MOD); F.gates = (float*)(ws + WS_GATES); F.ctx1 = (float*)(ws + WS_CTX1);
    F.hxy = (bf16*)(ws + WS_HXY); F.P = (bf16*)(ws + WS_P); F.UX = (bf16*)(ws + WS_P); F.oth = (bf16*)(ws + WS_OH); F.sth = (float*)(ws + WS_STH); F.otm = (bf16*)(ws + WS_OM); F.stm = (float*)(ws + WS_STM); F.rope = (float*)(ws + WS_ROPE);
    for (int u = F.tid; u < (LDS_BYTES - LDSCTL_OFF) / 4; u += 512) ((LAS unsigned*)(F.lds + LDSCTL_OFF))[u] = 0u;
    __syncthreads();
    XcdBarrier bar = xcd_barrier_post((unsigned*)(ws + WS_CTL) + CW_BAR, (volatile LAS unsigned*)(F.lds + MISC_OFF) + 8);

    const int lo = args.ph_lo, hi = args.ph_hi;
#ifndef DUP_PHASE
#define DUP_PHASE -1
#endif
#define IN(k) (lo <= (k) && (k) < hi)
#define SEAM(k) do { if ((k) + 1 < hi) xcd_barrier(bar); } while (0)
#define PHASE(k, ...) if (IN(k)) { TS_START(F, 100 + (k)); __VA_ARGS__; if ((k) == DUP_PHASE) { xcd_barrier(bar); __VA_ARGS__; } SEAM(k); TS_STOP(F, 100 + (k)); }
    PHASE(0, phase_p0(F))
    PHASE(1, { phase_prenorm0(F); phase_p1_transposes(F); })
#define LAYER(l) \
    PHASE(2 + 5 * (l), { \
        pg8::Gemm g{F.hxy, F.wt_in + (size_t)(l) * NPAD * 1024, M, NPAD, 1024}; \
        pg8::EpiIn E{F.P, F.gates, F.gate_b + (l) * 16}; \
        pg8::StaticOrder SO; SO.init(M, NPAD, F.G, (int)blockIdx.x); pg8::gemm_phase<pg8::EpiIn, pg8::StaticOrder, true, true>(F.lds + RING_OFF, g, SO, E); }) \
    PHASE(3 + 5 * (l), phase_mixA(F, (l), (unsigned*)(args.ws + WS_CTL) + 8192 + 64 * (l))) \
    PHASE(4 + 5 * (l), phase_mixC(F, (l))) \
    PHASE(5 + 5 * (l), { \
        constexpr int Ml = (l) == 0 ? M : MX; \
        pg8::Gemm g{F.hxy, F.wt_out + (size_t)(l) * 1024 * 1024, Ml, 1024, 1024}; pg8::StaticOrder SO; SO.init(Ml, 1024, F.G, (int)blockIdx.x); \
        pg8::EpiOut E{F.UX}; \
        pg8::gemm_phase<pg8::EpiOut, pg8::StaticOrder, true, true>(F.lds + RING_OFF, g, SO, E); }) \
    PHASE(6 + 5 * (l), phase_post(F, (l)))
    LAYER(0)
    LAYER(1)
#undef LAYER
#undef PHASE
#undef IN
#undef SEAM
    if (PROBE_T != 0 && blockIdx.x == 0 && F.tid == 0) { const unsigned long long t0 = __builtin_amdgcn_s_memtime(), dt = 8ull * TS_LDS(F)[0]; while (__builtin_amdgcn_s_memtime() - t0 < dt) __builtin_amdgcn_s_sleep(8); }
}

extern "C" void kernel_launch(void* const* d_in, const int* in_sizes, int n_in, void* d_out, int out_size, void* d_ws, size_t ws_size, hipStream_t stream) {
    static int grid = 0;
    if (grid == 0) {
        if (n_in != 15 || ws_size < WS_END) { fprintf(stderr, "kernel_launch: unexpected n_in %d / ws_size %zu (need %zu); nothing launched\n", n_in, ws_size, (size_t)WS_END); grid = -1; return; }
        int dev = 0, cus = 0, per_cu = 0;
        if (hipGetDevice(&dev) != hipSuccess || hipDeviceGetAttribute(&cus, hipDeviceAttributeMultiprocessorCount, dev) != hipSuccess) { grid = -1; return; }
        if (hipFuncSetAttribute((const void*)mega_fwd, hipFuncAttributeMaxDynamicSharedMemorySize, LDS_BYTES) != hipSuccess) { fprintf(stderr, "kernel_launch: hipFuncSetAttribute failed\n"); grid = -1; return; }
        if (hipOccupancyMaxActiveBlocksPerMultiprocessor(&per_cu, (const void*)mega_fwd, 512, LDS_BYTES) != hipSuccess || per_cu < 1) { fprintf(stderr, "kernel_launch: occupancy query says %d blocks/CU\n", per_cu); (void)hipGetLastError(); grid = -1; return; }
        grid = cus;
    }
    if (grid < 0) return;
    (void)hipMemsetAsync((char*)d_ws + WS_CTL, 0, CTL_BYTES, stream);
    Args a{};
    for (int i = 0; i < 15; ++i) a.in[i] = (const float*)d_in[i];
    a.out = (float*)d_out; a.ws = (unsigned char*)d_ws; a.ph_lo = 0; a.ph_hi = NPH;
    hipLaunchKernelGGL(mega_fwd, dim3(grid), dim3(512), LDS_BYTES, stream, a);
}
```

```cpp
#include <hip/hip_runtime.h>
#include <stdint.h>
#include <cstdio>

namespace cfg {
constexpr int D = 1024, NB = 8, S = 4096, CTX = 256;
constexpr int MX = NB * S, MC = NB * CTX, M = MX + MC;
constexpr int PIN = 4752, NPAD = 4864, PLD = 4736;
constexpr int A_Q = 0, A_FF = 256, A_FB = 512, A_I = 768, A_Z = 1024, B_Q = 1280, B_K = 1664, B_V = 2048, B_O = 2432, B_Z = 2816,
              C_Q = 3200, C_K = 3584, C_V = 3968, C_Z = 4352;
constexpr float EPS = 1e-6f;
constexpr size_t WS_CTL = 0, CTL_BYTES = 65536;
constexpr size_t WS_WT_IN = WS_CTL + CTL_BYTES;
constexpr size_t WS_WT_OUT = WS_WT_IN + 2ull * NPAD * 1024 * 2;
constexpr size_t WS_MOD = WS_WT_OUT + 2ull * 1024 * 1024 * 2;
constexpr size_t WS_GATES = WS_MOD + 2ull * 9 * 3072 * 4;
constexpr size_t WS_CTX1 = WS_GATES + (size_t)M * 16 * 4;
constexpr size_t WS_HXY = WS_CTX1 + (size_t)MC * 1024 * 4;
constexpr size_t WS_P = WS_HXY + (size_t)M * 1024 * 2;
constexpr size_t WS_OH = WS_P + (size_t)M * PLD * 2;
constexpr size_t WS_OM = WS_OH + (size_t)M * 256 * 4;
constexpr size_t WS_STM = WS_OM + (size_t)M * 384 * 2;
constexpr size_t WS_ROPE = WS_STM + 32ull * 2 * 8 * (96 * 112 + 16) * 4;
constexpr size_t WS_STH = WS_ROPE + 64 * 24 * 8;
constexpr size_t WS_END = WS_STH + 32ull * 2 * 8 * (64 * 64 + 64) * 4;
static_assert(WS_END <= 536870912ull, "workspace");
static_assert(WS_WT_IN % 256 == 0 && WS_MOD % 256 == 0 && WS_GATES % 256 == 0 && WS_CTX1 % 256 == 0 && WS_HXY % 256 == 0 && WS_P % 256 == 0 && WS_OH % 256 == 0 && WS_OM % 256 == 0 && WS_STM % 256 == 0 && WS_ROPE % 256 == 0 && WS_STH % 256 == 0, "align");
}
using namespace cfg;

namespace pg8 {
#define PG8_LAS __attribute__((address_space(3)))
typedef unsigned short bf16_t;
typedef short bf16x8 __attribute__((ext_vector_type(8)));
typedef float f32x4 __attribute__((ext_vector_type(4)));
typedef unsigned u32x4 __attribute__((ext_vector_type(4)));
constexpr int BM = 256, BK = 64, HALF = 128, HTB = HALF * BK * 2  , STAGE_BYTES = 8 * HTB, NXCD = 8, WGM = 8;

__host__ __device__ __forceinline__ int lds_byte(int r, int c) { const int st = (r >> 4) * 2 + (c >> 5), rr = r & 15, cc = c & 31, ob = rr * 64 + cc * 2; return st * 1024 + (ob ^ (((ob >> 9) & 1) << 5)); }
__host__ __device__ __forceinline__ void stage_rc(int b, int& R, int& C) { const int st = b / 1024, sb = b % 1024, swz = sb ^ (((sb >> 9) & 1) << 5); R = (st >> 1) * 16 + swz / 64; C = (st & 1) * 32 + (swz % 64) / 2; }
__host__ __device__ __forceinline__ int perm32(int rho) { const int n = rho >> 4, i = rho & 15; return 8 * (i >> 2) + 4 * n + (i & 3); }

struct Unit { int pm, pn; };
struct Gemm { const bf16_t* A; const bf16_t* Bt; int M, N, K; };

struct StaticOrder {
    int nM, nN, nwg, G, c;
    __host__ __device__ void init(int M, int N, int G_, int c_) { nM = M / BM; nN = N / BM; nwg = nM * nN; G = G_; c = c_; }
    __host__ __device__ bool next(int i, Unit& u) const {
        const long L = (long)i * G + c; if (L >= nwg) return false;
        int wgid = (int)L; { const int q = nwg / NXCD, r = nwg % NXCD, xcd = wgid % NXCD, off = wgid / NXCD; wgid = (xcd < r ? xcd * (q + 1) : r * (q + 1) + (xcd - r) * q) + off; }
        const int nig = WGM * nN, gid = wgid / nig, fm = gid * WGM, gsz = (nM - fm) < WGM ? (nM - fm) : WGM;
        u.pm = fm + ((wgid % nig) % gsz); u.pn = (wgid % nig) / gsz; return true;
    }
    __device__ __forceinline__ void a_ready(const Unit&) const {}
    __device__ __forceinline__ void done(const Unit&) const {}
};

__device__ __forceinline__ unsigned cvt_pk_bf16(float lo, float hi) { unsigned r; asm volatile("v_cvt_pk_bf16_f32 %0, %1, %2" : "=v"(r) : "v"(lo), "v"(hi)); return r; }
__device__ __forceinline__ float logsigmoid_e(float v) { return fminf(v, 0.f) - log1pf(__expf(-fabsf(v))); }

struct EpiIn {
    static constexpr bool PERM = true, AFTER_DRAIN = false;
    bf16_t* P; float* gates; const float* gate_b;
    __device__ __forceinline__ void operator()(const f32x4 (&acc)[2][2][4][2], const Unit& u, int wr, int wc, int fr, int fq) const {
        const int row0 = u.pm * BM + wr * 64 + fr, col0 = u.pn * BM + wc * 32 + 8 * fq;
#pragma unroll
        for (int bj = 0; bj < 2; ++bj) {
            const int col = col0 + bj * HALF;
            if (col < cfg::PLD) {
                const int act = col < 256 ? 1 : col < 1024 ? 0 : col < 1280 ? 2 : col < 1664 ? 3 : col < 2432 ? 0 : col < 2816 ? 4 : col < 3200 ? 2 : col < 3584 ? 5 : col < 4352 ? 0 : 2;
#pragma unroll
                for (int ai = 0; ai < 2; ++ai)
#pragma unroll
                    for (int m = 0; m < 4; ++m) { f32x4 v0 = acc[ai][bj][m][0], v1 = acc[ai][bj][m][1];
                        if (act == 1 || act == 2 || act == 4) { const float sc = act == 1 ? 0.125f : 1.f;
#pragma unroll
                            for (int e = 0; e < 4; ++e) { const float s0 = __builtin_amdgcn_rcpf(1.f + __expf(-v0[e])), s1 = __builtin_amdgcn_rcpf(1.f + __expf(-v1[e])); v0[e] = act == 4 ? s0 : v0[e] * s0 * sc; v1[e] = act == 4 ? s1 : v1[e] * s1 * sc; } }
                        else if (act == 3) { v0 = v0 * 0.10206207261596575f; v1 = v1 * 0.10206207261596575f; }
                        else if (act == 5) { v0 = v0 * (0.125f * 1.4426950408889634f); v1 = v1 * (0.125f * 1.4426950408889634f); }
                        u32x4 w; w.x = cvt_pk_bf16(v0[0], v0[1]); w.y = cvt_pk_bf16(v0[2], v0[3]); w.z = cvt_pk_bf16(v1[0], v1[1]); w.w = cvt_pk_bf16(v1[2], v1[3]);
                        *(u32x4*)(P + (size_t)(row0 + ai * HALF + m * 16) * cfg::PLD + col) = w; }
            } else if (col < cfg::PIN) {
                const int g0 = col - cfg::PLD;
                const f32x4 b0 = *(const f32x4*)(gate_b + g0), b1 = *(const f32x4*)(gate_b + g0 + 4);
#pragma unroll
                for (int ai = 0; ai < 2; ++ai)
#pragma unroll
                    for (int m = 0; m < 4; ++m) { f32x4 v0 = acc[ai][bj][m][0] + b0, v1 = acc[ai][bj][m][1] + b1;
                        if (g0 >= 8) {
#pragma unroll
                            for (int e = 0; e < 4; ++e) { v0[e] = logsigmoid_e(v0[e]); v1[e] = logsigmoid_e(v1[e]); } }
                        float* gp = gates + (size_t)(row0 + ai * HALF + m * 16) * 16 + g0;
                        *(f32x4*)gp = v0; *(f32x4*)(gp + 4) = v1; }
            }
        }
    }
};
struct EpiOut {
    static constexpr bool PERM = true, AFTER_DRAIN = false;
    bf16_t* C;
    __device__ __forceinline__ void operator()(const f32x4 (&acc)[2][2][4][2], const Unit& u, int wr, int wc, int fr, int fq) const {
        const int row0 = u.pm * BM + wr * 64 + fr, col0 = u.pn * BM + wc * 32 + 8 * fq;
#pragma unroll
        for (int ai = 0; ai < 2; ++ai)
#pragma unroll
            for (int m = 0; m < 4; ++m) { bf16_t* rowp = C + (size_t)(row0 + ai * HALF + m * 16) * 1024 + col0;
#pragma unroll
                for (int bj = 0; bj < 2; ++bj) { const f32x4 v0 = acc[ai][bj][m][0], v1 = acc[ai][bj][m][1];
                    u32x4 w; w.x = cvt_pk_bf16(v0[0], v0[1]); w.y = cvt_pk_bf16(v0[2], v0[3]); w.z = cvt_pk_bf16(v1[0], v1[1]); w.w = cvt_pk_bf16(v1[2], v1[3]);
                    *(u32x4*)(rowp + bj * HALF) = w; } }
    }
};

template <class Epi, class Sched, bool ALIGN_EPI = false, bool SP2 = false>
__device__ __forceinline__ void gemm_phase(PG8_LAS unsigned char* lds, const Gemm g, const Sched& S, const Epi& E) {
    const int tid = threadIdx.x, wid = __builtin_amdgcn_readfirstlane(tid >> 6), lane = tid & 63, wr = wid >> 2, wc = wid & 3, fr = lane & 15, fq = lane >> 4;
    const int K = g.K, nt = K / BK;
    unsigned voffA[2], voffB[2];
#pragma unroll
    for (int i = 0; i < 2; ++i) { int R, C; stage_rc(tid * 16 + i * 8192, R, C); const int Rb = Epi::PERM ? ((R & ~31) + perm32(R & 31)) : R;
        voffA[i] = (unsigned)(R * K + C) * 2u; voffB[i] = (unsigned)(Rb * K + C) * 2u; }
    const size_t kstep = (size_t)(BK * 2);
    const size_t hstep = (size_t)HALF * K * 2;
    const size_t tstep = 2 * hstep;
    const unsigned ldsw = (unsigned)wid * 1024u;
    const int aoff = lds_byte(wr * 64 + fr, fq * 8), boff = lds_byte(wc * 32 + fr, fq * 8);
#define PG8_SA(b, h) (((b) * 2 + (h)) * HTB)
#define PG8_SB(b, h) ((4 + (b) * 2 + (h)) * HTB)
#define PG8_STAGE(bufoff, gbase, voff) do { _Pragma("unroll") for (int _i = 0; _i < 2; ++_i) \
        __builtin_amdgcn_global_load_lds((const unsigned*)((const char*)(gbase) + (voff)[_i]), (PG8_LAS unsigned*)(lds + (bufoff) + ldsw + _i * 8192), 16, 0, 0); } while (0)
#define PG8_LDA(dst, b, h) do { _Pragma("unroll") for (int m = 0; m < 4; ++m) _Pragma("unroll") for (int k = 0; k < 2; ++k) dst[m][k] = *(const PG8_LAS bf16x8*)(lds + PG8_SA(b, h) + aoff + m * 2048 + k * 1024); } while (0)
#define PG8_LDB(dst, b, h) do { _Pragma("unroll") for (int n = 0; n < 2; ++n) _Pragma("unroll") for (int k = 0; k < 2; ++k) dst[n][k] = *(const PG8_LAS bf16x8*)(lds + PG8_SB(b, h) + boff + n * 2048 + k * 1024); } while (0)
#define PG8_MMA(ai, bj, At, Bt) do { __builtin_amdgcn_s_setprio(1); _Pragma("unroll") for (int m = 0; m < 4; ++m) _Pragma("unroll") for (int n = 0; n < 2; ++n) _Pragma("unroll") for (int k = 0; k < 2; ++k) \
        acc[ai][bj][m][n] = __builtin_amdgcn_mfma_f32_16x16x32_bf16(Bt[n][k], At[m][k], acc[ai][bj][m][n], 0, 0, 0); __builtin_amdgcn_s_setprio(0); } while (0)
#define PG8_WAIT_V(n) asm volatile("s_waitcnt vmcnt(" #n ")" ::: "memory")
#define PG8_WAIT_L(n) asm volatile("s_waitcnt lgkmcnt(" #n ")" ::: "memory")
#define PG8_BAR __builtin_amdgcn_s_barrier()
#define PG8_SCHED __builtin_amdgcn_sched_barrier(0)
    Unit cur, nxt; int ui = 0;
    if (!S.next(0, cur)) return;
    f32x4 acc[2][2][4][2];
#pragma unroll
    for (int a = 0; a < 2; ++a)
#pragma unroll
        for (int b = 0; b < 2; ++b)
#pragma unroll
            for (int m = 0; m < 4; ++m)
#pragma unroll
                for (int n = 0; n < 2; ++n) acc[a][b][m][n] = (f32x4){0.f, 0.f, 0.f, 0.f};
    bf16x8 At[4][2], B0[2][2], B1[2][2];
    const char* cA = (const char*)g.A + (size_t)cur.pm * tstep; const char* cB = (const char*)g.Bt + (size_t)cur.pn * tstep;
    S.a_ready(cur);
    if constexpr (SP2) {
        PG8_STAGE(PG8_SB(0, 0), cB, voffB); PG8_STAGE(PG8_SB(0, 1), cB + hstep, voffB); PG8_STAGE(PG8_SA(0, 0), cA, voffA); PG8_STAGE(PG8_SA(0, 1), cA + hstep, voffA);
        if (wr == 1) PG8_BAR;
        PG8_WAIT_V(2); PG8_BAR;
        PG8_STAGE(PG8_SB(1, 0), cB + kstep, voffB); PG8_STAGE(PG8_SA(1, 0), cA + kstep, voffA); PG8_STAGE(PG8_SB(1, 1), cB + hstep + kstep, voffB);
        PG8_WAIT_V(6); PG8_BAR;
    } else {
        PG8_STAGE(PG8_SB(0, 0), cB, voffB); PG8_STAGE(PG8_SA(0, 0), cA, voffA); PG8_STAGE(PG8_SB(0, 1), cB + hstep, voffB); PG8_STAGE(PG8_SA(0, 1), cA + hstep, voffA);
        if (wr == 1) PG8_BAR;
        PG8_WAIT_V(4); PG8_BAR;
        PG8_STAGE(PG8_SB(1, 0), cB + kstep, voffB); PG8_STAGE(PG8_SA(1, 0), cA + kstep, voffA); PG8_STAGE(PG8_SB(1, 1), cB + hstep + kstep, voffB);
        PG8_WAIT_V(6); PG8_BAR;
    }
    for (;;) {
        const bool has_next = S.next(ui + 1, nxt);
        const char* nA = has_next ? (const char*)g.A + (size_t)nxt.pm * tstep : cA; const char* nB = has_next ? (const char*)g.Bt + (size_t)nxt.pn * tstep : cB;
        for (int t = 0; t < nt; t += 2) {
            const bool last = (t == nt - 2);
            const char* a1 = cA + (size_t)(t + 1) * kstep;
            const char* a2 = last ? nA : cA + (size_t)(t + 2) * kstep; const char* b2 = last ? nB : cB + (size_t)(t + 2) * kstep;
            const char* a3 = a2 + kstep; const char* b3 = b2 + kstep;
            if (last && has_next) S.a_ready(nxt);
            if constexpr (SP2) {
            PG8_LDB(B0, 0, 0); PG8_LDB(B1, 0, 1); PG8_SCHED; PG8_LDA(At, 0, 0); PG8_STAGE(PG8_SA(1, 1), a1 + hstep, voffA);
            PG8_WAIT_V(8); PG8_WAIT_L(0); PG8_BAR; PG8_MMA(0, 0, At, B0); PG8_MMA(0, 1, At, B1); PG8_BAR; PG8_SCHED;
            PG8_LDA(At, 0, 1); PG8_STAGE(PG8_SB(0, 0), b2, voffB); PG8_STAGE(PG8_SB(0, 1), b2 + hstep, voffB); PG8_STAGE(PG8_SA(0, 0), a2, voffA);
            PG8_WAIT_V(8); PG8_WAIT_L(0); PG8_BAR; PG8_MMA(1, 0, At, B0); PG8_MMA(1, 1, At, B1); PG8_BAR; PG8_SCHED;
            PG8_LDB(B0, 1, 0); PG8_LDB(B1, 1, 1); PG8_SCHED; PG8_LDA(At, 1, 0); PG8_STAGE(PG8_SA(0, 1), a2 + hstep, voffA);
            PG8_WAIT_V(8); PG8_WAIT_L(0); PG8_BAR; PG8_MMA(0, 0, At, B0); PG8_MMA(0, 1, At, B1); PG8_BAR; PG8_SCHED;
            PG8_LDA(At, 1, 1); PG8_STAGE(PG8_SB(1, 0), b3, voffB); PG8_STAGE(PG8_SB(1, 1), b3 + hstep, voffB); PG8_STAGE(PG8_SA(1, 0), a3, voffA);
            PG8_WAIT_V(8); PG8_WAIT_L(0); PG8_BAR; PG8_MMA(1, 0, At, B0); PG8_MMA(1, 1, At, B1); PG8_BAR; PG8_SCHED;
            } else {
            PG8_LDB(B0, 0, 0); PG8_SCHED; PG8_LDA(At, 0, 0); PG8_STAGE(PG8_SA(1, 1), a1 + hstep, voffA);
            PG8_WAIT_L(8); PG8_BAR; PG8_WAIT_L(0); PG8_MMA(0, 0, At, B0); PG8_BAR; PG8_SCHED;
            PG8_LDB(B1, 0, 1); PG8_STAGE(PG8_SB(0, 0), b2, voffB);
            PG8_BAR; PG8_WAIT_L(0); PG8_MMA(0, 1, At, B1); PG8_BAR;
            PG8_LDA(At, 0, 1); PG8_STAGE(PG8_SA(0, 0), a2, voffA);
            PG8_BAR; PG8_WAIT_L(0); PG8_MMA(1, 0, At, B0); PG8_BAR; PG8_SCHED;
            PG8_STAGE(PG8_SB(0, 1), b2 + hstep, voffB);
            PG8_WAIT_V(6); PG8_BAR; PG8_MMA(1, 1, At, B1); PG8_BAR;
            PG8_LDB(B0, 1, 0); PG8_SCHED; PG8_LDA(At, 1, 0); PG8_STAGE(PG8_SA(0, 1), a2 + hstep, voffA);
            PG8_WAIT_L(8); PG8_BAR; PG8_WAIT_L(0); PG8_MMA(0, 0, At, B0); PG8_BAR; PG8_SCHED;
            PG8_LDB(B1, 1, 1); PG8_STAGE(PG8_SB(1, 0), b3, voffB);
            PG8_BAR; PG8_WAIT_L(0); PG8_MMA(0, 1, At, B1); PG8_BAR;
            PG8_LDA(At, 1, 1); PG8_STAGE(PG8_SA(1, 0), a3, voffA);
            PG8_BAR; PG8_WAIT_L(0); PG8_MMA(1, 0, At, B0); PG8_BAR; PG8_SCHED;
            PG8_STAGE(PG8_SB(1, 1), b3 + hstep, voffB);
            PG8_WAIT_V(6); PG8_BAR; PG8_MMA(1, 1, At, B1); PG8_BAR;
            }
        }
        if constexpr (ALIGN_EPI) { if (wr == 0) PG8_BAR; }
        if constexpr (!Epi::AFTER_DRAIN) { E(acc, cur, wr, wc, fr, fq); S.done(cur); }
        if (!has_next) break;
#pragma unroll
        for (int a = 0; a < 2; ++a)
#pragma unroll
            for (int b = 0; b < 2; ++b)
#pragma unroll
                for (int m = 0; m < 4; ++m)
#pragma unroll
                    for (int n = 0; n < 2; ++n) acc[a][b][m][n] = (f32x4){0.f, 0.f, 0.f, 0.f};
        cur = nxt; cA = nA; cB = nB; ++ui;
        if constexpr (ALIGN_EPI) { if (wr == 1) PG8_BAR; }
    }
    PG8_WAIT_V(0);
    if constexpr (!ALIGN_EPI) { if (wr == 0) PG8_BAR; }
    PG8_BAR;
    if constexpr (Epi::AFTER_DRAIN) { E.fused(acc, cur, wr, wc, fr, fq, lds, wid, lane); S.done(cur); }
#undef PG8_SA
#undef PG8_SB
#undef PG8_STAGE
#undef PG8_LDA
#undef PG8_LDB
#undef PG8_MMA
#undef PG8_WAIT_V
#undef PG8_WAIT_L
#undef PG8_BAR
#undef PG8_SCHED
}
}
constexpr int RING_OFF = 0, RING_BYTES = 131072;
constexpr int LDSCTL_OFF = RING_BYTES, MISC_OFF = LDSCTL_OFF + 320;
constexpr int LDS_BYTES = 147456;
constexpr int CW_BAR = 4096;

#define GAS __attribute__((address_space(1)))
#define LAS __attribute__((address_space(3)))
typedef unsigned short bf16;
typedef unsigned v4u __attribute__((ext_vector_type(4)));
typedef float f32x4 __attribute__((ext_vector_type(4)));
typedef short bf16x8 __attribute__((ext_vector_type(8)));
typedef GAS unsigned gu32;
#define RLX_AGENT __ATOMIC_RELAXED, __HIP_MEMORY_SCOPE_AGENT
#define LDS_WAIT() asm volatile("s_waitcnt lgkmcnt(0)" ::: "memory")
#define VM_WAIT() asm volatile("s_waitcnt vmcnt(0)" ::: "memory")
__device__ __forceinline__ unsigned f2bfu(float f) { unsigned u = __builtin_bit_cast(unsigned, f); return (u + 0x7fffu + ((u >> 16) & 1u)) >> 16; }
__device__ __forceinline__ bf16 f2bf(float f) { return (bf16)f2bfu(f); }
typedef float f32x2_t __attribute__((ext_vector_type(2))); typedef __bf16 bf16x2_t __attribute__((ext_vector_type(2)));
__device__ __forceinline__ unsigned pk2(float lo, float hi) { f32x2_t v = {lo, hi}; bf16x2_t b = __builtin_convertvector(v, bf16x2_t); return __builtin_bit_cast(unsigned, b); }
__device__ __forceinline__ float xor16_max(float v) { auto r = __builtin_amdgcn_permlane16_swap(__float_as_uint(v), __float_as_uint(v), false, false); return fmaxf(__uint_as_float(r[0]), __uint_as_float(r[1])); }
__device__ __forceinline__ float xor32_max(float v) { auto r = __builtin_amdgcn_permlane32_swap(__float_as_uint(v), __float_as_uint(v), false, false); return fmaxf(__uint_as_float(r[0]), __uint_as_float(r[1])); }
__device__ __forceinline__ float xor16_sum(float v) { auto r = __builtin_amdgcn_permlane16_swap(__float_as_uint(v), __float_as_uint(v), false, false); return __uint_as_float(r[0]) + __uint_as_float(r[1]); }
__device__ __forceinline__ float xor32_sum(float v) { auto r = __builtin_amdgcn_permlane32_swap(__float_as_uint(v), __float_as_uint(v), false, false); return __uint_as_float(r[0]) + __uint_as_float(r[1]); }
__device__ __forceinline__ float bf2f(bf16 v) { return __uint_as_float(((unsigned)v) << 16); }
__device__ __forceinline__ float silu_f(float v) { return v * __builtin_amdgcn_rcpf(1.f + __expf(-v)); }
__device__ __forceinline__ float sigmoid_f(float v) { return __builtin_amdgcn_rcpf(1.f + __expf(-v)); }
#define DPP_ADD_(v, ctrl) ((v) + __int_as_float(__builtin_amdgcn_update_dpp(0, __float_as_int(v), (ctrl), 0xF, 0xF, false)))
__device__ __forceinline__ float group8_sum(float v) {
    v = DPP_ADD_(v, 0xB1); v = DPP_ADD_(v, 0x4E); v = DPP_ADD_(v, 0x141); return v; }
__device__ __forceinline__ float wave_sum(float v) {
    v = group8_sum(v); v = DPP_ADD_(v, 0x140);
    { auto r = __builtin_amdgcn_permlane16_swap(__float_as_uint(v), __float_as_uint(v), false, false); v = __uint_as_float(r[0]) + __uint_as_float(r[1]); }
    { auto r = __builtin_amdgcn_permlane32_swap(__float_as_uint(v), __float_as_uint(v), false, false); v = __uint_as_float(r[0]) + __uint_as_float(r[1]); }
    return v;
}
__device__ __forceinline__ float rdlane(float v, int i) { return __int_as_float(__builtin_amdgcn_readlane(__float_as_int(v), i)); }


#ifndef PROBE_T
#define PROBE_T 0
#endif
#define TS_LDS(F) ((volatile LAS unsigned long long*)((F).lds + LDSCTL_OFF + 128))
#define TS_START(F, id) do { if (PROBE_T == (id) && blockIdx.x == 0 && (F).tid == 0) TS_LDS(F)[1] = __builtin_amdgcn_s_memtime(); } while (0)
#define TS_STOP(F, id)  do { if (PROBE_T == (id) && blockIdx.x == 0 && (F).tid == 0) TS_LDS(F)[0] += __builtin_amdgcn_s_memtime() - TS_LDS(F)[1]; } while (0)
#define XB_TMO      128
#define XB_XCNT(j)  (256  + 64 * (j))
#define XB_XSUB(j)  (1280 + 64 * (j))
#define XB_XGEN(j)  (2304 + 64 * (j))
#define XB_TOP      3328
#define XB_TOPGEN   3392
#define XCD_BAR_WORDS 3456
#define XB_SPIN_CAP (1u << 18)

__device__ __forceinline__ unsigned xb_ld(unsigned* p)              { return __hip_atomic_load(p, __ATOMIC_RELAXED, __HIP_MEMORY_SCOPE_AGENT); }
__device__ __forceinline__ unsigned xb_add(unsigned* p, unsigned v) { return __hip_atomic_fetch_add(p, v, __ATOMIC_RELAXED, __HIP_MEMORY_SCOPE_AGENT); }
__device__ __forceinline__ unsigned xb_xcc_id() { return (unsigned)__builtin_amdgcn_s_getreg((3 << 11) | 20) & 0xFu; }
#define XB_SPIN(cond, bar) do { unsigned _sp = 0; while (cond) { __builtin_amdgcn_s_sleep(1); \
    if ((++_sp & 255u) == 0u) { if (xb_ld(&(bar)[XB_TMO])) break; if (_sp > XB_SPIN_CAP) { atomicAdd(&(bar)[XB_TMO], 1u); break; } } } } while (0)

struct XcdBarrier {
    unsigned* bar; unsigned x;
    volatile LAS unsigned* st;
};

__device__ __forceinline__ XcdBarrier xcd_barrier_post(unsigned* bar, volatile LAS unsigned* st) {
    XcdBarrier b; b.bar = bar; b.x = xb_xcc_id(); b.st = st;
    if (threadIdx.x == 0) (void)xb_add(&bar[XB_XCNT(b.x)], 1u);
    return b;
}
__device__ __forceinline__ void xcd_barrier_complete(unsigned* bar, unsigned x, unsigned& nloc, unsigned& nx) {
    const unsigned G = gridDim.x * gridDim.y * gridDim.z;
    unsigned sum, cnt, mine, sp = 0u;
    for (;;) {
        sum = 0u; cnt = 0u; mine = 0u;
#pragma unroll
        for (unsigned j = 0; j < 16; ++j) { const unsigned c = xb_ld(&bar[XB_XCNT(j)]); sum += c; cnt += (c > 0u) ? 1u : 0u; mine = (j == x) ? c : mine; }
        if (sum == G) break;
        __builtin_amdgcn_s_sleep(1);
        if ((++sp & 255u) == 0u) { if (xb_ld(&bar[XB_TMO])) break; if (sp > XB_SPIN_CAP) { atomicAdd(&bar[XB_TMO], 1u); break; } }
    }
    nloc = mine > 0u ? mine : 1u; nx = cnt > 0u ? cnt : 1u;
}

__device__ __forceinline__ void xcd_barrier(const XcdBarrier& b) {
    asm volatile("s_waitcnt vmcnt(0)" ::: "memory");
    __syncthreads();
    if (threadIdx.x == 0) {
        unsigned* bar = b.bar;
        __builtin_amdgcn_s_waitcnt(0);
        unsigned nloc = b.st[0], nx = b.st[1];
        if (nloc == 0u) { xcd_barrier_complete(bar, b.x, nloc, nx); b.st[0] = nloc; b.st[1] = nx; }
        const unsigned old = xb_add(&bar[XB_XSUB(b.x)], 1u);
        const unsigned gen = old / nloc;
        if (old + 1u == (gen + 1u) * nloc) {
            __builtin_amdgcn_fence(__ATOMIC_RELEASE, "agent");
            asm volatile("s_waitcnt vmcnt(0)" ::: "memory");
            const unsigned og = xb_add(&bar[XB_TOP], 1u);
            const unsigned tg = og / nx;
            if (og + 1u == (tg + 1u) * nx) xb_add(&bar[XB_TOPGEN], 1u);
            else XB_SPIN(xb_ld(&bar[XB_TOPGEN]) == tg, bar);
            __builtin_amdgcn_fence(__ATOMIC_ACQUIRE, "agent");
            xb_add(&bar[XB_XGEN(b.x)], 1u);
            asm volatile("s_waitcnt vmcnt(0)" ::: "memory");
        } else {
            XB_SPIN(xb_ld(&bar[XB_XGEN(b.x)]) == gen, bar);
            __builtin_amdgcn_fence(__ATOMIC_ACQUIRE, "agent");
            asm volatile("s_waitcnt vmcnt(0)" ::: "memory");
        }
    }
    __syncthreads();
}

struct Ctx {
    LAS unsigned char* lds; int tid, lane, wave, vcu, G, gw, NGW;
    const float *x, *c, *ctx, *c_ctx, *w_mod, *b_mod, *g_pre, *g_post, *w_in, *w_out, *hgrn_lb, *hgrn_gn, *gate_b, *mlstm_gn, *na_rpb;
    float* out; bf16 *wt_in, *wt_out, *hxy, *P; float *mod, *gates, *ctx1, *stm, *sth, *rope; bf16 *otm, *oth, *UX;
};

__device__ __forceinline__ void transpose_item(const float* W, int N, int Nnew, bool remap, bf16* WT, LAS float* scr, int item, int lane) {
    const int nblk = Nnew / 32, kb = item / nblk, nb = item % nblk, k0 = 64 * kb, n0 = 32 * nb;
    const int rg = lane >> 3, c4 = (lane & 7) * 4, nn = n0 + c4;
    int no = nn; if (remap) no = nn < 3200 ? nn : (nn < 4736 ? nn + 16 : (nn < 4752 ? 3200 + nn - 4736 : -1));
    f32x4 v[8];
#pragma unroll
    for (int j = 0; j < 8; ++j) v[j] = no >= 0 ? __builtin_nontemporal_load((const f32x4*)(W + (size_t)(k0 + 8 * j + rg) * N + no)) : (f32x4){0.f, 0.f, 0.f, 0.f};
#pragma unroll
    for (int j = 0; j < 8; ++j) { LAS float* d = scr + (8 * j + rg) * 33 + c4; d[0] = v[j][0]; d[1] = v[j][1]; d[2] = v[j][2]; d[3] = v[j][3]; }
    LDS_WAIT(); asm volatile("" ::: "memory");
    const int c = lane & 7;
#pragma unroll
    for (int j = 0; j < 4; ++j) { const int n = (lane >> 3) + 8 * j; const LAS float* s = scr + (8 * c) * 33 + n;
        v4u o; o.x = pk2(s[0 * 33], s[1 * 33]); o.y = pk2(s[2 * 33], s[3 * 33]); o.z = pk2(s[4 * 33], s[5 * 33]); o.w = pk2(s[6 * 33], s[7 * 33]);
        *(GAS v4u*)(WT + (size_t)(n0 + n) * 1024 + k0 + 8 * c) = o; }
    LDS_WAIT(); asm volatile("" ::: "memory");
}
__device__ __forceinline__ void phase_p0(const Ctx& F) {
    if (F.vcu < 96) {
        LAS float* tab = (LAS float*)(F.lds);
        LAS float* part = (LAS float*)(F.lds + 36864);
        for (int i = F.tid; i < 9 * 1024; i += 512) { const int r = i >> 10, k = i & 1023; const float v = r < 8 ? F.c[r * 1024 + k] : F.c_ctx[k]; tab[i] = silu_f(v); }
        __syncthreads();
        for (int it = F.vcu; it < 96; it += F.G) {
            const int l = it / 48, jb = it % 48;
            const int rsub = F.lane >> 4, c4 = (F.lane & 15) * 4;
            float acc[9][4];
#pragma unroll
            for (int r = 0; r < 9; ++r) { acc[r][0] = acc[r][1] = acc[r][2] = acc[r][3] = 0.f; }
            const float* wp = F.w_mod + ((size_t)l * 1024 + F.wave * 128 + rsub) * 3072 + jb * 64 + c4;
            f32x4 wv[32];
#pragma unroll
            for (int j = 0; j < 32; ++j) wv[j] = __builtin_nontemporal_load((const f32x4*)(wp + (size_t)(4 * j) * 3072));
#pragma unroll
            for (int j = 0; j < 32; ++j)
#pragma unroll
                for (int r = 0; r < 9; ++r) { const float t = tab[r * 1024 + F.wave * 128 + 4 * j + rsub]; acc[r][0] += t * wv[j][0]; acc[r][1] += t * wv[j][1]; acc[r][2] += t * wv[j][2]; acc[r][3] += t * wv[j][3]; }
#pragma unroll
            for (int r = 0; r < 9; ++r)
#pragma unroll
                for (int e = 0; e < 4; ++e) acc[r][e] = xor32_sum(xor16_sum(acc[r][e]));
            if (rsub == 0) {
#pragma unroll
                for (int r = 0; r < 9; ++r) *(LAS f32x4*)(part + (F.wave * 9 + r) * 64 + c4) = (f32x4){acc[r][0], acc[r][1], acc[r][2], acc[r][3]}; }
            __syncthreads();
            for (int i = F.tid; i < 9 * 64; i += 512) { const int r = i >> 6, j = i & 63; float s = 0.f;
#pragma unroll
                for (int w = 0; w < 8; ++w) s += part[(w * 9 + r) * 64 + j];
                F.mod[((size_t)l * 9 + r) * 3072 + jb * 64 + j] = s + F.b_mod[l * 3072 + jb * 64 + j]; }
            __syncthreads();
        }
    }
    if (F.vcu == 96 % F.G) for (int i = F.tid; i < 64 * 24; i += 512) { const int pos = i / 24, f = i % 24; const float ang = (float)pos * expf(-(float)(2 * f) * (1.f / 48.f) * 9.210340371976184f); F.rope[2 * i] = cosf(ang); F.rope[2 * i + 1] = sinf(ang); }
    __syncthreads();
    LAS float* scr = (LAS float*)(F.lds + F.wave * 16384);
    constexpr int I_IN = 16 * (NPAD / 32);
    const int gwr = F.NGW - 1 - F.gw;
    for (int it = gwr; it < I_IN; it += F.NGW) transpose_item(F.w_in, PIN, NPAD, true, F.wt_in, scr, it, F.lane);
}
__device__ __forceinline__ void phase_p1_transposes(const Ctx& F) {
    LAS float* scr = (LAS float*)(F.lds + F.wave * 16384);
    constexpr int I_IN = 16 * (NPAD / 32), I_OUT = 16 * 32;
    for (int it = F.gw; it < I_IN + 2 * I_OUT; it += F.NGW) {
        if (it < I_OUT) transpose_item(F.w_out, 1024, 1024, false, F.wt_out, scr, it, F.lane);
        else if (it < I_OUT + I_IN) transpose_item(F.w_in + (size_t)1024 * PIN, PIN, NPAD, true, F.wt_in + (size_t)NPAD * 1024, scr, it - I_OUT, F.lane);
        else transpose_item(F.w_out + (size_t)1024 * 1024, 1024, 1024, false, F.wt_out + (size_t)1024 * 1024, scr, it - I_OUT - I_IN, F.lane);
    }
}

struct RowPar { float4 g[4], a[4], b[4]; };
__device__ __forceinline__ void load_par(RowPar& p, const float* g, const float* a, const float* b, int lane) {
#pragma unroll
    for (int j = 0; j < 4; ++j) { const int d = 4 * (lane + 64 * j); p.g[j] = *(const float4*)(g + d); p.a[j] = *(const float4*)(a + d); p.b[j] = *(const float4*)(b + d); }
}
__device__ __forceinline__ void prenorm_store(const float4 (&v)[4], float ss, const RowPar& p, bf16* dst, int lane) {
    const float rinv = __builtin_amdgcn_rsqf(ss * (1.f / 1024.f) + EPS);
#pragma unroll
    for (int j = 0; j < 4; ++j) {
        const int d = 4 * (lane + 64 * j);
        const float o0 = v[j].x * rinv * p.g[j].x * (1.f + p.a[j].x) + p.b[j].x, o1 = v[j].y * rinv * p.g[j].y * (1.f + p.a[j].y) + p.b[j].y;
        const float o2 = v[j].z * rinv * p.g[j].z * (1.f + p.a[j].z) + p.b[j].z, o3 = v[j].w * rinv * p.g[j].w * (1.f + p.a[j].w) + p.b[j].w;
        uint2 w; w.x = pk2(o0, o1); w.y = pk2(o2, o3);
        *(uint2*)(dst + d) = w;
    }
}
__device__ __forceinline__ void phase_prenorm0(const Ctx& F) {
    auto rowsrc = [&](int m) -> const float* { return m < MX ? F.x + (size_t)m * 1024 : F.ctx + (size_t)(m - MX) * 1024; };
    const int nrow = (M + F.NGW - 1) / F.NGW, m0 = F.gw * nrow, m1 = min(m0 + nrow, M);
    if (m0 >= m1) return;
    float4 nv[4];
#pragma unroll
    for (int j = 0; j < 4; ++j) { const f32x4 t = __builtin_nontemporal_load((const f32x4*)rowsrc(m0) + F.lane + 64 * j); nv[j] = make_float4(t[0], t[1], t[2], t[3]); }
    RowPar p; int rcur = -1;
    for (int m = m0; m < m1; ++m) {
        const int r = m < MX ? m / S : 8;
        if (r != rcur) { const float* mod_r = F.mod + (size_t)r * 3072; load_par(p, F.g_pre, mod_r + 1024, mod_r, F.lane); rcur = r; }
        float4 v[4];
#pragma unroll
        for (int j = 0; j < 4; ++j) v[j] = nv[j];
        if (m + 1 < m1) {
#pragma unroll
            for (int j = 0; j < 4; ++j) { const f32x4 t = __builtin_nontemporal_load((const f32x4*)rowsrc(m + 1) + F.lane + 64 * j); nv[j] = make_float4(t[0], t[1], t[2], t[3]); } }
        float ss = 0.f;
#pragma unroll
        for (int j = 0; j < 4; ++j) ss += v[j].x * v[j].x + v[j].y * v[j].y + v[j].z * v[j].z + v[j].w * v[j].w;
        ss = wave_sum(ss);
        prenorm_store(v, ss, p, F.hxy + (size_t)m * 1024, F.lane);
    }
}
__device__ __forceinline__ void phase_post(const Ctx& F, int l) {
    const int Ml = l == 0 ? M : MX;
    const float* mod_l = F.mod + (size_t)l * 9 * 3072; const float* g_post_l = F.g_post + l * 1024;
    auto rowsrc = [&](int m) -> const float* { return m < MX ? (l == 0 ? F.x : F.out) + (size_t)m * 1024 : F.ctx + (size_t)(m - MX) * 1024; };
    const int nrow = (Ml + F.NGW - 1) / F.NGW, m0 = F.gw * nrow, m1 = min(m0 + nrow, Ml);
    if (m0 >= m1) return;
    float4 nx[4]; uint2 nu[4];
#pragma unroll
    for (int j = 0; j < 4; ++j) { nx[j] = ((const float4*)rowsrc(m0))[F.lane + 64 * j]; nu[j] = ((const uint2*)(F.UX + (size_t)m0 * 1024))[F.lane + 64 * j]; }
    float4 pg[4], pt[4]; RowPar p2; int rcur = -1;
#pragma unroll
    for (int j = 0; j < 4; ++j) pg[j] = *(const float4*)(g_post_l + 4 * (F.lane + 64 * j));
    for (int m = m0; m < m1; ++m) {
        float* dst; int r;
        if (m < MX) { dst = F.out + (size_t)m * 1024; r = m / S; } else { dst = F.ctx1 + (size_t)(m - MX) * 1024; r = 8; }
        if (r != rcur) {
#pragma unroll
            for (int j = 0; j < 4; ++j) pt[j] = *(const float4*)(mod_l + r * 3072 + 2048 + 4 * (F.lane + 64 * j));
            if (l == 0) load_par(p2, F.g_pre + 1024, F.mod + (size_t)(9 + r) * 3072 + 1024, F.mod + (size_t)(9 + r) * 3072, F.lane);
            rcur = r; }
        float4 xr[4], u[4]; float ss = 0.f;
#pragma unroll
        for (int j = 0; j < 4; ++j) { xr[j] = nx[j]; const uint2 w = nu[j];
            u[j].x = __uint_as_float(w.x << 16); u[j].y = __uint_as_float(w.x & 0xffff0000u); u[j].z = __uint_as_float(w.y << 16); u[j].w = __uint_as_float(w.y & 0xffff0000u);
            ss += u[j].x * u[j].x + u[j].y * u[j].y + u[j].z * u[j].z + u[j].w * u[j].w; }
        if (m + 1 < m1) {
#pragma unroll
            for (int j = 0; j < 4; ++j) { nx[j] = ((const float4*)rowsrc(m + 1))[F.lane + 64 * j]; nu[j] = ((const uint2*)(F.UX + (size_t)(m + 1) * 1024))[F.lane + 64 * j]; } }
        ss = wave_sum(ss);
        const float rinv = __builtin_amdgcn_rsqf(ss * (1.f / 1024.f) + EPS);
        float ss2 = 0.f;
#pragma unroll
        for (int j = 0; j < 4; ++j) {
            const int d = 4 * (F.lane + 64 * j);
            const float4 g = pg[j], t = pt[j], xv = xr[j];
            float4 o; o.x = xv.x + t.x * (u[j].x * rinv * g.x); o.y = xv.y + t.y * (u[j].y * rinv * g.y); o.z = xv.z + t.z * (u[j].z * rinv * g.z); o.w = xv.w + t.w * (u[j].w * rinv * g.w);
            __builtin_nontemporal_store((f32x4){o.x, o.y, o.z, o.w}, (f32x4*)(dst + d)); u[j] = o; ss2 += o.x * o.x + o.y * o.y + o.z * o.z + o.w * o.w;
        }
        if (l == 0) { ss2 = wave_sum(ss2); prenorm_store(u, ss2, p2, F.hxy + (size_t)m * 1024, F.lane); }
    }
}


typedef short s16x4 __attribute__((ext_vector_type(4)));
typedef short v4i16_t __attribute__((ext_vector_type(4)));
__device__ __forceinline__ s16x4 tr_read(const LAS bf16* p) { return __builtin_bit_cast(s16x4, __builtin_amdgcn_ds_read_tr16_b64_v4i16((LAS v4i16_t*)p)); }
__device__ __forceinline__ bf16x8 tr_frag(const LAS bf16* T, int stride, int rowA, int rowB, int col0, int lane) {
    const int q = (lane >> 2) & 3, p = lane & 3;
    const s16x4 lo = tr_read(T + (rowA + q) * stride + col0 + 4 * p), hi = tr_read(T + (rowB + q) * stride + col0 + 4 * p);
    return (bf16x8){lo[0], lo[1], lo[2], lo[3], hi[0], hi[1], hi[2], hi[3]};
}
__device__ __forceinline__ bf16x8 rm_frag(const LAS bf16* T, int stride, int row, int k0) { return *(const LAS bf16x8*)(T + row * stride + k0); }
__device__ __forceinline__ f32x4 mfma16(bf16x8 a, bf16x8 b, f32x4 c) { return __builtin_amdgcn_mfma_f32_16x16x32_bf16(a, b, c, 0, 0, 0); }
typedef unsigned v2u __attribute__((ext_vector_type(2)));
typedef float f32x2 __attribute__((ext_vector_type(2)));
__device__ __forceinline__ void unpack8(const v4u w, float* f) {
    f[0] = __uint_as_float(w.x << 16); f[1] = __uint_as_float(w.x & 0xffff0000u); f[2] = __uint_as_float(w.y << 16); f[3] = __uint_as_float(w.y & 0xffff0000u);
    f[4] = __uint_as_float(w.z << 16); f[5] = __uint_as_float(w.z & 0xffff0000u); f[6] = __uint_as_float(w.w << 16); f[7] = __uint_as_float(w.w & 0xffff0000u);
}
__device__ __forceinline__ v4u pack8(const float* f) { v4u w; w.x = pk2(f[0], f[1]); w.y = pk2(f[2], f[3]); w.z = pk2(f[4], f[5]); w.w = pk2(f[6], f[7]); return w; }

__device__ __forceinline__ float wave_scan_incl(float x) {
    int v = __float_as_int(x);
#define DPP_ADD(ctrl, rmask) v = __float_as_int(__int_as_float(v) + __int_as_float(__builtin_amdgcn_update_dpp(0, v, ctrl, rmask, 0xF, false)))
    DPP_ADD(0x111, 0xF); DPP_ADD(0x112, 0xF); DPP_ADD(0x114, 0xF); DPP_ADD(0x118, 0xF); DPP_ADD(0x142, 0xA); DPP_ADD(0x143, 0xC);
#undef DPP_ADD
    return __int_as_float(v);
}
#define LDS_FENCE() asm volatile("" ::: "memory")
namespace ml {
constexpr int QSTR = 104, VSTR = 120;
constexpr int OFF_QS = 0, OFF_KS = OFF_QS + 64 * QSTR * 2, OFF_VS = OFF_KS + 64 * QSTR * 2, OFF_CT = OFF_VS + 64 * VSTR * 2;
constexpr int OFF_HT = OFF_CT + 2 * 112 * QSTR * 2, OFF_DEN = OFF_HT + 64 * 100 * 4, OFF_ROPE = OFF_DEN + 256, OFF_END = OFF_ROPE + 64 * 24 * 8;
static_assert(OFF_END <= RING_BYTES && 6 * 7 * 64 * 16 <= OFF_HT, "mlstm LDS");
constexpr int ST_FLOATS = 96 * 112 + 16;
}
constexpr int NSEG = 4, SEGTOK = S / NSEG, SEGCH = SEGTOK / 64;
struct MlJob { int b, h, isctx, t0, nchunk; };

__device__ __forceinline__ void mlstm_dir(const Ctx& F, int l, const MlJob jb, int dir, int fold_r, int emit_slot, int mode, bf16* otmp, float* ST) {
    using namespace ml;
    int tid_ = F.tid; asm volatile("" : "+v"(tid_));
    const int w = __builtin_amdgcn_readfirstlane(tid_ >> 6);
    const bool tsel = (mode != 0) && !jb.isctx && l == 0;
    if (tsel) TS_START(F, 10);
    LAS bf16* QS = (LAS bf16*)(F.lds + OFF_QS); LAS bf16* KS = (LAS bf16*)(F.lds + OFF_KS); LAS bf16* VS = (LAS bf16*)(F.lds + OFF_VS);
    LAS bf16* CT0 = (LAS bf16*)(F.lds + OFF_CT); LAS float* HT = (LAS float*)(F.lds + OFF_HT); LAS float* DEN = (LAS float*)(F.lds + OFF_DEN);
    const LAS f32x2* ROPE = (const LAS f32x2*)(F.lds + OFF_ROPE);
    const int rowbase = jb.isctx ? MX + jb.b * CTX : jb.b * S;
    const int h = jb.h; const bf16* P = F.P;
    float* STd = ST + (size_t)(((jb.b * 4 + h) * 2 + dir) * 8) * ST_FLOATS;
    f32x4 Cst[7];
#pragma unroll
    for (int et = 0; et < 7; ++et) Cst[et] = (f32x4){0.f, 0.f, 0.f, 0.f};
    if (fold_r >= 0) {
        LAS f32x4* FOLD = (LAS f32x4*)(F.lds + OFF_QS);
        float wk[8];
        { float bs[8]; bs[0] = 0.f;
#pragma unroll
          for (int k = 1; k < NSEG; ++k) bs[k] = STd[(size_t)k * ST_FLOATS + 96 * 112];
          float run = 1.f;
#pragma unroll
          for (int k = NSEG - 1; k >= 0; --k) { wk[k] = (k <= fold_r) ? run : 0.f; run = (k >= 1 && k <= fold_r) ? run * __expf(bs[k]) : run; } }
#pragma unroll 2
        for (int p = tid_; p < 6 * 7 * 64; p += 512) {
            f32x4 v[8];
#pragma unroll
            for (int k = 0; k < NSEG; ++k) v[k] = *(const f32x4*)(STd + (size_t)k * ST_FLOATS + 4 * p);
            f32x4 acc = v[0] * wk[0];
#pragma unroll
            for (int k = 1; k < NSEG; ++k) acc += v[k] * wk[k];
            FOLD[p] = acc;
        }
        __syncthreads();
        if (w < 6) {
#pragma unroll
            for (int et = 0; et < 7; ++et) Cst[et] = FOLD[(w * 7 + et) * 64 + (tid_ & 63)];
        }
        __syncthreads();
    }
    asm volatile("" : "+v"(tid_));
    const int tid = tid_, lane = tid & 63, g = lane >> 4, c = lane & 15;
    float Btot = 0.f;
    for (int i = tid; i < 64 * 16; i += 512) { const int s = i >> 4, e = 96 + (i & 15); VS[s * VSTR + e] = (e == 96) ? (bf16)0x3F80 : (bf16)0; }
    if (w < 6) {
#pragma unroll
        for (int et = 0; et < 7; ++et) { v2u v; v.x = pk2(Cst[et][0], Cst[et][1]); v.y = pk2(Cst[et][2], Cst[et][3]); *(LAS v2u*)(CT0 + (16 * et + c) * QSTR + 16 * w + 4 * g) = v; }
    }
    const bool hasqk = tid < 384; const int qk_tok = tid / 6, qk_pi = tid % 6, qk_part = qk_pi / 3, qk_pp = qk_pi % 3, qk_d0 = 48 * qk_part + 8 * qk_pp;
    const int v1_tok = tid / 12, v1_pc = tid % 12; const bool hasv2 = tid < 256; const int v2_tok = (512 + tid) / 12, v2_pc = (512 + tid) % 12;
    struct LoadSet { v4u q0, q1, k0, k1, v1, v2; float ig, lf; };
    LoadSet LA;
    v2u ft[3], fo[3], fz[3];
    const int fi_i = tid >> 3, fi_e0 = 12 * (tid & 7);
#pragma unroll
    for (int q4 = 0; q4 < 3; ++q4) { ft[q4] = (v2u){0u, 0u}; fo[q4] = (v2u){0u, 0u}; fz[q4] = (v2u){0u, 0u}; }
    LA.q0 = LA.q1 = LA.k0 = LA.k1 = LA.v1 = LA.v2 = (v4u){0u, 0u, 0u, 0u}; LA.ig = LA.lf = 0.f;
    auto tok_of = [&](int ci, int i) -> int { return dir == 0 ? jb.t0 + 64 * ci + i : jb.t0 + 64 * (jb.nchunk - 1 - ci) + (63 - i); };
    auto issue_loads = [&](LoadSet& L, int ci) {
        if (hasqk) { const bf16* pr = P + (size_t)(rowbase + tok_of(ci, qk_tok)) * PLD + h * 96 + qk_d0;
            if (mode != 0) { L.q0 = *(const v4u*)(pr + B_Q); L.q1 = *(const v4u*)(pr + B_Q + 24); }
            L.k0 = *(const v4u*)(pr + B_K); L.k1 = *(const v4u*)(pr + B_K + 24); }
        L.v1 = *(const v4u*)(P + (size_t)(rowbase + tok_of(ci, v1_tok)) * PLD + B_V + h * 96 + 8 * v1_pc);
        if (hasv2) L.v2 = *(const v4u*)(P + (size_t)(rowbase + tok_of(ci, v2_tok)) * PLD + B_V + h * 96 + 8 * v2_pc);
        const float* gp = F.gates + (size_t)(rowbase + tok_of(ci, lane)) * 16 + dir * 4 + h; L.ig = gp[0]; L.lf = gp[8];
    };
    auto issue_fin = [&](int ci) {
        const int m = rowbase + tok_of(ci, fi_i); const bf16* tp = otmp + (size_t)m * 384 + h * 96 + fi_e0; const bf16* pr = P + (size_t)m * PLD + h * 96 + fi_e0;
#pragma unroll
        for (int q4 = 0; q4 < 3; ++q4) { ft[q4] = *(const v2u*)(tp + 4 * q4); fo[q4] = *(const v2u*)(pr + B_O + 4 * q4); fz[q4] = *(const v2u*)(pr + B_Z + 4 * q4); }
    };
    auto finalize = [&](int ci) {
            const int i = tid >> 3, sub = tid & 7, e0 = 12 * sub; const int m = rowbase + tok_of(ci, i);
            float hv[12]; const float rden = __builtin_amdgcn_rcpf(fmaxf(fabsf(DEN[i]), 1.f));
#pragma unroll
            for (int q4 = 0; q4 < 3; ++q4) { const f32x4 v = *(const LAS f32x4*)(HT + i * 100 + e0 + 4 * q4); hv[4 * q4] = v[0] * rden; hv[4 * q4 + 1] = v[1] * rden; hv[4 * q4 + 2] = v[2] * rden; hv[4 * q4 + 3] = v[3] * rden; }
            bf16* tp = otmp + (size_t)m * 384 + h * 96 + e0;
            if (mode == 1) {
#pragma unroll
                for (int q4 = 0; q4 < 3; ++q4) { v2u v; v.x = pk2(hv[4 * q4], hv[4 * q4 + 1]); v.y = pk2(hv[4 * q4 + 2], hv[4 * q4 + 3]); *(v2u*)(tp + 4 * q4) = v; }
            } else {
                float ss = 0.f;
#pragma unroll
                for (int q4 = 0; q4 < 3; ++q4) { const v2u v = ft[q4];
                    hv[4 * q4] += __uint_as_float(v.x << 16); hv[4 * q4 + 1] += __uint_as_float(v.x & 0xffff0000u); hv[4 * q4 + 2] += __uint_as_float(v.y << 16); hv[4 * q4 + 3] += __uint_as_float(v.y & 0xffff0000u); }
#pragma unroll
                for (int e = 0; e < 12; ++e) ss += hv[e] * hv[e];
                ss = group8_sum(ss);
                const float rinv = __builtin_amdgcn_rsqf(ss * (1.f / 96.f) + EPS);
                bf16* yp = F.hxy + (size_t)m * 1024 + 256 + h * 96 + e0; const float* gnv = F.mlstm_gn + l * 384 + h * 96 + e0;
#pragma unroll
                for (int q4 = 0; q4 < 3; ++q4) { const v2u ov = fo[q4], zv = fz[q4];
                    const float og[4] = {__uint_as_float(ov.x << 16), __uint_as_float(ov.x & 0xffff0000u), __uint_as_float(ov.y << 16), __uint_as_float(ov.y & 0xffff0000u)};
                    const float zg[4] = {__uint_as_float(zv.x << 16), __uint_as_float(zv.x & 0xffff0000u), __uint_as_float(zv.y << 16), __uint_as_float(zv.y & 0xffff0000u)};
                    float o[4];
#pragma unroll
                    for (int e = 0; e < 4; ++e) o[e] = og[e] * (hv[4 * q4 + e] * rinv * gnv[4 * q4 + e]) * zg[e];
                    v2u v; v.x = pk2(o[0], o[1]); v.y = pk2(o[2], o[3]); *(v2u*)(yp + 4 * q4) = v; }
            }
    };
    struct Packed { v4u k0, k1, q0, q1, v1, v2; float bL, ebL; };
    auto stage_math = [&](LoadSet& L, int ci, Packed& K) {
        const float bcs = wave_scan_incl(L.lf);
        const float qsc = __expf(bcs), ksc = __expf(L.ig - bcs);
        K.bL = rdlane(bcs, 63); K.ebL = __expf(K.bL);
        if (hasqk) {
            const float ks_t = __shfl(ksc, qk_tok), qs_t = __shfl(qsc, qk_tok);
            float cs[8], sn[8];
            if (!jb.isctx) { const int t = tok_of(ci, qk_tok); const int pos = qk_part ? (t & 63) : (t >> 6);
#pragma unroll
                for (int e = 0; e < 8; ++e) { const f32x2 v = ROPE[pos * 24 + 8 * qk_pp + e]; cs[e] = v[0]; sn[e] = v[1]; } }
            else {
#pragma unroll
                for (int e = 0; e < 8; ++e) { cs[e] = 1.f; sn[e] = 0.f; } }
            float a[8], b2[8], o0[8], o1[8];
            unpack8(L.k0, a); unpack8(L.k1, b2);
#pragma unroll
            for (int e = 0; e < 8; ++e) { o0[e] = (a[e] * cs[e] - b2[e] * sn[e]) * ks_t; o1[e] = (b2[e] * cs[e] + a[e] * sn[e]) * ks_t; }
            K.k0 = pack8(o0); K.k1 = pack8(o1);
            if (mode != 0) {
                unpack8(L.q0, a); unpack8(L.q1, b2);
#pragma unroll
                for (int e = 0; e < 8; ++e) { o0[e] = (a[e] * cs[e] - b2[e] * sn[e]) * qs_t; o1[e] = (b2[e] * cs[e] + a[e] * sn[e]) * qs_t; }
                K.q0 = pack8(o0); K.q1 = pack8(o1);
            }
        } else { (void)__shfl(ksc, 0); (void)__shfl(qsc, 0); }
        K.v1 = L.v1; K.v2 = L.v2;
    };
    auto stage_write = [&](const Packed& K) {
        if (hasqk) {
            *(LAS v4u*)(KS + qk_tok * QSTR + qk_d0) = K.k0; *(LAS v4u*)(KS + qk_tok * QSTR + qk_d0 + 24) = K.k1;
            if (mode != 0) { *(LAS v4u*)(QS + qk_tok * QSTR + qk_d0) = K.q0; *(LAS v4u*)(QS + qk_tok * QSTR + qk_d0 + 24) = K.q1; }
        }
        *(LAS v4u*)(VS + v1_tok * VSTR + 8 * v1_pc) = K.v1;
        if (hasv2) *(LAS v4u*)(VS + v2_tok * VSTR + 8 * v2_pc) = K.v2;
    };
    Packed PK; PK.k0 = PK.k1 = PK.q0 = PK.q1 = PK.v1 = PK.v2 = (v4u){0u, 0u, 0u, 0u}; PK.bL = 0.f; PK.ebL = 1.f;
    issue_loads(LA, 0);
    __syncthreads();
    stage_math(LA, 0, PK); stage_write(PK);
    if (jb.nchunk > 1) issue_loads(LA, 1);
    float bL = PK.bL, ebL = PK.ebL;
    __syncthreads();
    if (tsel) TS_STOP(F, 10);
    auto chunk_step = [&](LoadSet& Lnext, int ci) {
        LAS bf16* CTc = CT0 + (ci & 1) * 112 * QSTR; LAS bf16* CTn = CT0 + ((ci + 1) & 1) * 112 * QSTR;
        if (mode == 2) issue_fin(ci);
        if (ci + 1 < jb.nchunk) { stage_math(Lnext, ci + 1, PK); if (ci + 2 < jb.nchunk) issue_loads(Lnext, ci + 2); }
        if (mode != 0) {
            const int tt = w & 3, jh = w >> 2;
            bf16x8 qf[3], kf[4][3];
#pragma unroll
            for (int ks = 0; ks < 3; ++ks) qf[ks] = rm_frag(QS, QSTR, 16 * tt + c, 32 * ks + 8 * g);
#pragma unroll
            for (int ss = 0; ss < 4; ++ss) if (ss <= tt) {
#pragma unroll
                for (int ks = 0; ks < 3; ++ks) kf[ss][ks] = rm_frag(KS, QSTR, 16 * ss + c, 32 * ks + 8 * g); }
            LDS_FENCE();
            f32x4 st[4];
#pragma unroll
            for (int ss = 0; ss < 4; ++ss) { st[ss] = (f32x4){0.f, 0.f, 0.f, 0.f};
                if (ss <= tt) {
#pragma unroll
                    for (int ks = 0; ks < 3; ++ks) st[ss] = mfma16(kf[ss][ks], qf[ks], st[ss]);
                    if (ss == tt) {
#pragma unroll
                        for (int r = 0; r < 4; ++r) if (4 * g + r > c) st[ss][r] = 0.f; }
                } }
            bf16x8 pf[2];
#pragma unroll
            for (int kk = 0; kk < 2; ++kk) { const unsigned u0 = pk2(st[2 * kk][0], st[2 * kk][1]), u1 = pk2(st[2 * kk][2], st[2 * kk][3]), u2 = pk2(st[2 * kk + 1][0], st[2 * kk + 1][1]), u3 = pk2(st[2 * kk + 1][2], st[2 * kk + 1][3]);
                pf[kk] = __builtin_bit_cast(bf16x8, (v4u){u0, u1, u2, u3}); }
#pragma unroll
            for (int eb = 0; eb < 4; eb += 2) {
                bf16x8 vf[2][2], cf[2][3];
#pragma unroll
                for (int e2 = 0; e2 < 2; ++e2) { const int et = 4 * jh + eb + e2;
                    if (et < 7) {
#pragma unroll
                        for (int kk = 0; kk < 2; ++kk) if (2 * kk <= tt) vf[e2][kk] = tr_frag(VS, VSTR, 32 * kk + 4 * g, 32 * kk + 16 + 4 * g, 16 * et, lane);
#pragma unroll
                        for (int ks = 0; ks < 3; ++ks) cf[e2][ks] = rm_frag(CTc, QSTR, 16 * et + c, 32 * ks + 8 * g); } }
                LDS_FENCE();
#pragma unroll
                for (int e2 = 0; e2 < 2; ++e2) { const int et = 4 * jh + eb + e2;
                    if (et < 7) {
                        f32x4 acc = (f32x4){0.f, 0.f, 0.f, 0.f};
#pragma unroll
                        for (int kk = 0; kk < 2; ++kk) if (2 * kk <= tt) acc = mfma16(vf[e2][kk], pf[kk], acc);
#pragma unroll
                        for (int ks = 0; ks < 3; ++ks) acc = mfma16(cf[e2][ks], qf[ks], acc);
                        if (et < 6) *(LAS f32x4*)(HT + (16 * tt + c) * 100 + 16 * et + 4 * g) = acc;
                        else if (g == 0) DEN[16 * tt + c] = acc[0];
                    } }
            }
        }
        if (w < 6) {
#pragma unroll
            for (int kk = 0; kk < 2; ++kk) {
                bf16x8 vf[7]; const bf16x8 af = tr_frag(KS, QSTR, 32 * kk + 8 * g, 32 * kk + 8 * g + 4, 16 * w, lane);
#pragma unroll
                for (int et = 0; et < 7; ++et) vf[et] = tr_frag(VS, VSTR, 32 * kk + 8 * g, 32 * kk + 8 * g + 4, 16 * et, lane);
                LDS_FENCE();
#pragma unroll
                for (int et = 0; et < 7; ++et) Cst[et] = mfma16(af, vf[et], Cst[et]);
            }
#pragma unroll
            for (int et = 0; et < 7; ++et) { Cst[et] = Cst[et] * ebL;
                if (mode != 0) { v2u v; v.x = pk2(Cst[et][0], Cst[et][1]); v.y = pk2(Cst[et][2], Cst[et][3]); *(LAS v2u*)(CTn + (16 * et + c) * QSTR + 16 * w + 4 * g) = v; } }
        }
        Btot += bL;
        __syncthreads();
        if (ci + 1 < jb.nchunk) { stage_write(PK); bL = PK.bL; ebL = PK.ebL; }
        if (mode != 0) finalize(ci);
        __syncthreads();
    };
    for (int ci = 0; ci < jb.nchunk; ++ci) chunk_step(LA, ci);
    if (emit_slot >= 0 && w < 6) {
        float* sl = STd + (size_t)emit_slot * ST_FLOATS;
#pragma unroll
        for (int et = 0; et < 7; ++et) *(f32x4*)(sl + ((w * 7 + et) * 64 + lane) * 4) = Cst[et];
        if (w == 0 && lane == 0) sl[96 * 112] = Btot;
    }
    __syncthreads();
}
__device__ __forceinline__ void mlstm_load_rope(const Ctx& F, const float* rope_tab) {
    LAS f32x2* ROPE = (LAS f32x2*)(F.lds + ml::OFF_ROPE);
    for (int i = F.tid; i < 64 * 24; i += 512) ROPE[i] = ((const f32x2*)rope_tab)[i];
}
__device__ __forceinline__ void mlstm_itemA(const Ctx& F, int l, int bh, int it, bf16* otmp, float* ST) {
    const int b = bh >> 2, h = bh & 3;
    if (it == 0) {
        const MlJob jb{b, h, 1, 0, 4};
        mlstm_dir(F, l, jb, 0, -1, 0, l == 0 ? 1 : 0, otmp, ST);
        mlstm_dir(F, l, jb, 1, -1, 0, l == 0 ? 2 : 0, otmp, ST);
    } else {
        const int dir = (it - 1) / (NSEG - 1), k = (it - 1) % (NSEG - 1), seg = dir == 0 ? k : NSEG - 1 - k;
        const MlJob jb{b, h, 0, SEGTOK * seg, SEGCH};
        mlstm_dir(F, l, jb, dir, -1, 1 + k, 0, otmp, ST);
    }
}
__device__ __forceinline__ void mlstm_itemC(const Ctx& F, int l, int bh, int seg, bf16* otmp, float* ST) {
    const MlJob jb{bh >> 2, bh & 3, 0, SEGTOK * seg, SEGCH};
    mlstm_dir(F, l, jb, 0, seg, -1, 1, otmp, ST);
    mlstm_dir(F, l, jb, 1, NSEG - 1 - seg, -1, 2, otmp, ST);
}

namespace hg {
constexpr int STR = 72;
constexpr int IMG = 64 * STR * 2;
constexpr int OFF_KO = 0, OFF_KH = IMG, OFF_VS = 2 * IMG, OFF_QJ = 3 * IMG, OFF_ST = 7 * IMG, OFF_HT = 9 * IMG, OFF_TOT = OFF_HT + 64 * 68 * 4, OFF_BL = OFF_TOT + 8 * 64 * 4, OFF_END = OFF_BL + 512;
static_assert(OFF_END <= RING_BYTES, "hgrn LDS");
constexpr int ST_FLOATS = 64 * 64 + 64;
}
__device__ __forceinline__ void hgrn_dir(const Ctx& F, int l, const MlJob jb, int dir, int fold_r, int emit_slot, int mode, bf16* otmp, float* ST) {
    using namespace hg;
    int tid_ = F.tid; asm volatile("" : "+v"(tid_));
    const int tid = tid_, lane = tid & 63, w = __builtin_amdgcn_readfirstlane(tid >> 6), g = lane >> 4, c = lane & 15;
    LAS bf16* KO = (LAS bf16*)(F.lds + OFF_KO); LAS bf16* KH = (LAS bf16*)(F.lds + OFF_KH); LAS bf16* VS = (LAS bf16*)(F.lds + OFF_VS); LAS bf16* QJ = (LAS bf16*)(F.lds + OFF_QJ);
    LAS bf16* ST0 = (LAS bf16*)(F.lds + OFF_ST); LAS float* HT = (LAS float*)(F.lds + OFF_HT); LAS float* TOT = (LAS float*)(F.lds + OFF_TOT); LAS float* BL = (LAS float*)(F.lds + OFF_BL);
    const int rowbase = jb.isctx ? MX + jb.b * CTX : jb.b * S;
    const int h = jb.h; const bf16* P = F.P;
    float* STd = ST + (size_t)(((jb.b * 4 + h) * 2 + dir) * 8) * ST_FLOATS;
    const int dt = w >> 1, et0 = 2 * (w & 1);
    f32x4 Sst[2]; float Btot[4];
#pragma unroll
    for (int i = 0; i < 2; ++i) Sst[i] = (f32x4){0.f, 0.f, 0.f, 0.f};
#pragma unroll
    for (int r = 0; r < 4; ++r) Btot[r] = 0.f;
    if (fold_r >= 0) {
        f32x4 v[8][2], dk[8];
#pragma unroll
        for (int k = 0; k < NSEG; ++k) { const float* sl = STd + (size_t)k * ST_FLOATS; v[k][0] = *(const f32x4*)(sl + ((w * 2 + 0) * 64 + lane) * 4); v[k][1] = *(const f32x4*)(sl + ((w * 2 + 1) * 64 + lane) * 4);
            dk[k] = *(const f32x4*)(sl + 64 * 64 + 16 * dt + 4 * g); }
        f32x4 run = (f32x4){1.f, 1.f, 1.f, 1.f};
#pragma unroll
        for (int k = NSEG - 1; k >= 0; --k) { const float on = (k <= fold_r) ? 1.f : 0.f; Sst[0] += v[k][0] * (run * on); Sst[1] += v[k][1] * (run * on);
            if (k >= 1) { const bool use = k <= fold_r; run[0] *= use ? __expf(dk[k][0]) : 1.f; run[1] *= use ? __expf(dk[k][1]) : 1.f; run[2] *= use ? __expf(dk[k][2]) : 1.f; run[3] *= use ? __expf(dk[k][3]) : 1.f; } }
    }
    if (mode != 0) {
#pragma unroll
        for (int i = 0; i < 2; ++i) { v2u v; v.x = pk2(Sst[i][0], Sst[i][1]); v.y = pk2(Sst[i][2], Sst[i][3]); *(LAS v2u*)(ST0 + (16 * (et0 + i) + c) * STR + 16 * dt + 4 * g) = v; }
    }
    const int ps = lane, d0 = 8 * w;
    float lbv[8];
#pragma unroll
    for (int e = 0; e < 8; ++e) { lbv[e] = 0.f;
        if (l == 1) { const float v0 = F.hgrn_lb[(0 * 2 + dir) * 256 + h * 64 + d0 + e], v1 = F.hgrn_lb[(1 * 2 + dir) * 256 + h * 64 + d0 + e]; lbv[e] = 1.f / (1.f + expf(v0 - v1)); } }
    const int fcol = dir ? A_FB : A_FF;
    auto tok_of = [&](int ci, int i) -> int { return dir == 0 ? jb.t0 + 64 * ci + i : jb.t0 + 64 * (jb.nchunk - 1 - ci) + (63 - i); };
    v4u rq, rf, rv; rq = rf = rv = (v4u){0u, 0u, 0u, 0u};
    v4u ft = (v4u){0u, 0u, 0u, 0u}, fz = (v4u){0u, 0u, 0u, 0u};
    const int fi_i = tid >> 3, fi_e0 = 8 * (tid & 7);
    float gnv[8];
#pragma unroll
    for (int e = 0; e < 8; ++e) gnv[e] = (mode == 2) ? F.hgrn_gn[l * 256 + h * 64 + fi_e0 + e] : 0.f;
    auto issue_loads = [&](int ci) {
        const bf16* pr = P + (size_t)(rowbase + tok_of(ci, ps)) * PLD + h * 64 + d0;
        if (mode != 0) rq = *(const v4u*)(pr + A_Q);
        rf = *(const v4u*)(pr + fcol); rv = *(const v4u*)(pr + A_I);
    };
    auto issue_fin = [&](int ci) { const int m = rowbase + tok_of(ci, fi_i); ft = *(const v4u*)(otmp + (size_t)m * 256 + h * 64 + fi_e0); fz = *(const v4u*)(P + (size_t)m * PLD + A_Z + h * 64 + fi_e0); };
    issue_loads(0);
    __syncthreads();
    for (int ci = 0; ci < jb.nchunk; ++ci) {
        LAS bf16* STc = ST0 + (ci & 1) * 64 * STR; LAS bf16* STn = ST0 + ((ci + 1) & 1) * 64 * STR;
        {
            float qv[8], kk[8], bb[8], fl[8];
            unpack8(rf, fl);
#pragma unroll
            for (int e = 0; e < 8; ++e) { const float sg = sigmoid_f(fl[e]); const float f = lbv[e] + (1.f - lbv[e]) * sg; bb[e] = __logf(f); kk[e] = (1.f - lbv[e]) * (1.f - sg); }
            if (mode != 0) unpack8(rq, qv);
            const v4u vraw = rv;
            if (ci + 1 < jb.nchunk) issue_loads(ci + 1);
            if (mode == 2) issue_fin(ci);
            float ref1[8], ref2[8], ref3[8], bl[8];
#pragma unroll
            for (int e = 0; e < 8; ++e) { bb[e] = wave_scan_incl(bb[e]); ref1[e] = rdlane(bb[e], 15); ref2[e] = rdlane(bb[e], 31); ref3[e] = rdlane(bb[e], 47); bl[e] = rdlane(bb[e], 63); }
            const int sub = lane >> 4;
            float o8[8];
            if (mode != 0) {
#pragma unroll
                for (int e = 0; e < 8; ++e) { const float rown = sub == 0 ? 0.f : (sub == 1 ? ref1[e] : (sub == 2 ? ref2[e] : ref3[e])); o8[e] = kk[e] * __expf(rown - bb[e]); }
                *(LAS v4u*)(KO + ps * STR + d0) = pack8(o8); }
#pragma unroll
            for (int e = 0; e < 8; ++e) o8[e] = kk[e] * __expf(bl[e] - bb[e]);
            *(LAS v4u*)(KH + ps * STR + d0) = pack8(o8);
            *(LAS v4u*)(VS + ps * STR + d0) = vraw;
            if (mode != 0) {
#pragma unroll
                for (int e = 0; e < 8; ++e) o8[e] = qv[e] * __expf(bb[e]);
                *(LAS v4u*)(QJ + ps * STR + d0) = pack8(o8);
                if (sub >= 1) {
#pragma unroll
                    for (int e = 0; e < 8; ++e) o8[e] = qv[e] * __expf(bb[e] - ref1[e]);
                    *(LAS v4u*)(QJ + (64 + ps) * STR + d0) = pack8(o8); }
                if (sub >= 2) {
#pragma unroll
                    for (int e = 0; e < 8; ++e) o8[e] = qv[e] * __expf(bb[e] - ref2[e]);
                    *(LAS v4u*)(QJ + (128 + ps) * STR + d0) = pack8(o8); }
                if (sub >= 3) {
#pragma unroll
                    for (int e = 0; e < 8; ++e) o8[e] = qv[e] * __expf(bb[e] - ref3[e]);
                    *(LAS v4u*)(QJ + (192 + ps) * STR + d0) = pack8(o8); }
            }
            if (lane == 0) { *(LAS f32x4*)(BL + d0) = (f32x4){bl[0], bl[1], bl[2], bl[3]}; *(LAS f32x4*)(BL + d0 + 4) = (f32x4){bl[4], bl[5], bl[6], bl[7]}; }
        }
        __syncthreads();
        if (mode != 0) {
            const int tt = w & 3, eh = w >> 2;
            f32x4 at[4];
            { bf16x8 kf[4][2], qjf[4][2];
#pragma unroll
              for (int j = 0; j < 4; ++j) if (j <= tt) {
#pragma unroll
                  for (int ks = 0; ks < 2; ++ks) { kf[j][ks] = rm_frag(KO, STR, 16 * j + c, 32 * ks + 8 * g); qjf[j][ks] = rm_frag(QJ + j * 64 * STR, STR, 16 * tt + c, 32 * ks + 8 * g); } }
              LDS_FENCE();
#pragma unroll
              for (int j = 0; j < 4; ++j) { at[j] = (f32x4){0.f, 0.f, 0.f, 0.f};
                  if (j <= tt) {
#pragma unroll
                      for (int ks = 0; ks < 2; ++ks) at[j] = mfma16(kf[j][ks], qjf[j][ks], at[j]);
                      if (j == tt) {
#pragma unroll
                          for (int r = 0; r < 4; ++r) if (4 * g + r > c) at[j][r] = 0.f; }
                  } } }
            bf16x8 pf[2];
#pragma unroll
            for (int k2 = 0; k2 < 2; ++k2) { const unsigned u0 = pk2(at[2 * k2][0], at[2 * k2][1]), u1 = pk2(at[2 * k2][2], at[2 * k2][3]), u2 = pk2(at[2 * k2 + 1][0], at[2 * k2 + 1][1]), u3 = pk2(at[2 * k2 + 1][2], at[2 * k2 + 1][3]);
                pf[k2] = __builtin_bit_cast(bf16x8, (v4u){u0, u1, u2, u3}); }
            { bf16x8 qf[2], vf[2][2], sf[2][2];
#pragma unroll
              for (int ks = 0; ks < 2; ++ks) qf[ks] = rm_frag(QJ, STR, 16 * tt + c, 32 * ks + 8 * g);
#pragma unroll
              for (int ei = 0; ei < 2; ++ei) { const int et = 2 * eh + ei;
#pragma unroll
                  for (int k2 = 0; k2 < 2; ++k2) if (2 * k2 <= tt) vf[ei][k2] = tr_frag(VS, STR, 32 * k2 + 4 * g, 32 * k2 + 16 + 4 * g, 16 * et, lane);
#pragma unroll
                  for (int ks = 0; ks < 2; ++ks) sf[ei][ks] = rm_frag(STc, STR, 16 * et + c, 32 * ks + 8 * g); }
              LDS_FENCE();
#pragma unroll
              for (int ei = 0; ei < 2; ++ei) { const int et = 2 * eh + ei;
                  f32x4 acc = (f32x4){0.f, 0.f, 0.f, 0.f};
#pragma unroll
                  for (int k2 = 0; k2 < 2; ++k2) if (2 * k2 <= tt) acc = mfma16(vf[ei][k2], pf[k2], acc);
#pragma unroll
                  for (int ks = 0; ks < 2; ++ks) acc = mfma16(sf[ei][ks], qf[ks], acc);
                  *(LAS f32x4*)(HT + (16 * tt + c) * 68 + 16 * et + 4 * g) = acc; } }
        }
        {
            const f32x4 blv = *(const LAS f32x4*)(BL + 16 * dt + 4 * g);
#pragma unroll
            for (int r = 0; r < 4; ++r) { const float dec = __expf(blv[r]); Sst[0][r] *= dec; Sst[1][r] *= dec; Btot[r] += blv[r]; }
            { bf16x8 af[2], vf[2][2];
#pragma unroll
              for (int k2 = 0; k2 < 2; ++k2) { af[k2] = tr_frag(KH, STR, 32 * k2 + 8 * g, 32 * k2 + 8 * g + 4, 16 * dt, lane);
#pragma unroll
                  for (int i = 0; i < 2; ++i) vf[k2][i] = tr_frag(VS, STR, 32 * k2 + 8 * g, 32 * k2 + 8 * g + 4, 16 * (et0 + i), lane); }
              LDS_FENCE();
#pragma unroll
              for (int k2 = 0; k2 < 2; ++k2)
#pragma unroll
                  for (int i = 0; i < 2; ++i) Sst[i] = mfma16(af[k2], vf[k2][i], Sst[i]); }
            if (mode != 0) {
#pragma unroll
                for (int i = 0; i < 2; ++i) { v2u v; v.x = pk2(Sst[i][0], Sst[i][1]); v.y = pk2(Sst[i][2], Sst[i][3]); *(LAS v2u*)(STn + (16 * (et0 + i) + c) * STR + 16 * dt + 4 * g) = v; } }
        }
        __syncthreads();
        if (mode != 0) {
            const int i = tid >> 3, sub8 = tid & 7, e0 = 8 * sub8; const int m = rowbase + tok_of(ci, i);
            float hv[8];
            { const f32x4 a0 = *(const LAS f32x4*)(HT + i * 68 + e0), a1 = *(const LAS f32x4*)(HT + i * 68 + e0 + 4); hv[0] = a0[0]; hv[1] = a0[1]; hv[2] = a0[2]; hv[3] = a0[3]; hv[4] = a1[0]; hv[5] = a1[1]; hv[6] = a1[2]; hv[7] = a1[3]; }
            bf16* tp = otmp + (size_t)m * 256 + h * 64 + e0;
            if (mode == 1) *(v4u*)tp = pack8(hv);
            else {
                float tv[8]; unpack8(ft, tv);
                float ss = 0.f;
#pragma unroll
                for (int e = 0; e < 8; ++e) { hv[e] += tv[e]; ss += hv[e] * hv[e]; }
                ss = group8_sum(ss);
                const float rinv = __builtin_amdgcn_rsqf(ss * (1.f / 64.f) + EPS);
                float zv[8]; unpack8(fz, zv);
#pragma unroll
                for (int e = 0; e < 8; ++e) hv[e] = hv[e] * rinv * gnv[e] * zv[e];
                *(v4u*)(F.hxy + (size_t)m * 1024 + h * 64 + e0) = pack8(hv);
            }
        }
    }
    if (emit_slot >= 0) {
        float* sl = STd + (size_t)emit_slot * ST_FLOATS;
        *(f32x4*)(sl + ((w * 2 + 0) * 64 + lane) * 4) = Sst[0]; *(f32x4*)(sl + ((w * 2 + 1) * 64 + lane) * 4) = Sst[1];
        if ((w & 1) == 0 && c == 0) *(f32x4*)(sl + 64 * 64 + 16 * dt + 4 * g) = (f32x4){Btot[0], Btot[1], Btot[2], Btot[3]};
    }
    __syncthreads();
}
__device__ __forceinline__ void hgrn_itemA(const Ctx& F, int l, int bh, int it, bf16* otmp, float* ST) {
    const int b = bh >> 2, h = bh & 3;
    if (it == 0) {
        const MlJob jb{b, h, 1, 0, 4};
        hgrn_dir(F, l, jb, 0, -1, 0, l == 0 ? 1 : 0, otmp, ST);
        hgrn_dir(F, l, jb, 1, -1, 0, l == 0 ? 2 : 0, otmp, ST);
    } else {
        const int dir = (it - 1) / (NSEG - 1), k = (it - 1) % (NSEG - 1), seg = dir == 0 ? k : NSEG - 1 - k;
        const MlJob jb{b, h, 0, SEGTOK * seg, SEGCH};
        hgrn_dir(F, l, jb, dir, -1, 1 + k, 0, otmp, ST);
    }
}
__device__ __forceinline__ void hgrn_itemC(const Ctx& F, int l, int bh, int seg, bf16* otmp, float* ST) {
    const MlJob jb{bh >> 2, bh & 3, 0, SEGTOK * seg, SEGCH};
    hgrn_dir(F, l, jb, 0, seg, -1, 1, otmp, ST);
    hgrn_dir(F, l, jb, 1, NSEG - 1 - seg, -1, 2, otmp, ST);
}

namespace nat {
constexpr int STR = 72, IMG = 64 * STR * 2;
constexpr int OFF_K = 0, OFF_V = 2 * IMG, OFF_RPB = 4 * IMG, OFF_END = OFF_RPB + 2048;
static_assert(OFF_END <= RING_BYTES, "na LDS");
}
template <int CH, bool WIN>
__device__ __forceinline__ void na_block(const LAS bf16* Kc, const LAS bf16* Vc, const LAS float* RPB, const bf16x8 (&qf)[2][2], f32x4 (&oacc)[2][4], float (&mrun)[2], float (&lrun)[2],
                                         const int g, const int c, const int lane, const int dr, const int (&qcol)[2], const int (&csq)[2]) {
    constexpr int STR = nat::STR;
    constexpr int KLO[2] = {WIN ? (CH == 0 ? 0 : 1) : 0, WIN ? (CH == 0 ? 0 : 2) : 0}, KHI[2] = {WIN ? (CH == 0 ? 1 : 3) : 3, WIN ? (CH == 0 ? 2 : 3) : 3};
    constexpr int ULO = KLO[0] < KLO[1] ? KLO[0] : KLO[1], UHI = KHI[0] > KHI[1] ? KHI[0] : KHI[1];
    f32x4 st[2][4];
    { bf16x8 kf[4][2];
#pragma unroll
      for (int kt = ULO; kt <= UHI; ++kt)
#pragma unroll
          for (int ks = 0; ks < 2; ++ks) kf[kt][ks] = rm_frag(Kc, STR, 16 * kt + c, 32 * ks + 8 * g);
      LDS_FENCE();
      __builtin_amdgcn_s_setprio(1);
#pragma unroll
      for (int qt = 0; qt < 2; ++qt)
#pragma unroll
          for (int kt = 0; kt < 4; ++kt) { st[qt][kt] = (f32x4){0.f, 0.f, 0.f, 0.f};
              if (kt >= KLO[qt] && kt <= KHI[qt]) {
#pragma unroll
                  for (int ks = 0; ks < 2; ++ks) st[qt][kt] = mfma16(kf[kt][ks], qf[qt][ks], st[qt][kt]); } }
      __builtin_amdgcn_s_setprio(0); }
    if (WIN) {
#pragma unroll
        for (int qt = 0; qt < 2; ++qt) { const int boff = dr * 31 + 15 - qcol[qt];
#pragma unroll
            for (int kt = KLO[qt]; kt <= KHI[qt]; ++kt)
#pragma unroll
                for (int r = 0; r < 4; ++r) { const int kc = 16 * kt + 4 * g + r; const float bias = RPB[min(max(boff + kc, 0), 464)]; const float v = st[qt][kt][r] + bias; st[qt][kt][r] = ((unsigned)(kc - csq[qt]) < 16u) ? v : -1e30f; } }
    }
    float alpha[2]; bf16x8 pf[2][2];
#pragma unroll
    for (int qt = 0; qt < 2; ++qt) {
        float bm = -1e30f;
#pragma unroll
        for (int kt = KLO[qt]; kt <= KHI[qt]; ++kt)
#pragma unroll
            for (int r = 0; r < 4; ++r) bm = fmaxf(bm, st[qt][kt][r]);
        bm = xor32_max(xor16_max(bm));
        const float mnew = fmaxf(mrun[qt], bm); alpha[qt] = __builtin_amdgcn_exp2f(mrun[qt] - mnew); mrun[qt] = mnew;
        float ps = 0.f;
#pragma unroll
        for (int kt = KLO[qt]; kt <= KHI[qt]; ++kt)
#pragma unroll
            for (int r = 0; r < 4; ++r) { const float p = __builtin_amdgcn_exp2f(st[qt][kt][r] - mnew); st[qt][kt][r] = p; ps += p; }
        lrun[qt] = lrun[qt] * alpha[qt] + ps;
#pragma unroll
        for (int k2 = 0; k2 < 2; ++k2) { const unsigned u0 = pk2(st[qt][2 * k2][0], st[qt][2 * k2][1]), u1 = pk2(st[qt][2 * k2][2], st[qt][2 * k2][3]), u2 = pk2(st[qt][2 * k2 + 1][0], st[qt][2 * k2 + 1][1]), u3 = pk2(st[qt][2 * k2 + 1][2], st[qt][2 * k2 + 1][3]);
            pf[qt][k2] = __builtin_bit_cast(bf16x8, (v4u){u0, u1, u2, u3}); }
    }
    { bf16x8 vf[4][2];
#pragma unroll
      for (int dtl = 0; dtl < 4; ++dtl)
#pragma unroll
          for (int k2 = ULO / 2; k2 <= UHI / 2; ++k2) vf[dtl][k2] = tr_frag(Vc, STR, 32 * k2 + 4 * g, 32 * k2 + 16 + 4 * g, 16 * dtl, lane);
      LDS_FENCE();
      __builtin_amdgcn_s_setprio(1);
#pragma unroll
      for (int qt = 0; qt < 2; ++qt)
#pragma unroll
          for (int dtl = 0; dtl < 4; ++dtl) { f32x4 a = oacc[qt][dtl] * alpha[qt];
#pragma unroll
              for (int k2 = KLO[qt] / 2; k2 <= KHI[qt] / 2; ++k2) a = mfma16(vf[dtl][k2], pf[qt][k2], a);
              oacc[qt][dtl] = a; }
      __builtin_amdgcn_s_setprio(0); }
}
__device__ __forceinline__ void na_item(const Ctx& F, int l, int b, int h, int R0) {
    using namespace nat;
    int tid_ = F.tid; asm volatile("" : "+v"(tid_));
    const int tid = tid_, lane = tid & 63, w = __builtin_amdgcn_readfirstlane(tid >> 6), g = lane >> 4, c = lane & 15;
    LAS bf16* KT = (LAS bf16*)(F.lds + OFF_K); LAS bf16* VT = (LAS bf16*)(F.lds + OFF_V); LAS float* RPB = (LAS float*)(F.lds + OFF_RPB);
    const bf16* P = F.P; const bool lat = R0 >= 0;
    const int R = R0 + (w >> 1), ch = w & 1;
    const int rsR = min(max(R - 4, 0), 56);
    const int kr0 = lat ? min(max(R0 - 4, 0), 56) : 0;
    const int nwin = lat ? (min(max(R0 + 3 - 4, 0), 56) + 8 - kr0) : 0, nblk = nwin + 4;
    if (lat) for (int i = tid; i < 15 * 31; i += 512) RPB[i] = F.na_rpb[((size_t)l * 6 + h) * 465 + i] * 1.4426950408889634f;
    int mq[2]; bf16x8 qf[2][2]; int csq[2], qcol[2];
#pragma unroll
    for (int qt = 0; qt < 2; ++qt) {
        if (lat) { qcol[qt] = 32 * ch + 16 * qt + c; mq[qt] = b * S + R * 64 + qcol[qt]; } else { qcol[qt] = 0; mq[qt] = MX + b * CTX + 32 * w + 16 * qt + c; }
        csq[qt] = min(max(qcol[qt] - 8, 0), 48);
#pragma unroll
        for (int ks = 0; ks < 2; ++ks) qf[qt][ks] = *(const bf16x8*)(P + (size_t)mq[qt] * PLD + C_Q + h * 64 + 32 * ks + 8 * g);
    }
    f32x4 oacc[2][4]; float mrun[2], lrun[2];
#pragma unroll
    for (int qt = 0; qt < 2; ++qt) { mrun[qt] = -1e30f; lrun[qt] = 0.f;
#pragma unroll
        for (int dtl = 0; dtl < 4; ++dtl) oacc[qt][dtl] = (f32x4){0.f, 0.f, 0.f, 0.f}; }
    const int stok = tid >> 3, spc = tid & 7;
    auto blk_row = [&](int i) -> int { return i < nwin ? b * S + (kr0 + i) * 64 + stok : MX + b * CTX + 64 * (i - nwin) + stok; };
    v4u rk0, rv0, rk1, rv1, rk2, rv2;
    auto ld = [&](int i, v4u& k_, v4u& v_) { const int ii = i < nblk ? i : nblk - 1; const bf16* pr = P + (size_t)blk_row(ii) * PLD + h * 64 + 8 * spc; k_ = *(const v4u*)(pr + C_K); v_ = *(const v4u*)(pr + C_V); };
    ld(0, rk0, rv0); ld(1, rk1, rv1); ld(2, rk2, rv2);
    __syncthreads();
    *(LAS v4u*)(KT + stok * STR + 8 * spc) = rk0; *(LAS v4u*)(VT + stok * STR + 8 * spc) = rv0;
    ld(3, rk0, rv0);
    __syncthreads();
    auto step = [&](int i, v4u& kn, v4u& vn) {
        const LAS bf16* Kc = KT + (i & 1) * 64 * STR; const LAS bf16* Vc = VT + (i & 1) * 64 * STR;
        if (i + 1 < nblk) { LAS bf16* Kn = KT + ((i + 1) & 1) * 64 * STR; LAS bf16* Vn = VT + ((i + 1) & 1) * 64 * STR;
            *(LAS v4u*)(Kn + stok * STR + 8 * spc) = kn; *(LAS v4u*)(Vn + stok * STR + 8 * spc) = vn;
            if (i + 4 < nblk) ld(i + 4, kn, vn); }
        const bool win = i < nwin; const int kr = kr0 + i;
        const bool active = !win || (kr >= rsR && kr < rsR + 8);
        if (active) {
            if (!win) na_block<0, false>(Kc, Vc, RPB, qf, oacc, mrun, lrun, g, c, lane, 0, qcol, csq);
            else if (ch == 0) na_block<0, true>(Kc, Vc, RPB, qf, oacc, mrun, lrun, g, c, lane, kr - R + 7, qcol, csq);
            else na_block<1, true>(Kc, Vc, RPB, qf, oacc, mrun, lrun, g, c, lane, kr - R + 7, qcol, csq);
        }
        __syncthreads();
    };
    for (int i = 0; i < nblk; i += 3) { step(i, rk1, rv1); if (i + 1 < nblk) step(i + 1, rk2, rv2); if (i + 2 < nblk) step(i + 2, rk0, rv0); }
#pragma unroll
    for (int qt = 0; qt < 2; ++qt) {
        const float lt = xor32_sum(xor16_sum(lrun[qt]));
        const float rl = __builtin_amdgcn_rcpf(lt);
        const bf16* zr = P + (size_t)mq[qt] * PLD + C_Z + h * 64; bf16* yr = F.hxy + (size_t)mq[qt] * 1024 + 640 + h * 64;
#pragma unroll
        for (int dtl = 0; dtl < 4; ++dtl) { const int d = 16 * dtl + 4 * g; const v2u zv = *(const v2u*)(zr + d);
            const float z0 = __uint_as_float(zv.x << 16), z1 = __uint_as_float(zv.x & 0xffff0000u), z2 = __uint_as_float(zv.y << 16), z3 = __uint_as_float(zv.y & 0xffff0000u);
            v2u o; o.x = pk2(oacc[qt][dtl][0] * rl * z0, oacc[qt][dtl][1] * rl * z1); o.y = pk2(oacc[qt][dtl][2] * rl * z2, oacc[qt][dtl][3] * rl * z3);
            *(v2u*)(yr + d) = o; }
    }
}

__device__ __forceinline__ void phase_mixA(const Ctx& F, int l, unsigned* ticket) {
    mlstm_load_rope(F, F.rope);
    volatile LAS unsigned* slot = (volatile LAS unsigned*)(F.lds + MISC_OFF) + 16;
    const int n_ctx = 64, n_na = 768, n_loc = 2 * 32 * 2 * (NSEG - 1), n_nactx = (l == 0) ? 48 : 0, n_all = n_ctx + n_na + n_loc + n_nactx;
    unsigned cur = 0;
    if (F.tid == 0) *slot = __hip_atomic_fetch_add(ticket, 1u, __ATOMIC_RELAXED, __HIP_MEMORY_SCOPE_AGENT);
    __syncthreads();
    cur = *slot;
    while ((int)cur < n_all) {
        unsigned nxt = 0;
        if (F.tid == 0) nxt = __hip_atomic_fetch_add(ticket, 1u, __ATOMIC_RELAXED, __HIP_MEMORY_SCOPE_AGENT);
        int it = (int)cur;
        const int tkind = it < n_ctx ? 22 : (it < n_ctx + n_loc ? 21 : 20);
        if (l == 0) { TS_START(F, tkind); if (PROBE_T == 25 && blockIdx.x == 0 && F.tid == 0) TS_LDS(F)[0] += 2000; }
        if (it < n_ctx) { if (it < 32) mlstm_itemA(F, l, it, 0, F.otm, F.stm); else hgrn_itemA(F, l, it - 32, 0, F.oth, F.sth); }
        else if ((it -= n_ctx) < n_loc) { constexpr int NL = 2 * (NSEG - 1); if (it < 32 * NL) mlstm_itemA(F, l, it / NL, 1 + it % NL, F.otm, F.stm); else { it -= 32 * NL; hgrn_itemA(F, l, it / NL, 1 + it % NL, F.oth, F.sth); } }
        else if ((it -= n_loc) < n_na) na_item(F, l, it / 96, (it / 16) % 6, 4 * (it % 16));
        else { it -= n_na; na_item(F, l, it / 6, it % 6, -1); }
        if (l == 0) TS_STOP(F, tkind);
        __syncthreads();
        if (F.tid == 0) *slot = nxt;
        __syncthreads();
        cur = *slot;
    }
}
__device__ __forceinline__ void phase_mixC(const Ctx& F, int l) {
    mlstm_load_rope(F, F.rope);
    for (int it = F.vcu; it < 2 * 32 * NSEG; it += F.G) {
        if (it < 32 * NSEG) mlstm_itemC(F, l, it / NSEG, it % NSEG, F.otm, F.stm);
        else hgrn_itemC(F, l, (it - 32 * NSEG) / NSEG, it % NSEG, F.oth, F.sth);
    }
}

constexpr int NPH = 12;
struct Args { const float* in[15]; float* out; unsigned char* ws; int ph_lo, ph_hi; };
__global__ void __launch_bounds__(512, 2) mega_fwd(Args args) {
    extern __shared__ __attribute__((aligned(16))) unsigned char lds[];
    Ctx F;
    F.lds = (LAS unsigned char*)lds;
    F.tid = threadIdx.x; F.lane = F.tid & 63; F.wave = __builtin_amdgcn_readfirstlane(F.tid >> 6);
    F.G = gridDim.x; { const int bx = blockIdx.x; F.vcu = (F.G % 8 == 0) ? (bx % 8) * (F.G / 8) + bx / 8 : bx; }
    F.gw = F.vcu * 8 + F.wave; F.NGW = F.G * 8;
    unsigned char* ws = args.ws;
    F.x = args.in[0]; F.c = args.in[1]; F.ctx = args.in[2]; F.c_ctx = args.in[3]; F.w_mod = args.in[4]; F.b_mod = args.in[5]; F.g_pre = args.in[6]; F.g_post = args.in[7];
    F.w_in = args.in[8]; F.w_out = args.in[9]; F.hgrn_lb = args.in[10]; F.hgrn_gn = args.in[11]; F.gate_b = args.in[12]; F.mlstm_gn = args.in[13]; F.na_rpb = args.in[14];
    F.out = args.out;
    F.wt_in = (bf16*)(ws + WS_WT_IN); F.wt_out = (bf16*)(ws + WS_WT_OUT); F.mod = (float*)(ws + WS_MOD); F.gates = (float*)(ws + WS_GATES); F.ctx1 = (float*)(ws + WS_CTX1);
    F.hxy = (bf16*)(ws + WS_HXY); F.P = (bf16*)(ws + WS_P); F.UX = (bf16*)(ws + WS_P); F.oth = (bf16*)(ws + WS_OH); F.sth = (float*)(ws + WS_STH); F.otm = (bf16*)(ws + WS_OM); F.stm = (float*)(ws + WS_STM); F.rope = (float*)(ws + WS_ROPE);
    for (int u = F.tid; u < (LDS_BYTES - LDSCTL_OFF) / 4; u += 512) ((LAS unsigned*)(F.lds + LDSCTL_OFF))[u] = 0u;
    __syncthreads();
    XcdBarrier bar = xcd_barrier_post((unsigned*)(ws + WS_CTL) + CW_BAR, (volatile LAS unsigned*)(F.lds + MISC_OFF) + 8);

    const int lo = args.ph_lo, hi = args.ph_hi;
#ifndef DUP_PHASE
#define DUP_PHASE -1
#endif
#define IN(k) (lo <= (k) && (k) < hi)
#define SEAM(k) do { if ((k) + 1 < hi) xcd_barrier(bar); } while (0)
#define PHASE(k, ...) if (IN(k)) { TS_START(F, 100 + (k)); __VA_ARGS__; if ((k) == DUP_PHASE) { xcd_barrier(bar); __VA_ARGS__; } SEAM(k); TS_STOP(F, 100 + (k)); }
    PHASE(0, phase_p0(F))
    PHASE(1, { phase_prenorm0(F); phase_p1_transposes(F); })
#define LAYER(l) \
    PHASE(2 + 5 * (l), { \
        pg8::Gemm g{F.hxy, F.wt_in + (size_t)(l) * NPAD * 1024, M, NPAD, 1024}; \
        pg8::EpiIn E{F.P, F.gates, F.gate_b + (l) * 16}; \
        pg8::StaticOrder SO; SO.init(M, NPAD, F.G, (int)blockIdx.x); pg8::gemm_phase<pg8::EpiIn, pg8::StaticOrder, true, true>(F.lds + RING_OFF, g, SO, E); }) \
    PHASE(3 + 5 * (l), phase_mixA(F, (l), (unsigned*)(args.ws + WS_CTL) + 8192 + 64 * (l))) \
    PHASE(4 + 5 * (l), phase_mixC(F, (l))) \
    PHASE(5 + 5 * (l), { \
        constexpr int Ml = (l) == 0 ? M : MX; \
        pg8::Gemm g{F.hxy, F.wt_out + (size_t)(l) * 1024 * 1024, Ml, 1024, 1024}; pg8::StaticOrder SO; SO.init(Ml, 1024, F.G, (int)blockIdx.x); \
        pg8::EpiOut E{F.UX}; \
        pg8::gemm_phase<pg8::EpiOut, pg8::StaticOrder, true, true>(F.lds + RING_OFF, g, SO, E); }) \
    PHASE(6 + 5 * (l), phase_post(F, (l)))
    LAYER(0)
    LAYER(1)
#undef LAYER
#undef PHASE
#undef IN
#undef SEAM
    if (PROBE_T != 0 && blockIdx.x == 0 && F.tid == 0) { const unsigned long long t0 = __builtin_amdgcn_s_memtime(), dt = 8ull * TS_LDS(F)[0]; while (__builtin_amdgcn_s_memtime() - t0 < dt) __builtin_amdgcn_s_sleep(8); }
}

extern "C" void kernel_launch(void* const* d_in, const int* in_sizes, int n_in, void* d_out, int out_size, void* d_ws, size_t ws_size, hipStream_t stream) {
    static int grid = 0;
    if (grid == 0) {
        if (n_in != 15 || ws_size < WS_END) { fprintf(stderr, "kernel_launch: unexpected n_in %d / ws_size %zu (need %zu); nothing launched\n", n_in, ws_size, (size_t)WS_END); grid = -1; return; }
        int dev = 0, cus = 0, per_cu = 0;
        if (hipGetDevice(&dev) != hipSuccess || hipDeviceGetAttribute(&cus, hipDeviceAttributeMultiprocessorCount, dev) != hipSuccess) { grid = -1; return; }
        if (hipFuncSetAttribute((const void*)mega_fwd, hipFuncAttributeMaxDynamicSharedMemorySize, LDS_BYTES) != hipSuccess) { fprintf(stderr, "kernel_launch: hipFuncSetAttribute failed\n"); grid = -1; return; }
        if (hipOccupancyMaxActiveBlocksPerMultiprocessor(&per_cu, (const void*)mega_fwd, 512, LDS_BYTES) != hipSuccess || per_cu < 1) { fprintf(stderr, "kernel_launch: occupancy query says %d blocks/CU\n", per_cu); (void)hipGetLastError(); grid = -1; return; }
        grid = cus;
    }
    if (grid < 0) return;
    (void)hipMemsetAsync((char*)d_ws + WS_CTL, 0, CTL_BYTES, stream);
    Args a{};
    for (int i = 0; i < 15; ++i) a.in[i] = (const float*)d_in[i];
    a.out = (float*)d_out; a.ws = (unsigned char*)d_ws; a.ph_lo = 0; a.ph_hi = NPH;
    hipLaunchKernelGGL(mega_fwd, dim3(grid), dim3(512), LDS_BYTES, stream, a);
}
```

```cpp
#include <hip/hip_runtime.h>
#include <stdint.h>
#include <cstdio>

namespace cfg {
constexpr int D = 1024, NB = 8, S = 4096, CTX = 256;
constexpr int MX = NB * S, MC = NB * CTX, M = MX + MC;
constexpr int PIN = 4752, NPAD = 4864, PLD = 4736;
constexpr int A_Q = 0, A_FF = 256, A_FB = 512, A_I = 768, A_Z = 1024, B_Q = 1280, B_K = 1664, B_V = 2048, B_O = 2432, B_Z = 2816,
              C_Q = 3200, C_K = 3584, C_V = 3968, C_Z = 4352;
constexpr float EPS = 1e-6f;
constexpr size_t WS_CTL = 0, CTL_BYTES = 65536;
constexpr size_t WS_WT_IN = WS_CTL + CTL_BYTES;
constexpr size_t WS_WT_OUT = WS_WT_IN + 2ull * NPAD * 1024 * 2;
constexpr size_t WS_MOD = WS_WT_OUT + 2ull * 1024 * 1024 * 2;
constexpr size_t WS_GATES = WS_MOD + 2ull * 9 * 3072 * 4;
constexpr size_t WS_CTX1 = WS_GATES + (size_t)M * 16 * 4;
constexpr size_t WS_HXY = WS_CTX1 + (size_t)MC * 1024 * 4;
constexpr size_t WS_P = WS_HXY + (size_t)M * 1024 * 2;
constexpr size_t WS_OH = WS_P + (size_t)M * PLD * 2;
constexpr size_t WS_OM = WS_OH + (size_t)M * 256 * 4;
constexpr size_t WS_STM = WS_OM + (size_t)M * 384 * 2;
constexpr size_t WS_ROPE = WS_STM + 32ull * 2 * 8 * (96 * 112 + 16) * 4;
constexpr size_t WS_STH = WS_ROPE + 64 * 24 * 8;
constexpr size_t WS_END = WS_STH + 32ull * 2 * 8 * (64 * 64 + 64) * 4;
static_assert(WS_END <= 536870912ull, "workspace");
static_assert(WS_WT_IN % 256 == 0 && WS_MOD % 256 == 0 && WS_GATES % 256 == 0 && WS_CTX1 % 256 == 0 && WS_HXY % 256 == 0 && WS_P % 256 == 0 && WS_OH % 256 == 0 && WS_OM % 256 == 0 && WS_STM % 256 == 0 && WS_ROPE % 256 == 0 && WS_STH % 256 == 0, "align");
}
using namespace cfg;

namespace pg8 {
#define PG8_LAS __attribute__((address_space(3)))
typedef unsigned short bf16_t;
typedef short bf16x8 __attribute__((ext_vector_type(8)));
typedef float f32x4 __attribute__((ext_vector_type(4)));
typedef unsigned u32x4 __attribute__((ext_vector_type(4)));
constexpr int BM = 256, BK = 64, HALF = 128, HTB = HALF * BK * 2  , STAGE_BYTES = 8 * HTB, NXCD = 8, WGM = 8;

__host__ __device__ __forceinline__ int lds_byte(int r, int c) { const int st = (r >> 4) * 2 + (c >> 5), rr = r & 15, cc = c & 31, ob = rr * 64 + cc * 2; return st * 1024 + (ob ^ (((ob >> 9) & 1) << 5)); }
__host__ __device__ __forceinline__ void stage_rc(int b, int& R, int& C) { const int st = b / 1024, sb = b % 1024, swz = sb ^ (((sb >> 9) & 1) << 5); R = (st >> 1) * 16 + swz / 64; C = (st & 1) * 32 + (swz % 64) / 2; }
__host__ __device__ __forceinline__ int perm32(int rho) { const int n = rho >> 4, i = rho & 15; return 8 * (i >> 2) + 4 * n + (i & 3); }

struct Unit { int pm, pn; };
struct Gemm { const bf16_t* A; const bf16_t* Bt; int M, N, K; };

struct StaticOrder {
    int nM, nN, nwg, G, c;
    __host__ __device__ void init(int M, int N, int G_, int c_) { nM = M / BM; nN = N / BM; nwg = nM * nN; G = G_; c = c_; }
    __host__ __device__ bool next(int i, Unit& u) const {
        const long L = (long)i * G + c; if (L >= nwg) return false;
        int wgid = (int)L; { const int q = nwg / NXCD, r = nwg % NXCD, xcd = wgid % NXCD, off = wgid / NXCD; wgid = (xcd < r ? xcd * (q + 1) : r * (q + 1) + (xcd - r) * q) + off; }
        const int nig = WGM * nN, gid = wgid / nig, fm = gid * WGM, gsz = (nM - fm) < WGM ? (nM - fm) : WGM;
        u.pm = fm + ((wgid % nig) % gsz); u.pn = (wgid % nig) / gsz; return true;
    }
    __device__ __forceinline__ void a_ready(const Unit&) const {}
    __device__ __forceinline__ void done(const Unit&) const {}
};

struct SkipOrder {
    int G, c;
    __host__ __device__ void init(int G_, int c_) { G = G_; c = c_; }
    __host__ __device__ bool next(int i, Unit& u) const {
        constexpr int NLAT = 128 * 19, NNEED = NLAT + 88, nN = 19, nM = 136;
        const long L = (long)i * G + c; if (L >= NNEED) return false;
        int n = (int)L; { const int q = NNEED / NXCD, r = NNEED % NXCD, xcd = n % NXCD, off = n / NXCD; n = (xcd < r ? xcd * (q + 1) : r * (q + 1) + (xcd - r) * q) + off; }
        int wg = n;
        if (n >= NLAT) { const int j = n - NLAT, jj = j >> 3; const int pn = jj < 3 ? 1 + jj : jj < 7 ? 3 + jj : jj < 10 ? 7 + jj : 18;
            wg = NLAT + 8 * pn + (j & 7); }
        const int nig = WGM * nN, gid = wg / nig, fm = gid * WGM, gsz = (nM - fm) < WGM ? (nM - fm) : WGM;
        u.pm = fm + ((wg % nig) % gsz); u.pn = (wg % nig) / gsz; return true;
    }
    __device__ __forceinline__ void a_ready(const Unit&) const {}
    __device__ __forceinline__ void done(const Unit&) const {}
};
struct DeferOrder {
    int G, c;
    static constexpr int NDEF = 32;
    __host__ __device__ void init(int G_, int c_) { G = G_; c = c_; }
    __host__ __device__ bool next(int i, Unit& u) const {
        constexpr int nN = 19, nM = 136, nig = WGM * nN, NKEEP = nM * nN - NDEF, NG = NDEF / WGM;
        const long L = (long)i * G + c; if (L >= NKEEP) return false;
        int n = (int)L; { const int q = NKEEP / NXCD, r = NKEEP % NXCD, xcd = n % NXCD, off = n / NXCD; n = (xcd < r ? xcd * (q + 1) : r * (q + 1) + (xcd - r) * q) + off; }
        const int wg = n < NG * (nig - WGM) ? (n / (nig - WGM)) * nig + WGM + n % (nig - WGM) : n + NDEF;
        const int gid = wg / nig, fm = gid * WGM, gsz = (nM - fm) < WGM ? (nM - fm) : WGM;
        u.pm = fm + ((wg % nig) % gsz); u.pn = (wg % nig) / gsz; return true;
    }
    __device__ __forceinline__ void a_ready(const Unit&) const {}
    __device__ __forceinline__ void done(const Unit&) const {}
};
struct OneUnit {
    int pm, pn;
    __host__ __device__ bool next(int i, Unit& u) const { if (i != 0) return false; u.pm = pm; u.pn = pn; return true; }
    __device__ __forceinline__ void a_ready(const Unit&) const {}
    __device__ __forceinline__ void done(const Unit&) const {}
};

__device__ __forceinline__ unsigned cvt_pk_bf16(float lo, float hi) { unsigned r; asm volatile("v_cvt_pk_bf16_f32 %0, %1, %2" : "=v"(r) : "v"(lo), "v"(hi)); return r; }
__device__ __forceinline__ float logsigmoid_e(float v) { return fminf(v, 0.f) - 0.6931471805599453f * __builtin_amdgcn_logf(1.f + __expf(-fabsf(v))); }

struct EpiIn {
    static constexpr bool PERM = true, AFTER_DRAIN = false;
    bf16_t* P; float* gates; const float* gate_b;
    __device__ __forceinline__ void operator()(const f32x4 (&acc)[2][2][4][2], const Unit& u, int wr, int wc, int fr, int fq) const {
        const int row0 = u.pm * BM + wr * 64 + fr, col0 = u.pn * BM + wc * 32 + 8 * fq;
#pragma unroll
        for (int bj = 0; bj < 2; ++bj) {
            const int col = col0 + bj * HALF;
            if (col < cfg::PLD) {
                const int act = col < 256 ? 1 : col < 1024 ? 0 : col < 1280 ? 2 : col < 1664 ? 3 : col < 2432 ? 0 : col < 2816 ? 4 : col < 3200 ? 2 : col < 3584 ? 5 : 0;
#pragma unroll
                for (int ai = 0; ai < 2; ++ai)
#pragma unroll
                    for (int m = 0; m < 4; ++m) { f32x4 v0 = acc[ai][bj][m][0], v1 = acc[ai][bj][m][1];
                        if (act == 1 || act == 2 || act == 4) { const float sc = act == 1 ? 0.125f : 1.f;
#pragma unroll
                            for (int e = 0; e < 4; ++e) { const float s0 = __builtin_amdgcn_rcpf(1.f + __expf(-v0[e])), s1 = __builtin_amdgcn_rcpf(1.f + __expf(-v1[e])); v0[e] = act == 4 ? s0 : v0[e] * s0 * sc; v1[e] = act == 4 ? s1 : v1[e] * s1 * sc; } }
                        else if (act == 3) { v0 = v0 * 0.10206207261596575f; v1 = v1 * 0.10206207261596575f; }
                        else if (act == 5) { v0 = v0 * (0.125f * 1.4426950408889634f); v1 = v1 * (0.125f * 1.4426950408889634f); }
                        u32x4 w; w.x = cvt_pk_bf16(v0[0], v0[1]); w.y = cvt_pk_bf16(v0[2], v0[3]); w.z = cvt_pk_bf16(v1[0], v1[1]); w.w = cvt_pk_bf16(v1[2], v1[3]);
                        *(u32x4*)(P + (size_t)(row0 + ai * HALF + m * 16) * cfg::PLD + col) = w; }
            } else if (col < cfg::PIN) {
                const int g0 = col - cfg::PLD;
                const f32x4 b0 = *(const f32x4*)(gate_b + g0), b1 = *(const f32x4*)(gate_b + g0 + 4);
#pragma unroll
                for (int ai = 0; ai < 2; ++ai)
#pragma unroll
                    for (int m = 0; m < 4; ++m) { f32x4 v0 = acc[ai][bj][m][0] + b0, v1 = acc[ai][bj][m][1] + b1;
                        if (g0 >= 8) {
#pragma unroll
                            for (int e = 0; e < 4; ++e) { v0[e] = logsigmoid_e(v0[e]); v1[e] = logsigmoid_e(v1[e]); } }
                        float* gp = gates + (size_t)(row0 + ai * HALF + m * 16) * 16 + g0;
                        *(f32x4*)gp = v0; *(f32x4*)(gp + 4) = v1; }
            }
        }
    }
};
struct EpiOut {
    static constexpr bool PERM = true, AFTER_DRAIN = false;
    bf16_t* C;
    __device__ __forceinline__ void operator()(const f32x4 (&acc)[2][2][4][2], const Unit& u, int wr, int wc, int fr, int fq) const {
        const int row0 = u.pm * BM + wr * 64 + fr, col0 = u.pn * BM + wc * 32 + 8 * fq;
#pragma unroll
        for (int ai = 0; ai < 2; ++ai)
#pragma unroll
            for (int m = 0; m < 4; ++m) { bf16_t* rowp = C + (size_t)(row0 + ai * HALF + m * 16) * 1024 + col0;
#pragma unroll
                for (int bj = 0; bj < 2; ++bj) { const f32x4 v0 = acc[ai][bj][m][0], v1 = acc[ai][bj][m][1];
                    u32x4 w; w.x = cvt_pk_bf16(v0[0], v0[1]); w.y = cvt_pk_bf16(v0[2], v0[3]); w.z = cvt_pk_bf16(v1[0], v1[1]); w.w = cvt_pk_bf16(v1[2], v1[3]);
                    *(u32x4*)(rowp + bj * HALF) = w; } }
    }
};

struct EpiOutWT {
    static constexpr bool PERM = true, AFTER_DRAIN = false;
    bf16_t* C;
    __device__ __forceinline__ void operator()(const f32x4 (&acc)[2][2][4][2], const Unit& u, int wr, int wc, int fr, int fq) const {
        const int row0 = u.pm * BM + wr * 64 + fr, col0 = u.pn * BM + wc * 32 + 8 * fq;
#pragma unroll
        for (int ai = 0; ai < 2; ++ai)
#pragma unroll
            for (int m = 0; m < 4; ++m) { bf16_t* rowp = C + (size_t)(row0 + ai * HALF + m * 16) * 1024 + col0;
#pragma unroll
                for (int bj = 0; bj < 2; ++bj) { const f32x4 v0 = acc[ai][bj][m][0], v1 = acc[ai][bj][m][1];
                    u32x4 w; w.x = cvt_pk_bf16(v0[0], v0[1]); w.y = cvt_pk_bf16(v0[2], v0[3]); w.z = cvt_pk_bf16(v1[0], v1[1]); w.w = cvt_pk_bf16(v1[2], v1[3]);
                    asm volatile("global_store_dwordx4 %0, %1, off sc0 sc1" :: "v"(rowp + bj * HALF), "v"(w) : "memory"); } }
    }
};

template <class Epi, class Sched, bool ALIGN_EPI = false, bool SP2 = false>
__device__ __forceinline__ void gemm_phase(PG8_LAS unsigned char* lds, const Gemm g, const Sched& S, const Epi& E) {
    const int tid = threadIdx.x, wid = __builtin_amdgcn_readfirstlane(tid >> 6), lane = tid & 63, wr = wid >> 2, wc = wid & 3, fr = lane & 15, fq = lane >> 4;
    const int K = g.K, nt = K / BK;
    unsigned voffA[2], voffB[2];
#pragma unroll
    for (int i = 0; i < 2; ++i) { int R, C; stage_rc(tid * 16 + i * 8192, R, C); const int Rb = Epi::PERM ? ((R & ~31) + perm32(R & 31)) : R;
        voffA[i] = (unsigned)(R * K + C) * 2u; voffB[i] = (unsigned)(Rb * K + C) * 2u; }
    const size_t kstep = (size_t)(BK * 2);
    const size_t hstep = (size_t)HALF * K * 2;
    const size_t tstep = 2 * hstep;
    const unsigned ldsw = (unsigned)wid * 1024u;
    const int aoff = lds_byte(wr * 64 + fr, fq * 8), boff = lds_byte(wc * 32 + fr, fq * 8);
#define PG8_SA(b, h) (((b) * 2 + (h)) * HTB)
#define PG8_SB(b, h) ((4 + (b) * 2 + (h)) * HTB)
#define PG8_STAGE(bufoff, gbase, voff) do { _Pragma("unroll") for (int _i = 0; _i < 2; ++_i) \
        __builtin_amdgcn_global_load_lds((const unsigned*)((const char*)(gbase) + (voff)[_i]), (PG8_LAS unsigned*)(lds + (bufoff) + ldsw + _i * 8192), 16, 0, 0); } while (0)
#define PG8_LDA(dst, b, h) do { _Pragma("unroll") for (int m = 0; m < 4; ++m) _Pragma("unroll") for (int k = 0; k < 2; ++k) dst[m][k] = *(const PG8_LAS bf16x8*)(lds + PG8_SA(b, h) + aoff + m * 2048 + k * 1024); } while (0)
#define PG8_LDB(dst, b, h) do { _Pragma("unroll") for (int n = 0; n < 2; ++n) _Pragma("unroll") for (int k = 0; k < 2; ++k) dst[n][k] = *(const PG8_LAS bf16x8*)(lds + PG8_SB(b, h) + boff + n * 2048 + k * 1024); } while (0)
#define PG8_MMA(ai, bj, At, Bt) do { __builtin_amdgcn_s_setprio(1); _Pragma("unroll") for (int m = 0; m < 4; ++m) _Pragma("unroll") for (int n = 0; n < 2; ++n) _Pragma("unroll") for (int k = 0; k < 2; ++k) \
        acc[ai][bj][m][n] = __builtin_amdgcn_mfma_f32_16x16x32_bf16(Bt[n][k], At[m][k], acc[ai][bj][m][n], 0, 0, 0); __builtin_amdgcn_s_setprio(0); } while (0)
#define PG8_WAIT_V(n) asm volatile("s_waitcnt vmcnt(" #n ")" ::: "memory")
#define PG8_WAIT_L(n) asm volatile("s_waitcnt lgkmcnt(" #n ")" ::: "memory")
#define PG8_BAR __builtin_amdgcn_s_barrier()
#define PG8_SCHED __builtin_amdgcn_sched_barrier(0)
    Unit cur, nxt; int ui = 0;
    if (!S.next(0, cur)) return;
    f32x4 acc[2][2][4][2];
#pragma unroll
    for (int a = 0; a < 2; ++a)
#pragma unroll
        for (int b = 0; b < 2; ++b)
#pragma unroll
            for (int m = 0; m < 4; ++m)
#pragma unroll
                for (int n = 0; n < 2; ++n) acc[a][b][m][n] = (f32x4){0.f, 0.f, 0.f, 0.f};
    bf16x8 At[4][2], B0[2][2], B1[2][2];
    const char* cA = (const char*)g.A + (size_t)cur.pm * tstep; const char* cB = (const char*)g.Bt + (size_t)cur.pn * tstep;
    S.a_ready(cur);
    if constexpr (SP2) {
        PG8_STAGE(PG8_SB(0, 0), cB, voffB); PG8_STAGE(PG8_SB(0, 1), cB + hstep, voffB); PG8_STAGE(PG8_SA(0, 0), cA, voffA); PG8_STAGE(PG8_SA(0, 1), cA + hstep, voffA);
        if (wr == 1) PG8_BAR;
        PG8_WAIT_V(2); PG8_BAR;
        PG8_STAGE(PG8_SB(1, 0), cB + kstep, voffB); PG8_STAGE(PG8_SA(1, 0), cA + kstep, voffA); PG8_STAGE(PG8_SB(1, 1), cB + hstep + kstep, voffB);
        PG8_WAIT_V(6); PG8_BAR;
    } else {
        PG8_STAGE(PG8_SB(0, 0), cB, voffB); PG8_STAGE(PG8_SA(0, 0), cA, voffA); PG8_STAGE(PG8_SB(0, 1), cB + hstep, voffB); PG8_STAGE(PG8_SA(0, 1), cA + hstep, voffA);
        if (wr == 1) PG8_BAR;
        PG8_WAIT_V(4); PG8_BAR;
        PG8_STAGE(PG8_SB(1, 0), cB + kstep, voffB); PG8_STAGE(PG8_SA(1, 0), cA + kstep, voffA); PG8_STAGE(PG8_SB(1, 1), cB + hstep + kstep, voffB);
        PG8_WAIT_V(6); PG8_BAR;
    }
    for (;;) {
        const bool has_next = S.next(ui + 1, nxt);
        const char* nA = has_next ? (const char*)g.A + (size_t)nxt.pm * tstep : cA; const char* nB = has_next ? (const char*)g.Bt + (size_t)nxt.pn * tstep : cB;
        for (int t = 0; t < nt; t += 2) {
            const bool last = (t == nt - 2);
            const char* a1 = cA + (size_t)(t + 1) * kstep;
            const char* a2 = last ? nA : cA + (size_t)(t + 2) * kstep; const char* b2 = last ? nB : cB + (size_t)(t + 2) * kstep;
            const char* a3 = a2 + kstep; const char* b3 = b2 + kstep;
            if (last && has_next) S.a_ready(nxt);
            if constexpr (SP2) {
            PG8_LDB(B0, 0, 0); PG8_LDB(B1, 0, 1); PG8_SCHED; PG8_LDA(At, 0, 0); PG8_STAGE(PG8_SA(1, 1), a1 + hstep, voffA);
            PG8_WAIT_V(8); PG8_WAIT_L(0); PG8_BAR; PG8_MMA(0, 0, At, B0); PG8_MMA(0, 1, At, B1); PG8_BAR; PG8_SCHED;
            PG8_LDA(At, 0, 1); PG8_STAGE(PG8_SB(0, 0), b2, voffB); PG8_STAGE(PG8_SB(0, 1), b2 + hstep, voffB); PG8_STAGE(PG8_SA(0, 0), a2, voffA);
            PG8_WAIT_V(8); PG8_WAIT_L(0); PG8_BAR; PG8_MMA(1, 0, At, B0); PG8_MMA(1, 1, At, B1); PG8_BAR; PG8_SCHED;
            PG8_LDB(B0, 1, 0); PG8_LDB(B1, 1, 1); PG8_SCHED; PG8_LDA(At, 1, 0); PG8_STAGE(PG8_SA(0, 1), a2 + hstep, voffA);
            PG8_WAIT_V(8); PG8_WAIT_L(0); PG8_BAR; PG8_MMA(0, 0, At, B0); PG8_MMA(0, 1, At, B1); PG8_BAR; PG8_SCHED;
            PG8_LDA(At, 1, 1); PG8_STAGE(PG8_SB(1, 0), b3, voffB); PG8_STAGE(PG8_SB(1, 1), b3 + hstep, voffB); PG8_STAGE(PG8_SA(1, 0), a3, voffA);
            PG8_WAIT_V(8); PG8_WAIT_L(0); PG8_BAR; PG8_MMA(1, 0, At, B0); PG8_MMA(1, 1, At, B1); PG8_BAR; PG8_SCHED;
            } else {
            PG8_LDB(B0, 0, 0); PG8_SCHED; PG8_LDA(At, 0, 0); PG8_STAGE(PG8_SA(1, 1), a1 + hstep, voffA);
            PG8_WAIT_L(8); PG8_BAR; PG8_WAIT_L(0); PG8_MMA(0, 0, At, B0); PG8_BAR; PG8_SCHED;
            PG8_LDB(B1, 0, 1); PG8_STAGE(PG8_SB(0, 0), b2, voffB);
            PG8_BAR; PG8_WAIT_L(0); PG8_MMA(0, 1, At, B1); PG8_BAR;
            PG8_LDA(At, 0, 1); PG8_STAGE(PG8_SA(0, 0), a2, voffA);
            PG8_BAR; PG8_WAIT_L(0); PG8_MMA(1, 0, At, B0); PG8_BAR; PG8_SCHED;
            PG8_STAGE(PG8_SB(0, 1), b2 + hstep, voffB);
            PG8_WAIT_V(6); PG8_BAR; PG8_MMA(1, 1, At, B1); PG8_BAR;
            PG8_LDB(B0, 1, 0); PG8_SCHED; PG8_LDA(At, 1, 0); PG8_STAGE(PG8_SA(0, 1), a2 + hstep, voffA);
            PG8_WAIT_L(8); PG8_BAR; PG8_WAIT_L(0); PG8_MMA(0, 0, At, B0); PG8_BAR; PG8_SCHED;
            PG8_LDB(B1, 1, 1); PG8_STAGE(PG8_SB(1, 0), b3, voffB);
            PG8_BAR; PG8_WAIT_L(0); PG8_MMA(0, 1, At, B1); PG8_BAR;
            PG8_LDA(At, 1, 1); PG8_STAGE(PG8_SA(1, 0), a3, voffA);
            PG8_BAR; PG8_WAIT_L(0); PG8_MMA(1, 0, At, B0); PG8_BAR; PG8_SCHED;
            PG8_STAGE(PG8_SB(1, 1), b3 + hstep, voffB);
            PG8_WAIT_V(6); PG8_BAR; PG8_MMA(1, 1, At, B1); PG8_BAR;
            }
        }
        if constexpr (ALIGN_EPI) { if (wr == 0) PG8_BAR; }
        if constexpr (!Epi::AFTER_DRAIN) { E(acc, cur, wr, wc, fr, fq); S.done(cur); }
        if (!has_next) break;
#pragma unroll
        for (int a = 0; a < 2; ++a)
#pragma unroll
            for (int b = 0; b < 2; ++b)
#pragma unroll
                for (int m = 0; m < 4; ++m)
#pragma unroll
                    for (int n = 0; n < 2; ++n) acc[a][b][m][n] = (f32x4){0.f, 0.f, 0.f, 0.f};
        cur = nxt; cA = nA; cB = nB; ++ui;
        if constexpr (ALIGN_EPI) { if (wr == 1) PG8_BAR; }
    }
    PG8_WAIT_V(0);
    if constexpr (!ALIGN_EPI) { if (wr == 0) PG8_BAR; }
    PG8_BAR;
    if constexpr (Epi::AFTER_DRAIN) { E.fused(acc, cur, wr, wc, fr, fq, lds, wid, lane); S.done(cur); }
#undef PG8_SA
#undef PG8_SB
#undef PG8_STAGE
#undef PG8_LDA
#undef PG8_LDB
#undef PG8_MMA
#undef PG8_WAIT_V
#undef PG8_WAIT_L
#undef PG8_BAR
#undef PG8_SCHED
}
}
constexpr int RING_OFF = 0, RING_BYTES = 131072;
constexpr int LDSCTL_OFF = RING_BYTES, MISC_OFF = LDSCTL_OFF + 320;
constexpr int LDS_BYTES = 147456;
constexpr int CW_BAR = 4096;

#define GAS __attribute__((address_space(1)))
#define LAS __attribute__((address_space(3)))
typedef unsigned short bf16;
typedef unsigned v4u __attribute__((ext_vector_type(4)));
typedef float f32x4 __attribute__((ext_vector_type(4)));
typedef short bf16x8 __attribute__((ext_vector_type(8)));
typedef GAS unsigned gu32;
#define RLX_AGENT __ATOMIC_RELAXED, __HIP_MEMORY_SCOPE_AGENT
#define LDS_WAIT() asm volatile("s_waitcnt lgkmcnt(0)" ::: "memory")
#define VM_WAIT() asm volatile("s_waitcnt vmcnt(0)" ::: "memory")
__device__ __forceinline__ unsigned f2bfu(float f) { unsigned u = __builtin_bit_cast(unsigned, f); return (u + 0x7fffu + ((u >> 16) & 1u)) >> 16; }
__device__ __forceinline__ bf16 f2bf(float f) { return (bf16)f2bfu(f); }
typedef float f32x2_t __attribute__((ext_vector_type(2))); typedef __bf16 bf16x2_t __attribute__((ext_vector_type(2)));
__device__ __forceinline__ unsigned pk2(float lo, float hi) { f32x2_t v = {lo, hi}; bf16x2_t b = __builtin_convertvector(v, bf16x2_t); return __builtin_bit_cast(unsigned, b); }
__device__ __forceinline__ float xor16_max(float v) { auto r = __builtin_amdgcn_permlane16_swap(__float_as_uint(v), __float_as_uint(v), false, false); return fmaxf(__uint_as_float(r[0]), __uint_as_float(r[1])); }
__device__ __forceinline__ float xor32_max(float v) { auto r = __builtin_amdgcn_permlane32_swap(__float_as_uint(v), __float_as_uint(v), false, false); return fmaxf(__uint_as_float(r[0]), __uint_as_float(r[1])); }
__device__ __forceinline__ float xor16_sum(float v) { auto r = __builtin_amdgcn_permlane16_swap(__float_as_uint(v), __float_as_uint(v), false, false); return __uint_as_float(r[0]) + __uint_as_float(r[1]); }
__device__ __forceinline__ float xor32_sum(float v) { auto r = __builtin_amdgcn_permlane32_swap(__float_as_uint(v), __float_as_uint(v), false, false); return __uint_as_float(r[0]) + __uint_as_float(r[1]); }
__device__ __forceinline__ float bf2f(bf16 v) { return __uint_as_float(((unsigned)v) << 16); }
__device__ __forceinline__ float silu_f(float v) { return v * __builtin_amdgcn_rcpf(1.f + __expf(-v)); }
__device__ __forceinline__ float sigmoid_f(float v) { return __builtin_amdgcn_rcpf(1.f + __expf(-v)); }
#define DPP_ADD_(v, ctrl) ((v) + __int_as_float(__builtin_amdgcn_update_dpp(0, __float_as_int(v), (ctrl), 0xF, 0xF, false)))
__device__ __forceinline__ float group8_sum(float v) {
    v = DPP_ADD_(v, 0xB1); v = DPP_ADD_(v, 0x4E); v = DPP_ADD_(v, 0x141); return v; }
__device__ __forceinline__ float wave_sum(float v) {
    v = group8_sum(v); v = DPP_ADD_(v, 0x140);
    { auto r = __builtin_amdgcn_permlane16_swap(__float_as_uint(v), __float_as_uint(v), false, false); v = __uint_as_float(r[0]) + __uint_as_float(r[1]); }
    { auto r = __builtin_amdgcn_permlane32_swap(__float_as_uint(v), __float_as_uint(v), false, false); v = __uint_as_float(r[0]) + __uint_as_float(r[1]); }
    return v;
}
__device__ __forceinline__ float rdlane(float v, int i) { return __int_as_float(__builtin_amdgcn_readlane(__float_as_int(v), i)); }


#ifndef PROBE_T
#define PROBE_T 0
#endif
#define TS_LDS(F) ((volatile LAS unsigned long long*)((F).lds + LDSCTL_OFF + 128))
#define TS_START(F, id) do { if (PROBE_T == (id) && blockIdx.x == 0 && (F).tid == 0) TS_LDS(F)[1] = __builtin_amdgcn_s_memtime(); } while (0)
#define TS_STOP(F, id)  do { if (PROBE_T == (id) && blockIdx.x == 0 && (F).tid == 0) TS_LDS(F)[0] += __builtin_amdgcn_s_memtime() - TS_LDS(F)[1]; } while (0)
#define XB_TMO      128
#define XB_XCNT(j)  (256  + 64 * (j))
#define XB_XSUB(j)  (1280 + 64 * (j))
#define XB_XGEN(j)  (2304 + 64 * (j))
#define XB_TOP      3328
#define XB_TOPGEN   3392
#define XCD_BAR_WORDS 3456
#define XB_SPIN_CAP (1u << 18)

__device__ __forceinline__ unsigned xb_ld(unsigned* p)              { return __hip_atomic_load(p, __ATOMIC_RELAXED, __HIP_MEMORY_SCOPE_AGENT); }
__device__ __forceinline__ unsigned xb_add(unsigned* p, unsigned v) { return __hip_atomic_fetch_add(p, v, __ATOMIC_RELAXED, __HIP_MEMORY_SCOPE_AGENT); }
__device__ __forceinline__ unsigned xb_xcc_id() { return (unsigned)__builtin_amdgcn_s_getreg((3 << 11) | 20) & 0xFu; }
#define XB_SPIN(cond, bar) do { unsigned _sp = 0; while (cond) { __builtin_amdgcn_s_sleep(1); \
    if ((++_sp & 255u) == 0u) { if (xb_ld(&(bar)[XB_TMO])) break; if (_sp > XB_SPIN_CAP) { atomicAdd(&(bar)[XB_TMO], 1u); break; } } } } while (0)

struct XcdBarrier {
    unsigned* bar; unsigned x;
    volatile LAS unsigned* st;
};

__device__ __forceinline__ XcdBarrier xcd_barrier_post(unsigned* bar, volatile LAS unsigned* st) {
    XcdBarrier b; b.bar = bar; b.x = xb_xcc_id(); b.st = st;
    if (threadIdx.x == 0) (void)xb_add(&bar[XB_XCNT(b.x)], 1u);
    return b;
}
__device__ __forceinline__ void xcd_barrier_complete(unsigned* bar, unsigned x, unsigned& nloc, unsigned& nx) {
    const unsigned G = gridDim.x * gridDim.y * gridDim.z;
    unsigned sum, cnt, mine, sp = 0u;
    for (;;) {
        sum = 0u; cnt = 0u; mine = 0u;
#pragma unroll
        for (unsigned j = 0; j < 16; ++j) { const unsigned c = xb_ld(&bar[XB_XCNT(j)]); sum += c; cnt += (c > 0u) ? 1u : 0u; mine = (j == x) ? c : mine; }
        if (sum == G) break;
        __builtin_amdgcn_s_sleep(1);
        if ((++sp & 255u) == 0u) { if (xb_ld(&bar[XB_TMO])) break; if (sp > XB_SPIN_CAP) { atomicAdd(&bar[XB_TMO], 1u); break; } }
    }
    nloc = mine > 0u ? mine : 1u; nx = cnt > 0u ? cnt : 1u;
}

__device__ __forceinline__ void xcd_barrier(const XcdBarrier& b) {
    asm volatile("s_waitcnt vmcnt(0)" ::: "memory");
    __syncthreads();
    if (threadIdx.x == 0) {
        unsigned* bar = b.bar;
        __builtin_amdgcn_s_waitcnt(0);
        unsigned nloc = b.st[0], nx = b.st[1];
        if (nloc == 0u) { xcd_barrier_complete(bar, b.x, nloc, nx); b.st[0] = nloc; b.st[1] = nx; }
        const unsigned old = xb_add(&bar[XB_XSUB(b.x)], 1u);
        const unsigned gen = old / nloc;
        if (old + 1u == (gen + 1u) * nloc) {
            __builtin_amdgcn_fence(__ATOMIC_RELEASE, "agent");
            asm volatile("s_waitcnt vmcnt(0)" ::: "memory");
            const unsigned og = xb_add(&bar[XB_TOP], 1u);
            const unsigned tg = og / nx;
            if (og + 1u == (tg + 1u) * nx) xb_add(&bar[XB_TOPGEN], 1u);
            else XB_SPIN(xb_ld(&bar[XB_TOPGEN]) == tg, bar);
            __builtin_amdgcn_fence(__ATOMIC_ACQUIRE, "agent");
            xb_add(&bar[XB_XGEN(b.x)], 1u);
            asm volatile("s_waitcnt vmcnt(0)" ::: "memory");
        } else {
            XB_SPIN(xb_ld(&bar[XB_XGEN(b.x)]) == gen, bar);
            __builtin_amdgcn_fence(__ATOMIC_ACQUIRE, "agent");
            asm volatile("s_waitcnt vmcnt(0)" ::: "memory");
        }
    }
    __syncthreads();
}

struct Ctx {
    LAS unsigned char* lds; int tid, lane, wave, vcu, G, gw, NGW;
    const float *x, *c, *ctx, *c_ctx, *w_mod, *b_mod, *g_pre, *g_post, *w_in, *w_out, *hgrn_lb, *hgrn_gn, *gate_b, *mlstm_gn, *na_rpb;
    float* out; bf16 *wt_in, *wt_out, *hxy, *P; float *mod, *gates, *ctx1, *stm, *sth, *rope; bf16 *otm, *oth, *UX;
};

struct TrJob { const float* W; int N, Nnew; bool remap; bf16* WT; int item; };
__device__ __forceinline__ void tr_load(const TrJob& J, f32x4 (&v)[8], int lane) {
    const int nblk = J.Nnew / 32, kb = J.item / nblk, nb = J.item % nblk, k0 = 64 * kb, n0 = 32 * nb;
    const int rg = lane >> 3, c4 = (lane & 7) * 4, nn = n0 + c4;
    int no = nn; if (J.remap) no = nn < 3200 ? nn : (nn < 4736 ? nn + 16 : (nn < 4752 ? 3200 + nn - 4736 : -1));
#pragma unroll
    for (int j = 0; j < 8; ++j) v[j] = no >= 0 ? __builtin_nontemporal_load((const f32x4*)(J.W + (size_t)(k0 + 8 * j + rg) * J.N + no)) : (f32x4){0.f, 0.f, 0.f, 0.f};
}
__device__ __forceinline__ void tr_finish(const TrJob& J, const f32x4 (&v)[8], LAS float* scr, int lane) {
    const int nblk = J.Nnew / 32, kb = J.item / nblk, nb = J.item % nblk, k0 = 64 * kb, n0 = 32 * nb;
    const int rg = lane >> 3, c4 = (lane & 7) * 4;
#pragma unroll
    for (int j = 0; j < 8; ++j) { LAS float* d = scr + (8 * j + rg) * 33 + c4; d[0] = v[j][0]; d[1] = v[j][1]; d[2] = v[j][2]; d[3] = v[j][3]; }
    LDS_WAIT(); asm volatile("" ::: "memory");
    const int c = lane & 7;
#pragma unroll
    for (int j = 0; j < 4; ++j) { const int n = (lane >> 3) + 8 * j; const LAS float* s = scr + (8 * c) * 33 + n;
        v4u o; o.x = pk2(s[0 * 33], s[1 * 33]); o.y = pk2(s[2 * 33], s[3 * 33]); o.z = pk2(s[4 * 33], s[5 * 33]); o.w = pk2(s[6 * 33], s[7 * 33]);
        *(GAS v4u*)(J.WT + (size_t)(n0 + n) * 1024 + k0 + 8 * c) = o; }
    LDS_WAIT(); asm volatile("" ::: "memory");
}
template <class Dec>
__device__ __forceinline__ void transpose_run(const Dec& dec, int first, int total, int step, LAS float* scr, int lane) {
    for (int it = first; it < total; it += 2 * step) {
        const bool hasB = it + step < total;
        const TrJob A = dec(it), B = dec(hasB ? it + step : it);
        f32x4 va[8], vb[8];
        tr_load(A, va, lane); tr_load(B, vb, lane);
        tr_finish(A, va, scr, lane);
        if (hasB) tr_finish(B, vb, scr, lane);
    }
}
__device__ __forceinline__ void phase_p0(const Ctx& F) {
    if (F.vcu < 96) {
        LAS float* tab = (LAS float*)(F.lds);
        LAS float* part = (LAS float*)(F.lds + 36864);
        for (int i = F.tid; i < 9 * 1024; i += 512) { const int r = i >> 10, k = i & 1023; const float v = r < 8 ? F.c[r * 1024 + k] : F.c_ctx[k]; tab[i] = silu_f(v); }
        __syncthreads();
        for (int it = F.vcu; it < 96; it += F.G) {
            const int l = it / 48, jb = it % 48;
            const int rsub = F.lane >> 4, c4 = (F.lane & 15) * 4;
            float acc[9][4];
#pragma unroll
            for (int r = 0; r < 9; ++r) { acc[r][0] = acc[r][1] = acc[r][2] = acc[r][3] = 0.f; }
            const float* wp = F.w_mod + ((size_t)l * 1024 + F.wave * 128 + rsub) * 3072 + jb * 64 + c4;
            f32x4 wv[32];
#pragma unroll
            for (int j = 0; j < 32; ++j) wv[j] = __builtin_nontemporal_load((const f32x4*)(wp + (size_t)(4 * j) * 3072));
#pragma unroll
            for (int j = 0; j < 32; ++j)
#pragma unroll
                for (int r = 0; r < 9; ++r) { const float t = tab[r * 1024 + F.wave * 128 + 4 * j + rsub]; acc[r][0] += t * wv[j][0]; acc[r][1] += t * wv[j][1]; acc[r][2] += t * wv[j][2]; acc[r][3] += t * wv[j][3]; }
#pragma unroll
            for (int r = 0; r < 9; ++r)
#pragma unroll
                for (int e = 0; e < 4; ++e) acc[r][e] = xor32_sum(xor16_sum(acc[r][e]));
            if (rsub == 0) {
#pragma unroll
                for (int r = 0; r < 9; ++r) *(LAS f32x4*)(part + (F.wave * 9 + r) * 64 + c4) = (f32x4){acc[r][0], acc[r][1], acc[r][2], acc[r][3]}; }
            __syncthreads();
            for (int i = F.tid; i < 9 * 64; i += 512) { const int r = i >> 6, j = i & 63; float s = 0.f;
#pragma unroll
                for (int w = 0; w < 8; ++w) s += part[(w * 9 + r) * 64 + j];
                F.mod[((size_t)l * 9 + r) * 3072 + jb * 64 + j] = s + F.b_mod[l * 3072 + jb * 64 + j]; }
            __syncthreads();
        }
    }
    if (F.vcu == 96 % F.G) for (int i = F.tid; i < 64 * 24; i += 512) { const int pos = i / 24, f = i % 24; const float ang = (float)pos * expf(-(float)(2 * f) * (1.f / 48.f) * 9.210340371976184f); F.rope[2 * i] = cosf(ang); F.rope[2 * i + 1] = sinf(ang); }
    __syncthreads();
    LAS float* scr = (LAS float*)(F.lds + F.wave * 16384);
    constexpr int I_IN = 16 * (NPAD / 32), I_OUT = 16 * 32;
    const bool split = F.G > 96;
    if (split && F.vcu < 96) return;
    transpose_run([&](int it) {
        if (it < I_IN) return TrJob{F.w_in, PIN, NPAD, true, F.wt_in, it};
        if (it < I_IN + I_OUT) return TrJob{F.w_out, 1024, 1024, false, F.wt_out, it - I_IN};
        if (it < 2 * I_IN + I_OUT) return TrJob{F.w_in + (size_t)1024 * PIN, PIN, NPAD, true, F.wt_in + (size_t)NPAD * 1024, it - I_IN - I_OUT};
        return TrJob{F.w_out + (size_t)1024 * 1024, 1024, 1024, false, F.wt_out + (size_t)1024 * 1024, it - 2 * I_IN - I_OUT}; },
        split ? (F.vcu - 96) * 8 + F.wave : F.gw, 2 * I_IN + 2 * I_OUT, split ? (F.G - 96) * 8 : F.NGW, scr, F.lane);
}

struct RowPar { float4 g[4], a[4], b[4]; };
__device__ __forceinline__ void load_par(RowPar& p, const float* g, const float* a, const float* b, int lane) {
#pragma unroll
    for (int j = 0; j < 4; ++j) { const int d = 4 * (lane + 64 * j); p.g[j] = *(const float4*)(g + d); p.a[j] = *(const float4*)(a + d); p.b[j] = *(const float4*)(b + d); }
}
__device__ __forceinline__ void prenorm_store(const float4 (&v)[4], float ss, const RowPar& p, bf16* dst, int lane) {
    const float rinv = __builtin_amdgcn_rsqf(ss * (1.f / 1024.f) + EPS);
#pragma unroll
    for (int j = 0; j < 4; ++j) {
        const int d = 4 * (lane + 64 * j);
        const float o0 = v[j].x * rinv * p.g[j].x * (1.f + p.a[j].x) + p.b[j].x, o1 = v[j].y * rinv * p.g[j].y * (1.f + p.a[j].y) + p.b[j].y;
        const float o2 = v[j].z * rinv * p.g[j].z * (1.f + p.a[j].z) + p.b[j].z, o3 = v[j].w * rinv * p.g[j].w * (1.f + p.a[j].w) + p.b[j].w;
        uint2 w; w.x = pk2(o0, o1); w.y = pk2(o2, o3);
        *(uint2*)(dst + d) = w;
    }
}
__device__ __forceinline__ void phase_prenorm0(const Ctx& F) {
    auto rowsrc = [&](int m) -> const float* { return m < MX ? F.x + (size_t)m * 1024 : F.ctx + (size_t)(m - MX) * 1024; };
    const int nrow = (M + F.NGW - 1) / F.NGW, m0 = F.gw * nrow, m1 = min(m0 + nrow, M);
    if (m0 >= m1) return;
    float4 nv[4];
#pragma unroll
    for (int j = 0; j < 4; ++j) { const f32x4 t = __builtin_nontemporal_load((const f32x4*)rowsrc(m0) + F.lane + 64 * j); nv[j] = make_float4(t[0], t[1], t[2], t[3]); }
    RowPar p; int rcur = -1;
    for (int m = m0; m < m1; ++m) {
        const int r = m < MX ? m / S : 8;
        if (r != rcur) { const float* mod_r = F.mod + (size_t)r * 3072; load_par(p, F.g_pre, mod_r + 1024, mod_r, F.lane); rcur = r; }
        float4 v[4];
#pragma unroll
        for (int j = 0; j < 4; ++j) v[j] = nv[j];
        if (m + 1 < m1) {
#pragma unroll
            for (int j = 0; j < 4; ++j) { const f32x4 t = __builtin_nontemporal_load((const f32x4*)rowsrc(m + 1) + F.lane + 64 * j); nv[j] = make_float4(t[0], t[1], t[2], t[3]); } }
        float ss = 0.f;
#pragma unroll
        for (int j = 0; j < 4; ++j) ss += v[j].x * v[j].x + v[j].y * v[j].y + v[j].z * v[j].z + v[j].w * v[j].w;
        ss = wave_sum(ss);
        prenorm_store(v, ss, p, F.hxy + (size_t)m * 1024, F.lane);
    }
}
typedef unsigned u32x2_t __attribute__((ext_vector_type(2)));
__device__ __forceinline__ void post_rows(const Ctx& F, int l, int m0, int m1) {
    const float* mod_l = F.mod + (size_t)l * 9 * 3072; const float* g_post_l = F.g_post + l * 1024;
    auto rowsrc = [&](int m) -> const float* { return m < MX ? F.x + (size_t)m * 1024 : F.ctx + (size_t)(m - MX) * 1024; };
    if (m0 >= m1) return;
    float4 nx[4]; uint2 nxb[4]; uint2 nu[4];
#pragma unroll
    for (int j = 0; j < 4; ++j) {
        if (l == 0) nx[j] = ((const float4*)rowsrc(m0))[F.lane + 64 * j]; else nxb[j] = ((const uint2*)(F.out + (size_t)m0 * 1024))[F.lane + 64 * j];
        nu[j] = ((const uint2*)(F.UX + (size_t)m0 * 1024))[F.lane + 64 * j]; }
    float4 pg[4], pt[4]; RowPar p2; int rcur = -1;
#pragma unroll
    for (int j = 0; j < 4; ++j) pg[j] = *(const float4*)(g_post_l + 4 * (F.lane + 64 * j));
    for (int m = m0; m < m1; ++m) {
        float* dst; int r;
        if (m < MX) { dst = F.out + (size_t)m * 1024; r = m / S; } else { dst = F.ctx1 + (size_t)(m - MX) * 1024; r = 8; }
        if (r != rcur) {
#pragma unroll
            for (int j = 0; j < 4; ++j) pt[j] = *(const float4*)(mod_l + r * 3072 + 2048 + 4 * (F.lane + 64 * j));
            if (l == 0) load_par(p2, F.g_pre + 1024, F.mod + (size_t)(9 + r) * 3072 + 1024, F.mod + (size_t)(9 + r) * 3072, F.lane);
            rcur = r; }
        float4 xr[4], u[4]; float ss = 0.f;
#pragma unroll
        for (int j = 0; j < 4; ++j) {
            if (l == 0) xr[j] = nx[j];
            else { const uint2 w = nxb[j]; xr[j].x = __uint_as_float(w.x << 16); xr[j].y = __uint_as_float(w.x & 0xffff0000u); xr[j].z = __uint_as_float(w.y << 16); xr[j].w = __uint_as_float(w.y & 0xffff0000u); }
            const uint2 w = nu[j];
            u[j].x = __uint_as_float(w.x << 16); u[j].y = __uint_as_float(w.x & 0xffff0000u); u[j].z = __uint_as_float(w.y << 16); u[j].w = __uint_as_float(w.y & 0xffff0000u);
            ss += u[j].x * u[j].x + u[j].y * u[j].y + u[j].z * u[j].z + u[j].w * u[j].w; }
        if (m + 1 < m1) {
#pragma unroll
            for (int j = 0; j < 4; ++j) {
                if (l == 0) nx[j] = ((const float4*)rowsrc(m + 1))[F.lane + 64 * j]; else nxb[j] = ((const uint2*)(F.out + (size_t)(m + 1) * 1024))[F.lane + 64 * j];
                nu[j] = ((const uint2*)(F.UX + (size_t)(m + 1) * 1024))[F.lane + 64 * j]; } }
        ss = wave_sum(ss);
        const float rinv = __builtin_amdgcn_rsqf(ss * (1.f / 1024.f) + EPS);
        float ss2 = 0.f;
        const bool as_bf16 = (l == 0) && (m < MX);
#pragma unroll
        for (int j = 0; j < 4; ++j) {
            const int d = 4 * (F.lane + 64 * j);
            const float4 g = pg[j], t = pt[j], xv = xr[j];
            float4 o; o.x = xv.x + t.x * (u[j].x * rinv * g.x); o.y = xv.y + t.y * (u[j].y * rinv * g.y); o.z = xv.z + t.z * (u[j].z * rinv * g.z); o.w = xv.w + t.w * (u[j].w * rinv * g.w);
            if (as_bf16) { u32x2_t w2; w2.x = pk2(o.x, o.y); w2.y = pk2(o.z, o.w); __builtin_nontemporal_store(w2, (u32x2_t*)dst + F.lane + 64 * j); }
            else __builtin_nontemporal_store((f32x4){o.x, o.y, o.z, o.w}, (f32x4*)(dst + d));
            u[j] = o; ss2 += o.x * o.x + o.y * o.y + o.z * o.z + o.w * o.w;
        }
        if (l == 0) { ss2 = wave_sum(ss2); prenorm_store(u, ss2, p2, F.hxy + (size_t)m * 1024, F.lane); }
    }
}

constexpr int SPEC_ROWS = 0;
__device__ __forceinline__ void phase_post(const Ctx& F, int l, unsigned* cnt) {
    if (l == 1) { const int nrow = (MX + F.NGW - 1) / F.NGW, m0 = F.gw * nrow; post_rows(F, 1, m0, min(m0 + nrow, MX)); return; }
    const int bx = blockIdx.x, G = F.G;
    if (bx < 32) {
        const int t = bx & 7, pn = bx >> 3;
        TS_START(F, 60);
        { pg8::Gemm g{F.hxy, F.wt_out, M, 1024, 1024}; pg8::OneUnit SO{128 + t, pn}; pg8::EpiOutWT E{F.UX};
          pg8::gemm_phase<pg8::EpiOutWT, pg8::OneUnit, true, true>(F.lds + RING_OFF, g, SO, E); }
        if (F.tid == 0) (void)xb_add(cnt + 16 * t, 1u);
        TS_STOP(F, 60);
        { const int sw = (t * 4 + pn) * 8 + F.wave; post_rows(F, 0, SPEC_ROWS * sw, SPEC_ROWS * sw + SPEC_ROWS); }
    } else {
        const int nr = (G % 8 == 0) ? (bx & 7) * (G / 8 - 4) + ((bx >> 3) - 4) : bx - 32;
        const int NW = (G - 32) * 8, gwn = nr * 8 + F.wave;
        constexpr int L0 = 256 * SPEC_ROWS;
        const int m0 = L0 + (int)(((long)gwn * (MX - L0)) / NW), m1 = L0 + (int)(((long)(gwn + 1) * (MX - L0)) / NW);
        post_rows(F, 0, m0, m1);
        const int c0 = (int)(((long)gwn * MC) / NW), c1 = (int)(((long)(gwn + 1) * MC) / NW);
        if (c0 < c1) {
            const int ta = c0 >> 8, tb = (c1 - 1) >> 8;
            { unsigned sp = 0; while (xb_ld(cnt + 16 * ta) < 4u || xb_ld(cnt + 16 * tb) < 4u) { __builtin_amdgcn_s_sleep(2); if (++sp > (1u << 22)) break; } }
            __builtin_amdgcn_fence(__ATOMIC_ACQUIRE, "agent");
            post_rows(F, 0, MX + c0, MX + c1);
        }
    }
}


typedef short s16x4 __attribute__((ext_vector_type(4)));
typedef short v4i16_t __attribute__((ext_vector_type(4)));
__device__ __forceinline__ s16x4 tr_read(const LAS bf16* p) { return __builtin_bit_cast(s16x4, __builtin_amdgcn_ds_read_tr16_b64_v4i16((LAS v4i16_t*)p)); }
__device__ __forceinline__ bf16x8 tr_frag(const LAS bf16* T, int stride, int rowA, int rowB, int col0, int lane) {
    const int q = (lane >> 2) & 3, p = lane & 3;
    const s16x4 lo = tr_read(T + (rowA + q) * stride + col0 + 4 * p), hi = tr_read(T + (rowB + q) * stride + col0 + 4 * p);
    return (bf16x8){lo[0], lo[1], lo[2], lo[3], hi[0], hi[1], hi[2], hi[3]};
}
__device__ __forceinline__ bf16x8 rm_frag(const LAS bf16* T, int stride, int row, int k0) { return *(const LAS bf16x8*)(T + row * stride + k0); }
__device__ __forceinline__ f32x4 mfma16(bf16x8 a, bf16x8 b, f32x4 c) { return __builtin_amdgcn_mfma_f32_16x16x32_bf16(a, b, c, 0, 0, 0); }
typedef unsigned v2u __attribute__((ext_vector_type(2)));
typedef float f32x2 __attribute__((ext_vector_type(2)));
__device__ __forceinline__ void unpack8(const v4u w, float* f) {
    f[0] = __uint_as_float(w.x << 16); f[1] = __uint_as_float(w.x & 0xffff0000u); f[2] = __uint_as_float(w.y << 16); f[3] = __uint_as_float(w.y & 0xffff0000u);
    f[4] = __uint_as_float(w.z << 16); f[5] = __uint_as_float(w.z & 0xffff0000u); f[6] = __uint_as_float(w.w << 16); f[7] = __uint_as_float(w.w & 0xffff0000u);
}
__device__ __forceinline__ v4u pack8(const float* f) { v4u w; w.x = pk2(f[0], f[1]); w.y = pk2(f[2], f[3]); w.z = pk2(f[4], f[5]); w.w = pk2(f[6], f[7]); return w; }

__device__ __forceinline__ float wave_scan_incl(float x) {
    int v = __float_as_int(x);
#define DPP_ADD(ctrl, rmask) v = __float_as_int(__int_as_float(v) + __int_as_float(__builtin_amdgcn_update_dpp(0, v, ctrl, rmask, 0xF, false)))
    DPP_ADD(0x111, 0xF); DPP_ADD(0x112, 0xF); DPP_ADD(0x114, 0xF); DPP_ADD(0x118, 0xF); DPP_ADD(0x142, 0xA); DPP_ADD(0x143, 0xC);
#undef DPP_ADD
    return __int_as_float(v);
}
#define LDS_FENCE() asm volatile("" ::: "memory")
namespace ml {
constexpr int QSTR = 104, VSTR = 120;
constexpr int OFF_QS = 0, OFF_KS = OFF_QS + 64 * QSTR * 2, OFF_VS = OFF_KS + 64 * QSTR * 2, OFF_CT = OFF_VS + 64 * VSTR * 2;
constexpr int OFF_HT = OFF_CT + 2 * 112 * QSTR * 2, OFF_DEN = OFF_HT + 64 * 100 * 4, OFF_ROPE = OFF_DEN + 256, OFF_END = OFF_ROPE + 64 * 24 * 8;
static_assert(OFF_END <= RING_BYTES && 6 * 7 * 64 * 16 <= OFF_HT, "mlstm LDS");
constexpr int ST_FLOATS = 96 * 112 + 16;
}
constexpr int NSEG = 4, SEGTOK = S / NSEG, SEGCH = SEGTOK / 64;
struct MlJob { int b, h, isctx, t0, nchunk; };

__device__ __forceinline__ void mlstm_dir(const Ctx& F, int l, const MlJob jb, int dir, int fold_r, int emit_slot, int mode, bf16* otmp, float* ST) {
    using namespace ml;
    int tid_ = F.tid; asm volatile("" : "+v"(tid_));
    const int w = __builtin_amdgcn_readfirstlane(tid_ >> 6);
    const bool isd = (w < 4) || (w >= 6); const int dw = w < 4 ? w : w - 2;
    const bool tsel = (mode != 0) && !jb.isctx && l == 0;
    if (tsel) TS_START(F, 10);
    LAS bf16* QS = (LAS bf16*)(F.lds + OFF_QS); LAS bf16* KS = (LAS bf16*)(F.lds + OFF_KS); LAS bf16* VS = (LAS bf16*)(F.lds + OFF_VS);
    LAS bf16* CT0 = (LAS bf16*)(F.lds + OFF_CT); LAS float* HT = (LAS float*)(F.lds + OFF_HT); LAS float* DEN = (LAS float*)(F.lds + OFF_DEN);
    const LAS f32x2* ROPE = (const LAS f32x2*)(F.lds + OFF_ROPE);
    const int rowbase = jb.isctx ? MX + jb.b * CTX : jb.b * S;
    const int h = jb.h; const bf16* P = F.P;
    float* STd = ST + (size_t)(((jb.b * 4 + h) * 2 + dir) * 8) * ST_FLOATS;
    f32x4 Cst[7];
#pragma unroll
    for (int et = 0; et < 7; ++et) Cst[et] = (f32x4){0.f, 0.f, 0.f, 0.f};
    if (fold_r >= 0) {
        LAS f32x4* FOLD = (LAS f32x4*)(F.lds + OFF_QS);
        float wk[8];
        { float bs[8]; bs[0] = 0.f;
#pragma unroll
          for (int k = 1; k < NSEG; ++k) bs[k] = STd[(size_t)k * ST_FLOATS + 96 * 112];
          float run = 1.f;
#pragma unroll
          for (int k = NSEG - 1; k >= 0; --k) { wk[k] = (k <= fold_r) ? run : 0.f; run = (k >= 1 && k <= fold_r) ? run * __expf(bs[k]) : run; } }
#pragma unroll 2
        for (int p = tid_; p < 6 * 7 * 64; p += 512) {
            f32x4 v[8];
#pragma unroll
            for (int k = 0; k < NSEG; ++k) v[k] = *(const f32x4*)(STd + (size_t)k * ST_FLOATS + 4 * p);
            f32x4 acc = v[0] * wk[0];
#pragma unroll
            for (int k = 1; k < NSEG; ++k) acc += v[k] * wk[k];
            FOLD[p] = acc;
        }
        __syncthreads();
        if (isd) {
#pragma unroll
            for (int et = 0; et < 7; ++et) Cst[et] = FOLD[(dw * 7 + et) * 64 + (tid_ & 63)];
        }
        __syncthreads();
    }
    asm volatile("" : "+v"(tid_));
    const int tid = tid_, lane = tid & 63, g = lane >> 4, c = lane & 15;
    float Btot = 0.f;
    for (int i = tid; i < 64 * 16; i += 512) { const int s = i >> 4, e = 96 + (i & 15); VS[s * VSTR + e] = (e == 96) ? (bf16)0x3F80 : (bf16)0; }
    if (isd) {
#pragma unroll
        for (int et = 0; et < 7; ++et) { v2u v; v.x = pk2(Cst[et][0], Cst[et][1]); v.y = pk2(Cst[et][2], Cst[et][3]); *(LAS v2u*)(CT0 + (16 * et + c) * QSTR + 16 * dw + 4 * g) = v; }
    }
    const bool hasqk = tid < 384; const int qk_tok = tid / 6, qk_pi = tid % 6, qk_part = qk_pi / 3, qk_pp = qk_pi % 3, qk_d0 = 48 * qk_part + 8 * qk_pp;
    const int v1_tok = tid / 12, v1_pc = tid % 12; const bool hasv2 = tid < 256; const int v2_tok = (512 + tid) / 12, v2_pc = (512 + tid) % 12;
    struct LoadSet { v4u q0, q1, k0, k1, v1, v2; float ig, lf; };
    LoadSet LA;
    v2u ft[3], fo[3], fz[3];
    f32x4 fg[3];
#pragma unroll
    for (int q4 = 0; q4 < 3; ++q4) fg[q4] = (f32x4){0.f, 0.f, 0.f, 0.f};
    const int fi_i = tid >> 3, fi_e0 = 12 * (tid & 7);
#pragma unroll
    for (int q4 = 0; q4 < 3; ++q4) { ft[q4] = (v2u){0u, 0u}; fo[q4] = (v2u){0u, 0u}; fz[q4] = (v2u){0u, 0u}; }
    LA.q0 = LA.q1 = LA.k0 = LA.k1 = LA.v1 = LA.v2 = (v4u){0u, 0u, 0u, 0u}; LA.ig = LA.lf = 0.f;
    auto tok_of = [&](int ci, int i) -> int { return dir == 0 ? jb.t0 + 64 * ci + i : jb.t0 + 64 * (jb.nchunk - 1 - ci) + (63 - i); };
    auto issue_loads = [&](LoadSet& L, int ci) {
        if (hasqk) { const bf16* pr = P + (size_t)(rowbase + tok_of(ci, qk_tok)) * PLD + h * 96 + qk_d0;
            if (mode != 0) { L.q0 = *(const v4u*)(pr + B_Q); L.q1 = *(const v4u*)(pr + B_Q + 24); }
            L.k0 = *(const v4u*)(pr + B_K); L.k1 = *(const v4u*)(pr + B_K + 24); }
        L.v1 = *(const v4u*)(P + (size_t)(rowbase + tok_of(ci, v1_tok)) * PLD + B_V + h * 96 + 8 * v1_pc);
        if (hasv2) L.v2 = *(const v4u*)(P + (size_t)(rowbase + tok_of(ci, v2_tok)) * PLD + B_V + h * 96 + 8 * v2_pc);
        const float* gp = F.gates + (size_t)(rowbase + tok_of(ci, lane)) * 16 + dir * 4 + h; L.ig = gp[0]; L.lf = gp[8];
    };
    auto issue_fin = [&](int ci) {
        const int m = rowbase + tok_of(ci, fi_i); const bf16* tp = otmp + (size_t)m * 384 + h * 96 + fi_e0; const bf16* pr = P + (size_t)m * PLD + h * 96 + fi_e0;
#pragma unroll
        for (int q4 = 0; q4 < 3; ++q4) { ft[q4] = *(const v2u*)(tp + 4 * q4); fo[q4] = *(const v2u*)(pr + B_O + 4 * q4); fz[q4] = *(const v2u*)(pr + B_Z + 4 * q4); fg[q4] = *(const f32x4*)(F.mlstm_gn + l * 384 + h * 96 + fi_e0 + 4 * q4); }
    };
    auto finalize = [&](int ci) {
            const int i = tid >> 3, sub = tid & 7, e0 = 12 * sub; const int m = rowbase + tok_of(ci, i);
            float hv[12]; const float rden = __builtin_amdgcn_rcpf(fmaxf(fabsf(DEN[i]), 1.f));
#pragma unroll
            for (int q4 = 0; q4 < 3; ++q4) { const f32x4 v = *(const LAS f32x4*)(HT + i * 100 + e0 + 4 * q4); hv[4 * q4] = v[0] * rden; hv[4 * q4 + 1] = v[1] * rden; hv[4 * q4 + 2] = v[2] * rden; hv[4 * q4 + 3] = v[3] * rden; }
            bf16* tp = otmp + (size_t)m * 384 + h * 96 + e0;
            if (mode == 1) {
#pragma unroll
                for (int q4 = 0; q4 < 3; ++q4) { v2u v; v.x = pk2(hv[4 * q4], hv[4 * q4 + 1]); v.y = pk2(hv[4 * q4 + 2], hv[4 * q4 + 3]); *(v2u*)(tp + 4 * q4) = v; }
            } else {
                float ss = 0.f;
#pragma unroll
                for (int q4 = 0; q4 < 3; ++q4) { const v2u v = ft[q4];
                    hv[4 * q4] += __uint_as_float(v.x << 16); hv[4 * q4 + 1] += __uint_as_float(v.x & 0xffff0000u); hv[4 * q4 + 2] += __uint_as_float(v.y << 16); hv[4 * q4 + 3] += __uint_as_float(v.y & 0xffff0000u); }
#pragma unroll
                for (int e = 0; e < 12; ++e) ss += hv[e] * hv[e];
                ss = group8_sum(ss);
                const float rinv = __builtin_amdgcn_rsqf(ss * (1.f / 96.f) + EPS);
                bf16* yp = F.hxy + (size_t)m * 1024 + 256 + h * 96 + e0;
#pragma unroll
                for (int q4 = 0; q4 < 3; ++q4) { const v2u ov = fo[q4], zv = fz[q4];
                    const float og[4] = {__uint_as_float(ov.x << 16), __uint_as_float(ov.x & 0xffff0000u), __uint_as_float(ov.y << 16), __uint_as_float(ov.y & 0xffff0000u)};
                    const float zg[4] = {__uint_as_float(zv.x << 16), __uint_as_float(zv.x & 0xffff0000u), __uint_as_float(zv.y << 16), __uint_as_float(zv.y & 0xffff0000u)};
                    float o[4];
#pragma unroll
                    for (int e = 0; e < 4; ++e) o[e] = og[e] * (hv[4 * q4 + e] * rinv * fg[q4][e]) * zg[e];
                    v2u v; v.x = pk2(o[0], o[1]); v.y = pk2(o[2], o[3]); *(v2u*)(yp + 4 * q4) = v; }
            }
    };
    struct Packed { v4u k0, k1, q0, q1, v1, v2; float bL, ebL; };
    auto stage_math = [&](LoadSet& L, int ci, Packed& K) {
        const float bcs = wave_scan_incl(L.lf);
        const float qsc = __expf(bcs), ksc = __expf(L.ig - bcs);
        K.bL = rdlane(bcs, 63); K.ebL = __expf(K.bL);
        if (hasqk) {
            const float ks_t = __shfl(ksc, qk_tok), qs_t = __shfl(qsc, qk_tok);
            float cs[8], sn[8];
            if (!jb.isctx) { const int t = tok_of(ci, qk_tok); const int pos = qk_part ? (t & 63) : (t >> 6);
#pragma unroll
                for (int e = 0; e < 8; ++e) { const f32x2 v = ROPE[pos * 24 + 8 * qk_pp + e]; cs[e] = v[0]; sn[e] = v[1]; } }
            else {
#pragma unroll
                for (int e = 0; e < 8; ++e) { cs[e] = 1.f; sn[e] = 0.f; } }
            float a[8], b2[8], o0[8], o1[8];
            unpack8(L.k0, a); unpack8(L.k1, b2);
#pragma unroll
            for (int e = 0; e < 8; ++e) { o0[e] = (a[e] * cs[e] - b2[e] * sn[e]) * ks_t; o1[e] = (b2[e] * cs[e] + a[e] * sn[e]) * ks_t; }
            K.k0 = pack8(o0); K.k1 = pack8(o1);
            if (mode != 0) {
                unpack8(L.q0, a); unpack8(L.q1, b2);
#pragma unroll
                for (int e = 0; e < 8; ++e) { o0[e] = (a[e] * cs[e] - b2[e] * sn[e]) * qs_t; o1[e] = (b2[e] * cs[e] + a[e] * sn[e]) * qs_t; }
                K.q0 = pack8(o0); K.q1 = pack8(o1);
            }
        } else { (void)__shfl(ksc, 0); (void)__shfl(qsc, 0); }
        K.v1 = L.v1; K.v2 = L.v2;
    };
    auto stage_write = [&](const Packed& K) {
        if (hasqk) {
            *(LAS v4u*)(KS + qk_tok * QSTR + qk_d0) = K.k0; *(LAS v4u*)(KS + qk_tok * QSTR + qk_d0 + 24) = K.k1;
            if (mode != 0) { *(LAS v4u*)(QS + qk_tok * QSTR + qk_d0) = K.q0; *(LAS v4u*)(QS + qk_tok * QSTR + qk_d0 + 24) = K.q1; }
        }
        *(LAS v4u*)(VS + v1_tok * VSTR + 8 * v1_pc) = K.v1;
        if (hasv2) *(LAS v4u*)(VS + v2_tok * VSTR + 8 * v2_pc) = K.v2;
    };
    Packed PK; PK.k0 = PK.k1 = PK.q0 = PK.q1 = PK.v1 = PK.v2 = (v4u){0u, 0u, 0u, 0u}; PK.bL = 0.f; PK.ebL = 1.f;
    issue_loads(LA, 0);
    __syncthreads();
    stage_math(LA, 0, PK); stage_write(PK);
    if (jb.nchunk > 1) issue_loads(LA, 1);
    float bL = PK.bL, ebL = PK.ebL;
    __syncthreads();
    if (tsel) TS_STOP(F, 10);
    auto chunk_step = [&](LoadSet& Lnext, int ci) {
        LAS bf16* CTc = CT0 + (ci & 1) * 112 * QSTR; LAS bf16* CTn = CT0 + ((ci + 1) & 1) * 112 * QSTR;
        if (mode == 2) issue_fin(ci);
        if (ci + 1 < jb.nchunk) { stage_math(Lnext, ci + 1, PK); if (ci + 2 < jb.nchunk) issue_loads(Lnext, ci + 2); }
        if (mode != 0) {
            const int jh = (w >> 1) & 1, tt = w < 4 ? 1 - (w & 1) : 2 + (w & 1);
            bf16x8 qf[3], kf[4][3];
#pragma unroll
            for (int ks = 0; ks < 3; ++ks) qf[ks] = rm_frag(QS, QSTR, 16 * tt + c, 32 * ks + 8 * g);
#pragma unroll
            for (int ss = 0; ss < 4; ++ss) if (ss <= tt) {
#pragma unroll
                for (int ks = 0; ks < 3; ++ks) kf[ss][ks] = rm_frag(KS, QSTR, 16 * ss + c, 32 * ks + 8 * g); }
            LDS_FENCE();
            f32x4 st[4];
#pragma unroll
            for (int ss = 0; ss < 4; ++ss) { st[ss] = (f32x4){0.f, 0.f, 0.f, 0.f};
                if (ss <= tt) {
#pragma unroll
                    for (int ks = 0; ks < 3; ++ks) st[ss] = mfma16(kf[ss][ks], qf[ks], st[ss]);
                    if (ss == tt) {
#pragma unroll
                        for (int r = 0; r < 4; ++r) if (4 * g + r > c) st[ss][r] = 0.f; }
                } }
            bf16x8 pf[2];
#pragma unroll
            for (int kk = 0; kk < 2; ++kk) { const unsigned u0 = pk2(st[2 * kk][0], st[2 * kk][1]), u1 = pk2(st[2 * kk][2], st[2 * kk][3]), u2 = pk2(st[2 * kk + 1][0], st[2 * kk + 1][1]), u3 = pk2(st[2 * kk + 1][2], st[2 * kk + 1][3]);
                pf[kk] = __builtin_bit_cast(bf16x8, (v4u){u0, u1, u2, u3}); }
#pragma unroll
            for (int eb = 0; eb < 4; eb += 2) {
                bf16x8 vf[2][2], cf[2][3];
#pragma unroll
                for (int e2 = 0; e2 < 2; ++e2) { const int et = 4 * jh + eb + e2;
                    if (et < 7) {
#pragma unroll
                        for (int kk = 0; kk < 2; ++kk) if (2 * kk <= tt) vf[e2][kk] = tr_frag(VS, VSTR, 32 * kk + 4 * g, 32 * kk + 16 + 4 * g, 16 * et, lane);
#pragma unroll
                        for (int ks = 0; ks < 3; ++ks) cf[e2][ks] = rm_frag(CTc, QSTR, 16 * et + c, 32 * ks + 8 * g); } }
                LDS_FENCE();
#pragma unroll
                for (int e2 = 0; e2 < 2; ++e2) { const int et = 4 * jh + eb + e2;
                    if (et < 7) {
                        f32x4 acc = (f32x4){0.f, 0.f, 0.f, 0.f};
#pragma unroll
                        for (int kk = 0; kk < 2; ++kk) if (2 * kk <= tt) acc = mfma16(vf[e2][kk], pf[kk], acc);
#pragma unroll
                        for (int ks = 0; ks < 3; ++ks) acc = mfma16(cf[e2][ks], qf[ks], acc);
                        if (et < 6) *(LAS f32x4*)(HT + (16 * tt + c) * 100 + 16 * et + 4 * g) = acc;
                        else if (g == 0) DEN[16 * tt + c] = acc[0];
                    } }
            }
        }
        if (isd) {
#pragma unroll
            for (int kk = 0; kk < 2; ++kk) {
                bf16x8 vf[7]; const bf16x8 af = tr_frag(KS, QSTR, 32 * kk + 8 * g, 32 * kk + 8 * g + 4, 16 * dw, lane);
#pragma unroll
                for (int et = 0; et < 7; ++et) vf[et] = tr_frag(VS, VSTR, 32 * kk + 8 * g, 32 * kk + 8 * g + 4, 16 * et, lane);
                LDS_FENCE();
#pragma unroll
                for (int et = 0; et < 7; ++et) Cst[et] = mfma16(af, vf[et], Cst[et]);
            }
#pragma unroll
            for (int et = 0; et < 7; ++et) { Cst[et] = Cst[et] * ebL;
                if (mode != 0) { v2u v; v.x = pk2(Cst[et][0], Cst[et][1]); v.y = pk2(Cst[et][2], Cst[et][3]); *(LAS v2u*)(CTn + (16 * et + c) * QSTR + 16 * dw + 4 * g) = v; } }
        }
        Btot += bL;
        __syncthreads();
        if (ci + 1 < jb.nchunk) { stage_write(PK); bL = PK.bL; ebL = PK.ebL; }
        if (mode != 0) finalize(ci);
        __syncthreads();
    };
    for (int ci = 0; ci < jb.nchunk; ++ci) chunk_step(LA, ci);
    if (emit_slot >= 0 && isd) {
        float* sl = STd + (size_t)emit_slot * ST_FLOATS;
#pragma unroll
        for (int et = 0; et < 7; ++et) *(f32x4*)(sl + ((dw * 7 + et) * 64 + lane) * 4) = Cst[et];
        if (w == 0 && lane == 0) sl[96 * 112] = Btot;
    }
    __syncthreads();
}
__device__ __forceinline__ void mlstm_load_rope(const Ctx& F, const float* rope_tab) {
    LAS f32x2* ROPE = (LAS f32x2*)(F.lds + ml::OFF_ROPE);
    for (int i = F.tid; i < 64 * 24; i += 512) ROPE[i] = ((const f32x2*)rope_tab)[i];
}
__device__ __forceinline__ void mlstm_itemA(const Ctx& F, int l, int bh, int it, bf16* otmp, float* ST) {
    const int b = bh >> 2, h = bh & 3;
    if (it == 0) {
        const MlJob jb{b, h, 1, 0, 4};
        mlstm_dir(F, l, jb, 0, -1, 0, l == 0 ? 1 : 0, otmp, ST);
        mlstm_dir(F, l, jb, 1, -1, 0, l == 0 ? 2 : 0, otmp, ST);
    } else {
        const int dir = (it - 1) / (NSEG - 1), k = (it - 1) % (NSEG - 1), seg = dir == 0 ? k : NSEG - 1 - k;
        const MlJob jb{b, h, 0, SEGTOK * seg, SEGCH};
        mlstm_dir(F, l, jb, dir, -1, 1 + k, 0, otmp, ST);
    }
}
__device__ __forceinline__ void mlstm_itemC(const Ctx& F, int l, int bh, int seg, bf16* otmp, float* ST) {
    const MlJob jb{bh >> 2, bh & 3, 0, SEGTOK * seg, SEGCH};
    mlstm_dir(F, l, jb, 0, seg, -1, 1, otmp, ST);
    mlstm_dir(F, l, jb, 1, NSEG - 1 - seg, -1, 2, otmp, ST);
}

namespace hg {
constexpr int STR = 72;
constexpr int IMG = 64 * STR * 2;
constexpr int OFF_KO = 0, OFF_KH = IMG, OFF_VS = 2 * IMG, OFF_QJ = 3 * IMG, OFF_ST = 7 * IMG, OFF_HT = 9 * IMG, OFF_TOT = OFF_HT + 64 * 68 * 4, OFF_BL = OFF_TOT + 8 * 64 * 4, OFF_END = OFF_BL + 512;
static_assert(OFF_END <= RING_BYTES, "hgrn LDS");
constexpr int ST_FLOATS = 64 * 64 + 64;
}
__device__ __forceinline__ void hgrn_dir(const Ctx& F, int l, const MlJob jb, int dir, int fold_r, int emit_slot, int mode, bf16* otmp, float* ST) {
    using namespace hg;
    int tid_ = F.tid; asm volatile("" : "+v"(tid_));
    const int tid = tid_, lane = tid & 63, w = __builtin_amdgcn_readfirstlane(tid >> 6), g = lane >> 4, c = lane & 15;
    LAS bf16* KO = (LAS bf16*)(F.lds + OFF_KO); LAS bf16* KH = (LAS bf16*)(F.lds + OFF_KH); LAS bf16* VS = (LAS bf16*)(F.lds + OFF_VS); LAS bf16* QJ = (LAS bf16*)(F.lds + OFF_QJ);
    LAS bf16* ST0 = (LAS bf16*)(F.lds + OFF_ST); LAS float* HT = (LAS float*)(F.lds + OFF_HT); LAS float* TOT = (LAS float*)(F.lds + OFF_TOT); LAS float* BL = (LAS float*)(F.lds + OFF_BL);
    const int rowbase = jb.isctx ? MX + jb.b * CTX : jb.b * S;
    const int h = jb.h; const bf16* P = F.P;
    float* STd = ST + (size_t)(((jb.b * 4 + h) * 2 + dir) * 8) * ST_FLOATS;
    const int dt = w >> 1, et0 = 2 * (w & 1);
    f32x4 Sst[2]; float Btot[4];
#pragma unroll
    for (int i = 0; i < 2; ++i) Sst[i] = (f32x4){0.f, 0.f, 0.f, 0.f};
#pragma unroll
    for (int r = 0; r < 4; ++r) Btot[r] = 0.f;
    const int ps = lane, d0 = 8 * w;
    float lb0[8], lb1[8];
#pragma unroll
    for (int e = 0; e < 8; ++e) { lb0[e] = 0.f; lb1[e] = 0.f;
        if (l == 1) { lb0[e] = F.hgrn_lb[(0 * 2 + dir) * 256 + h * 64 + d0 + e]; lb1[e] = F.hgrn_lb[(1 * 2 + dir) * 256 + h * 64 + d0 + e]; } }
    const int fcol = dir ? A_FB : A_FF;
    auto tok_of = [&](int ci, int i) -> int { return dir == 0 ? jb.t0 + 64 * ci + i : jb.t0 + 64 * (jb.nchunk - 1 - ci) + (63 - i); };
    v4u rq, rf, rv; rq = rf = rv = (v4u){0u, 0u, 0u, 0u};
    v4u ft = (v4u){0u, 0u, 0u, 0u}, fz = (v4u){0u, 0u, 0u, 0u};
    const int fi_i = tid >> 3, fi_e0 = 8 * (tid & 7);
    float gnv[8];
#pragma unroll
    for (int e = 0; e < 8; ++e) gnv[e] = (mode == 2) ? F.hgrn_gn[l * 256 + h * 64 + fi_e0 + e] : 0.f;
    auto issue_loads = [&](int ci) {
        const bf16* pr = P + (size_t)(rowbase + tok_of(ci, ps)) * PLD + h * 64 + d0;
        if (mode != 0) rq = *(const v4u*)(pr + A_Q);
        rf = *(const v4u*)(pr + fcol); rv = *(const v4u*)(pr + A_I);
    };
    auto issue_fin = [&](int ci) { const int m = rowbase + tok_of(ci, fi_i); ft = *(const v4u*)(otmp + (size_t)m * 256 + h * 64 + fi_e0); fz = *(const v4u*)(P + (size_t)m * PLD + A_Z + h * 64 + fi_e0); };
    issue_loads(0);
    if (fold_r >= 0) {
        f32x4 v[8][2], dk[8];
#pragma unroll
        for (int k = 0; k < NSEG; ++k) { const float* sl = STd + (size_t)k * ST_FLOATS; v[k][0] = *(const f32x4*)(sl + ((w * 2 + 0) * 64 + lane) * 4); v[k][1] = *(const f32x4*)(sl + ((w * 2 + 1) * 64 + lane) * 4);
            dk[k] = *(const f32x4*)(sl + 64 * 64 + 16 * dt + 4 * g); }
        f32x4 run = (f32x4){1.f, 1.f, 1.f, 1.f};
#pragma unroll
        for (int k = NSEG - 1; k >= 0; --k) { const float on = (k <= fold_r) ? 1.f : 0.f; Sst[0] += v[k][0] * (run * on); Sst[1] += v[k][1] * (run * on);
            if (k >= 1) { const bool use = k <= fold_r; run[0] *= use ? __builtin_amdgcn_exp2f(dk[k][0]) : 1.f; run[1] *= use ? __builtin_amdgcn_exp2f(dk[k][1]) : 1.f; run[2] *= use ? __builtin_amdgcn_exp2f(dk[k][2]) : 1.f; run[3] *= use ? __builtin_amdgcn_exp2f(dk[k][3]) : 1.f; } }
    }
    if (mode != 0) {
#pragma unroll
        for (int i = 0; i < 2; ++i) { v2u v; v.x = pk2(Sst[i][0], Sst[i][1]); v.y = pk2(Sst[i][2], Sst[i][3]); *(LAS v2u*)(ST0 + (16 * (et0 + i) + c) * STR + 16 * dt + 4 * g) = v; }
    }
    float lbv[8];
#pragma unroll
    for (int e = 0; e < 8; ++e) lbv[e] = (l == 1) ? __builtin_amdgcn_rcpf(1.f + __expf(lb0[e] - lb1[e])) : 0.f;
    __syncthreads();
    for (int ci = 0; ci < jb.nchunk; ++ci) {
        LAS bf16* STc = ST0 + (ci & 1) * 64 * STR; LAS bf16* STn = ST0 + ((ci + 1) & 1) * 64 * STR;
        {
            float qv[8], kk[8], bb[8], fl[8];
            unpack8(rf, fl);
#pragma unroll
            for (int e = 0; e < 8; ++e) { const float sg = sigmoid_f(fl[e]); const float f = lbv[e] + (1.f - lbv[e]) * sg; bb[e] = __builtin_amdgcn_logf(fmaxf(f, 1e-30f)); kk[e] = (1.f - lbv[e]) * (1.f - sg); }
            if (mode != 0) unpack8(rq, qv);
            const v4u vraw = rv;
            if (ci + 1 < jb.nchunk) issue_loads(ci + 1);
            if (mode == 2) issue_fin(ci);
            float ref1[8], ref2[8], ref3[8], bl[8];
#pragma unroll
            for (int e = 0; e < 8; ++e) { bb[e] = wave_scan_incl(bb[e]); ref1[e] = rdlane(bb[e], 15); ref2[e] = rdlane(bb[e], 31); ref3[e] = rdlane(bb[e], 47); bl[e] = rdlane(bb[e], 63); }
            const int sub = lane >> 4;
            const float se1 = sub == 1 ? 1.f : 0.f, se2 = sub == 2 ? 1.f : 0.f, se3 = sub == 3 ? 1.f : 0.f;
            float o8[8];
            if (mode != 0) {
#pragma unroll
                for (int e = 0; e < 8; ++e) { const float rown = se1 * ref1[e] + se2 * ref2[e] + se3 * ref3[e]; o8[e] = kk[e] * __builtin_amdgcn_exp2f(rown - bb[e]); }
                *(LAS v4u*)(KO + ps * STR + d0) = pack8(o8); }
#pragma unroll
            for (int e = 0; e < 8; ++e) o8[e] = kk[e] * __builtin_amdgcn_exp2f(bl[e] - bb[e]);
            *(LAS v4u*)(KH + ps * STR + d0) = pack8(o8);
            *(LAS v4u*)(VS + ps * STR + d0) = vraw;
            if (mode != 0) {
#pragma unroll
                for (int e = 0; e < 8; ++e) o8[e] = qv[e] * __builtin_amdgcn_exp2f(bb[e]);
                *(LAS v4u*)(QJ + ps * STR + d0) = pack8(o8);
                if (sub >= 1) {
#pragma unroll
                    for (int e = 0; e < 8; ++e) o8[e] = qv[e] * __builtin_amdgcn_exp2f(bb[e] - ref1[e]);
                    *(LAS v4u*)(QJ + (64 + ps) * STR + d0) = pack8(o8); }
                if (sub >= 2) {
#pragma unroll
                    for (int e = 0; e < 8; ++e) o8[e] = qv[e] * __builtin_amdgcn_exp2f(bb[e] - ref2[e]);
                    *(LAS v4u*)(QJ + (128 + ps) * STR + d0) = pack8(o8); }
                if (sub >= 3) {
#pragma unroll
                    for (int e = 0; e < 8; ++e) o8[e] = qv[e] * __builtin_amdgcn_exp2f(bb[e] - ref3[e]);
                    *(LAS v4u*)(QJ + (192 + ps) * STR + d0) = pack8(o8); }
            }
            if (lane == 0) { *(LAS f32x4*)(BL + d0) = (f32x4){bl[0], bl[1], bl[2], bl[3]}; *(LAS f32x4*)(BL + d0 + 4) = (f32x4){bl[4], bl[5], bl[6], bl[7]}; }
        }
        __syncthreads();
        if (mode != 0) {
            const int eh = w >> 2, tt = eh ? 3 - (w & 3) : (w & 3);
            f32x4 at[4];
            { bf16x8 kf[4][2], qjf[4][2];
#pragma unroll
              for (int j = 0; j < 4; ++j) if (j <= tt) {
#pragma unroll
                  for (int ks = 0; ks < 2; ++ks) { kf[j][ks] = rm_frag(KO, STR, 16 * j + c, 32 * ks + 8 * g); qjf[j][ks] = rm_frag(QJ + j * 64 * STR, STR, 16 * tt + c, 32 * ks + 8 * g); } }
              LDS_FENCE();
#pragma unroll
              for (int j = 0; j < 4; ++j) { at[j] = (f32x4){0.f, 0.f, 0.f, 0.f};
                  if (j <= tt) {
#pragma unroll
                      for (int ks = 0; ks < 2; ++ks) at[j] = mfma16(kf[j][ks], qjf[j][ks], at[j]);
                      if (j == tt) {
#pragma unroll
                          for (int r = 0; r < 4; ++r) if (4 * g + r > c) at[j][r] = 0.f; }
                  } } }
            bf16x8 pf[2];
#pragma unroll
            for (int k2 = 0; k2 < 2; ++k2) { const unsigned u0 = pk2(at[2 * k2][0], at[2 * k2][1]), u1 = pk2(at[2 * k2][2], at[2 * k2][3]), u2 = pk2(at[2 * k2 + 1][0], at[2 * k2 + 1][1]), u3 = pk2(at[2 * k2 + 1][2], at[2 * k2 + 1][3]);
                pf[k2] = __builtin_bit_cast(bf16x8, (v4u){u0, u1, u2, u3}); }
            { bf16x8 qf[2], vf[2][2], sf[2][2];
#pragma unroll
              for (int ks = 0; ks < 2; ++ks) qf[ks] = rm_frag(QJ, STR, 16 * tt + c, 32 * ks + 8 * g);
#pragma unroll
              for (int ei = 0; ei < 2; ++ei) { const int et = 2 * eh + ei;
#pragma unroll
                  for (int k2 = 0; k2 < 2; ++k2) if (2 * k2 <= tt) vf[ei][k2] = tr_frag(VS, STR, 32 * k2 + 4 * g, 32 * k2 + 16 + 4 * g, 16 * et, lane);
#pragma unroll
                  for (int ks = 0; ks < 2; ++ks) sf[ei][ks] = rm_frag(STc, STR, 16 * et + c, 32 * ks + 8 * g); }
              LDS_FENCE();
#pragma unroll
              for (int ei = 0; ei < 2; ++ei) { const int et = 2 * eh + ei;
                  f32x4 acc = (f32x4){0.f, 0.f, 0.f, 0.f};
#pragma unroll
                  for (int k2 = 0; k2 < 2; ++k2) if (2 * k2 <= tt) acc = mfma16(vf[ei][k2], pf[k2], acc);
#pragma unroll
                  for (int ks = 0; ks < 2; ++ks) acc = mfma16(sf[ei][ks], qf[ks], acc);
                  *(LAS f32x4*)(HT + (16 * tt + c) * 68 + 16 * et + 4 * g) = acc; } }
        }
        {
            const f32x4 blv = *(const LAS f32x4*)(BL + 16 * dt + 4 * g);
#pragma unroll
            for (int r = 0; r < 4; ++r) { const float dec = __builtin_amdgcn_exp2f(blv[r]); Sst[0][r] *= dec; Sst[1][r] *= dec; Btot[r] += blv[r]; }
            { bf16x8 af[2], vf[2][2];
#pragma unroll
              for (int k2 = 0; k2 < 2; ++k2) { af[k2] = tr_frag(KH, STR, 32 * k2 + 8 * g, 32 * k2 + 8 * g + 4, 16 * dt, lane);
#pragma unroll
                  for (int i = 0; i < 2; ++i) vf[k2][i] = tr_frag(VS, STR, 32 * k2 + 8 * g, 32 * k2 + 8 * g + 4, 16 * (et0 + i), lane); }
              LDS_FENCE();
#pragma unroll
              for (int k2 = 0; k2 < 2; ++k2)
#pragma unroll
                  for (int i = 0; i < 2; ++i) Sst[i] = mfma16(af[k2], vf[k2][i], Sst[i]); }
            if (mode != 0) {
#pragma unroll
                for (int i = 0; i < 2; ++i) { v2u v; v.x = pk2(Sst[i][0], Sst[i][1]); v.y = pk2(Sst[i][2], Sst[i][3]); *(LAS v2u*)(STn + (16 * (et0 + i) + c) * STR + 16 * dt + 4 * g) = v; } }
        }
        __syncthreads();
        if (mode != 0) {
            const int i = tid >> 3, sub8 = tid & 7, e0 = 8 * sub8; const int m = rowbase + tok_of(ci, i);
            float hv[8];
            { const f32x4 a0 = *(const LAS f32x4*)(HT + i * 68 + e0), a1 = *(const LAS f32x4*)(HT + i * 68 + e0 + 4); hv[0] = a0[0]; hv[1] = a0[1]; hv[2] = a0[2]; hv[3] = a0[3]; hv[4] = a1[0]; hv[5] = a1[1]; hv[6] = a1[2]; hv[7] = a1[3]; }
            bf16* tp = otmp + (size_t)m * 256 + h * 64 + e0;
            if (mode == 1) *(v4u*)tp = pack8(hv);
            else {
                float tv[8]; unpack8(ft, tv);
                float ss = 0.f;
#pragma unroll
                for (int e = 0; e < 8; ++e) { hv[e] += tv[e]; ss += hv[e] * hv[e]; }
                ss = group8_sum(ss);
                const float rinv = __builtin_amdgcn_rsqf(ss * (1.f / 64.f) + EPS);
                float zv[8]; unpack8(fz, zv);
#pragma unroll
                for (int e = 0; e < 8; ++e) hv[e] = hv[e] * rinv * gnv[e] * zv[e];
                *(v4u*)(F.hxy + (size_t)m * 1024 + h * 64 + e0) = pack8(hv);
            }
        }
    }
    if (emit_slot >= 0) {
        float* sl = STd + (size_t)emit_slot * ST_FLOATS;
        *(f32x4*)(sl + ((w * 2 + 0) * 64 + lane) * 4) = Sst[0]; *(f32x4*)(sl + ((w * 2 + 1) * 64 + lane) * 4) = Sst[1];
        if ((w & 1) == 0 && c == 0) *(f32x4*)(sl + 64 * 64 + 16 * dt + 4 * g) = (f32x4){Btot[0], Btot[1], Btot[2], Btot[3]};
    }
    __syncthreads();
}
__device__ __forceinline__ void hgrn_itemA(const Ctx& F, int l, int bh, int it, bf16* otmp, float* ST) {
    const int b = bh >> 2, h = bh & 3;
    if (it == 0) {
        const MlJob jb{b, h, 1, 0, 4};
        hgrn_dir(F, l, jb, 0, -1, 0, l == 0 ? 1 : 0, otmp, ST);
        hgrn_dir(F, l, jb, 1, -1, 0, l == 0 ? 2 : 0, otmp, ST);
    } else {
        const int dir = (it - 1) / (NSEG - 1), k = (it - 1) % (NSEG - 1), seg = dir == 0 ? k : NSEG - 1 - k;
        const MlJob jb{b, h, 0, SEGTOK * seg, SEGCH};
        hgrn_dir(F, l, jb, dir, -1, 1 + k, 0, otmp, ST);
    }
}
__device__ __forceinline__ void hgrn_itemC(const Ctx& F, int l, int bh, int seg, bf16* otmp, float* ST) {
    const MlJob jb{bh >> 2, bh & 3, 0, SEGTOK * seg, SEGCH};
    hgrn_dir(F, l, jb, 0, seg, -1, 1, otmp, ST);
    hgrn_dir(F, l, jb, 1, NSEG - 1 - seg, -1, 2, otmp, ST);
}

namespace nat {
constexpr int STR = 72, IMG = 64 * STR * 2;
constexpr int OFF_K = 0, OFF_V = 2 * IMG, OFF_RPB = 4 * IMG, OFF_END = OFF_RPB + 2304;
static_assert(OFF_END <= RING_BYTES, "na LDS");
}
template <int CH, bool WIN>
__device__ __forceinline__ void na_block(const LAS bf16* Kc, const LAS bf16* Vc, const LAS float* RPB, const bf16x8 (&qf)[2][2], f32x4 (&oacc)[2][4], float (&mrun)[2], float (&lrun)[2],
                                         const int g, const int c, const int lane, const int dr, const int (&qcol)[2], const bool (&mk)[2][4][4]) {
    constexpr int STR = nat::STR;
    constexpr int KLO[2] = {WIN ? (CH == 0 ? 0 : 1) : 0, WIN ? (CH == 0 ? 0 : 2) : 0}, KHI[2] = {WIN ? (CH == 0 ? 1 : 3) : 3, WIN ? (CH == 0 ? 2 : 3) : 3};
    constexpr int ULO = KLO[0] < KLO[1] ? KLO[0] : KLO[1], UHI = KHI[0] > KHI[1] ? KHI[0] : KHI[1];
    f32x4 st[2][4];
    { bf16x8 kf[4][2];
#pragma unroll
      for (int kt = ULO; kt <= UHI; ++kt)
#pragma unroll
          for (int ks = 0; ks < 2; ++ks) kf[kt][ks] = rm_frag(Kc, STR, 16 * kt + c, 32 * ks + 8 * g);
      if (WIN) {
#pragma unroll
          for (int qt = 0; qt < 2; ++qt) { const LAS float* rp = RPB + (dr * 31 + 63 - qcol[qt] + 4 * g);
#pragma unroll
              for (int kt = KLO[qt]; kt <= KHI[qt]; ++kt)
#pragma unroll
                  for (int r = 0; r < 4; ++r) st[qt][kt][r] = rp[16 * kt + r]; } }
      LDS_FENCE();
#pragma unroll
      for (int qt = 0; qt < 2; ++qt)
#pragma unroll
          for (int kt = 0; kt < 4; ++kt) {
              if (WIN && kt >= KLO[qt] && kt <= KHI[qt]) {
#pragma unroll
                  for (int r = 0; r < 4; ++r) st[qt][kt][r] = mk[qt][kt][r] ? st[qt][kt][r] : -1e30f; }
              else st[qt][kt] = (f32x4){0.f, 0.f, 0.f, 0.f}; }
      __builtin_amdgcn_s_setprio(1);
#pragma unroll
      for (int qt = 0; qt < 2; ++qt)
#pragma unroll
          for (int kt = 0; kt < 4; ++kt) {
              if (kt >= KLO[qt] && kt <= KHI[qt]) {
#pragma unroll
                  for (int ks = 0; ks < 2; ++ks) st[qt][kt] = mfma16(kf[kt][ks], qf[qt][ks], st[qt][kt]); } }
      __builtin_amdgcn_s_setprio(0); }
    float alpha[2]; bf16x8 pf[2][2];
#pragma unroll
    for (int qt = 0; qt < 2; ++qt) {
        float bm = -1e30f;
#pragma unroll
        for (int kt = KLO[qt]; kt <= KHI[qt]; ++kt)
#pragma unroll
            for (int r = 0; r < 4; ++r) bm = fmaxf(bm, st[qt][kt][r]);
        bm = xor32_max(xor16_max(bm));
        const float mnew = fmaxf(mrun[qt], bm); alpha[qt] = __builtin_amdgcn_exp2f(mrun[qt] - mnew); mrun[qt] = mnew;
        float ps = 0.f;
#pragma unroll
        for (int kt = KLO[qt]; kt <= KHI[qt]; ++kt)
#pragma unroll
            for (int r = 0; r < 4; ++r) { const float p = __builtin_amdgcn_exp2f(st[qt][kt][r] - mnew); st[qt][kt][r] = p; ps += p; }
        lrun[qt] = lrun[qt] * alpha[qt] + ps;
#pragma unroll
        for (int k2 = 0; k2 < 2; ++k2) { const unsigned u0 = pk2(st[qt][2 * k2][0], st[qt][2 * k2][1]), u1 = pk2(st[qt][2 * k2][2], st[qt][2 * k2][3]), u2 = pk2(st[qt][2 * k2 + 1][0], st[qt][2 * k2 + 1][1]), u3 = pk2(st[qt][2 * k2 + 1][2], st[qt][2 * k2 + 1][3]);
            pf[qt][k2] = __builtin_bit_cast(bf16x8, (v4u){u0, u1, u2, u3}); }
    }
    { bf16x8 vf[4][2];
#pragma unroll
      for (int dtl = 0; dtl < 4; ++dtl)
#pragma unroll
          for (int k2 = ULO / 2; k2 <= UHI / 2; ++k2) vf[dtl][k2] = tr_frag(Vc, STR, 32 * k2 + 4 * g, 32 * k2 + 16 + 4 * g, 16 * dtl, lane);
      LDS_FENCE();
      __builtin_amdgcn_s_setprio(1);
#pragma unroll
      for (int qt = 0; qt < 2; ++qt)
#pragma unroll
          for (int dtl = 0; dtl < 4; ++dtl) { f32x4 a = oacc[qt][dtl] * alpha[qt];
#pragma unroll
              for (int k2 = KLO[qt] / 2; k2 <= KHI[qt] / 2; ++k2) a = mfma16(vf[dtl][k2], pf[qt][k2], a);
              oacc[qt][dtl] = a; }
      __builtin_amdgcn_s_setprio(0); }
}
__device__ __forceinline__ void na_item(const Ctx& F, int l, int b, int h, int R0) {
    using namespace nat;
    int tid_ = F.tid; asm volatile("" : "+v"(tid_));
    const int tid = tid_, lane = tid & 63, w = __builtin_amdgcn_readfirstlane(tid >> 6), g = lane >> 4, c = lane & 15;
    LAS bf16* KT = (LAS bf16*)(F.lds + OFF_K); LAS bf16* VT = (LAS bf16*)(F.lds + OFF_V); LAS float* RPB = (LAS float*)(F.lds + OFF_RPB);
    const bf16* P = F.P; const bool lat = R0 >= 0;
    const int R = R0 + (w >> 1), ch = w & 1;
    const int rsR = min(max(R - 4, 0), 56);
    const int kr0 = lat ? min(max(R0 - 4, 0), 56) : 0;
    const int nwin = lat ? (min(max(R0 + 3 - 4, 0), 56) + 8 - kr0) : 0, nblk = nwin + 4;
    const float* rpb_g = F.na_rpb + ((size_t)l * 6 + h) * 465;
    const float rpb_a = rpb_g[min(max(tid - 48, 0), 464)], rpb_b = rpb_g[min(tid + 512 - 48, 464)];
    int mq[2]; bf16x8 qf[2][2]; int csq[2], qcol[2];
#pragma unroll
    for (int qt = 0; qt < 2; ++qt) {
        if (lat) { qcol[qt] = 32 * ch + 16 * qt + c; mq[qt] = b * S + R * 64 + qcol[qt]; } else { qcol[qt] = 0; mq[qt] = MX + b * CTX + 32 * w + 16 * qt + c; }
        csq[qt] = min(max(qcol[qt] - 8, 0), 48);
#pragma unroll
        for (int ks = 0; ks < 2; ++ks) qf[qt][ks] = *(const bf16x8*)(P + (size_t)mq[qt] * PLD + C_Q + h * 64 + 32 * ks + 8 * g);
    }
    bool mk[2][4][4];
#pragma unroll
    for (int qt = 0; qt < 2; ++qt)
#pragma unroll
        for (int kt = 0; kt < 4; ++kt)
#pragma unroll
            for (int r = 0; r < 4; ++r) mk[qt][kt][r] = (unsigned)(16 * kt + 4 * g + r - csq[qt]) < 16u;
    v2u zreg[2][4];
#pragma unroll
    for (int qt = 0; qt < 2; ++qt)
#pragma unroll
        for (int dtl = 0; dtl < 4; ++dtl) zreg[qt][dtl] = *(const v2u*)(P + (size_t)mq[qt] * PLD + C_Z + h * 64 + 16 * dtl + 4 * g);
    f32x4 oacc[2][4]; float mrun[2], lrun[2];
#pragma unroll
    for (int qt = 0; qt < 2; ++qt) { mrun[qt] = -1e30f; lrun[qt] = 0.f;
#pragma unroll
        for (int dtl = 0; dtl < 4; ++dtl) oacc[qt][dtl] = (f32x4){0.f, 0.f, 0.f, 0.f}; }
    const int stok = tid >> 3, spc = tid & 7;
    auto blk_row = [&](int i) -> int { return i < nwin ? b * S + (kr0 + i) * 64 + stok : MX + b * CTX + 64 * (i - nwin) + stok; };
    v4u rk0, rv0, rk1, rv1, rk2, rv2, rk3, rv3;
    auto ld = [&](int i, v4u& k_, v4u& v_) { const int ii = i < nblk ? i : nblk - 1; const bf16* pr = P + (size_t)blk_row(ii) * PLD + h * 64 + 8 * spc; k_ = *(const v4u*)(pr + C_K); v_ = *(const v4u*)(pr + C_V); };
    ld(0, rk0, rv0); ld(1, rk1, rv1); ld(2, rk2, rv2); ld(3, rk3, rv3);
    __syncthreads();
    if (lat) { RPB[tid] = (tid >= 48) ? rpb_a * 1.4426950408889634f : 0.f; if (tid < 64) RPB[tid + 512] = (tid + 512 < 513) ? rpb_b * 1.4426950408889634f : 0.f; }
    *(LAS v4u*)(KT + stok * STR + 8 * spc) = rk0; *(LAS v4u*)(VT + stok * STR + 8 * spc) = rv0;
    ld(4, rk0, rv0);
    __syncthreads();
    auto step = [&](int i, v4u& kn, v4u& vn) {
        const LAS bf16* Kc = KT + (i & 1) * 64 * STR; const LAS bf16* Vc = VT + (i & 1) * 64 * STR;
        if (i + 1 < nblk) { LAS bf16* Kn = KT + ((i + 1) & 1) * 64 * STR; LAS bf16* Vn = VT + ((i + 1) & 1) * 64 * STR;
            *(LAS v4u*)(Kn + stok * STR + 8 * spc) = kn; *(LAS v4u*)(Vn + stok * STR + 8 * spc) = vn;
            if (i + 5 < nblk) ld(i + 5, kn, vn); }
        const bool win = i < nwin; const int kr = kr0 + i;
        const bool active = !win || (kr >= rsR && kr < rsR + 8);
        if (active) {
            if (!win) na_block<0, false>(Kc, Vc, RPB, qf, oacc, mrun, lrun, g, c, lane, 0, qcol, mk);
            else if (ch == 0) na_block<0, true>(Kc, Vc, RPB, qf, oacc, mrun, lrun, g, c, lane, kr - R + 7, qcol, mk);
            else na_block<1, true>(Kc, Vc, RPB, qf, oacc, mrun, lrun, g, c, lane, kr - R + 7, qcol, mk);
        }
        __syncthreads();
    };
    for (int i = 0; i < nblk; i += 4) { step(i, rk1, rv1); if (i + 1 < nblk) step(i + 1, rk2, rv2); if (i + 2 < nblk) step(i + 2, rk3, rv3); if (i + 3 < nblk) step(i + 3, rk0, rv0); }
#pragma unroll
    for (int qt = 0; qt < 2; ++qt) {
        const float lt = xor32_sum(xor16_sum(lrun[qt]));
        const float rl = __builtin_amdgcn_rcpf(lt);
        bf16* yr = F.hxy + (size_t)mq[qt] * 1024 + 640 + h * 64;
#pragma unroll
        for (int dtl = 0; dtl < 4; ++dtl) { const int d = 16 * dtl + 4 * g; const v2u zv = zreg[qt][dtl];
            const float z0 = silu_f(__uint_as_float(zv.x << 16)), z1 = silu_f(__uint_as_float(zv.x & 0xffff0000u)), z2 = silu_f(__uint_as_float(zv.y << 16)), z3 = silu_f(__uint_as_float(zv.y & 0xffff0000u));
            v2u o; o.x = pk2(oacc[qt][dtl][0] * rl * z0, oacc[qt][dtl][1] * rl * z1); o.y = pk2(oacc[qt][dtl][2] * rl * z2, oacc[qt][dtl][3] * rl * z3);
            *(v2u*)(yr + d) = o; }
    }
}

__device__ __forceinline__ void phase_mixA(const Ctx& F, int l, unsigned* ticket) {
    if (l == 0 && (int)blockIdx.x < pg8::DeferOrder::NDEF) {
        pg8::Gemm g{F.hxy, F.wt_in, M, NPAD, 1024}; pg8::EpiIn E{F.P, F.gates, F.gate_b}; pg8::OneUnit SO{(int)blockIdx.x, 0};
        pg8::gemm_phase<pg8::EpiIn, pg8::OneUnit, true, true>(F.lds + RING_OFF, g, SO, E);
    }
    mlstm_load_rope(F, F.rope);
    volatile LAS unsigned* slot = (volatile LAS unsigned*)(F.lds + MISC_OFF) + 16;
    const int n_ctx = 64, n_na = 768, n_loc = 2 * 32 * 2 * (NSEG - 1), n_nactx = (l == 0) ? 48 : 0, n_all = n_ctx + n_na + n_loc + n_nactx;
    unsigned cur = (unsigned)blockIdx.x;
    __syncthreads();
    while ((int)cur < n_all) {
        unsigned nxt = 0;
        if (F.tid == 0) nxt = (unsigned)F.G + __hip_atomic_fetch_add(ticket, 1u, __ATOMIC_RELAXED, __HIP_MEMORY_SCOPE_AGENT);
        int it = (int)cur;
        const int tkind = it < n_ctx ? 22 : (it < n_ctx + n_loc ? 21 : 20);
        if (l == 0) { TS_START(F, tkind); if (PROBE_T == 25 && blockIdx.x == 0 && F.tid == 0) TS_LDS(F)[0] += 2000; }
        if (it < n_ctx) { if (it < 32) mlstm_itemA(F, l, it, 0, F.otm, F.stm); else hgrn_itemA(F, l, it - 32, 0, F.oth, F.sth); }
        else if ((it -= n_ctx) < n_loc) { constexpr int NL = 2 * (NSEG - 1); if (it < 32 * NL) mlstm_itemA(F, l, it / NL, 1 + it % NL, F.otm, F.stm); else { it -= 32 * NL; hgrn_itemA(F, l, it / NL, 1 + it % NL, F.oth, F.sth); } }
        else if ((it -= n_loc) < n_na) na_item(F, l, it / 96, (it / 16) % 6, 4 * (it % 16));
        else { it -= n_na; na_item(F, l, it / 6, it % 6, -1); }
        if (l == 0) TS_STOP(F, tkind);
        __syncthreads();
        if (F.tid == 0) *slot = nxt;
        __syncthreads();
        cur = *slot;
    }
}
__device__ __forceinline__ void phase_mixC(const Ctx& F, int l) {
    mlstm_load_rope(F, F.rope);
    for (int v = F.vcu; v < 2 * 32 * NSEG; v += F.G) {
        const int it = (v & 1) ? 32 * NSEG + (v >> 1) : (v >> 1);
        if (it < 32 * NSEG) mlstm_itemC(F, l, it / NSEG, it % NSEG, F.otm, F.stm);
        else hgrn_itemC(F, l, (it - 32 * NSEG) / NSEG, it % NSEG, F.oth, F.sth);
    }
}

constexpr int NPH = 12;
struct Args { const float* in[15]; float* out; unsigned char* ws; int ph_lo, ph_hi; };
__global__ void __launch_bounds__(512, 2) mega_fwd(Args args) {
    extern __shared__ __attribute__((aligned(16))) unsigned char lds[];
    Ctx F;
    F.lds = (LAS unsigned char*)lds;
    F.tid = threadIdx.x; F.lane = F.tid & 63; F.wave = __builtin_amdgcn_readfirstlane(F.tid >> 6);
    F.G = gridDim.x; { const int bx = blockIdx.x; F.vcu = (F.G % 8 == 0) ? (bx % 8) * (F.G / 8) + bx / 8 : bx; }
    F.gw = F.vcu * 8 + F.wave; F.NGW = F.G * 8;
    unsigned char* ws = args.ws;
    F.x = args.in[0]; F.c = args.in[1]; F.ctx = args.in[2]; F.c_ctx = args.in[3]; F.w_mod = args.in[4]; F.b_mod = args.in[5]; F.g_pre = args.in[6]; F.g_post = args.in[7];
    F.w_in = args.in[8]; F.w_out = args.in[9]; F.hgrn_lb = args.in[10]; F.hgrn_gn = args.in[11]; F.gate_b = args.in[12]; F.mlstm_gn = args.in[13]; F.na_rpb = args.in[14];
    F.out = args.out;
    F.wt_in = (bf16*)(ws + WS_WT_IN); F.wt_out = (bf16*)(ws + WS_WT_OUT); F.mod = (float*)(ws + WS_MOD); F.gates = (float*)(ws + WS_GATES); F.ctx1 = (float*)(ws + WS_CTX1);
    F.hxy = (bf16*)(ws + WS_HXY); F.P = (bf16*)(ws + WS_P); F.UX = (bf16*)(ws + WS_P); F.oth = (bf16*)(ws + WS_OH); F.sth = (float*)(ws + WS_STH); F.otm = (bf16*)(ws + WS_OM); F.stm = (float*)(ws + WS_STM); F.rope = (float*)(ws + WS_ROPE);
    for (int u = F.tid; u < (LDS_BYTES - LDSCTL_OFF) / 4; u += 512) ((LAS unsigned*)(F.lds + LDSCTL_OFF))[u] = 0u;
    __syncthreads();
    XcdBarrier bar = xcd_barrier_post((unsigned*)(ws + WS_CTL) + CW_BAR, (volatile LAS unsigned*)(F.lds + MISC_OFF) + 8);

    const int lo = args.ph_lo, hi = args.ph_hi;
#ifndef DUP_PHASE
#define DUP_PHASE -1
#endif
#define IN(k) (lo <= (k) && (k) < hi)
#define SEAM(k) do { if ((k) + 1 < hi) xcd_barrier(bar); } while (0)
#define PHASE(k, ...) if (IN(k)) { TS_START(F, 100 + (k)); __VA_ARGS__; if ((k) == DUP_PHASE) { xcd_barrier(bar); __VA_ARGS__; } SEAM(k); TS_STOP(F, 100 + (k)); }
    PHASE(0, phase_p0(F))
    PHASE(1, phase_prenorm0(F))
#define LAYER(l) \
    PHASE(2 + 5 * (l), { \
        pg8::Gemm g{F.hxy, F.wt_in + (size_t)(l) * NPAD * 1024, M, NPAD, 1024}; \
        pg8::EpiIn E{F.P, F.gates, F.gate_b + (l) * 16}; \
        if ((l) == 0) { pg8::DeferOrder SO; SO.init(F.G, (int)blockIdx.x); pg8::gemm_phase<pg8::EpiIn, pg8::DeferOrder, true, true>(F.lds + RING_OFF, g, SO, E); } \
        else { pg8::SkipOrder SO; SO.init(F.G, (int)blockIdx.x); pg8::gemm_phase<pg8::EpiIn, pg8::SkipOrder, true, true>(F.lds + RING_OFF, g, SO, E); } }) \
    PHASE(3 + 5 * (l), phase_mixA(F, (l), (unsigned*)(args.ws + WS_CTL) + 8192 + 64 * (l))) \
    PHASE(4 + 5 * (l), phase_mixC(F, (l))) \
    PHASE(5 + 5 * (l), { \
        constexpr int Ml = MX;     \
        pg8::Gemm g{F.hxy, F.wt_out + (size_t)(l) * 1024 * 1024, Ml, 1024, 1024}; pg8::StaticOrder SO; SO.init(Ml, 1024, F.G, (int)blockIdx.x); \
        pg8::EpiOut E{F.UX}; \
        pg8::gemm_phase<pg8::EpiOut, pg8::StaticOrder, true, true>(F.lds + RING_OFF, g, SO, E); }) \
    PHASE(6 + 5 * (l), phase_post(F, (l), (unsigned*)(args.ws + WS_CTL) + 12288))
    LAYER(0)
    LAYER(1)
#undef LAYER
#undef PHASE
#undef IN
#undef SEAM
    if (PROBE_T != 0 && blockIdx.x == 0 && F.tid == 0) { const unsigned long long t0 = __builtin_amdgcn_s_memtime(), dt = 8ull * TS_LDS(F)[0]; while (__builtin_amdgcn_s_memtime() - t0 < dt) __builtin_amdgcn_s_sleep(8); }
}

extern "C" void kernel_launch(void* const* d_in, const int* in_sizes, int n_in, void* d_out, int out_size, void* d_ws, size_t ws_size, hipStream_t stream) {
    static int grid = 0;
    if (grid == 0) {
        if (n_in != 15 || ws_size < WS_END) { fprintf(stderr, "kernel_launch: unexpected n_in %d / ws_size %zu (need %zu); nothing launched\n", n_in, ws_size, (size_t)WS_END); grid = -1; return; }
        int dev = 0, cus = 0, per_cu = 0;
        if (hipGetDevice(&dev) != hipSuccess || hipDeviceGetAttribute(&cus, hipDeviceAttributeMultiprocessorCount, dev) != hipSuccess) { grid = -1; return; }
        if (hipFuncSetAttribute((const void*)mega_fwd, hipFuncAttributeMaxDynamicSharedMemorySize, LDS_BYTES) != hipSuccess) { fprintf(stderr, "kernel_launch: hipFuncSetAttribute failed\n"); grid = -1; return; }
        if (hipOccupancyMaxActiveBlocksPerMultiprocessor(&per_cu, (const void*)mega_fwd, 512, LDS_BYTES) != hipSuccess || per_cu < 1) { fprintf(stderr, "kernel_launch: occupancy query says %d blocks/CU\n", per_cu); (void)hipGetLastError(); grid = -1; return; }
        if (cus < 128) { fprintf(stderr, "kernel_launch: %d CUs: the static work splits assume at least 128 workgroups\n", cus); grid = -1; return; }
        grid = cus;
    }
    if (grid < 0) return;
    (void)hipMemsetAsync((char*)d_ws + WS_CTL, 0, CTL_BYTES, stream);
    Args a{};
    for (int i = 0; i < 15; ++i) a.in[i] = (const float*)d_in[i];
    a.out = (float*)d_out; a.ws = (unsigned char*)d_ws; a.ph_lo = 0; a.ph_hi = NPH;
    hipLaunchKernelGGL(mega_fwd, dim3(grid), dim3(512), LDS_BYTES, stream, a);
}
```
